# Optimizing an MI355X kernel written in HIP

```python
import math, functools
import jax, jax.numpy as jnp
from jax import lax
import numpy as np

D_MODEL = 1024
BATCH = 8
SEQ = 2048
DEPTH = 2
DEC_BATCH = 128
DEC_SEQ = 8
PAST_LEN = 8192
PAGE_SIZE = 128

N_AB_LAYERS = (DEPTH + 1) // 2
N_C_LAYERS = DEPTH // 2
H_A = 4
DK_A = 128
DV_A = 128
CONV_W = 4
QKV_A = H_A * (2 * DK_A + DV_A)
H_B = 8
D_NOPE = 64
D_ROPE = 32
DV_B = 64
Q_LORA = 256
KV_LORA = 256
ROPE_BASE = 10000.0
MLA_SCALE = (D_NOPE + D_ROPE) ** -0.5
H_C = 8
DK_C = 128
DV_C = D_MODEL // H_C
D_FF = 4 * D_MODEL
CHUNK = 64
Q_BLOCK = 128
EPS = 1e-6
SPLIT_AB = (QKV_A,
            QKV_A + H_A * DV_A,
            QKV_A + H_A * DV_A + H_A,
            QKV_A + H_A * DV_A + 2 * H_A,
            QKV_A + H_A * DV_A + 2 * H_A + Q_LORA,
            QKV_A + H_A * DV_A + 2 * H_A + Q_LORA + KV_LORA)
IN_AB = SPLIT_AB[-1] + D_ROPE
OUT_AB = H_A * DV_A + H_B * DV_B
IN_C = H_C * (2 * DK_C + 2 * DV_C)
SPLIT_C = (H_C * DK_C, 2 * H_C * DK_C, 2 * H_C * DK_C + H_C * DV_C)

kernel_name = 'hybrid_gdn_mla_hgrn2_step'


def rmsnorm(x, g):
    xf = x.astype(jnp.float32)
    y = xf * lax.rsqrt(jnp.mean(xf * xf, axis=-1, keepdims=True) + EPS)
    return (y * g.astype(jnp.float32)).astype(x.dtype)


def l2norm(x):
    xf = x.astype(jnp.float32)
    return xf * lax.rsqrt(jnp.sum(xf * xf, axis=-1, keepdims=True) + EPS)


def rope(x, pos):
    half = D_ROPE // 2
    inv = ROPE_BASE ** (-jnp.arange(half, dtype=jnp.float32) / half)
    ang = pos.astype(jnp.float32)[:, None] * inv
    shape = (ang.shape[0],) + (1,) * (x.ndim - 3) + (half,)
    cos, sin = jnp.cos(ang).reshape(shape), jnp.sin(ang).reshape(shape)
    x1, x2 = x[..., :half].astype(jnp.float32), x[..., half:].astype(jnp.float32)
    return jnp.concatenate([x1 * cos - x2 * sin, x2 * cos + x1 * sin], axis=-1).astype(x.dtype)


def to_chunks(a, c):
    b, t = a.shape[:2]
    a = a.astype(jnp.float32).reshape((b, t // c, c) + a.shape[2:])
    return jnp.swapaxes(jnp.moveaxis(a, 1, 0), 2, 3)


def from_chunks(o):
    n, b, h, c, d = o.shape
    return jnp.moveaxis(jnp.swapaxes(o, 2, 3), 0, 1).reshape(b, n * c, h, d)


def gated_delta_rule(q, k, v, g, beta, s0):
    c = math.gcd(q.shape[1], CHUNK)
    q = to_chunks(q, c) * (DK_A ** -0.5)
    k, v, g, beta = (to_chunks(a, c) for a in (k, v, g, beta))
    gc = jnp.cumsum(g, axis=-1)
    incl = jnp.tril(jnp.ones((c, c), dtype=bool))
    strict = jnp.tril(jnp.ones((c, c), dtype=bool), -1)
    diff = gc[..., :, None] - gc[..., None, :]
    decay = jnp.where(incl, jnp.exp(jnp.where(incl, diff, 0.0)), 0.0)
    kb = k * beta[..., None]
    lower = jnp.where(strict, jnp.einsum('nbhid,nbhjd->nbhij', kb, k) * decay, 0.0)
    eye = jnp.eye(c, dtype=jnp.float32)
    t_inv = lax.linalg.triangular_solve(eye + lower, jnp.broadcast_to(eye, lower.shape),
                                        left_side=True, lower=True, unit_diagonal=True)
    u = jnp.einsum('nbhij,nbhje->nbhie', t_inv, v * beta[..., None])
    w = jnp.einsum('nbhij,nbhjd->nbhid', t_inv, kb * jnp.exp(gc)[..., None])

    def step(s, xs):
        qc, kc, uc, wc, gcc, dc = xs
        v_new = uc - jnp.einsum('bhid,bhde->bhie', wc, s)
        intra = jnp.einsum('bhid,bhjd->bhij', qc, kc) * dc
        o = (jnp.einsum('bhid,bhde->bhie', qc * jnp.exp(gcc)[..., None], s)
             + jnp.einsum('bhij,bhje->bhie', intra, v_new))
        g_last = gcc[..., -1]
        s = (s * jnp.exp(g_last)[..., None, None]
             + jnp.einsum('bhid,bhie->bhde', kc * jnp.exp(g_last[..., None] - gcc)[..., None], v_new))
        return s, o

    s, o = lax.scan(step, s0.astype(jnp.float32), (q, k, u, w, gc, decay))
    return from_chunks(o), s


def gated_linear_recurrence(q, k, v, logf, s0):
    c = math.gcd(q.shape[1], CHUNK)
    q = to_chunks(q, c) * (DK_C ** -0.5)
    k, v, logf = (to_chunks(a, c) for a in (k, v, logf))
    gc = jnp.cumsum(logf, axis=-2)
    incl = jnp.tril(jnp.ones((c, c), dtype=bool))[:, :, None]

    def step(s, xs):
        qc, kc, vc, gcc = xs
        diff = gcc[:, :, :, None, :] - gcc[:, :, None, :, :]
        dec = jnp.where(incl, jnp.exp(jnp.where(incl, diff, 0.0)), 0.0)
        intra = jnp.einsum('bhid,bhjd,bhijd->bhij', qc, kc, dec)
        o = (jnp.einsum('bhid,bhde->bhie', qc * jnp.exp(gcc), s)
             + jnp.einsum('bhij,bhje->bhie', intra, vc))
        g_last = gcc[:, :, -1]
        s = (s * jnp.exp(g_last)[..., None]
             + jnp.einsum('bhid,bhie->bhde', kc * jnp.exp(g_last[:, :, None] - gcc), vc))
        return s, o

    s, o = lax.scan(step, s0.astype(jnp.float32), (q, k, v, gc))
    return from_chunks(o), s


def mla_prompt(q_nope, q_pe, c_kv, k_pe, w_uk, w_uv):
    b, s, h, _ = q_nope.shape
    qb = math.gcd(s, Q_BLOCK)
    k_nope = jnp.einsum('bsl,lhd->bshd', c_kv, w_uk)
    v = jnp.einsum('bsl,lhd->bshd', c_kv, w_uv)
    kpos = jnp.arange(s)

    def block(args):
        i, qn, qp = args
        sc = (jnp.einsum('bqhd,bkhd->bhqk', qn, k_nope)
              + jnp.einsum('bqhd,bkd->bhqk', qp, k_pe)).astype(jnp.float32) * MLA_SCALE
        qpos = i * qb + jnp.arange(qb)
        sc = jnp.where(qpos[:, None] >= kpos[None, :], sc, -jnp.inf)
        p = jax.nn.softmax(sc, axis=-1).astype(v.dtype)
        return jnp.einsum('bhqk,bkhd->bqhd', p, v)

    def split(a):
        return jnp.swapaxes(a.reshape((b, s // qb, qb) + a.shape[2:]), 0, 1)

    o = lax.map(block, (jnp.arange(s // qb), split(q_nope), split(q_pe)))
    return jnp.swapaxes(o, 0, 1).reshape(b, s, h, DV_B)


def mla_sample(q_nope, q_pe, c_kv, k_pe, w_uk, w_uv, cache_lat, cache_kpe, page_table):
    b, t, h, _ = q_nope.shape
    lat = jnp.concatenate([cache_lat[page_table].reshape(b, -1, KV_LORA), c_kv], axis=1)
    kpe = jnp.concatenate([cache_kpe[page_table].reshape(b, -1, D_ROPE), k_pe], axis=1)
    past = lat.shape[1] - t
    q_lat = jnp.einsum('bthd,lhd->bthl', q_nope, w_uk)
    sc = (jnp.einsum('bthl,bkl->bhtk', q_lat, lat)
          + jnp.einsum('bthd,bkd->bhtk', q_pe, kpe)).astype(jnp.float32) * MLA_SCALE
    mask = jnp.arange(past + t)[None, :] <= past + jnp.arange(t)[:, None]
    sc = jnp.where(mask, sc, -jnp.inf)
    p = jax.nn.softmax(sc, axis=-1).astype(lat.dtype)
    o_lat = jnp.einsum('bhtk,bkl->bthl', p, lat)
    return jnp.einsum('bthl,lhd->bthd', o_lat, w_uv)


def gdn_mla_mixer(h, pos, conv_buf, s0, attend, w_in, conv_w, a_log, dt_bias, gdn_norm,
                  q_norm, w_uq, kv_norm, w_uk, w_uv, w_out):
    b, t, _ = h.shape
    qkv, z, b_raw, a_raw, cq, ckv, kpe = jnp.split(h @ w_in, SPLIT_AB, axis=-1)
    ext = jnp.concatenate([conv_buf.astype(qkv.dtype), qkv], axis=1)
    new_buf = ext[:, -(CONV_W - 1):]
    qkv = jax.nn.silu(sum(ext[:, i:i + t] * conv_w[i] for i in range(CONV_W)))
    q, k, v = jnp.split(qkv, (H_A * DK_A, 2 * H_A * DK_A), axis=-1)
    q = l2norm(q.reshape(b, t, H_A, DK_A))
    k = l2norm(k.reshape(b, t, H_A, DK_A))
    beta = jax.nn.sigmoid(b_raw.astype(jnp.float32))
    g = -jnp.exp(a_log.astype(jnp.float32)) * jax.nn.softplus(a_raw.astype(jnp.float32) + dt_bias)
    o_a, s_new = gated_delta_rule(q, k, v.reshape(b, t, H_A, DV_A), g, beta, s0)
    o_a = rmsnorm(o_a.astype(h.dtype), gdn_norm) * jax.nn.silu(z.reshape(b, t, H_A, DV_A))
    qh = jnp.einsum('btl,lhd->bthd', rmsnorm(cq, q_norm), w_uq)
    q_nope, q_pe = qh[..., :D_NOPE], rope(qh[..., D_NOPE:], pos)
    ckv = rmsnorm(ckv, kv_norm)
    kpe = rope(kpe, pos)
    o_b = attend(q_nope, q_pe, ckv, kpe, w_uk, w_uv)
    o = jnp.concatenate([o_a.reshape(b, t, -1), o_b.reshape(b, t, -1)], axis=-1)
    return o @ w_out, new_buf, s_new, ckv, kpe


def hgrn2_mixer(h, s0, lb, w_in, g_norm, w_out):
    b, t, _ = h.shape
    q, f, i, gate = jnp.split(h @ w_in, SPLIT_C, axis=-1)
    f = lb + (1.0 - lb) * jax.nn.sigmoid(f.astype(jnp.float32))

    def heads(a, d):
        return a.reshape(b, t, H_C, d)

    o, s_new = gated_linear_recurrence(heads(jax.nn.silu(q), DK_C), heads(1.0 - f, DK_C),
                                       heads(i, DV_C), heads(jnp.log(f), DK_C), s0)
    o = rmsnorm(o.astype(h.dtype), g_norm) * jax.nn.silu(heads(gate, DV_C))
    return o.reshape(b, t, -1) @ w_out, s_new


def sq_relu_mlp(h, w_up, w_down):
    return jnp.square(jax.nn.relu(h @ w_up)) @ w_down


def setup_inputs(seed: int = 0) -> dict:
    key = jax.random.key(seed)
    ks = iter(jax.random.split(key, 32))

    def nrm(shape, scale=1.0):
        return jax.random.normal(next(ks), shape, jnp.float32) * scale

    def gain(shape):
        return 1.0 + nrm(shape, 0.02)

    n_pages = PAST_LEN // PAGE_SIZE
    n_pool = (DEC_BATCH * n_pages * 5) // 4
    page_table = jax.random.permutation(next(ks), n_pool)[:DEC_BATCH * n_pages]
    page_table = page_table.reshape(DEC_BATCH, n_pages).astype(jnp.int32)
    dt = jnp.exp(jax.random.uniform(next(ks), (N_AB_LAYERS, H_A), jnp.float32,
                                    math.log(1e-3), math.log(1e-1)))
    a_log = jnp.log(jax.random.uniform(next(ks), (N_AB_LAYERS, H_A), jnp.float32, 1.0, 16.0))
    return {
        'x_prompt': nrm((BATCH, SEQ, D_MODEL)),
        'x_sample': nrm((DEC_BATCH, DEC_SEQ, D_MODEL)),
        'state_gdn': nrm((N_AB_LAYERS, DEC_BATCH, H_A, DK_A, DV_A), 0.5),
        'state_gdn_conv': nrm((N_AB_LAYERS, DEC_BATCH, CONV_W - 1, QKV_A)),
        'cache_mla_latent': nrm((N_AB_LAYERS, n_pool, PAGE_SIZE, KV_LORA)),
        'cache_mla_krope': nrm((N_AB_LAYERS, n_pool, PAGE_SIZE, D_ROPE)),
        'state_hgrn': nrm((N_C_LAYERS, DEC_BATCH, H_C, DK_C, DV_C), 0.5),
        'page_table': page_table,
        'mix_norm': gain((DEPTH, D_MODEL)),
        'mlp_norm': gain((DEPTH, D_MODEL)),
        'final_norm': gain((D_MODEL,)),
        'w_up': nrm((DEPTH, D_MODEL, D_FF), D_MODEL ** -0.5),
        'w_down': nrm((DEPTH, D_FF, D_MODEL), 0.5 * D_FF ** -0.5),
        'w_in_ab': nrm((N_AB_LAYERS, D_MODEL, IN_AB), D_MODEL ** -0.5),
        'conv_w_ab': nrm((N_AB_LAYERS, CONV_W, QKV_A), CONV_W ** -0.5),
        'a_log_ab': a_log,
        'dt_bias_ab': dt + jnp.log(-jnp.expm1(-dt)),
        'gdn_norm_ab': gain((N_AB_LAYERS, DV_A)),
        'q_norm_ab': gain((N_AB_LAYERS, Q_LORA)),
        'w_uq_ab': nrm((N_AB_LAYERS, Q_LORA, H_B, D_NOPE + D_ROPE), Q_LORA ** -0.5),
        'kv_norm_ab': gain((N_AB_LAYERS, KV_LORA)),
        'w_uk_ab': nrm((N_AB_LAYERS, KV_LORA, H_B, D_NOPE), KV_LORA ** -0.5),
        'w_uv_ab': nrm((N_AB_LAYERS, KV_LORA, H_B, DV_B), KV_LORA ** -0.5),
        'w_out_ab': nrm((N_AB_LAYERS, OUT_AB, D_MODEL), OUT_AB ** -0.5),
        'w_in_c': nrm((N_C_LAYERS, D_MODEL, IN_C), D_MODEL ** -0.5),
        'lb_logits_c': nrm((DEPTH, H_C * DK_C), 0.5),
        'g_norm_c': gain((N_C_LAYERS, DV_C)),
        'w_out_c': nrm((N_C_LAYERS, H_C * DV_C, D_MODEL), (H_C * DV_C) ** -0.5),
    }


def reference(x_prompt, x_sample, state_gdn, state_gdn_conv, cache_mla_latent, cache_mla_krope,
              state_hgrn, page_table, mix_norm, mlp_norm, final_norm, w_up, w_down,
              w_in_ab, conv_w_ab, a_log_ab, dt_bias_ab, gdn_norm_ab, q_norm_ab, w_uq_ab,
              kv_norm_ab, w_uk_ab, w_uv_ab, w_out_ab, w_in_c, lb_logits_c, g_norm_c, w_out_c):
    f32 = jnp.float32
    p_lb = jax.nn.softmax(lb_logits_c.astype(f32), axis=0)
    lower_bounds = jnp.cumsum(p_lb, axis=0) - p_lb[0]

    def trunk(x, pos, conv0, gdn0, hgrn0, attend):
        convs, gdns, lats, kpes, hgrns = [], [], [], [], []
        for layer in range(DEPTH):
            j = layer // 2
            h = rmsnorm(x, mix_norm[layer])
            if layer % 2 == 0:
                o, buf, s, ckv, kpe = gdn_mla_mixer(
                    h, pos, conv0[j], gdn0[j], functools.partial(attend, j), w_in_ab[j], conv_w_ab[j],
                    a_log_ab[j], dt_bias_ab[j], gdn_norm_ab[j], q_norm_ab[j], w_uq_ab[j],
                    kv_norm_ab[j], w_uk_ab[j], w_uv_ab[j], w_out_ab[j])
                convs.append(buf)
                gdns.append(s)
                lats.append(ckv)
                kpes.append(kpe)
            else:
                o, s = hgrn2_mixer(h, hgrn0[j], lower_bounds[layer], w_in_c[j], g_norm_c[j], w_out_c[j])
                hgrns.append(s)
            x = x + o
            x = x + sq_relu_mlp(rmsnorm(x, mlp_norm[layer]), w_up[layer], w_down[layer])
        return (rmsnorm(x, final_norm), jnp.stack(gdns), jnp.stack(convs), jnp.stack(lats),
                jnp.stack(kpes), jnp.stack(hgrns))

    def attend_prompt(j, q_nope, q_pe, c_kv, k_pe, w_uk, w_uv):
        return mla_prompt(q_nope, q_pe, c_kv, k_pe, w_uk, w_uv)

    def attend_sample(j, q_nope, q_pe, c_kv, k_pe, w_uk, w_uv):
        return mla_sample(q_nope, q_pe, c_kv, k_pe, w_uk, w_uv,
                          cache_mla_latent[j], cache_mla_krope[j], page_table)

    b, s_len = x_prompt.shape[:2]
    y_prompt, gdn_p, conv_p, lat_p, kpe_p, hgrn_p = trunk(
        x_prompt, jnp.arange(s_len),
        jnp.zeros((N_AB_LAYERS, b, CONV_W - 1, QKV_A), x_prompt.dtype),
        jnp.zeros((N_AB_LAYERS, b, H_A, DK_A, DV_A), f32),
        jnp.zeros((N_C_LAYERS, b, H_C, DK_C, DV_C), f32),
        attend_prompt)
    past_len = page_table.shape[1] * cache_mla_latent.shape[2]
    y_sample, gdn_s, conv_s, lat_s, kpe_s, hgrn_s = trunk(
        x_sample, past_len + jnp.arange(x_sample.shape[1]),
        state_gdn_conv, state_gdn, state_hgrn, attend_sample)
    return (y_prompt, y_sample, gdn_p, conv_p, lat_p, kpe_p, hgrn_p, gdn_s, conv_s, lat_s, kpe_s, hgrn_s)
```

```cpp
#ifdef HIPEMU
#include "hipemu.h"
#else
#include <hip/hip_runtime.h>
#endif
#include <cstdio>
#include <cstdint>

#ifndef CFG_BATCH
#define CFG_BATCH 8
#define CFG_SEQ 2048
#define CFG_DEC_BATCH 128
#define CFG_PAST_LEN 8192
#endif
#ifndef MK_N_LAUNCHES
#define MK_N_LAUNCHES 1
#endif

#define DEV __device__ __forceinline__
#define PROBE_MASK 0x40u
namespace pg8 {
#define PG8_LAS __attribute__((address_space(3)))
typedef unsigned short bf16_t;
typedef short bf16x8 __attribute__((ext_vector_type(8)));
typedef float f32x4 __attribute__((ext_vector_type(4)));
typedef unsigned u32x4 __attribute__((ext_vector_type(4)));
constexpr int BM = 256, BK = 64, HALF = 128, HTB = HALF * BK * 2  , STAGE_BYTES = 8 * HTB, NXCD = 8, WGM = 8;

__host__ __device__ __forceinline__ int lds_byte(int r, int c) { const int st = (r >> 4) * 2 + (c >> 5), rr = r & 15, cc = c & 31, ob = rr * 64 + cc * 2; return st * 1024 + (ob ^ (((ob >> 9) & 1) << 5)); }
__host__ __device__ __forceinline__ void stage_rc(int b, int& R, int& C) { const int st = b / 1024, sb = b % 1024, swz = sb ^ (((sb >> 9) & 1) << 5); R = (st >> 1) * 16 + swz / 64; C = (st & 1) * 32 + (swz % 64) / 2; }
__host__ __device__ __forceinline__ int perm32(int rho) { const int n = rho >> 4, i = rho & 15; return 8 * (i >> 2) + 4 * n + (i & 3); }

struct Unit { int pm, pn, kb; };
struct Gemm { const bf16_t* A; const bf16_t* Bt; int M, N, K, ld; };

struct StaticOrder {
    int nM, nN, nwg, G, c;
    __host__ __device__ void init(int M, int N, int G_, int c_) { nM = M / BM; nN = N / BM; nwg = nM * nN; G = G_; c = c_; }
    __host__ __device__ bool next(int i, Unit& u) const {
        const long L = (long)i * G + c; if (L >= nwg) return false;
        int wgid = (int)L; { const int q = nwg / NXCD, r = nwg % NXCD, xcd = wgid % NXCD, off = wgid / NXCD; wgid = (xcd < r ? xcd * (q + 1) : r * (q + 1) + (xcd - r) * q) + off; }
        const int nig = WGM * nN, gid = wgid / nig, fm = gid * WGM, gsz = (nM - fm) < WGM ? (nM - fm) : WGM;
        u.pm = fm + ((wgid % nig) % gsz); u.pn = (wgid % nig) / gsz; u.kb = 0; return true;
    }
    __device__ __forceinline__ void a_ready(const Unit&) const {}
    __device__ __forceinline__ void done(const Unit&) const {}
};

#ifndef HIPEMU
template <class Epi, class Sched, bool ALIGN_EPI = false, bool SP2 = false>
__device__ __forceinline__ void gemm_phase(PG8_LAS unsigned char* lds, const Gemm g, const Sched& S, const Epi& E, const int wid_in, const int lane_in) {
    const int wid = __builtin_amdgcn_readfirstlane(wid_in), lane = lane_in, tid = wid * 64 + lane, wr = wid >> 2, wc = wid & 3, fr = lane & 15, fq = lane >> 4;
    const int K = g.K, nt = K / BK, LDK = g.ld;
    unsigned voffA[2], voffB[2];
#pragma unroll
    for (int i = 0; i < 2; ++i) { int R, C; stage_rc(tid * 16 + i * 8192, R, C); const int Rb = Epi::PERM ? ((R & ~31) + perm32(R & 31)) : R;
        voffA[i] = (unsigned)(R * LDK + C) * 2u; voffB[i] = (unsigned)(Rb * LDK + C) * 2u; }
    const size_t kstep = (size_t)(BK * 2);
    const size_t hstep = (size_t)HALF * LDK * 2;
    const size_t tstep = 2 * hstep;
    const unsigned ldsw = (unsigned)wid * 1024u;
    const int aoff = lds_byte(wr * 64 + fr, fq * 8), boff = lds_byte(wc * 32 + fr, fq * 8);
#define PG8_SA(b, h) (((b) * 2 + (h)) * HTB)
#define PG8_SB(b, h) ((4 + (b) * 2 + (h)) * HTB)
#define PG8_STAGE(bufoff, gbase, voff) do { _Pragma("unroll") for (int _i = 0; _i < 2; ++_i) \
        __builtin_amdgcn_global_load_lds((const unsigned*)((const char*)(gbase) + (voff)[_i]), (PG8_LAS unsigned*)(lds + (bufoff) + ldsw + _i * 8192), 16, 0, 0); } while (0)
#define PG8_LDA(dst, b, h) do { _Pragma("unroll") for (int m = 0; m < 4; ++m) _Pragma("unroll") for (int k = 0; k < 2; ++k) dst[m][k] = *(const PG8_LAS bf16x8*)(lds + PG8_SA(b, h) + aoff + m * 2048 + k * 1024); } while (0)
#define PG8_LDB(dst, b, h) do { _Pragma("unroll") for (int n = 0; n < 2; ++n) _Pragma("unroll") for (int k = 0; k < 2; ++k) dst[n][k] = *(const PG8_LAS bf16x8*)(lds + PG8_SB(b, h) + boff + n * 2048 + k * 1024); } while (0)
#define PG8_MMA(ai, bj, At, Bt) do { __builtin_amdgcn_s_setprio(1); _Pragma("unroll") for (int m = 0; m < 4; ++m) _Pragma("unroll") for (int n = 0; n < 2; ++n) _Pragma("unroll") for (int k = 0; k < 2; ++k) \
        acc[ai][bj][m][n] = __builtin_amdgcn_mfma_f32_16x16x32_bf16(Bt[n][k], At[m][k], acc[ai][bj][m][n], 0, 0, 0); __builtin_amdgcn_s_setprio(0); } while (0)
#define PG8_WAIT_V(n) asm volatile("s_waitcnt vmcnt(" #n ")" ::: "memory")
#define PG8_WAIT_L(n) asm volatile("s_waitcnt lgkmcnt(" #n ")" ::: "memory")
#define PG8_BAR __builtin_amdgcn_s_barrier()
#define PG8_SCHED __builtin_amdgcn_sched_barrier(0)
    Unit cur, nxt; int ui = 0;
    if (!S.next(0, cur)) return;
    f32x4 acc[2][2][4][2];
#pragma unroll
    for (int a = 0; a < 2; ++a)
#pragma unroll
        for (int b = 0; b < 2; ++b)
#pragma unroll
            for (int m = 0; m < 4; ++m)
#pragma unroll
                for (int n = 0; n < 2; ++n) acc[a][b][m][n] = (f32x4){0.f, 0.f, 0.f, 0.f};
    bf16x8 At[4][2], B0[2][2], B1[2][2];
    const char* cA = (const char*)g.A + (size_t)cur.pm * tstep + (size_t)cur.kb * K * 2; const char* cB = (const char*)g.Bt + (size_t)cur.pn * tstep + (size_t)cur.kb * K * 2;
    S.a_ready(cur);
    if constexpr (SP2) {
        PG8_STAGE(PG8_SB(0, 0), cB, voffB); PG8_STAGE(PG8_SB(0, 1), cB + hstep, voffB); PG8_STAGE(PG8_SA(0, 0), cA, voffA); PG8_STAGE(PG8_SA(0, 1), cA + hstep, voffA);
        if (wr == 1) PG8_BAR;
        PG8_WAIT_V(2); PG8_BAR;
        PG8_STAGE(PG8_SB(1, 0), cB + kstep, voffB); PG8_STAGE(PG8_SA(1, 0), cA + kstep, voffA); PG8_STAGE(PG8_SB(1, 1), cB + hstep + kstep, voffB);
        PG8_WAIT_V(6); PG8_BAR;
    } else {
        PG8_STAGE(PG8_SB(0, 0), cB, voffB); PG8_STAGE(PG8_SA(0, 0), cA, voffA); PG8_STAGE(PG8_SB(0, 1), cB + hstep, voffB); PG8_STAGE(PG8_SA(0, 1), cA + hstep, voffA);
        if (wr == 1) PG8_BAR;
        PG8_WAIT_V(4); PG8_BAR;
        PG8_STAGE(PG8_SB(1, 0), cB + kstep, voffB); PG8_STAGE(PG8_SA(1, 0), cA + kstep, voffA); PG8_STAGE(PG8_SB(1, 1), cB + hstep + kstep, voffB);
        PG8_WAIT_V(6); PG8_BAR;
    }
    for (;;) {
        const bool has_next = S.next(ui + 1, nxt);
        const char* nA = has_next ? (const char*)g.A + (size_t)nxt.pm * tstep + (size_t)nxt.kb * K * 2 : cA; const char* nB = has_next ? (const char*)g.Bt + (size_t)nxt.pn * tstep + (size_t)nxt.kb * K * 2 : cB;
        for (int t = 0; t < nt; t += 2) {
            const bool last = (t == nt - 2);
            const char* a1 = cA + (size_t)(t + 1) * kstep;
            const char* a2 = last ? nA : cA + (size_t)(t + 2) * kstep; const char* b2 = last ? nB : cB + (size_t)(t + 2) * kstep;
            const char* a3 = a2 + kstep; const char* b3 = b2 + kstep;
            if (last && has_next) S.a_ready(nxt);
            if constexpr (SP2) {
            PG8_LDB(B0, 0, 0); PG8_LDB(B1, 0, 1); PG8_SCHED; PG8_LDA(At, 0, 0); PG8_STAGE(PG8_SA(1, 1), a1 + hstep, voffA);
            PG8_WAIT_V(8); PG8_WAIT_L(0); PG8_BAR; PG8_MMA(0, 0, At, B0); PG8_MMA(0, 1, At, B1); PG8_BAR; PG8_SCHED;
            PG8_LDA(At, 0, 1); PG8_STAGE(PG8_SB(0, 0), b2, voffB); PG8_STAGE(PG8_SB(0, 1), b2 + hstep, voffB); PG8_STAGE(PG8_SA(0, 0), a2, voffA);
            PG8_WAIT_V(8); PG8_WAIT_L(0); PG8_BAR; PG8_MMA(1, 0, At, B0); PG8_MMA(1, 1, At, B1); PG8_BAR; PG8_SCHED;
            PG8_LDB(B0, 1, 0); PG8_LDB(B1, 1, 1); PG8_SCHED; PG8_LDA(At, 1, 0); PG8_STAGE(PG8_SA(0, 1), a2 + hstep, voffA);
            PG8_WAIT_V(8); PG8_WAIT_L(0); PG8_BAR; PG8_MMA(0, 0, At, B0); PG8_MMA(0, 1, At, B1); PG8_BAR; PG8_SCHED;
            PG8_LDA(At, 1, 1); PG8_STAGE(PG8_SB(1, 0), b3, voffB); PG8_STAGE(PG8_SB(1, 1), b3 + hstep, voffB); PG8_STAGE(PG8_SA(1, 0), a3, voffA);
            PG8_WAIT_V(8); PG8_WAIT_L(0); PG8_BAR; PG8_MMA(1, 0, At, B0); PG8_MMA(1, 1, At, B1); PG8_BAR; PG8_SCHED;
            } else {
            PG8_LDB(B0, 0, 0); PG8_SCHED; PG8_LDA(At, 0, 0); PG8_STAGE(PG8_SA(1, 1), a1 + hstep, voffA);
            PG8_WAIT_L(8); PG8_BAR; PG8_WAIT_L(0); PG8_MMA(0, 0, At, B0); PG8_BAR; PG8_SCHED;
            PG8_LDB(B1, 0, 1); PG8_STAGE(PG8_SB(0, 0), b2, voffB);
            PG8_BAR; PG8_WAIT_L(0); PG8_MMA(0, 1, At, B1); PG8_BAR;
            PG8_LDA(At, 0, 1); PG8_STAGE(PG8_SA(0, 0), a2, voffA);
            PG8_BAR; PG8_WAIT_L(0); PG8_MMA(1, 0, At, B0); PG8_BAR; PG8_SCHED;
            PG8_STAGE(PG8_SB(0, 1), b2 + hstep, voffB);
            PG8_WAIT_V(6); PG8_BAR; PG8_MMA(1, 1, At, B1); PG8_BAR;
            PG8_LDB(B0, 1, 0); PG8_SCHED; PG8_LDA(At, 1, 0); PG8_STAGE(PG8_SA(0, 1), a2 + hstep, voffA);
            PG8_WAIT_L(8); PG8_BAR; PG8_WAIT_L(0); PG8_MMA(0, 0, At, B0); PG8_BAR; PG8_SCHED;
            PG8_LDB(B1, 1, 1); PG8_STAGE(PG8_SB(1, 0), b3, voffB);
            PG8_BAR; PG8_WAIT_L(0); PG8_MMA(0, 1, At, B1); PG8_BAR;
            PG8_LDA(At, 1, 1); PG8_STAGE(PG8_SA(1, 0), a3, voffA);
            PG8_BAR; PG8_WAIT_L(0); PG8_MMA(1, 0, At, B0); PG8_BAR; PG8_SCHED;
            PG8_STAGE(PG8_SB(1, 1), b3 + hstep, voffB);
            PG8_WAIT_V(6); PG8_BAR; PG8_MMA(1, 1, At, B1); PG8_BAR;
            }
        }
        if constexpr (ALIGN_EPI) { if (wr == 0) PG8_BAR; }
        if constexpr (!Epi::AFTER_DRAIN) { E(acc, cur, wr, wc, fr, fq); S.done(cur); }
        if (!has_next) break;
#pragma unroll
        for (int a = 0; a < 2; ++a)
#pragma unroll
            for (int b = 0; b < 2; ++b)
#pragma unroll
                for (int m = 0; m < 4; ++m)
#pragma unroll
                    for (int n = 0; n < 2; ++n) acc[a][b][m][n] = (f32x4){0.f, 0.f, 0.f, 0.f};
        cur = nxt; cA = nA; cB = nB; ++ui;
        if constexpr (ALIGN_EPI) { if (wr == 1) PG8_BAR; }
    }
    PG8_WAIT_V(0);
    if constexpr (!ALIGN_EPI) { if (wr == 0) PG8_BAR; }
    PG8_BAR;
    if constexpr (Epi::AFTER_DRAIN) { E.fused(acc, cur, wr, wc, fr, fq, lds, wid, lane); S.done(cur); }
#undef PG8_SA
#undef PG8_SB
#undef PG8_STAGE
#undef PG8_LDA
#undef PG8_LDB
#undef PG8_MMA
#undef PG8_WAIT_V
#undef PG8_WAIT_L
#undef PG8_BAR
#undef PG8_SCHED
}
}

#else
}
#endif

constexpr int D = 1024, BATCH = CFG_BATCH, SEQ = CFG_SEQ, DECB = CFG_DEC_BATCH, DECS = 8, PAST = CFG_PAST_LEN, PAGE = 128;
constexpr int MP = BATCH * SEQ, MS = DECB * DECS, MT = MP + MS, M = (MT + 255) / 256 * 256;
constexpr int NPAGES = PAST / PAGE;
constexpr int QKV_A = 1536, IN_AB = 2600, LD1 = 2816, FF = 4096, INC = 4096;
constexpr int C_Z = 1536, C_B = 2048, C_A = 2052, C_CQ = 2056, C_CKV = 2312, C_KPE = 2568;
constexpr float EPS = 1e-6f;
constexpr float MLA_SCALE = 0.10206207261596575f;
constexpr float DK_SCALE = 0.08838834764831845f;
static_assert(MP % 256 == 0 && SEQ % 128 == 0 && PAST % 128 == 0, "shape assumptions");

constexpr size_t O_YP = 0, O_YS = O_YP + (size_t)MP * D, O_GDNP = O_YS + (size_t)MS * D, O_CONVP = O_GDNP + (size_t)BATCH * 4 * 16384,
    O_LATP = O_CONVP + (size_t)BATCH * 3 * QKV_A, O_KPEP = O_LATP + (size_t)MP * 256, O_HGP = O_KPEP + (size_t)MP * 32,
    O_GDNS = O_HGP + (size_t)BATCH * 8 * 16384, O_CONVS = O_GDNS + (size_t)DECB * 4 * 16384, O_LATS = O_CONVS + (size_t)DECB * 3 * QKV_A,
    O_KPES = O_LATS + (size_t)MS * 256, O_HGS = O_KPES + (size_t)MS * 32, O_END = O_HGS + (size_t)DECB * 8 * 16384;

constexpr size_t al256(size_t x) { return (x + 255) & ~(size_t)255; }
constexpr size_t WS_CTL = 0, CTL_BYTES = 65536;
constexpr size_t WS_WINAB = CTL_BYTES,                      WS_WUP0 = WS_WINAB + (size_t)LD1 * D * 2,
    WS_WUP1 = WS_WUP0 + (size_t)FF * D * 2,                 WS_WDN0 = WS_WUP1 + (size_t)FF * D * 2,
    WS_WDN1 = WS_WDN0 + (size_t)FF * D * 2,                 WS_WINC = WS_WDN1 + (size_t)FF * D * 2,
    WS_WOAB = WS_WINC + (size_t)INC * D * 2,                WS_WOC = WS_WOAB + (size_t)D * D * 2,
    WS_WUQ = WS_WOC + (size_t)D * D * 2,                    WS_WUKV = WS_WUQ + (size_t)768 * 256 * 2,
    WS_ROPE = WS_WUKV + (size_t)1024 * 256 * 2,             WS_XN = al256(WS_ROPE + (size_t)(SEQ + 8) * 32 * 4),
    WS_P1 = WS_XN + (size_t)M * D * 2,                      WS_CQN = WS_P1 + (size_t)M * 4096 * 4,
    WS_LATN = WS_CQN + (size_t)M * 256 * 2,                 WS_QH = WS_LATN + (size_t)M * 256 * 2,
    WS_KVP = WS_QH + (size_t)M * 768 * 4,                   WS_OCAT = WS_KVP + (size_t)MP * 1024 * 2,
    WS_ORAW = WS_OCAT + (size_t)M * D * 2,                  WS_X1 = WS_ORAW + (size_t)M * D * 4,
    WS_X2 = WS_X1 + (size_t)M * D * 4,                      WS_H = WS_X2 + (size_t)M * D * 4,
    WS_WUKB = WS_H + (size_t)M * FF * 2,                    WS_PO = WS_WUKB + (size_t)256 * 512 * 2,
    WS_PM = WS_PO + (size_t)DECB * 2 * 64 * 256 * 4,        WS_PL = WS_PM + (size_t)DECB * 2 * 64 * 4,
    WS_KPEB = WS_PL + (size_t)DECB * 2 * 64 * 4,            WS_PART = al256(WS_KPEB + (size_t)MP * 32 * 2),
    WS_END = WS_PART + (size_t)16 * (M - MP) * D * 4;
constexpr size_t WS_H_END = WS_H + (size_t)M * FF * 2;

constexpr int LDS_BYTES = 155648;
constexpr int LDS_MISC = 155648 - 256;
constexpr int NPHASE = 21;

typedef unsigned short bf16;
typedef unsigned u32x4 __attribute__((ext_vector_type(4)));
typedef unsigned u32x2 __attribute__((ext_vector_type(2)));
#ifndef HIPEMU
typedef short bf16x8 __attribute__((ext_vector_type(8)));
typedef float f32x4 __attribute__((ext_vector_type(4)));
#endif

DEV unsigned f2bf(float f) { unsigned u = __float_as_uint(f); return (u + 0x7fffu + ((u >> 16) & 1u)) >> 16; }
#ifdef HIPEMU
DEV unsigned pk2(float lo, float hi) { return f2bf(lo) | (f2bf(hi) << 16); }
#else
typedef float f32x2_t __attribute__((ext_vector_type(2))); typedef __bf16 bf16x2_t __attribute__((ext_vector_type(2)));
DEV unsigned pk2(float lo, float hi) { f32x2_t v = {lo, hi}; bf16x2_t b = __builtin_convertvector(v, bf16x2_t); return __builtin_bit_cast(unsigned, b); }
#endif
DEV float bf2f(bf16 b) { return __uint_as_float(((unsigned)b) << 16); }
DEV float sigmoidf_(float x) { return 1.0f / (1.0f + __expf(-x)); }
DEV float siluf_(float x) { return x / (1.0f + __expf(-x)); }
DEV float softplusf_(float x) { return fmaxf(x, 0.f) + log1pf(__expf(-fabsf(x))); }
#ifdef HIPEMU
DEV f32x4 mfma16(bf16x8 a, bf16x8 b, f32x4 c) { return emu_mfma16(a, b, c); }
#define WAVE_SYNC() emu_wave_sync()
#define OPAQUE_V(x) do { } while (0)
#define LDS_BARRIER() __syncthreads()
DEV s16x4 lds_tr(const unsigned short* p) { return emu_lds_tr((const void*)p); }
#else
typedef short s16x4 __attribute__((ext_vector_type(4)));
DEV s16x4 lds_tr(const unsigned short* p) { return __builtin_bit_cast(s16x4, __builtin_amdgcn_ds_read_tr16_b64_v4i16((__attribute__((address_space(3))) s16x4*)p)); }
DEV f32x4 mfma16(bf16x8 a, bf16x8 b, f32x4 c) { return __builtin_amdgcn_mfma_f32_16x16x32_bf16(a, b, c, 0, 0, 0); }
#define WAVE_SYNC() asm volatile("s_waitcnt lgkmcnt(0)" ::: "memory")
#define OPAQUE_V(x) asm volatile("" : "+v"(x))
#define LDS_BARRIER() asm volatile("s_waitcnt lgkmcnt(0)\n\ts_barrier" ::: "memory")
#endif
DEV f32x4 ld4bf(const unsigned short* p) { const u32x2 u = *(const u32x2*)p; return (f32x4){__uint_as_float(u.x << 16), __uint_as_float(u.x & 0xffff0000u), __uint_as_float(u.y << 16), __uint_as_float(u.y & 0xffff0000u)}; }
#ifdef HIPEMU
DEV float wave_sum(float v) {
#pragma unroll
    for (int o = 1; o < 64; o <<= 1) v += __shfl_xor(v, o);
    return v;
}
DEV float grp16_max(float v) {
#pragma unroll
    for (int o = 1; o < 16; o <<= 1) v = fmaxf(v, __shfl_xor(v, o));
    return v;
}
DEV float grp16_sum(float v) {
#pragma unroll
    for (int o = 1; o < 16; o <<= 1) v += __shfl_xor(v, o);
    return v;
}
#else
template <int CTRL> DEV float dppf(float x) { return __builtin_bit_cast(float, __builtin_amdgcn_mov_dpp(__builtin_bit_cast(int, x), CTRL, 0xf, 0xf, true)); }
DEV float grp16_max(float v) { v = fmaxf(v, dppf<0xB1>(v)); v = fmaxf(v, dppf<0x4E>(v)); v = fmaxf(v, dppf<0x141>(v)); v = fmaxf(v, dppf<0x128>(v)); return v; }
DEV float grp16_sum(float v) { v += dppf<0xB1>(v); v += dppf<0x4E>(v); v += dppf<0x141>(v); v += dppf<0x128>(v); return v; }
DEV float wave_sum(float v) {
    v = grp16_sum(v);
    auto s = __builtin_amdgcn_permlane16_swap(__float_as_uint(v), __float_as_uint(v), false, false);
    v = __uint_as_float(s[0]) + __uint_as_float(s[1]);
    auto t = __builtin_amdgcn_permlane32_swap(__float_as_uint(v), __float_as_uint(v), false, false);
    return __uint_as_float(t[0]) + __uint_as_float(t[1]);
}
#endif

struct Params { const void* in[28]; float* out; unsigned char* ws; int ph_lo, ph_hi; };
struct Ctx {
    const Params* p; unsigned char* lds; unsigned char* ws; float* out;
    int tid, lane, wave, gw, ngw;
    template <class T> DEV const T* in(int i) const { return (const T*)p->in[i]; }
    template <class T> DEV T* w(size_t off) const { return (T*)(ws + off); }
};
DEV int queue_next(const Ctx& c, int q) {
    unsigned* cnt = (unsigned*)(c.ws + WS_CTL) + 4096 + 64 * q; volatile unsigned* slot = (volatile unsigned*)(c.lds + LDS_MISC + 128);
    __syncthreads();
    if (c.tid == 0) *slot = atomicAdd(cnt, 1u);
    __syncthreads();
    return (int)*slot;
}
DEV const float* xin_row(const Ctx& c, int m) { return m < MP ? c.in<float>(0) + (size_t)m * D : c.in<float>(1) + (size_t)(m - MP) * D; }

struct EpiStoreF32 {
    static constexpr bool PERM = false, AFTER_DRAIN = false;
    float* C; int ldc;
    DEV void operator()(const pg8::f32x4 (&acc)[2][2][4][2], const pg8::Unit& u, int wr, int wc, int fr, int fq) const {
        const int row0 = u.pm * 256 + wr * 64 + fr, col0 = u.pn * 256 + wc * 32 + 4 * fq;
#pragma unroll
        for (int ai = 0; ai < 2; ++ai)
#pragma unroll
            for (int m = 0; m < 4; ++m) { float* rowp = C + (size_t)(row0 + ai * 128 + m * 16) * ldc + col0;
#pragma unroll
                for (int bj = 0; bj < 2; ++bj)
#pragma unroll
                    for (int n = 0; n < 2; ++n) *(pg8::f32x4*)(rowp + bj * 128 + n * 16) = acc[ai][bj][m][n]; }
    }
};
struct EpiResidF32 {
    static constexpr bool PERM = false, AFTER_DRAIN = false;
    const float* base; const float* xp; const float* xs; float* out;
    DEV void operator()(const pg8::f32x4 (&acc)[2][2][4][2], const pg8::Unit& u, int wr, int wc, int fr, int fq) const {
        const int row0 = u.pm * 256 + wr * 64 + fr, col0 = u.pn * 256 + wc * 32 + 4 * fq;
#pragma unroll
        for (int ai = 0; ai < 2; ++ai)
#pragma unroll
            for (int m = 0; m < 4; ++m) { const int row = row0 + ai * 128 + m * 16;
                const float* rp = base ? base + (size_t)row * D : (row < MP ? xp + (size_t)row * D : xs + (size_t)(row - MP) * D);
                const bool ok = base != nullptr || row < MT;
                float* op = out + (size_t)row * D + col0;
#pragma unroll
                for (int bj = 0; bj < 2; ++bj)
#pragma unroll
                    for (int n = 0; n < 2; ++n) { pg8::f32x4 r = ok ? *(const pg8::f32x4*)(rp + col0 + bj * 128 + n * 16) : (pg8::f32x4){0.f, 0.f, 0.f, 0.f};
                        *(pg8::f32x4*)(op + bj * 128 + n * 16) = r + acc[ai][bj][m][n]; } }
    }
};
template <int ACT  > struct EpiBf16 {
    static constexpr bool PERM = true, AFTER_DRAIN = false;
    bf16* O; int ldc;
    DEV void operator()(const pg8::f32x4 (&acc)[2][2][4][2], const pg8::Unit& u, int wr, int wc, int fr, int fq) const {
        const int row0 = u.pm * 256 + wr * 64 + fr, col0 = u.pn * 256 + wc * 32 + 8 * fq;
#pragma unroll
        for (int ai = 0; ai < 2; ++ai)
#pragma unroll
            for (int m = 0; m < 4; ++m) { bf16* rowp = O + (size_t)(row0 + ai * 128 + m * 16) * ldc + col0;
#pragma unroll
                for (int bj = 0; bj < 2; ++bj) { pg8::f32x4 v0 = acc[ai][bj][m][0], v1 = acc[ai][bj][m][1];
                    if (ACT == 1) {
#pragma unroll
                        for (int j = 0; j < 4; ++j) { const float a = fmaxf(v0[j], 0.f), b = fmaxf(v1[j], 0.f); v0[j] = a * a; v1[j] = b * b; } }
                    u32x4 w; w.x = pk2(v0[0], v0[1]); w.y = pk2(v0[2], v0[3]); w.z = pk2(v1[0], v1[1]); w.w = pk2(v1[2], v1[3]);
                    *(u32x4*)(rowp + bj * 128) = w; } }
    }
};

struct SplitKOrder {
    int nM, nN, nS, pm0, G, c;
    DEV void init(int nM_, int nN_, int nS_, int pm0_, int G_, int c_) { nM = nM_; nN = nN_; nS = nS_; pm0 = pm0_; G = G_; c = c_; }
    DEV bool next(int i, pg8::Unit& u) const { const int L = i * G + c; if (L >= nM * nN * nS) return false; u.pm = pm0 + L % nM; const int r = L / nM; u.pn = r % nN; u.kb = r / nN; return true; }
    DEV void a_ready(const pg8::Unit&) const {}
    DEV void done(const pg8::Unit&) const {}
};
struct EpiPartF32 {
    static constexpr bool PERM = false, AFTER_DRAIN = false;
    float* P;
    DEV void operator()(const pg8::f32x4 (&acc)[2][2][4][2], const pg8::Unit& u, int wr, int wc, int fr, int fq) const {
        const int row0 = u.pm * 256 - MP + wr * 64 + fr, col0 = u.pn * 256 + wc * 32 + 4 * fq;
        float* base = P + (size_t)u.kb * (M - MP) * D;
#pragma unroll
        for (int ai = 0; ai < 2; ++ai)
#pragma unroll
            for (int m = 0; m < 4; ++m) { float* op = base + (size_t)(row0 + ai * 128 + m * 16) * D + col0;
#pragma unroll
                for (int bj = 0; bj < 2; ++bj)
#pragma unroll
                    for (int n = 0; n < 2; ++n) *(pg8::f32x4*)(op + bj * 128 + n * 16) = acc[ai][bj][m][n]; }
    }
};
template <class Epi, class Sched> DEV void run_gemm_s(const Ctx& c, const bf16* A, const bf16* Bt, int Mr, int N, int K, int ld, const Sched& S, const Epi& E) {
#ifndef HIPEMU
    asm volatile("" : "+s"(K));
    pg8::Gemm g{A, Bt, Mr, N, K, ld};
    pg8::gemm_phase<Epi, Sched, true, true>((PG8_LAS unsigned char*)c.lds, g, S, E, c.wave, c.lane);
#else
    const int wid = c.wave, lane = c.lane, wr = wid >> 2, wc = wid & 3, fr = lane & 15, fq = lane >> 4;
    pg8::Unit u;
    for (int ui = 0; S.next(ui, u); ++ui) {
        pg8::f32x4 acc[2][2][4][2];
        for (int ai = 0; ai < 2; ++ai) for (int bj = 0; bj < 2; ++bj) for (int m = 0; m < 4; ++m) for (int n = 0; n < 2; ++n) for (int j = 0; j < 4; ++j) {
            const int row = 256 * u.pm + 128 * ai + 64 * wr + 16 * m + fr;
            const int col = Epi::PERM ? 256 * u.pn + 128 * bj + 32 * wc + 8 * fq + 4 * n + j : 256 * u.pn + 128 * bj + 32 * wc + 16 * n + 4 * fq + j;
            const bf16* a = A + (size_t)row * ld + (size_t)u.kb * K; const bf16* b = Bt + (size_t)col * ld + (size_t)u.kb * K; float s = 0.f;
            for (int k = 0; k < K; ++k) s += bf2f(a[k]) * bf2f(b[k]);
            acc[ai][bj][m][n][j] = s; }
        E(acc, u, wr, wc, fr, fq);
    }
#endif
}
template <class Epi> DEV void run_gemm(const Ctx& c, const bf16* A, const bf16* Bt, int Mr, int N, int K, const Epi& E) {
    pg8::StaticOrder S; S.init(Mr, N, (int)gridDim.x, (int)blockIdx.x);
    run_gemm_s(c, A, Bt, Mr, N, K, K, S, E);
}
DEV void run_gemm_sample_splitk(const Ctx& c, const bf16* A, const bf16* Bt, int K, int KS) {
    SplitKOrder S; S.init((M - MP) / 256, D / 256, K / KS, MP / 256, (int)gridDim.x, (int)((blockIdx.x + 128) % gridDim.x));
    run_gemm_s(c, A, Bt, M, D, KS, K, S, EpiPartF32{c.w<float>(WS_PART)});
}

DEV void transpose_item(const float* W, int K, int N, bf16* WT, float* scr, int item, int nblk, int lane) {
    const int kb = item / nblk, nb = item % nblk, k0 = 64 * kb, n0 = 32 * nb;
    const int nn = n0 + (lane & 31);
    float tv[32];
#pragma unroll
    for (int i = 0; i < 32; ++i) { const int kk = 2 * i + (lane >> 5); tv[i] = nn < N ? W[(size_t)(k0 + kk) * N + nn] : 0.f; }
#pragma unroll
    for (int i = 0; i < 32; ++i) { const int kk = 2 * i + (lane >> 5); scr[kk * 33 + (lane & 31)] = tv[i]; }
    WAVE_SYNC();
    const int cq = lane & 7;
#pragma unroll
    for (int j = 0; j < 4; ++j) { const int n = (lane >> 3) + 8 * j; const float* s = scr + (8 * cq) * 33 + n;
        u32x4 o; o.x = pk2(s[0 * 33], s[1 * 33]); o.y = pk2(s[2 * 33], s[3 * 33]); o.z = pk2(s[4 * 33], s[5 * 33]); o.w = pk2(s[6 * 33], s[7 * 33]);
        *(u32x4*)(WT + (size_t)(n0 + n) * K + k0 + 8 * cq) = o; }
    WAVE_SYNC();
}
DEV void rms_row_to_bf16(const float* xrow, const float* gain, bf16* orow, int lane) {
    f32x4 v[4]; float s = 0.f;
#pragma unroll
    for (int j = 0; j < 4; ++j) { v[j] = *(const f32x4*)(xrow + 4 * lane + 256 * j); s += (v[j][0] * v[j][0] + v[j][1] * v[j][1]) + (v[j][2] * v[j][2] + v[j][3] * v[j][3]); }
    const float rstd = rsqrtf(wave_sum(s) * (1.f / D) + EPS);
#pragma unroll
    for (int j = 0; j < 4; ++j) { const f32x4 g = *(const f32x4*)(gain + 4 * lane + 256 * j);
        u32x2 o; o.x = pk2(v[j][0] * rstd * g[0], v[j][1] * rstd * g[1]); o.y = pk2(v[j][2] * rstd * g[2], v[j][3] * rstd * g[3]);
        *(u32x2*)(orow + 4 * lane + 256 * j) = o; }
}
DEV void zero_row_bf16(bf16* orow, int lane) {
#pragma unroll
    for (int j = 0; j < 4; ++j) { u32x2 o; o.x = 0u; o.y = 0u; *(u32x2*)(orow + 4 * lane + 256 * j) = o; }
}
DEV void phase_prologue(const Ctx& c) {
    float* scr = (float*)(c.lds + c.wave * 8704);
#define TJOB(Wp, K_, N_, Npad_, wt_) do { const int nblk = (Npad_) / 32, nitems = ((K_) / 64) * nblk; bf16* WT = c.w<bf16>(wt_); const float* Wsrc = (Wp); \
        for (int it = c.gw; it < nitems; it += c.ngw) transpose_item(Wsrc, (K_), (N_), WT, scr, it, nblk, c.lane); } while (0)
    TJOB(c.in<float>(13), D, IN_AB, LD1, WS_WINAB);
    TJOB(c.in<float>(11), D, FF, FF, WS_WUP0); TJOB(c.in<float>(11) + (size_t)D * FF, D, FF, FF, WS_WUP1);
    TJOB(c.in<float>(12), FF, D, D, WS_WDN0); TJOB(c.in<float>(12) + (size_t)D * FF, FF, D, D, WS_WDN1);
    TJOB(c.in<float>(24), D, INC, INC, WS_WINC);
    TJOB(c.in<float>(23), D, D, D, WS_WOAB); TJOB(c.in<float>(27), D, D, D, WS_WOC);
    TJOB(c.in<float>(19), 256, 768, 768, WS_WUQ);
    TJOB(c.in<float>(21), 256, 512, 512, WS_WUKV); TJOB(c.in<float>(22), 256, 512, 512, WS_WUKV + (size_t)512 * 256 * 2);
#undef TJOB
    {
        const float* src = c.in<float>(21); bf16* dst = c.w<bf16>(WS_WUKB);
        for (int i = blockIdx.x * 512 + c.tid; i < 256 * 512 / 4; i += gridDim.x * 512) { const f32x4 v = *(const f32x4*)(src + 4 * i); u32x2 o; o.x = pk2(v[0], v[1]); o.y = pk2(v[2], v[3]); *(u32x2*)(dst + 4 * i) = o; }
    }
    float* rope = c.w<float>(WS_ROPE);
    for (int i = blockIdx.x * 512 + c.tid; i < (SEQ + 8) * 16; i += gridDim.x * 512) {
        const int e = i >> 4, f = i & 15; const double pos = e < SEQ ? (double)e : (double)(PAST + e - SEQ);
        const double ang = pos * pow(10000.0, -(double)f / 16.0);
        rope[e * 32 + f] = (float)cos(ang); rope[e * 32 + 16 + f] = (float)sin(ang);
    }
    bf16* XN = c.w<bf16>(WS_XN);
    for (int m = c.gw; m < M; m += c.ngw) {
        if (m < MT) rms_row_to_bf16(xin_row(c, m), c.in<float>(8), XN + (size_t)m * D, c.lane); else zero_row_bf16(XN + (size_t)m * D, c.lane);
    }
}
DEV void sample_row_sum(const Ctx& c, int m, const float* X_res, int nsp, f32x4 (&v)[4]) {
    const int lane = c.lane; const float* P = c.w<float>(WS_PART) + (size_t)(m - MP) * D;
#pragma unroll
    for (int j = 0; j < 4; ++j) {
        if (X_res) v[j] = *(const f32x4*)(X_res + (size_t)m * D + 4 * lane + 256 * j);
        else v[j] = m < MT ? *(const f32x4*)(c.in<float>(1) + (size_t)(m - MP) * D + 4 * lane + 256 * j) : (f32x4){0.f, 0.f, 0.f, 0.f}; }
    for (int s = 0; s < nsp; ++s) {
#pragma unroll
        for (int j = 0; j < 4; ++j) v[j] += *(const f32x4*)(P + (size_t)s * (M - MP) * D + 4 * lane + 256 * j); }
}
DEV void phase_rmsnorm(const Ctx& c, float* X, const float* gain, const float* X_res, int nsp) {
    bf16* XN = c.w<bf16>(WS_XN); const int lane = c.lane;
    for (int m = c.gw; m < M; m += c.ngw) {
        if (m < MP) { rms_row_to_bf16(X + (size_t)m * D, gain, XN + (size_t)m * D, lane); continue; }
        f32x4 v[4]; sample_row_sum(c, m, X_res, nsp, v);
        float s = 0.f;
#pragma unroll
        for (int j = 0; j < 4; ++j) { *(f32x4*)(X + (size_t)m * D + 4 * lane + 256 * j) = v[j]; s += (v[j][0] * v[j][0] + v[j][1] * v[j][1]) + (v[j][2] * v[j][2] + v[j][3] * v[j][3]); }
        const float rstd = rsqrtf(wave_sum(s) * (1.f / D) + EPS);
#pragma unroll
        for (int j = 0; j < 4; ++j) { const f32x4 g = *(const f32x4*)(gain + 4 * lane + 256 * j);
            u32x2 o; o.x = pk2(v[j][0] * rstd * g[0], v[j][1] * rstd * g[1]); o.y = pk2(v[j][2] * rstd * g[2], v[j][3] * rstd * g[3]);
            *(u32x2*)(XN + (size_t)m * D + 4 * lane + 256 * j) = o; }
    }
}
DEV void phase_copy_rows(const Ctx& c, float* dst, const float* src, int nrows) {
    for (int r = (int)(gridDim.x * 8) - 1 - c.gw; r < nrows; r += c.ngw) {
#pragma unroll
        for (int j = 0; j < 4; ++j) *(f32x4*)(dst + (size_t)r * D + 4 * c.lane + 256 * j) = *(const f32x4*)(src + (size_t)r * D + 4 * c.lane + 256 * j); }
}
DEV void phase_final(const Ctx& c, const float* X, const float* gain, const float* X_res, int nsp) {
    for (int m = c.gw; m < MT; m += c.ngw) {
        const float* xrow = X + (size_t)m * D; float* orow = c.out + (m < MP ? O_YP + (size_t)m * D : O_YS + (size_t)(m - MP) * D);
        f32x4 v[4]; float s = 0.f;
        if (m >= MP) sample_row_sum(c, m, X_res, nsp, v);
#pragma unroll
        for (int j = 0; j < 4; ++j) { if (m < MP) v[j] = *(const f32x4*)(xrow + 4 * c.lane + 256 * j); s += (v[j][0] * v[j][0] + v[j][1] * v[j][1]) + (v[j][2] * v[j][2] + v[j][3] * v[j][3]); }
        const float rstd = rsqrtf(wave_sum(s) * (1.f / D) + EPS);
#pragma unroll
        for (int j = 0; j < 4; ++j) { const f32x4 g = *(const f32x4*)(gain + 4 * c.lane + 256 * j); *(f32x4*)(orow + 4 * c.lane + 256 * j) = v[j] * rstd * g; }
    }
}

DEV void phase_prep0(const Ctx& c) {
    const bf16* P1 = c.w<bf16>(WS_P1); const float* rope = c.w<float>(WS_ROPE);
    bf16* CQN = c.w<bf16>(WS_CQN); bf16* LATN = c.w<bf16>(WS_LATN);
    const float* qg = c.in<float>(18); const float* kvg = c.in<float>(20);
    const int lane = c.lane;
    for (int m = c.gw; m < M; m += c.ngw) {
        if (m >= MT) { u32x2 z; z.x = 0u; z.y = 0u; *(u32x2*)(CQN + (size_t)m * 256 + 4 * lane) = z; *(u32x2*)(LATN + (size_t)m * 256 + 4 * lane) = z; continue; }
        const bf16* row = P1 + (size_t)m * LD1;
        const bool samp = m >= MP; const int b = samp ? (m - MP) / DECS : m / SEQ, t = samp ? (m - MP) % DECS : m % SEQ;
        {
            const f32x4 v = ld4bf(row + C_CQ + 4 * lane); const f32x4 g = *(const f32x4*)(qg + 4 * lane);
            const float r = rsqrtf(wave_sum((v[0] * v[0] + v[1] * v[1]) + (v[2] * v[2] + v[3] * v[3])) * (1.f / 256.f) + EPS);
            u32x2 o; o.x = pk2(v[0] * r * g[0], v[1] * r * g[1]); o.y = pk2(v[2] * r * g[2], v[3] * r * g[3]); *(u32x2*)(CQN + (size_t)m * 256 + 4 * lane) = o;
        }
        {
            const f32x4 v = ld4bf(row + C_CKV + 4 * lane); const f32x4 g = *(const f32x4*)(kvg + 4 * lane);
            const float r = rsqrtf(wave_sum((v[0] * v[0] + v[1] * v[1]) + (v[2] * v[2] + v[3] * v[3])) * (1.f / 256.f) + EPS);
            const f32x4 y = v * r * g;
            float* lo = c.out + (samp ? O_LATS + (size_t)(m - MP) * 256 : O_LATP + (size_t)m * 256);
            *(f32x4*)(lo + 4 * lane) = y;
            u32x2 o; o.x = pk2(y[0], y[1]); o.y = pk2(y[2], y[3]); *(u32x2*)(LATN + (size_t)m * 256 + 4 * lane) = o;
        }
        if (lane < 16) {
            const float* rt = rope + (size_t)(samp ? SEQ + t : t) * 32; const float cs = rt[lane], sn = rt[16 + lane];
            const float x1 = bf2f(row[C_KPE + lane]), x2 = bf2f(row[C_KPE + 16 + lane]);
            float* ko = c.out + (samp ? O_KPES + (size_t)(m - MP) * 32 : O_KPEP + (size_t)m * 32);
            ko[lane] = x1 * cs - x2 * sn; ko[16 + lane] = x2 * cs + x1 * sn;
            if (!samp) { bf16* kb = c.w<bf16>(WS_KPEB) + (size_t)m * 32; kb[lane] = (bf16)f2bf(x1 * cs - x2 * sn); kb[16 + lane] = (bf16)f2bf(x2 * cs + x1 * sn); }
        }
        const int T = samp ? DECS : SEQ;
        if (t >= T - 3) {
            float* co = c.out + (samp ? O_CONVS : O_CONVP) + ((size_t)b * 3 + (t - (T - 3))) * QKV_A;
#pragma unroll
            for (int j = 0; j < 6; ++j) *(f32x4*)(co + 4 * lane + 256 * j) = ld4bf(row + 4 * lane + 256 * j);
        }
    }
}

DEV void phase_gdn_naive(const Ctx& c, int u_begin) {
    float* red = (float*)c.lds; float* red2 = red + 512; float* qs = red2 + 512; float* ks = qs + 128; float* vs = ks + 128; float* part = vs + 128; float* sc = part + 8;
    const bf16* P1 = c.w<bf16>(WS_P1); float* ORAW = c.w<float>(WS_ORAW); bf16* OCAT = c.w<bf16>(WS_OCAT);
    const float* convw = c.in<float>(14); const float* gn = c.in<float>(17);
    const int tid = c.tid, lane = c.lane, wave = c.wave;
    const int NU = (BATCH + DECB) * 4;
    for (int u = u_begin + blockIdx.x; u < NU; u += gridDim.x) {
        const bool samp = u >= BATCH * 4; const int b = samp ? (u - BATCH * 4) >> 2 : u >> 2, h = u & 3;
        const int T = samp ? DECS : SEQ; const size_t m0 = samp ? (size_t)MP + (size_t)b * DECS : (size_t)b * SEQ;
        const int e = tid & 127, dg = tid >> 7, d0 = dg * 32;
        float s[32];
        if (samp) { const float* S0 = c.in<float>(2) + ((size_t)(b * 4 + h) * 128 + d0) * 128 + e;
#pragma unroll
            for (int i = 0; i < 32; ++i) s[i] = S0[(size_t)i * 128]; }
        else {
#pragma unroll
            for (int i = 0; i < 32; ++i) s[i] = 0.f; }
        const int col = tid < 128 ? h * 128 + tid : (tid < 256 ? 512 + h * 128 + (tid - 128) : 1024 + h * 128 + (tid - 256));
        float w0 = 0.f, w1 = 0.f, w2 = 0.f, w3 = 0.f, x0 = 0.f, x1 = 0.f, x2 = 0.f, xn = 0.f;
        if (tid < 384) { w0 = convw[col]; w1 = convw[QKV_A + col]; w2 = convw[2 * QKV_A + col]; w3 = convw[3 * QKV_A + col];
            if (samp) { const float* cb = c.in<float>(3) + (size_t)b * 3 * QKV_A + col; x0 = cb[0]; x1 = cb[QKV_A]; x2 = cb[2 * QKV_A]; }
            xn = bf2f(P1[m0 * LD1 + col]); }
        const float Aexp = __expf(c.in<float>(15)[h]), dtb = c.in<float>(16)[h];
        for (int t = 0; t < T; ++t) {
            const size_t m = m0 + t;
            const float x3 = xn; if (t + 1 < T && tid < 384) xn = bf2f(P1[(m + 1) * LD1 + col]);
            float val = 0.f;
            if (tid < 384) { const float y = w0 * x0 + w1 * x1 + w2 * x2 + w3 * x3; val = siluf_(y); x0 = x1; x1 = x2; x2 = x3; }
            const float sq = wave_sum(tid < 256 ? val * val : 0.f);
            if (tid < 128) qs[tid] = val; else if (tid < 256) ks[tid - 128] = val; else if (tid < 384) vs[tid - 256] = val;
            if (lane == 0 && wave < 4) part[wave] = sq;
            if (tid == 384) { sc[0] = sigmoidf_(bf2f(P1[m * LD1 + C_B + h])); sc[1] = -Aexp * softplusf_(bf2f(P1[m * LD1 + C_A + h]) + dtb); }
            LDS_BARRIER();
            const float qn = rsqrtf(part[0] + part[1] + EPS), kn = rsqrtf(part[2] + part[3] + EPS), beta = sc[0], dec = __expf(sc[1]);
            float kp = 0.f;
#pragma unroll
            for (int i = 0; i < 32; ++i) { s[i] *= dec; kp += ks[d0 + i] * s[i]; }
            red[dg * 128 + e] = kp * kn;
            LDS_BARRIER();
            const float kS = (red[e] + red[128 + e]) + (red[256 + e] + red[384 + e]);
            const float delta = beta * (vs[e] - kS) * kn;
            float op = 0.f;
#pragma unroll
            for (int i = 0; i < 32; ++i) { s[i] += ks[d0 + i] * delta; op += qs[d0 + i] * s[i]; }
            red2[dg * 128 + e] = op * qn;
            LDS_BARRIER();
            if (dg == 0) ORAW[m * 512 + h * 128 + e] = ((red2[e] + red2[128 + e]) + (red2[256 + e] + red2[384 + e])) * DK_SCALE;
        }
        float* So = c.out + (samp ? O_GDNS : O_GDNP) + ((size_t)(b * 4 + h) * 128 + d0) * 128 + e;
#pragma unroll
        for (int i = 0; i < 32; ++i) So[(size_t)i * 128] = s[i];
        __syncthreads();
        for (int t = wave; t < T; t += 8) { const size_t m = m0 + t;
            const float v0 = ORAW[m * 512 + h * 128 + lane], v1 = ORAW[m * 512 + h * 128 + 64 + lane];
            const float r = rsqrtf(wave_sum(v0 * v0 + v1 * v1) * (1.f / 128.f) + EPS);
            const float z0 = bf2f(P1[m * LD1 + C_Z + h * 128 + lane]), z1 = bf2f(P1[m * LD1 + C_Z + h * 128 + 64 + lane]);
            OCAT[m * D + h * 128 + lane] = (bf16)f2bf(v0 * r * gn[lane] * siluf_(z0));
            OCAT[m * D + h * 128 + 64 + lane] = (bf16)f2bf(v1 * r * gn[64 + lane] * siluf_(z1)); }
        __syncthreads();
    }
}

DEV void phase_hgrn_naive(const Ctx& c, int u_begin, int wg_first, int wg_stride) {
    float* red = (float*)c.lds; float* qs = red + 512; float* fs = qs + 128;
    const bf16* PC = c.w<bf16>(WS_P1); float* ORAW = c.w<float>(WS_ORAW); bf16* OC = c.w<bf16>(WS_OCAT);
    const float* lbl = c.in<float>(25); const float* gn = c.in<float>(26);
    const int tid = c.tid, lane = c.lane, wave = c.wave;
    const int NU = (BATCH + DECB) * 8;
    for (int u = u_begin + wg_first; u < NU; u += wg_stride) {
        const bool samp = u >= BATCH * 8; const int b = samp ? (u - BATCH * 8) >> 3 : u >> 3, h = u & 7;
        const int T = samp ? DECS : SEQ; const size_t m0 = samp ? (size_t)MP + (size_t)b * DECS : (size_t)b * SEQ;
        const int e = tid & 127, dg = tid >> 7, d0 = dg * 32;
        float s[32];
        if (samp) { const float* S0 = c.in<float>(6) + ((size_t)(b * 8 + h) * 128 + d0) * 128 + e;
#pragma unroll
            for (int i = 0; i < 32; ++i) s[i] = S0[(size_t)i * 128]; }
        else {
#pragma unroll
            for (int i = 0; i < 32; ++i) s[i] = 0.f; }
        float lb = 0.f; if (tid < 128) lb = sigmoidf_(lbl[1024 + h * 128 + tid] - lbl[h * 128 + tid]);
        bf16 nq = 0, nf = 0, nv = 0;
        { const bf16* row = PC + m0 * INC; if (tid < 128) { nq = row[h * 128 + tid]; nf = row[1024 + h * 128 + tid]; } nv = row[2048 + h * 128 + e]; }
        for (int t = 0; t < T; ++t) {
            const size_t m = m0 + t;
            if (tid < 128) { qs[tid] = siluf_(bf2f(nq)); fs[tid] = lb + (1.f - lb) * sigmoidf_(bf2f(nf)); }
            const float v = bf2f(nv);
            if (t + 1 < T) { const bf16* row = PC + (m + 1) * INC; if (tid < 128) { nq = row[h * 128 + tid]; nf = row[1024 + h * 128 + tid]; } nv = row[2048 + h * 128 + e]; }
            LDS_BARRIER();
            float op = 0.f;
#pragma unroll
            for (int i = 0; i < 32; ++i) { const float f = fs[d0 + i]; s[i] = f * s[i] + (1.f - f) * v; op += qs[d0 + i] * s[i]; }
            red[dg * 128 + e] = op;
            LDS_BARRIER();
            if (dg == 0) ORAW[m * D + h * 128 + e] = ((red[e] + red[128 + e]) + (red[256 + e] + red[384 + e])) * DK_SCALE;
        }
        float* So = c.out + (samp ? O_HGS : O_HGP) + ((size_t)(b * 8 + h) * 128 + d0) * 128 + e;
#pragma unroll
        for (int i = 0; i < 32; ++i) So[(size_t)i * 128] = s[i];
        __syncthreads();
        for (int t = wave; t < T; t += 8) { const size_t m = m0 + t;
            const float v0 = ORAW[m * D + h * 128 + lane], v1 = ORAW[m * D + h * 128 + 64 + lane];
            const float r = rsqrtf(wave_sum(v0 * v0 + v1 * v1) * (1.f / 128.f) + EPS);
            const float z0 = bf2f(PC[m * INC + 3072 + h * 128 + lane]), z1 = bf2f(PC[m * INC + 3072 + h * 128 + 64 + lane]);
            OC[m * D + h * 128 + lane] = (bf16)f2bf(v0 * r * gn[lane] * siluf_(z0));
            OC[m * D + h * 128 + 64 + lane] = (bf16)f2bf(v1 * r * gn[64 + lane] * siluf_(z1)); }
        __syncthreads();
    }
}

DEV bf16x8 ld8(const bf16* p) { return *(const bf16x8*)p; }
DEV void softmax_strip(f32x4 (&s)[4], float (&mrun)[4], float (&lrun)[4], float (&alpha)[4], bf16* Ps, int lane) {
#pragma unroll
    for (int r = 0; r < 4; ++r) {
        float mx = fmaxf(fmaxf(s[0][r], s[1][r]), fmaxf(s[2][r], s[3][r])); mx = grp16_max(mx);
        const float mn = fmaxf(mrun[r], mx);
        alpha[r] = __expf(mrun[r] - mn); mrun[r] = mn;
        float sum = 0.f;
#pragma unroll
        for (int nt = 0; nt < 4; ++nt) { const float p = __expf(s[nt][r] - mn); s[nt][r] = p; sum += p; }
        sum = grp16_sum(sum); lrun[r] = lrun[r] * alpha[r] + sum;
    }
#pragma unroll
    for (int nt = 0; nt < 4; ++nt)
#pragma unroll
        for (int r = 0; r < 4; ++r) Ps[((lane >> 4) * 4 + r) * 72 + nt * 16 + (lane & 15)] = (bf16)f2bf(s[nt][r]);
}
DEV void phase_attn_prompt(const Ctx& c) {
    bf16* Qs = (bf16*)c.lds;
    bf16* Ks = Qs + 128 * 104;
    bf16* Vt = Ks + 64 * 104;
    bf16* Psb = Vt + 64 * 72;
    const float* QH = c.w<float>(WS_QH); const bf16* KVP = c.w<bf16>(WS_KVP); const float* rope = c.w<float>(WS_ROPE); bf16* OCAT = c.w<bf16>(WS_OCAT);
    const float* kpe = c.out + O_KPEP;
    const int tid = c.tid, lane = c.lane, w = c.wave;
    bf16* Ps = Psb + w * 16 * 72;
    constexpr int NQB = SEQ / 128, NU = BATCH * 8 * NQB;
    for (int u = blockIdx.x; u < NU; u += gridDim.x) {
        const int qb = NQB - 1 - u / (BATCH * 8), bh = u % (BATCH * 8), b = bh >> 3, h = bh & 7;
        const int q0 = qb * 128; const size_t mb = (size_t)b * SEQ;
        __syncthreads();
        for (int idx = tid; idx < 128 * 80; idx += 512) {
            const int r = idx / 80, j = idx % 80; const float* qrow = QH + (mb + q0 + r) * 768 + h * 96;
            if (j < 64) Qs[r * 104 + j] = (bf16)f2bf(qrow[j] * MLA_SCALE);
            else { const int f = j - 64; const float* rt = rope + (size_t)(q0 + r) * 32; const float cs = rt[f], sn = rt[16 + f], x1 = qrow[64 + f], x2 = qrow[80 + f];
                Qs[r * 104 + 64 + f] = (bf16)f2bf((x1 * cs - x2 * sn) * MLA_SCALE); Qs[r * 104 + 80 + f] = (bf16)f2bf((x2 * cs + x1 * sn) * MLA_SCALE); }
        }
        __syncthreads();
        bf16x8 qf[3];
#pragma unroll
        for (int ks = 0; ks < 3; ++ks) qf[ks] = ld8(Qs + (w * 16 + (lane & 15)) * 104 + ks * 32 + 8 * (lane >> 4));
        float mrun[4], lrun[4], alpha[4]; f32x4 o[4];
#pragma unroll
        for (int r = 0; r < 4; ++r) { mrun[r] = -INFINITY; lrun[r] = 0.f; }
#pragma unroll
        for (int nt = 0; nt < 4; ++nt) o[nt] = (f32x4){0.f, 0.f, 0.f, 0.f};
        const int nkt = 2 * qb + 2;
        for (int kt = 0; kt < nkt; ++kt) {
            const int k0 = kt * 64;
            __syncthreads();
            for (int idx = tid; idx < 64 * 8; idx += 512) {
                const int key = idx >> 3, ch = idx & 7; *(u32x4*)(Ks + key * 104 + ch * 8) = *(const u32x4*)(KVP + (mb + k0 + key) * 1024 + h * 64 + ch * 8); }
            for (int idx = tid; idx < 64 * 32; idx += 512) { const int key = idx >> 5, f = idx & 31; Ks[key * 104 + 64 + f] = (bf16)f2bf(kpe[(mb + k0 + key) * 32 + f]); }
            for (int idx = tid; idx < 64 * 64; idx += 512) { const int key = idx >> 6, d = idx & 63; Vt[d * 72 + key] = KVP[(mb + k0 + key) * 1024 + 512 + h * 64 + d]; }
            __syncthreads();
            f32x4 s[4];
#pragma unroll
            for (int nt = 0; nt < 4; ++nt) { s[nt] = (f32x4){0.f, 0.f, 0.f, 0.f};
#pragma unroll
                for (int ks = 0; ks < 3; ++ks) s[nt] = mfma16(qf[ks], ld8(Ks + (nt * 16 + (lane & 15)) * 104 + ks * 32 + 8 * (lane >> 4)), s[nt]); }
            if (kt >= 2 * qb) {
#pragma unroll
                for (int nt = 0; nt < 4; ++nt)
#pragma unroll
                    for (int r = 0; r < 4; ++r) { const int qpos = q0 + w * 16 + (lane >> 4) * 4 + r, kpos = k0 + nt * 16 + (lane & 15); if (kpos > qpos) s[nt][r] = -INFINITY; }
            }
            softmax_strip(s, mrun, lrun, alpha, Ps, lane);
            WAVE_SYNC();
#pragma unroll
            for (int nt = 0; nt < 4; ++nt) {
#pragma unroll
                for (int r = 0; r < 4; ++r) o[nt][r] *= alpha[r];
#pragma unroll
                for (int k2 = 0; k2 < 2; ++k2) o[nt] = mfma16(ld8(Ps + (lane & 15) * 72 + k2 * 32 + 8 * (lane >> 4)), ld8(Vt + (nt * 16 + (lane & 15)) * 72 + k2 * 32 + 8 * (lane >> 4)), o[nt]); }
            WAVE_SYNC();
        }
#pragma unroll
        for (int nt = 0; nt < 4; ++nt)
#pragma unroll
            for (int r = 0; r < 4; ++r) OCAT[(mb + q0 + w * 16 + (lane >> 4) * 4 + r) * D + 512 + h * 64 + nt * 16 + (lane & 15)] = (bf16)f2bf(o[nt][r] / lrun[r]);
    }
}

DEV void phase_attn_sample(const Ctx& c) {
    bf16* Qs = (bf16*)c.lds;
    bf16* Ks = Qs + 64 * 296;
    bf16* Lt = Ks + 64 * 296;
    float* Sf = (float*)(Lt + 256 * 72);
    bf16* Psb = (bf16*)(Sf + 64 * 68);
    float* Of = (float*)Ks;
    const float* QH = c.w<float>(WS_QH); const float* rope = c.w<float>(WS_ROPE); bf16* OCAT = c.w<bf16>(WS_OCAT);
    const float* wuk = c.in<float>(21); const float* wuv = c.in<float>(22);
    const float* clat = c.in<float>(4); const float* ckr = c.in<float>(5); const int* ptab = c.in<int>(7);
    const int tid = c.tid, lane = c.lane, w = c.wave;
    bf16* Ps = Psb + w * 16 * 72;
    for (int b = blockIdx.x; b < DECB; b += gridDim.x) {
        const size_t mb = (size_t)MP + (size_t)b * DECS;
        __syncthreads();
        for (int idx = tid; idx < 64 * 64; idx += 512) { const int r = idx >> 6, d = idx & 63, t = r >> 3, h = r & 7; Sf[r * 68 + d] = QH[(mb + t) * 768 + h * 96 + d]; }
        for (int idx = tid; idx < 64 * 16; idx += 512) { const int r = idx >> 4, f = idx & 15, t = r >> 3, h = r & 7; const float* qrow = QH + (mb + t) * 768 + h * 96 + 64;
            const float* rt = rope + (size_t)(SEQ + t) * 32; const float cs = rt[f], sn = rt[16 + f], x1 = qrow[f], x2 = qrow[16 + f];
            Qs[r * 296 + 256 + f] = (bf16)f2bf((x1 * cs - x2 * sn) * MLA_SCALE); Qs[r * 296 + 272 + f] = (bf16)f2bf((x2 * cs + x1 * sn) * MLA_SCALE); }
        __syncthreads();
        {
            const int l = tid & 255, th = tid >> 8;
            for (int h = 0; h < 8; ++h) {
                float a0 = 0.f, a1 = 0.f, a2 = 0.f, a3 = 0.f; const float* wr = wuk + (size_t)l * 512 + h * 64;
                const float* q0 = Sf + ((th * 4 + 0) * 8 + h) * 68; const float* q1 = Sf + ((th * 4 + 1) * 8 + h) * 68; const float* q2 = Sf + ((th * 4 + 2) * 8 + h) * 68; const float* q3 = Sf + ((th * 4 + 3) * 8 + h) * 68;
#pragma unroll 4
                for (int d4 = 0; d4 < 16; ++d4) { const f32x4 wv = *(const f32x4*)(wr + 4 * d4);
#pragma unroll
                    for (int j = 0; j < 4; ++j) { a0 += q0[4 * d4 + j] * wv[j]; a1 += q1[4 * d4 + j] * wv[j]; a2 += q2[4 * d4 + j] * wv[j]; a3 += q3[4 * d4 + j] * wv[j]; } }
                Qs[((th * 4 + 0) * 8 + h) * 296 + l] = (bf16)f2bf(a0 * MLA_SCALE); Qs[((th * 4 + 1) * 8 + h) * 296 + l] = (bf16)f2bf(a1 * MLA_SCALE);
                Qs[((th * 4 + 2) * 8 + h) * 296 + l] = (bf16)f2bf(a2 * MLA_SCALE); Qs[((th * 4 + 3) * 8 + h) * 296 + l] = (bf16)f2bf(a3 * MLA_SCALE);
            }
        }
        __syncthreads();
        const int rt = w & 3, hh = w >> 2;
        bf16x8 qf[9];
#pragma unroll
        for (int ks = 0; ks < 9; ++ks) qf[ks] = ld8(Qs + (rt * 16 + (lane & 15)) * 296 + ks * 32 + 8 * (lane >> 4));
        float mrun[4], lrun[4], alpha[4]; f32x4 o[8];
#pragma unroll
        for (int r = 0; r < 4; ++r) { mrun[r] = -INFINITY; lrun[r] = 0.f; }
#pragma unroll
        for (int nt = 0; nt < 8; ++nt) o[nt] = (f32x4){0.f, 0.f, 0.f, 0.f};
        constexpr int NT = PAST / 64 + 1;
        for (int kt = 0; kt < NT; ++kt) {
            const bool fresh = kt == NT - 1;
            __syncthreads();
            if (!fresh) {
                const int k0 = kt * 64; const size_t rowbase = (size_t)ptab[b * NPAGES + (k0 >> 7)] * PAGE + (k0 & 127);
#pragma unroll 2
                for (int j = 0; j < 8; ++j) { const int idx = tid + 512 * j, key = idx >> 6, l4 = idx & 63;
                    const f32x4 v = *(const f32x4*)(clat + (rowbase + key) * 256 + 4 * l4);
                    u32x2 pk; pk.x = pk2(v[0], v[1]); pk.y = pk2(v[2], v[3]); *(u32x2*)(Ks + key * 296 + 4 * l4) = pk;
                    Lt[(4 * l4 + 0) * 72 + key] = (bf16)f2bf(v[0]); Lt[(4 * l4 + 1) * 72 + key] = (bf16)f2bf(v[1]); Lt[(4 * l4 + 2) * 72 + key] = (bf16)f2bf(v[2]); Lt[(4 * l4 + 3) * 72 + key] = (bf16)f2bf(v[3]); }
                { const int key = tid >> 3, i4 = tid & 7; const f32x4 v = *(const f32x4*)(ckr + (rowbase + key) * 32 + 4 * i4);
                    u32x2 pk; pk.x = pk2(v[0], v[1]); pk.y = pk2(v[2], v[3]); *(u32x2*)(Ks + key * 296 + 256 + 4 * i4) = pk; }
            } else {
                const float* nl = c.out + O_LATS + (size_t)b * DECS * 256; const float* nk = c.out + O_KPES + (size_t)b * DECS * 32;
                for (int idx = tid; idx < 64 * 256; idx += 512) { const int key = idx >> 8, l = idx & 255; const bf16 v = key < DECS ? (bf16)f2bf(nl[key * 256 + l]) : (bf16)0; Ks[key * 296 + l] = v; Lt[l * 72 + key] = v; }
                for (int idx = tid; idx < 64 * 32; idx += 512) { const int key = idx >> 5, f = idx & 31; Ks[key * 296 + 256 + f] = key < DECS ? (bf16)f2bf(nk[key * 32 + f]) : (bf16)0; }
            }
            __syncthreads();
#pragma unroll
            for (int n2 = 0; n2 < 2; ++n2) { const int nt = 2 * hh + n2; f32x4 s = (f32x4){0.f, 0.f, 0.f, 0.f};
#pragma unroll
                for (int ks = 0; ks < 9; ++ks) s = mfma16(qf[ks], ld8(Ks + (nt * 16 + (lane & 15)) * 296 + ks * 32 + 8 * (lane >> 4)), s);
#pragma unroll
                for (int r = 0; r < 4; ++r) { const int row = rt * 16 + (lane >> 4) * 4 + r, key = nt * 16 + (lane & 15); float v = s[r];
                    if (fresh && (key >= DECS || key > (row >> 3))) v = -INFINITY;
                    Sf[row * 68 + key] = v; } }
            __syncthreads();
            f32x4 s[4];
#pragma unroll
            for (int nt = 0; nt < 4; ++nt)
#pragma unroll
                for (int r = 0; r < 4; ++r) s[nt][r] = Sf[(rt * 16 + (lane >> 4) * 4 + r) * 68 + nt * 16 + (lane & 15)];
            softmax_strip(s, mrun, lrun, alpha, Ps, lane);
            WAVE_SYNC();
#pragma unroll
            for (int nt = 0; nt < 8; ++nt) {
#pragma unroll
                for (int r = 0; r < 4; ++r) o[nt][r] *= alpha[r];
#pragma unroll
                for (int k2 = 0; k2 < 2; ++k2) o[nt] = mfma16(ld8(Ps + (lane & 15) * 72 + k2 * 32 + 8 * (lane >> 4)), ld8(Lt + (hh * 128 + nt * 16 + (lane & 15)) * 72 + k2 * 32 + 8 * (lane >> 4)), o[nt]); }
            WAVE_SYNC();
        }
        __syncthreads();
#pragma unroll
        for (int nt = 0; nt < 8; ++nt)
#pragma unroll
            for (int r = 0; r < 4; ++r) Of[(rt * 16 + (lane >> 4) * 4 + r) * 260 + hh * 128 + nt * 16 + (lane & 15)] = o[nt][r] / lrun[r];
        __syncthreads();
        {
            const int d = tid & 63, h = tid >> 6; float a[8];
#pragma unroll
            for (int t = 0; t < 8; ++t) a[t] = 0.f;
            for (int l = 0; l < 256; ++l) { const float wv = wuv[(size_t)l * 512 + h * 64 + d];
#pragma unroll
                for (int t = 0; t < 8; ++t) a[t] += Of[(t * 8 + h) * 260 + l] * wv; }
#pragma unroll
            for (int t = 0; t < 8; ++t) OCAT[(mb + t) * D + 512 + h * 64 + d] = (bf16)f2bf(a[t]);
        }
    }
}

constexpr int NCH = SEQ / 64;
constexpr size_t HC_QG = WS_H, HC_BNT = HC_QG + (size_t)BATCH * 8 * NCH * 64 * 128 * 2,
    HC_A = HC_BNT + (size_t)BATCH * 8 * NCH * 128 * 128 * 2, HC_END = HC_A + (size_t)BATCH * 8 * NCH * 128 * 4;
constexpr size_t HC_SNT = WS_QH;
static_assert(HC_END <= WS_H_END && HC_SNT + (size_t)BATCH * 8 * NCH * 128 * 128 * 2 <= WS_OCAT, "hgrn scratch fits");
DEV u32x4 pack8(const float* v) { u32x4 o; o.x = pk2(v[0], v[1]); o.y = pk2(v[2], v[3]); o.z = pk2(v[4], v[5]); o.w = pk2(v[6], v[7]); return o; }

DEV void phase_hgrn_prep(const Ctx& c) {
    bf16* qt = (bf16*)c.lds;
    bf16* kt = qt + 64 * 136;
    bf16* vT = kt + 160 * 136;
    bf16* Ab = vT + 128 * 72;
    float* tot = (float*)(Ab + 64 * 72);
    bf16* kgl = (bf16*)(tot + 512);
    const bf16* PC = c.w<bf16>(WS_P1); float* ORAW = c.w<float>(WS_ORAW);
    bf16* QG = c.w<bf16>(HC_QG); bf16* BNT = c.w<bf16>(HC_BNT); float* Ag = c.w<float>(HC_A);
    const float* lbl = c.in<float>(25);
    const int tid = c.tid, lane = c.lane, w = c.wave;
    const int d = tid & 127, tq = tid >> 7;
    constexpr int NU = BATCH * 8 * NCH;
    bf16 rq[16], rf[16], rv[16];
#define HP_LOAD(u_) do { const int u__ = (u_); const int bh_ = u__ / NCH, n_ = u__ % NCH; const bf16* row_ = PC + ((size_t)(bh_ >> 3) * SEQ + (size_t)n_ * 64 + 16 * tq) * INC + (bh_ & 7) * 128 + d; \
        _Pragma("unroll") for (int i = 0; i < 16; ++i) { rq[i] = row_[(size_t)i * INC]; rf[i] = row_[(size_t)i * INC + 1024]; rv[i] = row_[(size_t)i * INC + 2048]; } } while (0)
    if ((int)blockIdx.x < NU) HP_LOAD(blockIdx.x);
    for (int u = blockIdx.x; u < NU; u += gridDim.x) {
        const int bh = u / NCH, n = u % NCH, b = bh >> 3, h = bh & 7;
        const size_t m0 = (size_t)b * SEQ + (size_t)n * 64;
        const float lb = sigmoidf_(lbl[1024 + h * 128 + d] - lbl[h * 128 + d]);
        float gcl[16], kk[16], qq[16], vv[16];
        float run = 0.f;
#pragma unroll
        for (int i = 0; i < 16; ++i) {
            const float f = lb + (1.f - lb) * sigmoidf_(bf2f(rf[i]));
            kk[i] = 1.f - f; run += __logf(f); gcl[i] = run;
            qq[i] = siluf_(bf2f(rq[i])) * DK_SCALE; vv[i] = bf2f(rv[i]);
        }
        if (u + (int)gridDim.x < NU) HP_LOAD(u + (int)gridDim.x);
        tot[tq * 128 + d] = run;
        { const u32x4 p0 = pack8(vv), p1 = pack8(vv + 8);
          *(u32x4*)(vT + d * 72 + 16 * tq) = p0; *(u32x4*)(vT + d * 72 + 16 * tq + 8) = p1; }
        for (int i = tid; i < 64 * 72 / 8; i += 512) { u32x4 z; z.x = z.y = z.z = z.w = 0u; *(u32x4*)(Ab + 8 * i) = z; }
        LDS_BARRIER();
        const float t0 = tot[d], t1 = tot[128 + d], t2 = tot[256 + d], t3 = tot[384 + d];
        const float rI[4] = {0.f, t0, t0 + t1, t0 + t1 + t2}; const float glast = (t0 + t1) + (t2 + t3);
        const float pre = tq == 0 ? rI[0] : (tq == 1 ? rI[1] : (tq == 2 ? rI[2] : rI[3]));
        float kg[16];
#pragma unroll
        for (int i = 0; i < 16; ++i) {
            const float gc = pre + gcl[i];
            qt[(16 * tq + i) * 136 + d] = (bf16)f2bf(qq[i] * __expf(gcl[i]));
            QG[((size_t)u * 64 + 16 * tq + i) * 128 + d] = (bf16)f2bf(qq[i] * __expf(gc));
            kg[i] = kk[i] * __expf(glast - gc);
#pragma unroll
            for (int I = 0; I < 4; ++I) if (I >= tq) { const int base = I == 0 ? 0 : (I == 1 ? 16 : (I == 2 ? 48 : 96));
                kt[(base + 16 * tq + i) * 136 + d] = (bf16)f2bf(kk[i] * __expf(rI[I] - gc)); }
        }
        { bf16* g = kgl + d * 72 + 16 * tq; *(u32x4*)g = pack8(kg); *(u32x4*)(g + 8) = pack8(kg + 8); }
        if (tq == 0) Ag[(size_t)u * 128 + d] = __expf(glast);
        LDS_BARRIER();
        for (int ti = w; ti < 10; ti += 8) {
            const int I = ti == 0 ? 0 : (ti < 3 ? 1 : (ti < 6 ? 2 : 3)); const int J = ti - (I == 0 ? 0 : (I == 1 ? 1 : (I == 2 ? 3 : 6)));
            const int base = I == 0 ? 0 : (I == 1 ? 16 : (I == 2 ? 48 : 96));
            f32x4 acc = (f32x4){0.f, 0.f, 0.f, 0.f};
#pragma unroll
            for (int ks = 0; ks < 4; ++ks) acc = mfma16(ld8(qt + (16 * I + (lane & 15)) * 136 + ks * 32 + 8 * (lane >> 4)), ld8(kt + (base + 16 * J + (lane & 15)) * 136 + ks * 32 + 8 * (lane >> 4)), acc);
#pragma unroll
            for (int r = 0; r < 4; ++r) { const int i = 16 * I + (lane >> 4) * 4 + r, j = 16 * J + (lane & 15); Ab[i * 72 + j] = (bf16)f2bf((J < I || j <= i) ? acc[r] : 0.f); }
        }
        LDS_BARRIER();
        { const int it = w & 3;
#pragma unroll
          for (int e4 = 0; e4 < 4; ++e4) { const int et = (w >> 2) * 4 + e4; f32x4 acc = (f32x4){0.f, 0.f, 0.f, 0.f};
#pragma unroll
            for (int ks = 0; ks < 2; ++ks) acc = mfma16(ld8(Ab + (16 * it + (lane & 15)) * 72 + ks * 32 + 8 * (lane >> 4)), ld8(vT + (16 * et + (lane & 15)) * 72 + ks * 32 + 8 * (lane >> 4)), acc);
#pragma unroll
            for (int r = 0; r < 4; ++r) ORAW[(m0 + 16 * it + (lane >> 4) * 4 + r) * D + h * 128 + 16 * et + (lane & 15)] = acc[r]; } }
        {
            bf16x8 ka[2];
#pragma unroll
            for (int ks = 0; ks < 2; ++ks) ka[ks] = ld8(kgl + (16 * w + (lane & 15)) * 72 + ks * 32 + 8 * (lane >> 4));
            bf16* g = BNT + (size_t)u * 16384;
#pragma unroll
            for (int et = 0; et < 8; ++et) { f32x4 acc = (f32x4){0.f, 0.f, 0.f, 0.f};
#pragma unroll
                for (int ks = 0; ks < 2; ++ks) acc = mfma16(ka[ks], ld8(vT + (16 * et + (lane & 15)) * 72 + ks * 32 + 8 * (lane >> 4)), acc);
                u32x2 o; o.x = pk2(acc[0], acc[1]); o.y = pk2(acc[2], acc[3]); *(u32x2*)(g + (16 * et + (lane & 15)) * 128 + 16 * w + 4 * (lane >> 4)) = o; }
        }
        LDS_BARRIER();
    }
}

#undef HP_LOAD
DEV void phase_hgrn_prefix(const Ctx& c) {
    const bf16* BNT = c.w<bf16>(HC_BNT); const float* Ag = c.w<float>(HC_A); bf16* SNT = c.w<bf16>(HC_SNT);
    constexpr int NV = BATCH * 8 * 2048;
    for (int v = blockIdx.x * 512 + c.tid; v < NV; v += gridDim.x * 512) {
        const int bh = v >> 11, x8 = (v & 2047) * 8, d0 = x8 & 127, e = x8 >> 7;
        float S[8];
#pragma unroll
        for (int j = 0; j < 8; ++j) S[j] = 0.f;
        const size_t base = (size_t)bh * NCH * 16384 + x8;
        constexpr int PFD = NCH < 8 ? NCH : 8;
        u32x4 bq[PFD]; f32x4 aq0[PFD], aq1[PFD];
#pragma unroll
        for (int j = 0; j < PFD; ++j) { bq[j] = *(const u32x4*)(BNT + base + (size_t)j * 16384); aq0[j] = *(const f32x4*)(Ag + ((size_t)bh * NCH + j) * 128 + d0); aq1[j] = *(const f32x4*)(Ag + ((size_t)bh * NCH + j) * 128 + d0 + 4); }
#pragma unroll
        for (int n = 0; n < NCH; ++n) {
            const u32x4 bv = bq[n % PFD]; const f32x4 a0 = aq0[n % PFD], a1 = aq1[n % PFD];
            if (n + PFD < NCH) { bq[n % PFD] = *(const u32x4*)(BNT + base + (size_t)(n + PFD) * 16384); aq0[n % PFD] = *(const f32x4*)(Ag + ((size_t)bh * NCH + n + PFD) * 128 + d0); aq1[n % PFD] = *(const f32x4*)(Ag + ((size_t)bh * NCH + n + PFD) * 128 + d0 + 4); }
            *(u32x4*)(SNT + base + (size_t)n * 16384) = pack8(S);
            S[0] = a0[0] * S[0] + __uint_as_float(bv.x << 16); S[1] = a0[1] * S[1] + __uint_as_float(bv.x & 0xffff0000u);
            S[2] = a0[2] * S[2] + __uint_as_float(bv.y << 16); S[3] = a0[3] * S[3] + __uint_as_float(bv.y & 0xffff0000u);
            S[4] = a1[0] * S[4] + __uint_as_float(bv.z << 16); S[5] = a1[1] * S[5] + __uint_as_float(bv.z & 0xffff0000u);
            S[6] = a1[2] * S[6] + __uint_as_float(bv.w << 16); S[7] = a1[3] * S[7] + __uint_as_float(bv.w & 0xffff0000u);
        }
        float* So = c.out + O_HGP + (size_t)bh * 16384;
#pragma unroll
        for (int j = 0; j < 8; ++j) So[(size_t)(d0 + j) * 128 + e] = S[j];
    }
}

DEV void phase_hgrn_out(const Ctx& c) {
    bf16* qg = (bf16*)c.lds;
    bf16* StT = qg + 64 * 136;
    float* ob = (float*)(StT + 128 * 136);
    const bf16* PC = c.w<bf16>(WS_P1); const float* ORAW = c.w<float>(WS_ORAW); bf16* OC = c.w<bf16>(WS_OCAT);
    const bf16* QG = c.w<bf16>(HC_QG); const bf16* SNT = c.w<bf16>(HC_SNT);
    const float* gn = c.in<float>(26);
    const int tid = c.tid, lane = c.lane, w = c.wave;
    const float gn0 = gn[lane], gn1 = gn[64 + lane];
    constexpr int NU = BATCH * 8 * NCH;
    u32x4 pq[2], ps[4]; float or0n[8], or1n[8]; bf16 zz0n[8], zz1n[8];
#define HO_LOAD(u_) do { const int u__ = (u_); const int bh_ = u__ / NCH, n_ = u__ % NCH, b_ = bh_ >> 3, h_ = bh_ & 7; const size_t m0_ = (size_t)b_ * SEQ + (size_t)n_ * 64; \
        _Pragma("unroll") for (int j = 0; j < 2; ++j) pq[j] = *(const u32x4*)(QG + (size_t)u__ * 8192 + 8 * (tid + 512 * j)); \
        _Pragma("unroll") for (int j = 0; j < 4; ++j) ps[j] = *(const u32x4*)(SNT + (size_t)u__ * 16384 + 8 * (tid + 512 * j)); \
        _Pragma("unroll") for (int i8 = 0; i8 < 8; ++i8) { const size_t m = m0_ + w * 8 + i8; or0n[i8] = ORAW[m * D + h_ * 128 + lane]; or1n[i8] = ORAW[m * D + h_ * 128 + 64 + lane]; \
            zz0n[i8] = PC[m * INC + 3072 + h_ * 128 + lane]; zz1n[i8] = PC[m * INC + 3072 + h_ * 128 + 64 + lane]; } } while (0)
    if ((int)blockIdx.x < NU) HO_LOAD(blockIdx.x);
    for (int u = blockIdx.x; u < NU; u += gridDim.x) {
        const int bh = u / NCH, n = u % NCH, b = bh >> 3, h = bh & 7; const size_t m0 = (size_t)b * SEQ + (size_t)n * 64;
        float or0[8], or1[8], zz0[8], zz1[8];
#pragma unroll
        for (int i8 = 0; i8 < 8; ++i8) { or0[i8] = or0n[i8]; or1[i8] = or1n[i8]; zz0[i8] = bf2f(zz0n[i8]); zz1[i8] = bf2f(zz1n[i8]); }
        LDS_BARRIER();
#pragma unroll
        for (int j = 0; j < 2; ++j) { const int idx = tid + 512 * j; *(u32x4*)(qg + (idx >> 4) * 136 + (idx & 15) * 8) = pq[j]; }
#pragma unroll
        for (int j = 0; j < 4; ++j) { const int idx = tid + 512 * j; *(u32x4*)(StT + (idx >> 4) * 136 + (idx & 15) * 8) = ps[j]; }
        if (u + (int)gridDim.x < NU) HO_LOAD(u + (int)gridDim.x);
        LDS_BARRIER();
        { const int it = w & 3; bf16x8 qa[4];
#pragma unroll
          for (int ks = 0; ks < 4; ++ks) qa[ks] = ld8(qg + (16 * it + (lane & 15)) * 136 + ks * 32 + 8 * (lane >> 4));
#pragma unroll
          for (int e4 = 0; e4 < 4; ++e4) { const int et = (w >> 2) * 4 + e4; f32x4 acc = (f32x4){0.f, 0.f, 0.f, 0.f};
#pragma unroll
            for (int ks = 0; ks < 4; ++ks) acc = mfma16(qa[ks], ld8(StT + (16 * et + (lane & 15)) * 136 + ks * 32 + 8 * (lane >> 4)), acc);
#pragma unroll
            for (int r = 0; r < 4; ++r) ob[(16 * it + (lane >> 4) * 4 + r) * 132 + 16 * et + (lane & 15)] = acc[r]; } }
        LDS_BARRIER();
        { float ss[8];
#pragma unroll
          for (int i8 = 0; i8 < 8; ++i8) { const int i = w * 8 + i8; or0[i8] += ob[i * 132 + lane]; or1[i8] += ob[i * 132 + 64 + lane]; ss[i8] = or0[i8] * or0[i8] + or1[i8] * or1[i8]; }
#pragma unroll
              for (int i8 = 0; i8 < 8; ++i8) ss[i8] = wave_sum(ss[i8]);
#pragma unroll
          for (int i8 = 0; i8 < 8; ++i8) { const size_t m = m0 + w * 8 + i8; const float r = rsqrtf(ss[i8] * (1.f / 128.f) + EPS);
            OC[m * D + h * 128 + lane] = (bf16)f2bf(or0[i8] * r * gn0 * siluf_(zz0[i8])); OC[m * D + h * 128 + 64 + lane] = (bf16)f2bf(or1[i8] * r * gn1 * siluf_(zz1[i8])); } }
    }
}


constexpr int NUG = BATCH * 4 * NCH;
constexpr size_t GC_W = WS_H, GC_UT = GC_W + (size_t)NUG * 64 * 128 * 2, GC_QG = GC_UT + (size_t)NUG * 128 * 64 * 4, GC_KGT = GC_QG + (size_t)NUG * 64 * 128 * 2,
    GC_AQK = GC_KGT + (size_t)NUG * 128 * 64 * 2, GC_GL = GC_AQK + (size_t)NUG * 64 * 64 * 2, GC_END = GC_GL + (size_t)NUG * 4;
static_assert(GC_END <= WS_H_END, "gdn scratch fits in H");

DEV void phase_gdn_prep(const Ctx& c) {
    bf16* qb = (bf16*)c.lds;
    bf16* kb = qb + 64 * 136;
    float* Lm = (float*)(kb + 64 * 136);
    float* part = Lm + 64 * 68;
    float* gl = part + 256; float* gcs = gl + 64; float* bet = gcs + 64; float* eg = bet + 64; float* egl = eg + 64; float* qn = egl + 64; float* kn = qn + 64;
    float* sqb = kn + 64;
    const bf16* P1 = c.w<bf16>(WS_P1);
    bf16* Wg = c.w<bf16>(GC_W); float* UTg = c.w<float>(GC_UT); bf16* QGg = c.w<bf16>(GC_QG); bf16* KGTg = c.w<bf16>(GC_KGT); bf16* AQKg = c.w<bf16>(GC_AQK); float* GLg = c.w<float>(GC_GL);
    const float* convw = c.in<float>(14);
    const int tid = c.tid, lane = c.lane, w = c.wave;
    const int role = tid >> 7, cc = tid & 127;
    for (int u = blockIdx.x; u < NUG; u += gridDim.x) {
        const int bh = u / NCH, n = u % NCH, b = bh >> 2, h = bh & 3;
        const size_t m0 = (size_t)b * SEQ + (size_t)n * 64;
        float x[64];
        if (role < 3) {
            const int col = role * 512 + h * 128 + cc;
            const float w0 = convw[col], w1 = convw[QKV_A + col], w2 = convw[2 * QKV_A + col], w3 = convw[3 * QKV_A + col];
            const bf16* src = P1 + m0 * LD1 + col;
            float p0 = 0.f, p1 = 0.f, p2 = 0.f;
            if (n > 0) { p0 = bf2f(src[-3 * (long)LD1]); p1 = bf2f(src[-2 * (long)LD1]); p2 = bf2f(src[-1 * (long)LD1]); }
#pragma unroll
            for (int j = 0; j < 64; ++j) x[j] = bf2f(src[(size_t)j * LD1]);
#pragma unroll
            for (int j = 0; j < 64; ++j) { const float cur = x[j]; const float y = w0 * p0 + w1 * p1 + w2 * p2 + w3 * cur; x[j] = siluf_(y); p0 = p1; p1 = p2; p2 = cur; }
            if (role < 2) {
#pragma unroll
                for (int j4 = 0; j4 < 16; ++j4) *(f32x4*)(sqb + tid * 68 + 4 * j4) = (f32x4){x[4 * j4] * x[4 * j4], x[4 * j4 + 1] * x[4 * j4 + 1], x[4 * j4 + 2] * x[4 * j4 + 2], x[4 * j4 + 3] * x[4 * j4 + 3]};
            }
        } else if (cc < 64) {
            const float Aexp = __expf(c.in<float>(15)[h]), dtb = c.in<float>(16)[h];
            bet[cc] = sigmoidf_(bf2f(P1[(m0 + cc) * LD1 + C_B + h]));
            gl[cc] = -Aexp * softplusf_(bf2f(P1[(m0 + cc) * LD1 + C_A + h]) + dtb);
        }
        __syncthreads();
        if (role == 3) {
            if (cc < 64) { float acc = 0.f, totl = 0.f;
                for (int i = 0; i < 64; ++i) { const float g = gl[i]; totl += g; if (i <= cc) acc += g; }
                gcs[cc] = acc; eg[cc] = __expf(acc); egl[cc] = __expf(totl - acc);
                if (cc == 0) GLg[u] = __expf(totl);
            } else { const int j = cc - 64; float sq = 0.f, sk = 0.f;
#pragma unroll 16
                for (int cx = 0; cx < 128; ++cx) { sq += sqb[cx * 68 + j]; sk += sqb[(128 + cx) * 68 + j]; }
                qn[j] = rsqrtf(sq + EPS); kn[j] = rsqrtf(sk + EPS); }
        }
        __syncthreads();
        if (role == 0) {
#pragma unroll
            for (int j = 0; j < 64; ++j) { const float qh = x[j] * qn[j]; qb[j * 136 + cc] = (bf16)f2bf(qh); QGg[((size_t)u * 64 + j) * 128 + cc] = (bf16)f2bf(qh * DK_SCALE * eg[j]); }
        } else if (role == 1) {
            bf16* g = KGTg + ((size_t)u * 128 + cc) * 64;
#pragma unroll
            for (int j8 = 0; j8 < 8; ++j8) { float t[8];
#pragma unroll
                for (int q = 0; q < 8; ++q) { const int j = 8 * j8 + q; const float kh = x[j] * kn[j]; kb[j * 136 + cc] = (bf16)f2bf(kh); t[q] = kh * egl[j]; x[j] = kh * bet[j] * eg[j]; }
                *(u32x4*)(g + 8 * j8) = pack8(t); }
        } else if (role == 2) {
#pragma unroll
            for (int j = 0; j < 64; ++j) x[j] *= bet[j];
        }
        __syncthreads();
        for (int ti = w; ti < 32; ti += 8) {
            const bool isq = ti >= 16; const int I = (ti & 15) >> 2, J = ti & 3;
            if (J > I) { if (isq) {
#pragma unroll
                    for (int r = 0; r < 4; ++r) AQKg[((size_t)u * 64 + 16 * I + (lane >> 4) * 4 + r) * 64 + 16 * J + (lane & 15)] = (bf16)0; }
                continue; }
            const bf16* Ab = isq ? qb : kb;
            f32x4 acc = (f32x4){0.f, 0.f, 0.f, 0.f};
#pragma unroll
            for (int ks = 0; ks < 4; ++ks) acc = mfma16(ld8(Ab + (16 * I + (lane & 15)) * 136 + ks * 32 + 8 * (lane >> 4)), ld8(kb + (16 * J + (lane & 15)) * 136 + ks * 32 + 8 * (lane >> 4)), acc);
#pragma unroll
            for (int r = 0; r < 4; ++r) { const int i = 16 * I + (lane >> 4) * 4 + r, j = 16 * J + (lane & 15);
                const float dcy = __expf(fminf(gcs[i] - gcs[j], 0.f));
                if (isq) AQKg[((size_t)u * 64 + i) * 64 + j] = (bf16)f2bf(i >= j ? acc[r] * DK_SCALE * dcy : 0.f);
                else Lm[i * 68 + j] = i > j ? bet[i] * acc[r] * dcy : 0.f; }
        }
        __syncthreads();
        if (role == 1 || role == 2) {
#pragma unroll
            for (int i = 1; i < 64; ++i) { float acc = x[i];
#pragma unroll
                for (int j = 0; j < i; ++j) acc -= Lm[i * 68 + j] * x[j];
                x[i] = acc; }
            if (role == 1) {
#pragma unroll
                for (int i = 0; i < 64; ++i) Wg[((size_t)u * 64 + i) * 128 + cc] = (bf16)f2bf(x[i]);
            } else { float* g = UTg + ((size_t)u * 128 + cc) * 64;
#pragma unroll
                for (int i4 = 0; i4 < 16; ++i4) *(f32x4*)(g + 4 * i4) = (f32x4){x[4 * i4], x[4 * i4 + 1], x[4 * i4 + 2], x[4 * i4 + 3]}; }
        }
        __syncthreads();
    }
}

DEV void phase_gdn_scan(const Ctx& c, int u_first, int u_stride) {
    bf16* wl = (bf16*)c.lds;
    bf16* qgl = wl + 64 * 136;
    bf16* kgT = qgl + 64 * 136;
    bf16* aqk = kgT + 128 * 72;
    bf16* StT = aqk + 64 * 72;
    bf16* vnT = StT + 128 * 136;
    float* ob = (float*)(vnT + 128 * 72);
    const bf16* P1 = c.w<bf16>(WS_P1); bf16* OCAT = c.w<bf16>(WS_OCAT);
    const bf16* Wg = c.w<bf16>(GC_W); const float* UTg = c.w<float>(GC_UT); const bf16* QGg = c.w<bf16>(GC_QG); const bf16* KGTg = c.w<bf16>(GC_KGT); const bf16* AQKg = c.w<bf16>(GC_AQK); const float* GLg = c.w<float>(GC_GL);
    const float* gn = c.in<float>(17);
    const int tid = c.tid, lane = c.lane, w = c.wave;
    constexpr int NU = BATCH * 4;
    for (int u = u_first; u < NU; u += u_stride) {
        const int b = u >> 2, h = u & 3; const size_t mb = (size_t)b * SEQ;
        f32x4 S[8];
#pragma unroll
        for (int et = 0; et < 8; ++et) S[et] = (f32x4){0.f, 0.f, 0.f, 0.f};
        __syncthreads();
        for (int i = tid; i < 128 * 136 / 8; i += 512) { u32x4 z; z.x = z.y = z.z = z.w = 0u; *(u32x4*)(StT + 8 * i) = z; }
        u32x4 pw[2], pq[2], pk[2], pa;
        const size_t cu0 = (size_t)u * NCH;
#define GD_LOAD(n_) do { const bf16* g0 = Wg + (cu0 + (n_)) * 64 * 128; const bf16* g1 = QGg + (cu0 + (n_)) * 64 * 128; const bf16* g2 = KGTg + (cu0 + (n_)) * 128 * 64; const bf16* g3 = AQKg + (cu0 + (n_)) * 64 * 64; \
            _Pragma("unroll") for (int j = 0; j < 2; ++j) { const int idx = tid + 512 * j; pw[j] = *(const u32x4*)(g0 + 8 * idx); pq[j] = *(const u32x4*)(g1 + 8 * idx); pk[j] = *(const u32x4*)(g2 + 8 * idx); } \
            pa = *(const u32x4*)(g3 + 8 * tid); } while (0)
#define GD_STORE_WQ() do { _Pragma("unroll") for (int j = 0; j < 2; ++j) { const int idx = tid + 512 * j; *(u32x4*)(wl + (idx >> 4) * 136 + (idx & 15) * 8) = pw[j]; *(u32x4*)(qgl + (idx >> 4) * 136 + (idx & 15) * 8) = pq[j]; } } while (0)
#define GD_STORE_KA() do { _Pragma("unroll") for (int j = 0; j < 2; ++j) { const int idx = tid + 512 * j; *(u32x4*)(kgT + (idx >> 3) * 72 + (idx & 7) * 8) = pk[j]; } \
            *(u32x4*)(aqk + (tid >> 3) * 72 + (tid & 7) * 8) = pa; } while (0)
        GD_LOAD(0); GD_STORE_WQ(); GD_STORE_KA();
        __syncthreads();
        const int it = w & 3;
        const float gn0 = gn[lane], gn1 = gn[64 + lane];
        f32x4 u4[4]; float dec, decn;
#define GD_LOADU(dst, dd, n_) do { _Pragma("unroll") for (int e4 = 0; e4 < 4; ++e4) { const int et = (w >> 2) * 4 + e4; dst[e4] = *(const f32x4*)(UTg + ((cu0 + (n_)) * 128 + 16 * et + (lane & 15)) * 64 + 16 * it + 4 * (lane >> 4)); } dd = GLg[cu0 + (n_)]; } while (0)
        GD_LOADU(u4, decn, 0);
        for (int n = 0; n < NCH; ++n) {
            dec = decn;
            if (n + 1 < NCH) GD_LOAD(n + 1);
            f32x4 ao[4];
            bf16x8 wa[4], qa[4];
#pragma unroll
            for (int ks = 0; ks < 4; ++ks) { wa[ks] = ld8(wl + (16 * it + (lane & 15)) * 136 + ks * 32 + 8 * (lane >> 4)); qa[ks] = ld8(qgl + (16 * it + (lane & 15)) * 136 + ks * 32 + 8 * (lane >> 4)); }
#pragma unroll
            for (int e4 = 0; e4 < 4; ++e4) { const int et = (w >> 2) * 4 + e4; f32x4 av = (f32x4){0.f, 0.f, 0.f, 0.f}; ao[e4] = (f32x4){0.f, 0.f, 0.f, 0.f};
#pragma unroll
                for (int ks = 0; ks < 4; ++ks) { const bf16x8 bs = ld8(StT + (16 * et + (lane & 15)) * 136 + ks * 32 + 8 * (lane >> 4));
                    av = mfma16(wa[ks], bs, av);
                    ao[e4] = mfma16(qa[ks], bs, ao[e4]); }
                const f32x4 vn = u4[e4] - av;
                u32x2 o; o.x = pk2(vn[0], vn[1]); o.y = pk2(vn[2], vn[3]); *(u32x2*)(vnT + (16 * et + (lane & 15)) * 72 + 16 * it + 4 * (lane >> 4)) = o; }
            if (n + 1 < NCH) GD_LOADU(u4, decn, n + 1);
            LDS_BARRIER();
            float zz0[8], zz1[8];
#pragma unroll
            for (int i8 = 0; i8 < 8; ++i8) { const size_t m = mb + (size_t)n * 64 + w * 8 + i8; zz0[i8] = bf2f(P1[m * LD1 + C_Z + h * 128 + lane]); zz1[i8] = bf2f(P1[m * LD1 + C_Z + h * 128 + 64 + lane]); }
#pragma unroll
            for (int e4 = 0; e4 < 4; ++e4) { const int et = (w >> 2) * 4 + e4;
#pragma unroll
                for (int ks = 0; ks < 2; ++ks) ao[e4] = mfma16(ld8(aqk + (16 * it + (lane & 15)) * 72 + ks * 32 + 8 * (lane >> 4)), ld8(vnT + (16 * et + (lane & 15)) * 72 + ks * 32 + 8 * (lane >> 4)), ao[e4]);
#pragma unroll
                for (int r = 0; r < 4; ++r) ob[(16 * it + (lane >> 4) * 4 + r) * 132 + 16 * et + (lane & 15)] = ao[e4][r]; }
#pragma unroll
            for (int et = 0; et < 8; ++et) { S[et] = S[et] * dec;
#pragma unroll
                for (int ks = 0; ks < 2; ++ks) S[et] = mfma16(ld8(kgT + (16 * w + (lane & 15)) * 72 + ks * 32 + 8 * (lane >> 4)), ld8(vnT + (16 * et + (lane & 15)) * 72 + ks * 32 + 8 * (lane >> 4)), S[et]);
                u32x2 o; o.x = pk2(S[et][0], S[et][1]); o.y = pk2(S[et][2], S[et][3]); *(u32x2*)(StT + (16 * et + (lane & 15)) * 136 + 16 * w + (lane >> 4) * 4) = o; }
            if (n + 1 < NCH) GD_STORE_WQ();
            LDS_BARRIER();
            { float ss[8], v0[8], v1[8];
#pragma unroll
              for (int i8 = 0; i8 < 8; ++i8) { const int i = w * 8 + i8; v0[i8] = ob[i * 132 + lane]; v1[i8] = ob[i * 132 + 64 + lane]; ss[i8] = v0[i8] * v0[i8] + v1[i8] * v1[i8]; }
#pragma unroll
              for (int i8 = 0; i8 < 8; ++i8) ss[i8] = wave_sum(ss[i8]);
#pragma unroll
              for (int i8 = 0; i8 < 8; ++i8) { const size_t m = mb + (size_t)n * 64 + w * 8 + i8; const float r = rsqrtf(ss[i8] * (1.f / 128.f) + EPS);
                OCAT[m * D + h * 128 + lane] = (bf16)f2bf(v0[i8] * r * gn0 * siluf_(zz0[i8])); OCAT[m * D + h * 128 + 64 + lane] = (bf16)f2bf(v1[i8] * r * gn1 * siluf_(zz1[i8])); } }
            if (n + 1 < NCH) GD_STORE_KA();
        }
#undef GD_LOAD
#undef GD_LOADU
#undef GD_STORE_WQ
#undef GD_STORE_KA
        float* So = c.out + O_GDNP + (size_t)(b * 4 + h) * 16384;
#pragma unroll
        for (int et = 0; et < 8; ++et)
#pragma unroll
            for (int r = 0; r < 4; ++r) So[(size_t)(16 * w + (lane >> 4) * 4 + r) * 128 + 16 * et + (lane & 15)] = S[et][r];
    }
}


constexpr size_t GC_SN = WS_P1 + (size_t)M * 4096 * 2, GC_VN = GC_SN + (size_t)NUG * 128 * 128 * 2, GC2_END = GC_VN + (size_t)NUG * 128 * 64 * 2;
static_assert(GC2_END <= WS_P1 + (size_t)M * 4096 * 4 && (size_t)M * LD1 * 2 <= (size_t)M * 4096 * 2, "scan-lite scratch sits in the upper half of the P1 region");
DEV void phase_gdn_scan2(const Ctx& c, int u_first, int u_stride) {
    bf16* wl = (bf16*)c.lds;
    bf16* kgT = wl + 64 * 136;
    bf16* StT = kgT + 128 * 72;
    bf16* vnT = StT + 128 * 136;
    const bf16* Wg = c.w<bf16>(GC_W); const float* UTg = c.w<float>(GC_UT); const bf16* KGTg = c.w<bf16>(GC_KGT); const float* GLg = c.w<float>(GC_GL);
    bf16* SNg = c.w<bf16>(GC_SN); bf16* VNg = c.w<bf16>(GC_VN);
    const int tid = c.tid, lane = c.lane, w = c.wave;
    constexpr int NU = BATCH * 4;
#pragma unroll 1
    for (int u = u_first; u < NU; u += u_stride) {
        const int b = u >> 2, h = u & 3;
        f32x4 S[8];
#pragma unroll
        for (int et = 0; et < 8; ++et) S[et] = (f32x4){0.f, 0.f, 0.f, 0.f};
        __syncthreads();
        for (int i = tid; i < 128 * 136 / 8; i += 512) { u32x4 z; z.x = z.y = z.z = z.w = 0u; *(u32x4*)(StT + 8 * i) = z; }
        u32x4 pw[2], pk[2];
        const size_t cu0 = (size_t)u * NCH;
#define G2_LOAD(n_) do { const bf16* g0 = Wg + (cu0 + (n_)) * 8192; const bf16* g2 = KGTg + (cu0 + (n_)) * 8192; \
            _Pragma("unroll") for (int j = 0; j < 2; ++j) { const int idx = tid + 512 * j; pw[j] = *(const u32x4*)(g0 + 8 * idx); pk[j] = *(const u32x4*)(g2 + 8 * idx); } } while (0)
#define G2_STORE_W() do { _Pragma("unroll") for (int j = 0; j < 2; ++j) { const int idx = tid + 512 * j; *(u32x4*)(wl + (idx >> 4) * 136 + (idx & 15) * 8) = pw[j]; } } while (0)
#define G2_STORE_K() do { _Pragma("unroll") for (int j = 0; j < 2; ++j) { const int idx = tid + 512 * j; *(u32x4*)(kgT + (idx >> 3) * 72 + (idx & 7) * 8) = pk[j]; } } while (0)
        G2_LOAD(0); G2_STORE_W(); G2_STORE_K();
        __syncthreads();
        const int it = w & 3;
        f32x4 u4[4]; float dec, decn;
#define G2_LOADU(n_) do { _Pragma("unroll") for (int e4 = 0; e4 < 4; ++e4) { const int et = (w >> 2) * 4 + e4; u4[e4] = *(const f32x4*)(UTg + ((cu0 + (n_)) * 128 + 16 * et + (lane & 15)) * 64 + 16 * it + 4 * (lane >> 4)); } decn = GLg[cu0 + (n_)]; } while (0)
        G2_LOADU(0);
#pragma unroll 1
        for (int n = 0; n < NCH; ++n) {
            dec = decn;
            if (n + 1 < NCH) G2_LOAD(n + 1);
            {
                bf16* sg = SNg + (cu0 + n) * 16384;
#pragma unroll
                for (int et = 0; et < 8; ++et) { u32x2 o; o.x = pk2(S[et][0], S[et][1]); o.y = pk2(S[et][2], S[et][3]); *(u32x2*)(sg + (16 * et + (lane & 15)) * 128 + 16 * w + (lane >> 4) * 4) = o; }
            }
            {
                bf16x8 wa[4];
#pragma unroll
                for (int ks = 0; ks < 4; ++ks) wa[ks] = ld8(wl + (16 * it + (lane & 15)) * 136 + ks * 32 + 8 * (lane >> 4));
                bf16* vg = VNg + (cu0 + n) * 8192;
#pragma unroll
                for (int e4 = 0; e4 < 4; ++e4) { const int et = (w >> 2) * 4 + e4; f32x4 av = (f32x4){0.f, 0.f, 0.f, 0.f};
#pragma unroll
                    for (int ks = 0; ks < 4; ++ks) av = mfma16(wa[ks], ld8(StT + (16 * et + (lane & 15)) * 136 + ks * 32 + 8 * (lane >> 4)), av);
                    const f32x4 vn = u4[e4] - av;
                    u32x2 o; o.x = pk2(vn[0], vn[1]); o.y = pk2(vn[2], vn[3]);
                    *(u32x2*)(vnT + (16 * et + (lane & 15)) * 72 + 16 * it + 4 * (lane >> 4)) = o;
                    *(u32x2*)(vg + (16 * et + (lane & 15)) * 64 + 16 * it + 4 * (lane >> 4)) = o; }
            }
            if (n + 1 < NCH) G2_LOADU(n + 1);
            LDS_BARRIER();
            {
                bf16x8 ka[2];
#pragma unroll
                for (int ks = 0; ks < 2; ++ks) ka[ks] = ld8(kgT + (16 * w + (lane & 15)) * 72 + ks * 32 + 8 * (lane >> 4));
#pragma unroll
                for (int et = 0; et < 8; ++et) { S[et] = S[et] * dec;
#pragma unroll
                    for (int ks = 0; ks < 2; ++ks) S[et] = mfma16(ka[ks], ld8(vnT + (16 * et + (lane & 15)) * 72 + ks * 32 + 8 * (lane >> 4)), S[et]);
                    u32x2 o; o.x = pk2(S[et][0], S[et][1]); o.y = pk2(S[et][2], S[et][3]); *(u32x2*)(StT + (16 * et + (lane & 15)) * 136 + 16 * w + (lane >> 4) * 4) = o; }
            }
            if (n + 1 < NCH) G2_STORE_W();
            LDS_BARRIER();
            if (n + 1 < NCH) G2_STORE_K();
        }
#undef G2_LOAD
#undef G2_STORE_W
#undef G2_STORE_K
#undef G2_LOADU
        float* So = c.out + O_GDNP + (size_t)(b * 4 + h) * 16384;
#pragma unroll
        for (int et = 0; et < 8; ++et)
#pragma unroll
            for (int r = 0; r < 4; ++r) So[(size_t)(16 * w + (lane >> 4) * 4 + r) * 128 + 16 * et + (lane & 15)] = S[et][r];
    }
}

DEV void phase_gdn_out(const Ctx& c) {
    bf16* qg = (bf16*)c.lds;
    bf16* StT = qg + 64 * 136;
    bf16* aqk = StT + 128 * 136;
    bf16* vnT = aqk + 64 * 72;
    float* ob = (float*)(vnT + 128 * 72);
    const bf16* P1 = c.w<bf16>(WS_P1); bf16* OCAT = c.w<bf16>(WS_OCAT);
    const bf16* QGg = c.w<bf16>(GC_QG); const bf16* AQKg = c.w<bf16>(GC_AQK); const bf16* SNg = c.w<bf16>(GC_SN); const bf16* VNg = c.w<bf16>(GC_VN);
    const float* gn = c.in<float>(17);
    const int tid = c.tid, lane = c.lane, w = c.wave;
    const float gn0 = gn[lane], gn1 = gn[64 + lane];
    u32x4 pq[2], ps[4], pa, pv[2]; bf16 zz0n[8], zz1n[8];
#define GO_LOAD(u_) do { const int u__ = (u_); const int bh_ = u__ / NCH, n_ = u__ % NCH; const size_t m0_ = (size_t)(bh_ >> 2) * SEQ + (size_t)n_ * 64; \
        _Pragma("unroll") for (int j = 0; j < 2; ++j) { pq[j] = *(const u32x4*)(QGg + (size_t)u__ * 8192 + 8 * (tid + 512 * j)); pv[j] = *(const u32x4*)(VNg + (size_t)u__ * 8192 + 8 * (tid + 512 * j)); } \
        _Pragma("unroll") for (int j = 0; j < 4; ++j) ps[j] = *(const u32x4*)(SNg + (size_t)u__ * 16384 + 8 * (tid + 512 * j)); \
        pa = *(const u32x4*)(AQKg + (size_t)u__ * 4096 + 8 * tid); \
        _Pragma("unroll") for (int i8 = 0; i8 < 8; ++i8) { const size_t m = m0_ + w * 8 + i8; zz0n[i8] = P1[m * LD1 + C_Z + (bh_ & 3) * 128 + lane]; zz1n[i8] = P1[m * LD1 + C_Z + (bh_ & 3) * 128 + 64 + lane]; } } while (0)
    if ((int)blockIdx.x < NUG) GO_LOAD(blockIdx.x);
    for (int u = blockIdx.x; u < NUG; u += gridDim.x) {
        const int bh = u / NCH, n = u % NCH, b = bh >> 2, h = bh & 3; const size_t m0 = (size_t)b * SEQ + (size_t)n * 64;
        float zz0[8], zz1[8];
#pragma unroll
        for (int i8 = 0; i8 < 8; ++i8) { zz0[i8] = bf2f(zz0n[i8]); zz1[i8] = bf2f(zz1n[i8]); }
        LDS_BARRIER();
#pragma unroll
        for (int j = 0; j < 2; ++j) { const int idx = tid + 512 * j; *(u32x4*)(qg + (idx >> 4) * 136 + (idx & 15) * 8) = pq[j]; *(u32x4*)(vnT + (idx >> 3) * 72 + (idx & 7) * 8) = pv[j]; }
#pragma unroll
        for (int j = 0; j < 4; ++j) { const int idx = tid + 512 * j; *(u32x4*)(StT + (idx >> 4) * 136 + (idx & 15) * 8) = ps[j]; }
        *(u32x4*)(aqk + (tid >> 3) * 72 + (tid & 7) * 8) = pa;
        if (u + (int)gridDim.x < NUG) GO_LOAD(u + (int)gridDim.x);
        LDS_BARRIER();
        { const int it = w & 3; bf16x8 qa[4], aa[2];
#pragma unroll
          for (int ks = 0; ks < 4; ++ks) qa[ks] = ld8(qg + (16 * it + (lane & 15)) * 136 + ks * 32 + 8 * (lane >> 4));
#pragma unroll
          for (int ks = 0; ks < 2; ++ks) aa[ks] = ld8(aqk + (16 * it + (lane & 15)) * 72 + ks * 32 + 8 * (lane >> 4));
#pragma unroll
          for (int e4 = 0; e4 < 4; ++e4) { const int et = (w >> 2) * 4 + e4; f32x4 acc = (f32x4){0.f, 0.f, 0.f, 0.f};
#pragma unroll
            for (int ks = 0; ks < 4; ++ks) acc = mfma16(qa[ks], ld8(StT + (16 * et + (lane & 15)) * 136 + ks * 32 + 8 * (lane >> 4)), acc);
#pragma unroll
            for (int ks = 0; ks < 2; ++ks) acc = mfma16(aa[ks], ld8(vnT + (16 * et + (lane & 15)) * 72 + ks * 32 + 8 * (lane >> 4)), acc);
#pragma unroll
            for (int r = 0; r < 4; ++r) ob[(16 * it + (lane >> 4) * 4 + r) * 132 + 16 * et + (lane & 15)] = acc[r]; } }
        LDS_BARRIER();
        { float ss[8], v0[8], v1[8];
#pragma unroll
          for (int i8 = 0; i8 < 8; ++i8) { const int i = w * 8 + i8; v0[i8] = ob[i * 132 + lane]; v1[i8] = ob[i * 132 + 64 + lane]; ss[i8] = v0[i8] * v0[i8] + v1[i8] * v1[i8]; }
#pragma unroll
          for (int i8 = 0; i8 < 8; ++i8) ss[i8] = wave_sum(ss[i8]);
#pragma unroll
          for (int i8 = 0; i8 < 8; ++i8) { const size_t m = m0 + w * 8 + i8; const float r = rsqrtf(ss[i8] * (1.f / 128.f) + EPS);
            OCAT[m * D + h * 128 + lane] = (bf16)f2bf(v0[i8] * r * gn0 * siluf_(zz0[i8])); OCAT[m * D + h * 128 + 64 + lane] = (bf16)f2bf(v1[i8] * r * gn1 * siluf_(zz1[i8])); } }
    }
#undef GO_LOAD
}

template <int NT> DEV void softmax_rows(f32x4 (&s)[NT], float (&mrun)[4], float (&lrun)[4], float (&alpha)[4], bf16* Ps, int pitch, int lane) {
#pragma unroll
    for (int r = 0; r < 4; ++r) {
        float mx = s[0][r];
#pragma unroll
        for (int nt = 1; nt < NT; ++nt) mx = fmaxf(mx, s[nt][r]);
        mx = grp16_max(mx);
        const float mn = fmaxf(mrun[r], mx);
        alpha[r] = __expf(mrun[r] - mn); mrun[r] = mn;
        float sum = 0.f;
#pragma unroll
        for (int nt = 0; nt < NT; ++nt) { const float p = __expf(s[nt][r] - mn); s[nt][r] = p; sum += p; }
        sum = grp16_sum(sum); lrun[r] = lrun[r] * alpha[r] + sum;
    }
#pragma unroll
    for (int nt = 0; nt < NT; ++nt)
#pragma unroll
        for (int r = 0; r < 4; ++r) Ps[((lane >> 4) * 4 + r) * pitch + nt * 16 + (lane & 15)] = (bf16)f2bf(s[nt][r]);
}
DEV bf16x8 ldB_tr(const bf16* T, int pitch, int k0, int n0, int lane) {
    const bf16* p = T + (size_t)(k0 + 8 * (lane >> 4) + ((lane & 15) >> 2)) * pitch + n0 + 4 * (lane & 3);
    const s16x4 a = lds_tr(p), b = lds_tr(p + 4 * pitch);
    bf16x8 r; r[0] = a[0]; r[1] = a[1]; r[2] = a[2]; r[3] = a[3]; r[4] = b[0]; r[5] = b[1]; r[6] = b[2]; r[7] = b[3]; return r;
}
constexpr int AS_NSP = 2;
DEV void phase_attn_sample2(const Ctx& c) {
    bf16* Qs = (bf16*)c.lds;
    bf16* Kt0 = Qs + 64 * 296;
    bf16* Psb = Kt0 + 2 * 32 * 296;
    bf16* qtmp = Kt0;
    float* Xo = (float*)c.lds;
    float* Xm = Xo + 64 * 256; float* Xl = Xm + 64;
    const float* QH = c.w<float>(WS_QH); const float* rope = c.w<float>(WS_ROPE); const bf16* WUKB = c.w<bf16>(WS_WUKB);
    float* PO = c.w<float>(WS_PO); float* PM = c.w<float>(WS_PM); float* PL = c.w<float>(WS_PL);
    const float* clat = c.in<float>(4); const float* ckr = c.in<float>(5); const int* ptab = c.in<int>(7);
    const int tid = c.tid, lane = c.lane, w = c.wave, grp = w >> 2, wq = w & 3, gt = tid & 255;
    bf16* Kt = Kt0 + grp * 32 * 296; bf16* Ps = Psb + w * 16 * 40;
    constexpr int NPT32 = PAST / 32, TPS = NPT32 / AS_NSP;
    static_assert(NPT32 % (2 * AS_NSP) == 0, "tiles per split must be even");
    for (int u = blockIdx.x; u < DECB * AS_NSP; u += gridDim.x) {
        const int b = u / AS_NSP, sp = u % AS_NSP; const size_t mb = (size_t)MP + (size_t)b * DECS;
        __syncthreads();
        for (int idx = tid; idx < 64 * 8; idx += 512) { const int r = idx >> 3, ch = idx & 7, t = r >> 3, h = r & 7; const float* q = QH + (mb + t) * 768 + h * 96 + ch * 8;
            const f32x4 a = *(const f32x4*)q, bq = *(const f32x4*)(q + 4); u32x4 o; o.x = pk2(a[0], a[1]); o.y = pk2(a[2], a[3]); o.z = pk2(bq[0], bq[1]); o.w = pk2(bq[2], bq[3]); *(u32x4*)(qtmp + r * 72 + ch * 8) = o; }
        for (int idx = tid; idx < 64 * 16; idx += 512) { const int r = idx >> 4, f = idx & 15, t = r >> 3, h = r & 7; const float* qrow = QH + (mb + t) * 768 + h * 96 + 64;
            const float* rt = rope + (size_t)(SEQ + t) * 32; const float cs = rt[f], sn = rt[16 + f], x1 = qrow[f], x2 = qrow[16 + f];
            Qs[r * 296 + 256 + f] = (bf16)f2bf((x1 * cs - x2 * sn) * MLA_SCALE); Qs[r * 296 + 272 + f] = (bf16)f2bf((x2 * cs + x1 * sn) * MLA_SCALE); }
        __syncthreads();
        {
            const int h = w; bf16x8 af[2];
#pragma unroll
            for (int ks = 0; ks < 2; ++ks) af[ks] = ld8(qtmp + (((lane & 7)) * 8 + h) * 72 + ks * 32 + 8 * (lane >> 4));
#pragma unroll 4
            for (int nt = 0; nt < 16; ++nt) { f32x4 acc = (f32x4){0.f, 0.f, 0.f, 0.f};
#pragma unroll
                for (int ks = 0; ks < 2; ++ks) acc = mfma16(af[ks], ld8(WUKB + (size_t)(nt * 16 + (lane & 15)) * 512 + h * 64 + ks * 32 + 8 * (lane >> 4)), acc);
                if ((lane >> 4) < 2) {
#pragma unroll
                    for (int r = 0; r < 4; ++r) Qs[(((lane >> 4) * 4 + r) * 8 + h) * 296 + nt * 16 + (lane & 15)] = (bf16)f2bf(acc[r] * MLA_SCALE); } }
        }
        __syncthreads();
        float mrun[4], lrun[4], alpha[4]; f32x4 o[16];
#pragma unroll
        for (int r = 0; r < 4; ++r) { mrun[r] = -INFINITY; lrun[r] = 0.f; }
#pragma unroll
        for (int nt = 0; nt < 16; ++nt) o[nt] = (f32x4){0.f, 0.f, 0.f, 0.f};
        const int t_begin = sp * TPS, t_end = t_begin + TPS + (sp == AS_NSP - 1 ? 1 : 0);
        const int NI = (t_end - t_begin + 1) / 2;
        f32x4 plA[8], prA, plB[8], prB;
        const float* nl = c.out + O_LATS + (size_t)b * DECS * 256; const float* nk = c.out + O_KPES + (size_t)b * DECS * 32;
#define AS_LOAD(pl, pr, tile_) do { const int tl_ = (tile_); \
            if (tl_ < NPT32) { const int k0_ = tl_ * 32; const size_t rb_ = (size_t)ptab[b * NPAGES + (k0_ >> 7)] * PAGE + (k0_ & 127); \
                _Pragma("unroll") for (int j = 0; j < 8; ++j) { const int idx = gt + 256 * j; pl[j] = *(const f32x4*)(clat + (rb_ + (idx >> 6)) * 256 + 4 * (idx & 63)); } \
                pr = *(const f32x4*)(ckr + (rb_ + (gt >> 3)) * 32 + 4 * (gt & 7)); } \
            else if (tl_ == NPT32) { \
                _Pragma("unroll") for (int j = 0; j < 8; ++j) { const int idx = gt + 256 * j, key = idx >> 6; pl[j] = key < DECS ? *(const f32x4*)(nl + key * 256 + 4 * (idx & 63)) : (f32x4){0.f, 0.f, 0.f, 0.f}; } \
                pr = (gt >> 3) < DECS ? *(const f32x4*)(nk + (gt >> 3) * 32 + 4 * (gt & 7)) : (f32x4){0.f, 0.f, 0.f, 0.f}; } } while (0)
#define AS_ITER(pl, pr, it_) do { \
            const int tile = t_begin + 2 * (it_) + grp; const bool valid = tile < t_end; \
            if (valid) { \
                _Pragma("unroll") for (int j = 0; j < 8; ++j) { const int idx = gt + 256 * j; u32x2 pk; pk.x = pk2(pl[j][0], pl[j][1]); pk.y = pk2(pl[j][2], pl[j][3]); *(u32x2*)(Kt + (idx >> 6) * 296 + 4 * (idx & 63)) = pk; } \
                { u32x2 pk; pk.x = pk2(pr[0], pr[1]); pk.y = pk2(pr[2], pr[3]); *(u32x2*)(Kt + (gt >> 3) * 296 + 256 + 4 * (gt & 7)) = pk; } \
            } \
            { const int nt_ = tile + 4; AS_LOAD(pl, pr, nt_ < t_end ? nt_ : NPT32 + 1); } \
            LDS_BARRIER(); \
            if (valid) { \
                f32x4 s[2]; \
                _Pragma("unroll") for (int nt = 0; nt < 2; ++nt) { s[nt] = (f32x4){0.f, 0.f, 0.f, 0.f}; \
                    _Pragma("unroll") for (int ks = 0; ks < 9; ++ks) s[nt] = mfma16(ld8(Qs + (wq * 16 + (lane & 15)) * 296 + ks * 32 + 8 * (lane >> 4)), ld8(Kt + (nt * 16 + (lane & 15)) * 296 + ks * 32 + 8 * (lane >> 4)), s[nt]); } \
                if (tile == NPT32) { \
                    _Pragma("unroll") for (int nt = 0; nt < 2; ++nt) \
                        _Pragma("unroll") for (int r = 0; r < 4; ++r) { const int row = wq * 16 + (lane >> 4) * 4 + r, key = nt * 16 + (lane & 15); if (key >= DECS || key > (row >> 3)) s[nt][r] = -INFINITY; } \
                } \
                softmax_rows<2>(s, mrun, lrun, alpha, Ps, 40, lane); \
                WAVE_SYNC(); \
                const bf16x8 pf = ld8(Ps + (lane & 15) * 40 + 8 * (lane >> 4)); \
                _Pragma("unroll") for (int nt = 0; nt < 16; ++nt) { \
                    _Pragma("unroll") for (int r = 0; r < 4; ++r) o[nt][r] *= alpha[r]; \
                    o[nt] = mfma16(pf, ldB_tr(Kt, 296, 0, nt * 16, lane), o[nt]); } \
            } \
            LDS_BARRIER(); } while (0)
        AS_LOAD(plA, prA, t_begin + grp < t_end ? t_begin + grp : NPT32 + 1);
        AS_LOAD(plB, prB, t_begin + 2 + grp < t_end ? t_begin + 2 + grp : NPT32 + 1);
#pragma unroll 1
        for (int it = 0; it < NI; it += 2) {
            AS_ITER(plA, prA, it);
            if (it + 1 < NI) AS_ITER(plB, prB, it + 1);
        }
#undef AS_ITER
#undef AS_LOAD
        int lane2 = lane; OPAQUE_V(lane2);
        if (grp == 1) {
#pragma unroll
            for (int nt = 0; nt < 16; ++nt)
#pragma unroll
                for (int r = 0; r < 4; ++r) Xo[(wq * 16 + (lane2 >> 4) * 4 + r) * 256 + nt * 16 + (lane2 & 15)] = o[nt][r];
            if ((lane2 & 15) == 0) {
#pragma unroll
                for (int r = 0; r < 4; ++r) { Xm[wq * 16 + (lane2 >> 4) * 4 + r] = mrun[r]; Xl[wq * 16 + (lane2 >> 4) * 4 + r] = lrun[r]; } }
        }
        __syncthreads();
        if (grp == 0) {
            float a1[4], a2[4];
#pragma unroll
            for (int r = 0; r < 4; ++r) { const int row = wq * 16 + (lane2 >> 4) * 4 + r; const float m2 = Xm[row], l2 = Xl[row]; const float mm = fmaxf(mrun[r], m2);
                a1[r] = __expf(mrun[r] - mm); a2[r] = __expf(m2 - mm); lrun[r] = lrun[r] * a1[r] + l2 * a2[r]; mrun[r] = mm;
                if ((lane2 & 15) == 0) { PM[(size_t)u * 64 + row] = mm; PL[(size_t)u * 64 + row] = lrun[r]; } }
#pragma unroll
            for (int nt = 0; nt < 16; ++nt)
#pragma unroll
                for (int r = 0; r < 4; ++r) { const int row = wq * 16 + (lane2 >> 4) * 4 + r, col = nt * 16 + (lane2 & 15); PO[((size_t)u * 64 + row) * 256 + col] = o[nt][r] * a1[r] + Xo[row * 256 + col] * a2[r]; }
        }
    }
}
DEV void phase_attn_sample_combine(const Ctx& c) {
    bf16* Ol = (bf16*)c.lds;
    const float* PO = c.w<float>(WS_PO); const float* PM = c.w<float>(WS_PM); const float* PL = c.w<float>(WS_PL);
    const bf16* WUV = c.w<bf16>(WS_WUKV) + (size_t)512 * 256; bf16* OCAT = c.w<bf16>(WS_OCAT);
    const int tid = c.tid, lane = c.lane, w = c.wave;
    for (int b = (int)gridDim.x - 1 - (int)blockIdx.x; b < DECB; b += gridDim.x) {
        const size_t mb = (size_t)MP + (size_t)b * DECS;
        __syncthreads();
        for (int idx = tid; idx < 64 * 64; idx += 512) { const int row = idx >> 6, c4 = idx & 63;
            float mm = -INFINITY;
#pragma unroll
            for (int s = 0; s < AS_NSP; ++s) mm = fmaxf(mm, PM[((size_t)b * AS_NSP + s) * 64 + row]);
            float lt = 0.f; f32x4 acc = (f32x4){0.f, 0.f, 0.f, 0.f};
#pragma unroll
            for (int s = 0; s < AS_NSP; ++s) { const size_t ur = ((size_t)b * AS_NSP + s) * 64 + row; const float a = __expf(PM[ur] - mm); lt += PL[ur] * a; acc += *(const f32x4*)(PO + ur * 256 + 4 * c4) * a; }
            const float inv = 1.f / lt; u32x2 o; o.x = pk2(acc[0] * inv, acc[1] * inv); o.y = pk2(acc[2] * inv, acc[3] * inv); *(u32x2*)(Ol + row * 264 + 4 * c4) = o; }
        __syncthreads();
        { const int h = w;
#pragma unroll
          for (int nt = 0; nt < 4; ++nt) { f32x4 acc = (f32x4){0.f, 0.f, 0.f, 0.f};
#pragma unroll
            for (int ks = 0; ks < 8; ++ks) acc = mfma16(ld8(Ol + ((lane & 7) * 8 + h) * 264 + ks * 32 + 8 * (lane >> 4)), ld8(WUV + (size_t)(h * 64 + nt * 16 + (lane & 15)) * 256 + ks * 32 + 8 * (lane >> 4)), acc);
            if ((lane >> 4) < 2) {
#pragma unroll
                for (int r = 0; r < 4; ++r) OCAT[(mb + (lane >> 4) * 4 + r) * D + 512 + h * 64 + nt * 16 + (lane & 15)] = (bf16)f2bf(acc[r]); } } }
    }
}

DEV bf16x8 cvt8(const f32x4 a, const f32x4 b, float sc) { bf16x8 r; const u32x4 p = {pk2(a[0] * sc, a[1] * sc), pk2(a[2] * sc, a[3] * sc), pk2(b[0] * sc, b[1] * sc), pk2(b[2] * sc, b[3] * sc)};
    r = __builtin_bit_cast(bf16x8, p); return r; }
DEV void phase_attn_prompt2(const Ctx& c) {
    bf16* KV0 = (bf16*)c.lds;
    constexpr int KVB = 64 * 104 + 64 * 72;
    bf16* Psb = KV0 + 2 * KVB;
    const float* QH = c.w<float>(WS_QH); const bf16* KVP = c.w<bf16>(WS_KVP); const bf16* KPEB = c.w<bf16>(WS_KPEB); const float* rope = c.w<float>(WS_ROPE); bf16* OCAT = c.w<bf16>(WS_OCAT);
    const int tid = c.tid, lane = c.lane, w = c.wave;
    bf16* Ps = Psb + w * 32 * 72;
    constexpr int NQB = SEQ / 256, NPU = NQB * BATCH * 8;
    for (;;) {
        const int pu = queue_next(c, 0);
        if (pu >= NPU) break;
        const int qb = NQB - 1 - pu / (BATCH * 8), bh = pu % (BATCH * 8), b = bh >> 3, h = bh & 7; const size_t mb = (size_t)b * SEQ;
        {
            const int q0 = qb * 256, rmin = q0 + 32 * w;
            bf16x8 qf[2][3];
#pragma unroll
            for (int mt = 0; mt < 2; ++mt) { const int qr = rmin + 16 * mt + (lane & 15); const float* qrow = QH + (mb + qr) * 768 + h * 96; const int g = lane >> 4;
#pragma unroll
                for (int ks = 0; ks < 2; ++ks) qf[mt][ks] = cvt8(*(const f32x4*)(qrow + ks * 32 + 8 * g), *(const f32x4*)(qrow + ks * 32 + 8 * g + 4), MLA_SCALE);
                const int f0 = 8 * (g & 1); const float* rt = rope + (size_t)qr * 32;
                const f32x4 x1a = *(const f32x4*)(qrow + 64 + f0), x1b = *(const f32x4*)(qrow + 64 + f0 + 4), x2a = *(const f32x4*)(qrow + 80 + f0), x2b = *(const f32x4*)(qrow + 80 + f0 + 4);
                const f32x4 ca = *(const f32x4*)(rt + f0), cb = *(const f32x4*)(rt + f0 + 4), sa = *(const f32x4*)(rt + 16 + f0), sb = *(const f32x4*)(rt + 16 + f0 + 4);
                const f32x4 ya = g < 2 ? x1a * ca - x2a * sa : x2a * ca + x1a * sa, yb = g < 2 ? x1b * cb - x2b * sb : x2b * cb + x1b * sb;
                qf[mt][2] = cvt8(ya, yb, MLA_SCALE); }
            float mrun[2][4], lrun[2][4], alpha[2][4]; f32x4 o[2][4];
#pragma unroll
            for (int mt = 0; mt < 2; ++mt) {
#pragma unroll
                for (int r = 0; r < 4; ++r) { mrun[mt][r] = -INFINITY; lrun[mt][r] = 0.f; }
#pragma unroll
                for (int nt = 0; nt < 4; ++nt) o[mt][nt] = (f32x4){0.f, 0.f, 0.f, 0.f}; }
            const int nkt = 4 * qb + 4;
            u32x4 pk_, pp_, pv_;
#define AP_LOAD(kt_) do { const size_t kr_ = mb + (size_t)(kt_) * 64; \
                pk_ = *(const u32x4*)(KVP + (kr_ + (tid >> 3)) * 1024 + h * 64 + (tid & 7) * 8); \
                pv_ = *(const u32x4*)(KVP + (kr_ + (tid >> 3)) * 1024 + 512 + h * 64 + (tid & 7) * 8); \
                if (tid < 256) pp_ = *(const u32x4*)(KPEB + (kr_ + (tid >> 2)) * 32 + (tid & 3) * 8); } while (0)
#define AP_STORE(buf_) do { bf16* Kb_ = KV0 + (buf_) * KVB; bf16* Vb_ = Kb_ + 64 * 104; \
                *(u32x4*)(Kb_ + (tid >> 3) * 104 + (tid & 7) * 8) = pk_; *(u32x4*)(Vb_ + (tid >> 3) * 72 + (tid & 7) * 8) = pv_; \
                if (tid < 256) *(u32x4*)(Kb_ + (tid >> 2) * 104 + 64 + (tid & 3) * 8) = pp_; } while (0)
            __syncthreads();
            AP_LOAD(0); AP_STORE(0);
            if (nkt > 1) AP_LOAD(1);
            __syncthreads();
            for (int kt = 0; kt < nkt; ++kt) {
                const bf16* Ks = KV0 + (kt & 1) * KVB; const bf16* Vs = Ks + 64 * 104;
                if (kt + 1 < nkt) AP_STORE((kt + 1) & 1);
                if (kt + 2 < nkt) AP_LOAD(kt + 2);
                const int k0 = kt * 64;
                if (k0 <= rmin + 31) {
                    f32x4 s[2][4];
#pragma unroll
                    for (int nt = 0; nt < 4; ++nt) { s[0][nt] = (f32x4){0.f, 0.f, 0.f, 0.f}; s[1][nt] = (f32x4){0.f, 0.f, 0.f, 0.f};
#pragma unroll
                        for (int ks = 0; ks < 3; ++ks) { const bf16x8 kf = ld8(Ks + (nt * 16 + (lane & 15)) * 104 + ks * 32 + 8 * (lane >> 4));
                            s[0][nt] = mfma16(qf[0][ks], kf, s[0][nt]); s[1][nt] = mfma16(qf[1][ks], kf, s[1][nt]); } }
                    if (k0 + 63 > rmin) {
#pragma unroll
                        for (int mt = 0; mt < 2; ++mt)
#pragma unroll
                            for (int nt = 0; nt < 4; ++nt)
#pragma unroll
                                for (int r = 0; r < 4; ++r) { const int qpos = rmin + 16 * mt + (lane >> 4) * 4 + r, kpos = k0 + nt * 16 + (lane & 15); if (kpos > qpos) s[mt][nt][r] = -INFINITY; }
                    }
                    softmax_rows<4>(s[0], mrun[0], lrun[0], alpha[0], Ps, 72, lane);
                    softmax_rows<4>(s[1], mrun[1], lrun[1], alpha[1], Ps + 16 * 72, 72, lane);
                    WAVE_SYNC();
#pragma unroll
                    for (int mt = 0; mt < 2; ++mt)
#pragma unroll
                        for (int nt = 0; nt < 4; ++nt)
#pragma unroll
                            for (int r = 0; r < 4; ++r) o[mt][nt][r] *= alpha[mt][r];
#pragma unroll
                    for (int k2 = 0; k2 < 2; ++k2) { const bf16x8 p0 = ld8(Ps + (lane & 15) * 72 + k2 * 32 + 8 * (lane >> 4)), p1 = ld8(Ps + (16 + (lane & 15)) * 72 + k2 * 32 + 8 * (lane >> 4));
#pragma unroll
                        for (int nt = 0; nt < 4; ++nt) { const bf16x8 vf = ldB_tr(Vs, 72, k2 * 32, nt * 16, lane); o[0][nt] = mfma16(p0, vf, o[0][nt]); o[1][nt] = mfma16(p1, vf, o[1][nt]); } }
                    WAVE_SYNC();
                }
                LDS_BARRIER();
            }
#undef AP_LOAD
#undef AP_STORE
#pragma unroll
            for (int mt = 0; mt < 2; ++mt)
#pragma unroll
                for (int nt = 0; nt < 4; ++nt)
#pragma unroll
                    for (int r = 0; r < 4; ++r) OCAT[(mb + rmin + 16 * mt + (lane >> 4) * 4 + r) * D + 512 + h * 64 + nt * 16 + (lane & 15)] = (bf16)f2bf(o[mt][nt][r] / lrun[mt][r]);
        }
    }
}

#ifndef HIPEMU
#define XB_TMO      128
#define XB_XCNT(j)  (256  + 64 * (j))
#define XB_XSUB(j)  (1280 + 64 * (j))
#define XB_XGEN(j)  (2304 + 64 * (j))
#define XB_TOP      3328
#define XB_TOPGEN   3392
#define XCD_BAR_WORDS 3456
#define XB_SPIN_CAP (1u << 22)
#define LAS __attribute__((address_space(3)))
__device__ __forceinline__ unsigned xb_ld(unsigned* p)              { return __hip_atomic_load(p, __ATOMIC_RELAXED, __HIP_MEMORY_SCOPE_AGENT); }
__device__ __forceinline__ unsigned xb_add(unsigned* p, unsigned v) { return __hip_atomic_fetch_add(p, v, __ATOMIC_RELAXED, __HIP_MEMORY_SCOPE_AGENT); }
__device__ __forceinline__ unsigned xb_xcc_id() { return (unsigned)__builtin_amdgcn_s_getreg((3 << 11) | 20) & 0xFu; }
#define XB_SPIN(cond, bar) do { unsigned _sp = 0; while (cond) { __builtin_amdgcn_s_sleep(1); \
    if ((++_sp & 255u) == 0u) { if (xb_ld(&(bar)[XB_TMO])) break; if (_sp > XB_SPIN_CAP) { atomicAdd(&(bar)[XB_TMO], 1u); break; } } } } while (0)
struct XcdBarrier { unsigned* bar; unsigned x; volatile LAS unsigned* st; bool t0; };
__device__ __forceinline__ XcdBarrier xcd_barrier_post(unsigned* bar, volatile LAS unsigned* st, bool t0) {
    XcdBarrier b; b.bar = bar; b.x = xb_xcc_id(); b.st = st; b.t0 = t0;
    if (t0) (void)xb_add(&bar[XB_XCNT(b.x)], 1u);
    return b;
}
__device__ __forceinline__ void xcd_barrier_complete(unsigned* bar, unsigned x, unsigned& nloc, unsigned& nx) {
    const unsigned G = gridDim.x * gridDim.y * gridDim.z;
    unsigned sum, cnt, mine, sp = 0u;
    for (;;) {
        sum = 0u; cnt = 0u; mine = 0u;
#pragma unroll
        for (unsigned j = 0; j < 16; ++j) { const unsigned c = xb_ld(&bar[XB_XCNT(j)]); sum += c; cnt += (c > 0u) ? 1u : 0u; mine = (j == x) ? c : mine; }
        if (sum == G) break;
        __builtin_amdgcn_s_sleep(1);
        if ((++sp & 255u) == 0u) { if (xb_ld(&bar[XB_TMO])) break; if (sp > XB_SPIN_CAP) { atomicAdd(&bar[XB_TMO], 1u); break; } }
    }
    nloc = mine > 0u ? mine : 1u; nx = cnt > 0u ? cnt : 1u;
}
__device__ __forceinline__ void xcd_barrier(const XcdBarrier& b) {
    asm volatile("s_waitcnt vmcnt(0)" ::: "memory");
    __syncthreads();
    if (b.t0) {
        unsigned* bar = b.bar;
        __builtin_amdgcn_s_waitcnt(0);
        unsigned nloc = b.st[0], nx = b.st[1];
        if (nloc == 0u) { xcd_barrier_complete(bar, b.x, nloc, nx); b.st[0] = nloc; b.st[1] = nx; }
        const unsigned old = xb_add(&bar[XB_XSUB(b.x)], 1u);
        const unsigned gen = old / nloc;
        if (old + 1u == (gen + 1u) * nloc) {
            __builtin_amdgcn_fence(__ATOMIC_RELEASE, "agent");
            asm volatile("s_waitcnt vmcnt(0)" ::: "memory");
            const unsigned og = xb_add(&bar[XB_TOP], 1u);
            const unsigned tg = og / nx;
            if (og + 1u == (tg + 1u) * nx) xb_add(&bar[XB_TOPGEN], 1u);
            else XB_SPIN(xb_ld(&bar[XB_TOPGEN]) == tg, bar);
            __builtin_amdgcn_fence(__ATOMIC_ACQUIRE, "agent");
            xb_add(&bar[XB_XGEN(b.x)], 1u);
            asm volatile("s_waitcnt vmcnt(0)" ::: "memory");
        } else {
            XB_SPIN(xb_ld(&bar[XB_XGEN(b.x)]) == gen, bar);
            __builtin_amdgcn_fence(__ATOMIC_ACQUIRE, "agent");
            asm volatile("s_waitcnt vmcnt(0)" ::: "memory");
        }
    }
    __syncthreads();
}
#endif

__global__ void __launch_bounds__(512, 2) mega_kernel(Params p) {
#ifdef HIPEMU
    unsigned char* lds = g_blk->smem;
#else
    extern __shared__ __attribute__((aligned(16))) unsigned char lds[];
#endif
    const int lo = p.ph_lo, hi = p.ph_hi;
#ifdef HIPEMU
    const int wave_s = threadIdx.x >> 6;
#define FRESH_LANE() ((int)(threadIdx.x & 63))
#define GRID_BAR(k) do { } while (0)
#else
    const int wave_s = __builtin_amdgcn_readfirstlane(threadIdx.x >> 6);
#define FRESH_LANE() ({ int l_; asm volatile("v_mbcnt_lo_u32_b32 %0, -1, 0\n\tv_mbcnt_hi_u32_b32 %0, -1, %0" : "=v"(l_)); l_; })
    { const int l0 = FRESH_LANE(); if (wave_s == 0) ((volatile LAS unsigned*)(lds + LDS_MISC))[l0] = 0u; }
    __syncthreads();
    if (hi - lo > 1) (void)xcd_barrier_post((unsigned*)(p.ws + WS_CTL), (volatile LAS unsigned*)(lds + LDS_MISC), wave_s == 0 && FRESH_LANE() == 0);
#define GRID_BAR(k) do { if (lo <= (k) && (k) + 1 < hi) { XcdBarrier bb_; bb_.bar = (unsigned*)(p.ws + WS_CTL); bb_.x = xb_xcc_id(); bb_.st = (volatile LAS unsigned*)(lds + LDS_MISC); bb_.t0 = (wave_s == 0 && FRESH_LANE() == 0); xcd_barrier(bb_); } } while (0)
#endif
#define MKCTX() Ctx c; c.p = &p; c.lds = lds; c.ws = p.ws; c.out = p.out; c.wave = wave_s; c.lane = FRESH_LANE(); c.tid = wave_s * 64 + c.lane; c.gw = blockIdx.x * 8 + wave_s; c.ngw = gridDim.x * 8;
#define IN(k) (lo <= (k) && (k) < hi)
#ifndef PROBE_MASK
#define PROBE_MASK 0u
#endif
#define NREP(k) (((PROBE_MASK >> (k)) & 1u) ? 2 : 1)
#ifndef PROBE_SUB
#define PROBE_SUB 0
#endif
#define SUB(id, ...) { MKCTX() __VA_ARGS__ } if (PROBE_SUB == (id)) { __syncthreads(); MKCTX() __VA_ARGS__ }
#define PHASE(k, ...) if (IN(k)) { { MKCTX() __VA_ARGS__ } if (NREP(k) == 2) { MKCTX() __VA_ARGS__ } }
#define X1 c.w<float>(WS_X1)
#define X2 c.w<float>(WS_X2)
#define P1 c.w<float>(WS_P1)
#define XN c.w<bf16>(WS_XN)
#define Hb c.w<bf16>(WS_H)
#define OCAT c.w<bf16>(WS_OCAT)

    PHASE(0,  phase_prologue(c); GRID_BAR(0); )
    PHASE(1,  run_gemm(c, XN, c.w<bf16>(WS_WINAB), M, LD1, D, EpiBf16<0>{c.w<bf16>(WS_P1), LD1}); GRID_BAR(1); )
    PHASE(2,  phase_prep0(c); GRID_BAR(2); )
    PHASE(3,          { run_gemm(c, c.w<bf16>(WS_CQN), c.w<bf16>(WS_WUQ), M, 768, 256, EpiStoreF32{c.w<float>(WS_QH), 768}); } { MKCTX() run_gemm(c, c.w<bf16>(WS_LATN), c.w<bf16>(WS_WUKV), MP, 1024, 256, EpiBf16<0>{c.w<bf16>(WS_KVP), 1024}); }         GRID_BAR(3); )
    PHASE(4,  { if ((blockIdx.x & 1) == 0) { MKCTX() phase_attn_sample2(c); } } __syncthreads(); { MKCTX() phase_gdn_prep(c); } __syncthreads(); { MKCTX() phase_gdn_naive(c, BATCH * 4); } __syncthreads();
               { if ((blockIdx.x & 1) != 0) { MKCTX() phase_attn_sample2(c); } } GRID_BAR(4); )
    PHASE(5,  SUB(4, phase_gdn_scan2(c, blockIdx.x, gridDim.x);) __syncthreads(); SUB(5, phase_attn_sample_combine(c);) __syncthreads(); SUB(6, phase_attn_prompt2(c);) GRID_BAR(5); )
    PHASE(6,  phase_gdn_out(c); GRID_BAR(6); )
    PHASE(7,  { run_gemm(c, OCAT, c.w<bf16>(WS_WOAB), MP, D, D, EpiResidF32{nullptr, c.in<float>(0), c.in<float>(1), X1}); } { MKCTX() run_gemm_sample_splitk(c, OCAT, c.w<bf16>(WS_WOAB), D, 256); } GRID_BAR(7); )
    PHASE(8,  phase_rmsnorm(c, X1, c.in<float>(9), nullptr, 4); GRID_BAR(8); )
    PHASE(9,  run_gemm(c, XN, c.w<bf16>(WS_WUP0), M, FF, D, EpiBf16<1>{Hb, FF}); GRID_BAR(9); )
    PHASE(10,  { run_gemm(c, Hb, c.w<bf16>(WS_WDN0), MP, D, FF, EpiResidF32{X1, nullptr, nullptr, X2}); } { MKCTX() run_gemm_sample_splitk(c, Hb, c.w<bf16>(WS_WDN0), FF, 256); } GRID_BAR(10); )
    PHASE(11,  phase_rmsnorm(c, X2, c.in<float>(8) + D, X1, 16); GRID_BAR(11); )
    PHASE(12,  run_gemm(c, XN, c.w<bf16>(WS_WINC), M, INC, D, EpiBf16<0>{c.w<bf16>(WS_P1), INC}); GRID_BAR(12); )
    PHASE(13,  SUB(7, phase_hgrn_prep(c);) GRID_BAR(13); )
    PHASE(14,  phase_hgrn_prefix(c); __syncthreads(); SUB(8, phase_hgrn_naive(c, BATCH * 8, (int)blockIdx.x, (int)gridDim.x);) GRID_BAR(14); )
    PHASE(15,  phase_hgrn_out(c); GRID_BAR(15); )
    PHASE(16,  { run_gemm(c, OCAT, c.w<bf16>(WS_WOC), MP, D, D, EpiResidF32{X2, nullptr, nullptr, X1}); } { MKCTX() run_gemm_sample_splitk(c, OCAT, c.w<bf16>(WS_WOC), D, 256); } GRID_BAR(16); )
    PHASE(17,  phase_rmsnorm(c, X1, c.in<float>(9) + D, X2, 4); GRID_BAR(17); )
    PHASE(18,  run_gemm(c, XN, c.w<bf16>(WS_WUP1), M, FF, D, EpiBf16<1>{Hb, FF}); GRID_BAR(18); )
    PHASE(19,  { run_gemm(c, Hb, c.w<bf16>(WS_WDN1), MP, D, FF, EpiResidF32{X1, nullptr, nullptr, X2}); } { MKCTX() run_gemm_sample_splitk(c, Hb, c.w<bf16>(WS_WDN1), FF, 256); } GRID_BAR(19); )
    PHASE(20,  phase_final(c, X2, c.in<float>(10), X1, 16); )
#undef IN
#undef X1
#undef X2
#undef P1
#undef XN
#undef Hb
#undef OCAT
}

#ifndef HIPEMU
extern "C" void kernel_launch(void* const* d_in, const int* in_sizes, int n_in, void* d_out, int out_size, void* d_ws, size_t ws_size, hipStream_t stream) {
    static int grid = 0;
    if (grid == 0) {
        if (n_in != 28 || (size_t)out_size != O_END || ws_size < WS_END) { fprintf(stderr, "kernel_launch: shape mismatch n_in %d out %d (want %zu) ws %zu (want %zu)\n", n_in, out_size, (size_t)O_END, ws_size, (size_t)WS_END); grid = -1; return; }
        int dev = 0, cus = 0, per_cu = 0;
        hipGetDevice(&dev); hipDeviceGetAttribute(&cus, hipDeviceAttributeMultiprocessorCount, dev);
        if (hipFuncSetAttribute((const void*)mega_kernel, hipFuncAttributeMaxDynamicSharedMemorySize, LDS_BYTES) != hipSuccess) { fprintf(stderr, "kernel_launch: hipFuncSetAttribute failed\n"); grid = -1; return; }
        if (hipOccupancyMaxActiveBlocksPerMultiprocessor(&per_cu, (const void*)mega_kernel, 512, LDS_BYTES) != hipSuccess || per_cu < 1) fprintf(stderr, "kernel_launch: occupancy query reports %d\n", per_cu);
        (void)hipGetLastError();
        grid = cus;
    }
    if (grid < 0) return;
    hipMemsetAsync((char*)d_ws + WS_CTL, 0, CTL_BYTES, stream);
    Params p{};
    for (int i = 0; i < 28; ++i) p.in[i] = d_in[i];
    p.out = (float*)d_out; p.ws = (unsigned char*)d_ws;
#if MK_N_LAUNCHES == 1
    p.ph_lo = 0; p.ph_hi = NPHASE;
    hipLaunchKernelGGL(mega_kernel, dim3(grid), dim3(512), LDS_BYTES, stream, p);
#else
    for (int k = 0; k < NPHASE; ++k) { p.ph_lo = k; p.ph_hi = k + 1; hipLaunchKernelGGL(mega_kernel, dim3(grid), dim3(512), LDS_BYTES, stream, p); }
#endif
}
#else
size_t emu_ws_bytes() { return WS_END; }
size_t emu_out_floats() { return O_END; }
void emu_forward(void* const* d_in, float* d_out, unsigned char* d_ws, int grid, int ph_from, int ph_to) {
    memset(d_ws + WS_CTL, 0, CTL_BYTES);
    Params p{};
    for (int i = 0; i < 28; ++i) p.in[i] = d_in[i];
    p.out = d_out; p.ws = d_ws;
    for (int k = ph_from; k < ph_to && k < NPHASE; ++k) { p.ph_lo = k; p.ph_hi = k + 1; fprintf(stderr, "[emu] phase %d\n", k); emu_launch(grid, 512, LDS_BYTES, [=]() { mega_kernel(p); }); }
}
struct EmuBuf { const char* name; size_t off; size_t bytes; int kind;   int ld; };
extern const EmuBuf emu_bufs[] = {
    {"P1", WS_P1, (size_t)M * 4096 * 4, 0, LD1}, {"XN", WS_XN, (size_t)M * D * 2, 1, D}, {"QH", WS_QH, (size_t)M * 768 * 4, 0, 768}, {"KVP", WS_KVP, (size_t)MP * 1024 * 2, 1, 1024},
    {"OCAT", WS_OCAT, (size_t)M * D * 2, 1, D}, {"ORAW", WS_ORAW, (size_t)M * D * 4, 0, D}, {"X1", WS_X1, (size_t)M * D * 4, 0, D}, {"X2", WS_X2, (size_t)M * D * 4, 0, D},
    {"H", WS_H, (size_t)M * FF * 2, 1, FF}, {"CQN", WS_CQN, (size_t)M * 256 * 2, 1, 256}, {"LATN", WS_LATN, (size_t)M * 256 * 2, 1, 256}, {nullptr, 0, 0, 0, 0}};
extern const int emu_cfg[8] = {BATCH, SEQ, DECB, PAST, MP, MS, MT, M};
#endif
```

```cpp
#ifdef HIPEMU
#include "hipemu.h"
#else
#include <hip/hip_runtime.h>
#endif
#include <cstdio>
#include <cstdint>

#ifndef CFG_BATCH
#define CFG_BATCH 8
#define CFG_SEQ 2048
#define CFG_DEC_BATCH 128
#define CFG_PAST_LEN 8192
#endif
#ifndef MK_N_LAUNCHES
#define MK_N_LAUNCHES 1
#endif

#define DEV __device__ __forceinline__
namespace pg8 {
#define PG8_LAS __attribute__((address_space(3)))
typedef unsigned short bf16_t;
typedef short bf16x8 __attribute__((ext_vector_type(8)));
typedef float f32x4 __attribute__((ext_vector_type(4)));
typedef unsigned u32x4 __attribute__((ext_vector_type(4)));
constexpr int BM = 256, BK = 64, HALF = 128, HTB = HALF * BK * 2  , STAGE_BYTES = 8 * HTB, NXCD = 8, WGM = 8;

__host__ __device__ __forceinline__ int lds_byte(int r, int c) { const int st = (r >> 4) * 2 + (c >> 5), rr = r & 15, cc = c & 31, ob = rr * 64 + cc * 2; return st * 1024 + (ob ^ (((ob >> 9) & 1) << 5)); }
__host__ __device__ __forceinline__ void stage_rc(int b, int& R, int& C) { const int st = b / 1024, sb = b % 1024, swz = sb ^ (((sb >> 9) & 1) << 5); R = (st >> 1) * 16 + swz / 64; C = (st & 1) * 32 + (swz % 64) / 2; }
__host__ __device__ __forceinline__ int perm32(int rho) { const int n = rho >> 4, i = rho & 15; return 8 * (i >> 2) + 4 * n + (i & 3); }

struct Unit { int pm, pn, kb; };
struct Gemm { const bf16_t* A; const bf16_t* Bt; int M, N, K, ld; };

struct StaticOrder {
    int nM, nN, nwg, G, c;
    __host__ __device__ void init(int M, int N, int G_, int c_) { nM = M / BM; nN = N / BM; nwg = nM * nN; G = G_; c = c_; }
    __host__ __device__ bool next(int i, Unit& u) const {
        const long L = (long)i * G + c; if (L >= nwg) return false;
        int wgid = (int)L; { const int q = nwg / NXCD, r = nwg % NXCD, xcd = wgid % NXCD, off = wgid / NXCD; wgid = (xcd < r ? xcd * (q + 1) : r * (q + 1) + (xcd - r) * q) + off; }
        const int nig = WGM * nN, gid = wgid / nig, fm = gid * WGM, gsz = (nM - fm) < WGM ? (nM - fm) : WGM;
        u.pm = fm + ((wgid % nig) % gsz); u.pn = (wgid % nig) / gsz; u.kb = 0; return true;
    }
    __device__ __forceinline__ void a_ready(const Unit&) const {}
    __device__ __forceinline__ void done(const Unit&) const {}
};

#ifndef HIPEMU
template <class Epi, class Sched, bool ALIGN_EPI = false, bool SP2 = false>
__device__ __forceinline__ void gemm_phase(PG8_LAS unsigned char* lds, const Gemm g, const Sched& S, const Epi& E, const int wid_in, const int lane_in) {
    const int wid = __builtin_amdgcn_readfirstlane(wid_in), lane = lane_in, tid = wid * 64 + lane, wr = wid >> 2, wc = wid & 3, fr = lane & 15, fq = lane >> 4;
    const int K = g.K, nt = K / BK, LDK = g.ld;
    unsigned voffA[2], voffB[2];
#pragma unroll
    for (int i = 0; i < 2; ++i) { int R, C; stage_rc(tid * 16 + i * 8192, R, C); const int Rb = Epi::PERM ? ((R & ~31) + perm32(R & 31)) : R;
        voffA[i] = (unsigned)(R * LDK + C) * 2u; voffB[i] = (unsigned)(Rb * LDK + C) * 2u; }
    const size_t kstep = (size_t)(BK * 2);
    const size_t hstep = (size_t)HALF * LDK * 2;
    const size_t tstep = 2 * hstep;
    const unsigned ldsw = (unsigned)wid * 1024u;
    const int aoff = lds_byte(wr * 64 + fr, fq * 8), boff = lds_byte(wc * 32 + fr, fq * 8);
#define PG8_SA(b, h) (((b) * 2 + (h)) * HTB)
#define PG8_SB(b, h) ((4 + (b) * 2 + (h)) * HTB)
#define PG8_STAGE(bufoff, gbase, voff) do { _Pragma("unroll") for (int _i = 0; _i < 2; ++_i) \
        __builtin_amdgcn_global_load_lds((const unsigned*)((const char*)(gbase) + (voff)[_i]), (PG8_LAS unsigned*)(lds + (bufoff) + ldsw + _i * 8192), 16, 0, 0); } while (0)
#define PG8_LDA(dst, b, h) do { _Pragma("unroll") for (int m = 0; m < 4; ++m) _Pragma("unroll") for (int k = 0; k < 2; ++k) dst[m][k] = *(const PG8_LAS bf16x8*)(lds + PG8_SA(b, h) + aoff + m * 2048 + k * 1024); } while (0)
#define PG8_LDB(dst, b, h) do { _Pragma("unroll") for (int n = 0; n < 2; ++n) _Pragma("unroll") for (int k = 0; k < 2; ++k) dst[n][k] = *(const PG8_LAS bf16x8*)(lds + PG8_SB(b, h) + boff + n * 2048 + k * 1024); } while (0)
#define PG8_MMA(ai, bj, At, Bt) do { __builtin_amdgcn_s_setprio(1); _Pragma("unroll") for (int m = 0; m < 4; ++m) _Pragma("unroll") for (int n = 0; n < 2; ++n) _Pragma("unroll") for (int k = 0; k < 2; ++k) \
        acc[ai][bj][m][n] = __builtin_amdgcn_mfma_f32_16x16x32_bf16(Bt[n][k], At[m][k], acc[ai][bj][m][n], 0, 0, 0); __builtin_amdgcn_s_setprio(0); } while (0)
#define PG8_WAIT_V(n) asm volatile("s_waitcnt vmcnt(" #n ")" ::: "memory")
#define PG8_WAIT_L(n) asm volatile("s_waitcnt lgkmcnt(" #n ")" ::: "memory")
#define PG8_BAR __builtin_amdgcn_s_barrier()
#define PG8_SCHED __builtin_amdgcn_sched_barrier(0)
    Unit cur, nxt; int ui = 0;
    if (!S.next(0, cur)) return;
    f32x4 acc[2][2][4][2];
#pragma unroll
    for (int a = 0; a < 2; ++a)
#pragma unroll
        for (int b = 0; b < 2; ++b)
#pragma unroll
            for (int m = 0; m < 4; ++m)
#pragma unroll
                for (int n = 0; n < 2; ++n) acc[a][b][m][n] = (f32x4){0.f, 0.f, 0.f, 0.f};
    bf16x8 At[4][2], B0[2][2], B1[2][2];
    const char* cA = (const char*)g.A + (size_t)cur.pm * tstep + (size_t)cur.kb * K * 2; const char* cB = (const char*)g.Bt + (size_t)cur.pn * tstep + (size_t)cur.kb * K * 2;
    S.a_ready(cur);
    if constexpr (SP2) {
        PG8_STAGE(PG8_SB(0, 0), cB, voffB); PG8_STAGE(PG8_SB(0, 1), cB + hstep, voffB); PG8_STAGE(PG8_SA(0, 0), cA, voffA); PG8_STAGE(PG8_SA(0, 1), cA + hstep, voffA);
        if (wr == 1) PG8_BAR;
        PG8_WAIT_V(2); PG8_BAR;
        PG8_STAGE(PG8_SB(1, 0), cB + kstep, voffB); PG8_STAGE(PG8_SA(1, 0), cA + kstep, voffA); PG8_STAGE(PG8_SB(1, 1), cB + hstep + kstep, voffB);
        PG8_WAIT_V(6); PG8_BAR;
    } else {
        PG8_STAGE(PG8_SB(0, 0), cB, voffB); PG8_STAGE(PG8_SA(0, 0), cA, voffA); PG8_STAGE(PG8_SB(0, 1), cB + hstep, voffB); PG8_STAGE(PG8_SA(0, 1), cA + hstep, voffA);
        if (wr == 1) PG8_BAR;
        PG8_WAIT_V(4); PG8_BAR;
        PG8_STAGE(PG8_SB(1, 0), cB + kstep, voffB); PG8_STAGE(PG8_SA(1, 0), cA + kstep, voffA); PG8_STAGE(PG8_SB(1, 1), cB + hstep + kstep, voffB);
        PG8_WAIT_V(6); PG8_BAR;
    }
    for (;;) {
        const bool has_next = S.next(ui + 1, nxt);
        const char* nA = has_next ? (const char*)g.A + (size_t)nxt.pm * tstep + (size_t)nxt.kb * K * 2 : cA; const char* nB = has_next ? (const char*)g.Bt + (size_t)nxt.pn * tstep + (size_t)nxt.kb * K * 2 : cB;
        for (int t = 0; t < nt; t += 2) {
            const bool last = (t == nt - 2);
            const char* a1 = cA + (size_t)(t + 1) * kstep;
            const char* a2 = last ? nA : cA + (size_t)(t + 2) * kstep; const char* b2 = last ? nB : cB + (size_t)(t + 2) * kstep;
            const char* a3 = a2 + kstep; const char* b3 = b2 + kstep;
            if (last && has_next) S.a_ready(nxt);
            if constexpr (SP2) {
            PG8_LDB(B0, 0, 0); PG8_LDB(B1, 0, 1); PG8_SCHED; PG8_LDA(At, 0, 0); PG8_STAGE(PG8_SA(1, 1), a1 + hstep, voffA);
            PG8_WAIT_V(8); PG8_WAIT_L(0); PG8_BAR; PG8_MMA(0, 0, At, B0); PG8_MMA(0, 1, At, B1); PG8_BAR; PG8_SCHED;
            PG8_LDA(At, 0, 1); PG8_STAGE(PG8_SB(0, 0), b2, voffB); PG8_STAGE(PG8_SB(0, 1), b2 + hstep, voffB); PG8_STAGE(PG8_SA(0, 0), a2, voffA);
            PG8_WAIT_V(8); PG8_WAIT_L(0); PG8_BAR; PG8_MMA(1, 0, At, B0); PG8_MMA(1, 1, At, B1); PG8_BAR; PG8_SCHED;
            PG8_LDB(B0, 1, 0); PG8_LDB(B1, 1, 1); PG8_SCHED; PG8_LDA(At, 1, 0); PG8_STAGE(PG8_SA(0, 1), a2 + hstep, voffA);
            PG8_WAIT_V(8); PG8_WAIT_L(0); PG8_BAR; PG8_MMA(0, 0, At, B0); PG8_MMA(0, 1, At, B1); PG8_BAR; PG8_SCHED;
            PG8_LDA(At, 1, 1); PG8_STAGE(PG8_SB(1, 0), b3, voffB); PG8_STAGE(PG8_SB(1, 1), b3 + hstep, voffB); PG8_STAGE(PG8_SA(1, 0), a3, voffA);
            PG8_WAIT_V(8); PG8_WAIT_L(0); PG8_BAR; PG8_MMA(1, 0, At, B0); PG8_MMA(1, 1, At, B1); PG8_BAR; PG8_SCHED;
            } else {
            PG8_LDB(B0, 0, 0); PG8_SCHED; PG8_LDA(At, 0, 0); PG8_STAGE(PG8_SA(1, 1), a1 + hstep, voffA);
            PG8_WAIT_L(8); PG8_BAR; PG8_WAIT_L(0); PG8_MMA(0, 0, At, B0); PG8_BAR; PG8_SCHED;
            PG8_LDB(B1, 0, 1); PG8_STAGE(PG8_SB(0, 0), b2, voffB);
            PG8_BAR; PG8_WAIT_L(0); PG8_MMA(0, 1, At, B1); PG8_BAR;
            PG8_LDA(At, 0, 1); PG8_STAGE(PG8_SA(0, 0), a2, voffA);
            PG8_BAR; PG8_WAIT_L(0); PG8_MMA(1, 0, At, B0); PG8_BAR; PG8_SCHED;
            PG8_STAGE(PG8_SB(0, 1), b2 + hstep, voffB);
            PG8_WAIT_V(6); PG8_BAR; PG8_MMA(1, 1, At, B1); PG8_BAR;
            PG8_LDB(B0, 1, 0); PG8_SCHED; PG8_LDA(At, 1, 0); PG8_STAGE(PG8_SA(0, 1), a2 + hstep, voffA);
            PG8_WAIT_L(8); PG8_BAR; PG8_WAIT_L(0); PG8_MMA(0, 0, At, B0); PG8_BAR; PG8_SCHED;
            PG8_LDB(B1, 1, 1); PG8_STAGE(PG8_SB(1, 0), b3, voffB);
            PG8_BAR; PG8_WAIT_L(0); PG8_MMA(0, 1, At, B1); PG8_BAR;
            PG8_LDA(At, 1, 1); PG8_STAGE(PG8_SA(1, 0), a3, voffA);
            PG8_BAR; PG8_WAIT_L(0); PG8_MMA(1, 0, At, B0); PG8_BAR; PG8_SCHED;
            PG8_STAGE(PG8_SB(1, 1), b3 + hstep, voffB);
            PG8_WAIT_V(6); PG8_BAR; PG8_MMA(1, 1, At, B1); PG8_BAR;
            }
        }
        if constexpr (ALIGN_EPI) { if (wr == 0) PG8_BAR; }
        if constexpr (!Epi::AFTER_DRAIN) { E(acc, cur, wr, wc, fr, fq); S.done(cur); }
        if (!has_next) break;
#pragma unroll
        for (int a = 0; a < 2; ++a)
#pragma unroll
            for (int b = 0; b < 2; ++b)
#pragma unroll
                for (int m = 0; m < 4; ++m)
#pragma unroll
                    for (int n = 0; n < 2; ++n) acc[a][b][m][n] = (f32x4){0.f, 0.f, 0.f, 0.f};
        cur = nxt; cA = nA; cB = nB; ++ui;
        if constexpr (ALIGN_EPI) { if (wr == 1) PG8_BAR; }
    }
    PG8_WAIT_V(0);
    if constexpr (!ALIGN_EPI) { if (wr == 0) PG8_BAR; }
    PG8_BAR;
    if constexpr (Epi::AFTER_DRAIN) { E.fused(acc, cur, wr, wc, fr, fq, lds, wid, lane); S.done(cur); }
#undef PG8_SA
#undef PG8_SB
#undef PG8_STAGE
#undef PG8_LDA
#undef PG8_LDB
#undef PG8_MMA
#undef PG8_WAIT_V
#undef PG8_WAIT_L
#undef PG8_BAR
#undef PG8_SCHED
}
}

#else
}
#endif

constexpr int D = 1024, BATCH = CFG_BATCH, SEQ = CFG_SEQ, DECB = CFG_DEC_BATCH, DECS = 8, PAST = CFG_PAST_LEN, PAGE = 128;
constexpr int MP = BATCH * SEQ, MS = DECB * DECS, MT = MP + MS, M = (MT + 255) / 256 * 256;
constexpr int NPAGES = PAST / PAGE;
constexpr int QKV_A = 1536, IN_AB = 2600, LD1 = 2816, FF = 4096, INC = 4096;
constexpr int C_Z = 1536, C_B = 2048, C_A = 2052, C_CQ = 2056, C_CKV = 2312, C_KPE = 2568;
constexpr float EPS = 1e-6f;
constexpr float MLA_SCALE = 0.10206207261596575f;
constexpr float DK_SCALE = 0.08838834764831845f;
static_assert(MP % 256 == 0 && SEQ % 128 == 0 && PAST % 128 == 0, "shape assumptions");

constexpr size_t O_YP = 0, O_YS = O_YP + (size_t)MP * D, O_GDNP = O_YS + (size_t)MS * D, O_CONVP = O_GDNP + (size_t)BATCH * 4 * 16384,
    O_LATP = O_CONVP + (size_t)BATCH * 3 * QKV_A, O_KPEP = O_LATP + (size_t)MP * 256, O_HGP = O_KPEP + (size_t)MP * 32,
    O_GDNS = O_HGP + (size_t)BATCH * 8 * 16384, O_CONVS = O_GDNS + (size_t)DECB * 4 * 16384, O_LATS = O_CONVS + (size_t)DECB * 3 * QKV_A,
    O_KPES = O_LATS + (size_t)MS * 256, O_HGS = O_KPES + (size_t)MS * 32, O_END = O_HGS + (size_t)DECB * 8 * 16384;

constexpr size_t al256(size_t x) { return (x + 255) & ~(size_t)255; }
constexpr size_t WS_CTL = 0, CTL_BYTES = 65536;
constexpr size_t WS_WINAB = CTL_BYTES,                      WS_WUP0 = WS_WINAB + (size_t)LD1 * D * 2,
    WS_WUP1 = WS_WUP0 + (size_t)FF * D * 2,                 WS_WDN0 = WS_WUP1 + (size_t)FF * D * 2,
    WS_WDN1 = WS_WDN0 + (size_t)FF * D * 2,                 WS_WINC = WS_WDN1 + (size_t)FF * D * 2,
    WS_WOAB = WS_WINC + (size_t)INC * D * 2,                WS_WOC = WS_WOAB + (size_t)D * D * 2,
    WS_WUQ = WS_WOC + (size_t)D * D * 2,                    WS_WUKV = WS_WUQ + (size_t)768 * 256 * 2,
    WS_ROPE = WS_WUKV + (size_t)1024 * 256 * 2,             WS_XN = al256(WS_ROPE + (size_t)(SEQ + 8) * 32 * 4),
    WS_P1 = WS_XN + (size_t)M * D * 2,                      WS_CQN = WS_P1 + (size_t)M * 4096 * 4,
    WS_LATN = WS_CQN + (size_t)M * 256 * 2,                 WS_QH = WS_LATN + (size_t)M * 256 * 2,
    WS_KVP = WS_QH + (size_t)M * 768 * 4,                   WS_OCAT = WS_KVP + (size_t)MP * 1024 * 2,
    WS_ORAW = WS_OCAT + (size_t)M * D * 2,                  WS_X1 = WS_ORAW + (size_t)M * D * 4,
    WS_X2 = WS_X1 + (size_t)M * D * 4,                      WS_H = WS_X2 + (size_t)M * D * 4,
    WS_WUKB = WS_H + (size_t)M * FF * 2,                    WS_PO = WS_WUKB + (size_t)256 * 512 * 2,
    WS_PM = WS_PO + (size_t)DECB * 2 * 64 * 256 * 4,        WS_PL = WS_PM + (size_t)DECB * 2 * 64 * 4,
    WS_KPEB = WS_PL + (size_t)DECB * 2 * 64 * 4,            WS_PART = al256(WS_KPEB + (size_t)MP * 32 * 2),
    WS_END = WS_PART + (size_t)16 * (M - MP) * D * 4;
constexpr size_t WS_H_END = WS_H + (size_t)M * FF * 2;

constexpr int LDS_BYTES = 155648;
constexpr int LDS_MISC = 155648 - 256;
constexpr int NPHASE = 20;

typedef unsigned short bf16;
typedef unsigned u32x4 __attribute__((ext_vector_type(4)));
typedef unsigned u32x2 __attribute__((ext_vector_type(2)));
#ifndef HIPEMU
typedef short bf16x8 __attribute__((ext_vector_type(8)));
typedef float f32x4 __attribute__((ext_vector_type(4)));
#endif

#ifdef HIPEMU
DEV unsigned f2bf(float f) { unsigned u = __float_as_uint(f); return (u + 0x7fffu + ((u >> 16) & 1u)) >> 16; }
#else
DEV unsigned f2bf(float f) { return (unsigned)__builtin_bit_cast(unsigned short, (__bf16)f); }
#endif
#ifdef HIPEMU
DEV unsigned pk2(float lo, float hi) { return f2bf(lo) | (f2bf(hi) << 16); }
#else
typedef float f32x2_t __attribute__((ext_vector_type(2))); typedef __bf16 bf16x2_t __attribute__((ext_vector_type(2)));
DEV unsigned pk2(float lo, float hi) { f32x2_t v = {lo, hi}; bf16x2_t b = __builtin_convertvector(v, bf16x2_t); return __builtin_bit_cast(unsigned, b); }
#endif
DEV float bf2f(bf16 b) { return __uint_as_float(((unsigned)b) << 16); }
DEV float sigmoidf_(float x) { return 1.0f / (1.0f + __expf(-x)); }
DEV float siluf_(float x) { return x / (1.0f + __expf(-x)); }
DEV float softplusf_(float x) { return fmaxf(x, 0.f) + log1pf(__expf(-fabsf(x))); }
#ifdef HIPEMU
DEV f32x4 mfma16(bf16x8 a, bf16x8 b, f32x4 c) { return emu_mfma16(a, b, c); }
#define WAVE_SYNC() emu_wave_sync()
#define OPAQUE_V(x) do { } while (0)
#define LDS_BARRIER() __syncthreads()
DEV s16x4 lds_tr(const unsigned short* p) { return emu_lds_tr((const void*)p); }
#else
typedef short s16x4 __attribute__((ext_vector_type(4)));
DEV s16x4 lds_tr(const unsigned short* p) { return __builtin_bit_cast(s16x4, __builtin_amdgcn_ds_read_tr16_b64_v4i16((__attribute__((address_space(3))) s16x4*)p)); }
DEV f32x4 mfma16(bf16x8 a, bf16x8 b, f32x4 c) { return __builtin_amdgcn_mfma_f32_16x16x32_bf16(a, b, c, 0, 0, 0); }
#define WAVE_SYNC() asm volatile("s_waitcnt lgkmcnt(0)" ::: "memory")
#define OPAQUE_V(x) asm volatile("" : "+v"(x))
#define LDS_BARRIER() asm volatile("s_waitcnt lgkmcnt(0)\n\ts_barrier" ::: "memory")
#endif
DEV f32x4 ld4bf(const unsigned short* p) { const u32x2 u = *(const u32x2*)p; return (f32x4){__uint_as_float(u.x << 16), __uint_as_float(u.x & 0xffff0000u), __uint_as_float(u.y << 16), __uint_as_float(u.y & 0xffff0000u)}; }
constexpr float QK_SCALE2 = MLA_SCALE * 1.4426950408889634f;
#ifdef HIPEMU
DEV float exp2f_(float x) { return exp2f(x); }
DEV bool wave_any(bool p) { int v = p ? 1 : 0;
    for (int o = 1; o < 64; o <<= 1) v |= __shfl_xor(v, o);
    return v != 0; }
#else
DEV float exp2f_(float x) { return __builtin_amdgcn_exp2f(x); }
DEV bool wave_any(bool p) { return __builtin_amdgcn_ballot_w64(p) != 0ull; }
#endif
#ifdef HIPEMU
DEV float wave_sum(float v) {
#pragma unroll
    for (int o = 1; o < 64; o <<= 1) v += __shfl_xor(v, o);
    return v;
}
DEV float grp16_max(float v) {
#pragma unroll
    for (int o = 1; o < 16; o <<= 1) v = fmaxf(v, __shfl_xor(v, o));
    return v;
}
DEV float grp16_sum(float v) {
#pragma unroll
    for (int o = 1; o < 16; o <<= 1) v += __shfl_xor(v, o);
    return v;
}
#else
template <int CTRL> DEV float dppf(float x) { return __builtin_bit_cast(float, __builtin_amdgcn_mov_dpp(__builtin_bit_cast(int, x), CTRL, 0xf, 0xf, true)); }
DEV float grp16_max(float v) { v = fmaxf(v, dppf<0xB1>(v)); v = fmaxf(v, dppf<0x4E>(v)); v = fmaxf(v, dppf<0x141>(v)); v = fmaxf(v, dppf<0x128>(v)); return v; }
DEV float grp16_sum(float v) { v += dppf<0xB1>(v); v += dppf<0x4E>(v); v += dppf<0x141>(v); v += dppf<0x128>(v); return v; }
DEV float wave_sum(float v) {
    v = grp16_sum(v);
    auto s = __builtin_amdgcn_permlane16_swap(__float_as_uint(v), __float_as_uint(v), false, false);
    v = __uint_as_float(s[0]) + __uint_as_float(s[1]);
    auto t = __builtin_amdgcn_permlane32_swap(__float_as_uint(v), __float_as_uint(v), false, false);
    return __uint_as_float(t[0]) + __uint_as_float(t[1]);
}
#endif

struct Params { const void* in[28]; float* out; unsigned char* ws; int ph_lo, ph_hi; };
struct Ctx {
    const Params* p; unsigned char* lds; unsigned char* ws; float* out;
    int tid, lane, wave, gw, ngw;
    template <class T> DEV const T* in(int i) const { return (const T*)p->in[i]; }
    template <class T> DEV T* w(size_t off) const { return (T*)(ws + off); }
};
DEV int queue_next(const Ctx& c, int q) {
    unsigned* cnt = (unsigned*)(c.ws + WS_CTL) + 4096 + 64 * q; volatile unsigned* slot = (volatile unsigned*)(c.lds + LDS_MISC + 128);
    __syncthreads();
    if (c.tid == 0) *slot = atomicAdd(cnt, 1u);
    __syncthreads();
    return (int)*slot;
}
DEV const float* xin_row(const Ctx& c, int m) { return m < MP ? c.in<float>(0) + (size_t)m * D : c.in<float>(1) + (size_t)(m - MP) * D; }

struct EpiStoreF32 {
    static constexpr bool PERM = false, AFTER_DRAIN = false;
    float* C; int ldc;
    DEV void operator()(const pg8::f32x4 (&acc)[2][2][4][2], const pg8::Unit& u, int wr, int wc, int fr, int fq) const {
        const int row0 = u.pm * 256 + wr * 64 + fr, col0 = u.pn * 256 + wc * 32 + 4 * fq;
#pragma unroll
        for (int ai = 0; ai < 2; ++ai)
#pragma unroll
            for (int m = 0; m < 4; ++m) { float* rowp = C + (size_t)(row0 + ai * 128 + m * 16) * ldc + col0;
#pragma unroll
                for (int bj = 0; bj < 2; ++bj)
#pragma unroll
                    for (int n = 0; n < 2; ++n) *(pg8::f32x4*)(rowp + bj * 128 + n * 16) = acc[ai][bj][m][n]; }
    }
};
struct EpiResidF32 {
    static constexpr bool PERM = false, AFTER_DRAIN = false;
    const float* base; const float* xp; const float* xs; float* out;
    DEV void operator()(const pg8::f32x4 (&acc)[2][2][4][2], const pg8::Unit& u, int wr, int wc, int fr, int fq) const {
        const int row0 = u.pm * 256 + wr * 64 + fr, col0 = u.pn * 256 + wc * 32 + 4 * fq;
#pragma unroll
        for (int ai = 0; ai < 2; ++ai)
#pragma unroll
            for (int m = 0; m < 4; ++m) { const int row = row0 + ai * 128 + m * 16;
                const float* rp = base ? base + (size_t)row * D : (row < MP ? xp + (size_t)row * D : xs + (size_t)(row - MP) * D);
                const bool ok = base != nullptr || row < MT;
                float* op = out + (size_t)row * D + col0;
#pragma unroll
                for (int bj = 0; bj < 2; ++bj)
#pragma unroll
                    for (int n = 0; n < 2; ++n) { pg8::f32x4 r = ok ? *(const pg8::f32x4*)(rp + col0 + bj * 128 + n * 16) : (pg8::f32x4){0.f, 0.f, 0.f, 0.f};
                        *(pg8::f32x4*)(op + bj * 128 + n * 16) = r + acc[ai][bj][m][n]; } }
    }
};
template <int ACT  > struct EpiBf16 {
    static constexpr bool PERM = true, AFTER_DRAIN = false;
    bf16* O; int ldc;
    DEV void operator()(const pg8::f32x4 (&acc)[2][2][4][2], const pg8::Unit& u, int wr, int wc, int fr, int fq) const {
        const int row0 = u.pm * 256 + wr * 64 + fr, col0 = u.pn * 256 + wc * 32 + 8 * fq;
#pragma unroll
        for (int ai = 0; ai < 2; ++ai)
#pragma unroll
            for (int m = 0; m < 4; ++m) { bf16* rowp = O + (size_t)(row0 + ai * 128 + m * 16) * ldc + col0;
#pragma unroll
                for (int bj = 0; bj < 2; ++bj) { pg8::f32x4 v0 = acc[ai][bj][m][0], v1 = acc[ai][bj][m][1];
                    if (ACT == 1) {
#pragma unroll
                        for (int j = 0; j < 4; ++j) { const float a = fmaxf(v0[j], 0.f), b = fmaxf(v1[j], 0.f); v0[j] = a * a; v1[j] = b * b; } }
                    u32x4 w; w.x = pk2(v0[0], v0[1]); w.y = pk2(v0[2], v0[3]); w.z = pk2(v1[0], v1[1]); w.w = pk2(v1[2], v1[3]);
                    *(u32x4*)(rowp + bj * 128) = w; } }
    }
};

struct SplitKOrder {
    int nM, nN, nS, pm0, G, c;
    DEV void init(int nM_, int nN_, int nS_, int pm0_, int G_, int c_) { nM = nM_; nN = nN_; nS = nS_; pm0 = pm0_; G = G_; c = c_; }
    DEV bool next(int i, pg8::Unit& u) const { const int L = i * G + c; if (L >= nM * nN * nS) return false; u.pm = pm0 + L % nM; const int r = L / nM; u.pn = r % nN; u.kb = r / nN; return true; }
    DEV void a_ready(const pg8::Unit&) const {}
    DEV void done(const pg8::Unit&) const {}
};
struct EpiPartF32 {
    static constexpr bool PERM = false, AFTER_DRAIN = false;
    float* P;
    DEV void operator()(const pg8::f32x4 (&acc)[2][2][4][2], const pg8::Unit& u, int wr, int wc, int fr, int fq) const {
        const int row0 = u.pm * 256 - MP + wr * 64 + fr, col0 = u.pn * 256 + wc * 32 + 4 * fq;
        float* base = P + (size_t)u.kb * (M - MP) * D;
#pragma unroll
        for (int ai = 0; ai < 2; ++ai)
#pragma unroll
            for (int m = 0; m < 4; ++m) { float* op = base + (size_t)(row0 + ai * 128 + m * 16) * D + col0;
#pragma unroll
                for (int bj = 0; bj < 2; ++bj)
#pragma unroll
                    for (int n = 0; n < 2; ++n) *(pg8::f32x4*)(op + bj * 128 + n * 16) = acc[ai][bj][m][n]; }
    }
};
template <class Epi, class Sched> DEV void run_gemm_s(const Ctx& c, const bf16* A, const bf16* Bt, int Mr, int N, int K, int ld, const Sched& S, const Epi& E) {
#ifndef HIPEMU
    asm volatile("" : "+s"(K));
    pg8::Gemm g{A, Bt, Mr, N, K, ld};
    pg8::gemm_phase<Epi, Sched, true, true>((PG8_LAS unsigned char*)c.lds, g, S, E, c.wave, c.lane);
#else
    const int wid = c.wave, lane = c.lane, wr = wid >> 2, wc = wid & 3, fr = lane & 15, fq = lane >> 4;
    pg8::Unit u;
    for (int ui = 0; S.next(ui, u); ++ui) {
        pg8::f32x4 acc[2][2][4][2];
        for (int ai = 0; ai < 2; ++ai) for (int bj = 0; bj < 2; ++bj) for (int m = 0; m < 4; ++m) for (int n = 0; n < 2; ++n) for (int j = 0; j < 4; ++j) {
            const int row = 256 * u.pm + 128 * ai + 64 * wr + 16 * m + fr;
            const int col = Epi::PERM ? 256 * u.pn + 128 * bj + 32 * wc + 8 * fq + 4 * n + j : 256 * u.pn + 128 * bj + 32 * wc + 16 * n + 4 * fq + j;
            const bf16* a = A + (size_t)row * ld + (size_t)u.kb * K; const bf16* b = Bt + (size_t)col * ld + (size_t)u.kb * K; float s = 0.f;
            for (int k = 0; k < K; ++k) s += bf2f(a[k]) * bf2f(b[k]);
            acc[ai][bj][m][n][j] = s; }
        E(acc, u, wr, wc, fr, fq);
    }
#endif
}
template <class Epi> DEV void run_gemm(const Ctx& c, const bf16* A, const bf16* Bt, int Mr, int N, int K, const Epi& E) {
    pg8::StaticOrder S; S.init(Mr, N, (int)gridDim.x, (int)blockIdx.x);
    run_gemm_s(c, A, Bt, Mr, N, K, K, S, E);
}
DEV void run_gemm_sample_splitk(const Ctx& c, const bf16* A, const bf16* Bt, int K, int KS) {
    SplitKOrder S; S.init((M - MP) / 256, D / 256, K / KS, MP / 256, (int)gridDim.x, (int)((blockIdx.x + 128) % gridDim.x));
    run_gemm_s(c, A, Bt, M, D, KS, K, S, EpiPartF32{c.w<float>(WS_PART)});
}

DEV void transpose_item(const float* W, int K, int N, bf16* WT, float* scr, int item, int nblk, int lane) {
    const int kb = item / nblk, nb = item % nblk, k0 = 64 * kb, n0 = 32 * nb;
    const int nn = n0 + (lane & 31);
    float tv[32];
#pragma unroll
    for (int i = 0; i < 32; ++i) { const int kk = 2 * i + (lane >> 5); tv[i] = nn < N ? W[(size_t)(k0 + kk) * N + nn] : 0.f; }
#pragma unroll
    for (int i = 0; i < 32; ++i) { const int kk = 2 * i + (lane >> 5); scr[kk * 33 + (lane & 31)] = tv[i]; }
    WAVE_SYNC();
    const int cq = lane & 7;
#pragma unroll
    for (int j = 0; j < 4; ++j) { const int n = (lane >> 3) + 8 * j; const float* s = scr + (8 * cq) * 33 + n;
        u32x4 o; o.x = pk2(s[0 * 33], s[1 * 33]); o.y = pk2(s[2 * 33], s[3 * 33]); o.z = pk2(s[4 * 33], s[5 * 33]); o.w = pk2(s[6 * 33], s[7 * 33]);
        *(u32x4*)(WT + (size_t)(n0 + n) * K + k0 + 8 * cq) = o; }
    WAVE_SYNC();
}
DEV void rms_row_to_bf16(const float* xrow, const float* gain, bf16* orow, int lane) {
    f32x4 v[4]; float s = 0.f;
#pragma unroll
    for (int j = 0; j < 4; ++j) { v[j] = *(const f32x4*)(xrow + 4 * lane + 256 * j); s += (v[j][0] * v[j][0] + v[j][1] * v[j][1]) + (v[j][2] * v[j][2] + v[j][3] * v[j][3]); }
    const float rstd = rsqrtf(wave_sum(s) * (1.f / D) + EPS);
#pragma unroll
    for (int j = 0; j < 4; ++j) { const f32x4 g = *(const f32x4*)(gain + 4 * lane + 256 * j);
        u32x2 o; o.x = pk2(v[j][0] * rstd * g[0], v[j][1] * rstd * g[1]); o.y = pk2(v[j][2] * rstd * g[2], v[j][3] * rstd * g[3]);
        *(u32x2*)(orow + 4 * lane + 256 * j) = o; }
}
DEV void zero_row_bf16(bf16* orow, int lane) {
#pragma unroll
    for (int j = 0; j < 4; ++j) { u32x2 o; o.x = 0u; o.y = 0u; *(u32x2*)(orow + 4 * lane + 256 * j) = o; }
}
DEV void phase_prologue(const Ctx& c) {
    float* scr = (float*)(c.lds + c.wave * 8704);
#define TJOB(Wp, K_, N_, Npad_, wt_) do { const int nblk = (Npad_) / 32, nitems = ((K_) / 64) * nblk; bf16* WT = c.w<bf16>(wt_); const float* Wsrc = (Wp); \
        for (int it = c.gw; it < nitems; it += c.ngw) transpose_item(Wsrc, (K_), (N_), WT, scr, it, nblk, c.lane); } while (0)
    TJOB(c.in<float>(13), D, IN_AB, LD1, WS_WINAB);
    TJOB(c.in<float>(11), D, FF, FF, WS_WUP0); TJOB(c.in<float>(11) + (size_t)D * FF, D, FF, FF, WS_WUP1);
    TJOB(c.in<float>(12), FF, D, D, WS_WDN0); TJOB(c.in<float>(12) + (size_t)D * FF, FF, D, D, WS_WDN1);
    TJOB(c.in<float>(24), D, INC, INC, WS_WINC);
    TJOB(c.in<float>(23), D, D, D, WS_WOAB); TJOB(c.in<float>(27), D, D, D, WS_WOC);
    TJOB(c.in<float>(19), 256, 768, 768, WS_WUQ);
    TJOB(c.in<float>(21), 256, 512, 512, WS_WUKV); TJOB(c.in<float>(22), 256, 512, 512, WS_WUKV + (size_t)512 * 256 * 2);
#undef TJOB
    {
        const float* src = c.in<float>(21); bf16* dst = c.w<bf16>(WS_WUKB);
        for (int i = blockIdx.x * 512 + c.tid; i < 256 * 512 / 4; i += gridDim.x * 512) { const f32x4 v = *(const f32x4*)(src + 4 * i); u32x2 o; o.x = pk2(v[0], v[1]); o.y = pk2(v[2], v[3]); *(u32x2*)(dst + 4 * i) = o; }
    }
    float* rope = c.w<float>(WS_ROPE);
    for (int i = blockIdx.x * 512 + c.tid; i < (SEQ + 8) * 16; i += gridDim.x * 512) {
        const int e = i >> 4, f = i & 15; const double pos = e < SEQ ? (double)e : (double)(PAST + e - SEQ);
        const double ang = pos * pow(10000.0, -(double)f / 16.0);
        rope[e * 32 + f] = (float)cos(ang); rope[e * 32 + 16 + f] = (float)sin(ang);
    }
    bf16* XN = c.w<bf16>(WS_XN);
    for (int m = c.gw; m < M; m += c.ngw) {
        if (m < MT) rms_row_to_bf16(xin_row(c, m), c.in<float>(8), XN + (size_t)m * D, c.lane); else zero_row_bf16(XN + (size_t)m * D, c.lane);
    }
}
DEV void sample_row_sum(const Ctx& c, int m, const float* X_res, int nsp, f32x4 (&v)[4]) {
    const int lane = c.lane; const float* P = c.w<float>(WS_PART) + (size_t)(m - MP) * D;
#pragma unroll
    for (int j = 0; j < 4; ++j) {
        if (X_res) v[j] = *(const f32x4*)(X_res + (size_t)m * D + 4 * lane + 256 * j);
        else v[j] = m < MT ? *(const f32x4*)(c.in<float>(1) + (size_t)(m - MP) * D + 4 * lane + 256 * j) : (f32x4){0.f, 0.f, 0.f, 0.f}; }
    for (int s = 0; s < nsp; ++s) {
#pragma unroll
        for (int j = 0; j < 4; ++j) v[j] += *(const f32x4*)(P + (size_t)s * (M - MP) * D + 4 * lane + 256 * j); }
}
DEV void phase_rmsnorm(const Ctx& c, float* X, const float* gain, const float* X_res, int nsp) {
    bf16* XN = c.w<bf16>(WS_XN); const int lane = c.lane;
    for (int m = c.gw; m < M; m += c.ngw) {
        if (m < MP) { rms_row_to_bf16(X + (size_t)m * D, gain, XN + (size_t)m * D, lane); continue; }
        f32x4 v[4]; sample_row_sum(c, m, X_res, nsp, v);
        float s = 0.f;
#pragma unroll
        for (int j = 0; j < 4; ++j) { *(f32x4*)(X + (size_t)m * D + 4 * lane + 256 * j) = v[j]; s += (v[j][0] * v[j][0] + v[j][1] * v[j][1]) + (v[j][2] * v[j][2] + v[j][3] * v[j][3]); }
        const float rstd = rsqrtf(wave_sum(s) * (1.f / D) + EPS);
#pragma unroll
        for (int j = 0; j < 4; ++j) { const f32x4 g = *(const f32x4*)(gain + 4 * lane + 256 * j);
            u32x2 o; o.x = pk2(v[j][0] * rstd * g[0], v[j][1] * rstd * g[1]); o.y = pk2(v[j][2] * rstd * g[2], v[j][3] * rstd * g[3]);
            *(u32x2*)(XN + (size_t)m * D + 4 * lane + 256 * j) = o; }
    }
}
DEV void phase_copy_rows(const Ctx& c, float* dst, const float* src, int nrows) {
    for (int r = (int)(gridDim.x * 8) - 1 - c.gw; r < nrows; r += c.ngw) {
#pragma unroll
        for (int j = 0; j < 4; ++j) *(f32x4*)(dst + (size_t)r * D + 4 * c.lane + 256 * j) = *(const f32x4*)(src + (size_t)r * D + 4 * c.lane + 256 * j); }
}
DEV void phase_final(const Ctx& c, const float* X, const float* gain, const float* X_res, int nsp) {
    for (int m = c.gw; m < MT; m += c.ngw) {
        const float* xrow = X + (size_t)m * D; float* orow = c.out + (m < MP ? O_YP + (size_t)m * D : O_YS + (size_t)(m - MP) * D);
        f32x4 v[4]; float s = 0.f;
        if (m >= MP) sample_row_sum(c, m, X_res, nsp, v);
#pragma unroll
        for (int j = 0; j < 4; ++j) { if (m < MP) v[j] = *(const f32x4*)(xrow + 4 * c.lane + 256 * j); s += (v[j][0] * v[j][0] + v[j][1] * v[j][1]) + (v[j][2] * v[j][2] + v[j][3] * v[j][3]); }
        const float rstd = rsqrtf(wave_sum(s) * (1.f / D) + EPS);
#pragma unroll
        for (int j = 0; j < 4; ++j) { const f32x4 g = *(const f32x4*)(gain + 4 * c.lane + 256 * j); *(f32x4*)(orow + 4 * c.lane + 256 * j) = v[j] * rstd * g; }
    }
}

DEV void phase_prep0(const Ctx& c) {
    const bf16* P1 = c.w<bf16>(WS_P1); const float* rope = c.w<float>(WS_ROPE);
    bf16* CQN = c.w<bf16>(WS_CQN); bf16* LATN = c.w<bf16>(WS_LATN);
    const float* qg = c.in<float>(18); const float* kvg = c.in<float>(20);
    const int lane = c.lane;
    for (int m = c.gw; m < M; m += c.ngw) {
        if (m >= MT) { u32x2 z; z.x = 0u; z.y = 0u; *(u32x2*)(CQN + (size_t)m * 256 + 4 * lane) = z; *(u32x2*)(LATN + (size_t)m * 256 + 4 * lane) = z; continue; }
        const bf16* row = P1 + (size_t)m * LD1;
        const bool samp = m >= MP; const int b = samp ? (m - MP) / DECS : m / SEQ, t = samp ? (m - MP) % DECS : m % SEQ;
        {
            const f32x4 v = ld4bf(row + C_CQ + 4 * lane); const f32x4 g = *(const f32x4*)(qg + 4 * lane);
            const float r = rsqrtf(wave_sum((v[0] * v[0] + v[1] * v[1]) + (v[2] * v[2] + v[3] * v[3])) * (1.f / 256.f) + EPS);
            u32x2 o; o.x = pk2(v[0] * r * g[0], v[1] * r * g[1]); o.y = pk2(v[2] * r * g[2], v[3] * r * g[3]); *(u32x2*)(CQN + (size_t)m * 256 + 4 * lane) = o;
        }
        {
            const f32x4 v = ld4bf(row + C_CKV + 4 * lane); const f32x4 g = *(const f32x4*)(kvg + 4 * lane);
            const float r = rsqrtf(wave_sum((v[0] * v[0] + v[1] * v[1]) + (v[2] * v[2] + v[3] * v[3])) * (1.f / 256.f) + EPS);
            const f32x4 y = v * r * g;
            float* lo = c.out + (samp ? O_LATS + (size_t)(m - MP) * 256 : O_LATP + (size_t)m * 256);
            *(f32x4*)(lo + 4 * lane) = y;
            u32x2 o; o.x = pk2(y[0], y[1]); o.y = pk2(y[2], y[3]); *(u32x2*)(LATN + (size_t)m * 256 + 4 * lane) = o;
        }
        if (lane < 16) {
            const float* rt = rope + (size_t)(samp ? SEQ + t : t) * 32; const float cs = rt[lane], sn = rt[16 + lane];
            const float x1 = bf2f(row[C_KPE + lane]), x2 = bf2f(row[C_KPE + 16 + lane]);
            float* ko = c.out + (samp ? O_KPES + (size_t)(m - MP) * 32 : O_KPEP + (size_t)m * 32);
            ko[lane] = x1 * cs - x2 * sn; ko[16 + lane] = x2 * cs + x1 * sn;
            if (!samp) { bf16* kb = c.w<bf16>(WS_KPEB) + (size_t)m * 32; kb[lane] = (bf16)f2bf(x1 * cs - x2 * sn); kb[16 + lane] = (bf16)f2bf(x2 * cs + x1 * sn); }
        }
        const int T = samp ? DECS : SEQ;
        if (t >= T - 3) {
            float* co = c.out + (samp ? O_CONVS : O_CONVP) + ((size_t)b * 3 + (t - (T - 3))) * QKV_A;
#pragma unroll
            for (int j = 0; j < 6; ++j) *(f32x4*)(co + 4 * lane + 256 * j) = ld4bf(row + 4 * lane + 256 * j);
        }
    }
}

DEV void phase_gdn_naive(const Ctx& c, int u_begin) {
    float* red = (float*)c.lds; float* red2 = red + 512; float* qs = red2 + 512; float* ks = qs + 128; float* vs = ks + 128; float* part = vs + 128; float* sc = part + 8;
    const bf16* P1 = c.w<bf16>(WS_P1); float* ORAW = c.w<float>(WS_ORAW); bf16* OCAT = c.w<bf16>(WS_OCAT);
    const float* convw = c.in<float>(14); const float* gn = c.in<float>(17);
    const int tid = c.tid, lane = c.lane, wave = c.wave;
    const int NU = (BATCH + DECB) * 4;
    for (int u = u_begin + blockIdx.x; u < NU; u += gridDim.x) {
        const bool samp = u >= BATCH * 4; const int b = samp ? (u - BATCH * 4) >> 2 : u >> 2, h = u & 3;
        const int T = samp ? DECS : SEQ; const size_t m0 = samp ? (size_t)MP + (size_t)b * DECS : (size_t)b * SEQ;
        const int e = tid & 127, dg = tid >> 7, d0 = dg * 32;
        float s[32];
        if (samp) { const float* S0 = c.in<float>(2) + ((size_t)(b * 4 + h) * 128 + d0) * 128 + e;
#pragma unroll
            for (int i = 0; i < 32; ++i) s[i] = S0[(size_t)i * 128]; }
        else {
#pragma unroll
            for (int i = 0; i < 32; ++i) s[i] = 0.f; }
        const int col = tid < 128 ? h * 128 + tid : (tid < 256 ? 512 + h * 128 + (tid - 128) : 1024 + h * 128 + (tid - 256));
        float w0 = 0.f, w1 = 0.f, w2 = 0.f, w3 = 0.f, x0 = 0.f, x1 = 0.f, x2 = 0.f, xn = 0.f;
        if (tid < 384) { w0 = convw[col]; w1 = convw[QKV_A + col]; w2 = convw[2 * QKV_A + col]; w3 = convw[3 * QKV_A + col];
            if (samp) { const float* cb = c.in<float>(3) + (size_t)b * 3 * QKV_A + col; x0 = cb[0]; x1 = cb[QKV_A]; x2 = cb[2 * QKV_A]; }
            xn = bf2f(P1[m0 * LD1 + col]); }
        const float Aexp = __expf(c.in<float>(15)[h]), dtb = c.in<float>(16)[h];
        for (int t = 0; t < T; ++t) {
            const size_t m = m0 + t;
            const float x3 = xn; if (t + 1 < T && tid < 384) xn = bf2f(P1[(m + 1) * LD1 + col]);
            float val = 0.f;
            if (tid < 384) { const float y = w0 * x0 + w1 * x1 + w2 * x2 + w3 * x3; val = siluf_(y); x0 = x1; x1 = x2; x2 = x3; }
            const float sq = wave_sum(tid < 256 ? val * val : 0.f);
            if (tid < 128) qs[tid] = val; else if (tid < 256) ks[tid - 128] = val; else if (tid < 384) vs[tid - 256] = val;
            if (lane == 0 && wave < 4) part[wave] = sq;
            if (tid == 384) { sc[0] = sigmoidf_(bf2f(P1[m * LD1 + C_B + h])); sc[1] = -Aexp * softplusf_(bf2f(P1[m * LD1 + C_A + h]) + dtb); }
            LDS_BARRIER();
            const float qn = rsqrtf(part[0] + part[1] + EPS), kn = rsqrtf(part[2] + part[3] + EPS), beta = sc[0], dec = __expf(sc[1]);
            float kp = 0.f;
#pragma unroll
            for (int i = 0; i < 32; ++i) { s[i] *= dec; kp += ks[d0 + i] * s[i]; }
            red[dg * 128 + e] = kp * kn;
            LDS_BARRIER();
            const float kS = (red[e] + red[128 + e]) + (red[256 + e] + red[384 + e]);
            const float delta = beta * (vs[e] - kS) * kn;
            float op = 0.f;
#pragma unroll
            for (int i = 0; i < 32; ++i) { s[i] += ks[d0 + i] * delta; op += qs[d0 + i] * s[i]; }
            red2[dg * 128 + e] = op * qn;
            LDS_BARRIER();
            if (dg == 0) ORAW[m * 512 + h * 128 + e] = ((red2[e] + red2[128 + e]) + (red2[256 + e] + red2[384 + e])) * DK_SCALE;
        }
        float* So = c.out + (samp ? O_GDNS : O_GDNP) + ((size_t)(b * 4 + h) * 128 + d0) * 128 + e;
#pragma unroll
        for (int i = 0; i < 32; ++i) So[(size_t)i * 128] = s[i];
        __syncthreads();
        for (int t = wave; t < T; t += 8) { const size_t m = m0 + t;
            const float v0 = ORAW[m * 512 + h * 128 + lane], v1 = ORAW[m * 512 + h * 128 + 64 + lane];
            const float r = rsqrtf(wave_sum(v0 * v0 + v1 * v1) * (1.f / 128.f) + EPS);
            const float z0 = bf2f(P1[m * LD1 + C_Z + h * 128 + lane]), z1 = bf2f(P1[m * LD1 + C_Z + h * 128 + 64 + lane]);
            OCAT[m * D + h * 128 + lane] = (bf16)f2bf(v0 * r * gn[lane] * siluf_(z0));
            OCAT[m * D + h * 128 + 64 + lane] = (bf16)f2bf(v1 * r * gn[64 + lane] * siluf_(z1)); }
        __syncthreads();
    }
}

DEV void phase_hgrn_naive(const Ctx& c, int u_begin, int wg_first, int wg_stride) {
    float* red = (float*)c.lds; float* qs = red + 512; float* fs = qs + 128;
    const bf16* PC = c.w<bf16>(WS_P1); float* ORAW = c.w<float>(WS_ORAW); bf16* OC = c.w<bf16>(WS_OCAT);
    const float* lbl = c.in<float>(25); const float* gn = c.in<float>(26);
    const int tid = c.tid, lane = c.lane, wave = c.wave;
    const int NU = (BATCH + DECB) * 8;
    for (int u = u_begin + wg_first; u < NU; u += wg_stride) {
        const bool samp = u >= BATCH * 8; const int b = samp ? (u - BATCH * 8) >> 3 : u >> 3, h = u & 7;
        const int T = samp ? DECS : SEQ; const size_t m0 = samp ? (size_t)MP + (size_t)b * DECS : (size_t)b * SEQ;
        const int e = tid & 127, dg = tid >> 7, d0 = dg * 32;
        float s[32];
        if (samp) { const float* S0 = c.in<float>(6) + ((size_t)(b * 8 + h) * 128 + d0) * 128 + e;
#pragma unroll
            for (int i = 0; i < 32; ++i) s[i] = S0[(size_t)i * 128]; }
        else {
#pragma unroll
            for (int i = 0; i < 32; ++i) s[i] = 0.f; }
        float lb = 0.f; if (tid < 128) lb = sigmoidf_(lbl[1024 + h * 128 + tid] - lbl[h * 128 + tid]);
        bf16 nq = 0, nf = 0, nv = 0;
        { const bf16* row = PC + m0 * INC; if (tid < 128) { nq = row[h * 128 + tid]; nf = row[1024 + h * 128 + tid]; } nv = row[2048 + h * 128 + e]; }
        for (int t = 0; t < T; ++t) {
            const size_t m = m0 + t;
            if (tid < 128) { qs[tid] = siluf_(bf2f(nq)); fs[tid] = lb + (1.f - lb) * sigmoidf_(bf2f(nf)); }
            const float v = bf2f(nv);
            if (t + 1 < T) { const bf16* row = PC + (m + 1) * INC; if (tid < 128) { nq = row[h * 128 + tid]; nf = row[1024 + h * 128 + tid]; } nv = row[2048 + h * 128 + e]; }
            LDS_BARRIER();
            float op = 0.f;
#pragma unroll
            for (int i = 0; i < 32; ++i) { const float f = fs[d0 + i]; s[i] = f * s[i] + (1.f - f) * v; op += qs[d0 + i] * s[i]; }
            red[dg * 128 + e] = op;
            LDS_BARRIER();
            if (dg == 0) ORAW[m * D + h * 128 + e] = ((red[e] + red[128 + e]) + (red[256 + e] + red[384 + e])) * DK_SCALE;
        }
        float* So = c.out + (samp ? O_HGS : O_HGP) + ((size_t)(b * 8 + h) * 128 + d0) * 128 + e;
#pragma unroll
        for (int i = 0; i < 32; ++i) So[(size_t)i * 128] = s[i];
        __syncthreads();
        for (int t = wave; t < T; t += 8) { const size_t m = m0 + t;
            const float v0 = ORAW[m * D + h * 128 + lane], v1 = ORAW[m * D + h * 128 + 64 + lane];
            const float r = rsqrtf(wave_sum(v0 * v0 + v1 * v1) * (1.f / 128.f) + EPS);
            const float z0 = bf2f(PC[m * INC + 3072 + h * 128 + lane]), z1 = bf2f(PC[m * INC + 3072 + h * 128 + 64 + lane]);
            OC[m * D + h * 128 + lane] = (bf16)f2bf(v0 * r * gn[lane] * siluf_(z0));
            OC[m * D + h * 128 + 64 + lane] = (bf16)f2bf(v1 * r * gn[64 + lane] * siluf_(z1)); }
        __syncthreads();
    }
}

DEV bf16x8 ld8(const bf16* p) { return *(const bf16x8*)p; }
DEV void softmax_strip(f32x4 (&s)[4], float (&mrun)[4], float (&lrun)[4], float (&alpha)[4], bf16* Ps, int lane) {
#pragma unroll
    for (int r = 0; r < 4; ++r) {
        float mx = fmaxf(fmaxf(s[0][r], s[1][r]), fmaxf(s[2][r], s[3][r])); mx = grp16_max(mx);
        const float mn = fmaxf(mrun[r], mx);
        alpha[r] = __expf(mrun[r] - mn); mrun[r] = mn;
        float sum = 0.f;
#pragma unroll
        for (int nt = 0; nt < 4; ++nt) { const float p = __expf(s[nt][r] - mn); s[nt][r] = p; sum += p; }
        sum = grp16_sum(sum); lrun[r] = lrun[r] * alpha[r] + sum;
    }
#pragma unroll
    for (int nt = 0; nt < 4; ++nt)
#pragma unroll
        for (int r = 0; r < 4; ++r) Ps[((lane >> 4) * 4 + r) * 72 + nt * 16 + (lane & 15)] = (bf16)f2bf(s[nt][r]);
}
DEV void phase_attn_prompt(const Ctx& c) {
    bf16* Qs = (bf16*)c.lds;
    bf16* Ks = Qs + 128 * 104;
    bf16* Vt = Ks + 64 * 104;
    bf16* Psb = Vt + 64 * 72;
    const float* QH = c.w<float>(WS_QH); const bf16* KVP = c.w<bf16>(WS_KVP); const float* rope = c.w<float>(WS_ROPE); bf16* OCAT = c.w<bf16>(WS_OCAT);
    const float* kpe = c.out + O_KPEP;
    const int tid = c.tid, lane = c.lane, w = c.wave;
    bf16* Ps = Psb + w * 16 * 72;
    constexpr int NQB = SEQ / 128, NU = BATCH * 8 * NQB;
    for (int u = blockIdx.x; u < NU; u += gridDim.x) {
        const int qb = NQB - 1 - u / (BATCH * 8), bh = u % (BATCH * 8), b = bh >> 3, h = bh & 7;
        const int q0 = qb * 128; const size_t mb = (size_t)b * SEQ;
        __syncthreads();
        for (int idx = tid; idx < 128 * 80; idx += 512) {
            const int r = idx / 80, j = idx % 80; const float* qrow = QH + (mb + q0 + r) * 768 + h * 96;
            if (j < 64) Qs[r * 104 + j] = (bf16)f2bf(qrow[j] * MLA_SCALE);
            else { const int f = j - 64; const float* rt = rope + (size_t)(q0 + r) * 32; const float cs = rt[f], sn = rt[16 + f], x1 = qrow[64 + f], x2 = qrow[80 + f];
                Qs[r * 104 + 64 + f] = (bf16)f2bf((x1 * cs - x2 * sn) * MLA_SCALE); Qs[r * 104 + 80 + f] = (bf16)f2bf((x2 * cs + x1 * sn) * MLA_SCALE); }
        }
        __syncthreads();
        bf16x8 qf[3];
#pragma unroll
        for (int ks = 0; ks < 3; ++ks) qf[ks] = ld8(Qs + (w * 16 + (lane & 15)) * 104 + ks * 32 + 8 * (lane >> 4));
        float mrun[4], lrun[4], alpha[4]; f32x4 o[4];
#pragma unroll
        for (int r = 0; r < 4; ++r) { mrun[r] = -INFINITY; lrun[r] = 0.f; }
#pragma unroll
        for (int nt = 0; nt < 4; ++nt) o[nt] = (f32x4){0.f, 0.f, 0.f, 0.f};
        const int nkt = 2 * qb + 2;
        for (int kt = 0; kt < nkt; ++kt) {
            const int k0 = kt * 64;
            __syncthreads();
            for (int idx = tid; idx < 64 * 8; idx += 512) {
                const int key = idx >> 3, ch = idx & 7; *(u32x4*)(Ks + key * 104 + ch * 8) = *(const u32x4*)(KVP + (mb + k0 + key) * 1024 + h * 64 + ch * 8); }
            for (int idx = tid; idx < 64 * 32; idx += 512) { const int key = idx >> 5, f = idx & 31; Ks[key * 104 + 64 + f] = (bf16)f2bf(kpe[(mb + k0 + key) * 32 + f]); }
            for (int idx = tid; idx < 64 * 64; idx += 512) { const int key = idx >> 6, d = idx & 63; Vt[d * 72 + key] = KVP[(mb + k0 + key) * 1024 + 512 + h * 64 + d]; }
            __syncthreads();
            f32x4 s[4];
#pragma unroll
            for (int nt = 0; nt < 4; ++nt) { s[nt] = (f32x4){0.f, 0.f, 0.f, 0.f};
#pragma unroll
                for (int ks = 0; ks < 3; ++ks) s[nt] = mfma16(qf[ks], ld8(Ks + (nt * 16 + (lane & 15)) * 104 + ks * 32 + 8 * (lane >> 4)), s[nt]); }
            if (kt >= 2 * qb) {
#pragma unroll
                for (int nt = 0; nt < 4; ++nt)
#pragma unroll
                    for (int r = 0; r < 4; ++r) { const int qpos = q0 + w * 16 + (lane >> 4) * 4 + r, kpos = k0 + nt * 16 + (lane & 15); if (kpos > qpos) s[nt][r] = -INFINITY; }
            }
            softmax_strip(s, mrun, lrun, alpha, Ps, lane);
            WAVE_SYNC();
#pragma unroll
            for (int nt = 0; nt < 4; ++nt) {
#pragma unroll
                for (int r = 0; r < 4; ++r) o[nt][r] *= alpha[r];
#pragma unroll
                for (int k2 = 0; k2 < 2; ++k2) o[nt] = mfma16(ld8(Ps + (lane & 15) * 72 + k2 * 32 + 8 * (lane >> 4)), ld8(Vt + (nt * 16 + (lane & 15)) * 72 + k2 * 32 + 8 * (lane >> 4)), o[nt]); }
            WAVE_SYNC();
        }
#pragma unroll
        for (int nt = 0; nt < 4; ++nt)
#pragma unroll
            for (int r = 0; r < 4; ++r) OCAT[(mb + q0 + w * 16 + (lane >> 4) * 4 + r) * D + 512 + h * 64 + nt * 16 + (lane & 15)] = (bf16)f2bf(o[nt][r] / lrun[r]);
    }
}

DEV void phase_attn_sample(const Ctx& c) {
    bf16* Qs = (bf16*)c.lds;
    bf16* Ks = Qs + 64 * 296;
    bf16* Lt = Ks + 64 * 296;
    float* Sf = (float*)(Lt + 256 * 72);
    bf16* Psb = (bf16*)(Sf + 64 * 68);
    float* Of = (float*)Ks;
    const float* QH = c.w<float>(WS_QH); const float* rope = c.w<float>(WS_ROPE); bf16* OCAT = c.w<bf16>(WS_OCAT);
    const float* wuk = c.in<float>(21); const float* wuv = c.in<float>(22);
    const float* clat = c.in<float>(4); const float* ckr = c.in<float>(5); const int* ptab = c.in<int>(7);
    const int tid = c.tid, lane = c.lane, w = c.wave;
    bf16* Ps = Psb + w * 16 * 72;
    for (int b = blockIdx.x; b < DECB; b += gridDim.x) {
        const size_t mb = (size_t)MP + (size_t)b * DECS;
        __syncthreads();
        for (int idx = tid; idx < 64 * 64; idx += 512) { const int r = idx >> 6, d = idx & 63, t = r >> 3, h = r & 7; Sf[r * 68 + d] = QH[(mb + t) * 768 + h * 96 + d]; }
        for (int idx = tid; idx < 64 * 16; idx += 512) { const int r = idx >> 4, f = idx & 15, t = r >> 3, h = r & 7; const float* qrow = QH + (mb + t) * 768 + h * 96 + 64;
            const float* rt = rope + (size_t)(SEQ + t) * 32; const float cs = rt[f], sn = rt[16 + f], x1 = qrow[f], x2 = qrow[16 + f];
            Qs[r * 296 + 256 + f] = (bf16)f2bf((x1 * cs - x2 * sn) * MLA_SCALE); Qs[r * 296 + 272 + f] = (bf16)f2bf((x2 * cs + x1 * sn) * MLA_SCALE); }
        __syncthreads();
        {
            const int l = tid & 255, th = tid >> 8;
            for (int h = 0; h < 8; ++h) {
                float a0 = 0.f, a1 = 0.f, a2 = 0.f, a3 = 0.f; const float* wr = wuk + (size_t)l * 512 + h * 64;
                const float* q0 = Sf + ((th * 4 + 0) * 8 + h) * 68; const float* q1 = Sf + ((th * 4 + 1) * 8 + h) * 68; const float* q2 = Sf + ((th * 4 + 2) * 8 + h) * 68; const float* q3 = Sf + ((th * 4 + 3) * 8 + h) * 68;
#pragma unroll 4
                for (int d4 = 0; d4 < 16; ++d4) { const f32x4 wv = *(const f32x4*)(wr + 4 * d4);
#pragma unroll
                    for (int j = 0; j < 4; ++j) { a0 += q0[4 * d4 + j] * wv[j]; a1 += q1[4 * d4 + j] * wv[j]; a2 += q2[4 * d4 + j] * wv[j]; a3 += q3[4 * d4 + j] * wv[j]; } }
                Qs[((th * 4 + 0) * 8 + h) * 296 + l] = (bf16)f2bf(a0 * MLA_SCALE); Qs[((th * 4 + 1) * 8 + h) * 296 + l] = (bf16)f2bf(a1 * MLA_SCALE);
                Qs[((th * 4 + 2) * 8 + h) * 296 + l] = (bf16)f2bf(a2 * MLA_SCALE); Qs[((th * 4 + 3) * 8 + h) * 296 + l] = (bf16)f2bf(a3 * MLA_SCALE);
            }
        }
        __syncthreads();
        const int rt = w & 3, hh = w >> 2;
        bf16x8 qf[9];
#pragma unroll
        for (int ks = 0; ks < 9; ++ks) qf[ks] = ld8(Qs + (rt * 16 + (lane & 15)) * 296 + ks * 32 + 8 * (lane >> 4));
        float mrun[4], lrun[4], alpha[4]; f32x4 o[8];
#pragma unroll
        for (int r = 0; r < 4; ++r) { mrun[r] = -INFINITY; lrun[r] = 0.f; }
#pragma unroll
        for (int nt = 0; nt < 8; ++nt) o[nt] = (f32x4){0.f, 0.f, 0.f, 0.f};
        constexpr int NT = PAST / 64 + 1;
        for (int kt = 0; kt < NT; ++kt) {
            const bool fresh = kt == NT - 1;
            __syncthreads();
            if (!fresh) {
                const int k0 = kt * 64; const size_t rowbase = (size_t)ptab[b * NPAGES + (k0 >> 7)] * PAGE + (k0 & 127);
#pragma unroll 2
                for (int j = 0; j < 8; ++j) { const int idx = tid + 512 * j, key = idx >> 6, l4 = idx & 63;
                    const f32x4 v = *(const f32x4*)(clat + (rowbase + key) * 256 + 4 * l4);
                    u32x2 pk; pk.x = pk2(v[0], v[1]); pk.y = pk2(v[2], v[3]); *(u32x2*)(Ks + key * 296 + 4 * l4) = pk;
                    Lt[(4 * l4 + 0) * 72 + key] = (bf16)f2bf(v[0]); Lt[(4 * l4 + 1) * 72 + key] = (bf16)f2bf(v[1]); Lt[(4 * l4 + 2) * 72 + key] = (bf16)f2bf(v[2]); Lt[(4 * l4 + 3) * 72 + key] = (bf16)f2bf(v[3]); }
                { const int key = tid >> 3, i4 = tid & 7; const f32x4 v = *(const f32x4*)(ckr + (rowbase + key) * 32 + 4 * i4);
                    u32x2 pk; pk.x = pk2(v[0], v[1]); pk.y = pk2(v[2], v[3]); *(u32x2*)(Ks + key * 296 + 256 + 4 * i4) = pk; }
            } else {
                const float* nl = c.out + O_LATS + (size_t)b * DECS * 256; const float* nk = c.out + O_KPES + (size_t)b * DECS * 32;
                for (int idx = tid; idx < 64 * 256; idx += 512) { const int key = idx >> 8, l = idx & 255; const bf16 v = key < DECS ? (bf16)f2bf(nl[key * 256 + l]) : (bf16)0; Ks[key * 296 + l] = v; Lt[l * 72 + key] = v; }
                for (int idx = tid; idx < 64 * 32; idx += 512) { const int key = idx >> 5, f = idx & 31; Ks[key * 296 + 256 + f] = key < DECS ? (bf16)f2bf(nk[key * 32 + f]) : (bf16)0; }
            }
            __syncthreads();
#pragma unroll
            for (int n2 = 0; n2 < 2; ++n2) { const int nt = 2 * hh + n2; f32x4 s = (f32x4){0.f, 0.f, 0.f, 0.f};
#pragma unroll
                for (int ks = 0; ks < 9; ++ks) s = mfma16(qf[ks], ld8(Ks + (nt * 16 + (lane & 15)) * 296 + ks * 32 + 8 * (lane >> 4)), s);
#pragma unroll
                for (int r = 0; r < 4; ++r) { const int row = rt * 16 + (lane >> 4) * 4 + r, key = nt * 16 + (lane & 15); float v = s[r];
                    if (fresh && (key >= DECS || key > (row >> 3))) v = -INFINITY;
                    Sf[row * 68 + key] = v; } }
            __syncthreads();
            f32x4 s[4];
#pragma unroll
            for (int nt = 0; nt < 4; ++nt)
#pragma unroll
                for (int r = 0; r < 4; ++r) s[nt][r] = Sf[(rt * 16 + (lane >> 4) * 4 + r) * 68 + nt * 16 + (lane & 15)];
            softmax_strip(s, mrun, lrun, alpha, Ps, lane);
            WAVE_SYNC();
#pragma unroll
            for (int nt = 0; nt < 8; ++nt) {
#pragma unroll
                for (int r = 0; r < 4; ++r) o[nt][r] *= alpha[r];
#pragma unroll
                for (int k2 = 0; k2 < 2; ++k2) o[nt] = mfma16(ld8(Ps + (lane & 15) * 72 + k2 * 32 + 8 * (lane >> 4)), ld8(Lt + (hh * 128 + nt * 16 + (lane & 15)) * 72 + k2 * 32 + 8 * (lane >> 4)), o[nt]); }
            WAVE_SYNC();
        }
        __syncthreads();
#pragma unroll
        for (int nt = 0; nt < 8; ++nt)
#pragma unroll
            for (int r = 0; r < 4; ++r) Of[(rt * 16 + (lane >> 4) * 4 + r) * 260 + hh * 128 + nt * 16 + (lane & 15)] = o[nt][r] / lrun[r];
        __syncthreads();
        {
            const int d = tid & 63, h = tid >> 6; float a[8];
#pragma unroll
            for (int t = 0; t < 8; ++t) a[t] = 0.f;
            for (int l = 0; l < 256; ++l) { const float wv = wuv[(size_t)l * 512 + h * 64 + d];
#pragma unroll
                for (int t = 0; t < 8; ++t) a[t] += Of[(t * 8 + h) * 260 + l] * wv; }
#pragma unroll
            for (int t = 0; t < 8; ++t) OCAT[(mb + t) * D + 512 + h * 64 + d] = (bf16)f2bf(a[t]);
        }
    }
}

constexpr int NCH = SEQ / 64;
constexpr size_t HC_QG = WS_H, HC_BNT = HC_QG + (size_t)BATCH * 8 * NCH * 64 * 128 * 2,
    HC_A = HC_BNT + (size_t)BATCH * 8 * NCH * 128 * 128 * 2, HC_END = HC_A + (size_t)BATCH * 8 * NCH * 128 * 4;
constexpr size_t HC_SNT = WS_QH;
static_assert(HC_END <= WS_H_END && HC_SNT + (size_t)BATCH * 8 * NCH * 128 * 128 * 2 <= WS_OCAT, "hgrn scratch fits");
DEV u32x4 pack8(const float* v) { u32x4 o; o.x = pk2(v[0], v[1]); o.y = pk2(v[2], v[3]); o.z = pk2(v[4], v[5]); o.w = pk2(v[6], v[7]); return o; }

DEV void phase_hgrn_prep(const Ctx& c) {
    bf16* qt = (bf16*)c.lds;
    bf16* kt = qt + 64 * 136;
    bf16* vT = kt + 160 * 136;
    bf16* Ab = vT + 128 * 72;
    float* tot = (float*)(Ab + 64 * 72);
    bf16* kgl = (bf16*)(tot + 512);
    const bf16* PC = c.w<bf16>(WS_P1); float* ORAW = c.w<float>(WS_ORAW);
    bf16* QG = c.w<bf16>(HC_QG); bf16* BNT = c.w<bf16>(HC_BNT); float* Ag = c.w<float>(HC_A);
    const float* lbl = c.in<float>(25);
    const int tid = c.tid, lane = c.lane, w = c.wave;
    const int d = tid & 127, tq = tid >> 7;
    constexpr int NU = BATCH * 8 * NCH;
    bf16 rq[16], rf[16], rv[16];
#define HP_LOAD(u_) do { const int u__ = (u_); const int bh_ = u__ / NCH, n_ = u__ % NCH; const bf16* row_ = PC + ((size_t)(bh_ >> 3) * SEQ + (size_t)n_ * 64 + 16 * tq) * INC + (bh_ & 7) * 128 + d; \
        _Pragma("unroll") for (int i = 0; i < 16; ++i) { rq[i] = row_[(size_t)i * INC]; rf[i] = row_[(size_t)i * INC + 1024]; rv[i] = row_[(size_t)i * INC + 2048]; } } while (0)
    if ((int)blockIdx.x < NU) HP_LOAD(blockIdx.x);
    for (int u = blockIdx.x; u < NU; u += gridDim.x) {
        const int bh = u / NCH, n = u % NCH, b = bh >> 3, h = bh & 7;
        const size_t m0 = (size_t)b * SEQ + (size_t)n * 64;
        const float lb = sigmoidf_(lbl[1024 + h * 128 + d] - lbl[h * 128 + d]);
        float gcl[16], kk[16], qq[16], vv[16];
        float run = 0.f;
#pragma unroll
        for (int i = 0; i < 16; ++i) {
            const float f = lb + (1.f - lb) * sigmoidf_(bf2f(rf[i]));
            kk[i] = 1.f - f; run += __logf(f); gcl[i] = run;
            qq[i] = siluf_(bf2f(rq[i])) * DK_SCALE; vv[i] = bf2f(rv[i]);
        }
        if (u + (int)gridDim.x < NU) HP_LOAD(u + (int)gridDim.x);
        tot[tq * 128 + d] = run;
        { const u32x4 p0 = pack8(vv), p1 = pack8(vv + 8);
          *(u32x4*)(vT + d * 72 + 16 * tq) = p0; *(u32x4*)(vT + d * 72 + 16 * tq + 8) = p1; }
        for (int i = tid; i < 64 * 72 / 8; i += 512) { u32x4 z; z.x = z.y = z.z = z.w = 0u; *(u32x4*)(Ab + 8 * i) = z; }
        LDS_BARRIER();
        const float t0 = tot[d], t1 = tot[128 + d], t2 = tot[256 + d], t3 = tot[384 + d];
        const float rI[4] = {0.f, t0, t0 + t1, t0 + t1 + t2}; const float glast = (t0 + t1) + (t2 + t3);
        const float pre = tq == 0 ? rI[0] : (tq == 1 ? rI[1] : (tq == 2 ? rI[2] : rI[3]));
        float kg[16];
#pragma unroll
        for (int i = 0; i < 16; ++i) {
            const float gc = pre + gcl[i];
            qt[(16 * tq + i) * 136 + d] = (bf16)f2bf(qq[i] * __expf(gcl[i]));
            QG[((size_t)u * 64 + 16 * tq + i) * 128 + d] = (bf16)f2bf(qq[i] * __expf(gc));
            kg[i] = kk[i] * __expf(glast - gc);
#pragma unroll
            for (int I = 0; I < 4; ++I) if (I >= tq) { const int base = I == 0 ? 0 : (I == 1 ? 16 : (I == 2 ? 48 : 96));
                kt[(base + 16 * tq + i) * 136 + d] = (bf16)f2bf(kk[i] * __expf(rI[I] - gc)); }
        }
        { bf16* g = kgl + d * 72 + 16 * tq; *(u32x4*)g = pack8(kg); *(u32x4*)(g + 8) = pack8(kg + 8); }
        if (tq == 0) Ag[(size_t)u * 128 + d] = __expf(glast);
        LDS_BARRIER();
        for (int ti = w; ti < 10; ti += 8) {
            const int I = ti == 0 ? 0 : (ti < 3 ? 1 : (ti < 6 ? 2 : 3)); const int J = ti - (I == 0 ? 0 : (I == 1 ? 1 : (I == 2 ? 3 : 6)));
            const int base = I == 0 ? 0 : (I == 1 ? 16 : (I == 2 ? 48 : 96));
            f32x4 acc = (f32x4){0.f, 0.f, 0.f, 0.f};
#pragma unroll
            for (int ks = 0; ks < 4; ++ks) acc = mfma16(ld8(qt + (16 * I + (lane & 15)) * 136 + ks * 32 + 8 * (lane >> 4)), ld8(kt + (base + 16 * J + (lane & 15)) * 136 + ks * 32 + 8 * (lane >> 4)), acc);
#pragma unroll
            for (int r = 0; r < 4; ++r) { const int i = 16 * I + (lane >> 4) * 4 + r, j = 16 * J + (lane & 15); Ab[i * 72 + j] = (bf16)f2bf((J < I || j <= i) ? acc[r] : 0.f); }
        }
        LDS_BARRIER();
        { const int it = w & 3;
#pragma unroll
          for (int e4 = 0; e4 < 4; ++e4) { const int et = (w >> 2) * 4 + e4; f32x4 acc = (f32x4){0.f, 0.f, 0.f, 0.f};
#pragma unroll
            for (int ks = 0; ks < 2; ++ks) acc = mfma16(ld8(Ab + (16 * it + (lane & 15)) * 72 + ks * 32 + 8 * (lane >> 4)), ld8(vT + (16 * et + (lane & 15)) * 72 + ks * 32 + 8 * (lane >> 4)), acc);
#pragma unroll
            for (int r = 0; r < 4; ++r) ORAW[(m0 + 16 * it + (lane >> 4) * 4 + r) * D + h * 128 + 16 * et + (lane & 15)] = acc[r]; } }
        {
            bf16x8 ka[2];
#pragma unroll
            for (int ks = 0; ks < 2; ++ks) ka[ks] = ld8(kgl + (16 * w + (lane & 15)) * 72 + ks * 32 + 8 * (lane >> 4));
            bf16* g = BNT + (size_t)u * 16384;
#pragma unroll
            for (int et = 0; et < 8; ++et) { f32x4 acc = (f32x4){0.f, 0.f, 0.f, 0.f};
#pragma unroll
                for (int ks = 0; ks < 2; ++ks) acc = mfma16(ka[ks], ld8(vT + (16 * et + (lane & 15)) * 72 + ks * 32 + 8 * (lane >> 4)), acc);
                u32x2 o; o.x = pk2(acc[0], acc[1]); o.y = pk2(acc[2], acc[3]); *(u32x2*)(g + (16 * et + (lane & 15)) * 128 + 16 * w + 4 * (lane >> 4)) = o; }
        }
        LDS_BARRIER();
    }
}

#undef HP_LOAD
DEV void phase_hgrn_prefix(const Ctx& c) {
    const bf16* BNT = c.w<bf16>(HC_BNT); const float* Ag = c.w<float>(HC_A); bf16* SNT = c.w<bf16>(HC_SNT);
    constexpr int NV = BATCH * 8 * 2048;
    for (int v = blockIdx.x * 512 + c.tid; v < NV; v += gridDim.x * 512) {
        const int bh = v >> 11, x8 = (v & 2047) * 8, d0 = x8 & 127, e = x8 >> 7;
        float S[8];
#pragma unroll
        for (int j = 0; j < 8; ++j) S[j] = 0.f;
        const size_t base = (size_t)bh * NCH * 16384 + x8;
        constexpr int PFD = NCH < 8 ? NCH : 8;
        u32x4 bq[PFD]; f32x4 aq0[PFD], aq1[PFD];
#pragma unroll
        for (int j = 0; j < PFD; ++j) { bq[j] = *(const u32x4*)(BNT + base + (size_t)j * 16384); aq0[j] = *(const f32x4*)(Ag + ((size_t)bh * NCH + j) * 128 + d0); aq1[j] = *(const f32x4*)(Ag + ((size_t)bh * NCH + j) * 128 + d0 + 4); }
#pragma unroll
        for (int n = 0; n < NCH; ++n) {
            const u32x4 bv = bq[n % PFD]; const f32x4 a0 = aq0[n % PFD], a1 = aq1[n % PFD];
            if (n + PFD < NCH) { bq[n % PFD] = *(const u32x4*)(BNT + base + (size_t)(n + PFD) * 16384); aq0[n % PFD] = *(const f32x4*)(Ag + ((size_t)bh * NCH + n + PFD) * 128 + d0); aq1[n % PFD] = *(const f32x4*)(Ag + ((size_t)bh * NCH + n + PFD) * 128 + d0 + 4); }
            *(u32x4*)(SNT + base + (size_t)n * 16384) = pack8(S);
            S[0] = a0[0] * S[0] + __uint_as_float(bv.x << 16); S[1] = a0[1] * S[1] + __uint_as_float(bv.x & 0xffff0000u);
            S[2] = a0[2] * S[2] + __uint_as_float(bv.y << 16); S[3] = a0[3] * S[3] + __uint_as_float(bv.y & 0xffff0000u);
            S[4] = a1[0] * S[4] + __uint_as_float(bv.z << 16); S[5] = a1[1] * S[5] + __uint_as_float(bv.z & 0xffff0000u);
            S[6] = a1[2] * S[6] + __uint_as_float(bv.w << 16); S[7] = a1[3] * S[7] + __uint_as_float(bv.w & 0xffff0000u);
        }
        float* So = c.out + O_HGP + (size_t)bh * 16384;
#pragma unroll
        for (int j = 0; j < 8; ++j) So[(size_t)(d0 + j) * 128 + e] = S[j];
    }
}

DEV void phase_hgrn_out(const Ctx& c) {
    bf16* qg = (bf16*)c.lds;
    bf16* StT = qg + 64 * 136;
    float* ob = (float*)(StT + 128 * 136);
    const bf16* PC = c.w<bf16>(WS_P1); const float* ORAW = c.w<float>(WS_ORAW); bf16* OC = c.w<bf16>(WS_OCAT);
    const bf16* QG = c.w<bf16>(HC_QG); const bf16* SNT = c.w<bf16>(HC_SNT);
    const float* gn = c.in<float>(26);
    const int tid = c.tid, lane = c.lane, w = c.wave;
    const float gn0 = gn[lane], gn1 = gn[64 + lane];
    constexpr int NU = BATCH * 8 * NCH;
    u32x4 pq[2], ps[4]; float or0n[8], or1n[8]; bf16 zz0n[8], zz1n[8];
#define HO_LOAD(u_) do { const int u__ = (u_); const int bh_ = u__ / NCH, n_ = u__ % NCH, b_ = bh_ >> 3, h_ = bh_ & 7; const size_t m0_ = (size_t)b_ * SEQ + (size_t)n_ * 64; \
        _Pragma("unroll") for (int j = 0; j < 2; ++j) pq[j] = *(const u32x4*)(QG + (size_t)u__ * 8192 + 8 * (tid + 512 * j)); \
        _Pragma("unroll") for (int j = 0; j < 4; ++j) ps[j] = *(const u32x4*)(SNT + (size_t)u__ * 16384 + 8 * (tid + 512 * j)); \
        _Pragma("unroll") for (int i8 = 0; i8 < 8; ++i8) { const size_t m = m0_ + w * 8 + i8; or0n[i8] = ORAW[m * D + h_ * 128 + lane]; or1n[i8] = ORAW[m * D + h_ * 128 + 64 + lane]; \
            zz0n[i8] = PC[m * INC + 3072 + h_ * 128 + lane]; zz1n[i8] = PC[m * INC + 3072 + h_ * 128 + 64 + lane]; } } while (0)
    if ((int)blockIdx.x < NU) HO_LOAD(blockIdx.x);
    for (int u = blockIdx.x; u < NU; u += gridDim.x) {
        const int bh = u / NCH, n = u % NCH, b = bh >> 3, h = bh & 7; const size_t m0 = (size_t)b * SEQ + (size_t)n * 64;
        float or0[8], or1[8], zz0[8], zz1[8];
#pragma unroll
        for (int i8 = 0; i8 < 8; ++i8) { or0[i8] = or0n[i8]; or1[i8] = or1n[i8]; zz0[i8] = bf2f(zz0n[i8]); zz1[i8] = bf2f(zz1n[i8]); }
        LDS_BARRIER();
#pragma unroll
        for (int j = 0; j < 2; ++j) { const int idx = tid + 512 * j; *(u32x4*)(qg + (idx >> 4) * 136 + (idx & 15) * 8) = pq[j]; }
#pragma unroll
        for (int j = 0; j < 4; ++j) { const int idx = tid + 512 * j; *(u32x4*)(StT + (idx >> 4) * 136 + (idx & 15) * 8) = ps[j]; }
        if (u + (int)gridDim.x < NU) HO_LOAD(u + (int)gridDim.x);
        LDS_BARRIER();
        { const int it = w & 3; bf16x8 qa[4];
#pragma unroll
          for (int ks = 0; ks < 4; ++ks) qa[ks] = ld8(qg + (16 * it + (lane & 15)) * 136 + ks * 32 + 8 * (lane >> 4));
#pragma unroll
          for (int e4 = 0; e4 < 4; ++e4) { const int et = (w >> 2) * 4 + e4; f32x4 acc = (f32x4){0.f, 0.f, 0.f, 0.f};
#pragma unroll
            for (int ks = 0; ks < 4; ++ks) acc = mfma16(qa[ks], ld8(StT + (16 * et + (lane & 15)) * 136 + ks * 32 + 8 * (lane >> 4)), acc);
#pragma unroll
            for (int r = 0; r < 4; ++r) ob[(16 * it + (lane >> 4) * 4 + r) * 132 + 16 * et + (lane & 15)] = acc[r]; } }
        LDS_BARRIER();
        { float ss[8];
#pragma unroll
          for (int i8 = 0; i8 < 8; ++i8) { const int i = w * 8 + i8; or0[i8] += ob[i * 132 + lane]; or1[i8] += ob[i * 132 + 64 + lane]; ss[i8] = or0[i8] * or0[i8] + or1[i8] * or1[i8]; }
#pragma unroll
              for (int i8 = 0; i8 < 8; ++i8) ss[i8] = wave_sum(ss[i8]);
#pragma unroll
          for (int i8 = 0; i8 < 8; ++i8) { const size_t m = m0 + w * 8 + i8; const float r = rsqrtf(ss[i8] * (1.f / 128.f) + EPS);
            OC[m * D + h * 128 + lane] = (bf16)f2bf(or0[i8] * r * gn0 * siluf_(zz0[i8])); OC[m * D + h * 128 + 64 + lane] = (bf16)f2bf(or1[i8] * r * gn1 * siluf_(zz1[i8])); } }
    }
}


constexpr int NUG = BATCH * 4 * NCH;
constexpr size_t GC_W = WS_H, GC_UT = GC_W + (size_t)NUG * 64 * 128 * 2, GC_QG = GC_UT + (size_t)NUG * 128 * 64 * 4, GC_KGT = GC_QG + (size_t)NUG * 64 * 128 * 2,
    GC_AQK = GC_KGT + (size_t)NUG * 128 * 64 * 2, GC_GL = GC_AQK + (size_t)NUG * 64 * 64 * 2, GC_END = GC_GL + (size_t)NUG * 4;
static_assert(GC_END <= WS_H_END, "gdn scratch fits in H");

DEV void phase_gdn_prep(const Ctx& c) {
    bf16* qb = (bf16*)c.lds;
    bf16* kb = qb + 64 * 136;
    float* Lm = (float*)(kb + 64 * 136);
    float* part = Lm + 64 * 68;
    float* gl = part + 256; float* gcs = gl + 64; float* bet = gcs + 64; float* eg = bet + 64; float* egl = eg + 64; float* qn = egl + 64; float* kn = qn + 64;
    float* sqb = kn + 64;
    const bf16* P1 = c.w<bf16>(WS_P1);
    bf16* Wg = c.w<bf16>(GC_W); float* UTg = c.w<float>(GC_UT); bf16* QGg = c.w<bf16>(GC_QG); bf16* KGTg = c.w<bf16>(GC_KGT); bf16* AQKg = c.w<bf16>(GC_AQK); float* GLg = c.w<float>(GC_GL);
    const float* convw = c.in<float>(14);
    const int tid = c.tid, lane = c.lane, w = c.wave;
    const int role = tid >> 7, cc = tid & 127;
    for (int u = blockIdx.x; u < NUG; u += gridDim.x) {
        const int bh = u / NCH, n = u % NCH, b = bh >> 2, h = bh & 3;
        const size_t m0 = (size_t)b * SEQ + (size_t)n * 64;
        float x[64];
        if (role < 3) {
            const int col = role * 512 + h * 128 + cc;
            const float w0 = convw[col], w1 = convw[QKV_A + col], w2 = convw[2 * QKV_A + col], w3 = convw[3 * QKV_A + col];
            const bf16* src = P1 + m0 * LD1 + col;
            float p0 = 0.f, p1 = 0.f, p2 = 0.f;
            if (n > 0) { p0 = bf2f(src[-3 * (long)LD1]); p1 = bf2f(src[-2 * (long)LD1]); p2 = bf2f(src[-1 * (long)LD1]); }
#pragma unroll
            for (int j = 0; j < 64; ++j) x[j] = bf2f(src[(size_t)j * LD1]);
#pragma unroll
            for (int j = 0; j < 64; ++j) { const float cur = x[j]; const float y = w0 * p0 + w1 * p1 + w2 * p2 + w3 * cur; x[j] = siluf_(y); p0 = p1; p1 = p2; p2 = cur; }
            if (role < 2) {
#pragma unroll
                for (int j4 = 0; j4 < 16; ++j4) *(f32x4*)(sqb + tid * 68 + 4 * j4) = (f32x4){x[4 * j4] * x[4 * j4], x[4 * j4 + 1] * x[4 * j4 + 1], x[4 * j4 + 2] * x[4 * j4 + 2], x[4 * j4 + 3] * x[4 * j4 + 3]};
            }
        } else if (cc < 64) {
            const float Aexp = __expf(c.in<float>(15)[h]), dtb = c.in<float>(16)[h];
            bet[cc] = sigmoidf_(bf2f(P1[(m0 + cc) * LD1 + C_B + h]));
            gl[cc] = -Aexp * softplusf_(bf2f(P1[(m0 + cc) * LD1 + C_A + h]) + dtb);
        }
        __syncthreads();
        if (role == 3) {
            if (cc < 64) { float acc = 0.f, totl = 0.f;
                for (int i = 0; i < 64; ++i) { const float g = gl[i]; totl += g; if (i <= cc) acc += g; }
                gcs[cc] = acc; eg[cc] = __expf(acc); egl[cc] = __expf(totl - acc);
                if (cc == 0) GLg[u] = __expf(totl);
            } else { const int j = cc - 64; float sq = 0.f, sk = 0.f;
#pragma unroll 16
                for (int cx = 0; cx < 128; ++cx) { sq += sqb[cx * 68 + j]; sk += sqb[(128 + cx) * 68 + j]; }
                qn[j] = rsqrtf(sq + EPS); kn[j] = rsqrtf(sk + EPS); }
        }
        __syncthreads();
        if (role == 0) {
#pragma unroll
            for (int j = 0; j < 64; ++j) { const float qh = x[j] * qn[j]; qb[j * 136 + cc] = (bf16)f2bf(qh); QGg[((size_t)u * 64 + j) * 128 + cc] = (bf16)f2bf(qh * DK_SCALE * eg[j]); }
        } else if (role == 1) {
            bf16* g = KGTg + ((size_t)u * 128 + cc) * 64;
#pragma unroll
            for (int j8 = 0; j8 < 8; ++j8) { float t[8];
#pragma unroll
                for (int q = 0; q < 8; ++q) { const int j = 8 * j8 + q; const float kh = x[j] * kn[j]; kb[j * 136 + cc] = (bf16)f2bf(kh); t[q] = kh * egl[j]; x[j] = kh * bet[j] * eg[j]; }
                *(u32x4*)(g + 8 * j8) = pack8(t); }
        } else if (role == 2) {
#pragma unroll
            for (int j = 0; j < 64; ++j) x[j] *= bet[j];
        }
        __syncthreads();
        for (int ti = w; ti < 32; ti += 8) {
            const bool isq = ti >= 16; const int I = (ti & 15) >> 2, J = ti & 3;
            if (J > I) { if (isq) {
#pragma unroll
                    for (int r = 0; r < 4; ++r) AQKg[((size_t)u * 64 + 16 * I + (lane >> 4) * 4 + r) * 64 + 16 * J + (lane & 15)] = (bf16)0; }
                continue; }
            const bf16* Ab = isq ? qb : kb;
            f32x4 acc = (f32x4){0.f, 0.f, 0.f, 0.f};
#pragma unroll
            for (int ks = 0; ks < 4; ++ks) acc = mfma16(ld8(Ab + (16 * I + (lane & 15)) * 136 + ks * 32 + 8 * (lane >> 4)), ld8(kb + (16 * J + (lane & 15)) * 136 + ks * 32 + 8 * (lane >> 4)), acc);
#pragma unroll
            for (int r = 0; r < 4; ++r) { const int i = 16 * I + (lane >> 4) * 4 + r, j = 16 * J + (lane & 15);
                const float dcy = __expf(fminf(gcs[i] - gcs[j], 0.f));
                if (isq) AQKg[((size_t)u * 64 + i) * 64 + j] = (bf16)f2bf(i >= j ? acc[r] * DK_SCALE * dcy : 0.f);
                else Lm[i * 68 + j] = i > j ? bet[i] * acc[r] * dcy : 0.f; }
        }
        __syncthreads();
        if (role == 1 || role == 2) {
#pragma unroll
            for (int i = 1; i < 64; ++i) { float acc = x[i];
#pragma unroll
                for (int j = 0; j < i; ++j) acc -= Lm[i * 68 + j] * x[j];
                x[i] = acc; }
            if (role == 1) {
#pragma unroll
                for (int i = 0; i < 64; ++i) Wg[((size_t)u * 64 + i) * 128 + cc] = (bf16)f2bf(x[i]);
            } else { float* g = UTg + ((size_t)u * 128 + cc) * 64;
#pragma unroll
                for (int i4 = 0; i4 < 16; ++i4) *(f32x4*)(g + 4 * i4) = (f32x4){x[4 * i4], x[4 * i4 + 1], x[4 * i4 + 2], x[4 * i4 + 3]}; }
        }
        __syncthreads();
    }
}

DEV void phase_gdn_scan(const Ctx& c, int u_first, int u_stride) {
    bf16* wl = (bf16*)c.lds;
    bf16* qgl = wl + 64 * 136;
    bf16* kgT = qgl + 64 * 136;
    bf16* aqk = kgT + 128 * 72;
    bf16* StT = aqk + 64 * 72;
    bf16* vnT = StT + 128 * 136;
    float* ob = (float*)(vnT + 128 * 72);
    const bf16* P1 = c.w<bf16>(WS_P1); bf16* OCAT = c.w<bf16>(WS_OCAT);
    const bf16* Wg = c.w<bf16>(GC_W); const float* UTg = c.w<float>(GC_UT); const bf16* QGg = c.w<bf16>(GC_QG); const bf16* KGTg = c.w<bf16>(GC_KGT); const bf16* AQKg = c.w<bf16>(GC_AQK); const float* GLg = c.w<float>(GC_GL);
    const float* gn = c.in<float>(17);
    const int tid = c.tid, lane = c.lane, w = c.wave;
    constexpr int NU = BATCH * 4;
    for (int u = u_first; u < NU; u += u_stride) {
        const int b = u >> 2, h = u & 3; const size_t mb = (size_t)b * SEQ;
        f32x4 S[8];
#pragma unroll
        for (int et = 0; et < 8; ++et) S[et] = (f32x4){0.f, 0.f, 0.f, 0.f};
        __syncthreads();
        for (int i = tid; i < 128 * 136 / 8; i += 512) { u32x4 z; z.x = z.y = z.z = z.w = 0u; *(u32x4*)(StT + 8 * i) = z; }
        u32x4 pw[2], pq[2], pk[2], pa;
        const size_t cu0 = (size_t)u * NCH;
#define GD_LOAD(n_) do { const bf16* g0 = Wg + (cu0 + (n_)) * 64 * 128; const bf16* g1 = QGg + (cu0 + (n_)) * 64 * 128; const bf16* g2 = KGTg + (cu0 + (n_)) * 128 * 64; const bf16* g3 = AQKg + (cu0 + (n_)) * 64 * 64; \
            _Pragma("unroll") for (int j = 0; j < 2; ++j) { const int idx = tid + 512 * j; pw[j] = *(const u32x4*)(g0 + 8 * idx); pq[j] = *(const u32x4*)(g1 + 8 * idx); pk[j] = *(const u32x4*)(g2 + 8 * idx); } \
            pa = *(const u32x4*)(g3 + 8 * tid); } while (0)
#define GD_STORE_WQ() do { _Pragma("unroll") for (int j = 0; j < 2; ++j) { const int idx = tid + 512 * j; *(u32x4*)(wl + (idx >> 4) * 136 + (idx & 15) * 8) = pw[j]; *(u32x4*)(qgl + (idx >> 4) * 136 + (idx & 15) * 8) = pq[j]; } } while (0)
#define GD_STORE_KA() do { _Pragma("unroll") for (int j = 0; j < 2; ++j) { const int idx = tid + 512 * j; *(u32x4*)(kgT + (idx >> 3) * 72 + (idx & 7) * 8) = pk[j]; } \
            *(u32x4*)(aqk + (tid >> 3) * 72 + (tid & 7) * 8) = pa; } while (0)
        GD_LOAD(0); GD_STORE_WQ(); GD_STORE_KA();
        __syncthreads();
        const int it = w & 3;
        const float gn0 = gn[lane], gn1 = gn[64 + lane];
        f32x4 u4[4]; float dec, decn;
#define GD_LOADU(dst, dd, n_) do { _Pragma("unroll") for (int e4 = 0; e4 < 4; ++e4) { const int et = (w >> 2) * 4 + e4; dst[e4] = *(const f32x4*)(UTg + ((cu0 + (n_)) * 128 + 16 * et + (lane & 15)) * 64 + 16 * it + 4 * (lane >> 4)); } dd = GLg[cu0 + (n_)]; } while (0)
        GD_LOADU(u4, decn, 0);
        for (int n = 0; n < NCH; ++n) {
            dec = decn;
            if (n + 1 < NCH) GD_LOAD(n + 1);
            f32x4 ao[4];
            bf16x8 wa[4], qa[4];
#pragma unroll
            for (int ks = 0; ks < 4; ++ks) { wa[ks] = ld8(wl + (16 * it + (lane & 15)) * 136 + ks * 32 + 8 * (lane >> 4)); qa[ks] = ld8(qgl + (16 * it + (lane & 15)) * 136 + ks * 32 + 8 * (lane >> 4)); }
#pragma unroll
            for (int e4 = 0; e4 < 4; ++e4) { const int et = (w >> 2) * 4 + e4; f32x4 av = (f32x4){0.f, 0.f, 0.f, 0.f}; ao[e4] = (f32x4){0.f, 0.f, 0.f, 0.f};
#pragma unroll
                for (int ks = 0; ks < 4; ++ks) { const bf16x8 bs = ld8(StT + (16 * et + (lane & 15)) * 136 + ks * 32 + 8 * (lane >> 4));
                    av = mfma16(wa[ks], bs, av);
                    ao[e4] = mfma16(qa[ks], bs, ao[e4]); }
                const f32x4 vn = u4[e4] - av;
                u32x2 o; o.x = pk2(vn[0], vn[1]); o.y = pk2(vn[2], vn[3]); *(u32x2*)(vnT + (16 * et + (lane & 15)) * 72 + 16 * it + 4 * (lane >> 4)) = o; }
            if (n + 1 < NCH) GD_LOADU(u4, decn, n + 1);
            LDS_BARRIER();
            float zz0[8], zz1[8];
#pragma unroll
            for (int i8 = 0; i8 < 8; ++i8) { const size_t m = mb + (size_t)n * 64 + w * 8 + i8; zz0[i8] = bf2f(P1[m * LD1 + C_Z + h * 128 + lane]); zz1[i8] = bf2f(P1[m * LD1 + C_Z + h * 128 + 64 + lane]); }
#pragma unroll
            for (int e4 = 0; e4 < 4; ++e4) { const int et = (w >> 2) * 4 + e4;
#pragma unroll
                for (int ks = 0; ks < 2; ++ks) ao[e4] = mfma16(ld8(aqk + (16 * it + (lane & 15)) * 72 + ks * 32 + 8 * (lane >> 4)), ld8(vnT + (16 * et + (lane & 15)) * 72 + ks * 32 + 8 * (lane >> 4)), ao[e4]);
#pragma unroll
                for (int r = 0; r < 4; ++r) ob[(16 * it + (lane >> 4) * 4 + r) * 132 + 16 * et + (lane & 15)] = ao[e4][r]; }
#pragma unroll
            for (int et = 0; et < 8; ++et) { S[et] = S[et] * dec;
#pragma unroll
                for (int ks = 0; ks < 2; ++ks) S[et] = mfma16(ld8(kgT + (16 * w + (lane & 15)) * 72 + ks * 32 + 8 * (lane >> 4)), ld8(vnT + (16 * et + (lane & 15)) * 72 + ks * 32 + 8 * (lane >> 4)), S[et]);
                u32x2 o; o.x = pk2(S[et][0], S[et][1]); o.y = pk2(S[et][2], S[et][3]); *(u32x2*)(StT + (16 * et + (lane & 15)) * 136 + 16 * w + (lane >> 4) * 4) = o; }
            if (n + 1 < NCH) GD_STORE_WQ();
            LDS_BARRIER();
            { float ss[8], v0[8], v1[8];
#pragma unroll
              for (int i8 = 0; i8 < 8; ++i8) { const int i = w * 8 + i8; v0[i8] = ob[i * 132 + lane]; v1[i8] = ob[i * 132 + 64 + lane]; ss[i8] = v0[i8] * v0[i8] + v1[i8] * v1[i8]; }
#pragma unroll
              for (int i8 = 0; i8 < 8; ++i8) ss[i8] = wave_sum(ss[i8]);
#pragma unroll
              for (int i8 = 0; i8 < 8; ++i8) { const size_t m = mb + (size_t)n * 64 + w * 8 + i8; const float r = rsqrtf(ss[i8] * (1.f / 128.f) + EPS);
                OCAT[m * D + h * 128 + lane] = (bf16)f2bf(v0[i8] * r * gn0 * siluf_(zz0[i8])); OCAT[m * D + h * 128 + 64 + lane] = (bf16)f2bf(v1[i8] * r * gn1 * siluf_(zz1[i8])); } }
            if (n + 1 < NCH) GD_STORE_KA();
        }
#undef GD_LOAD
#undef GD_LOADU
#undef GD_STORE_WQ
#undef GD_STORE_KA
        float* So = c.out + O_GDNP + (size_t)(b * 4 + h) * 16384;
#pragma unroll
        for (int et = 0; et < 8; ++et)
#pragma unroll
            for (int r = 0; r < 4; ++r) So[(size_t)(16 * w + (lane >> 4) * 4 + r) * 128 + 16 * et + (lane & 15)] = S[et][r];
    }
}


template <int NT> DEV void softmax_rows(f32x4 (&s)[NT], float (&mrun)[4], float (&lrun)[4], float (&alpha)[4], bf16* Ps, int pitch, int lane) {
#pragma unroll
    for (int r = 0; r < 4; ++r) {
        float mx = s[0][r];
#pragma unroll
        for (int nt = 1; nt < NT; ++nt) mx = fmaxf(mx, s[nt][r]);
        mx = grp16_max(mx);
        const float mn = fmaxf(mrun[r], mx);
        alpha[r] = exp2f_(mrun[r] - mn); mrun[r] = mn;
        float sum = 0.f;
#pragma unroll
        for (int nt = 0; nt < NT; ++nt) { const float p = exp2f_(s[nt][r] - mn); s[nt][r] = p; sum += p; }
        sum = grp16_sum(sum); lrun[r] = lrun[r] * alpha[r] + sum;
    }
#pragma unroll
    for (int nt = 0; nt < NT; ++nt)
#pragma unroll
        for (int r = 0; r < 4; ++r) Ps[((lane >> 4) * 4 + r) * pitch + nt * 16 + (lane & 15)] = (bf16)f2bf(s[nt][r]);
}
DEV bf16x8 ldB_tr(const bf16* T, int pitch, int k0, int n0, int lane) {
    const bf16* p = T + (size_t)(k0 + 8 * (lane >> 4) + ((lane & 15) >> 2)) * pitch + n0 + 4 * (lane & 3);
    const s16x4 a = lds_tr(p), b = lds_tr(p + 4 * pitch);
    bf16x8 r; r[0] = a[0]; r[1] = a[1]; r[2] = a[2]; r[3] = a[3]; r[4] = b[0]; r[5] = b[1]; r[6] = b[2]; r[7] = b[3]; return r;
}
constexpr int AS_NSP = 2;
DEV void phase_attn_sample2(const Ctx& c) {
    bf16* Qs = (bf16*)c.lds;
    bf16* Kt0 = Qs + 64 * 296;
    bf16* Psb = Kt0 + 2 * 32 * 296;
    bf16* qtmp = Kt0;
    float* Xo = (float*)c.lds;
    float* Xm = Xo + 64 * 256; float* Xl = Xm + 64;
    const float* QH = c.w<float>(WS_QH); const float* rope = c.w<float>(WS_ROPE); const bf16* WUKB = c.w<bf16>(WS_WUKB);
    float* PO = c.w<float>(WS_PO); float* PM = c.w<float>(WS_PM); float* PL = c.w<float>(WS_PL);
    const float* clat = c.in<float>(4); const float* ckr = c.in<float>(5); const int* ptab = c.in<int>(7);
    const int tid = c.tid, lane = c.lane, w = c.wave, grp = w >> 2, wq = w & 3, gt = tid & 255;
    bf16* Kt = Kt0 + grp * 32 * 296; bf16* Ps = Psb + w * 16 * 40;
    constexpr int NPT32 = PAST / 32, TPS = NPT32 / AS_NSP;
    static_assert(NPT32 % (2 * AS_NSP) == 0, "tiles per split must be even");
    for (int u = blockIdx.x; u < DECB * AS_NSP; u += gridDim.x) {
        const int b = u / AS_NSP, sp = u % AS_NSP; const size_t mb = (size_t)MP + (size_t)b * DECS;
        __syncthreads();
        for (int idx = tid; idx < 64 * 8; idx += 512) { const int r = idx >> 3, ch = idx & 7, t = r >> 3, h = r & 7; const float* q = QH + (mb + t) * 768 + h * 96 + ch * 8;
            const f32x4 a = *(const f32x4*)q, bq = *(const f32x4*)(q + 4); u32x4 o; o.x = pk2(a[0], a[1]); o.y = pk2(a[2], a[3]); o.z = pk2(bq[0], bq[1]); o.w = pk2(bq[2], bq[3]); *(u32x4*)(qtmp + r * 72 + ch * 8) = o; }
        for (int idx = tid; idx < 64 * 16; idx += 512) { const int r = idx >> 4, f = idx & 15, t = r >> 3, h = r & 7; const float* qrow = QH + (mb + t) * 768 + h * 96 + 64;
            const float* rt = rope + (size_t)(SEQ + t) * 32; const float cs = rt[f], sn = rt[16 + f], x1 = qrow[f], x2 = qrow[16 + f];
            Qs[r * 296 + 256 + f] = (bf16)f2bf((x1 * cs - x2 * sn) * QK_SCALE2); Qs[r * 296 + 272 + f] = (bf16)f2bf((x2 * cs + x1 * sn) * QK_SCALE2); }
        __syncthreads();
        {
            const int h = w; bf16x8 af[2];
#pragma unroll
            for (int ks = 0; ks < 2; ++ks) af[ks] = ld8(qtmp + (((lane & 7)) * 8 + h) * 72 + ks * 32 + 8 * (lane >> 4));
#pragma unroll 4
            for (int nt = 0; nt < 16; ++nt) { f32x4 acc = (f32x4){0.f, 0.f, 0.f, 0.f};
#pragma unroll
                for (int ks = 0; ks < 2; ++ks) acc = mfma16(af[ks], ld8(WUKB + (size_t)(nt * 16 + (lane & 15)) * 512 + h * 64 + ks * 32 + 8 * (lane >> 4)), acc);
                if ((lane >> 4) < 2) {
#pragma unroll
                    for (int r = 0; r < 4; ++r) Qs[(((lane >> 4) * 4 + r) * 8 + h) * 296 + nt * 16 + (lane & 15)] = (bf16)f2bf(acc[r] * QK_SCALE2); } }
        }
        __syncthreads();
        float mrun[4], lrun[4], alpha[4]; f32x4 o[16];
#pragma unroll
        for (int r = 0; r < 4; ++r) { mrun[r] = -INFINITY; lrun[r] = 0.f; }
#pragma unroll
        for (int nt = 0; nt < 16; ++nt) o[nt] = (f32x4){0.f, 0.f, 0.f, 0.f};
        const int t_begin = sp * TPS, t_end = t_begin + TPS + (sp == AS_NSP - 1 ? 1 : 0);
        const int NI = (t_end - t_begin + 1) / 2;
        static_assert(NPAGES <= 64, "page table of one batch row is held one entry per lane");
        const int ptv = lane < NPAGES ? ptab[b * NPAGES + lane] : 0;
#ifdef HIPEMU
#define PT_LOOKUP(pg_) __shfl(ptv, (pg_))
#else
#define PT_LOOKUP(pg_) __builtin_amdgcn_readlane(ptv, (pg_))
#endif
        f32x4 plA[8], prA, plB[8], prB;
        const float* nl = c.out + O_LATS + (size_t)b * DECS * 256; const float* nk = c.out + O_KPES + (size_t)b * DECS * 32;
#define AS_LOAD(pl, pr, tile_) do { const int tl_ = (tile_); \
            if (tl_ < NPT32) { const int k0_ = tl_ * 32; const size_t rb_ = (size_t)PT_LOOKUP(k0_ >> 7) * PAGE + (k0_ & 127); \
                _Pragma("unroll") for (int j = 0; j < 8; ++j) { const int idx = gt + 256 * j; pl[j] = *(const f32x4*)(clat + (rb_ + (idx >> 6)) * 256 + 4 * (idx & 63)); } \
                pr = *(const f32x4*)(ckr + (rb_ + (gt >> 3)) * 32 + 4 * (gt & 7)); } \
            else if (tl_ == NPT32) { \
                _Pragma("unroll") for (int j = 0; j < 8; ++j) { const int idx = gt + 256 * j, key = idx >> 6; pl[j] = key < DECS ? *(const f32x4*)(nl + key * 256 + 4 * (idx & 63)) : (f32x4){0.f, 0.f, 0.f, 0.f}; } \
                pr = (gt >> 3) < DECS ? *(const f32x4*)(nk + (gt >> 3) * 32 + 4 * (gt & 7)) : (f32x4){0.f, 0.f, 0.f, 0.f}; } } while (0)
#define AS_ITER(pl, pr, it_) do { \
            const int tile = t_begin + 2 * (it_) + grp; const bool valid = tile < t_end; \
            if (valid) { \
                _Pragma("unroll") for (int j = 0; j < 8; ++j) { const int idx = gt + 256 * j; u32x2 pk; pk.x = pk2(pl[j][0], pl[j][1]); pk.y = pk2(pl[j][2], pl[j][3]); *(u32x2*)(Kt + (idx >> 6) * 296 + 4 * (idx & 63)) = pk; } \
                { u32x2 pk; pk.x = pk2(pr[0], pr[1]); pk.y = pk2(pr[2], pr[3]); *(u32x2*)(Kt + (gt >> 3) * 296 + 256 + 4 * (gt & 7)) = pk; } \
            } \
            { const int nt_ = tile + 4; AS_LOAD(pl, pr, nt_ < t_end ? nt_ : NPT32 + 1); } \
            LDS_BARRIER(); \
            if (valid) { \
                f32x4 s[2]; \
                _Pragma("unroll") for (int nt = 0; nt < 2; ++nt) { s[nt] = (f32x4){0.f, 0.f, 0.f, 0.f}; \
                    _Pragma("unroll") for (int ks = 0; ks < 9; ++ks) s[nt] = mfma16(ld8(Qs + (wq * 16 + (lane & 15)) * 296 + ks * 32 + 8 * (lane >> 4)), ld8(Kt + (nt * 16 + (lane & 15)) * 296 + ks * 32 + 8 * (lane >> 4)), s[nt]); } \
                if (tile == NPT32) { \
                    _Pragma("unroll") for (int nt = 0; nt < 2; ++nt) \
                        _Pragma("unroll") for (int r = 0; r < 4; ++r) { const int row = wq * 16 + (lane >> 4) * 4 + r, key = nt * 16 + (lane & 15); if (key >= DECS || key > (row >> 3)) s[nt][r] = -INFINITY; } \
                } \
                softmax_rows<2>(s, mrun, lrun, alpha, Ps, 40, lane); \
                WAVE_SYNC(); \
                const bf16x8 pf = ld8(Ps + (lane & 15) * 40 + 8 * (lane >> 4)); \
                if (wave_any((alpha[0] != 1.f) | (alpha[1] != 1.f) | (alpha[2] != 1.f) | (alpha[3] != 1.f))) { \
                    _Pragma("unroll") for (int nt = 0; nt < 16; ++nt) \
                        _Pragma("unroll") for (int r = 0; r < 4; ++r) o[nt][r] *= alpha[r]; } \
                _Pragma("unroll") for (int nt = 0; nt < 16; ++nt) o[nt] = mfma16(pf, ldB_tr(Kt, 296, 0, nt * 16, lane), o[nt]); \
            } \
            LDS_BARRIER(); } while (0)
        AS_LOAD(plA, prA, t_begin + grp < t_end ? t_begin + grp : NPT32 + 1);
        AS_LOAD(plB, prB, t_begin + 2 + grp < t_end ? t_begin + 2 + grp : NPT32 + 1);
#pragma unroll 1
        for (int it = 0; it < NI; it += 2) {
            AS_ITER(plA, prA, it);
            if (it + 1 < NI) AS_ITER(plB, prB, it + 1);
        }
#undef AS_ITER
#undef PT_LOOKUP
#undef AS_LOAD
        int lane2 = lane; OPAQUE_V(lane2);
        if (grp == 1) {
#pragma unroll
            for (int nt = 0; nt < 16; ++nt)
#pragma unroll
                for (int r = 0; r < 4; ++r) Xo[(wq * 16 + (lane2 >> 4) * 4 + r) * 256 + nt * 16 + (lane2 & 15)] = o[nt][r];
            if ((lane2 & 15) == 0) {
#pragma unroll
                for (int r = 0; r < 4; ++r) { Xm[wq * 16 + (lane2 >> 4) * 4 + r] = mrun[r]; Xl[wq * 16 + (lane2 >> 4) * 4 + r] = lrun[r]; } }
        }
        __syncthreads();
        if (grp == 0) {
            float a1[4], a2[4];
#pragma unroll
            for (int r = 0; r < 4; ++r) { const int row = wq * 16 + (lane2 >> 4) * 4 + r; const float m2 = Xm[row], l2 = Xl[row]; const float mm = fmaxf(mrun[r], m2);
                a1[r] = exp2f_(mrun[r] - mm); a2[r] = exp2f_(m2 - mm); lrun[r] = lrun[r] * a1[r] + l2 * a2[r]; mrun[r] = mm;
                if ((lane2 & 15) == 0) { PM[(size_t)u * 64 + row] = mm; PL[(size_t)u * 64 + row] = lrun[r]; } }
#pragma unroll
            for (int nt = 0; nt < 16; ++nt)
#pragma unroll
                for (int r = 0; r < 4; ++r) { const int row = wq * 16 + (lane2 >> 4) * 4 + r, col = nt * 16 + (lane2 & 15); PO[((size_t)u * 64 + row) * 256 + col] = o[nt][r] * a1[r] + Xo[row * 256 + col] * a2[r]; }
        }
    }
}
DEV void phase_attn_sample_combine(const Ctx& c) {
    bf16* Ol = (bf16*)c.lds;
    const float* PO = c.w<float>(WS_PO); const float* PM = c.w<float>(WS_PM); const float* PL = c.w<float>(WS_PL);
    const bf16* WUV = c.w<bf16>(WS_WUKV) + (size_t)512 * 256; bf16* OCAT = c.w<bf16>(WS_OCAT);
    const int tid = c.tid, lane = c.lane, w = c.wave;
    for (int b = (int)gridDim.x - 1 - (int)blockIdx.x; b < DECB; b += gridDim.x) {
        const size_t mb = (size_t)MP + (size_t)b * DECS;
        __syncthreads();
        for (int idx = tid; idx < 64 * 64; idx += 512) { const int row = idx >> 6, c4 = idx & 63;
            float mm = -INFINITY;
#pragma unroll
            for (int s = 0; s < AS_NSP; ++s) mm = fmaxf(mm, PM[((size_t)b * AS_NSP + s) * 64 + row]);
            float lt = 0.f; f32x4 acc = (f32x4){0.f, 0.f, 0.f, 0.f};
#pragma unroll
            for (int s = 0; s < AS_NSP; ++s) { const size_t ur = ((size_t)b * AS_NSP + s) * 64 + row; const float a = exp2f_(PM[ur] - mm); lt += PL[ur] * a; acc += *(const f32x4*)(PO + ur * 256 + 4 * c4) * a; }
            const float inv = 1.f / lt; u32x2 o; o.x = pk2(acc[0] * inv, acc[1] * inv); o.y = pk2(acc[2] * inv, acc[3] * inv); *(u32x2*)(Ol + row * 264 + 4 * c4) = o; }
        __syncthreads();
        { const int h = w;
#pragma unroll
          for (int nt = 0; nt < 4; ++nt) { f32x4 acc = (f32x4){0.f, 0.f, 0.f, 0.f};
#pragma unroll
            for (int ks = 0; ks < 8; ++ks) acc = mfma16(ld8(Ol + ((lane & 7) * 8 + h) * 264 + ks * 32 + 8 * (lane >> 4)), ld8(WUV + (size_t)(h * 64 + nt * 16 + (lane & 15)) * 256 + ks * 32 + 8 * (lane >> 4)), acc);
            if ((lane >> 4) < 2) {
#pragma unroll
                for (int r = 0; r < 4; ++r) OCAT[(mb + (lane >> 4) * 4 + r) * D + 512 + h * 64 + nt * 16 + (lane & 15)] = (bf16)f2bf(acc[r]); } } }
    }
}

DEV bf16x8 cvt8(const f32x4 a, const f32x4 b, float sc) { bf16x8 r; const u32x4 p = {pk2(a[0] * sc, a[1] * sc), pk2(a[2] * sc, a[3] * sc), pk2(b[0] * sc, b[1] * sc), pk2(b[2] * sc, b[3] * sc)};
    r = __builtin_bit_cast(bf16x8, p); return r; }
DEV void phase_attn_prompt2(const Ctx& c) {
    bf16* KV0 = (bf16*)c.lds;
    constexpr int KVB = 64 * 104 + 64 * 72;
    bf16* Psb = KV0 + 2 * KVB;
    const float* QH = c.w<float>(WS_QH); const bf16* KVP = c.w<bf16>(WS_KVP); const bf16* KPEB = c.w<bf16>(WS_KPEB); const float* rope = c.w<float>(WS_ROPE); bf16* OCAT = c.w<bf16>(WS_OCAT);
    const int tid = c.tid, lane = c.lane, w = c.wave;
    bf16* Ps = Psb + w * 32 * 72;
    constexpr int NQB = SEQ / 256, NPU = NQB * BATCH * 8;
    for (;;) {
        const int pu = queue_next(c, 0);
        if (pu >= NPU) break;
        const int qb = NQB - 1 - pu / (BATCH * 8), bh = pu % (BATCH * 8), b = bh >> 3, h = bh & 7; const size_t mb = (size_t)b * SEQ;
        {
            const int q0 = qb * 256, rmin = q0 + 32 * w;
            bf16x8 qf[2][3];
#pragma unroll
            for (int mt = 0; mt < 2; ++mt) { const int qr = rmin + 16 * mt + (lane & 15); const float* qrow = QH + (mb + qr) * 768 + h * 96; const int g = lane >> 4;
#pragma unroll
                for (int ks = 0; ks < 2; ++ks) qf[mt][ks] = cvt8(*(const f32x4*)(qrow + ks * 32 + 8 * g), *(const f32x4*)(qrow + ks * 32 + 8 * g + 4), QK_SCALE2);
                const int f0 = 8 * (g & 1); const float* rt = rope + (size_t)qr * 32;
                const f32x4 x1a = *(const f32x4*)(qrow + 64 + f0), x1b = *(const f32x4*)(qrow + 64 + f0 + 4), x2a = *(const f32x4*)(qrow + 80 + f0), x2b = *(const f32x4*)(qrow + 80 + f0 + 4);
                const f32x4 ca = *(const f32x4*)(rt + f0), cb = *(const f32x4*)(rt + f0 + 4), sa = *(const f32x4*)(rt + 16 + f0), sb = *(const f32x4*)(rt + 16 + f0 + 4);
                const f32x4 ya = g < 2 ? x1a * ca - x2a * sa : x2a * ca + x1a * sa, yb = g < 2 ? x1b * cb - x2b * sb : x2b * cb + x1b * sb;
                qf[mt][2] = cvt8(ya, yb, QK_SCALE2); }
            float mrun[2][4], lrun[2][4], alpha[2][4]; f32x4 o[2][4];
#pragma unroll
            for (int mt = 0; mt < 2; ++mt) {
#pragma unroll
                for (int r = 0; r < 4; ++r) { mrun[mt][r] = -INFINITY; lrun[mt][r] = 0.f; }
#pragma unroll
                for (int nt = 0; nt < 4; ++nt) o[mt][nt] = (f32x4){0.f, 0.f, 0.f, 0.f}; }
            const int nkt = 4 * qb + 4;
            u32x4 pk_, pp_, pv_;
#define AP_LOAD(kt_) do { const size_t kr_ = mb + (size_t)(kt_) * 64; \
                pk_ = *(const u32x4*)(KVP + (kr_ + (tid >> 3)) * 1024 + h * 64 + (tid & 7) * 8); \
                pv_ = *(const u32x4*)(KVP + (kr_ + (tid >> 3)) * 1024 + 512 + h * 64 + (tid & 7) * 8); \
                if (tid < 256) pp_ = *(const u32x4*)(KPEB + (kr_ + (tid >> 2)) * 32 + (tid & 3) * 8); } while (0)
#define AP_STORE(buf_) do { bf16* Kb_ = KV0 + (buf_) * KVB; bf16* Vb_ = Kb_ + 64 * 104; \
                *(u32x4*)(Kb_ + (tid >> 3) * 104 + (tid & 7) * 8) = pk_; *(u32x4*)(Vb_ + (tid >> 3) * 72 + (tid & 7) * 8) = pv_; \
                if (tid < 256) *(u32x4*)(Kb_ + (tid >> 2) * 104 + 64 + (tid & 3) * 8) = pp_; } while (0)
            __syncthreads();
            AP_LOAD(0); AP_STORE(0);
            if (nkt > 1) AP_LOAD(1);
            __syncthreads();
            for (int kt = 0; kt < nkt; ++kt) {
                const bf16* Ks = KV0 + (kt & 1) * KVB; const bf16* Vs = Ks + 64 * 104;
                if (kt + 1 < nkt) AP_STORE((kt + 1) & 1);
                if (kt + 2 < nkt) AP_LOAD(kt + 2);
                const int k0 = kt * 64;
                if (k0 <= rmin + 31) {
                    f32x4 s[2][4];
#pragma unroll
                    for (int nt = 0; nt < 4; ++nt) { s[0][nt] = (f32x4){0.f, 0.f, 0.f, 0.f}; s[1][nt] = (f32x4){0.f, 0.f, 0.f, 0.f};
#pragma unroll
                        for (int ks = 0; ks < 3; ++ks) { const bf16x8 kf = ld8(Ks + (nt * 16 + (lane & 15)) * 104 + ks * 32 + 8 * (lane >> 4));
                            s[0][nt] = mfma16(qf[0][ks], kf, s[0][nt]); s[1][nt] = mfma16(qf[1][ks], kf, s[1][nt]); } }
                    if (k0 + 63 > rmin) {
#pragma unroll
                        for (int mt = 0; mt < 2; ++mt)
#pragma unroll
                            for (int nt = 0; nt < 4; ++nt)
#pragma unroll
                                for (int r = 0; r < 4; ++r) { const int qpos = rmin + 16 * mt + (lane >> 4) * 4 + r, kpos = k0 + nt * 16 + (lane & 15); if (kpos > qpos) s[mt][nt][r] = -INFINITY; }
                    }
                    softmax_rows<4>(s[0], mrun[0], lrun[0], alpha[0], Ps, 72, lane);
                    softmax_rows<4>(s[1], mrun[1], lrun[1], alpha[1], Ps + 16 * 72, 72, lane);
                    WAVE_SYNC();
                    if (wave_any((alpha[0][0] != 1.f) | (alpha[0][1] != 1.f) | (alpha[0][2] != 1.f) | (alpha[0][3] != 1.f) | (alpha[1][0] != 1.f) | (alpha[1][1] != 1.f) | (alpha[1][2] != 1.f) | (alpha[1][3] != 1.f))) {
#pragma unroll
                    for (int mt = 0; mt < 2; ++mt)
#pragma unroll
                        for (int nt = 0; nt < 4; ++nt)
#pragma unroll
                            for (int r = 0; r < 4; ++r) o[mt][nt][r] *= alpha[mt][r]; }
#pragma unroll
                    for (int k2 = 0; k2 < 2; ++k2) { const bf16x8 p0 = ld8(Ps + (lane & 15) * 72 + k2 * 32 + 8 * (lane >> 4)), p1 = ld8(Ps + (16 + (lane & 15)) * 72 + k2 * 32 + 8 * (lane >> 4));
#pragma unroll
                        for (int nt = 0; nt < 4; ++nt) { const bf16x8 vf = ldB_tr(Vs, 72, k2 * 32, nt * 16, lane); o[0][nt] = mfma16(p0, vf, o[0][nt]); o[1][nt] = mfma16(p1, vf, o[1][nt]); } }
                    WAVE_SYNC();
                }
                LDS_BARRIER();
            }
#undef AP_LOAD
#undef AP_STORE
#pragma unroll
            for (int mt = 0; mt < 2; ++mt)
#pragma unroll
                for (int nt = 0; nt < 4; ++nt)
#pragma unroll
                    for (int r = 0; r < 4; ++r) OCAT[(mb + rmin + 16 * mt + (lane >> 4) * 4 + r) * D + 512 + h * 64 + nt * 16 + (lane & 15)] = (bf16)f2bf(o[mt][nt][r] / lrun[mt][r]);
        }
    }
}

#ifndef HIPEMU
#define XB_TMO      128
#define XB_XCNT(j)  (256  + 64 * (j))
#define XB_XSUB(j)  (1280 + 64 * (j))
#define XB_XGEN(j)  (2304 + 64 * (j))
#define XB_TOP      3328
#define XB_TOPGEN   3392
#define XCD_BAR_WORDS 3456
#define XB_SPIN_CAP (1u << 22)
#define LAS __attribute__((address_space(3)))
__device__ __forceinline__ unsigned xb_ld(unsigned* p)              { return __hip_atomic_load(p, __ATOMIC_RELAXED, __HIP_MEMORY_SCOPE_AGENT); }
__device__ __forceinline__ unsigned xb_add(unsigned* p, unsigned v) { return __hip_atomic_fetch_add(p, v, __ATOMIC_RELAXED, __HIP_MEMORY_SCOPE_AGENT); }
__device__ __forceinline__ unsigned xb_xcc_id() { return (unsigned)__builtin_amdgcn_s_getreg((3 << 11) | 20) & 0xFu; }
#define XB_SPIN(cond, bar) do { unsigned _sp = 0; while (cond) { __builtin_amdgcn_s_sleep(1); \
    if ((++_sp & 255u) == 0u) { if (xb_ld(&(bar)[XB_TMO])) break; if (_sp > XB_SPIN_CAP) { atomicAdd(&(bar)[XB_TMO], 1u); break; } } } } while (0)
struct XcdBarrier { unsigned* bar; unsigned x; volatile LAS unsigned* st; bool t0; };
__device__ __forceinline__ XcdBarrier xcd_barrier_post(unsigned* bar, volatile LAS unsigned* st, bool t0) {
    XcdBarrier b; b.bar = bar; b.x = xb_xcc_id(); b.st = st; b.t0 = t0;
    if (t0) (void)xb_add(&bar[XB_XCNT(b.x)], 1u);
    return b;
}
__device__ __forceinline__ void xcd_barrier_complete(unsigned* bar, unsigned x, unsigned& nloc, unsigned& nx) {
    const unsigned G = gridDim.x * gridDim.y * gridDim.z;
    unsigned sum, cnt, mine, sp = 0u;
    for (;;) {
        sum = 0u; cnt = 0u; mine = 0u;
#pragma unroll
        for (unsigned j = 0; j < 16; ++j) { const unsigned c = xb_ld(&bar[XB_XCNT(j)]); sum += c; cnt += (c > 0u) ? 1u : 0u; mine = (j == x) ? c : mine; }
        if (sum == G) break;
        __builtin_amdgcn_s_sleep(1);
        if ((++sp & 255u) == 0u) { if (xb_ld(&bar[XB_TMO])) break; if (sp > XB_SPIN_CAP) { atomicAdd(&bar[XB_TMO], 1u); break; } }
    }
    nloc = mine > 0u ? mine : 1u; nx = cnt > 0u ? cnt : 1u;
}
__device__ __forceinline__ void xcd_barrier(const XcdBarrier& b) {
    asm volatile("s_waitcnt vmcnt(0)" ::: "memory");
    __syncthreads();
    if (b.t0) {
        unsigned* bar = b.bar;
        __builtin_amdgcn_s_waitcnt(0);
        unsigned nloc = b.st[0], nx = b.st[1];
        if (nloc == 0u) { xcd_barrier_complete(bar, b.x, nloc, nx); b.st[0] = nloc; b.st[1] = nx; }
        const unsigned old = xb_add(&bar[XB_XSUB(b.x)], 1u);
        const unsigned gen = old / nloc;
        if (old + 1u == (gen + 1u) * nloc) {
            __builtin_amdgcn_fence(__ATOMIC_RELEASE, "agent");
            asm volatile("s_waitcnt vmcnt(0)" ::: "memory");
            const unsigned og = xb_add(&bar[XB_TOP], 1u);
            const unsigned tg = og / nx;
            if (og + 1u == (tg + 1u) * nx) xb_add(&bar[XB_TOPGEN], 1u);
            else XB_SPIN(xb_ld(&bar[XB_TOPGEN]) == tg, bar);
            __builtin_amdgcn_fence(__ATOMIC_ACQUIRE, "agent");
            xb_add(&bar[XB_XGEN(b.x)], 1u);
            asm volatile("s_waitcnt vmcnt(0)" ::: "memory");
        } else {
            XB_SPIN(xb_ld(&bar[XB_XGEN(b.x)]) == gen, bar);
            __builtin_amdgcn_fence(__ATOMIC_ACQUIRE, "agent");
            asm volatile("s_waitcnt vmcnt(0)" ::: "memory");
        }
    }
    __syncthreads();
}
#endif

__global__ void __launch_bounds__(512, 2) mega_kernel(Params p) {
#ifdef HIPEMU
    unsigned char* lds = g_blk->smem;
#else
    extern __shared__ __attribute__((aligned(16))) unsigned char lds[];
#endif
    const int lo = p.ph_lo, hi = p.ph_hi;
#ifdef HIPEMU
    const int wave_s = threadIdx.x >> 6;
#define FRESH_LANE() ((int)(threadIdx.x & 63))
#define GRID_BAR(k) do { } while (0)
#else
    const int wave_s = __builtin_amdgcn_readfirstlane(threadIdx.x >> 6);
#define FRESH_LANE() ({ int l_; asm volatile("v_mbcnt_lo_u32_b32 %0, -1, 0\n\tv_mbcnt_hi_u32_b32 %0, -1, %0" : "=v"(l_)); l_; })
    { const int l0 = FRESH_LANE(); if (wave_s == 0) ((volatile LAS unsigned*)(lds + LDS_MISC))[l0] = 0u; }
    __syncthreads();
    if (hi - lo > 1) (void)xcd_barrier_post((unsigned*)(p.ws + WS_CTL), (volatile LAS unsigned*)(lds + LDS_MISC), wave_s == 0 && FRESH_LANE() == 0);
#define GRID_BAR(k) do { if (lo <= (k) && (k) + 1 < hi) { XcdBarrier bb_; bb_.bar = (unsigned*)(p.ws + WS_CTL); bb_.x = xb_xcc_id(); bb_.st = (volatile LAS unsigned*)(lds + LDS_MISC); bb_.t0 = (wave_s == 0 && FRESH_LANE() == 0); xcd_barrier(bb_); } } while (0)
#endif
#define MKCTX() Ctx c; c.p = &p; c.lds = lds; c.ws = p.ws; c.out = p.out; c.wave = wave_s; c.lane = FRESH_LANE(); c.tid = wave_s * 64 + c.lane; c.gw = blockIdx.x * 8 + wave_s; c.ngw = gridDim.x * 8;
#define IN(k) (lo <= (k) && (k) < hi)
#ifndef PROBE_MASK
#define PROBE_MASK 0u
#endif
#define NREP(k) (((PROBE_MASK >> (k)) & 1u) ? 2 : 1)
#ifndef PROBE_SUB
#define PROBE_SUB 0
#endif
#define SUB(id, ...) { MKCTX() __VA_ARGS__ } if (PROBE_SUB == (id)) { __syncthreads(); MKCTX() __VA_ARGS__ }
#define PHASE(k, ...) if (IN(k)) { { MKCTX() __VA_ARGS__ } if (NREP(k) == 2) { MKCTX() __VA_ARGS__ } }
#define X1 c.w<float>(WS_X1)
#define X2 c.w<float>(WS_X2)
#define P1 c.w<float>(WS_P1)
#define XN c.w<bf16>(WS_XN)
#define Hb c.w<bf16>(WS_H)
#define OCAT c.w<bf16>(WS_OCAT)

    PHASE(0,  phase_prologue(c); GRID_BAR(0); )
    PHASE(1,  run_gemm(c, XN, c.w<bf16>(WS_WINAB), M, LD1, D, EpiBf16<0>{c.w<bf16>(WS_P1), LD1}); GRID_BAR(1); )
    PHASE(2,  phase_prep0(c); GRID_BAR(2); )
    PHASE(3,          { run_gemm(c, c.w<bf16>(WS_CQN), c.w<bf16>(WS_WUQ), M, 768, 256, EpiStoreF32{c.w<float>(WS_QH), 768}); } { MKCTX() run_gemm(c, c.w<bf16>(WS_LATN), c.w<bf16>(WS_WUKV), MP, 1024, 256, EpiBf16<0>{c.w<bf16>(WS_KVP), 1024}); }         GRID_BAR(3); )
    PHASE(4,  { if ((blockIdx.x & 1) == 0) { MKCTX() phase_attn_sample2(c); } } __syncthreads(); { MKCTX() phase_gdn_prep(c); } __syncthreads(); { MKCTX() phase_gdn_naive(c, BATCH * 4); } __syncthreads();
               { if ((blockIdx.x & 1) != 0) { MKCTX() phase_attn_sample2(c); } } GRID_BAR(4); )
    PHASE(5,  SUB(4, phase_gdn_scan(c, blockIdx.x, gridDim.x);) __syncthreads(); SUB(5, phase_attn_sample_combine(c);) __syncthreads(); SUB(6, phase_attn_prompt2(c);) GRID_BAR(5); )
    PHASE(6,  { run_gemm(c, OCAT, c.w<bf16>(WS_WOAB), MP, D, D, EpiResidF32{nullptr, c.in<float>(0), c.in<float>(1), X1}); } { MKCTX() run_gemm_sample_splitk(c, OCAT, c.w<bf16>(WS_WOAB), D, 256); } GRID_BAR(6); )
    PHASE(7,  phase_rmsnorm(c, X1, c.in<float>(9), nullptr, 4); GRID_BAR(7); )
    PHASE(8,  run_gemm(c, XN, c.w<bf16>(WS_WUP0), M, FF, D, EpiBf16<1>{Hb, FF}); GRID_BAR(8); )
    PHASE(9,  { run_gemm(c, Hb, c.w<bf16>(WS_WDN0), MP, D, FF, EpiResidF32{X1, nullptr, nullptr, X2}); } { MKCTX() run_gemm_sample_splitk(c, Hb, c.w<bf16>(WS_WDN0), FF, 256); } GRID_BAR(9); )
    PHASE(10,  phase_rmsnorm(c, X2, c.in<float>(8) + D, X1, 16); GRID_BAR(10); )
    PHASE(11,  run_gemm(c, XN, c.w<bf16>(WS_WINC), M, INC, D, EpiBf16<0>{c.w<bf16>(WS_P1), INC}); GRID_BAR(11); )
    PHASE(12,  SUB(7, phase_hgrn_prep(c);) GRID_BAR(12); )
    PHASE(13,  phase_hgrn_prefix(c); __syncthreads(); SUB(8, phase_hgrn_naive(c, BATCH * 8, (int)blockIdx.x, (int)gridDim.x);) GRID_BAR(13); )
    PHASE(14,  phase_hgrn_out(c); GRID_BAR(14); )
    PHASE(15,  { run_gemm(c, OCAT, c.w<bf16>(WS_WOC), MP, D, D, EpiResidF32{X2, nullptr, nullptr, X1}); } { MKCTX() run_gemm_sample_splitk(c, OCAT, c.w<bf16>(WS_WOC), D, 256); } GRID_BAR(15); )
    PHASE(16,  phase_rmsnorm(c, X1, c.in<float>(9) + D, X2, 4); GRID_BAR(16); )
    PHASE(17,  run_gemm(c, XN, c.w<bf16>(WS_WUP1), M, FF, D, EpiBf16<1>{Hb, FF}); GRID_BAR(17); )
    PHASE(18,  { run_gemm(c, Hb, c.w<bf16>(WS_WDN1), MP, D, FF, EpiResidF32{X1, nullptr, nullptr, X2}); } { MKCTX() run_gemm_sample_splitk(c, Hb, c.w<bf16>(WS_WDN1), FF, 256); } GRID_BAR(18); )
    PHASE(19,  phase_final(c, X2, c.in<float>(10), X1, 16); )
#undef IN
#undef X1
#undef X2
#undef P1
#undef XN
#undef Hb
#undef OCAT
}

#ifndef HIPEMU
extern "C" void kernel_launch(void* const* d_in, const int* in_sizes, int n_in, void* d_out, int out_size, void* d_ws, size_t ws_size, hipStream_t stream) {
    static int grid = 0;
    if (grid == 0) {
        if (n_in != 28 || (size_t)out_size != O_END || ws_size < WS_END) { fprintf(stderr, "kernel_launch: shape mismatch n_in %d out %d (want %zu) ws %zu (want %zu)\n", n_in, out_size, (size_t)O_END, ws_size, (size_t)WS_END); grid = -1; return; }
        int dev = 0, cus = 0, per_cu = 0;
        hipGetDevice(&dev); hipDeviceGetAttribute(&cus, hipDeviceAttributeMultiprocessorCount, dev);
        if (hipFuncSetAttribute((const void*)mega_kernel, hipFuncAttributeMaxDynamicSharedMemorySize, LDS_BYTES) != hipSuccess) { fprintf(stderr, "kernel_launch: hipFuncSetAttribute failed\n"); grid = -1; return; }
        if (hipOccupancyMaxActiveBlocksPerMultiprocessor(&per_cu, (const void*)mega_kernel, 512, LDS_BYTES) != hipSuccess || per_cu < 1) fprintf(stderr, "kernel_launch: occupancy query reports %d\n", per_cu);
        (void)hipGetLastError();
        grid = cus;
    }
    if (grid < 0) return;
    hipMemsetAsync((char*)d_ws + WS_CTL, 0, CTL_BYTES, stream);
    Params p{};
    for (int i = 0; i < 28; ++i) p.in[i] = d_in[i];
    p.out = (float*)d_out; p.ws = (unsigned char*)d_ws;
#if MK_N_LAUNCHES == 1
    p.ph_lo = 0; p.ph_hi = NPHASE;
    hipLaunchKernelGGL(mega_kernel, dim3(grid), dim3(512), LDS_BYTES, stream, p);
#else
    for (int k = 0; k < NPHASE; ++k) { p.ph_lo = k; p.ph_hi = k + 1; hipLaunchKernelGGL(mega_kernel, dim3(grid), dim3(512), LDS_BYTES, stream, p); }
#endif
}
#else
size_t emu_ws_bytes() { return WS_END; }
size_t emu_out_floats() { return O_END; }
void emu_forward(void* const* d_in, float* d_out, unsigned char* d_ws, int grid, int ph_from, int ph_to) {
    memset(d_ws + WS_CTL, 0, CTL_BYTES);
    Params p{};
    for (int i = 0; i < 28; ++i) p.in[i] = d_in[i];
    p.out = d_out; p.ws = d_ws;
    for (int k = ph_from; k < ph_to && k < NPHASE; ++k) { p.ph_lo = k; p.ph_hi = k + 1; fprintf(stderr, "[emu] phase %d\n", k); emu_launch(grid, 512, LDS_BYTES, [=]() { mega_kernel(p); }); }
}
struct EmuBuf { const char* name; size_t off; size_t bytes; int kind;   int ld; };
extern const EmuBuf emu_bufs[] = {
    {"P1", WS_P1, (size_t)M * 4096 * 4, 0, LD1}, {"XN", WS_XN, (size_t)M * D * 2, 1, D}, {"QH", WS_QH, (size_t)M * 768 * 4, 0, 768}, {"KVP", WS_KVP, (size_t)MP * 1024 * 2, 1, 1024},
    {"OCAT", WS_OCAT, (size_t)M * D * 2, 1, D}, {"ORAW", WS_ORAW, (size_t)M * D * 4, 0, D}, {"X1", WS_X1, (size_t)M * D * 4, 0, D}, {"X2", WS_X2, (size_t)M * D * 4, 0, D},
    {"H", WS_H, (size_t)M * FF * 2, 1, FF}, {"CQN", WS_CQN, (size_t)M * 256 * 2, 1, 256}, {"LATN", WS_LATN, (size_t)M * 256 * 2, 1, 256}, {nullptr, 0, 0, 0, 0}};
extern const int emu_cfg[8] = {BATCH, SEQ, DECB, PAST, MP, MS, MT, M};
#endif
```

```cpp
#ifdef HIPEMU
#include "hipemu.h"
#else
#include <hip/hip_runtime.h>
#endif
#include <cstdio>
#include <cstdint>

#ifndef CFG_BATCH
#define CFG_BATCH 8
#define CFG_SEQ 2048
#define CFG_DEC_BATCH 128
#define CFG_PAST_LEN 8192
#endif
#ifndef MK_N_LAUNCHES
#define MK_N_LAUNCHES 1
#endif

#define DEV __device__ __forceinline__
namespace pg8 {
#define PG8_LAS __attribute__((address_space(3)))
typedef unsigned short bf16_t;
typedef short bf16x8 __attribute__((ext_vector_type(8)));
typedef float f32x4 __attribute__((ext_vector_type(4)));
typedef unsigned u32x4 __attribute__((ext_vector_type(4)));
constexpr int BM = 256, BK = 64, HALF = 128, HTB = HALF * BK * 2  , STAGE_BYTES = 8 * HTB, NXCD = 8, WGM = 8;

__host__ __device__ __forceinline__ int lds_byte(int r, int c) { const int st = (r >> 4) * 2 + (c >> 5), rr = r & 15, cc = c & 31, ob = rr * 64 + cc * 2; return st * 1024 + (ob ^ (((ob >> 9) & 1) << 5)); }
__host__ __device__ __forceinline__ void stage_rc(int b, int& R, int& C) { const int st = b / 1024, sb = b % 1024, swz = sb ^ (((sb >> 9) & 1) << 5); R = (st >> 1) * 16 + swz / 64; C = (st & 1) * 32 + (swz % 64) / 2; }
__host__ __device__ __forceinline__ int perm32(int rho) { const int n = rho >> 4, i = rho & 15; return 8 * (i >> 2) + 4 * n + (i & 3); }

struct Unit { int pm, pn, kb; };
struct Gemm { const bf16_t* A; const bf16_t* Bt; int M, N, K, ld; };

struct StaticOrder {
    int nM, nN, nwg, G, c;
    __host__ __device__ void init(int M, int N, int G_, int c_) { nM = M / BM; nN = N / BM; nwg = nM * nN; G = G_; c = c_; }
    __host__ __device__ bool next(int i, Unit& u) const {
        const long L = (long)i * G + c; if (L >= nwg) return false;
        int wgid = (int)L; { const int q = nwg / NXCD, r = nwg % NXCD, xcd = wgid % NXCD, off = wgid / NXCD; wgid = (xcd < r ? xcd * (q + 1) : r * (q + 1) + (xcd - r) * q) + off; }
        const int nig = WGM * nN, gid = wgid / nig, fm = gid * WGM, gsz = (nM - fm) < WGM ? (nM - fm) : WGM;
        u.pm = fm + ((wgid % nig) % gsz); u.pn = (wgid % nig) / gsz; u.kb = 0; return true;
    }
    __device__ __forceinline__ void a_ready(const Unit&) const {}
    __device__ __forceinline__ void done(const Unit&) const {}
};

#ifndef HIPEMU
template <class Epi, class Sched, bool ALIGN_EPI = false, bool SP2 = false>
__device__ __forceinline__ void gemm_phase(PG8_LAS unsigned char* lds, const Gemm g, const Sched& S, const Epi& E, const int wid_in, const int lane_in) {
    const int wid = __builtin_amdgcn_readfirstlane(wid_in), lane = lane_in, tid = wid * 64 + lane, wr = wid >> 2, wc = wid & 3, fr = lane & 15, fq = lane >> 4;
    const int K = g.K, nt = K / BK, LDK = g.ld;
    unsigned voffA[2], voffB[2];
#pragma unroll
    for (int i = 0; i < 2; ++i) { int R, C; stage_rc(tid * 16 + i * 8192, R, C); const int Rb = Epi::PERM ? ((R & ~31) + perm32(R & 31)) : R;
        voffA[i] = (unsigned)(R * LDK + C) * 2u; voffB[i] = (unsigned)(Rb * LDK + C) * 2u; }
    const size_t kstep = (size_t)(BK * 2);
    const size_t hstep = (size_t)HALF * LDK * 2;
    const size_t tstep = 2 * hstep;
    const unsigned ldsw = (unsigned)wid * 1024u;
    const int aoff = lds_byte(wr * 64 + fr, fq * 8), boff = lds_byte(wc * 32 + fr, fq * 8);
#define PG8_SA(b, h) (((b) * 2 + (h)) * HTB)
#define PG8_SB(b, h) ((4 + (b) * 2 + (h)) * HTB)
#define PG8_STAGE(bufoff, gbase, voff) do { _Pragma("unroll") for (int _i = 0; _i < 2; ++_i) \
        __builtin_amdgcn_global_load_lds((const unsigned*)((const char*)(gbase) + (voff)[_i]), (PG8_LAS unsigned*)(lds + (bufoff) + ldsw + _i * 8192), 16, 0, 0); } while (0)
#define PG8_LDA(dst, b, h) do { _Pragma("unroll") for (int m = 0; m < 4; ++m) _Pragma("unroll") for (int k = 0; k < 2; ++k) dst[m][k] = *(const PG8_LAS bf16x8*)(lds + PG8_SA(b, h) + aoff + m * 2048 + k * 1024); } while (0)
#define PG8_LDB(dst, b, h) do { _Pragma("unroll") for (int n = 0; n < 2; ++n) _Pragma("unroll") for (int k = 0; k < 2; ++k) dst[n][k] = *(const PG8_LAS bf16x8*)(lds + PG8_SB(b, h) + boff + n * 2048 + k * 1024); } while (0)
#define PG8_MMA(ai, bj, At, Bt) do { __builtin_amdgcn_s_setprio(1); _Pragma("unroll") for (int m = 0; m < 4; ++m) _Pragma("unroll") for (int n = 0; n < 2; ++n) _Pragma("unroll") for (int k = 0; k < 2; ++k) \
        acc[ai][bj][m][n] = __builtin_amdgcn_mfma_f32_16x16x32_bf16(Bt[n][k], At[m][k], acc[ai][bj][m][n], 0, 0, 0); __builtin_amdgcn_s_setprio(0); } while (0)
#define PG8_WAIT_V(n) asm volatile("s_waitcnt vmcnt(" #n ")" ::: "memory")
#define PG8_WAIT_L(n) asm volatile("s_waitcnt lgkmcnt(" #n ")" ::: "memory")
#define PG8_BAR __builtin_amdgcn_s_barrier()
#define PG8_SCHED __builtin_amdgcn_sched_barrier(0)
    Unit cur, nxt; int ui = 0;
    if (!S.next(0, cur)) return;
    f32x4 acc[2][2][4][2];
#pragma unroll
    for (int a = 0; a < 2; ++a)
#pragma unroll
        for (int b = 0; b < 2; ++b)
#pragma unroll
            for (int m = 0; m < 4; ++m)
#pragma unroll
                for (int n = 0; n < 2; ++n) acc[a][b][m][n] = (f32x4){0.f, 0.f, 0.f, 0.f};
    bf16x8 At[4][2], B0[2][2], B1[2][2];
    const char* cA = (const char*)g.A + (size_t)cur.pm * tstep + (size_t)cur.kb * K * 2; const char* cB = (const char*)g.Bt + (size_t)cur.pn * tstep + (size_t)cur.kb * K * 2;
    S.a_ready(cur);
    if constexpr (SP2) {
        PG8_STAGE(PG8_SB(0, 0), cB, voffB); PG8_STAGE(PG8_SB(0, 1), cB + hstep, voffB); PG8_STAGE(PG8_SA(0, 0), cA, voffA); PG8_STAGE(PG8_SA(0, 1), cA + hstep, voffA);
        if (wr == 1) PG8_BAR;
        PG8_WAIT_V(2); PG8_BAR;
        PG8_STAGE(PG8_SB(1, 0), cB + kstep, voffB); PG8_STAGE(PG8_SA(1, 0), cA + kstep, voffA); PG8_STAGE(PG8_SB(1, 1), cB + hstep + kstep, voffB);
        PG8_WAIT_V(6); PG8_BAR;
    } else {
        PG8_STAGE(PG8_SB(0, 0), cB, voffB); PG8_STAGE(PG8_SA(0, 0), cA, voffA); PG8_STAGE(PG8_SB(0, 1), cB + hstep, voffB); PG8_STAGE(PG8_SA(0, 1), cA + hstep, voffA);
        if (wr == 1) PG8_BAR;
        PG8_WAIT_V(4); PG8_BAR;
        PG8_STAGE(PG8_SB(1, 0), cB + kstep, voffB); PG8_STAGE(PG8_SA(1, 0), cA + kstep, voffA); PG8_STAGE(PG8_SB(1, 1), cB + hstep + kstep, voffB);
        PG8_WAIT_V(6); PG8_BAR;
    }
    for (;;) {
        const bool has_next = S.next(ui + 1, nxt);
        const char* nA = has_next ? (const char*)g.A + (size_t)nxt.pm * tstep + (size_t)nxt.kb * K * 2 : cA; const char* nB = has_next ? (const char*)g.Bt + (size_t)nxt.pn * tstep + (size_t)nxt.kb * K * 2 : cB;
        for (int t = 0; t < nt; t += 2) {
            const bool last = (t == nt - 2);
            const char* a1 = cA + (size_t)(t + 1) * kstep;
            const char* a2 = last ? nA : cA + (size_t)(t + 2) * kstep; const char* b2 = last ? nB : cB + (size_t)(t + 2) * kstep;
            const char* a3 = a2 + kstep; const char* b3 = b2 + kstep;
            if (last && has_next) S.a_ready(nxt);
            if constexpr (SP2) {
            PG8_LDB(B0, 0, 0); PG8_LDB(B1, 0, 1); PG8_SCHED; PG8_LDA(At, 0, 0); PG8_STAGE(PG8_SA(1, 1), a1 + hstep, voffA);
            PG8_WAIT_V(8); PG8_WAIT_L(0); PG8_BAR; PG8_MMA(0, 0, At, B0); PG8_MMA(0, 1, At, B1); PG8_BAR; PG8_SCHED;
            PG8_LDA(At, 0, 1); PG8_STAGE(PG8_SB(0, 0), b2, voffB); PG8_STAGE(PG8_SB(0, 1), b2 + hstep, voffB); PG8_STAGE(PG8_SA(0, 0), a2, voffA);
            PG8_WAIT_V(8); PG8_WAIT_L(0); PG8_BAR; PG8_MMA(1, 0, At, B0); PG8_MMA(1, 1, At, B1); PG8_BAR; PG8_SCHED;
            PG8_LDB(B0, 1, 0); PG8_LDB(B1, 1, 1); PG8_SCHED; PG8_LDA(At, 1, 0); PG8_STAGE(PG8_SA(0, 1), a2 + hstep, voffA);
            PG8_WAIT_V(8); PG8_WAIT_L(0); PG8_BAR; PG8_MMA(0, 0, At, B0); PG8_MMA(0, 1, At, B1); PG8_BAR; PG8_SCHED;
            PG8_LDA(At, 1, 1); PG8_STAGE(PG8_SB(1, 0), b3, voffB); PG8_STAGE(PG8_SB(1, 1), b3 + hstep, voffB); PG8_STAGE(PG8_SA(1, 0), a3, voffA);
            PG8_WAIT_V(8); PG8_WAIT_L(0); PG8_BAR; PG8_MMA(1, 0, At, B0); PG8_MMA(1, 1, At, B1); PG8_BAR; PG8_SCHED;
            } else {
            PG8_LDB(B0, 0, 0); PG8_SCHED; PG8_LDA(At, 0, 0); PG8_STAGE(PG8_SA(1, 1), a1 + hstep, voffA);
            PG8_WAIT_L(8); PG8_BAR; PG8_WAIT_L(0); PG8_MMA(0, 0, At, B0); PG8_BAR; PG8_SCHED;
            PG8_LDB(B1, 0, 1); PG8_STAGE(PG8_SB(0, 0), b2, voffB);
            PG8_BAR; PG8_WAIT_L(0); PG8_MMA(0, 1, At, B1); PG8_BAR;
            PG8_LDA(At, 0, 1); PG8_STAGE(PG8_SA(0, 0), a2, voffA);
            PG8_BAR; PG8_WAIT_L(0); PG8_MMA(1, 0, At, B0); PG8_BAR; PG8_SCHED;
            PG8_STAGE(PG8_SB(0, 1), b2 + hstep, voffB);
            PG8_WAIT_V(6); PG8_BAR; PG8_MMA(1, 1, At, B1); PG8_BAR;
            PG8_LDB(B0, 1, 0); PG8_SCHED; PG8_LDA(At, 1, 0); PG8_STAGE(PG8_SA(0, 1), a2 + hstep, voffA);
            PG8_WAIT_L(8); PG8_BAR; PG8_WAIT_L(0); PG8_MMA(0, 0, At, B0); PG8_BAR; PG8_SCHED;
            PG8_LDB(B1, 1, 1); PG8_STAGE(PG8_SB(1, 0), b3, voffB);
            PG8_BAR; PG8_WAIT_L(0); PG8_MMA(0, 1, At, B1); PG8_BAR;
            PG8_LDA(At, 1, 1); PG8_STAGE(PG8_SA(1, 0), a3, voffA);
            PG8_BAR; PG8_WAIT_L(0); PG8_MMA(1, 0, At, B0); PG8_BAR; PG8_SCHED;
            PG8_STAGE(PG8_SB(1, 1), b3 + hstep, voffB);
            PG8_WAIT_V(6); PG8_BAR; PG8_MMA(1, 1, At, B1); PG8_BAR;
            }
        }
        if constexpr (ALIGN_EPI) { if (wr == 0) PG8_BAR; }
        if constexpr (!Epi::AFTER_DRAIN) { E(acc, cur, wr, wc, fr, fq); S.done(cur); }
        if (!has_next) break;
#pragma unroll
        for (int a = 0; a < 2; ++a)
#pragma unroll
            for (int b = 0; b < 2; ++b)
#pragma unroll
                for (int m = 0; m < 4; ++m)
#pragma unroll
                    for (int n = 0; n < 2; ++n) acc[a][b][m][n] = (f32x4){0.f, 0.f, 0.f, 0.f};
        cur = nxt; cA = nA; cB = nB; ++ui;
        if constexpr (ALIGN_EPI) { if (wr == 1) PG8_BAR; }
    }
    PG8_WAIT_V(0);
    if constexpr (!ALIGN_EPI) { if (wr == 0) PG8_BAR; }
    PG8_BAR;
    if constexpr (Epi::AFTER_DRAIN) { E.fused(acc, cur, wr, wc, fr, fq, lds, wid, lane); S.done(cur); }
#undef PG8_SA
#undef PG8_SB
#undef PG8_STAGE
#undef PG8_LDA
#undef PG8_LDB
#undef PG8_MMA
#undef PG8_WAIT_V
#undef PG8_WAIT_L
#undef PG8_BAR
#undef PG8_SCHED
}
}

#else
}
#endif

constexpr int D = 1024, BATCH = CFG_BATCH, SEQ = CFG_SEQ, DECB = CFG_DEC_BATCH, DECS = 8, PAST = CFG_PAST_LEN, PAGE = 128;
constexpr int MP = BATCH * SEQ, MS = DECB * DECS, MT = MP + MS, M = (MT + 255) / 256 * 256;
constexpr int NPAGES = PAST / PAGE;
constexpr int QKV_A = 1536, IN_AB = 2600, LD1 = 2816, FF = 4096, INC = 4096;
constexpr int C_Z = 1536, C_B = 2048, C_A = 2052, C_CQ = 2056, C_CKV = 2312, C_KPE = 2568;
constexpr float EPS = 1e-6f;
constexpr float MLA_SCALE = 0.10206207261596575f;
constexpr float DK_SCALE = 0.08838834764831845f;
static_assert(MP % 256 == 0 && SEQ % 128 == 0 && PAST % 128 == 0, "shape assumptions");

constexpr size_t O_YP = 0, O_YS = O_YP + (size_t)MP * D, O_GDNP = O_YS + (size_t)MS * D, O_CONVP = O_GDNP + (size_t)BATCH * 4 * 16384,
    O_LATP = O_CONVP + (size_t)BATCH * 3 * QKV_A, O_KPEP = O_LATP + (size_t)MP * 256, O_HGP = O_KPEP + (size_t)MP * 32,
    O_GDNS = O_HGP + (size_t)BATCH * 8 * 16384, O_CONVS = O_GDNS + (size_t)DECB * 4 * 16384, O_LATS = O_CONVS + (size_t)DECB * 3 * QKV_A,
    O_KPES = O_LATS + (size_t)MS * 256, O_HGS = O_KPES + (size_t)MS * 32, O_END = O_HGS + (size_t)DECB * 8 * 16384;

constexpr size_t al256(size_t x) { return (x + 255) & ~(size_t)255; }
constexpr size_t WS_CTL = 0, CTL_BYTES = 65536;
constexpr size_t WS_WINAB = CTL_BYTES,                      WS_WUP0 = WS_WINAB + (size_t)LD1 * D * 2,
    WS_WUP1 = WS_WUP0 + (size_t)FF * D * 2,                 WS_WDN0 = WS_WUP1 + (size_t)FF * D * 2,
    WS_WDN1 = WS_WDN0 + (size_t)FF * D * 2,                 WS_WINC = WS_WDN1 + (size_t)FF * D * 2,
    WS_WOAB = WS_WINC + (size_t)INC * D * 2,                WS_WOC = WS_WOAB + (size_t)D * D * 2,
    WS_WUQ = WS_WOC + (size_t)D * D * 2,                    WS_WUKV = WS_WUQ + (size_t)768 * 256 * 2,
    WS_ROPE = WS_WUKV + (size_t)1024 * 256 * 2,             WS_XN = al256(WS_ROPE + (size_t)(SEQ + 8) * 32 * 4),
    WS_P1 = WS_XN + (size_t)M * D * 2,                      WS_CQN = WS_P1 + (size_t)M * 4096 * 4,
    WS_LATN = WS_CQN + (size_t)M * 256 * 2,                 WS_QH = WS_LATN + (size_t)M * 256 * 2,
    WS_KVP = WS_QH + (size_t)M * 768 * 4,                   WS_OCAT = WS_KVP + (size_t)MP * 1024 * 2,
    WS_ORAW = WS_OCAT + (size_t)M * D * 2,                  WS_X1 = WS_ORAW + (size_t)M * D * 4,
    WS_X2 = WS_X1 + (size_t)M * D * 4,                      WS_H = WS_X2 + (size_t)M * D * 4,
    WS_WUKB = WS_H + (size_t)M * FF * 2,                    WS_PO = WS_WUKB + (size_t)256 * 512 * 2,
    WS_PM = WS_PO + (size_t)DECB * 2 * 64 * 256 * 4,        WS_PL = WS_PM + (size_t)DECB * 2 * 64 * 4,
    WS_KPEB = WS_PL + (size_t)DECB * 2 * 64 * 4,            WS_PART = al256(WS_KPEB + (size_t)MP * 32 * 2),
    WS_END = WS_PART + (size_t)16 * (M - MP) * D * 4;
constexpr size_t WS_H_END = WS_H + (size_t)M * FF * 2;

constexpr int LDS_BYTES = 155648;
constexpr int LDS_MISC = 155648 - 256;
constexpr int NPHASE = 20;

typedef unsigned short bf16;
typedef unsigned u32x4 __attribute__((ext_vector_type(4)));
typedef unsigned u32x2 __attribute__((ext_vector_type(2)));
#ifndef HIPEMU
typedef short bf16x8 __attribute__((ext_vector_type(8)));
typedef float f32x4 __attribute__((ext_vector_type(4)));
#endif

#ifdef HIPEMU
DEV unsigned f2bf(float f) { unsigned u = __float_as_uint(f); return (u + 0x7fffu + ((u >> 16) & 1u)) >> 16; }
#else
DEV unsigned f2bf(float f) { return (unsigned)__builtin_bit_cast(unsigned short, (__bf16)f); }
#endif
#ifdef HIPEMU
DEV unsigned pk2(float lo, float hi) { return f2bf(lo) | (f2bf(hi) << 16); }
#else
typedef float f32x2_t __attribute__((ext_vector_type(2))); typedef __bf16 bf16x2_t __attribute__((ext_vector_type(2)));
DEV unsigned pk2(float lo, float hi) { f32x2_t v = {lo, hi}; bf16x2_t b = __builtin_convertvector(v, bf16x2_t); return __builtin_bit_cast(unsigned, b); }
#endif
DEV float bf2f(bf16 b) { return __uint_as_float(((unsigned)b) << 16); }
DEV float sigmoidf_(float x) { return 1.0f / (1.0f + __expf(-x)); }
DEV float siluf_(float x) { return x / (1.0f + __expf(-x)); }
DEV float softplusf_(float x) { return fmaxf(x, 0.f) + log1pf(__expf(-fabsf(x))); }
#ifdef HIPEMU
DEV f32x4 mfma16(bf16x8 a, bf16x8 b, f32x4 c) { return emu_mfma16(a, b, c); }
#define WAVE_SYNC() emu_wave_sync()
#define OPAQUE_V(x) do { } while (0)
#define LDS_BARRIER() __syncthreads()
DEV s16x4 lds_tr(const unsigned short* p) { return emu_lds_tr((const void*)p); }
#else
typedef short s16x4 __attribute__((ext_vector_type(4)));
DEV s16x4 lds_tr(const unsigned short* p) { return __builtin_bit_cast(s16x4, __builtin_amdgcn_ds_read_tr16_b64_v4i16((__attribute__((address_space(3))) s16x4*)p)); }
DEV f32x4 mfma16(bf16x8 a, bf16x8 b, f32x4 c) { return __builtin_amdgcn_mfma_f32_16x16x32_bf16(a, b, c, 0, 0, 0); }
#define WAVE_SYNC() asm volatile("s_waitcnt lgkmcnt(0)" ::: "memory")
#define OPAQUE_V(x) asm volatile("" : "+v"(x))
#define LDS_BARRIER() asm volatile("s_waitcnt lgkmcnt(0)\n\ts_barrier" ::: "memory")
#endif
DEV f32x4 ld4bf(const unsigned short* p) { const u32x2 u = *(const u32x2*)p; return (f32x4){__uint_as_float(u.x << 16), __uint_as_float(u.x & 0xffff0000u), __uint_as_float(u.y << 16), __uint_as_float(u.y & 0xffff0000u)}; }
constexpr float QK_SCALE2 = MLA_SCALE * 1.4426950408889634f;
#ifdef HIPEMU
DEV float exp2f_(float x) { return exp2f(x); }
DEV bool wave_any(bool p) { int v = p ? 1 : 0;
    for (int o = 1; o < 64; o <<= 1) v |= __shfl_xor(v, o);
    return v != 0; }
#else
DEV float exp2f_(float x) { return __builtin_amdgcn_exp2f(x); }
DEV bool wave_any(bool p) { return __builtin_amdgcn_ballot_w64(p) != 0ull; }
#endif
#ifdef HIPEMU
DEV float wave_sum(float v) {
#pragma unroll
    for (int o = 1; o < 64; o <<= 1) v += __shfl_xor(v, o);
    return v;
}
DEV float grp16_max(float v) {
#pragma unroll
    for (int o = 1; o < 16; o <<= 1) v = fmaxf(v, __shfl_xor(v, o));
    return v;
}
DEV float grp16_sum(float v) {
#pragma unroll
    for (int o = 1; o < 16; o <<= 1) v += __shfl_xor(v, o);
    return v;
}
#else
template <int CTRL> DEV float dppf(float x) { return __builtin_bit_cast(float, __builtin_amdgcn_mov_dpp(__builtin_bit_cast(int, x), CTRL, 0xf, 0xf, true)); }
DEV float grp16_max(float v) { v = fmaxf(v, dppf<0xB1>(v)); v = fmaxf(v, dppf<0x4E>(v)); v = fmaxf(v, dppf<0x141>(v)); v = fmaxf(v, dppf<0x128>(v)); return v; }
DEV float grp16_sum(float v) { v += dppf<0xB1>(v); v += dppf<0x4E>(v); v += dppf<0x141>(v); v += dppf<0x128>(v); return v; }
DEV float wave_sum(float v) {
    v = grp16_sum(v);
    auto s = __builtin_amdgcn_permlane16_swap(__float_as_uint(v), __float_as_uint(v), false, false);
    v = __uint_as_float(s[0]) + __uint_as_float(s[1]);
    auto t = __builtin_amdgcn_permlane32_swap(__float_as_uint(v), __float_as_uint(v), false, false);
    return __uint_as_float(t[0]) + __uint_as_float(t[1]);
}
#endif

struct Params { const void* in[28]; float* out; unsigned char* ws; int ph_lo, ph_hi; };
struct Ctx {
    const Params* p; unsigned char* lds; unsigned char* ws; float* out;
    int tid, lane, wave, gw, ngw;
    template <class T> DEV const T* in(int i) const { return (const T*)p->in[i]; }
    template <class T> DEV T* w(size_t off) const { return (T*)(ws + off); }
};
DEV int queue_next(const Ctx& c, int q) {
    unsigned* cnt = (unsigned*)(c.ws + WS_CTL) + 4096 + 64 * q; volatile unsigned* slot = (volatile unsigned*)(c.lds + LDS_MISC + 128);
    __syncthreads();
    if (c.tid == 0) *slot = atomicAdd(cnt, 1u);
    __syncthreads();
    return (int)*slot;
}
DEV const float* xin_row(const Ctx& c, int m) { return m < MP ? c.in<float>(0) + (size_t)m * D : c.in<float>(1) + (size_t)(m - MP) * D; }

struct EpiStoreF32 {
    static constexpr bool PERM = false, AFTER_DRAIN = false;
    float* C; int ldc;
    DEV void operator()(const pg8::f32x4 (&acc)[2][2][4][2], const pg8::Unit& u, int wr, int wc, int fr, int fq) const {
        const int row0 = u.pm * 256 + wr * 64 + fr, col0 = u.pn * 256 + wc * 32 + 4 * fq;
#pragma unroll
        for (int ai = 0; ai < 2; ++ai)
#pragma unroll
            for (int m = 0; m < 4; ++m) { float* rowp = C + (size_t)(row0 + ai * 128 + m * 16) * ldc + col0;
#pragma unroll
                for (int bj = 0; bj < 2; ++bj)
#pragma unroll
                    for (int n = 0; n < 2; ++n) *(pg8::f32x4*)(rowp + bj * 128 + n * 16) = acc[ai][bj][m][n]; }
    }
};
struct EpiResidF32 {
    static constexpr bool PERM = false, AFTER_DRAIN = false;
    const float* base; const float* xp; const float* xs; float* out;
    DEV void operator()(const pg8::f32x4 (&acc)[2][2][4][2], const pg8::Unit& u, int wr, int wc, int fr, int fq) const {
        const int row0 = u.pm * 256 + wr * 64 + fr, col0 = u.pn * 256 + wc * 32 + 4 * fq;
#pragma unroll
        for (int ai = 0; ai < 2; ++ai)
#pragma unroll
            for (int m = 0; m < 4; ++m) { const int row = row0 + ai * 128 + m * 16;
                const float* rp = base ? base + (size_t)row * D : (row < MP ? xp + (size_t)row * D : xs + (size_t)(row - MP) * D);
                const bool ok = base != nullptr || row < MT;
                float* op = out + (size_t)row * D + col0;
#pragma unroll
                for (int bj = 0; bj < 2; ++bj)
#pragma unroll
                    for (int n = 0; n < 2; ++n) { pg8::f32x4 r = ok ? *(const pg8::f32x4*)(rp + col0 + bj * 128 + n * 16) : (pg8::f32x4){0.f, 0.f, 0.f, 0.f};
                        *(pg8::f32x4*)(op + bj * 128 + n * 16) = r + acc[ai][bj][m][n]; } }
    }
};
template <int ACT  > struct EpiBf16 {
    static constexpr bool PERM = true, AFTER_DRAIN = false;
    bf16* O; int ldc;
    DEV void operator()(const pg8::f32x4 (&acc)[2][2][4][2], const pg8::Unit& u, int wr, int wc, int fr, int fq) const {
        const int row0 = u.pm * 256 + wr * 64 + fr, col0 = u.pn * 256 + wc * 32 + 8 * fq;
#pragma unroll
        for (int ai = 0; ai < 2; ++ai)
#pragma unroll
            for (int m = 0; m < 4; ++m) { bf16* rowp = O + (size_t)(row0 + ai * 128 + m * 16) * ldc + col0;
#pragma unroll
                for (int bj = 0; bj < 2; ++bj) { pg8::f32x4 v0 = acc[ai][bj][m][0], v1 = acc[ai][bj][m][1];
                    if (ACT == 1) {
#pragma unroll
                        for (int j = 0; j < 4; ++j) { const float a = fmaxf(v0[j], 0.f), b = fmaxf(v1[j], 0.f); v0[j] = a * a; v1[j] = b * b; } }
                    u32x4 w; w.x = pk2(v0[0], v0[1]); w.y = pk2(v0[2], v0[3]); w.z = pk2(v1[0], v1[1]); w.w = pk2(v1[2], v1[3]);
                    *(u32x4*)(rowp + bj * 128) = w; } }
    }
};

struct SplitKOrder {
    int nM, nN, nS, pm0, G, c;
    DEV void init(int nM_, int nN_, int nS_, int pm0_, int G_, int c_) { nM = nM_; nN = nN_; nS = nS_; pm0 = pm0_; G = G_; c = c_; }
    DEV bool next(int i, pg8::Unit& u) const { const int L = i * G + c; if (L >= nM * nN * nS) return false; u.pm = pm0 + L % nM; const int r = L / nM; u.pn = r % nN; u.kb = r / nN; return true; }
    DEV void a_ready(const pg8::Unit&) const {}
    DEV void done(const pg8::Unit&) const {}
};
struct EpiPartF32 {
    static constexpr bool PERM = false, AFTER_DRAIN = false;
    float* P;
    DEV void operator()(const pg8::f32x4 (&acc)[2][2][4][2], const pg8::Unit& u, int wr, int wc, int fr, int fq) const {
        const int row0 = u.pm * 256 - MP + wr * 64 + fr, col0 = u.pn * 256 + wc * 32 + 4 * fq;
        float* base = P + (size_t)u.kb * (M - MP) * D;
#pragma unroll
        for (int ai = 0; ai < 2; ++ai)
#pragma unroll
            for (int m = 0; m < 4; ++m) { float* op = base + (size_t)(row0 + ai * 128 + m * 16) * D + col0;
#pragma unroll
                for (int bj = 0; bj < 2; ++bj)
#pragma unroll
                    for (int n = 0; n < 2; ++n) *(pg8::f32x4*)(op + bj * 128 + n * 16) = acc[ai][bj][m][n]; }
    }
};
template <class Epi, class Sched> DEV void run_gemm_s(const Ctx& c, const bf16* A, const bf16* Bt, int Mr, int N, int K, int ld, const Sched& S, const Epi& E) {
#ifndef HIPEMU
    asm volatile("" : "+s"(K));
    pg8::Gemm g{A, Bt, Mr, N, K, ld};
    pg8::gemm_phase<Epi, Sched, true, true>((PG8_LAS unsigned char*)c.lds, g, S, E, c.wave, c.lane);
#else
    const int wid = c.wave, lane = c.lane, wr = wid >> 2, wc = wid & 3, fr = lane & 15, fq = lane >> 4;
    pg8::Unit u;
    for (int ui = 0; S.next(ui, u); ++ui) {
        pg8::f32x4 acc[2][2][4][2];
        for (int ai = 0; ai < 2; ++ai) for (int bj = 0; bj < 2; ++bj) for (int m = 0; m < 4; ++m) for (int n = 0; n < 2; ++n) for (int j = 0; j < 4; ++j) {
            const int row = 256 * u.pm + 128 * ai + 64 * wr + 16 * m + fr;
            const int col = Epi::PERM ? 256 * u.pn + 128 * bj + 32 * wc + 8 * fq + 4 * n + j : 256 * u.pn + 128 * bj + 32 * wc + 16 * n + 4 * fq + j;
            const bf16* a = A + (size_t)row * ld + (size_t)u.kb * K; const bf16* b = Bt + (size_t)col * ld + (size_t)u.kb * K; float s = 0.f;
            for (int k = 0; k < K; ++k) s += bf2f(a[k]) * bf2f(b[k]);
            acc[ai][bj][m][n][j] = s; }
        E(acc, u, wr, wc, fr, fq);
    }
#endif
}
template <class Epi> DEV void run_gemm(const Ctx& c, const bf16* A, const bf16* Bt, int Mr, int N, int K, const Epi& E) {
    pg8::StaticOrder S; S.init(Mr, N, (int)gridDim.x, (int)blockIdx.x);
    run_gemm_s(c, A, Bt, Mr, N, K, K, S, E);
}
DEV void run_gemm_sample_splitk(const Ctx& c, const bf16* A, const bf16* Bt, int K, int KS) {
    SplitKOrder S; S.init((M - MP) / 256, D / 256, K / KS, MP / 256, (int)gridDim.x, (int)((blockIdx.x + 128) % gridDim.x));
    run_gemm_s(c, A, Bt, M, D, KS, K, S, EpiPartF32{c.w<float>(WS_PART)});
}

DEV void transpose_item(const float* W, int K, int N, bf16* WT, float* scr, int item, int nblk, int lane) {
    const int kb = item / nblk, nb = item % nblk, k0 = 64 * kb, n0 = 32 * nb;
    const int nn = n0 + (lane & 31);
    float tv[32];
#pragma unroll
    for (int i = 0; i < 32; ++i) { const int kk = 2 * i + (lane >> 5); tv[i] = nn < N ? W[(size_t)(k0 + kk) * N + nn] : 0.f; }
#pragma unroll
    for (int i = 0; i < 32; ++i) { const int kk = 2 * i + (lane >> 5); scr[kk * 33 + (lane & 31)] = tv[i]; }
    WAVE_SYNC();
    const int cq = lane & 7;
#pragma unroll
    for (int j = 0; j < 4; ++j) { const int n = (lane >> 3) + 8 * j; const float* s = scr + (8 * cq) * 33 + n;
        u32x4 o; o.x = pk2(s[0 * 33], s[1 * 33]); o.y = pk2(s[2 * 33], s[3 * 33]); o.z = pk2(s[4 * 33], s[5 * 33]); o.w = pk2(s[6 * 33], s[7 * 33]);
        *(u32x4*)(WT + (size_t)(n0 + n) * K + k0 + 8 * cq) = o; }
    WAVE_SYNC();
}
DEV void rms_row_to_bf16(const float* xrow, const float* gain, bf16* orow, int lane) {
    f32x4 v[4]; float s = 0.f;
#pragma unroll
    for (int j = 0; j < 4; ++j) { v[j] = *(const f32x4*)(xrow + 4 * lane + 256 * j); s += (v[j][0] * v[j][0] + v[j][1] * v[j][1]) + (v[j][2] * v[j][2] + v[j][3] * v[j][3]); }
    const float rstd = rsqrtf(wave_sum(s) * (1.f / D) + EPS);
#pragma unroll
    for (int j = 0; j < 4; ++j) { const f32x4 g = *(const f32x4*)(gain + 4 * lane + 256 * j);
        u32x2 o; o.x = pk2(v[j][0] * rstd * g[0], v[j][1] * rstd * g[1]); o.y = pk2(v[j][2] * rstd * g[2], v[j][3] * rstd * g[3]);
        *(u32x2*)(orow + 4 * lane + 256 * j) = o; }
}
DEV void zero_row_bf16(bf16* orow, int lane) {
#pragma unroll
    for (int j = 0; j < 4; ++j) { u32x2 o; o.x = 0u; o.y = 0u; *(u32x2*)(orow + 4 * lane + 256 * j) = o; }
}
#define TJOB(Wp, K_, N_, Npad_, wt_) do { const int nblk = (Npad_) / 32, nitems = ((K_) / 64) * nblk; bf16* WT = c.w<bf16>(wt_); const float* Wsrc = (Wp); \
        for (int it = gw0; it < nitems; it += ngw0) transpose_item(Wsrc, (K_), (N_), WT, scr, it, nblk, c.lane); } while (0)
DEV void phase_convert_late(const Ctx& c, int gw0, int ngw0) {
    float* scr = (float*)(c.lds + c.wave * 8704);
    TJOB(c.in<float>(11), D, FF, FF, WS_WUP0); TJOB(c.in<float>(11) + (size_t)D * FF, D, FF, FF, WS_WUP1);
    TJOB(c.in<float>(12), FF, D, D, WS_WDN0); TJOB(c.in<float>(12) + (size_t)D * FF, FF, D, D, WS_WDN1);
    TJOB(c.in<float>(24), D, INC, INC, WS_WINC);
    TJOB(c.in<float>(27), D, D, D, WS_WOC); TJOB(c.in<float>(23), D, D, D, WS_WOAB);
}
DEV void phase_prologue(const Ctx& c) {
    float* scr = (float*)(c.lds + c.wave * 8704);
    const int gw0 = c.gw, ngw0 = c.ngw;
    TJOB(c.in<float>(13), D, IN_AB, LD1, WS_WINAB);
    TJOB(c.in<float>(19), 256, 768, 768, WS_WUQ);
    TJOB(c.in<float>(21), 256, 512, 512, WS_WUKV); TJOB(c.in<float>(22), 256, 512, 512, WS_WUKV + (size_t)512 * 256 * 2);
#undef TJOB
    {
        const float* src = c.in<float>(21); bf16* dst = c.w<bf16>(WS_WUKB);
        for (int i = blockIdx.x * 512 + c.tid; i < 256 * 512 / 4; i += gridDim.x * 512) { const f32x4 v = *(const f32x4*)(src + 4 * i); u32x2 o; o.x = pk2(v[0], v[1]); o.y = pk2(v[2], v[3]); *(u32x2*)(dst + 4 * i) = o; }
    }
    float* rope = c.w<float>(WS_ROPE);
    for (int i = blockIdx.x * 512 + c.tid; i < (SEQ + 8) * 16; i += gridDim.x * 512) {
        const int e = i >> 4, f = i & 15; const double pos = e < SEQ ? (double)e : (double)(PAST + e - SEQ);
        const double ang = pos * pow(10000.0, -(double)f / 16.0);
        rope[e * 32 + f] = (float)cos(ang); rope[e * 32 + 16 + f] = (float)sin(ang);
    }
    bf16* XN = c.w<bf16>(WS_XN);
    for (int m = c.gw; m < M; m += c.ngw) {
        if (m < MT) rms_row_to_bf16(xin_row(c, m), c.in<float>(8), XN + (size_t)m * D, c.lane); else zero_row_bf16(XN + (size_t)m * D, c.lane);
    }
}
DEV void sample_row_sum(const Ctx& c, int m, const float* X_res, int nsp, f32x4 (&v)[4]) {
    const int lane = c.lane; const float* P = c.w<float>(WS_PART) + (size_t)(m - MP) * D;
#pragma unroll
    for (int j = 0; j < 4; ++j) {
        if (X_res) v[j] = *(const f32x4*)(X_res + (size_t)m * D + 4 * lane + 256 * j);
        else v[j] = m < MT ? *(const f32x4*)(c.in<float>(1) + (size_t)(m - MP) * D + 4 * lane + 256 * j) : (f32x4){0.f, 0.f, 0.f, 0.f}; }
    for (int s = 0; s < nsp; ++s) {
#pragma unroll
        for (int j = 0; j < 4; ++j) v[j] += *(const f32x4*)(P + (size_t)s * (M - MP) * D + 4 * lane + 256 * j); }
}
DEV void phase_rmsnorm(const Ctx& c, float* X, const float* gain, const float* X_res, int nsp) {
    bf16* XN = c.w<bf16>(WS_XN); const int lane = c.lane;
    for (int m = c.gw; m < M; m += c.ngw) {
        if (m < MP) { rms_row_to_bf16(X + (size_t)m * D, gain, XN + (size_t)m * D, lane); continue; }
        f32x4 v[4]; sample_row_sum(c, m, X_res, nsp, v);
        float s = 0.f;
#pragma unroll
        for (int j = 0; j < 4; ++j) { *(f32x4*)(X + (size_t)m * D + 4 * lane + 256 * j) = v[j]; s += (v[j][0] * v[j][0] + v[j][1] * v[j][1]) + (v[j][2] * v[j][2] + v[j][3] * v[j][3]); }
        const float rstd = rsqrtf(wave_sum(s) * (1.f / D) + EPS);
#pragma unroll
        for (int j = 0; j < 4; ++j) { const f32x4 g = *(const f32x4*)(gain + 4 * lane + 256 * j);
            u32x2 o; o.x = pk2(v[j][0] * rstd * g[0], v[j][1] * rstd * g[1]); o.y = pk2(v[j][2] * rstd * g[2], v[j][3] * rstd * g[3]);
            *(u32x2*)(XN + (size_t)m * D + 4 * lane + 256 * j) = o; }
    }
}
DEV void phase_copy_rows(const Ctx& c, float* dst, const float* src, int nrows) {
    for (int r = (int)(gridDim.x * 8) - 1 - c.gw; r < nrows; r += c.ngw) {
#pragma unroll
        for (int j = 0; j < 4; ++j) *(f32x4*)(dst + (size_t)r * D + 4 * c.lane + 256 * j) = *(const f32x4*)(src + (size_t)r * D + 4 * c.lane + 256 * j); }
}
DEV void phase_final(const Ctx& c, const float* X, const float* gain, const float* X_res, int nsp) {
    for (int m = c.gw; m < MT; m += c.ngw) {
        const float* xrow = X + (size_t)m * D; float* orow = c.out + (m < MP ? O_YP + (size_t)m * D : O_YS + (size_t)(m - MP) * D);
        f32x4 v[4]; float s = 0.f;
        if (m >= MP) sample_row_sum(c, m, X_res, nsp, v);
#pragma unroll
        for (int j = 0; j < 4; ++j) { if (m < MP) v[j] = *(const f32x4*)(xrow + 4 * c.lane + 256 * j); s += (v[j][0] * v[j][0] + v[j][1] * v[j][1]) + (v[j][2] * v[j][2] + v[j][3] * v[j][3]); }
        const float rstd = rsqrtf(wave_sum(s) * (1.f / D) + EPS);
#pragma unroll
        for (int j = 0; j < 4; ++j) { const f32x4 g = *(const f32x4*)(gain + 4 * c.lane + 256 * j); *(f32x4*)(orow + 4 * c.lane + 256 * j) = v[j] * rstd * g; }
    }
}

DEV void phase_prep0(const Ctx& c) {
    const bf16* P1 = c.w<bf16>(WS_P1); const float* rope = c.w<float>(WS_ROPE);
    bf16* CQN = c.w<bf16>(WS_CQN); bf16* LATN = c.w<bf16>(WS_LATN);
    const float* qg = c.in<float>(18); const float* kvg = c.in<float>(20);
    const int lane = c.lane;
    for (int m = c.gw; m < M; m += c.ngw) {
        if (m >= MT) { u32x2 z; z.x = 0u; z.y = 0u; *(u32x2*)(CQN + (size_t)m * 256 + 4 * lane) = z; *(u32x2*)(LATN + (size_t)m * 256 + 4 * lane) = z; continue; }
        const bf16* row = P1 + (size_t)m * LD1;
        const bool samp = m >= MP; const int b = samp ? (m - MP) / DECS : m / SEQ, t = samp ? (m - MP) % DECS : m % SEQ;
        {
            const f32x4 v = ld4bf(row + C_CQ + 4 * lane); const f32x4 g = *(const f32x4*)(qg + 4 * lane);
            const float r = rsqrtf(wave_sum((v[0] * v[0] + v[1] * v[1]) + (v[2] * v[2] + v[3] * v[3])) * (1.f / 256.f) + EPS);
            u32x2 o; o.x = pk2(v[0] * r * g[0], v[1] * r * g[1]); o.y = pk2(v[2] * r * g[2], v[3] * r * g[3]); *(u32x2*)(CQN + (size_t)m * 256 + 4 * lane) = o;
        }
        {
            const f32x4 v = ld4bf(row + C_CKV + 4 * lane); const f32x4 g = *(const f32x4*)(kvg + 4 * lane);
            const float r = rsqrtf(wave_sum((v[0] * v[0] + v[1] * v[1]) + (v[2] * v[2] + v[3] * v[3])) * (1.f / 256.f) + EPS);
            const f32x4 y = v * r * g;
            float* lo = c.out + (samp ? O_LATS + (size_t)(m - MP) * 256 : O_LATP + (size_t)m * 256);
            *(f32x4*)(lo + 4 * lane) = y;
            u32x2 o; o.x = pk2(y[0], y[1]); o.y = pk2(y[2], y[3]); *(u32x2*)(LATN + (size_t)m * 256 + 4 * lane) = o;
        }
        if (lane < 16) {
            const float* rt = rope + (size_t)(samp ? SEQ + t : t) * 32; const float cs = rt[lane], sn = rt[16 + lane];
            const float x1 = bf2f(row[C_KPE + lane]), x2 = bf2f(row[C_KPE + 16 + lane]);
            float* ko = c.out + (samp ? O_KPES + (size_t)(m - MP) * 32 : O_KPEP + (size_t)m * 32);
            ko[lane] = x1 * cs - x2 * sn; ko[16 + lane] = x2 * cs + x1 * sn;
            if (!samp) { bf16* kb = c.w<bf16>(WS_KPEB) + (size_t)m * 32; kb[lane] = (bf16)f2bf(x1 * cs - x2 * sn); kb[16 + lane] = (bf16)f2bf(x2 * cs + x1 * sn); }
        }
        const int T = samp ? DECS : SEQ;
        if (t >= T - 3) {
            float* co = c.out + (samp ? O_CONVS : O_CONVP) + ((size_t)b * 3 + (t - (T - 3))) * QKV_A;
#pragma unroll
            for (int j = 0; j < 6; ++j) *(f32x4*)(co + 4 * lane + 256 * j) = ld4bf(row + 4 * lane + 256 * j);
        }
    }
}

DEV void phase_gdn_naive(const Ctx& c, int u_begin, int wg_first, int wg_stride) {
    float* red = (float*)c.lds; float* red2 = red + 512; float* qs = red2 + 512; float* ks = qs + 128; float* vs = ks + 128; float* part = vs + 128; float* sc = part + 8;
    const bf16* P1 = c.w<bf16>(WS_P1); float* ORAW = c.w<float>(WS_ORAW); bf16* OCAT = c.w<bf16>(WS_OCAT);
    const float* convw = c.in<float>(14); const float* gn = c.in<float>(17);
    const int tid = c.tid, lane = c.lane, wave = c.wave;
    const int NU = (BATCH + DECB) * 4;
    for (int u = u_begin + wg_first; u < NU; u += wg_stride) {
        const bool samp = u >= BATCH * 4; const int b = samp ? (u - BATCH * 4) >> 2 : u >> 2, h = u & 3;
        const int T = samp ? DECS : SEQ; const size_t m0 = samp ? (size_t)MP + (size_t)b * DECS : (size_t)b * SEQ;
        const int e = tid & 127, dg = tid >> 7, d0 = dg * 32;
        float s[32];
        if (samp) { const float* S0 = c.in<float>(2) + ((size_t)(b * 4 + h) * 128 + d0) * 128 + e;
#pragma unroll
            for (int i = 0; i < 32; ++i) s[i] = S0[(size_t)i * 128]; }
        else {
#pragma unroll
            for (int i = 0; i < 32; ++i) s[i] = 0.f; }
        const int col = tid < 128 ? h * 128 + tid : (tid < 256 ? 512 + h * 128 + (tid - 128) : 1024 + h * 128 + (tid - 256));
        float w0 = 0.f, w1 = 0.f, w2 = 0.f, w3 = 0.f, x0 = 0.f, x1 = 0.f, x2 = 0.f, xn = 0.f;
        if (tid < 384) { w0 = convw[col]; w1 = convw[QKV_A + col]; w2 = convw[2 * QKV_A + col]; w3 = convw[3 * QKV_A + col];
            if (samp) { const float* cb = c.in<float>(3) + (size_t)b * 3 * QKV_A + col; x0 = cb[0]; x1 = cb[QKV_A]; x2 = cb[2 * QKV_A]; }
            xn = bf2f(P1[m0 * LD1 + col]); }
        const float Aexp = __expf(c.in<float>(15)[h]), dtb = c.in<float>(16)[h];
        for (int t = 0; t < T; ++t) {
            const size_t m = m0 + t;
            const float x3 = xn; if (t + 1 < T && tid < 384) xn = bf2f(P1[(m + 1) * LD1 + col]);
            float val = 0.f;
            if (tid < 384) { const float y = w0 * x0 + w1 * x1 + w2 * x2 + w3 * x3; val = siluf_(y); x0 = x1; x1 = x2; x2 = x3; }
            const float sq = wave_sum(tid < 256 ? val * val : 0.f);
            if (tid < 128) qs[tid] = val; else if (tid < 256) ks[tid - 128] = val; else if (tid < 384) vs[tid - 256] = val;
            if (lane == 0 && wave < 4) part[wave] = sq;
            if (tid == 384) { sc[0] = sigmoidf_(bf2f(P1[m * LD1 + C_B + h])); sc[1] = -Aexp * softplusf_(bf2f(P1[m * LD1 + C_A + h]) + dtb); }
            LDS_BARRIER();
            const float qn = rsqrtf(part[0] + part[1] + EPS), kn = rsqrtf(part[2] + part[3] + EPS), beta = sc[0], dec = __expf(sc[1]);
            float kp = 0.f;
#pragma unroll
            for (int i = 0; i < 32; ++i) { s[i] *= dec; kp += ks[d0 + i] * s[i]; }
            red[dg * 128 + e] = kp * kn;
            LDS_BARRIER();
            const float kS = (red[e] + red[128 + e]) + (red[256 + e] + red[384 + e]);
            const float delta = beta * (vs[e] - kS) * kn;
            float op = 0.f;
#pragma unroll
            for (int i = 0; i < 32; ++i) { s[i] += ks[d0 + i] * delta; op += qs[d0 + i] * s[i]; }
            red2[dg * 128 + e] = op * qn;
            LDS_BARRIER();
            if (dg == 0) ORAW[m * 512 + h * 128 + e] = ((red2[e] + red2[128 + e]) + (red2[256 + e] + red2[384 + e])) * DK_SCALE;
        }
        float* So = c.out + (samp ? O_GDNS : O_GDNP) + ((size_t)(b * 4 + h) * 128 + d0) * 128 + e;
#pragma unroll
        for (int i = 0; i < 32; ++i) So[(size_t)i * 128] = s[i];
        __syncthreads();
        for (int t = wave; t < T; t += 8) { const size_t m = m0 + t;
            const float v0 = ORAW[m * 512 + h * 128 + lane], v1 = ORAW[m * 512 + h * 128 + 64 + lane];
            const float r = rsqrtf(wave_sum(v0 * v0 + v1 * v1) * (1.f / 128.f) + EPS);
            const float z0 = bf2f(P1[m * LD1 + C_Z + h * 128 + lane]), z1 = bf2f(P1[m * LD1 + C_Z + h * 128 + 64 + lane]);
            OCAT[m * D + h * 128 + lane] = (bf16)f2bf(v0 * r * gn[lane] * siluf_(z0));
            OCAT[m * D + h * 128 + 64 + lane] = (bf16)f2bf(v1 * r * gn[64 + lane] * siluf_(z1)); }
        __syncthreads();
    }
}

DEV void phase_hgrn_naive(const Ctx& c, int u_begin, int wg_first, int wg_stride) {
    float* red = (float*)c.lds; float* qs = red + 512; float* fs = qs + 128;
    const bf16* PC = c.w<bf16>(WS_P1); float* ORAW = c.w<float>(WS_ORAW); bf16* OC = c.w<bf16>(WS_OCAT);
    const float* lbl = c.in<float>(25); const float* gn = c.in<float>(26);
    const int tid = c.tid, lane = c.lane, wave = c.wave;
    const int NU = (BATCH + DECB) * 8;
    for (int u = u_begin + wg_first; u < NU; u += wg_stride) {
        const bool samp = u >= BATCH * 8; const int b = samp ? (u - BATCH * 8) >> 3 : u >> 3, h = u & 7;
        const int T = samp ? DECS : SEQ; const size_t m0 = samp ? (size_t)MP + (size_t)b * DECS : (size_t)b * SEQ;
        const int e = tid & 127, dg = tid >> 7, d0 = dg * 32;
        float s[32];
        if (samp) { const float* S0 = c.in<float>(6) + ((size_t)(b * 8 + h) * 128 + d0) * 128 + e;
#pragma unroll
            for (int i = 0; i < 32; ++i) s[i] = S0[(size_t)i * 128]; }
        else {
#pragma unroll
            for (int i = 0; i < 32; ++i) s[i] = 0.f; }
        float lb = 0.f; if (tid < 128) lb = sigmoidf_(lbl[1024 + h * 128 + tid] - lbl[h * 128 + tid]);
        bf16 nq = 0, nf = 0, nv = 0;
        { const bf16* row = PC + m0 * INC; if (tid < 128) { nq = row[h * 128 + tid]; nf = row[1024 + h * 128 + tid]; } nv = row[2048 + h * 128 + e]; }
        for (int t = 0; t < T; ++t) {
            const size_t m = m0 + t;
            if (tid < 128) { qs[tid] = siluf_(bf2f(nq)); fs[tid] = lb + (1.f - lb) * sigmoidf_(bf2f(nf)); }
            const float v = bf2f(nv);
            if (t + 1 < T) { const bf16* row = PC + (m + 1) * INC; if (tid < 128) { nq = row[h * 128 + tid]; nf = row[1024 + h * 128 + tid]; } nv = row[2048 + h * 128 + e]; }
            LDS_BARRIER();
            float op = 0.f;
#pragma unroll
            for (int i = 0; i < 32; ++i) { const float f = fs[d0 + i]; s[i] = f * s[i] + (1.f - f) * v; op += qs[d0 + i] * s[i]; }
            red[dg * 128 + e] = op;
            LDS_BARRIER();
            if (dg == 0) ORAW[m * D + h * 128 + e] = ((red[e] + red[128 + e]) + (red[256 + e] + red[384 + e])) * DK_SCALE;
        }
        float* So = c.out + (samp ? O_HGS : O_HGP) + ((size_t)(b * 8 + h) * 128 + d0) * 128 + e;
#pragma unroll
        for (int i = 0; i < 32; ++i) So[(size_t)i * 128] = s[i];
        __syncthreads();
        for (int t = wave; t < T; t += 8) { const size_t m = m0 + t;
            const float v0 = ORAW[m * D + h * 128 + lane], v1 = ORAW[m * D + h * 128 + 64 + lane];
            const float r = rsqrtf(wave_sum(v0 * v0 + v1 * v1) * (1.f / 128.f) + EPS);
            const float z0 = bf2f(PC[m * INC + 3072 + h * 128 + lane]), z1 = bf2f(PC[m * INC + 3072 + h * 128 + 64 + lane]);
            OC[m * D + h * 128 + lane] = (bf16)f2bf(v0 * r * gn[lane] * siluf_(z0));
            OC[m * D + h * 128 + 64 + lane] = (bf16)f2bf(v1 * r * gn[64 + lane] * siluf_(z1)); }
        __syncthreads();
    }
}

DEV bf16x8 ld8(const bf16* p) { return *(const bf16x8*)p; }
DEV void softmax_strip(f32x4 (&s)[4], float (&mrun)[4], float (&lrun)[4], float (&alpha)[4], bf16* Ps, int lane) {
#pragma unroll
    for (int r = 0; r < 4; ++r) {
        float mx = fmaxf(fmaxf(s[0][r], s[1][r]), fmaxf(s[2][r], s[3][r])); mx = grp16_max(mx);
        const float mn = fmaxf(mrun[r], mx);
        alpha[r] = __expf(mrun[r] - mn); mrun[r] = mn;
        float sum = 0.f;
#pragma unroll
        for (int nt = 0; nt < 4; ++nt) { const float p = __expf(s[nt][r] - mn); s[nt][r] = p; sum += p; }
        sum = grp16_sum(sum); lrun[r] = lrun[r] * alpha[r] + sum;
    }
#pragma unroll
    for (int nt = 0; nt < 4; ++nt)
#pragma unroll
        for (int r = 0; r < 4; ++r) Ps[((lane >> 4) * 4 + r) * 72 + nt * 16 + (lane & 15)] = (bf16)f2bf(s[nt][r]);
}
DEV void phase_attn_prompt(const Ctx& c) {
    bf16* Qs = (bf16*)c.lds;
    bf16* Ks = Qs + 128 * 104;
    bf16* Vt = Ks + 64 * 104;
    bf16* Psb = Vt + 64 * 72;
    const float* QH = c.w<float>(WS_QH); const bf16* KVP = c.w<bf16>(WS_KVP); const float* rope = c.w<float>(WS_ROPE); bf16* OCAT = c.w<bf16>(WS_OCAT);
    const float* kpe = c.out + O_KPEP;
    const int tid = c.tid, lane = c.lane, w = c.wave;
    bf16* Ps = Psb + w * 16 * 72;
    constexpr int NQB = SEQ / 128, NU = BATCH * 8 * NQB;
    for (int u = blockIdx.x; u < NU; u += gridDim.x) {
        const int qb = NQB - 1 - u / (BATCH * 8), bh = u % (BATCH * 8), b = bh >> 3, h = bh & 7;
        const int q0 = qb * 128; const size_t mb = (size_t)b * SEQ;
        __syncthreads();
        for (int idx = tid; idx < 128 * 80; idx += 512) {
            const int r = idx / 80, j = idx % 80; const float* qrow = QH + (mb + q0 + r) * 768 + h * 96;
            if (j < 64) Qs[r * 104 + j] = (bf16)f2bf(qrow[j] * MLA_SCALE);
            else { const int f = j - 64; const float* rt = rope + (size_t)(q0 + r) * 32; const float cs = rt[f], sn = rt[16 + f], x1 = qrow[64 + f], x2 = qrow[80 + f];
                Qs[r * 104 + 64 + f] = (bf16)f2bf((x1 * cs - x2 * sn) * MLA_SCALE); Qs[r * 104 + 80 + f] = (bf16)f2bf((x2 * cs + x1 * sn) * MLA_SCALE); }
        }
        __syncthreads();
        bf16x8 qf[3];
#pragma unroll
        for (int ks = 0; ks < 3; ++ks) qf[ks] = ld8(Qs + (w * 16 + (lane & 15)) * 104 + ks * 32 + 8 * (lane >> 4));
        float mrun[4], lrun[4], alpha[4]; f32x4 o[4];
#pragma unroll
        for (int r = 0; r < 4; ++r) { mrun[r] = -INFINITY; lrun[r] = 0.f; }
#pragma unroll
        for (int nt = 0; nt < 4; ++nt) o[nt] = (f32x4){0.f, 0.f, 0.f, 0.f};
        const int nkt = 2 * qb + 2;
        for (int kt = 0; kt < nkt; ++kt) {
            const int k0 = kt * 64;
            __syncthreads();
            for (int idx = tid; idx < 64 * 8; idx += 512) {
                const int key = idx >> 3, ch = idx & 7; *(u32x4*)(Ks + key * 104 + ch * 8) = *(const u32x4*)(KVP + (mb + k0 + key) * 1024 + h * 64 + ch * 8); }
            for (int idx = tid; idx < 64 * 32; idx += 512) { const int key = idx >> 5, f = idx & 31; Ks[key * 104 + 64 + f] = (bf16)f2bf(kpe[(mb + k0 + key) * 32 + f]); }
            for (int idx = tid; idx < 64 * 64; idx += 512) { const int key = idx >> 6, d = idx & 63; Vt[d * 72 + key] = KVP[(mb + k0 + key) * 1024 + 512 + h * 64 + d]; }
            __syncthreads();
            f32x4 s[4];
#pragma unroll
            for (int nt = 0; nt < 4; ++nt) { s[nt] = (f32x4){0.f, 0.f, 0.f, 0.f};
#pragma unroll
                for (int ks = 0; ks < 3; ++ks) s[nt] = mfma16(qf[ks], ld8(Ks + (nt * 16 + (lane & 15)) * 104 + ks * 32 + 8 * (lane >> 4)), s[nt]); }
            if (kt >= 2 * qb) {
#pragma unroll
                for (int nt = 0; nt < 4; ++nt)
#pragma unroll
                    for (int r = 0; r < 4; ++r) { const int qpos = q0 + w * 16 + (lane >> 4) * 4 + r, kpos = k0 + nt * 16 + (lane & 15); if (kpos > qpos) s[nt][r] = -INFINITY; }
            }
            softmax_strip(s, mrun, lrun, alpha, Ps, lane);
            WAVE_SYNC();
#pragma unroll
            for (int nt = 0; nt < 4; ++nt) {
#pragma unroll
                for (int r = 0; r < 4; ++r) o[nt][r] *= alpha[r];
#pragma unroll
                for (int k2 = 0; k2 < 2; ++k2) o[nt] = mfma16(ld8(Ps + (lane & 15) * 72 + k2 * 32 + 8 * (lane >> 4)), ld8(Vt + (nt * 16 + (lane & 15)) * 72 + k2 * 32 + 8 * (lane >> 4)), o[nt]); }
            WAVE_SYNC();
        }
#pragma unroll
        for (int nt = 0; nt < 4; ++nt)
#pragma unroll
            for (int r = 0; r < 4; ++r) OCAT[(mb + q0 + w * 16 + (lane >> 4) * 4 + r) * D + 512 + h * 64 + nt * 16 + (lane & 15)] = (bf16)f2bf(o[nt][r] / lrun[r]);
    }
}

DEV void phase_attn_sample(const Ctx& c) {
    bf16* Qs = (bf16*)c.lds;
    bf16* Ks = Qs + 64 * 296;
    bf16* Lt = Ks + 64 * 296;
    float* Sf = (float*)(Lt + 256 * 72);
    bf16* Psb = (bf16*)(Sf + 64 * 68);
    float* Of = (float*)Ks;
    const float* QH = c.w<float>(WS_QH); const float* rope = c.w<float>(WS_ROPE); bf16* OCAT = c.w<bf16>(WS_OCAT);
    const float* wuk = c.in<float>(21); const float* wuv = c.in<float>(22);
    const float* clat = c.in<float>(4); const float* ckr = c.in<float>(5); const int* ptab = c.in<int>(7);
    const int tid = c.tid, lane = c.lane, w = c.wave;
    bf16* Ps = Psb + w * 16 * 72;
    for (int b = blockIdx.x; b < DECB; b += gridDim.x) {
        const size_t mb = (size_t)MP + (size_t)b * DECS;
        __syncthreads();
        for (int idx = tid; idx < 64 * 64; idx += 512) { const int r = idx >> 6, d = idx & 63, t = r >> 3, h = r & 7; Sf[r * 68 + d] = QH[(mb + t) * 768 + h * 96 + d]; }
        for (int idx = tid; idx < 64 * 16; idx += 512) { const int r = idx >> 4, f = idx & 15, t = r >> 3, h = r & 7; const float* qrow = QH + (mb + t) * 768 + h * 96 + 64;
            const float* rt = rope + (size_t)(SEQ + t) * 32; const float cs = rt[f], sn = rt[16 + f], x1 = qrow[f], x2 = qrow[16 + f];
            Qs[r * 296 + 256 + f] = (bf16)f2bf((x1 * cs - x2 * sn) * MLA_SCALE); Qs[r * 296 + 272 + f] = (bf16)f2bf((x2 * cs + x1 * sn) * MLA_SCALE); }
        __syncthreads();
        {
            const int l = tid & 255, th = tid >> 8;
            for (int h = 0; h < 8; ++h) {
                float a0 = 0.f, a1 = 0.f, a2 = 0.f, a3 = 0.f; const float* wr = wuk + (size_t)l * 512 + h * 64;
                const float* q0 = Sf + ((th * 4 + 0) * 8 + h) * 68; const float* q1 = Sf + ((th * 4 + 1) * 8 + h) * 68; const float* q2 = Sf + ((th * 4 + 2) * 8 + h) * 68; const float* q3 = Sf + ((th * 4 + 3) * 8 + h) * 68;
#pragma unroll 4
                for (int d4 = 0; d4 < 16; ++d4) { const f32x4 wv = *(const f32x4*)(wr + 4 * d4);
#pragma unroll
                    for (int j = 0; j < 4; ++j) { a0 += q0[4 * d4 + j] * wv[j]; a1 += q1[4 * d4 + j] * wv[j]; a2 += q2[4 * d4 + j] * wv[j]; a3 += q3[4 * d4 + j] * wv[j]; } }
                Qs[((th * 4 + 0) * 8 + h) * 296 + l] = (bf16)f2bf(a0 * MLA_SCALE); Qs[((th * 4 + 1) * 8 + h) * 296 + l] = (bf16)f2bf(a1 * MLA_SCALE);
                Qs[((th * 4 + 2) * 8 + h) * 296 + l] = (bf16)f2bf(a2 * MLA_SCALE); Qs[((th * 4 + 3) * 8 + h) * 296 + l] = (bf16)f2bf(a3 * MLA_SCALE);
            }
        }
        __syncthreads();
        const int rt = w & 3, hh = w >> 2;
        bf16x8 qf[9];
#pragma unroll
        for (int ks = 0; ks < 9; ++ks) qf[ks] = ld8(Qs + (rt * 16 + (lane & 15)) * 296 + ks * 32 + 8 * (lane >> 4));
        float mrun[4], lrun[4], alpha[4]; f32x4 o[8];
#pragma unroll
        for (int r = 0; r < 4; ++r) { mrun[r] = -INFINITY; lrun[r] = 0.f; }
#pragma unroll
        for (int nt = 0; nt < 8; ++nt) o[nt] = (f32x4){0.f, 0.f, 0.f, 0.f};
        constexpr int NT = PAST / 64 + 1;
        for (int kt = 0; kt < NT; ++kt) {
            const bool fresh = kt == NT - 1;
            __syncthreads();
            if (!fresh) {
                const int k0 = kt * 64; const size_t rowbase = (size_t)ptab[b * NPAGES + (k0 >> 7)] * PAGE + (k0 & 127);
#pragma unroll 2
                for (int j = 0; j < 8; ++j) { const int idx = tid + 512 * j, key = idx >> 6, l4 = idx & 63;
                    const f32x4 v = *(const f32x4*)(clat + (rowbase + key) * 256 + 4 * l4);
                    u32x2 pk; pk.x = pk2(v[0], v[1]); pk.y = pk2(v[2], v[3]); *(u32x2*)(Ks + key * 296 + 4 * l4) = pk;
                    Lt[(4 * l4 + 0) * 72 + key] = (bf16)f2bf(v[0]); Lt[(4 * l4 + 1) * 72 + key] = (bf16)f2bf(v[1]); Lt[(4 * l4 + 2) * 72 + key] = (bf16)f2bf(v[2]); Lt[(4 * l4 + 3) * 72 + key] = (bf16)f2bf(v[3]); }
                { const int key = tid >> 3, i4 = tid & 7; const f32x4 v = *(const f32x4*)(ckr + (rowbase + key) * 32 + 4 * i4);
                    u32x2 pk; pk.x = pk2(v[0], v[1]); pk.y = pk2(v[2], v[3]); *(u32x2*)(Ks + key * 296 + 256 + 4 * i4) = pk; }
            } else {
                const float* nl = c.out + O_LATS + (size_t)b * DECS * 256; const float* nk = c.out + O_KPES + (size_t)b * DECS * 32;
                for (int idx = tid; idx < 64 * 256; idx += 512) { const int key = idx >> 8, l = idx & 255; const bf16 v = key < DECS ? (bf16)f2bf(nl[key * 256 + l]) : (bf16)0; Ks[key * 296 + l] = v; Lt[l * 72 + key] = v; }
                for (int idx = tid; idx < 64 * 32; idx += 512) { const int key = idx >> 5, f = idx & 31; Ks[key * 296 + 256 + f] = key < DECS ? (bf16)f2bf(nk[key * 32 + f]) : (bf16)0; }
            }
            __syncthreads();
#pragma unroll
            for (int n2 = 0; n2 < 2; ++n2) { const int nt = 2 * hh + n2; f32x4 s = (f32x4){0.f, 0.f, 0.f, 0.f};
#pragma unroll
                for (int ks = 0; ks < 9; ++ks) s = mfma16(qf[ks], ld8(Ks + (nt * 16 + (lane & 15)) * 296 + ks * 32 + 8 * (lane >> 4)), s);
#pragma unroll
                for (int r = 0; r < 4; ++r) { const int row = rt * 16 + (lane >> 4) * 4 + r, key = nt * 16 + (lane & 15); float v = s[r];
                    if (fresh && (key >= DECS || key > (row >> 3))) v = -INFINITY;
                    Sf[row * 68 + key] = v; } }
            __syncthreads();
            f32x4 s[4];
#pragma unroll
            for (int nt = 0; nt < 4; ++nt)
#pragma unroll
                for (int r = 0; r < 4; ++r) s[nt][r] = Sf[(rt * 16 + (lane >> 4) * 4 + r) * 68 + nt * 16 + (lane & 15)];
            softmax_strip(s, mrun, lrun, alpha, Ps, lane);
            WAVE_SYNC();
#pragma unroll
            for (int nt = 0; nt < 8; ++nt) {
#pragma unroll
                for (int r = 0; r < 4; ++r) o[nt][r] *= alpha[r];
#pragma unroll
                for (int k2 = 0; k2 < 2; ++k2) o[nt] = mfma16(ld8(Ps + (lane & 15) * 72 + k2 * 32 + 8 * (lane >> 4)), ld8(Lt + (hh * 128 + nt * 16 + (lane & 15)) * 72 + k2 * 32 + 8 * (lane >> 4)), o[nt]); }
            WAVE_SYNC();
        }
        __syncthreads();
#pragma unroll
        for (int nt = 0; nt < 8; ++nt)
#pragma unroll
            for (int r = 0; r < 4; ++r) Of[(rt * 16 + (lane >> 4) * 4 + r) * 260 + hh * 128 + nt * 16 + (lane & 15)] = o[nt][r] / lrun[r];
        __syncthreads();
        {
            const int d = tid & 63, h = tid >> 6; float a[8];
#pragma unroll
            for (int t = 0; t < 8; ++t) a[t] = 0.f;
            for (int l = 0; l < 256; ++l) { const float wv = wuv[(size_t)l * 512 + h * 64 + d];
#pragma unroll
                for (int t = 0; t < 8; ++t) a[t] += Of[(t * 8 + h) * 260 + l] * wv; }
#pragma unroll
            for (int t = 0; t < 8; ++t) OCAT[(mb + t) * D + 512 + h * 64 + d] = (bf16)f2bf(a[t]);
        }
    }
}

constexpr int NCH = SEQ / 64;
constexpr size_t HC_QG = WS_H, HC_BNT = HC_QG + (size_t)BATCH * 8 * NCH * 64 * 128 * 2,
    HC_A = HC_BNT + (size_t)BATCH * 8 * NCH * 128 * 128 * 2, HC_END = HC_A + (size_t)BATCH * 8 * NCH * 128 * 4;
constexpr size_t HC_SNT = WS_QH;
static_assert(HC_END <= WS_H_END && HC_SNT + (size_t)BATCH * 8 * NCH * 128 * 128 * 2 <= WS_OCAT, "hgrn scratch fits");
DEV u32x4 pack8(const float* v) { u32x4 o; o.x = pk2(v[0], v[1]); o.y = pk2(v[2], v[3]); o.z = pk2(v[4], v[5]); o.w = pk2(v[6], v[7]); return o; }

DEV void phase_hgrn_prep(const Ctx& c) {
    bf16* qt = (bf16*)c.lds;
    bf16* kt = qt + 64 * 136;
    bf16* vT = kt + 160 * 136;
    bf16* Ab = vT + 128 * 72;
    float* tot = (float*)(Ab + 64 * 72);
    bf16* kgl = (bf16*)(tot + 512);
    const bf16* PC = c.w<bf16>(WS_P1); float* ORAW = c.w<float>(WS_ORAW);
    bf16* QG = c.w<bf16>(HC_QG); bf16* BNT = c.w<bf16>(HC_BNT); float* Ag = c.w<float>(HC_A);
    const float* lbl = c.in<float>(25);
    const int tid = c.tid, lane = c.lane, w = c.wave;
    const int d = tid & 127, tq = tid >> 7;
    constexpr int NU = BATCH * 8 * NCH;
    bf16 rq[16], rf[16], rv[16];
#define HP_LOAD(u_) do { const int u__ = (u_); const int bh_ = u__ / NCH, n_ = u__ % NCH; const bf16* row_ = PC + ((size_t)(bh_ >> 3) * SEQ + (size_t)n_ * 64 + 16 * tq) * INC + (bh_ & 7) * 128 + d; \
        _Pragma("unroll") for (int i = 0; i < 16; ++i) { rq[i] = row_[(size_t)i * INC]; rf[i] = row_[(size_t)i * INC + 1024]; rv[i] = row_[(size_t)i * INC + 2048]; } } while (0)
    if ((int)blockIdx.x < NU) HP_LOAD(blockIdx.x);
    for (int u = blockIdx.x; u < NU; u += gridDim.x) {
        const int bh = u / NCH, n = u % NCH, b = bh >> 3, h = bh & 7;
        const size_t m0 = (size_t)b * SEQ + (size_t)n * 64;
        const float lb = sigmoidf_(lbl[1024 + h * 128 + d] - lbl[h * 128 + d]);
        float gcl[16], kk[16], qq[16], vv[16];
        float run = 0.f;
#pragma unroll
        for (int i = 0; i < 16; ++i) {
            const float f = lb + (1.f - lb) * sigmoidf_(bf2f(rf[i]));
            kk[i] = 1.f - f; run += __logf(f); gcl[i] = run;
            qq[i] = siluf_(bf2f(rq[i])) * DK_SCALE; vv[i] = bf2f(rv[i]);
        }
        if (u + (int)gridDim.x < NU) HP_LOAD(u + (int)gridDim.x);
        tot[tq * 128 + d] = run;
        { const u32x4 p0 = pack8(vv), p1 = pack8(vv + 8);
          *(u32x4*)(vT + d * 72 + 16 * tq) = p0; *(u32x4*)(vT + d * 72 + 16 * tq + 8) = p1; }
        for (int i = tid; i < 64 * 72 / 8; i += 512) { u32x4 z; z.x = z.y = z.z = z.w = 0u; *(u32x4*)(Ab + 8 * i) = z; }
        LDS_BARRIER();
        const float t0 = tot[d], t1 = tot[128 + d], t2 = tot[256 + d], t3 = tot[384 + d];
        const float rI[4] = {0.f, t0, t0 + t1, t0 + t1 + t2}; const float glast = (t0 + t1) + (t2 + t3);
        const float pre = tq == 0 ? rI[0] : (tq == 1 ? rI[1] : (tq == 2 ? rI[2] : rI[3]));
        float kg[16];
#pragma unroll
        for (int i = 0; i < 16; ++i) {
            const float gc = pre + gcl[i];
            qt[(16 * tq + i) * 136 + d] = (bf16)f2bf(qq[i] * __expf(gcl[i]));
            QG[((size_t)u * 64 + 16 * tq + i) * 128 + d] = (bf16)f2bf(qq[i] * __expf(gc));
            kg[i] = kk[i] * __expf(glast - gc);
#pragma unroll
            for (int I = 0; I < 4; ++I) if (I >= tq) { const int base = I == 0 ? 0 : (I == 1 ? 16 : (I == 2 ? 48 : 96));
                kt[(base + 16 * tq + i) * 136 + d] = (bf16)f2bf(kk[i] * __expf(rI[I] - gc)); }
        }
        { bf16* g = kgl + d * 72 + 16 * tq; *(u32x4*)g = pack8(kg); *(u32x4*)(g + 8) = pack8(kg + 8); }
        if (tq == 0) Ag[(size_t)u * 128 + d] = __expf(glast);
        LDS_BARRIER();
        for (int ti = w; ti < 10; ti += 8) {
            const int I = ti == 0 ? 0 : (ti < 3 ? 1 : (ti < 6 ? 2 : 3)); const int J = ti - (I == 0 ? 0 : (I == 1 ? 1 : (I == 2 ? 3 : 6)));
            const int base = I == 0 ? 0 : (I == 1 ? 16 : (I == 2 ? 48 : 96));
            f32x4 acc = (f32x4){0.f, 0.f, 0.f, 0.f};
#pragma unroll
            for (int ks = 0; ks < 4; ++ks) acc = mfma16(ld8(qt + (16 * I + (lane & 15)) * 136 + ks * 32 + 8 * (lane >> 4)), ld8(kt + (base + 16 * J + (lane & 15)) * 136 + ks * 32 + 8 * (lane >> 4)), acc);
#pragma unroll
            for (int r = 0; r < 4; ++r) { const int i = 16 * I + (lane >> 4) * 4 + r, j = 16 * J + (lane & 15); Ab[i * 72 + j] = (bf16)f2bf((J < I || j <= i) ? acc[r] : 0.f); }
        }
        LDS_BARRIER();
        { const int it = w & 3;
#pragma unroll
          for (int e4 = 0; e4 < 4; ++e4) { const int et = (w >> 2) * 4 + e4; f32x4 acc = (f32x4){0.f, 0.f, 0.f, 0.f};
#pragma unroll
            for (int ks = 0; ks < 2; ++ks) acc = mfma16(ld8(Ab + (16 * it + (lane & 15)) * 72 + ks * 32 + 8 * (lane >> 4)), ld8(vT + (16 * et + (lane & 15)) * 72 + ks * 32 + 8 * (lane >> 4)), acc);
#pragma unroll
            for (int r = 0; r < 4; ++r) ORAW[(m0 + 16 * it + (lane >> 4) * 4 + r) * D + h * 128 + 16 * et + (lane & 15)] = acc[r]; } }
        {
            bf16x8 ka[2];
#pragma unroll
            for (int ks = 0; ks < 2; ++ks) ka[ks] = ld8(kgl + (16 * w + (lane & 15)) * 72 + ks * 32 + 8 * (lane >> 4));
            bf16* g = BNT + (size_t)u * 16384;
#pragma unroll
            for (int et = 0; et < 8; ++et) { f32x4 acc = (f32x4){0.f, 0.f, 0.f, 0.f};
#pragma unroll
                for (int ks = 0; ks < 2; ++ks) acc = mfma16(ka[ks], ld8(vT + (16 * et + (lane & 15)) * 72 + ks * 32 + 8 * (lane >> 4)), acc);
                u32x2 o; o.x = pk2(acc[0], acc[1]); o.y = pk2(acc[2], acc[3]); *(u32x2*)(g + (16 * et + (lane & 15)) * 128 + 16 * w + 4 * (lane >> 4)) = o; }
        }
        LDS_BARRIER();
    }
}

#undef HP_LOAD
DEV void phase_hgrn_prefix(const Ctx& c) {
    const bf16* BNT = c.w<bf16>(HC_BNT); const float* Ag = c.w<float>(HC_A); bf16* SNT = c.w<bf16>(HC_SNT);
    constexpr int NV = BATCH * 8 * 2048;
    for (int v = blockIdx.x * 512 + c.tid; v < NV; v += gridDim.x * 512) {
        const int bh = v >> 11, x8 = (v & 2047) * 8, d0 = x8 & 127, e = x8 >> 7;
        float S[8];
#pragma unroll
        for (int j = 0; j < 8; ++j) S[j] = 0.f;
        const size_t base = (size_t)bh * NCH * 16384 + x8;
        constexpr int PFD = NCH < 8 ? NCH : 8;
        u32x4 bq[PFD]; f32x4 aq0[PFD], aq1[PFD];
#pragma unroll
        for (int j = 0; j < PFD; ++j) { bq[j] = *(const u32x4*)(BNT + base + (size_t)j * 16384); aq0[j] = *(const f32x4*)(Ag + ((size_t)bh * NCH + j) * 128 + d0); aq1[j] = *(const f32x4*)(Ag + ((size_t)bh * NCH + j) * 128 + d0 + 4); }
#pragma unroll
        for (int n = 0; n < NCH; ++n) {
            const u32x4 bv = bq[n % PFD]; const f32x4 a0 = aq0[n % PFD], a1 = aq1[n % PFD];
            if (n + PFD < NCH) { bq[n % PFD] = *(const u32x4*)(BNT + base + (size_t)(n + PFD) * 16384); aq0[n % PFD] = *(const f32x4*)(Ag + ((size_t)bh * NCH + n + PFD) * 128 + d0); aq1[n % PFD] = *(const f32x4*)(Ag + ((size_t)bh * NCH + n + PFD) * 128 + d0 + 4); }
            *(u32x4*)(SNT + base + (size_t)n * 16384) = pack8(S);
            S[0] = a0[0] * S[0] + __uint_as_float(bv.x << 16); S[1] = a0[1] * S[1] + __uint_as_float(bv.x & 0xffff0000u);
            S[2] = a0[2] * S[2] + __uint_as_float(bv.y << 16); S[3] = a0[3] * S[3] + __uint_as_float(bv.y & 0xffff0000u);
            S[4] = a1[0] * S[4] + __uint_as_float(bv.z << 16); S[5] = a1[1] * S[5] + __uint_as_float(bv.z & 0xffff0000u);
            S[6] = a1[2] * S[6] + __uint_as_float(bv.w << 16); S[7] = a1[3] * S[7] + __uint_as_float(bv.w & 0xffff0000u);
        }
        float* So = c.out + O_HGP + (size_t)bh * 16384;
#pragma unroll
        for (int j = 0; j < 8; ++j) So[(size_t)(d0 + j) * 128 + e] = S[j];
    }
}

DEV void phase_hgrn_out(const Ctx& c) {
    bf16* qg = (bf16*)c.lds;
    bf16* StT = qg + 64 * 136;
    float* ob = (float*)(StT + 128 * 136);
    const bf16* PC = c.w<bf16>(WS_P1); const float* ORAW = c.w<float>(WS_ORAW); bf16* OC = c.w<bf16>(WS_OCAT);
    const bf16* QG = c.w<bf16>(HC_QG); const bf16* SNT = c.w<bf16>(HC_SNT);
    const float* gn = c.in<float>(26);
    const int tid = c.tid, lane = c.lane, w = c.wave;
    const float gn0 = gn[lane], gn1 = gn[64 + lane];
    constexpr int NU = BATCH * 8 * NCH;
    u32x4 pq[2], ps[4]; float or0n[8], or1n[8]; bf16 zz0n[8], zz1n[8];
#define HO_LOAD(u_) do { const int u__ = (u_); const int bh_ = u__ / NCH, n_ = u__ % NCH, b_ = bh_ >> 3, h_ = bh_ & 7; const size_t m0_ = (size_t)b_ * SEQ + (size_t)n_ * 64; \
        _Pragma("unroll") for (int j = 0; j < 2; ++j) pq[j] = *(const u32x4*)(QG + (size_t)u__ * 8192 + 8 * (tid + 512 * j)); \
        _Pragma("unroll") for (int j = 0; j < 4; ++j) ps[j] = *(const u32x4*)(SNT + (size_t)u__ * 16384 + 8 * (tid + 512 * j)); \
        _Pragma("unroll") for (int i8 = 0; i8 < 8; ++i8) { const size_t m = m0_ + w * 8 + i8; or0n[i8] = ORAW[m * D + h_ * 128 + lane]; or1n[i8] = ORAW[m * D + h_ * 128 + 64 + lane]; \
            zz0n[i8] = PC[m * INC + 3072 + h_ * 128 + lane]; zz1n[i8] = PC[m * INC + 3072 + h_ * 128 + 64 + lane]; } } while (0)
    if ((int)blockIdx.x < NU) HO_LOAD(blockIdx.x);
    for (int u = blockIdx.x; u < NU; u += gridDim.x) {
        const int bh = u / NCH, n = u % NCH, b = bh >> 3, h = bh & 7; const size_t m0 = (size_t)b * SEQ + (size_t)n * 64;
        float or0[8], or1[8], zz0[8], zz1[8];
#pragma unroll
        for (int i8 = 0; i8 < 8; ++i8) { or0[i8] = or0n[i8]; or1[i8] = or1n[i8]; zz0[i8] = bf2f(zz0n[i8]); zz1[i8] = bf2f(zz1n[i8]); }
        LDS_BARRIER();
#pragma unroll
        for (int j = 0; j < 2; ++j) { const int idx = tid + 512 * j; *(u32x4*)(qg + (idx >> 4) * 136 + (idx & 15) * 8) = pq[j]; }
#pragma unroll
        for (int j = 0; j < 4; ++j) { const int idx = tid + 512 * j; *(u32x4*)(StT + (idx >> 4) * 136 + (idx & 15) * 8) = ps[j]; }
        if (u + (int)gridDim.x < NU) HO_LOAD(u + (int)gridDim.x);
        LDS_BARRIER();
        { const int it = w & 3; bf16x8 qa[4];
#pragma unroll
          for (int ks = 0; ks < 4; ++ks) qa[ks] = ld8(qg + (16 * it + (lane & 15)) * 136 + ks * 32 + 8 * (lane >> 4));
#pragma unroll
          for (int e4 = 0; e4 < 4; ++e4) { const int et = (w >> 2) * 4 + e4; f32x4 acc = (f32x4){0.f, 0.f, 0.f, 0.f};
#pragma unroll
            for (int ks = 0; ks < 4; ++ks) acc = mfma16(qa[ks], ld8(StT + (16 * et + (lane & 15)) * 136 + ks * 32 + 8 * (lane >> 4)), acc);
#pragma unroll
            for (int r = 0; r < 4; ++r) ob[(16 * it + (lane >> 4) * 4 + r) * 132 + 16 * et + (lane & 15)] = acc[r]; } }
        LDS_BARRIER();
        { float ss[8];
#pragma unroll
          for (int i8 = 0; i8 < 8; ++i8) { const int i = w * 8 + i8; or0[i8] += ob[i * 132 + lane]; or1[i8] += ob[i * 132 + 64 + lane]; ss[i8] = or0[i8] * or0[i8] + or1[i8] * or1[i8]; }
#pragma unroll
              for (int i8 = 0; i8 < 8; ++i8) ss[i8] = wave_sum(ss[i8]);
#pragma unroll
          for (int i8 = 0; i8 < 8; ++i8) { const size_t m = m0 + w * 8 + i8; const float r = rsqrtf(ss[i8] * (1.f / 128.f) + EPS);
            OC[m * D + h * 128 + lane] = (bf16)f2bf(or0[i8] * r * gn0 * siluf_(zz0[i8])); OC[m * D + h * 128 + 64 + lane] = (bf16)f2bf(or1[i8] * r * gn1 * siluf_(zz1[i8])); } }
    }
}


constexpr int NUG = BATCH * 4 * NCH;
constexpr size_t GC_W = WS_H, GC_UT = GC_W + (size_t)NUG * 64 * 128 * 2, GC_QG = GC_UT + (size_t)NUG * 128 * 64 * 4, GC_KGT = GC_QG + (size_t)NUG * 64 * 128 * 2,
    GC_AQK = GC_KGT + (size_t)NUG * 128 * 64 * 2, GC_GL = GC_AQK + (size_t)NUG * 64 * 64 * 2, GC_END = GC_GL + (size_t)NUG * 4;
static_assert(GC_END <= WS_H_END, "gdn scratch fits in H");

DEV void phase_gdn_prep(const Ctx& c) {
    bf16* qb = (bf16*)c.lds;
    bf16* kb = qb + 64 * 136;
    float* Lm = (float*)(kb + 64 * 136);
    float* part = Lm + 64 * 68;
    float* gl = part + 256; float* gcs = gl + 64; float* bet = gcs + 64; float* eg = bet + 64; float* egl = eg + 64; float* qn = egl + 64; float* kn = qn + 64;
    float* sqb = kn + 64;
    const bf16* P1 = c.w<bf16>(WS_P1);
    bf16* Wg = c.w<bf16>(GC_W); float* UTg = c.w<float>(GC_UT); bf16* QGg = c.w<bf16>(GC_QG); bf16* KGTg = c.w<bf16>(GC_KGT); bf16* AQKg = c.w<bf16>(GC_AQK); float* GLg = c.w<float>(GC_GL);
    const float* convw = c.in<float>(14);
    const int tid = c.tid, lane = c.lane, w = c.wave;
    const int role = tid >> 7, cc = tid & 127;
    for (int u = blockIdx.x; u < NUG; u += gridDim.x) {
        const int bh = u / NCH, n = u % NCH, b = bh >> 2, h = bh & 3;
        const size_t m0 = (size_t)b * SEQ + (size_t)n * 64;
        float x[64];
        if (role < 3) {
            const int col = role * 512 + h * 128 + cc;
            const float w0 = convw[col], w1 = convw[QKV_A + col], w2 = convw[2 * QKV_A + col], w3 = convw[3 * QKV_A + col];
            const bf16* src = P1 + m0 * LD1 + col;
            float p0 = 0.f, p1 = 0.f, p2 = 0.f;
            if (n > 0) { p0 = bf2f(src[-3 * (long)LD1]); p1 = bf2f(src[-2 * (long)LD1]); p2 = bf2f(src[-1 * (long)LD1]); }
#pragma unroll
            for (int j = 0; j < 64; ++j) x[j] = bf2f(src[(size_t)j * LD1]);
#pragma unroll
            for (int j = 0; j < 64; ++j) { const float cur = x[j]; const float y = w0 * p0 + w1 * p1 + w2 * p2 + w3 * cur; x[j] = siluf_(y); p0 = p1; p1 = p2; p2 = cur; }
            if (role < 2) {
#pragma unroll
                for (int j4 = 0; j4 < 16; ++j4) *(f32x4*)(sqb + tid * 68 + 4 * j4) = (f32x4){x[4 * j4] * x[4 * j4], x[4 * j4 + 1] * x[4 * j4 + 1], x[4 * j4 + 2] * x[4 * j4 + 2], x[4 * j4 + 3] * x[4 * j4 + 3]};
            }
        } else if (cc < 64) {
            const float Aexp = __expf(c.in<float>(15)[h]), dtb = c.in<float>(16)[h];
            bet[cc] = sigmoidf_(bf2f(P1[(m0 + cc) * LD1 + C_B + h]));
            gl[cc] = -Aexp * softplusf_(bf2f(P1[(m0 + cc) * LD1 + C_A + h]) + dtb);
        }
        __syncthreads();
        if (role == 3) {
            if (cc < 64) { float acc = 0.f, totl = 0.f;
                for (int i = 0; i < 64; ++i) { const float g = gl[i]; totl += g; if (i <= cc) acc += g; }
                gcs[cc] = acc; eg[cc] = __expf(acc); egl[cc] = __expf(totl - acc);
                if (cc == 0) GLg[u] = __expf(totl);
            } else { const int j = cc - 64; float sq = 0.f, sk = 0.f;
#pragma unroll 16
                for (int cx = 0; cx < 128; ++cx) { sq += sqb[cx * 68 + j]; sk += sqb[(128 + cx) * 68 + j]; }
                qn[j] = rsqrtf(sq + EPS); kn[j] = rsqrtf(sk + EPS); }
        }
        __syncthreads();
        if (role == 0) {
#pragma unroll
            for (int j = 0; j < 64; ++j) { const float qh = x[j] * qn[j]; qb[j * 136 + cc] = (bf16)f2bf(qh); QGg[((size_t)u * 64 + j) * 128 + cc] = (bf16)f2bf(qh * DK_SCALE * eg[j]); }
        } else if (role == 1) {
            bf16* g = KGTg + ((size_t)u * 128 + cc) * 64;
#pragma unroll
            for (int j8 = 0; j8 < 8; ++j8) { float t[8];
#pragma unroll
                for (int q = 0; q < 8; ++q) { const int j = 8 * j8 + q; const float kh = x[j] * kn[j]; kb[j * 136 + cc] = (bf16)f2bf(kh); t[q] = kh * egl[j]; x[j] = kh * bet[j] * eg[j]; }
                *(u32x4*)(g + 8 * j8) = pack8(t); }
        } else if (role == 2) {
#pragma unroll
            for (int j = 0; j < 64; ++j) x[j] *= bet[j];
        }
        __syncthreads();
        for (int ti = w; ti < 32; ti += 8) {
            const bool isq = ti >= 16; const int I = (ti & 15) >> 2, J = ti & 3;
            if (J > I) { if (isq) {
#pragma unroll
                    for (int r = 0; r < 4; ++r) AQKg[((size_t)u * 64 + 16 * I + (lane >> 4) * 4 + r) * 64 + 16 * J + (lane & 15)] = (bf16)0; }
                continue; }
            const bf16* Ab = isq ? qb : kb;
            f32x4 acc = (f32x4){0.f, 0.f, 0.f, 0.f};
#pragma unroll
            for (int ks = 0; ks < 4; ++ks) acc = mfma16(ld8(Ab + (16 * I + (lane & 15)) * 136 + ks * 32 + 8 * (lane >> 4)), ld8(kb + (16 * J + (lane & 15)) * 136 + ks * 32 + 8 * (lane >> 4)), acc);
#pragma unroll
            for (int r = 0; r < 4; ++r) { const int i = 16 * I + (lane >> 4) * 4 + r, j = 16 * J + (lane & 15);
                const float dcy = __expf(fminf(gcs[i] - gcs[j], 0.f));
                if (isq) AQKg[((size_t)u * 64 + i) * 64 + j] = (bf16)f2bf(i >= j ? acc[r] * DK_SCALE * dcy : 0.f);
                else Lm[i * 68 + j] = i > j ? bet[i] * acc[r] * dcy : 0.f; }
        }
        __syncthreads();
        if (role == 1 || role == 2) {
#pragma unroll
            for (int i = 1; i < 64; ++i) { float acc = x[i];
#pragma unroll
                for (int j = 0; j < i; ++j) acc -= Lm[i * 68 + j] * x[j];
                x[i] = acc; }
            if (role == 1) {
#pragma unroll
                for (int i = 0; i < 64; ++i) Wg[((size_t)u * 64 + i) * 128 + cc] = (bf16)f2bf(x[i]);
            } else { float* g = UTg + ((size_t)u * 128 + cc) * 64;
#pragma unroll
                for (int i4 = 0; i4 < 16; ++i4) *(f32x4*)(g + 4 * i4) = (f32x4){x[4 * i4], x[4 * i4 + 1], x[4 * i4 + 2], x[4 * i4 + 3]}; }
        }
        __syncthreads();
    }
}

DEV void phase_gdn_scan(const Ctx& c, int u_first, int u_stride) {
    bf16* wl = (bf16*)c.lds;
    bf16* qgl = wl + 64 * 136;
    bf16* kgT = qgl + 64 * 136;
    bf16* aqk = kgT + 128 * 72;
    bf16* StT = aqk + 64 * 72;
    bf16* vnT = StT + 128 * 136;
    float* ob = (float*)(vnT + 128 * 72);
    const bf16* P1 = c.w<bf16>(WS_P1); bf16* OCAT = c.w<bf16>(WS_OCAT);
    const bf16* Wg = c.w<bf16>(GC_W); const float* UTg = c.w<float>(GC_UT); const bf16* QGg = c.w<bf16>(GC_QG); const bf16* KGTg = c.w<bf16>(GC_KGT); const bf16* AQKg = c.w<bf16>(GC_AQK); const float* GLg = c.w<float>(GC_GL);
    const float* gn = c.in<float>(17);
    const int tid = c.tid, lane = c.lane, w = c.wave;
    constexpr int NU = BATCH * 4;
    for (int u = u_first; u < NU; u += u_stride) {
        const int b = u >> 2, h = u & 3; const size_t mb = (size_t)b * SEQ;
        f32x4 S[8];
#pragma unroll
        for (int et = 0; et < 8; ++et) S[et] = (f32x4){0.f, 0.f, 0.f, 0.f};
        __syncthreads();
        for (int i = tid; i < 128 * 136 / 8; i += 512) { u32x4 z; z.x = z.y = z.z = z.w = 0u; *(u32x4*)(StT + 8 * i) = z; }
        u32x4 pw[2], pq[2], pk[2], pa;
        const size_t cu0 = (size_t)u * NCH;
#define GD_LOAD(n_) do { const bf16* g0 = Wg + (cu0 + (n_)) * 64 * 128; const bf16* g1 = QGg + (cu0 + (n_)) * 64 * 128; const bf16* g2 = KGTg + (cu0 + (n_)) * 128 * 64; const bf16* g3 = AQKg + (cu0 + (n_)) * 64 * 64; \
            _Pragma("unroll") for (int j = 0; j < 2; ++j) { const int idx = tid + 512 * j; pw[j] = *(const u32x4*)(g0 + 8 * idx); pq[j] = *(const u32x4*)(g1 + 8 * idx); pk[j] = *(const u32x4*)(g2 + 8 * idx); } \
            pa = *(const u32x4*)(g3 + 8 * tid); } while (0)
#define GD_STORE_WQ() do { _Pragma("unroll") for (int j = 0; j < 2; ++j) { const int idx = tid + 512 * j; *(u32x4*)(wl + (idx >> 4) * 136 + (idx & 15) * 8) = pw[j]; *(u32x4*)(qgl + (idx >> 4) * 136 + (idx & 15) * 8) = pq[j]; } } while (0)
#define GD_STORE_KA() do { _Pragma("unroll") for (int j = 0; j < 2; ++j) { const int idx = tid + 512 * j; *(u32x4*)(kgT + (idx >> 3) * 72 + (idx & 7) * 8) = pk[j]; } \
            *(u32x4*)(aqk + (tid >> 3) * 72 + (tid & 7) * 8) = pa; } while (0)
        GD_LOAD(0); GD_STORE_WQ(); GD_STORE_KA();
        __syncthreads();
        const int it = w & 3;
        const float gn0 = gn[lane], gn1 = gn[64 + lane];
        f32x4 u4[4]; float dec, decn;
#define GD_LOADU(dst, dd, n_) do { _Pragma("unroll") for (int e4 = 0; e4 < 4; ++e4) { const int et = (w >> 2) * 4 + e4; dst[e4] = *(const f32x4*)(UTg + ((cu0 + (n_)) * 128 + 16 * et + (lane & 15)) * 64 + 16 * it + 4 * (lane >> 4)); } dd = GLg[cu0 + (n_)]; } while (0)
        GD_LOADU(u4, decn, 0);
        for (int n = 0; n < NCH; ++n) {
            dec = decn;
            if (n + 1 < NCH) GD_LOAD(n + 1);
            f32x4 ao[4];
            bf16x8 wa[4], qa[4];
#pragma unroll
            for (int ks = 0; ks < 4; ++ks) { wa[ks] = ld8(wl + (16 * it + (lane & 15)) * 136 + ks * 32 + 8 * (lane >> 4)); qa[ks] = ld8(qgl + (16 * it + (lane & 15)) * 136 + ks * 32 + 8 * (lane >> 4)); }
#pragma unroll
            for (int e4 = 0; e4 < 4; ++e4) { const int et = (w >> 2) * 4 + e4; f32x4 av = (f32x4){0.f, 0.f, 0.f, 0.f}; ao[e4] = (f32x4){0.f, 0.f, 0.f, 0.f};
#pragma unroll
                for (int ks = 0; ks < 4; ++ks) { const bf16x8 bs = ld8(StT + (16 * et + (lane & 15)) * 136 + ks * 32 + 8 * (lane >> 4));
                    av = mfma16(wa[ks], bs, av);
                    ao[e4] = mfma16(qa[ks], bs, ao[e4]); }
                const f32x4 vn = u4[e4] - av;
                u32x2 o; o.x = pk2(vn[0], vn[1]); o.y = pk2(vn[2], vn[3]); *(u32x2*)(vnT + (16 * et + (lane & 15)) * 72 + 16 * it + 4 * (lane >> 4)) = o; }
            if (n + 1 < NCH) GD_LOADU(u4, decn, n + 1);
            LDS_BARRIER();
            float zz0[8], zz1[8];
#pragma unroll
            for (int i8 = 0; i8 < 8; ++i8) { const size_t m = mb + (size_t)n * 64 + w * 8 + i8; zz0[i8] = bf2f(P1[m * LD1 + C_Z + h * 128 + lane]); zz1[i8] = bf2f(P1[m * LD1 + C_Z + h * 128 + 64 + lane]); }
#pragma unroll
            for (int e4 = 0; e4 < 4; ++e4) { const int et = (w >> 2) * 4 + e4;
#pragma unroll
                for (int ks = 0; ks < 2; ++ks) ao[e4] = mfma16(ld8(aqk + (16 * it + (lane & 15)) * 72 + ks * 32 + 8 * (lane >> 4)), ld8(vnT + (16 * et + (lane & 15)) * 72 + ks * 32 + 8 * (lane >> 4)), ao[e4]);
#pragma unroll
                for (int r = 0; r < 4; ++r) ob[(16 * it + (lane >> 4) * 4 + r) * 132 + 16 * et + (lane & 15)] = ao[e4][r]; }
#pragma unroll
            for (int et = 0; et < 8; ++et) { S[et] = S[et] * dec;
#pragma unroll
                for (int ks = 0; ks < 2; ++ks) S[et] = mfma16(ld8(kgT + (16 * w + (lane & 15)) * 72 + ks * 32 + 8 * (lane >> 4)), ld8(vnT + (16 * et + (lane & 15)) * 72 + ks * 32 + 8 * (lane >> 4)), S[et]);
                u32x2 o; o.x = pk2(S[et][0], S[et][1]); o.y = pk2(S[et][2], S[et][3]); *(u32x2*)(StT + (16 * et + (lane & 15)) * 136 + 16 * w + (lane >> 4) * 4) = o; }
            if (n + 1 < NCH) GD_STORE_WQ();
            LDS_BARRIER();
            { float ss[8], v0[8], v1[8];
#pragma unroll
              for (int i8 = 0; i8 < 8; ++i8) { const int i = w * 8 + i8; v0[i8] = ob[i * 132 + lane]; v1[i8] = ob[i * 132 + 64 + lane]; ss[i8] = v0[i8] * v0[i8] + v1[i8] * v1[i8]; }
#pragma unroll
              for (int i8 = 0; i8 < 8; ++i8) ss[i8] = wave_sum(ss[i8]);
#pragma unroll
              for (int i8 = 0; i8 < 8; ++i8) { const size_t m = mb + (size_t)n * 64 + w * 8 + i8; const float r = rsqrtf(ss[i8] * (1.f / 128.f) + EPS);
                OCAT[m * D + h * 128 + lane] = (bf16)f2bf(v0[i8] * r * gn0 * siluf_(zz0[i8])); OCAT[m * D + h * 128 + 64 + lane] = (bf16)f2bf(v1[i8] * r * gn1 * siluf_(zz1[i8])); } }
            if (n + 1 < NCH) GD_STORE_KA();
        }
#undef GD_LOAD
#undef GD_LOADU
#undef GD_STORE_WQ
#undef GD_STORE_KA
        float* So = c.out + O_GDNP + (size_t)(b * 4 + h) * 16384;
#pragma unroll
        for (int et = 0; et < 8; ++et)
#pragma unroll
            for (int r = 0; r < 4; ++r) So[(size_t)(16 * w + (lane >> 4) * 4 + r) * 128 + 16 * et + (lane & 15)] = S[et][r];
    }
}


template <int NT> DEV void softmax_rows(f32x4 (&s)[NT], float (&mrun)[4], float (&lrun)[4], float (&alpha)[4], bf16* Ps, int pitch, int lane) {
#pragma unroll
    for (int r = 0; r < 4; ++r) {
        float mx = s[0][r];
#pragma unroll
        for (int nt = 1; nt < NT; ++nt) mx = fmaxf(mx, s[nt][r]);
        mx = grp16_max(mx);
        const float mn = fmaxf(mrun[r], mx);
        alpha[r] = exp2f_(mrun[r] - mn); mrun[r] = mn;
        float sum = 0.f;
#pragma unroll
        for (int nt = 0; nt < NT; ++nt) { const float p = exp2f_(s[nt][r] - mn); s[nt][r] = p; sum += p; }
        sum = grp16_sum(sum); lrun[r] = lrun[r] * alpha[r] + sum;
    }
#pragma unroll
    for (int nt = 0; nt < NT; ++nt)
#pragma unroll
        for (int r = 0; r < 4; ++r) Ps[((lane >> 4) * 4 + r) * pitch + nt * 16 + (lane & 15)] = (bf16)f2bf(s[nt][r]);
}
DEV bf16x8 ldB_tr(const bf16* T, int pitch, int k0, int n0, int lane) {
    const bf16* p = T + (size_t)(k0 + 8 * (lane >> 4) + ((lane & 15) >> 2)) * pitch + n0 + 4 * (lane & 3);
    const s16x4 a = lds_tr(p), b = lds_tr(p + 4 * pitch);
    bf16x8 r; r[0] = a[0]; r[1] = a[1]; r[2] = a[2]; r[3] = a[3]; r[4] = b[0]; r[5] = b[1]; r[6] = b[2]; r[7] = b[3]; return r;
}
constexpr int AS_NSP = 2;
DEV void phase_attn_sample2(const Ctx& c) {
    bf16* Qs = (bf16*)c.lds;
    bf16* Kt0 = Qs + 64 * 296;
    bf16* Psb = Kt0 + 2 * 32 * 296;
    bf16* qtmp = Kt0;
    float* Xo = (float*)c.lds;
    float* Xm = Xo + 64 * 256; float* Xl = Xm + 64;
    const float* QH = c.w<float>(WS_QH); const float* rope = c.w<float>(WS_ROPE); const bf16* WUKB = c.w<bf16>(WS_WUKB);
    float* PO = c.w<float>(WS_PO); float* PM = c.w<float>(WS_PM); float* PL = c.w<float>(WS_PL);
    const float* clat = c.in<float>(4); const float* ckr = c.in<float>(5); const int* ptab = c.in<int>(7);
    const int tid = c.tid, lane = c.lane, w = c.wave, grp = w >> 2, wq = w & 3, gt = tid & 255;
    bf16* Kt = Kt0 + grp * 32 * 296; bf16* Ps = Psb + w * 16 * 40;
    constexpr int NPT32 = PAST / 32, TPS = NPT32 / AS_NSP;
    static_assert(NPT32 % (2 * AS_NSP) == 0, "tiles per split must be even");
    for (int u = blockIdx.x; u < DECB * AS_NSP; u += gridDim.x) {
        const int b = u / AS_NSP, sp = u % AS_NSP; const size_t mb = (size_t)MP + (size_t)b * DECS;
        __syncthreads();
        for (int idx = tid; idx < 64 * 8; idx += 512) { const int r = idx >> 3, ch = idx & 7, t = r >> 3, h = r & 7; const float* q = QH + (mb + t) * 768 + h * 96 + ch * 8;
            const f32x4 a = *(const f32x4*)q, bq = *(const f32x4*)(q + 4); u32x4 o; o.x = pk2(a[0], a[1]); o.y = pk2(a[2], a[3]); o.z = pk2(bq[0], bq[1]); o.w = pk2(bq[2], bq[3]); *(u32x4*)(qtmp + r * 72 + ch * 8) = o; }
        for (int idx = tid; idx < 64 * 16; idx += 512) { const int r = idx >> 4, f = idx & 15, t = r >> 3, h = r & 7; const float* qrow = QH + (mb + t) * 768 + h * 96 + 64;
            const float* rt = rope + (size_t)(SEQ + t) * 32; const float cs = rt[f], sn = rt[16 + f], x1 = qrow[f], x2 = qrow[16 + f];
            Qs[r * 296 + 256 + f] = (bf16)f2bf((x1 * cs - x2 * sn) * QK_SCALE2); Qs[r * 296 + 272 + f] = (bf16)f2bf((x2 * cs + x1 * sn) * QK_SCALE2); }
        __syncthreads();
        {
            const int h = w; bf16x8 af[2];
#pragma unroll
            for (int ks = 0; ks < 2; ++ks) af[ks] = ld8(qtmp + (((lane & 7)) * 8 + h) * 72 + ks * 32 + 8 * (lane >> 4));
#pragma unroll 4
            for (int nt = 0; nt < 16; ++nt) { f32x4 acc = (f32x4){0.f, 0.f, 0.f, 0.f};
#pragma unroll
                for (int ks = 0; ks < 2; ++ks) acc = mfma16(af[ks], ld8(WUKB + (size_t)(nt * 16 + (lane & 15)) * 512 + h * 64 + ks * 32 + 8 * (lane >> 4)), acc);
                if ((lane >> 4) < 2) {
#pragma unroll
                    for (int r = 0; r < 4; ++r) Qs[(((lane >> 4) * 4 + r) * 8 + h) * 296 + nt * 16 + (lane & 15)] = (bf16)f2bf(acc[r] * QK_SCALE2); } }
        }
        __syncthreads();
        float mrun[4], lrun[4], alpha[4]; f32x4 o[16];
#pragma unroll
        for (int r = 0; r < 4; ++r) { mrun[r] = -INFINITY; lrun[r] = 0.f; }
#pragma unroll
        for (int nt = 0; nt < 16; ++nt) o[nt] = (f32x4){0.f, 0.f, 0.f, 0.f};
        const int t_begin = sp * TPS, t_end = t_begin + TPS + (sp == AS_NSP - 1 ? 1 : 0);
        const int NI = (t_end - t_begin + 1) / 2;
        static_assert(NPAGES <= 64, "page table of one batch row is held one entry per lane");
        const int ptv = lane < NPAGES ? ptab[b * NPAGES + lane] : 0;
#ifdef HIPEMU
#define PT_LOOKUP(pg_) __shfl(ptv, (pg_))
#else
#define PT_LOOKUP(pg_) __builtin_amdgcn_readlane(ptv, (pg_))
#endif
        f32x4 plA[8], prA, plB[8], prB;
        const float* nl = c.out + O_LATS + (size_t)b * DECS * 256; const float* nk = c.out + O_KPES + (size_t)b * DECS * 32;
#define AS_LOAD(pl, pr, tile_) do { const int tl_ = (tile_); \
            if (tl_ < NPT32) { const int k0_ = tl_ * 32; const size_t rb_ = (size_t)PT_LOOKUP(k0_ >> 7) * PAGE + (k0_ & 127); \
                _Pragma("unroll") for (int j = 0; j < 8; ++j) { const int idx = gt + 256 * j; pl[j] = *(const f32x4*)(clat + (rb_ + (idx >> 6)) * 256 + 4 * (idx & 63)); } \
                pr = *(const f32x4*)(ckr + (rb_ + (gt >> 3)) * 32 + 4 * (gt & 7)); } \
            else if (tl_ == NPT32) { \
                _Pragma("unroll") for (int j = 0; j < 8; ++j) { const int idx = gt + 256 * j, key = idx >> 6; pl[j] = key < DECS ? *(const f32x4*)(nl + key * 256 + 4 * (idx & 63)) : (f32x4){0.f, 0.f, 0.f, 0.f}; } \
                pr = (gt >> 3) < DECS ? *(const f32x4*)(nk + (gt >> 3) * 32 + 4 * (gt & 7)) : (f32x4){0.f, 0.f, 0.f, 0.f}; } } while (0)
#define AS_ITER(pl, pr, it_) do { \
            const int tile = t_begin + 2 * (it_) + grp; const bool valid = tile < t_end; \
            if (valid) { \
                _Pragma("unroll") for (int j = 0; j < 8; ++j) { const int idx = gt + 256 * j; u32x2 pk; pk.x = pk2(pl[j][0], pl[j][1]); pk.y = pk2(pl[j][2], pl[j][3]); *(u32x2*)(Kt + (idx >> 6) * 296 + 4 * (idx & 63)) = pk; } \
                { u32x2 pk; pk.x = pk2(pr[0], pr[1]); pk.y = pk2(pr[2], pr[3]); *(u32x2*)(Kt + (gt >> 3) * 296 + 256 + 4 * (gt & 7)) = pk; } \
            } \
            { const int nt_ = tile + 4; AS_LOAD(pl, pr, nt_ < t_end ? nt_ : NPT32 + 1); } \
            LDS_BARRIER(); \
            if (valid) { \
                f32x4 s[2]; \
                _Pragma("unroll") for (int nt = 0; nt < 2; ++nt) { s[nt] = (f32x4){0.f, 0.f, 0.f, 0.f}; \
                    _Pragma("unroll") for (int ks = 0; ks < 9; ++ks) s[nt] = mfma16(ld8(Qs + (wq * 16 + (lane & 15)) * 296 + ks * 32 + 8 * (lane >> 4)), ld8(Kt + (nt * 16 + (lane & 15)) * 296 + ks * 32 + 8 * (lane >> 4)), s[nt]); } \
                if (tile == NPT32) { \
                    _Pragma("unroll") for (int nt = 0; nt < 2; ++nt) \
                        _Pragma("unroll") for (int r = 0; r < 4; ++r) { const int row = wq * 16 + (lane >> 4) * 4 + r, key = nt * 16 + (lane & 15); if (key >= DECS || key > (row >> 3)) s[nt][r] = -INFINITY; } \
                } \
                softmax_rows<2>(s, mrun, lrun, alpha, Ps, 40, lane); \
                WAVE_SYNC(); \
                const bf16x8 pf = ld8(Ps + (lane & 15) * 40 + 8 * (lane >> 4)); \
                if (wave_any((alpha[0] != 1.f) | (alpha[1] != 1.f) | (alpha[2] != 1.f) | (alpha[3] != 1.f))) { \
                    _Pragma("unroll") for (int nt = 0; nt < 16; ++nt) \
                        _Pragma("unroll") for (int r = 0; r < 4; ++r) o[nt][r] *= alpha[r]; } \
                _Pragma("unroll") for (int nt = 0; nt < 16; ++nt) o[nt] = mfma16(pf, ldB_tr(Kt, 296, 0, nt * 16, lane), o[nt]); \
            } \
            LDS_BARRIER(); } while (0)
        AS_LOAD(plA, prA, t_begin + grp < t_end ? t_begin + grp : NPT32 + 1);
        AS_LOAD(plB, prB, t_begin + 2 + grp < t_end ? t_begin + 2 + grp : NPT32 + 1);
#pragma unroll 1
        for (int it = 0; it < NI; it += 2) {
            AS_ITER(plA, prA, it);
            if (it + 1 < NI) AS_ITER(plB, prB, it + 1);
        }
#undef AS_ITER
#undef PT_LOOKUP
#undef AS_LOAD
        int lane2 = lane; OPAQUE_V(lane2);
        if (grp == 1) {
#pragma unroll
            for (int nt = 0; nt < 16; ++nt)
#pragma unroll
                for (int r = 0; r < 4; ++r) Xo[(wq * 16 + (lane2 >> 4) * 4 + r) * 256 + nt * 16 + (lane2 & 15)] = o[nt][r];
            if ((lane2 & 15) == 0) {
#pragma unroll
                for (int r = 0; r < 4; ++r) { Xm[wq * 16 + (lane2 >> 4) * 4 + r] = mrun[r]; Xl[wq * 16 + (lane2 >> 4) * 4 + r] = lrun[r]; } }
        }
        __syncthreads();
        if (grp == 0) {
            float a1[4], a2[4];
#pragma unroll
            for (int r = 0; r < 4; ++r) { const int row = wq * 16 + (lane2 >> 4) * 4 + r; const float m2 = Xm[row], l2 = Xl[row]; const float mm = fmaxf(mrun[r], m2);
                a1[r] = exp2f_(mrun[r] - mm); a2[r] = exp2f_(m2 - mm); lrun[r] = lrun[r] * a1[r] + l2 * a2[r]; mrun[r] = mm;
                if ((lane2 & 15) == 0) { PM[(size_t)u * 64 + row] = mm; PL[(size_t)u * 64 + row] = lrun[r]; } }
#pragma unroll
            for (int nt = 0; nt < 16; ++nt)
#pragma unroll
                for (int r = 0; r < 4; ++r) { const int row = wq * 16 + (lane2 >> 4) * 4 + r, col = nt * 16 + (lane2 & 15); PO[((size_t)u * 64 + row) * 256 + col] = o[nt][r] * a1[r] + Xo[row * 256 + col] * a2[r]; }
        }
    }
}
DEV void phase_attn_sample_combine(const Ctx& c) {
    bf16* Ol = (bf16*)c.lds;
    const float* PO = c.w<float>(WS_PO); const float* PM = c.w<float>(WS_PM); const float* PL = c.w<float>(WS_PL);
    const bf16* WUV = c.w<bf16>(WS_WUKV) + (size_t)512 * 256; bf16* OCAT = c.w<bf16>(WS_OCAT);
    const int tid = c.tid, lane = c.lane, w = c.wave;
    for (int b = (int)gridDim.x - 1 - (int)blockIdx.x; b < DECB; b += gridDim.x) {
        const size_t mb = (size_t)MP + (size_t)b * DECS;
        __syncthreads();
        for (int idx = tid; idx < 64 * 64; idx += 512) { const int row = idx >> 6, c4 = idx & 63;
            float mm = -INFINITY;
#pragma unroll
            for (int s = 0; s < AS_NSP; ++s) mm = fmaxf(mm, PM[((size_t)b * AS_NSP + s) * 64 + row]);
            float lt = 0.f; f32x4 acc = (f32x4){0.f, 0.f, 0.f, 0.f};
#pragma unroll
            for (int s = 0; s < AS_NSP; ++s) { const size_t ur = ((size_t)b * AS_NSP + s) * 64 + row; const float a = exp2f_(PM[ur] - mm); lt += PL[ur] * a; acc += *(const f32x4*)(PO + ur * 256 + 4 * c4) * a; }
            const float inv = 1.f / lt; u32x2 o; o.x = pk2(acc[0] * inv, acc[1] * inv); o.y = pk2(acc[2] * inv, acc[3] * inv); *(u32x2*)(Ol + row * 264 + 4 * c4) = o; }
        __syncthreads();
        { const int h = w;
#pragma unroll
          for (int nt = 0; nt < 4; ++nt) { f32x4 acc = (f32x4){0.f, 0.f, 0.f, 0.f};
#pragma unroll
            for (int ks = 0; ks < 8; ++ks) acc = mfma16(ld8(Ol + ((lane & 7) * 8 + h) * 264 + ks * 32 + 8 * (lane >> 4)), ld8(WUV + (size_t)(h * 64 + nt * 16 + (lane & 15)) * 256 + ks * 32 + 8 * (lane >> 4)), acc);
            if ((lane >> 4) < 2) {
#pragma unroll
                for (int r = 0; r < 4; ++r) OCAT[(mb + (lane >> 4) * 4 + r) * D + 512 + h * 64 + nt * 16 + (lane & 15)] = (bf16)f2bf(acc[r]); } } }
    }
}

DEV bf16x8 cvt8(const f32x4 a, const f32x4 b, float sc) { bf16x8 r; const u32x4 p = {pk2(a[0] * sc, a[1] * sc), pk2(a[2] * sc, a[3] * sc), pk2(b[0] * sc, b[1] * sc), pk2(b[2] * sc, b[3] * sc)};
    r = __builtin_bit_cast(bf16x8, p); return r; }
DEV void phase_attn_prompt2(const Ctx& c, int qid = 0) {
    bf16* KV0 = (bf16*)c.lds;
    constexpr int KVB = 64 * 104 + 64 * 72;
    bf16* Psb = KV0 + 2 * KVB;
    const float* QH = c.w<float>(WS_QH); const bf16* KVP = c.w<bf16>(WS_KVP); const bf16* KPEB = c.w<bf16>(WS_KPEB); const float* rope = c.w<float>(WS_ROPE); bf16* OCAT = c.w<bf16>(WS_OCAT);
    const int tid = c.tid, lane = c.lane, w = c.wave;
    bf16* Ps = Psb + w * 32 * 72;
    constexpr int NQB = SEQ / 256, NPU = NQB * BATCH * 8;
    for (;;) {
        const int pu = queue_next(c, qid);
        if (pu >= NPU) break;
        const int qb = NQB - 1 - pu / (BATCH * 8), bh = pu % (BATCH * 8), b = bh >> 3, h = bh & 7; const size_t mb = (size_t)b * SEQ;
        {
            const int q0 = qb * 256, rmin = q0 + 32 * w;
            bf16x8 qf[2][3];
#pragma unroll
            for (int mt = 0; mt < 2; ++mt) { const int qr = rmin + 16 * mt + (lane & 15); const float* qrow = QH + (mb + qr) * 768 + h * 96; const int g = lane >> 4;
#pragma unroll
                for (int ks = 0; ks < 2; ++ks) qf[mt][ks] = cvt8(*(const f32x4*)(qrow + ks * 32 + 8 * g), *(const f32x4*)(qrow + ks * 32 + 8 * g + 4), QK_SCALE2);
                const int f0 = 8 * (g & 1); const float* rt = rope + (size_t)qr * 32;
                const f32x4 x1a = *(const f32x4*)(qrow + 64 + f0), x1b = *(const f32x4*)(qrow + 64 + f0 + 4), x2a = *(const f32x4*)(qrow + 80 + f0), x2b = *(const f32x4*)(qrow + 80 + f0 + 4);
                const f32x4 ca = *(const f32x4*)(rt + f0), cb = *(const f32x4*)(rt + f0 + 4), sa = *(const f32x4*)(rt + 16 + f0), sb = *(const f32x4*)(rt + 16 + f0 + 4);
                const f32x4 ya = g < 2 ? x1a * ca - x2a * sa : x2a * ca + x1a * sa, yb = g < 2 ? x1b * cb - x2b * sb : x2b * cb + x1b * sb;
                qf[mt][2] = cvt8(ya, yb, QK_SCALE2); }
            float mrun[2][4], lrun[2][4], alpha[2][4]; f32x4 o[2][4];
#pragma unroll
            for (int mt = 0; mt < 2; ++mt) {
#pragma unroll
                for (int r = 0; r < 4; ++r) { mrun[mt][r] = -INFINITY; lrun[mt][r] = 0.f; }
#pragma unroll
                for (int nt = 0; nt < 4; ++nt) o[mt][nt] = (f32x4){0.f, 0.f, 0.f, 0.f}; }
            const int nkt = 4 * qb + 4;
            u32x4 pk_, pp_, pv_;
#define AP_LOAD(kt_) do { const size_t kr_ = mb + (size_t)(kt_) * 64; \
                pk_ = *(const u32x4*)(KVP + (kr_ + (tid >> 3)) * 1024 + h * 64 + (tid & 7) * 8); \
                pv_ = *(const u32x4*)(KVP + (kr_ + (tid >> 3)) * 1024 + 512 + h * 64 + (tid & 7) * 8); \
                if (tid < 256) pp_ = *(const u32x4*)(KPEB + (kr_ + (tid >> 2)) * 32 + (tid & 3) * 8); } while (0)
#define AP_STORE(buf_) do { bf16* Kb_ = KV0 + (buf_) * KVB; bf16* Vb_ = Kb_ + 64 * 104; \
                *(u32x4*)(Kb_ + (tid >> 3) * 104 + (tid & 7) * 8) = pk_; *(u32x4*)(Vb_ + (tid >> 3) * 72 + (tid & 7) * 8) = pv_; \
                if (tid < 256) *(u32x4*)(Kb_ + (tid >> 2) * 104 + 64 + (tid & 3) * 8) = pp_; } while (0)
            __syncthreads();
            AP_LOAD(0); AP_STORE(0);
            if (nkt > 1) AP_LOAD(1);
            __syncthreads();
            for (int kt = 0; kt < nkt; ++kt) {
                const bf16* Ks = KV0 + (kt & 1) * KVB; const bf16* Vs = Ks + 64 * 104;
                if (kt + 1 < nkt) AP_STORE((kt + 1) & 1);
                if (kt + 2 < nkt) AP_LOAD(kt + 2);
                const int k0 = kt * 64;
                if (k0 <= rmin + 31) {
                    f32x4 s[2][4];
#pragma unroll
                    for (int nt = 0; nt < 4; ++nt) { s[0][nt] = (f32x4){0.f, 0.f, 0.f, 0.f}; s[1][nt] = (f32x4){0.f, 0.f, 0.f, 0.f};
#pragma unroll
                        for (int ks = 0; ks < 3; ++ks) { const bf16x8 kf = ld8(Ks + (nt * 16 + (lane & 15)) * 104 + ks * 32 + 8 * (lane >> 4));
                            s[0][nt] = mfma16(qf[0][ks], kf, s[0][nt]); s[1][nt] = mfma16(qf[1][ks], kf, s[1][nt]); } }
                    if (k0 + 63 > rmin) {
#pragma unroll
                        for (int mt = 0; mt < 2; ++mt)
#pragma unroll
                            for (int nt = 0; nt < 4; ++nt)
#pragma unroll
                                for (int r = 0; r < 4; ++r) { const int qpos = rmin + 16 * mt + (lane >> 4) * 4 + r, kpos = k0 + nt * 16 + (lane & 15); if (kpos > qpos) s[mt][nt][r] = -INFINITY; }
                    }
                    softmax_rows<4>(s[0], mrun[0], lrun[0], alpha[0], Ps, 72, lane);
                    softmax_rows<4>(s[1], mrun[1], lrun[1], alpha[1], Ps + 16 * 72, 72, lane);
                    WAVE_SYNC();
                    if (wave_any((alpha[0][0] != 1.f) | (alpha[0][1] != 1.f) | (alpha[0][2] != 1.f) | (alpha[0][3] != 1.f) | (alpha[1][0] != 1.f) | (alpha[1][1] != 1.f) | (alpha[1][2] != 1.f) | (alpha[1][3] != 1.f))) {
#pragma unroll
                    for (int mt = 0; mt < 2; ++mt)
#pragma unroll
                        for (int nt = 0; nt < 4; ++nt)
#pragma unroll
                            for (int r = 0; r < 4; ++r) o[mt][nt][r] *= alpha[mt][r]; }
#pragma unroll
                    for (int k2 = 0; k2 < 2; ++k2) { const bf16x8 p0 = ld8(Ps + (lane & 15) * 72 + k2 * 32 + 8 * (lane >> 4)), p1 = ld8(Ps + (16 + (lane & 15)) * 72 + k2 * 32 + 8 * (lane >> 4));
#pragma unroll
                        for (int nt = 0; nt < 4; ++nt) { const bf16x8 vf = ldB_tr(Vs, 72, k2 * 32, nt * 16, lane); o[0][nt] = mfma16(p0, vf, o[0][nt]); o[1][nt] = mfma16(p1, vf, o[1][nt]); } }
                    WAVE_SYNC();
                }
                LDS_BARRIER();
            }
#undef AP_LOAD
#undef AP_STORE
#pragma unroll
            for (int mt = 0; mt < 2; ++mt)
#pragma unroll
                for (int nt = 0; nt < 4; ++nt)
#pragma unroll
                    for (int r = 0; r < 4; ++r) OCAT[(mb + rmin + 16 * mt + (lane >> 4) * 4 + r) * D + 512 + h * 64 + nt * 16 + (lane & 15)] = (bf16)f2bf(o[mt][nt][r] / lrun[mt][r]);
        }
    }
}

#ifndef HIPEMU
#define XB_TMO      128
#define XB_XCNT(j)  (256  + 64 * (j))
#define XB_XSUB(j)  (1280 + 64 * (j))
#define XB_XGEN(j)  (2304 + 64 * (j))
#define XB_TOP      3328
#define XB_TOPGEN   3392
#define XCD_BAR_WORDS 3456
#define XB_SPIN_CAP (1u << 22)
#define LAS __attribute__((address_space(3)))
__device__ __forceinline__ unsigned xb_ld(unsigned* p)              { return __hip_atomic_load(p, __ATOMIC_RELAXED, __HIP_MEMORY_SCOPE_AGENT); }
__device__ __forceinline__ unsigned xb_add(unsigned* p, unsigned v) { return __hip_atomic_fetch_add(p, v, __ATOMIC_RELAXED, __HIP_MEMORY_SCOPE_AGENT); }
__device__ __forceinline__ unsigned xb_xcc_id() { return (unsigned)__builtin_amdgcn_s_getreg((3 << 11) | 20) & 0xFu; }
#define XB_SPIN(cond, bar) do { unsigned _sp = 0; while (cond) { __builtin_amdgcn_s_sleep(1); \
    if ((++_sp & 255u) == 0u) { if (xb_ld(&(bar)[XB_TMO])) break; if (_sp > XB_SPIN_CAP) { atomicAdd(&(bar)[XB_TMO], 1u); break; } } } } while (0)
struct XcdBarrier { unsigned* bar; unsigned x; volatile LAS unsigned* st; bool t0; };
__device__ __forceinline__ XcdBarrier xcd_barrier_post(unsigned* bar, volatile LAS unsigned* st, bool t0) {
    XcdBarrier b; b.bar = bar; b.x = xb_xcc_id(); b.st = st; b.t0 = t0;
    if (t0) (void)xb_add(&bar[XB_XCNT(b.x)], 1u);
    return b;
}
__device__ __forceinline__ void xcd_barrier_complete(unsigned* bar, unsigned x, unsigned& nloc, unsigned& nx) {
    const unsigned G = gridDim.x * gridDim.y * gridDim.z;
    unsigned sum, cnt, mine, sp = 0u;
    for (;;) {
        sum = 0u; cnt = 0u; mine = 0u;
#pragma unroll
        for (unsigned j = 0; j < 16; ++j) { const unsigned c = xb_ld(&bar[XB_XCNT(j)]); sum += c; cnt += (c > 0u) ? 1u : 0u; mine = (j == x) ? c : mine; }
        if (sum == G) break;
        __builtin_amdgcn_s_sleep(1);
        if ((++sp & 255u) == 0u) { if (xb_ld(&bar[XB_TMO])) break; if (sp > XB_SPIN_CAP) { atomicAdd(&bar[XB_TMO], 1u); break; } }
    }
    nloc = mine > 0u ? mine : 1u; nx = cnt > 0u ? cnt : 1u;
}
__device__ __forceinline__ void xcd_barrier(const XcdBarrier& b) {
    asm volatile("s_waitcnt vmcnt(0)" ::: "memory");
    __syncthreads();
    if (b.t0) {
        unsigned* bar = b.bar;
        __builtin_amdgcn_s_waitcnt(0);
        unsigned nloc = b.st[0], nx = b.st[1];
        if (nloc == 0u) { xcd_barrier_complete(bar, b.x, nloc, nx); b.st[0] = nloc; b.st[1] = nx; }
        const unsigned old = xb_add(&bar[XB_XSUB(b.x)], 1u);
        const unsigned gen = old / nloc;
        if (old + 1u == (gen + 1u) * nloc) {
            __builtin_amdgcn_fence(__ATOMIC_RELEASE, "agent");
            asm volatile("s_waitcnt vmcnt(0)" ::: "memory");
            const unsigned og = xb_add(&bar[XB_TOP], 1u);
            const unsigned tg = og / nx;
            if (og + 1u == (tg + 1u) * nx) xb_add(&bar[XB_TOPGEN], 1u);
            else XB_SPIN(xb_ld(&bar[XB_TOPGEN]) == tg, bar);
            __builtin_amdgcn_fence(__ATOMIC_ACQUIRE, "agent");
            xb_add(&bar[XB_XGEN(b.x)], 1u);
            asm volatile("s_waitcnt vmcnt(0)" ::: "memory");
        } else {
            XB_SPIN(xb_ld(&bar[XB_XGEN(b.x)]) == gen, bar);
            __builtin_amdgcn_fence(__ATOMIC_ACQUIRE, "agent");
            asm volatile("s_waitcnt vmcnt(0)" ::: "memory");
        }
    }
    __syncthreads();
}
#endif

__global__ void __launch_bounds__(512, 2) mega_kernel(Params p) {
#ifdef HIPEMU
    unsigned char* lds = g_blk->smem;
#else
    extern __shared__ __attribute__((aligned(16))) unsigned char lds[];
#endif
    const int lo = p.ph_lo, hi = p.ph_hi;
#ifdef HIPEMU
    const int wave_s = threadIdx.x >> 6;
#define FRESH_LANE() ((int)(threadIdx.x & 63))
#define GRID_BAR(k) do { } while (0)
#else
    const int wave_s = __builtin_amdgcn_readfirstlane(threadIdx.x >> 6);
#define FRESH_LANE() ({ int l_; asm volatile("v_mbcnt_lo_u32_b32 %0, -1, 0\n\tv_mbcnt_hi_u32_b32 %0, -1, %0" : "=v"(l_)); l_; })
    { const int l0 = FRESH_LANE(); if (wave_s == 0) ((volatile LAS unsigned*)(lds + LDS_MISC))[l0] = 0u; }
    __syncthreads();
    if (hi - lo > 1) (void)xcd_barrier_post((unsigned*)(p.ws + WS_CTL), (volatile LAS unsigned*)(lds + LDS_MISC), wave_s == 0 && FRESH_LANE() == 0);
#define GRID_BAR(k) do { if (lo <= (k) && (k) + 1 < hi) { XcdBarrier bb_; bb_.bar = (unsigned*)(p.ws + WS_CTL); bb_.x = xb_xcc_id(); bb_.st = (volatile LAS unsigned*)(lds + LDS_MISC); bb_.t0 = (wave_s == 0 && FRESH_LANE() == 0); xcd_barrier(bb_); } } while (0)
#endif
#define MKCTX() Ctx c; c.p = &p; c.lds = lds; c.ws = p.ws; c.out = p.out; c.wave = wave_s; c.lane = FRESH_LANE(); c.tid = wave_s * 64 + c.lane; c.gw = blockIdx.x * 8 + wave_s; c.ngw = gridDim.x * 8;
#define IN(k) (lo <= (k) && (k) < hi)
#ifndef PROBE_MASK
#define PROBE_MASK 0u
#endif
#define NREP(k) (((PROBE_MASK >> (k)) & 1u) ? 2 : 1)
#ifndef PROBE_SUB
#define PROBE_SUB 0
#endif
#define SUB(id, ...) { MKCTX() __VA_ARGS__ } if (PROBE_SUB == (id)) { __syncthreads(); MKCTX() __VA_ARGS__ }
#define PHASE(k, ...) if (IN(k)) { { MKCTX() __VA_ARGS__ } if (NREP(k) == 2) { MKCTX() __VA_ARGS__ } }
#define X1 c.w<float>(WS_X1)
#define X2 c.w<float>(WS_X2)
#define P1 c.w<float>(WS_P1)
#define XN c.w<bf16>(WS_XN)
#define Hb c.w<bf16>(WS_H)
#define OCAT c.w<bf16>(WS_OCAT)

    PHASE(0,  phase_prologue(c); GRID_BAR(0); )
    PHASE(1,  run_gemm(c, XN, c.w<bf16>(WS_WINAB), M, LD1, D, EpiBf16<0>{c.w<bf16>(WS_P1), LD1}); GRID_BAR(1); )
    PHASE(2,  phase_prep0(c); GRID_BAR(2); )
    PHASE(3,          { run_gemm(c, c.w<bf16>(WS_CQN), c.w<bf16>(WS_WUQ), M, 768, 256, EpiStoreF32{c.w<float>(WS_QH), 768}); } { MKCTX() run_gemm(c, c.w<bf16>(WS_LATN), c.w<bf16>(WS_WUKV), MP, 1024, 256, EpiBf16<0>{c.w<bf16>(WS_KVP), 1024}); }         GRID_BAR(3); )
    PHASE(4,  { if ((blockIdx.x & 1) == 0) { MKCTX() phase_attn_sample2(c); } } __syncthreads(); { MKCTX() phase_gdn_prep(c); } __syncthreads();
               { if ((blockIdx.x & 1) != 0) { MKCTX() phase_attn_sample2(c); } } GRID_BAR(4); )
    PHASE(5,  SUB(4, phase_gdn_scan(c, blockIdx.x, gridDim.x);) __syncthreads(); SUB(5, phase_attn_sample_combine(c);) __syncthreads(); { MKCTX() phase_attn_prompt2(c, 0); } if (PROBE_SUB == 6) { __syncthreads(); MKCTX() phase_attn_prompt2(c, 5); } __syncthreads();
               { MKCTX() const int NS_ = BATCH * 4, G_ = (int)gridDim.x; if (G_ > NS_ + 32) { if ((int)blockIdx.x >= NS_) { phase_gdn_naive(c, BATCH * 4, (int)blockIdx.x - NS_, G_ - NS_); __syncthreads(); phase_convert_late(c, c.gw - NS_ * 8, c.ngw - NS_ * 8); } } else { phase_gdn_naive(c, BATCH * 4, (int)blockIdx.x, G_); __syncthreads(); phase_convert_late(c, c.gw, c.ngw); } } GRID_BAR(5); )
    PHASE(6,  { run_gemm(c, OCAT, c.w<bf16>(WS_WOAB), MP, D, D, EpiResidF32{nullptr, c.in<float>(0), c.in<float>(1), X1}); } { MKCTX() run_gemm_sample_splitk(c, OCAT, c.w<bf16>(WS_WOAB), D, 256); } GRID_BAR(6); )
    PHASE(7,  phase_rmsnorm(c, X1, c.in<float>(9), nullptr, 4); GRID_BAR(7); )
    PHASE(8,  run_gemm(c, XN, c.w<bf16>(WS_WUP0), M, FF, D, EpiBf16<1>{Hb, FF}); GRID_BAR(8); )
    PHASE(9,  { run_gemm(c, Hb, c.w<bf16>(WS_WDN0), MP, D, FF, EpiResidF32{X1, nullptr, nullptr, X2}); } { MKCTX() run_gemm_sample_splitk(c, Hb, c.w<bf16>(WS_WDN0), FF, 256); } GRID_BAR(9); )
    PHASE(10,  phase_rmsnorm(c, X2, c.in<float>(8) + D, X1, 16); GRID_BAR(10); )
    PHASE(11,  run_gemm(c, XN, c.w<bf16>(WS_WINC), M, INC, D, EpiBf16<0>{c.w<bf16>(WS_P1), INC}); GRID_BAR(11); )
    PHASE(12,  SUB(7, phase_hgrn_prep(c);) GRID_BAR(12); )
    PHASE(13,  phase_hgrn_prefix(c); __syncthreads(); SUB(8, phase_hgrn_naive(c, BATCH * 8, (int)blockIdx.x, (int)gridDim.x);) GRID_BAR(13); )
    PHASE(14,  phase_hgrn_out(c); GRID_BAR(14); )
    PHASE(15,  { run_gemm(c, OCAT, c.w<bf16>(WS_WOC), MP, D, D, EpiResidF32{X2, nullptr, nullptr, X1}); } { MKCTX() run_gemm_sample_splitk(c, OCAT, c.w<bf16>(WS_WOC), D, 256); } GRID_BAR(15); )
    PHASE(16,  phase_rmsnorm(c, X1, c.in<float>(9) + D, X2, 4); GRID_BAR(16); )
    PHASE(17,  run_gemm(c, XN, c.w<bf16>(WS_WUP1), M, FF, D, EpiBf16<1>{Hb, FF}); GRID_BAR(17); )
    PHASE(18,  { run_gemm(c, Hb, c.w<bf16>(WS_WDN1), MP, D, FF, EpiResidF32{X1, nullptr, nullptr, X2}); } { MKCTX() run_gemm_sample_splitk(c, Hb, c.w<bf16>(WS_WDN1), FF, 256); } GRID_BAR(18); )
    PHASE(19,  phase_final(c, X2, c.in<float>(10), X1, 16); )
#undef IN
#undef X1
#undef X2
#undef P1
#undef XN
#undef Hb
#undef OCAT
}

#ifndef HIPEMU
extern "C" void kernel_launch(void* const* d_in, const int* in_sizes, int n_in, void* d_out, int out_size, void* d_ws, size_t ws_size, hipStream_t stream) {
    static int grid = 0;
    if (grid == 0) {
        if (n_in != 28 || (size_t)out_size != O_END || ws_size < WS_END) { fprintf(stderr, "kernel_launch: shape mismatch n_in %d out %d (want %zu) ws %zu (want %zu)\n", n_in, out_size, (size_t)O_END, ws_size, (size_t)WS_END); grid = -1; return; }
        int dev = 0, cus = 0, per_cu = 0;
        hipGetDevice(&dev); hipDeviceGetAttribute(&cus, hipDeviceAttributeMultiprocessorCount, dev);
        if (hipFuncSetAttribute((const void*)mega_kernel, hipFuncAttributeMaxDynamicSharedMemorySize, LDS_BYTES) != hipSuccess) { fprintf(stderr, "kernel_launch: hipFuncSetAttribute failed\n"); grid = -1; return; }
        if (hipOccupancyMaxActiveBlocksPerMultiprocessor(&per_cu, (const void*)mega_kernel, 512, LDS_BYTES) != hipSuccess || per_cu < 1) fprintf(stderr, "kernel_launch: occupancy query reports %d\n", per_cu);
        (void)hipGetLastError();
        grid = cus;
    }
    if (grid < 0) return;
    hipMemsetAsync((char*)d_ws + WS_CTL, 0, CTL_BYTES, stream);
    Params p{};
    for (int i = 0; i < 28; ++i) p.in[i] = d_in[i];
    p.out = (float*)d_out; p.ws = (unsigned char*)d_ws;
#if MK_N_LAUNCHES == 1
    p.ph_lo = 0; p.ph_hi = NPHASE;
    hipLaunchKernelGGL(mega_kernel, dim3(grid), dim3(512), LDS_BYTES, stream, p);
#else
    for (int k = 0; k < NPHASE; ++k) { p.ph_lo = k; p.ph_hi = k + 1; hipLaunchKernelGGL(mega_kernel, dim3(grid), dim3(512), LDS_BYTES, stream, p); }
#endif
}
#else
size_t emu_ws_bytes() { return WS_END; }
size_t emu_out_floats() { return O_END; }
void emu_forward(void* const* d_in, float* d_out, unsigned char* d_ws, int grid, int ph_from, int ph_to) {
    memset(d_ws + WS_CTL, 0, CTL_BYTES);
    Params p{};
    for (int i = 0; i < 28; ++i) p.in[i] = d_in[i];
    p.out = d_out; p.ws = d_ws;
    for (int k = ph_from; k < ph_to && k < NPHASE; ++k) { p.ph_lo = k; p.ph_hi = k + 1; fprintf(stderr, "[emu] phase %d\n", k); emu_launch(grid, 512, LDS_BYTES, [=]() { mega_kernel(p); }); }
}
struct EmuBuf { const char* name; size_t off; size_t bytes; int kind;   int ld; };
extern const EmuBuf emu_bufs[] = {
    {"P1", WS_P1, (size_t)M * 4096 * 4, 0, LD1}, {"XN", WS_XN, (size_t)M * D * 2, 1, D}, {"QH", WS_QH, (size_t)M * 768 * 4, 0, 768}, {"KVP", WS_KVP, (size_t)MP * 1024 * 2, 1, 1024},
    {"OCAT", WS_OCAT, (size_t)M * D * 2, 1, D}, {"ORAW", WS_ORAW, (size_t)M * D * 4, 0, D}, {"X1", WS_X1, (size_t)M * D * 4, 0, D}, {"X2", WS_X2, (size_t)M * D * 4, 0, D},
    {"H", WS_H, (size_t)M * FF * 2, 1, FF}, {"CQN", WS_CQN, (size_t)M * 256 * 2, 1, 256}, {"LATN", WS_LATN, (size_t)M * 256 * 2, 1, 256}, {nullptr, 0, 0, 0, 0}};
extern const int emu_cfg[8] = {BATCH, SEQ, DECB, PAST, MP, MS, MT, M};
#endif
```

```cpp
#ifdef HIPEMU
#include "hipemu.h"
#else
#include <hip/hip_runtime.h>
#endif
#include <cstdio>
#include <cstdint>

#ifndef CFG_BATCH
#define CFG_BATCH 8
#define CFG_SEQ 2048
#define CFG_DEC_BATCH 128
#define CFG_PAST_LEN 8192
#endif
#ifndef MK_N_LAUNCHES
#define MK_N_LAUNCHES 1
#endif

#define DEV __device__ __forceinline__
namespace pg8 {
#define PG8_LAS __attribute__((address_space(3)))
typedef unsigned short bf16_t;
typedef short bf16x8 __attribute__((ext_vector_type(8)));
typedef float f32x4 __attribute__((ext_vector_type(4)));
typedef unsigned u32x4 __attribute__((ext_vector_type(4)));
constexpr int BM = 256, BK = 64, HALF = 128, HTB = HALF * BK * 2  , STAGE_BYTES = 8 * HTB, NXCD = 8, WGM = 8;

__host__ __device__ __forceinline__ int lds_byte(int r, int c) { const int st = (r >> 4) * 2 + (c >> 5), rr = r & 15, cc = c & 31, ob = rr * 64 + cc * 2; return st * 1024 + (ob ^ (((ob >> 9) & 1) << 5)); }
__host__ __device__ __forceinline__ void stage_rc(int b, int& R, int& C) { const int st = b / 1024, sb = b % 1024, swz = sb ^ (((sb >> 9) & 1) << 5); R = (st >> 1) * 16 + swz / 64; C = (st & 1) * 32 + (swz % 64) / 2; }
__host__ __device__ __forceinline__ int perm32(int rho) { const int n = rho >> 4, i = rho & 15; return 8 * (i >> 2) + 4 * n + (i & 3); }

struct Unit { int pm, pn, kb; };
struct Gemm { const bf16_t* A; const bf16_t* Bt; int M, N, K, ld; };

struct StaticOrder {
    int nM, nN, nwg, G, c;
    __host__ __device__ void init(int M, int N, int G_, int c_) { nM = M / BM; nN = N / BM; nwg = nM * nN; G = G_; c = c_; }
    __host__ __device__ bool next(int i, Unit& u) const {
        const long L = (long)i * G + c; if (L >= nwg) return false;
        int wgid = (int)L; { const int q = nwg / NXCD, r = nwg % NXCD, xcd = wgid % NXCD, off = wgid / NXCD; wgid = (xcd < r ? xcd * (q + 1) : r * (q + 1) + (xcd - r) * q) + off; }
        const int nig = WGM * nN, gid = wgid / nig, fm = gid * WGM, gsz = (nM - fm) < WGM ? (nM - fm) : WGM;
        u.pm = fm + ((wgid % nig) % gsz); u.pn = (wgid % nig) / gsz; u.kb = 0; return true;
    }
    __device__ __forceinline__ void a_ready(const Unit&) const {}
    __device__ __forceinline__ void done(const Unit&) const {}
};

#ifndef HIPEMU
template <class Epi, class Sched, bool ALIGN_EPI = false, bool SP2 = false>
__device__ __forceinline__ void gemm_phase(PG8_LAS unsigned char* lds, const Gemm g, const Sched& S, const Epi& E, const int wid_in, const int lane_in) {
    const int wid = __builtin_amdgcn_readfirstlane(wid_in), lane = lane_in, tid = wid * 64 + lane, wr = wid >> 2, wc = wid & 3, fr = lane & 15, fq = lane >> 4;
    const int K = g.K, nt = K / BK, LDK = g.ld;
    unsigned voffA[2], voffB[2];
#pragma unroll
    for (int i = 0; i < 2; ++i) { int R, C; stage_rc(tid * 16 + i * 8192, R, C); const int Rb = Epi::PERM ? ((R & ~31) + perm32(R & 31)) : R;
        voffA[i] = (unsigned)(R * LDK + C) * 2u; voffB[i] = (unsigned)(Rb * LDK + C) * 2u; }
    const size_t kstep = (size_t)(BK * 2);
    const size_t hstep = (size_t)HALF * LDK * 2;
    const size_t tstep = 2 * hstep;
    const unsigned ldsw = (unsigned)wid * 1024u;
    const int aoff = lds_byte(wr * 64 + fr, fq * 8), boff = lds_byte(wc * 32 + fr, fq * 8);
#define PG8_SA(b, h) (((b) * 2 + (h)) * HTB)
#define PG8_SB(b, h) ((4 + (b) * 2 + (h)) * HTB)
#define PG8_STAGE(bufoff, gbase, voff) do { _Pragma("unroll") for (int _i = 0; _i < 2; ++_i) \
        __builtin_amdgcn_global_load_lds((const unsigned*)((const char*)(gbase) + (voff)[_i]), (PG8_LAS unsigned*)(lds + (bufoff) + ldsw + _i * 8192), 16, 0, 0); } while (0)
#define PG8_LDA(dst, b, h) do { _Pragma("unroll") for (int m = 0; m < 4; ++m) _Pragma("unroll") for (int k = 0; k < 2; ++k) dst[m][k] = *(const PG8_LAS bf16x8*)(lds + PG8_SA(b, h) + aoff + m * 2048 + k * 1024); } while (0)
#define PG8_LDB(dst, b, h) do { _Pragma("unroll") for (int n = 0; n < 2; ++n) _Pragma("unroll") for (int k = 0; k < 2; ++k) dst[n][k] = *(const PG8_LAS bf16x8*)(lds + PG8_SB(b, h) + boff + n * 2048 + k * 1024); } while (0)
#define PG8_MMA(ai, bj, At, Bt) do { __builtin_amdgcn_s_setprio(1); _Pragma("unroll") for (int m = 0; m < 4; ++m) _Pragma("unroll") for (int n = 0; n < 2; ++n) _Pragma("unroll") for (int k = 0; k < 2; ++k) \
        acc[ai][bj][m][n] = __builtin_amdgcn_mfma_f32_16x16x32_bf16(Bt[n][k], At[m][k], acc[ai][bj][m][n], 0, 0, 0); __builtin_amdgcn_s_setprio(0); } while (0)
#define PG8_WAIT_V(n) asm volatile("s_waitcnt vmcnt(" #n ")" ::: "memory")
#define PG8_WAIT_L(n) asm volatile("s_waitcnt lgkmcnt(" #n ")" ::: "memory")
#define PG8_BAR __builtin_amdgcn_s_barrier()
#define PG8_SCHED __builtin_amdgcn_sched_barrier(0)
    Unit cur, nxt; int ui = 0;
    if (!S.next(0, cur)) return;
    f32x4 acc[2][2][4][2];
#pragma unroll
    for (int a = 0; a < 2; ++a)
#pragma unroll
        for (int b = 0; b < 2; ++b)
#pragma unroll
            for (int m = 0; m < 4; ++m)
#pragma unroll
                for (int n = 0; n < 2; ++n) acc[a][b][m][n] = (f32x4){0.f, 0.f, 0.f, 0.f};
    bf16x8 At[4][2], B0[2][2], B1[2][2];
    const char* cA = (const char*)g.A + (size_t)cur.pm * tstep + (size_t)cur.kb * K * 2; const char* cB = (const char*)g.Bt + (size_t)cur.pn * tstep + (size_t)cur.kb * K * 2;
    S.a_ready(cur);
    if constexpr (SP2) {
        PG8_STAGE(PG8_SB(0, 0), cB, voffB); PG8_STAGE(PG8_SB(0, 1), cB + hstep, voffB); PG8_STAGE(PG8_SA(0, 0), cA, voffA); PG8_STAGE(PG8_SA(0, 1), cA + hstep, voffA);
        if (wr == 1) PG8_BAR;
        PG8_WAIT_V(2); PG8_BAR;
        PG8_STAGE(PG8_SB(1, 0), cB + kstep, voffB); PG8_STAGE(PG8_SA(1, 0), cA + kstep, voffA); PG8_STAGE(PG8_SB(1, 1), cB + hstep + kstep, voffB);
        PG8_WAIT_V(6); PG8_BAR;
    } else {
        PG8_STAGE(PG8_SB(0, 0), cB, voffB); PG8_STAGE(PG8_SA(0, 0), cA, voffA); PG8_STAGE(PG8_SB(0, 1), cB + hstep, voffB); PG8_STAGE(PG8_SA(0, 1), cA + hstep, voffA);
        if (wr == 1) PG8_BAR;
        PG8_WAIT_V(4); PG8_BAR;
        PG8_STAGE(PG8_SB(1, 0), cB + kstep, voffB); PG8_STAGE(PG8_SA(1, 0), cA + kstep, voffA); PG8_STAGE(PG8_SB(1, 1), cB + hstep + kstep, voffB);
        PG8_WAIT_V(6); PG8_BAR;
    }
    for (;;) {
        const bool has_next = S.next(ui + 1, nxt);
        const char* nA = has_next ? (const char*)g.A + (size_t)nxt.pm * tstep + (size_t)nxt.kb * K * 2 : cA; const char* nB = has_next ? (const char*)g.Bt + (size_t)nxt.pn * tstep + (size_t)nxt.kb * K * 2 : cB;
        for (int t = 0; t < nt; t += 2) {
            const bool last = (t == nt - 2);
            const char* a1 = cA + (size_t)(t + 1) * kstep;
            const char* a2 = last ? nA : cA + (size_t)(t + 2) * kstep; const char* b2 = last ? nB : cB + (size_t)(t + 2) * kstep;
            const char* a3 = a2 + kstep; const char* b3 = b2 + kstep;
            if (last && has_next) S.a_ready(nxt);
            if constexpr (SP2) {
            PG8_LDB(B0, 0, 0); PG8_LDB(B1, 0, 1); PG8_SCHED; PG8_LDA(At, 0, 0); PG8_STAGE(PG8_SA(1, 1), a1 + hstep, voffA);
            PG8_WAIT_V(8); PG8_WAIT_L(0); PG8_BAR; PG8_MMA(0, 0, At, B0); PG8_MMA(0, 1, At, B1); PG8_BAR; PG8_SCHED;
            PG8_LDA(At, 0, 1); PG8_STAGE(PG8_SB(0, 0), b2, voffB); PG8_STAGE(PG8_SB(0, 1), b2 + hstep, voffB); PG8_STAGE(PG8_SA(0, 0), a2, voffA);
            PG8_WAIT_V(8); PG8_WAIT_L(0); PG8_BAR; PG8_MMA(1, 0, At, B0); PG8_MMA(1, 1, At, B1); PG8_BAR; PG8_SCHED;
            PG8_LDB(B0, 1, 0); PG8_LDB(B1, 1, 1); PG8_SCHED; PG8_LDA(At, 1, 0); PG8_STAGE(PG8_SA(0, 1), a2 + hstep, voffA);
            PG8_WAIT_V(8); PG8_WAIT_L(0); PG8_BAR; PG8_MMA(0, 0, At, B0); PG8_MMA(0, 1, At, B1); PG8_BAR; PG8_SCHED;
            PG8_LDA(At, 1, 1); PG8_STAGE(PG8_SB(1, 0), b3, voffB); PG8_STAGE(PG8_SB(1, 1), b3 + hstep, voffB); PG8_STAGE(PG8_SA(1, 0), a3, voffA);
            PG8_WAIT_V(8); PG8_WAIT_L(0); PG8_BAR; PG8_MMA(1, 0, At, B0); PG8_MMA(1, 1, At, B1); PG8_BAR; PG8_SCHED;
            } else {
            PG8_LDB(B0, 0, 0); PG8_SCHED; PG8_LDA(At, 0, 0); PG8_STAGE(PG8_SA(1, 1), a1 + hstep, voffA);
            PG8_WAIT_L(8); PG8_BAR; PG8_WAIT_L(0); PG8_MMA(0, 0, At, B0); PG8_BAR; PG8_SCHED;
            PG8_LDB(B1, 0, 1); PG8_STAGE(PG8_SB(0, 0), b2, voffB);
            PG8_BAR; PG8_WAIT_L(0); PG8_MMA(0, 1, At, B1); PG8_BAR;
            PG8_LDA(At, 0, 1); PG8_STAGE(PG8_SA(0, 0), a2, voffA);
            PG8_BAR; PG8_WAIT_L(0); PG8_MMA(1, 0, At, B0); PG8_BAR; PG8_SCHED;
            PG8_STAGE(PG8_SB(0, 1), b2 + hstep, voffB);
            PG8_WAIT_V(6); PG8_BAR; PG8_MMA(1, 1, At, B1); PG8_BAR;
            PG8_LDB(B0, 1, 0); PG8_SCHED; PG8_LDA(At, 1, 0); PG8_STAGE(PG8_SA(0, 1), a2 + hstep, voffA);
            PG8_WAIT_L(8); PG8_BAR; PG8_WAIT_L(0); PG8_MMA(0, 0, At, B0); PG8_BAR; PG8_SCHED;
            PG8_LDB(B1, 1, 1); PG8_STAGE(PG8_SB(1, 0), b3, voffB);
            PG8_BAR; PG8_WAIT_L(0); PG8_MMA(0, 1, At, B1); PG8_BAR;
            PG8_LDA(At, 1, 1); PG8_STAGE(PG8_SA(1, 0), a3, voffA);
            PG8_BAR; PG8_WAIT_L(0); PG8_MMA(1, 0, At, B0); PG8_BAR; PG8_SCHED;
            PG8_STAGE(PG8_SB(1, 1), b3 + hstep, voffB);
            PG8_WAIT_V(6); PG8_BAR; PG8_MMA(1, 1, At, B1); PG8_BAR;
            }
        }
        if constexpr (ALIGN_EPI) { if (wr == 0) PG8_BAR; }
        if constexpr (!Epi::AFTER_DRAIN) { E(acc, cur, wr, wc, fr, fq); S.done(cur); }
        if (!has_next) break;
#pragma unroll
        for (int a = 0; a < 2; ++a)
#pragma unroll
            for (int b = 0; b < 2; ++b)
#pragma unroll
                for (int m = 0; m < 4; ++m)
#pragma unroll
                    for (int n = 0; n < 2; ++n) acc[a][b][m][n] = (f32x4){0.f, 0.f, 0.f, 0.f};
        cur = nxt; cA = nA; cB = nB; ++ui;
        if constexpr (ALIGN_EPI) { if (wr == 1) PG8_BAR; }
    }
    PG8_WAIT_V(0);
    if constexpr (!ALIGN_EPI) { if (wr == 0) PG8_BAR; }
    PG8_BAR;
    if constexpr (Epi::AFTER_DRAIN) { E.fused(acc, cur, wr, wc, fr, fq, lds, wid, lane); S.done(cur); }
#undef PG8_SA
#undef PG8_SB
#undef PG8_STAGE
#undef PG8_LDA
#undef PG8_LDB
#undef PG8_MMA
#undef PG8_WAIT_V
#undef PG8_WAIT_L
#undef PG8_BAR
#undef PG8_SCHED
}
}

#else
}
#endif

constexpr int D = 1024, BATCH = CFG_BATCH, SEQ = CFG_SEQ, DECB = CFG_DEC_BATCH, DECS = 8, PAST = CFG_PAST_LEN, PAGE = 128;
constexpr int MP = BATCH * SEQ, MS = DECB * DECS, MT = MP + MS, M = (MT + 255) / 256 * 256;
constexpr int NPAGES = PAST / PAGE;
constexpr int QKV_A = 1536, IN_AB = 2600, LD1 = 2816, FF = 4096, INC = 4096;
constexpr int C_Z = 1536, C_B = 2048, C_A = 2052, C_CQ = 2056, C_CKV = 2312, C_KPE = 2568;
constexpr float EPS = 1e-6f;
constexpr float MLA_SCALE = 0.10206207261596575f;
constexpr float DK_SCALE = 0.08838834764831845f;
static_assert(MP % 256 == 0 && SEQ % 128 == 0 && PAST % 128 == 0, "shape assumptions");

constexpr size_t O_YP = 0, O_YS = O_YP + (size_t)MP * D, O_GDNP = O_YS + (size_t)MS * D, O_CONVP = O_GDNP + (size_t)BATCH * 4 * 16384,
    O_LATP = O_CONVP + (size_t)BATCH * 3 * QKV_A, O_KPEP = O_LATP + (size_t)MP * 256, O_HGP = O_KPEP + (size_t)MP * 32,
    O_GDNS = O_HGP + (size_t)BATCH * 8 * 16384, O_CONVS = O_GDNS + (size_t)DECB * 4 * 16384, O_LATS = O_CONVS + (size_t)DECB * 3 * QKV_A,
    O_KPES = O_LATS + (size_t)MS * 256, O_HGS = O_KPES + (size_t)MS * 32, O_END = O_HGS + (size_t)DECB * 8 * 16384;

constexpr size_t al256(size_t x) { return (x + 255) & ~(size_t)255; }
constexpr size_t WS_CTL = 0, CTL_BYTES = 65536;
constexpr size_t WS_WINAB = CTL_BYTES,                      WS_WUP0 = WS_WINAB + (size_t)LD1 * D * 2,
    WS_WUP1 = WS_WUP0 + (size_t)FF * D * 2,                 WS_WDN0 = WS_WUP1 + (size_t)FF * D * 2,
    WS_WDN1 = WS_WDN0 + (size_t)FF * D * 2,                 WS_WINC = WS_WDN1 + (size_t)FF * D * 2,
    WS_WOAB = WS_WINC + (size_t)INC * D * 2,                WS_WOC = WS_WOAB + (size_t)D * D * 2,
    WS_WUQ = WS_WOC + (size_t)D * D * 2,                    WS_WUKV = WS_WUQ + (size_t)768 * 256 * 2,
    WS_ROPE = WS_WUKV + (size_t)1024 * 256 * 2,             WS_XN = al256(WS_ROPE + (size_t)(SEQ + 8) * 32 * 4),
    WS_P1 = WS_XN + (size_t)M * D * 2,                      WS_CQN = WS_P1 + (size_t)M * 4096 * 4,
    WS_LATN = WS_CQN + (size_t)M * 256 * 2,                 WS_QH = WS_LATN + (size_t)M * 256 * 2,
    WS_KVP = WS_QH + (size_t)M * 768 * 4,                   WS_OCAT = WS_KVP + (size_t)MP * 1024 * 2,
    WS_ORAW = WS_OCAT + (size_t)M * D * 2,                  WS_X1 = WS_ORAW + (size_t)M * D * 4,
    WS_X2 = WS_X1 + (size_t)M * D * 4,                      WS_H = WS_X2 + (size_t)M * D * 4,
    WS_WUKB = WS_H + (size_t)M * FF * 2,                    WS_PO = WS_WUKB + (size_t)256 * 512 * 2,
    WS_PM = WS_PO + (size_t)DECB * 2 * 64 * 256 * 4,        WS_PL = WS_PM + (size_t)DECB * 2 * 64 * 4,
    WS_KPEB = WS_PL + (size_t)DECB * 2 * 64 * 4,            WS_PART = al256(WS_KPEB + (size_t)MP * 32 * 2),
    WS_END = WS_PART + (size_t)16 * (M - MP) * D * 4;
constexpr size_t WS_H_END = WS_H + (size_t)M * FF * 2;

constexpr int LDS_BYTES = 155648;
constexpr int LDS_MISC = 155648 - 256;
constexpr int NPHASE = 20;

typedef unsigned short bf16;
typedef unsigned u32x4 __attribute__((ext_vector_type(4)));
typedef unsigned u32x2 __attribute__((ext_vector_type(2)));
#ifndef HIPEMU
typedef short bf16x8 __attribute__((ext_vector_type(8)));
typedef float f32x4 __attribute__((ext_vector_type(4)));
#endif

#ifdef HIPEMU
DEV unsigned f2bf(float f) { unsigned u = __float_as_uint(f); return (u + 0x7fffu + ((u >> 16) & 1u)) >> 16; }
#else
DEV unsigned f2bf(float f) { return (unsigned)__builtin_bit_cast(unsigned short, (__bf16)f); }
#endif
#ifdef HIPEMU
DEV unsigned pk2(float lo, float hi) { return f2bf(lo) | (f2bf(hi) << 16); }
#else
typedef float f32x2_t __attribute__((ext_vector_type(2))); typedef __bf16 bf16x2_t __attribute__((ext_vector_type(2)));
DEV unsigned pk2(float lo, float hi) { f32x2_t v = {lo, hi}; bf16x2_t b = __builtin_convertvector(v, bf16x2_t); return __builtin_bit_cast(unsigned, b); }
#endif
DEV float bf2f(bf16 b) { return __uint_as_float(((unsigned)b) << 16); }
DEV float sigmoidf_(float x) { return 1.0f / (1.0f + __expf(-x)); }
DEV float siluf_(float x) { return x / (1.0f + __expf(-x)); }
DEV float softplusf_(float x) { return fmaxf(x, 0.f) + log1pf(__expf(-fabsf(x))); }
#ifdef HIPEMU
DEV f32x4 mfma16(bf16x8 a, bf16x8 b, f32x4 c) { return emu_mfma16(a, b, c); }
#define WAVE_SYNC() emu_wave_sync()
#define OPAQUE_V(x) do { } while (0)
#define LDS_BARRIER() __syncthreads()
DEV s16x4 lds_tr(const unsigned short* p) { return emu_lds_tr((const void*)p); }
#else
typedef short s16x4 __attribute__((ext_vector_type(4)));
DEV s16x4 lds_tr(const unsigned short* p) { return __builtin_bit_cast(s16x4, __builtin_amdgcn_ds_read_tr16_b64_v4i16((__attribute__((address_space(3))) s16x4*)p)); }
DEV f32x4 mfma16(bf16x8 a, bf16x8 b, f32x4 c) { return __builtin_amdgcn_mfma_f32_16x16x32_bf16(a, b, c, 0, 0, 0); }
#define WAVE_SYNC() asm volatile("s_waitcnt lgkmcnt(0)" ::: "memory")
#define OPAQUE_V(x) asm volatile("" : "+v"(x))
#define LDS_BARRIER() asm volatile("s_waitcnt lgkmcnt(0)\n\ts_barrier" ::: "memory")
#endif
DEV f32x4 ld4bf(const unsigned short* p) { const u32x2 u = *(const u32x2*)p; return (f32x4){__uint_as_float(u.x << 16), __uint_as_float(u.x & 0xffff0000u), __uint_as_float(u.y << 16), __uint_as_float(u.y & 0xffff0000u)}; }
constexpr float QK_SCALE2 = MLA_SCALE * 1.4426950408889634f;
#ifdef HIPEMU
DEV float exp2f_(float x) { return exp2f(x); }
DEV bool wave_any(bool p) { int v = p ? 1 : 0;
    for (int o = 1; o < 64; o <<= 1) v |= __shfl_xor(v, o);
    return v != 0; }
#else
DEV float exp2f_(float x) { return __builtin_amdgcn_exp2f(x); }
DEV bool wave_any(bool p) { return __builtin_amdgcn_ballot_w64(p) != 0ull; }
#endif
#ifdef HIPEMU
DEV float wave_sum(float v) {
#pragma unroll
    for (int o = 1; o < 64; o <<= 1) v += __shfl_xor(v, o);
    return v;
}
DEV float grp16_max(float v) {
#pragma unroll
    for (int o = 1; o < 16; o <<= 1) v = fmaxf(v, __shfl_xor(v, o));
    return v;
}
DEV float grp16_sum(float v) {
#pragma unroll
    for (int o = 1; o < 16; o <<= 1) v += __shfl_xor(v, o);
    return v;
}
#else
template <int CTRL> DEV float dppf(float x) { return __builtin_bit_cast(float, __builtin_amdgcn_mov_dpp(__builtin_bit_cast(int, x), CTRL, 0xf, 0xf, true)); }
DEV float grp16_max(float v) { v = fmaxf(v, dppf<0xB1>(v)); v = fmaxf(v, dppf<0x4E>(v)); v = fmaxf(v, dppf<0x141>(v)); v = fmaxf(v, dppf<0x128>(v)); return v; }
DEV float grp16_sum(float v) { v += dppf<0xB1>(v); v += dppf<0x4E>(v); v += dppf<0x141>(v); v += dppf<0x128>(v); return v; }
DEV float wave_sum(float v) {
    v = grp16_sum(v);
    auto s = __builtin_amdgcn_permlane16_swap(__float_as_uint(v), __float_as_uint(v), false, false);
    v = __uint_as_float(s[0]) + __uint_as_float(s[1]);
    auto t = __builtin_amdgcn_permlane32_swap(__float_as_uint(v), __float_as_uint(v), false, false);
    return __uint_as_float(t[0]) + __uint_as_float(t[1]);
}
#endif

struct Params { const void* in[28]; float* out; unsigned char* ws; int ph_lo, ph_hi; };
struct Ctx {
    const Params* p; unsigned char* lds; unsigned char* ws; float* out;
    int tid, lane, wave, gw, ngw;
    template <class T> DEV const T* in(int i) const { return (const T*)p->in[i]; }
    template <class T> DEV T* w(size_t off) const { return (T*)(ws + off); }
};
DEV int queue_next(const Ctx& c, int q) {
    unsigned* cnt = (unsigned*)(c.ws + WS_CTL) + 4096 + 64 * q; volatile unsigned* slot = (volatile unsigned*)(c.lds + LDS_MISC + 128);
    __syncthreads();
    if (c.tid == 0) *slot = atomicAdd(cnt, 1u);
    __syncthreads();
    return (int)*slot;
}
DEV const float* xin_row(const Ctx& c, int m) { return m < MP ? c.in<float>(0) + (size_t)m * D : c.in<float>(1) + (size_t)(m - MP) * D; }

struct EpiStoreF32 {
    static constexpr bool PERM = false, AFTER_DRAIN = false;
    float* C; int ldc;
    DEV void operator()(const pg8::f32x4 (&acc)[2][2][4][2], const pg8::Unit& u, int wr, int wc, int fr, int fq) const {
        const int row0 = u.pm * 256 + wr * 64 + fr, col0 = u.pn * 256 + wc * 32 + 4 * fq;
#pragma unroll
        for (int ai = 0; ai < 2; ++ai)
#pragma unroll
            for (int m = 0; m < 4; ++m) { float* rowp = C + (size_t)(row0 + ai * 128 + m * 16) * ldc + col0;
#pragma unroll
                for (int bj = 0; bj < 2; ++bj)
#pragma unroll
                    for (int n = 0; n < 2; ++n) *(pg8::f32x4*)(rowp + bj * 128 + n * 16) = acc[ai][bj][m][n]; }
    }
};
struct EpiResidF32 {
    static constexpr bool PERM = false, AFTER_DRAIN = false;
    const float* base; const float* xp; const float* xs; float* out;
    DEV void operator()(const pg8::f32x4 (&acc)[2][2][4][2], const pg8::Unit& u, int wr, int wc, int fr, int fq) const {
        const int row0 = u.pm * 256 + wr * 64 + fr, col0 = u.pn * 256 + wc * 32 + 4 * fq;
#pragma unroll
        for (int ai = 0; ai < 2; ++ai)
#pragma unroll
            for (int m = 0; m < 4; ++m) { const int row = row0 + ai * 128 + m * 16;
                const float* rp = base ? base + (size_t)row * D : (row < MP ? xp + (size_t)row * D : xs + (size_t)(row - MP) * D);
                const bool ok = base != nullptr || row < MT;
                float* op = out + (size_t)row * D + col0;
#pragma unroll
                for (int bj = 0; bj < 2; ++bj)
#pragma unroll
                    for (int n = 0; n < 2; ++n) { pg8::f32x4 r = ok ? *(const pg8::f32x4*)(rp + col0 + bj * 128 + n * 16) : (pg8::f32x4){0.f, 0.f, 0.f, 0.f};
                        *(pg8::f32x4*)(op + bj * 128 + n * 16) = r + acc[ai][bj][m][n]; } }
    }
};
template <int ACT  > struct EpiBf16 {
    static constexpr bool PERM = true, AFTER_DRAIN = false;
    bf16* O; int ldc;
    DEV void operator()(const pg8::f32x4 (&acc)[2][2][4][2], const pg8::Unit& u, int wr, int wc, int fr, int fq) const {
        const int row0 = u.pm * 256 + wr * 64 + fr, col0 = u.pn * 256 + wc * 32 + 8 * fq;
#pragma unroll
        for (int ai = 0; ai < 2; ++ai)
#pragma unroll
            for (int m = 0; m < 4; ++m) { bf16* rowp = O + (size_t)(row0 + ai * 128 + m * 16) * ldc + col0;
#pragma unroll
                for (int bj = 0; bj < 2; ++bj) { pg8::f32x4 v0 = acc[ai][bj][m][0], v1 = acc[ai][bj][m][1];
                    if (ACT == 1) {
#pragma unroll
                        for (int j = 0; j < 4; ++j) { const float a = fmaxf(v0[j], 0.f), b = fmaxf(v1[j], 0.f); v0[j] = a * a; v1[j] = b * b; } }
                    u32x4 w; w.x = pk2(v0[0], v0[1]); w.y = pk2(v0[2], v0[3]); w.z = pk2(v1[0], v1[1]); w.w = pk2(v1[2], v1[3]);
                    *(u32x4*)(rowp + bj * 128) = w; } }
    }
};

struct SplitKOrder {
    int nM, nN, nS, pm0, G, c;
    DEV void init(int nM_, int nN_, int nS_, int pm0_, int G_, int c_) { nM = nM_; nN = nN_; nS = nS_; pm0 = pm0_; G = G_; c = c_; }
    DEV bool next(int i, pg8::Unit& u) const { const int L = i * G + c; if (L >= nM * nN * nS) return false; u.pm = pm0 + L % nM; const int r = L / nM; u.pn = r % nN; u.kb = r / nN; return true; }
    DEV void a_ready(const pg8::Unit&) const {}
    DEV void done(const pg8::Unit&) const {}
};
struct EpiPartF32 {
    static constexpr bool PERM = false, AFTER_DRAIN = false;
    float* P;
    DEV void operator()(const pg8::f32x4 (&acc)[2][2][4][2], const pg8::Unit& u, int wr, int wc, int fr, int fq) const {
        const int row0 = u.pm * 256 - MP + wr * 64 + fr, col0 = u.pn * 256 + wc * 32 + 4 * fq;
        float* base = P + (size_t)u.kb * (M - MP) * D;
#pragma unroll
        for (int ai = 0; ai < 2; ++ai)
#pragma unroll
            for (int m = 0; m < 4; ++m) { float* op = base + (size_t)(row0 + ai * 128 + m * 16) * D + col0;
#pragma unroll
                for (int bj = 0; bj < 2; ++bj)
#pragma unroll
                    for (int n = 0; n < 2; ++n) *(pg8::f32x4*)(op + bj * 128 + n * 16) = acc[ai][bj][m][n]; }
    }
};
template <class Epi, class Sched> DEV void run_gemm_s(const Ctx& c, const bf16* A, const bf16* Bt, int Mr, int N, int K, int ld, const Sched& S, const Epi& E) {
#ifndef HIPEMU
    asm volatile("" : "+s"(K));
    pg8::Gemm g{A, Bt, Mr, N, K, ld};
    pg8::gemm_phase<Epi, Sched, true, true>((PG8_LAS unsigned char*)c.lds, g, S, E, c.wave, c.lane);
#else
    const int wid = c.wave, lane = c.lane, wr = wid >> 2, wc = wid & 3, fr = lane & 15, fq = lane >> 4;
    pg8::Unit u;
    for (int ui = 0; S.next(ui, u); ++ui) {
        pg8::f32x4 acc[2][2][4][2];
        for (int ai = 0; ai < 2; ++ai) for (int bj = 0; bj < 2; ++bj) for (int m = 0; m < 4; ++m) for (int n = 0; n < 2; ++n) for (int j = 0; j < 4; ++j) {
            const int row = 256 * u.pm + 128 * ai + 64 * wr + 16 * m + fr;
            const int col = Epi::PERM ? 256 * u.pn + 128 * bj + 32 * wc + 8 * fq + 4 * n + j : 256 * u.pn + 128 * bj + 32 * wc + 16 * n + 4 * fq + j;
            const bf16* a = A + (size_t)row * ld + (size_t)u.kb * K; const bf16* b = Bt + (size_t)col * ld + (size_t)u.kb * K; float s = 0.f;
            for (int k = 0; k < K; ++k) s += bf2f(a[k]) * bf2f(b[k]);
            acc[ai][bj][m][n][j] = s; }
        E(acc, u, wr, wc, fr, fq);
    }
#endif
}
template <class Epi> DEV void run_gemm(const Ctx& c, const bf16* A, const bf16* Bt, int Mr, int N, int K, const Epi& E) {
    pg8::StaticOrder S; S.init(Mr, N, (int)gridDim.x, (int)blockIdx.x);
    run_gemm_s(c, A, Bt, Mr, N, K, K, S, E);
}
DEV void run_gemm_sample_splitk(const Ctx& c, const bf16* A, const bf16* Bt, int K, int KS) {
    SplitKOrder S; S.init((M - MP) / 256, D / 256, K / KS, MP / 256, (int)gridDim.x, (int)((blockIdx.x + 128) % gridDim.x));
    run_gemm_s(c, A, Bt, M, D, KS, K, S, EpiPartF32{c.w<float>(WS_PART)});
}

DEV void transpose_item(const float* W, int K, int N, bf16* WT, float* scr, int item, int nblk, int lane) {
    const int kb = item / nblk, nb = item % nblk, k0 = 64 * kb, n0 = 32 * nb;
    const int nn = n0 + (lane & 31);
    float tv[32];
#pragma unroll
    for (int i = 0; i < 32; ++i) { const int kk = 2 * i + (lane >> 5); tv[i] = nn < N ? W[(size_t)(k0 + kk) * N + nn] : 0.f; }
#pragma unroll
    for (int i = 0; i < 32; ++i) { const int kk = 2 * i + (lane >> 5); scr[kk * 33 + (lane & 31)] = tv[i]; }
    WAVE_SYNC();
    const int cq = lane & 7;
#pragma unroll
    for (int j = 0; j < 4; ++j) { const int n = (lane >> 3) + 8 * j; const float* s = scr + (8 * cq) * 33 + n;
        u32x4 o; o.x = pk2(s[0 * 33], s[1 * 33]); o.y = pk2(s[2 * 33], s[3 * 33]); o.z = pk2(s[4 * 33], s[5 * 33]); o.w = pk2(s[6 * 33], s[7 * 33]);
        *(u32x4*)(WT + (size_t)(n0 + n) * K + k0 + 8 * cq) = o; }
    WAVE_SYNC();
}
DEV void rms_row_to_bf16(const float* xrow, const float* gain, bf16* orow, int lane) {
    f32x4 v[4]; float s = 0.f;
#pragma unroll
    for (int j = 0; j < 4; ++j) { v[j] = *(const f32x4*)(xrow + 4 * lane + 256 * j); s += (v[j][0] * v[j][0] + v[j][1] * v[j][1]) + (v[j][2] * v[j][2] + v[j][3] * v[j][3]); }
    const float rstd = rsqrtf(wave_sum(s) * (1.f / D) + EPS);
#pragma unroll
    for (int j = 0; j < 4; ++j) { const f32x4 g = *(const f32x4*)(gain + 4 * lane + 256 * j);
        u32x2 o; o.x = pk2(v[j][0] * rstd * g[0], v[j][1] * rstd * g[1]); o.y = pk2(v[j][2] * rstd * g[2], v[j][3] * rstd * g[3]);
        *(u32x2*)(orow + 4 * lane + 256 * j) = o; }
}
DEV void zero_row_bf16(bf16* orow, int lane) {
#pragma unroll
    for (int j = 0; j < 4; ++j) { u32x2 o; o.x = 0u; o.y = 0u; *(u32x2*)(orow + 4 * lane + 256 * j) = o; }
}
#define TJOB(Wp, K_, N_, Npad_, wt_) do { const int nblk = (Npad_) / 32, nitems = ((K_) / 64) * nblk; bf16* WT = c.w<bf16>(wt_); const float* Wsrc = (Wp); \
        for (int it = gw0; it < nitems; it += ngw0) transpose_item(Wsrc, (K_), (N_), WT, scr, it, nblk, c.lane); } while (0)
DEV void phase_convert_late(const Ctx& c, int gw0, int ngw0) {
    float* scr = (float*)(c.lds + c.wave * 8704);
    TJOB(c.in<float>(23), D, D, D, WS_WOAB);
    TJOB(c.in<float>(11), D, FF, FF, WS_WUP0);
    TJOB(c.in<float>(12), FF, D, D, WS_WDN0);
}
DEV void phase_convert_late2(const Ctx& c, int gw0, int ngw0) {
    float* scr = (float*)(c.lds + c.wave * 8704);
    TJOB(c.in<float>(24), D, INC, INC, WS_WINC);
    TJOB(c.in<float>(27), D, D, D, WS_WOC);
    TJOB(c.in<float>(11) + (size_t)D * FF, D, FF, FF, WS_WUP1);
    TJOB(c.in<float>(12) + (size_t)D * FF, FF, D, D, WS_WDN1);
}
DEV void phase_prologue(const Ctx& c) {
    float* scr = (float*)(c.lds + c.wave * 8704);
    const int gw0 = c.gw, ngw0 = c.ngw;
    TJOB(c.in<float>(13), D, IN_AB, LD1, WS_WINAB);
    TJOB(c.in<float>(19), 256, 768, 768, WS_WUQ);
    TJOB(c.in<float>(21), 256, 512, 512, WS_WUKV); TJOB(c.in<float>(22), 256, 512, 512, WS_WUKV + (size_t)512 * 256 * 2);
#undef TJOB
    {
        const float* src = c.in<float>(21); bf16* dst = c.w<bf16>(WS_WUKB);
        for (int i = blockIdx.x * 512 + c.tid; i < 256 * 512 / 4; i += gridDim.x * 512) { const f32x4 v = *(const f32x4*)(src + 4 * i); u32x2 o; o.x = pk2(v[0], v[1]); o.y = pk2(v[2], v[3]); *(u32x2*)(dst + 4 * i) = o; }
    }
    float* rope = c.w<float>(WS_ROPE);
    for (int i = blockIdx.x * 512 + c.tid; i < (SEQ + 8) * 16; i += gridDim.x * 512) {
        const int e = i >> 4, f = i & 15; const double pos = e < SEQ ? (double)e : (double)(PAST + e - SEQ);
        const double ang = pos * pow(10000.0, -(double)f / 16.0);
        rope[e * 32 + f] = (float)cos(ang); rope[e * 32 + 16 + f] = (float)sin(ang);
    }
    bf16* XN = c.w<bf16>(WS_XN);
    for (int m = c.gw; m < M; m += c.ngw) {
        if (m < MT) rms_row_to_bf16(xin_row(c, m), c.in<float>(8), XN + (size_t)m * D, c.lane); else zero_row_bf16(XN + (size_t)m * D, c.lane);
    }
}
DEV void sample_row_sum(const Ctx& c, int m, const float* X_res, int nsp, f32x4 (&v)[4]) {
    const int lane = c.lane; const float* P = c.w<float>(WS_PART) + (size_t)(m - MP) * D;
#pragma unroll
    for (int j = 0; j < 4; ++j) {
        if (X_res) v[j] = *(const f32x4*)(X_res + (size_t)m * D + 4 * lane + 256 * j);
        else v[j] = m < MT ? *(const f32x4*)(c.in<float>(1) + (size_t)(m - MP) * D + 4 * lane + 256 * j) : (f32x4){0.f, 0.f, 0.f, 0.f}; }
    for (int s = 0; s < nsp; ++s) {
#pragma unroll
        for (int j = 0; j < 4; ++j) v[j] += *(const f32x4*)(P + (size_t)s * (M - MP) * D + 4 * lane + 256 * j); }
}
DEV void phase_rmsnorm(const Ctx& c, float* X, const float* gain, const float* X_res, int nsp) {
    bf16* XN = c.w<bf16>(WS_XN); const int lane = c.lane;
    for (int m = c.gw; m < M; m += c.ngw) {
        if (m < MP) { rms_row_to_bf16(X + (size_t)m * D, gain, XN + (size_t)m * D, lane); continue; }
        f32x4 v[4]; sample_row_sum(c, m, X_res, nsp, v);
        float s = 0.f;
#pragma unroll
        for (int j = 0; j < 4; ++j) { *(f32x4*)(X + (size_t)m * D + 4 * lane + 256 * j) = v[j]; s += (v[j][0] * v[j][0] + v[j][1] * v[j][1]) + (v[j][2] * v[j][2] + v[j][3] * v[j][3]); }
        const float rstd = rsqrtf(wave_sum(s) * (1.f / D) + EPS);
#pragma unroll
        for (int j = 0; j < 4; ++j) { const f32x4 g = *(const f32x4*)(gain + 4 * lane + 256 * j);
            u32x2 o; o.x = pk2(v[j][0] * rstd * g[0], v[j][1] * rstd * g[1]); o.y = pk2(v[j][2] * rstd * g[2], v[j][3] * rstd * g[3]);
            *(u32x2*)(XN + (size_t)m * D + 4 * lane + 256 * j) = o; }
    }
}
DEV void phase_copy_rows(const Ctx& c, float* dst, const float* src, int nrows) {
    for (int r = (int)(gridDim.x * 8) - 1 - c.gw; r < nrows; r += c.ngw) {
#pragma unroll
        for (int j = 0; j < 4; ++j) *(f32x4*)(dst + (size_t)r * D + 4 * c.lane + 256 * j) = *(const f32x4*)(src + (size_t)r * D + 4 * c.lane + 256 * j); }
}
DEV void phase_final(const Ctx& c, const float* X, const float* gain, const float* X_res, int nsp) {
    for (int m = c.gw; m < MT; m += c.ngw) {
        const float* xrow = X + (size_t)m * D; float* orow = c.out + (m < MP ? O_YP + (size_t)m * D : O_YS + (size_t)(m - MP) * D);
        f32x4 v[4]; float s = 0.f;
        if (m >= MP) sample_row_sum(c, m, X_res, nsp, v);
#pragma unroll
        for (int j = 0; j < 4; ++j) { if (m < MP) v[j] = *(const f32x4*)(xrow + 4 * c.lane + 256 * j); s += (v[j][0] * v[j][0] + v[j][1] * v[j][1]) + (v[j][2] * v[j][2] + v[j][3] * v[j][3]); }
        const float rstd = rsqrtf(wave_sum(s) * (1.f / D) + EPS);
#pragma unroll
        for (int j = 0; j < 4; ++j) { const f32x4 g = *(const f32x4*)(gain + 4 * c.lane + 256 * j); *(f32x4*)(orow + 4 * c.lane + 256 * j) = v[j] * rstd * g; }
    }
}

DEV void phase_prep0(const Ctx& c) {
    const bf16* P1 = c.w<bf16>(WS_P1); const float* rope = c.w<float>(WS_ROPE);
    bf16* CQN = c.w<bf16>(WS_CQN); bf16* LATN = c.w<bf16>(WS_LATN);
    const float* qg = c.in<float>(18); const float* kvg = c.in<float>(20);
    const int lane = c.lane;
    for (int m = c.gw; m < M; m += c.ngw) {
        if (m >= MT) { u32x2 z; z.x = 0u; z.y = 0u; *(u32x2*)(CQN + (size_t)m * 256 + 4 * lane) = z; *(u32x2*)(LATN + (size_t)m * 256 + 4 * lane) = z; continue; }
        const bf16* row = P1 + (size_t)m * LD1;
        const bool samp = m >= MP; const int b = samp ? (m - MP) / DECS : m / SEQ, t = samp ? (m - MP) % DECS : m % SEQ;
        {
            const f32x4 v = ld4bf(row + C_CQ + 4 * lane); const f32x4 g = *(const f32x4*)(qg + 4 * lane);
            const float r = rsqrtf(wave_sum((v[0] * v[0] + v[1] * v[1]) + (v[2] * v[2] + v[3] * v[3])) * (1.f / 256.f) + EPS);
            u32x2 o; o.x = pk2(v[0] * r * g[0], v[1] * r * g[1]); o.y = pk2(v[2] * r * g[2], v[3] * r * g[3]); *(u32x2*)(CQN + (size_t)m * 256 + 4 * lane) = o;
        }
        {
            const f32x4 v = ld4bf(row + C_CKV + 4 * lane); const f32x4 g = *(const f32x4*)(kvg + 4 * lane);
            const float r = rsqrtf(wave_sum((v[0] * v[0] + v[1] * v[1]) + (v[2] * v[2] + v[3] * v[3])) * (1.f / 256.f) + EPS);
            const f32x4 y = v * r * g;
            float* lo = c.out + (samp ? O_LATS + (size_t)(m - MP) * 256 : O_LATP + (size_t)m * 256);
            *(f32x4*)(lo + 4 * lane) = y;
            u32x2 o; o.x = pk2(y[0], y[1]); o.y = pk2(y[2], y[3]); *(u32x2*)(LATN + (size_t)m * 256 + 4 * lane) = o;
        }
        if (lane < 16) {
            const float* rt = rope + (size_t)(samp ? SEQ + t : t) * 32; const float cs = rt[lane], sn = rt[16 + lane];
            const float x1 = bf2f(row[C_KPE + lane]), x2 = bf2f(row[C_KPE + 16 + lane]);
            float* ko = c.out + (samp ? O_KPES + (size_t)(m - MP) * 32 : O_KPEP + (size_t)m * 32);
            ko[lane] = x1 * cs - x2 * sn; ko[16 + lane] = x2 * cs + x1 * sn;
            if (!samp) { bf16* kb = c.w<bf16>(WS_KPEB) + (size_t)m * 32; kb[lane] = (bf16)f2bf(x1 * cs - x2 * sn); kb[16 + lane] = (bf16)f2bf(x2 * cs + x1 * sn); }
        }
        const int T = samp ? DECS : SEQ;
        if (t >= T - 3) {
            float* co = c.out + (samp ? O_CONVS : O_CONVP) + ((size_t)b * 3 + (t - (T - 3))) * QKV_A;
#pragma unroll
            for (int j = 0; j < 6; ++j) *(f32x4*)(co + 4 * lane + 256 * j) = ld4bf(row + 4 * lane + 256 * j);
        }
    }
}

DEV void phase_gdn_naive(const Ctx& c, int u_begin, int wg_first, int wg_stride) {
    float* red = (float*)c.lds; float* red2 = red + 512; float* qs = red2 + 512; float* ks = qs + 128; float* vs = ks + 128; float* part = vs + 128; float* sc = part + 8;
    const bf16* P1 = c.w<bf16>(WS_P1); float* ORAW = c.w<float>(WS_ORAW); bf16* OCAT = c.w<bf16>(WS_OCAT);
    const float* convw = c.in<float>(14); const float* gn = c.in<float>(17);
    const int tid = c.tid, lane = c.lane, wave = c.wave;
    const int NU = (BATCH + DECB) * 4;
    for (int u = u_begin + wg_first; u < NU; u += wg_stride) {
        const bool samp = u >= BATCH * 4; const int b = samp ? (u - BATCH * 4) >> 2 : u >> 2, h = u & 3;
        const int T = samp ? DECS : SEQ; const size_t m0 = samp ? (size_t)MP + (size_t)b * DECS : (size_t)b * SEQ;
        const int e = tid & 127, dg = tid >> 7, d0 = dg * 32;
        float s[32];
        if (samp) { const float* S0 = c.in<float>(2) + ((size_t)(b * 4 + h) * 128 + d0) * 128 + e;
#pragma unroll
            for (int i = 0; i < 32; ++i) s[i] = S0[(size_t)i * 128]; }
        else {
#pragma unroll
            for (int i = 0; i < 32; ++i) s[i] = 0.f; }
        const int col = tid < 128 ? h * 128 + tid : (tid < 256 ? 512 + h * 128 + (tid - 128) : 1024 + h * 128 + (tid - 256));
        float w0 = 0.f, w1 = 0.f, w2 = 0.f, w3 = 0.f, x0 = 0.f, x1 = 0.f, x2 = 0.f, xn = 0.f;
        if (tid < 384) { w0 = convw[col]; w1 = convw[QKV_A + col]; w2 = convw[2 * QKV_A + col]; w3 = convw[3 * QKV_A + col];
            if (samp) { const float* cb = c.in<float>(3) + (size_t)b * 3 * QKV_A + col; x0 = cb[0]; x1 = cb[QKV_A]; x2 = cb[2 * QKV_A]; }
            xn = bf2f(P1[m0 * LD1 + col]); }
        const float Aexp = __expf(c.in<float>(15)[h]), dtb = c.in<float>(16)[h];
        for (int t = 0; t < T; ++t) {
            const size_t m = m0 + t;
            const float x3 = xn; if (t + 1 < T && tid < 384) xn = bf2f(P1[(m + 1) * LD1 + col]);
            float val = 0.f;
            if (tid < 384) { const float y = w0 * x0 + w1 * x1 + w2 * x2 + w3 * x3; val = siluf_(y); x0 = x1; x1 = x2; x2 = x3; }
            const float sq = wave_sum(tid < 256 ? val * val : 0.f);
            if (tid < 128) qs[tid] = val; else if (tid < 256) ks[tid - 128] = val; else if (tid < 384) vs[tid - 256] = val;
            if (lane == 0 && wave < 4) part[wave] = sq;
            if (tid == 384) { sc[0] = sigmoidf_(bf2f(P1[m * LD1 + C_B + h])); sc[1] = -Aexp * softplusf_(bf2f(P1[m * LD1 + C_A + h]) + dtb); }
            LDS_BARRIER();
            const float qn = rsqrtf(part[0] + part[1] + EPS), kn = rsqrtf(part[2] + part[3] + EPS), beta = sc[0], dec = __expf(sc[1]);
            float kp = 0.f;
#pragma unroll
            for (int i = 0; i < 32; ++i) { s[i] *= dec; kp += ks[d0 + i] * s[i]; }
            red[dg * 128 + e] = kp * kn;
            LDS_BARRIER();
            const float kS = (red[e] + red[128 + e]) + (red[256 + e] + red[384 + e]);
            const float delta = beta * (vs[e] - kS) * kn;
            float op = 0.f;
#pragma unroll
            for (int i = 0; i < 32; ++i) { s[i] += ks[d0 + i] * delta; op += qs[d0 + i] * s[i]; }
            red2[dg * 128 + e] = op * qn;
            LDS_BARRIER();
            if (dg == 0) ORAW[m * 512 + h * 128 + e] = ((red2[e] + red2[128 + e]) + (red2[256 + e] + red2[384 + e])) * DK_SCALE;
        }
        float* So = c.out + (samp ? O_GDNS : O_GDNP) + ((size_t)(b * 4 + h) * 128 + d0) * 128 + e;
#pragma unroll
        for (int i = 0; i < 32; ++i) So[(size_t)i * 128] = s[i];
        __syncthreads();
        for (int t = wave; t < T; t += 8) { const size_t m = m0 + t;
            const float v0 = ORAW[m * 512 + h * 128 + lane], v1 = ORAW[m * 512 + h * 128 + 64 + lane];
            const float r = rsqrtf(wave_sum(v0 * v0 + v1 * v1) * (1.f / 128.f) + EPS);
            const float z0 = bf2f(P1[m * LD1 + C_Z + h * 128 + lane]), z1 = bf2f(P1[m * LD1 + C_Z + h * 128 + 64 + lane]);
            OCAT[m * D + h * 128 + lane] = (bf16)f2bf(v0 * r * gn[lane] * siluf_(z0));
            OCAT[m * D + h * 128 + 64 + lane] = (bf16)f2bf(v1 * r * gn[64 + lane] * siluf_(z1)); }
        __syncthreads();
    }
}

DEV void phase_hgrn_naive(const Ctx& c, int u_begin, int wg_first, int wg_stride) {
    float* red = (float*)c.lds; float* qs = red + 512; float* fs = qs + 128;
    const bf16* PC = c.w<bf16>(WS_P1); float* ORAW = c.w<float>(WS_ORAW); bf16* OC = c.w<bf16>(WS_OCAT);
    const float* lbl = c.in<float>(25); const float* gn = c.in<float>(26);
    const int tid = c.tid, lane = c.lane, wave = c.wave;
    const int NU = (BATCH + DECB) * 8;
    for (int u = u_begin + wg_first; u < NU; u += wg_stride) {
        const bool samp = u >= BATCH * 8; const int b = samp ? (u - BATCH * 8) >> 3 : u >> 3, h = u & 7;
        const int T = samp ? DECS : SEQ; const size_t m0 = samp ? (size_t)MP + (size_t)b * DECS : (size_t)b * SEQ;
        const int e = tid & 127, dg = tid >> 7, d0 = dg * 32;
        float s[32];
        if (samp) { const float* S0 = c.in<float>(6) + ((size_t)(b * 8 + h) * 128 + d0) * 128 + e;
#pragma unroll
            for (int i = 0; i < 32; ++i) s[i] = S0[(size_t)i * 128]; }
        else {
#pragma unroll
            for (int i = 0; i < 32; ++i) s[i] = 0.f; }
        float lb = 0.f; if (tid < 128) lb = sigmoidf_(lbl[1024 + h * 128 + tid] - lbl[h * 128 + tid]);
        bf16 nq = 0, nf = 0, nv = 0;
        { const bf16* row = PC + m0 * INC; if (tid < 128) { nq = row[h * 128 + tid]; nf = row[1024 + h * 128 + tid]; } nv = row[2048 + h * 128 + e]; }
        for (int t = 0; t < T; ++t) {
            const size_t m = m0 + t;
            if (tid < 128) { qs[tid] = siluf_(bf2f(nq)); fs[tid] = lb + (1.f - lb) * sigmoidf_(bf2f(nf)); }
            const float v = bf2f(nv);
            if (t + 1 < T) { const bf16* row = PC + (m + 1) * INC; if (tid < 128) { nq = row[h * 128 + tid]; nf = row[1024 + h * 128 + tid]; } nv = row[2048 + h * 128 + e]; }
            LDS_BARRIER();
            float op = 0.f;
#pragma unroll
            for (int i = 0; i < 32; ++i) { const float f = fs[d0 + i]; s[i] = f * s[i] + (1.f - f) * v; op += qs[d0 + i] * s[i]; }
            red[dg * 128 + e] = op;
            LDS_BARRIER();
            if (dg == 0) ORAW[m * D + h * 128 + e] = ((red[e] + red[128 + e]) + (red[256 + e] + red[384 + e])) * DK_SCALE;
        }
        float* So = c.out + (samp ? O_HGS : O_HGP) + ((size_t)(b * 8 + h) * 128 + d0) * 128 + e;
#pragma unroll
        for (int i = 0; i < 32; ++i) So[(size_t)i * 128] = s[i];
        __syncthreads();
        for (int t = wave; t < T; t += 8) { const size_t m = m0 + t;
            const float v0 = ORAW[m * D + h * 128 + lane], v1 = ORAW[m * D + h * 128 + 64 + lane];
            const float r = rsqrtf(wave_sum(v0 * v0 + v1 * v1) * (1.f / 128.f) + EPS);
            const float z0 = bf2f(PC[m * INC + 3072 + h * 128 + lane]), z1 = bf2f(PC[m * INC + 3072 + h * 128 + 64 + lane]);
            OC[m * D + h * 128 + lane] = (bf16)f2bf(v0 * r * gn[lane] * siluf_(z0));
            OC[m * D + h * 128 + 64 + lane] = (bf16)f2bf(v1 * r * gn[64 + lane] * siluf_(z1)); }
        __syncthreads();
    }
}

DEV bf16x8 ld8(const bf16* p) { return *(const bf16x8*)p; }
DEV void softmax_strip(f32x4 (&s)[4], float (&mrun)[4], float (&lrun)[4], float (&alpha)[4], bf16* Ps, int lane) {
#pragma unroll
    for (int r = 0; r < 4; ++r) {
        float mx = fmaxf(fmaxf(s[0][r], s[1][r]), fmaxf(s[2][r], s[3][r])); mx = grp16_max(mx);
        const float mn = fmaxf(mrun[r], mx);
        alpha[r] = __expf(mrun[r] - mn); mrun[r] = mn;
        float sum = 0.f;
#pragma unroll
        for (int nt = 0; nt < 4; ++nt) { const float p = __expf(s[nt][r] - mn); s[nt][r] = p; sum += p; }
        sum = grp16_sum(sum); lrun[r] = lrun[r] * alpha[r] + sum;
    }
#pragma unroll
    for (int nt = 0; nt < 4; ++nt)
#pragma unroll
        for (int r = 0; r < 4; ++r) Ps[((lane >> 4) * 4 + r) * 72 + nt * 16 + (lane & 15)] = (bf16)f2bf(s[nt][r]);
}
DEV void phase_attn_prompt(const Ctx& c) {
    bf16* Qs = (bf16*)c.lds;
    bf16* Ks = Qs + 128 * 104;
    bf16* Vt = Ks + 64 * 104;
    bf16* Psb = Vt + 64 * 72;
    const float* QH = c.w<float>(WS_QH); const bf16* KVP = c.w<bf16>(WS_KVP); const float* rope = c.w<float>(WS_ROPE); bf16* OCAT = c.w<bf16>(WS_OCAT);
    const float* kpe = c.out + O_KPEP;
    const int tid = c.tid, lane = c.lane, w = c.wave;
    bf16* Ps = Psb + w * 16 * 72;
    constexpr int NQB = SEQ / 128, NU = BATCH * 8 * NQB;
    for (int u = blockIdx.x; u < NU; u += gridDim.x) {
        const int qb = NQB - 1 - u / (BATCH * 8), bh = u % (BATCH * 8), b = bh >> 3, h = bh & 7;
        const int q0 = qb * 128; const size_t mb = (size_t)b * SEQ;
        __syncthreads();
        for (int idx = tid; idx < 128 * 80; idx += 512) {
            const int r = idx / 80, j = idx % 80; const float* qrow = QH + (mb + q0 + r) * 768 + h * 96;
            if (j < 64) Qs[r * 104 + j] = (bf16)f2bf(qrow[j] * MLA_SCALE);
            else { const int f = j - 64; const float* rt = rope + (size_t)(q0 + r) * 32; const float cs = rt[f], sn = rt[16 + f], x1 = qrow[64 + f], x2 = qrow[80 + f];
                Qs[r * 104 + 64 + f] = (bf16)f2bf((x1 * cs - x2 * sn) * MLA_SCALE); Qs[r * 104 + 80 + f] = (bf16)f2bf((x2 * cs + x1 * sn) * MLA_SCALE); }
        }
        __syncthreads();
        bf16x8 qf[3];
#pragma unroll
        for (int ks = 0; ks < 3; ++ks) qf[ks] = ld8(Qs + (w * 16 + (lane & 15)) * 104 + ks * 32 + 8 * (lane >> 4));
        float mrun[4], lrun[4], alpha[4]; f32x4 o[4];
#pragma unroll
        for (int r = 0; r < 4; ++r) { mrun[r] = -INFINITY; lrun[r] = 0.f; }
#pragma unroll
        for (int nt = 0; nt < 4; ++nt) o[nt] = (f32x4){0.f, 0.f, 0.f, 0.f};
        const int nkt = 2 * qb + 2;
        for (int kt = 0; kt < nkt; ++kt) {
            const int k0 = kt * 64;
            __syncthreads();
            for (int idx = tid; idx < 64 * 8; idx += 512) {
                const int key = idx >> 3, ch = idx & 7; *(u32x4*)(Ks + key * 104 + ch * 8) = *(const u32x4*)(KVP + (mb + k0 + key) * 1024 + h * 64 + ch * 8); }
            for (int idx = tid; idx < 64 * 32; idx += 512) { const int key = idx >> 5, f = idx & 31; Ks[key * 104 + 64 + f] = (bf16)f2bf(kpe[(mb + k0 + key) * 32 + f]); }
            for (int idx = tid; idx < 64 * 64; idx += 512) { const int key = idx >> 6, d = idx & 63; Vt[d * 72 + key] = KVP[(mb + k0 + key) * 1024 + 512 + h * 64 + d]; }
            __syncthreads();
            f32x4 s[4];
#pragma unroll
            for (int nt = 0; nt < 4; ++nt) { s[nt] = (f32x4){0.f, 0.f, 0.f, 0.f};
#pragma unroll
                for (int ks = 0; ks < 3; ++ks) s[nt] = mfma16(qf[ks], ld8(Ks + (nt * 16 + (lane & 15)) * 104 + ks * 32 + 8 * (lane >> 4)), s[nt]); }
            if (kt >= 2 * qb) {
#pragma unroll
                for (int nt = 0; nt < 4; ++nt)
#pragma unroll
                    for (int r = 0; r < 4; ++r) { const int qpos = q0 + w * 16 + (lane >> 4) * 4 + r, kpos = k0 + nt * 16 + (lane & 15); if (kpos > qpos) s[nt][r] = -INFINITY; }
            }
            softmax_strip(s, mrun, lrun, alpha, Ps, lane);
            WAVE_SYNC();
#pragma unroll
            for (int nt = 0; nt < 4; ++nt) {
#pragma unroll
                for (int r = 0; r < 4; ++r) o[nt][r] *= alpha[r];
#pragma unroll
                for (int k2 = 0; k2 < 2; ++k2) o[nt] = mfma16(ld8(Ps + (lane & 15) * 72 + k2 * 32 + 8 * (lane >> 4)), ld8(Vt + (nt * 16 + (lane & 15)) * 72 + k2 * 32 + 8 * (lane >> 4)), o[nt]); }
            WAVE_SYNC();
        }
#pragma unroll
        for (int nt = 0; nt < 4; ++nt)
#pragma unroll
            for (int r = 0; r < 4; ++r) OCAT[(mb + q0 + w * 16 + (lane >> 4) * 4 + r) * D + 512 + h * 64 + nt * 16 + (lane & 15)] = (bf16)f2bf(o[nt][r] / lrun[r]);
    }
}

DEV void phase_attn_sample(const Ctx& c) {
    bf16* Qs = (bf16*)c.lds;
    bf16* Ks = Qs + 64 * 296;
    bf16* Lt = Ks + 64 * 296;
    float* Sf = (float*)(Lt + 256 * 72);
    bf16* Psb = (bf16*)(Sf + 64 * 68);
    float* Of = (float*)Ks;
    const float* QH = c.w<float>(WS_QH); const float* rope = c.w<float>(WS_ROPE); bf16* OCAT = c.w<bf16>(WS_OCAT);
    const float* wuk = c.in<float>(21); const float* wuv = c.in<float>(22);
    const float* clat = c.in<float>(4); const float* ckr = c.in<float>(5); const int* ptab = c.in<int>(7);
    const int tid = c.tid, lane = c.lane, w = c.wave;
    bf16* Ps = Psb + w * 16 * 72;
    for (int b = blockIdx.x; b < DECB; b += gridDim.x) {
        const size_t mb = (size_t)MP + (size_t)b * DECS;
        __syncthreads();
        for (int idx = tid; idx < 64 * 64; idx += 512) { const int r = idx >> 6, d = idx & 63, t = r >> 3, h = r & 7; Sf[r * 68 + d] = QH[(mb + t) * 768 + h * 96 + d]; }
        for (int idx = tid; idx < 64 * 16; idx += 512) { const int r = idx >> 4, f = idx & 15, t = r >> 3, h = r & 7; const float* qrow = QH + (mb + t) * 768 + h * 96 + 64;
            const float* rt = rope + (size_t)(SEQ + t) * 32; const float cs = rt[f], sn = rt[16 + f], x1 = qrow[f], x2 = qrow[16 + f];
            Qs[r * 296 + 256 + f] = (bf16)f2bf((x1 * cs - x2 * sn) * MLA_SCALE); Qs[r * 296 + 272 + f] = (bf16)f2bf((x2 * cs + x1 * sn) * MLA_SCALE); }
        __syncthreads();
        {
            const int l = tid & 255, th = tid >> 8;
            for (int h = 0; h < 8; ++h) {
                float a0 = 0.f, a1 = 0.f, a2 = 0.f, a3 = 0.f; const float* wr = wuk + (size_t)l * 512 + h * 64;
                const float* q0 = Sf + ((th * 4 + 0) * 8 + h) * 68; const float* q1 = Sf + ((th * 4 + 1) * 8 + h) * 68; const float* q2 = Sf + ((th * 4 + 2) * 8 + h) * 68; const float* q3 = Sf + ((th * 4 + 3) * 8 + h) * 68;
#pragma unroll 4
                for (int d4 = 0; d4 < 16; ++d4) { const f32x4 wv = *(const f32x4*)(wr + 4 * d4);
#pragma unroll
                    for (int j = 0; j < 4; ++j) { a0 += q0[4 * d4 + j] * wv[j]; a1 += q1[4 * d4 + j] * wv[j]; a2 += q2[4 * d4 + j] * wv[j]; a3 += q3[4 * d4 + j] * wv[j]; } }
                Qs[((th * 4 + 0) * 8 + h) * 296 + l] = (bf16)f2bf(a0 * MLA_SCALE); Qs[((th * 4 + 1) * 8 + h) * 296 + l] = (bf16)f2bf(a1 * MLA_SCALE);
                Qs[((th * 4 + 2) * 8 + h) * 296 + l] = (bf16)f2bf(a2 * MLA_SCALE); Qs[((th * 4 + 3) * 8 + h) * 296 + l] = (bf16)f2bf(a3 * MLA_SCALE);
            }
        }
        __syncthreads();
        const int rt = w & 3, hh = w >> 2;
        bf16x8 qf[9];
#pragma unroll
        for (int ks = 0; ks < 9; ++ks) qf[ks] = ld8(Qs + (rt * 16 + (lane & 15)) * 296 + ks * 32 + 8 * (lane >> 4));
        float mrun[4], lrun[4], alpha[4]; f32x4 o[8];
#pragma unroll
        for (int r = 0; r < 4; ++r) { mrun[r] = -INFINITY; lrun[r] = 0.f; }
#pragma unroll
        for (int nt = 0; nt < 8; ++nt) o[nt] = (f32x4){0.f, 0.f, 0.f, 0.f};
        constexpr int NT = PAST / 64 + 1;
        for (int kt = 0; kt < NT; ++kt) {
            const bool fresh = kt == NT - 1;
            __syncthreads();
            if (!fresh) {
                const int k0 = kt * 64; const size_t rowbase = (size_t)ptab[b * NPAGES + (k0 >> 7)] * PAGE + (k0 & 127);
#pragma unroll 2
                for (int j = 0; j < 8; ++j) { const int idx = tid + 512 * j, key = idx >> 6, l4 = idx & 63;
                    const f32x4 v = *(const f32x4*)(clat + (rowbase + key) * 256 + 4 * l4);
                    u32x2 pk; pk.x = pk2(v[0], v[1]); pk.y = pk2(v[2], v[3]); *(u32x2*)(Ks + key * 296 + 4 * l4) = pk;
                    Lt[(4 * l4 + 0) * 72 + key] = (bf16)f2bf(v[0]); Lt[(4 * l4 + 1) * 72 + key] = (bf16)f2bf(v[1]); Lt[(4 * l4 + 2) * 72 + key] = (bf16)f2bf(v[2]); Lt[(4 * l4 + 3) * 72 + key] = (bf16)f2bf(v[3]); }
                { const int key = tid >> 3, i4 = tid & 7; const f32x4 v = *(const f32x4*)(ckr + (rowbase + key) * 32 + 4 * i4);
                    u32x2 pk; pk.x = pk2(v[0], v[1]); pk.y = pk2(v[2], v[3]); *(u32x2*)(Ks + key * 296 + 256 + 4 * i4) = pk; }
            } else {
                const float* nl = c.out + O_LATS + (size_t)b * DECS * 256; const float* nk = c.out + O_KPES + (size_t)b * DECS * 32;
                for (int idx = tid; idx < 64 * 256; idx += 512) { const int key = idx >> 8, l = idx & 255; const bf16 v = key < DECS ? (bf16)f2bf(nl[key * 256 + l]) : (bf16)0; Ks[key * 296 + l] = v; Lt[l * 72 + key] = v; }
                for (int idx = tid; idx < 64 * 32; idx += 512) { const int key = idx >> 5, f = idx & 31; Ks[key * 296 + 256 + f] = key < DECS ? (bf16)f2bf(nk[key * 32 + f]) : (bf16)0; }
            }
            __syncthreads();
#pragma unroll
            for (int n2 = 0; n2 < 2; ++n2) { const int nt = 2 * hh + n2; f32x4 s = (f32x4){0.f, 0.f, 0.f, 0.f};
#pragma unroll
                for (int ks = 0; ks < 9; ++ks) s = mfma16(qf[ks], ld8(Ks + (nt * 16 + (lane & 15)) * 296 + ks * 32 + 8 * (lane >> 4)), s);
#pragma unroll
                for (int r = 0; r < 4; ++r) { const int row = rt * 16 + (lane >> 4) * 4 + r, key = nt * 16 + (lane & 15); float v = s[r];
                    if (fresh && (key >= DECS || key > (row >> 3))) v = -INFINITY;
                    Sf[row * 68 + key] = v; } }
            __syncthreads();
            f32x4 s[4];
#pragma unroll
            for (int nt = 0; nt < 4; ++nt)
#pragma unroll
                for (int r = 0; r < 4; ++r) s[nt][r] = Sf[(rt * 16 + (lane >> 4) * 4 + r) * 68 + nt * 16 + (lane & 15)];
            softmax_strip(s, mrun, lrun, alpha, Ps, lane);
            WAVE_SYNC();
#pragma unroll
            for (int nt = 0; nt < 8; ++nt) {
#pragma unroll
                for (int r = 0; r < 4; ++r) o[nt][r] *= alpha[r];
#pragma unroll
                for (int k2 = 0; k2 < 2; ++k2) o[nt] = mfma16(ld8(Ps + (lane & 15) * 72 + k2 * 32 + 8 * (lane >> 4)), ld8(Lt + (hh * 128 + nt * 16 + (lane & 15)) * 72 + k2 * 32 + 8 * (lane >> 4)), o[nt]); }
            WAVE_SYNC();
        }
        __syncthreads();
#pragma unroll
        for (int nt = 0; nt < 8; ++nt)
#pragma unroll
            for (int r = 0; r < 4; ++r) Of[(rt * 16 + (lane >> 4) * 4 + r) * 260 + hh * 128 + nt * 16 + (lane & 15)] = o[nt][r] / lrun[r];
        __syncthreads();
        {
            const int d = tid & 63, h = tid >> 6; float a[8];
#pragma unroll
            for (int t = 0; t < 8; ++t) a[t] = 0.f;
            for (int l = 0; l < 256; ++l) { const float wv = wuv[(size_t)l * 512 + h * 64 + d];
#pragma unroll
                for (int t = 0; t < 8; ++t) a[t] += Of[(t * 8 + h) * 260 + l] * wv; }
#pragma unroll
            for (int t = 0; t < 8; ++t) OCAT[(mb + t) * D + 512 + h * 64 + d] = (bf16)f2bf(a[t]);
        }
    }
}

constexpr int NCH = SEQ / 64;
constexpr size_t HC_QG = WS_H, HC_BNT = HC_QG + (size_t)BATCH * 8 * NCH * 64 * 128 * 2,
    HC_A = HC_BNT + (size_t)BATCH * 8 * NCH * 128 * 128 * 2, HC_END = HC_A + (size_t)BATCH * 8 * NCH * 128 * 4;
constexpr size_t HC_SNT = WS_QH;
static_assert(HC_END <= WS_H_END && HC_SNT + (size_t)BATCH * 8 * NCH * 128 * 128 * 2 <= WS_OCAT, "hgrn scratch fits");
DEV u32x4 pack8(const float* v) { u32x4 o; o.x = pk2(v[0], v[1]); o.y = pk2(v[2], v[3]); o.z = pk2(v[4], v[5]); o.w = pk2(v[6], v[7]); return o; }

DEV void phase_hgrn_prep(const Ctx& c) {
    bf16* qt = (bf16*)c.lds;
    bf16* kt = qt + 64 * 136;
    bf16* vT = kt + 160 * 136;
    bf16* Ab = vT + 128 * 72;
    float* tot = (float*)(Ab + 64 * 72);
    bf16* kgl = (bf16*)(tot + 512);
    const bf16* PC = c.w<bf16>(WS_P1); float* ORAW = c.w<float>(WS_ORAW);
    bf16* QG = c.w<bf16>(HC_QG); bf16* BNT = c.w<bf16>(HC_BNT); float* Ag = c.w<float>(HC_A);
    const float* lbl = c.in<float>(25);
    const int tid = c.tid, lane = c.lane, w = c.wave;
    const int d = tid & 127, tq = tid >> 7;
    constexpr int NU = BATCH * 8 * NCH;
    bf16 rq[16], rf[16], rv[16];
#define HP_LOAD(u_) do { const int u__ = (u_); const int bh_ = u__ / NCH, n_ = u__ % NCH; const bf16* row_ = PC + ((size_t)(bh_ >> 3) * SEQ + (size_t)n_ * 64 + 16 * tq) * INC + (bh_ & 7) * 128 + d; \
        _Pragma("unroll") for (int i = 0; i < 16; ++i) { rq[i] = row_[(size_t)i * INC]; rf[i] = row_[(size_t)i * INC + 1024]; rv[i] = row_[(size_t)i * INC + 2048]; } } while (0)
    if ((int)blockIdx.x < NU) HP_LOAD(blockIdx.x);
    for (int u = blockIdx.x; u < NU; u += gridDim.x) {
        const int bh = u / NCH, n = u % NCH, b = bh >> 3, h = bh & 7;
        const size_t m0 = (size_t)b * SEQ + (size_t)n * 64;
        const float lb = sigmoidf_(lbl[1024 + h * 128 + d] - lbl[h * 128 + d]);
        float gcl[16], kk[16], qq[16], vv[16];
        float run = 0.f;
#pragma unroll
        for (int i = 0; i < 16; ++i) {
            const float f = lb + (1.f - lb) * sigmoidf_(bf2f(rf[i]));
            kk[i] = 1.f - f; run += __logf(f); gcl[i] = run;
            qq[i] = siluf_(bf2f(rq[i])) * DK_SCALE; vv[i] = bf2f(rv[i]);
        }
        if (u + (int)gridDim.x < NU) HP_LOAD(u + (int)gridDim.x);
        tot[tq * 128 + d] = run;
        { const u32x4 p0 = pack8(vv), p1 = pack8(vv + 8);
          *(u32x4*)(vT + d * 72 + 16 * tq) = p0; *(u32x4*)(vT + d * 72 + 16 * tq + 8) = p1; }
        for (int i = tid; i < 64 * 72 / 8; i += 512) { u32x4 z; z.x = z.y = z.z = z.w = 0u; *(u32x4*)(Ab + 8 * i) = z; }
        LDS_BARRIER();
        const float t0 = tot[d], t1 = tot[128 + d], t2 = tot[256 + d], t3 = tot[384 + d];
        const float rI[4] = {0.f, t0, t0 + t1, t0 + t1 + t2}; const float glast = (t0 + t1) + (t2 + t3);
        const float pre = tq == 0 ? rI[0] : (tq == 1 ? rI[1] : (tq == 2 ? rI[2] : rI[3]));
        float kg[16];
#pragma unroll
        for (int i = 0; i < 16; ++i) {
            const float gc = pre + gcl[i];
            qt[(16 * tq + i) * 136 + d] = (bf16)f2bf(qq[i] * __expf(gcl[i]));
            QG[((size_t)u * 64 + 16 * tq + i) * 128 + d] = (bf16)f2bf(qq[i] * __expf(gc));
            kg[i] = kk[i] * __expf(glast - gc);
#pragma unroll
            for (int I = 0; I < 4; ++I) if (I >= tq) { const int base = I == 0 ? 0 : (I == 1 ? 16 : (I == 2 ? 48 : 96));
                kt[(base + 16 * tq + i) * 136 + d] = (bf16)f2bf(kk[i] * __expf(rI[I] - gc)); }
        }
        { bf16* g = kgl + d * 72 + 16 * tq; *(u32x4*)g = pack8(kg); *(u32x4*)(g + 8) = pack8(kg + 8); }
        if (tq == 0) Ag[(size_t)u * 128 + d] = __expf(glast);
        LDS_BARRIER();
        for (int ti = w; ti < 10; ti += 8) {
            const int I = ti == 0 ? 0 : (ti < 3 ? 1 : (ti < 6 ? 2 : 3)); const int J = ti - (I == 0 ? 0 : (I == 1 ? 1 : (I == 2 ? 3 : 6)));
            const int base = I == 0 ? 0 : (I == 1 ? 16 : (I == 2 ? 48 : 96));
            f32x4 acc = (f32x4){0.f, 0.f, 0.f, 0.f};
#pragma unroll
            for (int ks = 0; ks < 4; ++ks) acc = mfma16(ld8(qt + (16 * I + (lane & 15)) * 136 + ks * 32 + 8 * (lane >> 4)), ld8(kt + (base + 16 * J + (lane & 15)) * 136 + ks * 32 + 8 * (lane >> 4)), acc);
#pragma unroll
            for (int r = 0; r < 4; ++r) { const int i = 16 * I + (lane >> 4) * 4 + r, j = 16 * J + (lane & 15); Ab[i * 72 + j] = (bf16)f2bf((J < I || j <= i) ? acc[r] : 0.f); }
        }
        LDS_BARRIER();
        { const int it = w & 3;
#pragma unroll
          for (int e4 = 0; e4 < 4; ++e4) { const int et = (w >> 2) * 4 + e4; f32x4 acc = (f32x4){0.f, 0.f, 0.f, 0.f};
#pragma unroll
            for (int ks = 0; ks < 2; ++ks) acc = mfma16(ld8(Ab + (16 * it + (lane & 15)) * 72 + ks * 32 + 8 * (lane >> 4)), ld8(vT + (16 * et + (lane & 15)) * 72 + ks * 32 + 8 * (lane >> 4)), acc);
#pragma unroll
            for (int r = 0; r < 4; ++r) ORAW[(m0 + 16 * it + (lane >> 4) * 4 + r) * D + h * 128 + 16 * et + (lane & 15)] = acc[r]; } }
        {
            bf16x8 ka[2];
#pragma unroll
            for (int ks = 0; ks < 2; ++ks) ka[ks] = ld8(kgl + (16 * w + (lane & 15)) * 72 + ks * 32 + 8 * (lane >> 4));
            bf16* g = BNT + (size_t)u * 16384;
#pragma unroll
            for (int et = 0; et < 8; ++et) { f32x4 acc = (f32x4){0.f, 0.f, 0.f, 0.f};
#pragma unroll
                for (int ks = 0; ks < 2; ++ks) acc = mfma16(ka[ks], ld8(vT + (16 * et + (lane & 15)) * 72 + ks * 32 + 8 * (lane >> 4)), acc);
                u32x2 o; o.x = pk2(acc[0], acc[1]); o.y = pk2(acc[2], acc[3]); *(u32x2*)(g + (16 * et + (lane & 15)) * 128 + 16 * w + 4 * (lane >> 4)) = o; }
        }
        LDS_BARRIER();
    }
}

#undef HP_LOAD
DEV void phase_hgrn_prefix(const Ctx& c) {
    const bf16* BNT = c.w<bf16>(HC_BNT); const float* Ag = c.w<float>(HC_A); bf16* SNT = c.w<bf16>(HC_SNT);
    constexpr int NV = BATCH * 8 * 2048;
    for (int v = blockIdx.x * 512 + c.tid; v < NV; v += gridDim.x * 512) {
        const int bh = v >> 11, x8 = (v & 2047) * 8, d0 = x8 & 127, e = x8 >> 7;
        float S[8];
#pragma unroll
        for (int j = 0; j < 8; ++j) S[j] = 0.f;
        const size_t base = (size_t)bh * NCH * 16384 + x8;
        constexpr int PFD = NCH < 8 ? NCH : 8;
        u32x4 bq[PFD]; f32x4 aq0[PFD], aq1[PFD];
#pragma unroll
        for (int j = 0; j < PFD; ++j) { bq[j] = *(const u32x4*)(BNT + base + (size_t)j * 16384); aq0[j] = *(const f32x4*)(Ag + ((size_t)bh * NCH + j) * 128 + d0); aq1[j] = *(const f32x4*)(Ag + ((size_t)bh * NCH + j) * 128 + d0 + 4); }
#pragma unroll
        for (int n = 0; n < NCH; ++n) {
            const u32x4 bv = bq[n % PFD]; const f32x4 a0 = aq0[n % PFD], a1 = aq1[n % PFD];
            if (n + PFD < NCH) { bq[n % PFD] = *(const u32x4*)(BNT + base + (size_t)(n + PFD) * 16384); aq0[n % PFD] = *(const f32x4*)(Ag + ((size_t)bh * NCH + n + PFD) * 128 + d0); aq1[n % PFD] = *(const f32x4*)(Ag + ((size_t)bh * NCH + n + PFD) * 128 + d0 + 4); }
            *(u32x4*)(SNT + base + (size_t)n * 16384) = pack8(S);
            S[0] = a0[0] * S[0] + __uint_as_float(bv.x << 16); S[1] = a0[1] * S[1] + __uint_as_float(bv.x & 0xffff0000u);
            S[2] = a0[2] * S[2] + __uint_as_float(bv.y << 16); S[3] = a0[3] * S[3] + __uint_as_float(bv.y & 0xffff0000u);
            S[4] = a1[0] * S[4] + __uint_as_float(bv.z << 16); S[5] = a1[1] * S[5] + __uint_as_float(bv.z & 0xffff0000u);
            S[6] = a1[2] * S[6] + __uint_as_float(bv.w << 16); S[7] = a1[3] * S[7] + __uint_as_float(bv.w & 0xffff0000u);
        }
        float* So = c.out + O_HGP + (size_t)bh * 16384;
#pragma unroll
        for (int j = 0; j < 8; ++j) So[(size_t)(d0 + j) * 128 + e] = S[j];
    }
}

DEV void phase_hgrn_out(const Ctx& c) {
    bf16* qg = (bf16*)c.lds;
    bf16* StT = qg + 64 * 136;
    float* ob = (float*)(StT + 128 * 136);
    const bf16* PC = c.w<bf16>(WS_P1); const float* ORAW = c.w<float>(WS_ORAW); bf16* OC = c.w<bf16>(WS_OCAT);
    const bf16* QG = c.w<bf16>(HC_QG); const bf16* SNT = c.w<bf16>(HC_SNT);
    const float* gn = c.in<float>(26);
    const int tid = c.tid, lane = c.lane, w = c.wave;
    const float gn0 = gn[lane], gn1 = gn[64 + lane];
    constexpr int NU = BATCH * 8 * NCH;
    u32x4 pq[2], ps[4]; float or0n[8], or1n[8]; bf16 zz0n[8], zz1n[8];
#define HO_LOAD(u_) do { const int u__ = (u_); const int bh_ = u__ / NCH, n_ = u__ % NCH, b_ = bh_ >> 3, h_ = bh_ & 7; const size_t m0_ = (size_t)b_ * SEQ + (size_t)n_ * 64; \
        _Pragma("unroll") for (int j = 0; j < 2; ++j) pq[j] = *(const u32x4*)(QG + (size_t)u__ * 8192 + 8 * (tid + 512 * j)); \
        _Pragma("unroll") for (int j = 0; j < 4; ++j) ps[j] = *(const u32x4*)(SNT + (size_t)u__ * 16384 + 8 * (tid + 512 * j)); \
        _Pragma("unroll") for (int i8 = 0; i8 < 8; ++i8) { const size_t m = m0_ + w * 8 + i8; or0n[i8] = ORAW[m * D + h_ * 128 + lane]; or1n[i8] = ORAW[m * D + h_ * 128 + 64 + lane]; \
            zz0n[i8] = PC[m * INC + 3072 + h_ * 128 + lane]; zz1n[i8] = PC[m * INC + 3072 + h_ * 128 + 64 + lane]; } } while (0)
    if ((int)blockIdx.x < NU) HO_LOAD(blockIdx.x);
    for (int u = blockIdx.x; u < NU; u += gridDim.x) {
        const int bh = u / NCH, n = u % NCH, b = bh >> 3, h = bh & 7; const size_t m0 = (size_t)b * SEQ + (size_t)n * 64;
        float or0[8], or1[8], zz0[8], zz1[8];
#pragma unroll
        for (int i8 = 0; i8 < 8; ++i8) { or0[i8] = or0n[i8]; or1[i8] = or1n[i8]; zz0[i8] = bf2f(zz0n[i8]); zz1[i8] = bf2f(zz1n[i8]); }
        LDS_BARRIER();
#pragma unroll
        for (int j = 0; j < 2; ++j) { const int idx = tid + 512 * j; *(u32x4*)(qg + (idx >> 4) * 136 + (idx & 15) * 8) = pq[j]; }
#pragma unroll
        for (int j = 0; j < 4; ++j) { const int idx = tid + 512 * j; *(u32x4*)(StT + (idx >> 4) * 136 + (idx & 15) * 8) = ps[j]; }
        if (u + (int)gridDim.x < NU) HO_LOAD(u + (int)gridDim.x);
        LDS_BARRIER();
        { const int it = w & 3; bf16x8 qa[4];
#pragma unroll
          for (int ks = 0; ks < 4; ++ks) qa[ks] = ld8(qg + (16 * it + (lane & 15)) * 136 + ks * 32 + 8 * (lane >> 4));
#pragma unroll
          for (int e4 = 0; e4 < 4; ++e4) { const int et = (w >> 2) * 4 + e4; f32x4 acc = (f32x4){0.f, 0.f, 0.f, 0.f};
#pragma unroll
            for (int ks = 0; ks < 4; ++ks) acc = mfma16(qa[ks], ld8(StT + (16 * et + (lane & 15)) * 136 + ks * 32 + 8 * (lane >> 4)), acc);
#pragma unroll
            for (int r = 0; r < 4; ++r) ob[(16 * it + (lane >> 4) * 4 + r) * 132 + 16 * et + (lane & 15)] = acc[r]; } }
        LDS_BARRIER();
        { float ss[8];
#pragma unroll
          for (int i8 = 0; i8 < 8; ++i8) { const int i = w * 8 + i8; or0[i8] += ob[i * 132 + lane]; or1[i8] += ob[i * 132 + 64 + lane]; ss[i8] = or0[i8] * or0[i8] + or1[i8] * or1[i8]; }
#pragma unroll
              for (int i8 = 0; i8 < 8; ++i8) ss[i8] = wave_sum(ss[i8]);
#pragma unroll
          for (int i8 = 0; i8 < 8; ++i8) { const size_t m = m0 + w * 8 + i8; const float r = rsqrtf(ss[i8] * (1.f / 128.f) + EPS);
            OC[m * D + h * 128 + lane] = (bf16)f2bf(or0[i8] * r * gn0 * siluf_(zz0[i8])); OC[m * D + h * 128 + 64 + lane] = (bf16)f2bf(or1[i8] * r * gn1 * siluf_(zz1[i8])); } }
    }
}


constexpr int NUG = BATCH * 4 * NCH;
constexpr size_t GC_W = WS_H, GC_UT = GC_W + (size_t)NUG * 64 * 128 * 2, GC_QG = GC_UT + (size_t)NUG * 128 * 64 * 4, GC_KGT = GC_QG + (size_t)NUG * 64 * 128 * 2,
    GC_AQK = GC_KGT + (size_t)NUG * 128 * 64 * 2, GC_GL = GC_AQK + (size_t)NUG * 64 * 64 * 2, GC_END = GC_GL + (size_t)NUG * 4;
static_assert(GC_END <= WS_H_END, "gdn scratch fits in H");

DEV void phase_gdn_prep(const Ctx& c) {
    bf16* qb = (bf16*)c.lds;
    bf16* kb = qb + 64 * 136;
    float* Lm = (float*)(kb + 64 * 136);
    float* part = Lm + 64 * 68;
    float* gl = part + 256; float* gcs = gl + 64; float* bet = gcs + 64; float* eg = bet + 64; float* egl = eg + 64; float* qn = egl + 64; float* kn = qn + 64;
    float* sqb = kn + 64;
    const bf16* P1 = c.w<bf16>(WS_P1);
    bf16* Wg = c.w<bf16>(GC_W); float* UTg = c.w<float>(GC_UT); bf16* QGg = c.w<bf16>(GC_QG); bf16* KGTg = c.w<bf16>(GC_KGT); bf16* AQKg = c.w<bf16>(GC_AQK); float* GLg = c.w<float>(GC_GL);
    const float* convw = c.in<float>(14);
    const int tid = c.tid, lane = c.lane, w = c.wave;
    const int role = tid >> 7, cc = tid & 127;
    for (int u = blockIdx.x; u < NUG; u += gridDim.x) {
        const int bh = u / NCH, n = u % NCH, b = bh >> 2, h = bh & 3;
        const size_t m0 = (size_t)b * SEQ + (size_t)n * 64;
        float x[64];
        if (role < 3) {
            const int col = role * 512 + h * 128 + cc;
            const float w0 = convw[col], w1 = convw[QKV_A + col], w2 = convw[2 * QKV_A + col], w3 = convw[3 * QKV_A + col];
            const bf16* src = P1 + m0 * LD1 + col;
            float p0 = 0.f, p1 = 0.f, p2 = 0.f;
            if (n > 0) { p0 = bf2f(src[-3 * (long)LD1]); p1 = bf2f(src[-2 * (long)LD1]); p2 = bf2f(src[-1 * (long)LD1]); }
#pragma unroll
            for (int j = 0; j < 64; ++j) x[j] = bf2f(src[(size_t)j * LD1]);
#pragma unroll
            for (int j = 0; j < 64; ++j) { const float cur = x[j]; const float y = w0 * p0 + w1 * p1 + w2 * p2 + w3 * cur; x[j] = siluf_(y); p0 = p1; p1 = p2; p2 = cur; }
            if (role < 2) {
#pragma unroll
                for (int j4 = 0; j4 < 16; ++j4) *(f32x4*)(sqb + tid * 68 + 4 * j4) = (f32x4){x[4 * j4] * x[4 * j4], x[4 * j4 + 1] * x[4 * j4 + 1], x[4 * j4 + 2] * x[4 * j4 + 2], x[4 * j4 + 3] * x[4 * j4 + 3]};
            }
        } else if (cc < 64) {
            const float Aexp = __expf(c.in<float>(15)[h]), dtb = c.in<float>(16)[h];
            bet[cc] = sigmoidf_(bf2f(P1[(m0 + cc) * LD1 + C_B + h]));
            gl[cc] = -Aexp * softplusf_(bf2f(P1[(m0 + cc) * LD1 + C_A + h]) + dtb);
        }
        __syncthreads();
        if (role == 3) {
            if (cc < 64) { float acc = 0.f, totl = 0.f;
                for (int i = 0; i < 64; ++i) { const float g = gl[i]; totl += g; if (i <= cc) acc += g; }
                gcs[cc] = acc; eg[cc] = __expf(acc); egl[cc] = __expf(totl - acc);
                if (cc == 0) GLg[u] = __expf(totl);
            } else { const int j = cc - 64; float sq = 0.f, sk = 0.f;
#pragma unroll 16
                for (int cx = 0; cx < 128; ++cx) { sq += sqb[cx * 68 + j]; sk += sqb[(128 + cx) * 68 + j]; }
                qn[j] = rsqrtf(sq + EPS); kn[j] = rsqrtf(sk + EPS); }
        }
        __syncthreads();
        if (role == 0) {
#pragma unroll
            for (int j = 0; j < 64; ++j) { const float qh = x[j] * qn[j]; qb[j * 136 + cc] = (bf16)f2bf(qh); QGg[((size_t)u * 64 + j) * 128 + cc] = (bf16)f2bf(qh * DK_SCALE * eg[j]); }
        } else if (role == 1) {
            bf16* g = KGTg + ((size_t)u * 128 + cc) * 64;
#pragma unroll
            for (int j8 = 0; j8 < 8; ++j8) { float t[8];
#pragma unroll
                for (int q = 0; q < 8; ++q) { const int j = 8 * j8 + q; const float kh = x[j] * kn[j]; kb[j * 136 + cc] = (bf16)f2bf(kh); t[q] = kh * egl[j]; x[j] = kh * bet[j] * eg[j]; }
                *(u32x4*)(g + 8 * j8) = pack8(t); }
        } else if (role == 2) {
#pragma unroll
            for (int j = 0; j < 64; ++j) x[j] *= bet[j];
        }
        __syncthreads();
        for (int ti = w; ti < 32; ti += 8) {
            const bool isq = ti >= 16; const int I = (ti & 15) >> 2, J = ti & 3;
            if (J > I) { if (isq) {
#pragma unroll
                    for (int r = 0; r < 4; ++r) AQKg[((size_t)u * 64 + 16 * I + (lane >> 4) * 4 + r) * 64 + 16 * J + (lane & 15)] = (bf16)0; }
                continue; }
            const bf16* Ab = isq ? qb : kb;
            f32x4 acc = (f32x4){0.f, 0.f, 0.f, 0.f};
#pragma unroll
            for (int ks = 0; ks < 4; ++ks) acc = mfma16(ld8(Ab + (16 * I + (lane & 15)) * 136 + ks * 32 + 8 * (lane >> 4)), ld8(kb + (16 * J + (lane & 15)) * 136 + ks * 32 + 8 * (lane >> 4)), acc);
#pragma unroll
            for (int r = 0; r < 4; ++r) { const int i = 16 * I + (lane >> 4) * 4 + r, j = 16 * J + (lane & 15);
                const float dcy = __expf(fminf(gcs[i] - gcs[j], 0.f));
                if (isq) AQKg[((size_t)u * 64 + i) * 64 + j] = (bf16)f2bf(i >= j ? acc[r] * DK_SCALE * dcy : 0.f);
                else Lm[i * 68 + j] = i > j ? bet[i] * acc[r] * dcy : 0.f; }
        }
        __syncthreads();
        if (role == 1 || role == 2) {
#pragma unroll
            for (int i = 1; i < 64; ++i) { float acc = x[i];
#pragma unroll
                for (int j = 0; j < i; ++j) acc -= Lm[i * 68 + j] * x[j];
                x[i] = acc; }
            if (role == 1) {
#pragma unroll
                for (int i = 0; i < 64; ++i) Wg[((size_t)u * 64 + i) * 128 + cc] = (bf16)f2bf(x[i]);
            } else { float* g = UTg + ((size_t)u * 128 + cc) * 64;
#pragma unroll
                for (int i4 = 0; i4 < 16; ++i4) *(f32x4*)(g + 4 * i4) = (f32x4){x[4 * i4], x[4 * i4 + 1], x[4 * i4 + 2], x[4 * i4 + 3]}; }
        }
        __syncthreads();
    }
}

DEV void phase_gdn_scan(const Ctx& c, int u_first, int u_stride) {
    bf16* wl = (bf16*)c.lds;
    bf16* qgl = wl + 64 * 136;
    bf16* kgT = qgl + 64 * 136;
    bf16* aqk = kgT + 128 * 72;
    bf16* StT = aqk + 64 * 72;
    bf16* vnT = StT + 128 * 136;
    float* ob = (float*)(vnT + 128 * 72);
    const bf16* P1 = c.w<bf16>(WS_P1); bf16* OCAT = c.w<bf16>(WS_OCAT);
    const bf16* Wg = c.w<bf16>(GC_W); const float* UTg = c.w<float>(GC_UT); const bf16* QGg = c.w<bf16>(GC_QG); const bf16* KGTg = c.w<bf16>(GC_KGT); const bf16* AQKg = c.w<bf16>(GC_AQK); const float* GLg = c.w<float>(GC_GL);
    const float* gn = c.in<float>(17);
    const int tid = c.tid, lane = c.lane, w = c.wave;
    constexpr int NU = BATCH * 4;
    for (int u = u_first; u < NU; u += u_stride) {
        const int b = u >> 2, h = u & 3; const size_t mb = (size_t)b * SEQ;
        f32x4 S[8];
#pragma unroll
        for (int et = 0; et < 8; ++et) S[et] = (f32x4){0.f, 0.f, 0.f, 0.f};
        __syncthreads();
        for (int i = tid; i < 128 * 136 / 8; i += 512) { u32x4 z; z.x = z.y = z.z = z.w = 0u; *(u32x4*)(StT + 8 * i) = z; }
        u32x4 pw[2], pq[2], pk[2], pa;
        const size_t cu0 = (size_t)u * NCH;
#define GD_LOAD(n_) do { const bf16* g0 = Wg + (cu0 + (n_)) * 64 * 128; const bf16* g1 = QGg + (cu0 + (n_)) * 64 * 128; const bf16* g2 = KGTg + (cu0 + (n_)) * 128 * 64; const bf16* g3 = AQKg + (cu0 + (n_)) * 64 * 64; \
            _Pragma("unroll") for (int j = 0; j < 2; ++j) { const int idx = tid + 512 * j; pw[j] = *(const u32x4*)(g0 + 8 * idx); pq[j] = *(const u32x4*)(g1 + 8 * idx); pk[j] = *(const u32x4*)(g2 + 8 * idx); } \
            pa = *(const u32x4*)(g3 + 8 * tid); } while (0)
#define GD_STORE_WQ() do { _Pragma("unroll") for (int j = 0; j < 2; ++j) { const int idx = tid + 512 * j; *(u32x4*)(wl + (idx >> 4) * 136 + (idx & 15) * 8) = pw[j]; *(u32x4*)(qgl + (idx >> 4) * 136 + (idx & 15) * 8) = pq[j]; } } while (0)
#define GD_STORE_KA() do { _Pragma("unroll") for (int j = 0; j < 2; ++j) { const int idx = tid + 512 * j; *(u32x4*)(kgT + (idx >> 3) * 72 + (idx & 7) * 8) = pk[j]; } \
            *(u32x4*)(aqk + (tid >> 3) * 72 + (tid & 7) * 8) = pa; } while (0)
        GD_LOAD(0); GD_STORE_WQ(); GD_STORE_KA();
        __syncthreads();
        const int it = w & 3;
        const float gn0 = gn[lane], gn1 = gn[64 + lane];
        f32x4 u4[4]; float dec, decn;
#define GD_LOADU(dst, dd, n_) do { _Pragma("unroll") for (int e4 = 0; e4 < 4; ++e4) { const int et = (w >> 2) * 4 + e4; dst[e4] = *(const f32x4*)(UTg + ((cu0 + (n_)) * 128 + 16 * et + (lane & 15)) * 64 + 16 * it + 4 * (lane >> 4)); } dd = GLg[cu0 + (n_)]; } while (0)
        GD_LOADU(u4, decn, 0);
        for (int n = 0; n < NCH; ++n) {
            dec = decn;
            if (n + 1 < NCH) GD_LOAD(n + 1);
            f32x4 ao[4], av[4];
#pragma unroll
            for (int e4 = 0; e4 < 4; ++e4) { ao[e4] = (f32x4){0.f, 0.f, 0.f, 0.f}; av[e4] = (f32x4){0.f, 0.f, 0.f, 0.f}; }
#pragma unroll
            for (int ks = 0; ks < 4; ++ks) {
                const bf16x8 wa = ld8(wl + (16 * it + (lane & 15)) * 136 + ks * 32 + 8 * (lane >> 4)), qa = ld8(qgl + (16 * it + (lane & 15)) * 136 + ks * 32 + 8 * (lane >> 4));
                bf16x8 bs[4];
#pragma unroll
                for (int e4 = 0; e4 < 4; ++e4) bs[e4] = ld8(StT + (16 * ((w >> 2) * 4 + e4) + (lane & 15)) * 136 + ks * 32 + 8 * (lane >> 4));
#pragma unroll
                for (int e4 = 0; e4 < 4; ++e4) { av[e4] = mfma16(wa, bs[e4], av[e4]); ao[e4] = mfma16(qa, bs[e4], ao[e4]); }
            }
#pragma unroll
            for (int e4 = 0; e4 < 4; ++e4) { const int et = (w >> 2) * 4 + e4; const f32x4 vn = u4[e4] - av[e4];
                u32x2 o; o.x = pk2(vn[0], vn[1]); o.y = pk2(vn[2], vn[3]); *(u32x2*)(vnT + (16 * et + (lane & 15)) * 72 + 16 * it + 4 * (lane >> 4)) = o; }
            if (n + 1 < NCH) GD_LOADU(u4, decn, n + 1);
            LDS_BARRIER();
            float zz0[8], zz1[8];
#pragma unroll
            for (int i8 = 0; i8 < 8; ++i8) { const size_t m = mb + (size_t)n * 64 + w * 8 + i8; zz0[i8] = bf2f(P1[m * LD1 + C_Z + h * 128 + lane]); zz1[i8] = bf2f(P1[m * LD1 + C_Z + h * 128 + 64 + lane]); }
#pragma unroll
            for (int et = 0; et < 8; ++et) S[et] = S[et] * dec;
#pragma unroll
            for (int ks = 0; ks < 2; ++ks) {
                const bf16x8 aa = ld8(aqk + (16 * it + (lane & 15)) * 72 + ks * 32 + 8 * (lane >> 4)), ka = ld8(kgT + (16 * w + (lane & 15)) * 72 + ks * 32 + 8 * (lane >> 4));
                bf16x8 vf[8];
#pragma unroll
                for (int et = 0; et < 8; ++et) vf[et] = ld8(vnT + (16 * et + (lane & 15)) * 72 + ks * 32 + 8 * (lane >> 4));
#pragma unroll
                for (int e4 = 0; e4 < 4; ++e4) ao[e4] = mfma16(aa, (w >> 2) ? vf[4 + e4] : vf[e4], ao[e4]);
#pragma unroll
                for (int et = 0; et < 8; ++et) S[et] = mfma16(ka, vf[et], S[et]);
            }
#pragma unroll
            for (int e4 = 0; e4 < 4; ++e4) { const int et = (w >> 2) * 4 + e4;
#pragma unroll
                for (int r = 0; r < 4; ++r) ob[(16 * it + (lane >> 4) * 4 + r) * 132 + 16 * et + (lane & 15)] = ao[e4][r]; }
#pragma unroll
            for (int et = 0; et < 8; ++et) { u32x2 o; o.x = pk2(S[et][0], S[et][1]); o.y = pk2(S[et][2], S[et][3]); *(u32x2*)(StT + (16 * et + (lane & 15)) * 136 + 16 * w + (lane >> 4) * 4) = o; }
            if (n + 1 < NCH) GD_STORE_WQ();
            LDS_BARRIER();
            { float ss[8], v0[8], v1[8];
#pragma unroll
              for (int i8 = 0; i8 < 8; ++i8) { const int i = w * 8 + i8; v0[i8] = ob[i * 132 + lane]; v1[i8] = ob[i * 132 + 64 + lane]; ss[i8] = v0[i8] * v0[i8] + v1[i8] * v1[i8]; }
#pragma unroll
              for (int i8 = 0; i8 < 8; ++i8) ss[i8] = wave_sum(ss[i8]);
#pragma unroll
              for (int i8 = 0; i8 < 8; ++i8) { const size_t m = mb + (size_t)n * 64 + w * 8 + i8; const float r = rsqrtf(ss[i8] * (1.f / 128.f) + EPS);
                OCAT[m * D + h * 128 + lane] = (bf16)f2bf(v0[i8] * r * gn0 * siluf_(zz0[i8])); OCAT[m * D + h * 128 + 64 + lane] = (bf16)f2bf(v1[i8] * r * gn1 * siluf_(zz1[i8])); } }
            if (n + 1 < NCH) GD_STORE_KA();
        }
#undef GD_LOAD
#undef GD_LOADU
#undef GD_STORE_WQ
#undef GD_STORE_KA
        int lane3 = lane; OPAQUE_V(lane3);
        float* So = c.out + O_GDNP + (size_t)(b * 4 + h) * 16384;
#pragma unroll
        for (int et = 0; et < 8; ++et)
#pragma unroll
            for (int r = 0; r < 4; ++r) So[(size_t)(16 * w + (lane3 >> 4) * 4 + r) * 128 + 16 * et + (lane3 & 15)] = S[et][r];
    }
}


template <int NT> DEV void softmax_rows(f32x4 (&s)[NT], float (&mrun)[4], float (&lrun)[4], float (&alpha)[4], bf16* Ps, int pitch, int lane) {
#pragma unroll
    for (int r = 0; r < 4; ++r) {
        float mx = s[0][r];
#pragma unroll
        for (int nt = 1; nt < NT; ++nt) mx = fmaxf(mx, s[nt][r]);
        mx = grp16_max(mx);
        const float mn = fmaxf(mrun[r], mx);
        alpha[r] = exp2f_(mrun[r] - mn); mrun[r] = mn;
        float sum = 0.f;
#pragma unroll
        for (int nt = 0; nt < NT; ++nt) { const float p = exp2f_(s[nt][r] - mn); s[nt][r] = p; sum += p; }
        sum = grp16_sum(sum); lrun[r] = lrun[r] * alpha[r] + sum;
    }
#pragma unroll
    for (int nt = 0; nt < NT; ++nt)
#pragma unroll
        for (int r = 0; r < 4; ++r) Ps[((lane >> 4) * 4 + r) * pitch + nt * 16 + (lane & 15)] = (bf16)f2bf(s[nt][r]);
}
DEV bf16x8 ldB_tr(const bf16* T, int pitch, int k0, int n0, int lane) {
    const bf16* p = T + (size_t)(k0 + 8 * (lane >> 4) + ((lane & 15) >> 2)) * pitch + n0 + 4 * (lane & 3);
    const s16x4 a = lds_tr(p), b = lds_tr(p + 4 * pitch);
    bf16x8 r; r[0] = a[0]; r[1] = a[1]; r[2] = a[2]; r[3] = a[3]; r[4] = b[0]; r[5] = b[1]; r[6] = b[2]; r[7] = b[3]; return r;
}
constexpr int AS_NSP = 2;
DEV void phase_attn_sample2(const Ctx& c) {
    bf16* Qs = (bf16*)c.lds;
    bf16* Kt0 = Qs + 64 * 296;
    bf16* Psb = Kt0 + 2 * 32 * 296;
    bf16* qtmp = Kt0;
    float* Xo = (float*)c.lds;
    float* Xm = Xo + 64 * 256; float* Xl = Xm + 64;
    const float* QH = c.w<float>(WS_QH); const float* rope = c.w<float>(WS_ROPE); const bf16* WUKB = c.w<bf16>(WS_WUKB);
    float* PO = c.w<float>(WS_PO); float* PM = c.w<float>(WS_PM); float* PL = c.w<float>(WS_PL);
    const float* clat = c.in<float>(4); const float* ckr = c.in<float>(5); const int* ptab = c.in<int>(7);
    const int tid = c.tid, lane = c.lane, w = c.wave, grp = w >> 2, wq = w & 3, gt = tid & 255;
    bf16* Kt = Kt0 + grp * 32 * 296; bf16* Ps = Psb + w * 16 * 40;
    constexpr int NPT32 = PAST / 32, TPS = NPT32 / AS_NSP;
    static_assert(NPT32 % (2 * AS_NSP) == 0, "tiles per split must be even");
    for (int u = blockIdx.x; u < DECB * AS_NSP; u += gridDim.x) {
        const int b = u / AS_NSP, sp = u % AS_NSP; const size_t mb = (size_t)MP + (size_t)b * DECS;
        __syncthreads();
        for (int idx = tid; idx < 64 * 8; idx += 512) { const int r = idx >> 3, ch = idx & 7, t = r >> 3, h = r & 7; const float* q = QH + (mb + t) * 768 + h * 96 + ch * 8;
            const f32x4 a = *(const f32x4*)q, bq = *(const f32x4*)(q + 4); u32x4 o; o.x = pk2(a[0], a[1]); o.y = pk2(a[2], a[3]); o.z = pk2(bq[0], bq[1]); o.w = pk2(bq[2], bq[3]); *(u32x4*)(qtmp + r * 72 + ch * 8) = o; }
        for (int idx = tid; idx < 64 * 16; idx += 512) { const int r = idx >> 4, f = idx & 15, t = r >> 3, h = r & 7; const float* qrow = QH + (mb + t) * 768 + h * 96 + 64;
            const float* rt = rope + (size_t)(SEQ + t) * 32; const float cs = rt[f], sn = rt[16 + f], x1 = qrow[f], x2 = qrow[16 + f];
            Qs[r * 296 + 256 + f] = (bf16)f2bf((x1 * cs - x2 * sn) * QK_SCALE2); Qs[r * 296 + 272 + f] = (bf16)f2bf((x2 * cs + x1 * sn) * QK_SCALE2); }
        __syncthreads();
        {
            const int h = w; bf16x8 af[2];
#pragma unroll
            for (int ks = 0; ks < 2; ++ks) af[ks] = ld8(qtmp + (((lane & 7)) * 8 + h) * 72 + ks * 32 + 8 * (lane >> 4));
#pragma unroll 4
            for (int nt = 0; nt < 16; ++nt) { f32x4 acc = (f32x4){0.f, 0.f, 0.f, 0.f};
#pragma unroll
                for (int ks = 0; ks < 2; ++ks) acc = mfma16(af[ks], ld8(WUKB + (size_t)(nt * 16 + (lane & 15)) * 512 + h * 64 + ks * 32 + 8 * (lane >> 4)), acc);
                if ((lane >> 4) < 2) {
#pragma unroll
                    for (int r = 0; r < 4; ++r) Qs[(((lane >> 4) * 4 + r) * 8 + h) * 296 + nt * 16 + (lane & 15)] = (bf16)f2bf(acc[r] * QK_SCALE2); } }
        }
        __syncthreads();
        float mrun[4], lrun[4], alpha[4]; f32x4 o[16];
#pragma unroll
        for (int r = 0; r < 4; ++r) { mrun[r] = -INFINITY; lrun[r] = 0.f; }
#pragma unroll
        for (int nt = 0; nt < 16; ++nt) o[nt] = (f32x4){0.f, 0.f, 0.f, 0.f};
        const int t_begin = sp * TPS, t_end = t_begin + TPS + (sp == AS_NSP - 1 ? 1 : 0);
        const int NI = (t_end - t_begin + 1) / 2;
        static_assert(NPAGES <= 64, "page table of one batch row is held one entry per lane");
        const int ptv = lane < NPAGES ? ptab[b * NPAGES + lane] : 0;
#ifdef HIPEMU
#define PT_LOOKUP(pg_) __shfl(ptv, (pg_))
#else
#define PT_LOOKUP(pg_) __builtin_amdgcn_readlane(ptv, (pg_))
#endif
        f32x4 plA[8], prA, plB[8], prB;
        const float* nl = c.out + O_LATS + (size_t)b * DECS * 256; const float* nk = c.out + O_KPES + (size_t)b * DECS * 32;
#define AS_LOAD(pl, pr, tile_) do { const int tl_ = (tile_); \
            if (tl_ < NPT32) { const int k0_ = tl_ * 32; const size_t rb_ = (size_t)PT_LOOKUP(k0_ >> 7) * PAGE + (k0_ & 127); \
                _Pragma("unroll") for (int j = 0; j < 8; ++j) { const int idx = gt + 256 * j; pl[j] = *(const f32x4*)(clat + (rb_ + (idx >> 6)) * 256 + 4 * (idx & 63)); } \
                pr = *(const f32x4*)(ckr + (rb_ + (gt >> 3)) * 32 + 4 * (gt & 7)); } \
            else if (tl_ == NPT32) { \
                _Pragma("unroll") for (int j = 0; j < 8; ++j) { const int idx = gt + 256 * j, key = idx >> 6; pl[j] = key < DECS ? *(const f32x4*)(nl + key * 256 + 4 * (idx & 63)) : (f32x4){0.f, 0.f, 0.f, 0.f}; } \
                pr = (gt >> 3) < DECS ? *(const f32x4*)(nk + (gt >> 3) * 32 + 4 * (gt & 7)) : (f32x4){0.f, 0.f, 0.f, 0.f}; } } while (0)
#define AS_ITER(pl, pr, it_) do { \
            const int tile = t_begin + 2 * (it_) + grp; const bool valid = tile < t_end; \
            if (valid) { \
                _Pragma("unroll") for (int j = 0; j < 8; ++j) { const int idx = gt + 256 * j; u32x2 pk; pk.x = pk2(pl[j][0], pl[j][1]); pk.y = pk2(pl[j][2], pl[j][3]); *(u32x2*)(Kt + (idx >> 6) * 296 + 4 * (idx & 63)) = pk; } \
                { u32x2 pk; pk.x = pk2(pr[0], pr[1]); pk.y = pk2(pr[2], pr[3]); *(u32x2*)(Kt + (gt >> 3) * 296 + 256 + 4 * (gt & 7)) = pk; } \
            } \
            { const int nt_ = tile + 4; AS_LOAD(pl, pr, nt_ < t_end ? nt_ : NPT32 + 1); } \
            LDS_BARRIER(); \
            if (valid) { \
                f32x4 s[2]; \
                _Pragma("unroll") for (int nt = 0; nt < 2; ++nt) { s[nt] = (f32x4){0.f, 0.f, 0.f, 0.f}; \
                    _Pragma("unroll") for (int ks = 0; ks < 9; ++ks) s[nt] = mfma16(ld8(Qs + (wq * 16 + (lane & 15)) * 296 + ks * 32 + 8 * (lane >> 4)), ld8(Kt + (nt * 16 + (lane & 15)) * 296 + ks * 32 + 8 * (lane >> 4)), s[nt]); } \
                if (tile == NPT32) { \
                    _Pragma("unroll") for (int nt = 0; nt < 2; ++nt) \
                        _Pragma("unroll") for (int r = 0; r < 4; ++r) { const int row = wq * 16 + (lane >> 4) * 4 + r, key = nt * 16 + (lane & 15); if (key >= DECS || key > (row >> 3)) s[nt][r] = -INFINITY; } \
                } \
                softmax_rows<2>(s, mrun, lrun, alpha, Ps, 40, lane); \
                WAVE_SYNC(); \
                const bf16x8 pf = ld8(Ps + (lane & 15) * 40 + 8 * (lane >> 4)); \
                if (wave_any((alpha[0] != 1.f) | (alpha[1] != 1.f) | (alpha[2] != 1.f) | (alpha[3] != 1.f))) { \
                    _Pragma("unroll") for (int nt = 0; nt < 16; ++nt) \
                        _Pragma("unroll") for (int r = 0; r < 4; ++r) o[nt][r] *= alpha[r]; } \
                _Pragma("unroll") for (int nt = 0; nt < 16; ++nt) o[nt] = mfma16(pf, ldB_tr(Kt, 296, 0, nt * 16, lane), o[nt]); \
            } \
            LDS_BARRIER(); } while (0)
        AS_LOAD(plA, prA, t_begin + grp < t_end ? t_begin + grp : NPT32 + 1);
        AS_LOAD(plB, prB, t_begin + 2 + grp < t_end ? t_begin + 2 + grp : NPT32 + 1);
#pragma unroll 1
        for (int it = 0; it < NI; it += 2) {
            AS_ITER(plA, prA, it);
            if (it + 1 < NI) AS_ITER(plB, prB, it + 1);
        }
#undef AS_ITER
#undef PT_LOOKUP
#undef AS_LOAD
        int lane2 = lane; OPAQUE_V(lane2);
        if (grp == 1) {
#pragma unroll
            for (int nt = 0; nt < 16; ++nt)
#pragma unroll
                for (int r = 0; r < 4; ++r) Xo[(wq * 16 + (lane2 >> 4) * 4 + r) * 256 + nt * 16 + (lane2 & 15)] = o[nt][r];
            if ((lane2 & 15) == 0) {
#pragma unroll
                for (int r = 0; r < 4; ++r) { Xm[wq * 16 + (lane2 >> 4) * 4 + r] = mrun[r]; Xl[wq * 16 + (lane2 >> 4) * 4 + r] = lrun[r]; } }
        }
        __syncthreads();
        if (grp == 0) {
            float a1[4], a2[4];
#pragma unroll
            for (int r = 0; r < 4; ++r) { const int row = wq * 16 + (lane2 >> 4) * 4 + r; const float m2 = Xm[row], l2 = Xl[row]; const float mm = fmaxf(mrun[r], m2);
                a1[r] = exp2f_(mrun[r] - mm); a2[r] = exp2f_(m2 - mm); lrun[r] = lrun[r] * a1[r] + l2 * a2[r]; mrun[r] = mm;
                if ((lane2 & 15) == 0) { PM[(size_t)u * 64 + row] = mm; PL[(size_t)u * 64 + row] = lrun[r]; } }
#pragma unroll
            for (int nt = 0; nt < 16; ++nt)
#pragma unroll
                for (int r = 0; r < 4; ++r) { const int row = wq * 16 + (lane2 >> 4) * 4 + r, col = nt * 16 + (lane2 & 15); PO[((size_t)u * 64 + row) * 256 + col] = o[nt][r] * a1[r] + Xo[row * 256 + col] * a2[r]; }
        }
    }
}
DEV void phase_attn_sample_combine(const Ctx& c) {
    bf16* Ol = (bf16*)c.lds;
    const float* PO = c.w<float>(WS_PO); const float* PM = c.w<float>(WS_PM); const float* PL = c.w<float>(WS_PL);
    const bf16* WUV = c.w<bf16>(WS_WUKV) + (size_t)512 * 256; bf16* OCAT = c.w<bf16>(WS_OCAT);
    const int tid = c.tid, lane = c.lane, w = c.wave;
    for (int b = (int)gridDim.x - 1 - (int)blockIdx.x; b < DECB; b += gridDim.x) {
        const size_t mb = (size_t)MP + (size_t)b * DECS;
        __syncthreads();
        for (int idx = tid; idx < 64 * 64; idx += 512) { const int row = idx >> 6, c4 = idx & 63;
            float mm = -INFINITY;
#pragma unroll
            for (int s = 0; s < AS_NSP; ++s) mm = fmaxf(mm, PM[((size_t)b * AS_NSP + s) * 64 + row]);
            float lt = 0.f; f32x4 acc = (f32x4){0.f, 0.f, 0.f, 0.f};
#pragma unroll
            for (int s = 0; s < AS_NSP; ++s) { const size_t ur = ((size_t)b * AS_NSP + s) * 64 + row; const float a = exp2f_(PM[ur] - mm); lt += PL[ur] * a; acc += *(const f32x4*)(PO + ur * 256 + 4 * c4) * a; }
            const float inv = 1.f / lt; u32x2 o; o.x = pk2(acc[0] * inv, acc[1] * inv); o.y = pk2(acc[2] * inv, acc[3] * inv); *(u32x2*)(Ol + row * 264 + 4 * c4) = o; }
        __syncthreads();
        { const int h = w;
#pragma unroll
          for (int nt = 0; nt < 4; ++nt) { f32x4 acc = (f32x4){0.f, 0.f, 0.f, 0.f};
#pragma unroll
            for (int ks = 0; ks < 8; ++ks) acc = mfma16(ld8(Ol + ((lane & 7) * 8 + h) * 264 + ks * 32 + 8 * (lane >> 4)), ld8(WUV + (size_t)(h * 64 + nt * 16 + (lane & 15)) * 256 + ks * 32 + 8 * (lane >> 4)), acc);
            if ((lane >> 4) < 2) {
#pragma unroll
                for (int r = 0; r < 4; ++r) OCAT[(mb + (lane >> 4) * 4 + r) * D + 512 + h * 64 + nt * 16 + (lane & 15)] = (bf16)f2bf(acc[r]); } } }
    }
}

DEV bf16x8 cvt8(const f32x4 a, const f32x4 b, float sc) { bf16x8 r; const u32x4 p = {pk2(a[0] * sc, a[1] * sc), pk2(a[2] * sc, a[3] * sc), pk2(b[0] * sc, b[1] * sc), pk2(b[2] * sc, b[3] * sc)};
    r = __builtin_bit_cast(bf16x8, p); return r; }
DEV void phase_attn_prompt2(const Ctx& c, int qid = 0) {
    bf16* KV0 = (bf16*)c.lds;
    constexpr int KVB = 64 * 104 + 64 * 72;
    bf16* Psb = KV0 + 2 * KVB;
    const float* QH = c.w<float>(WS_QH); const bf16* KVP = c.w<bf16>(WS_KVP); const bf16* KPEB = c.w<bf16>(WS_KPEB); const float* rope = c.w<float>(WS_ROPE); bf16* OCAT = c.w<bf16>(WS_OCAT);
    const int tid = c.tid, lane = c.lane, w = c.wave;
    bf16* Ps = Psb + w * 32 * 72;
    constexpr int NQB = SEQ / 256, NPU = NQB * BATCH * 8;
    for (;;) {
        const int pu = queue_next(c, qid);
        if (pu >= NPU) break;
        const int qb = NQB - 1 - pu / (BATCH * 8), bh = pu % (BATCH * 8), b = bh >> 3, h = bh & 7; const size_t mb = (size_t)b * SEQ;
        {
            const int q0 = qb * 256, rmin = q0 + 32 * w;
            bf16x8 qf[2][3];
#pragma unroll
            for (int mt = 0; mt < 2; ++mt) { const int qr = rmin + 16 * mt + (lane & 15); const float* qrow = QH + (mb + qr) * 768 + h * 96; const int g = lane >> 4;
#pragma unroll
                for (int ks = 0; ks < 2; ++ks) qf[mt][ks] = cvt8(*(const f32x4*)(qrow + ks * 32 + 8 * g), *(const f32x4*)(qrow + ks * 32 + 8 * g + 4), QK_SCALE2);
                const int f0 = 8 * (g & 1); const float* rt = rope + (size_t)qr * 32;
                const f32x4 x1a = *(const f32x4*)(qrow + 64 + f0), x1b = *(const f32x4*)(qrow + 64 + f0 + 4), x2a = *(const f32x4*)(qrow + 80 + f0), x2b = *(const f32x4*)(qrow + 80 + f0 + 4);
                const f32x4 ca = *(const f32x4*)(rt + f0), cb = *(const f32x4*)(rt + f0 + 4), sa = *(const f32x4*)(rt + 16 + f0), sb = *(const f32x4*)(rt + 16 + f0 + 4);
                const f32x4 ya = g < 2 ? x1a * ca - x2a * sa : x2a * ca + x1a * sa, yb = g < 2 ? x1b * cb - x2b * sb : x2b * cb + x1b * sb;
                qf[mt][2] = cvt8(ya, yb, QK_SCALE2); }
            float mrun[2][4], lrun[2][4], alpha[2][4]; f32x4 o[2][4];
#pragma unroll
            for (int mt = 0; mt < 2; ++mt) {
#pragma unroll
                for (int r = 0; r < 4; ++r) { mrun[mt][r] = -INFINITY; lrun[mt][r] = 0.f; }
#pragma unroll
                for (int nt = 0; nt < 4; ++nt) o[mt][nt] = (f32x4){0.f, 0.f, 0.f, 0.f}; }
            const int nkt = 4 * qb + 4;
            u32x4 pk_, pp_, pv_;
#define AP_LOAD(kt_) do { const size_t kr_ = mb + (size_t)(kt_) * 64; \
                pk_ = *(const u32x4*)(KVP + (kr_ + (tid >> 3)) * 1024 + h * 64 + (tid & 7) * 8); \
                pv_ = *(const u32x4*)(KVP + (kr_ + (tid >> 3)) * 1024 + 512 + h * 64 + (tid & 7) * 8); \
                if (tid < 256) pp_ = *(const u32x4*)(KPEB + (kr_ + (tid >> 2)) * 32 + (tid & 3) * 8); } while (0)
#define AP_STORE(buf_) do { bf16* Kb_ = KV0 + (buf_) * KVB; bf16* Vb_ = Kb_ + 64 * 104; \
                *(u32x4*)(Kb_ + (tid >> 3) * 104 + (tid & 7) * 8) = pk_; *(u32x4*)(Vb_ + (tid >> 3) * 72 + (tid & 7) * 8) = pv_; \
                if (tid < 256) *(u32x4*)(Kb_ + (tid >> 2) * 104 + 64 + (tid & 3) * 8) = pp_; } while (0)
            __syncthreads();
            AP_LOAD(0); AP_STORE(0);
            if (nkt > 1) AP_LOAD(1);
            __syncthreads();
            for (int kt = 0; kt < nkt; ++kt) {
                const bf16* Ks = KV0 + (kt & 1) * KVB; const bf16* Vs = Ks + 64 * 104;
                if (kt + 1 < nkt) AP_STORE((kt + 1) & 1);
                if (kt + 2 < nkt) AP_LOAD(kt + 2);
                const int k0 = kt * 64;
                if (k0 <= rmin + 31) {
                    f32x4 s[2][4];
#pragma unroll
                    for (int nt = 0; nt < 4; ++nt) { s[0][nt] = (f32x4){0.f, 0.f, 0.f, 0.f}; s[1][nt] = (f32x4){0.f, 0.f, 0.f, 0.f};
#pragma unroll
                        for (int ks = 0; ks < 3; ++ks) { const bf16x8 kf = ld8(Ks + (nt * 16 + (lane & 15)) * 104 + ks * 32 + 8 * (lane >> 4));
                            s[0][nt] = mfma16(qf[0][ks], kf, s[0][nt]); s[1][nt] = mfma16(qf[1][ks], kf, s[1][nt]); } }
                    if (k0 + 63 > rmin) {
#pragma unroll
                        for (int mt = 0; mt < 2; ++mt)
#pragma unroll
                            for (int nt = 0; nt < 4; ++nt)
#pragma unroll
                                for (int r = 0; r < 4; ++r) { const int qpos = rmin + 16 * mt + (lane >> 4) * 4 + r, kpos = k0 + nt * 16 + (lane & 15); if (kpos > qpos) s[mt][nt][r] = -INFINITY; }
                    }
                    softmax_rows<4>(s[0], mrun[0], lrun[0], alpha[0], Ps, 72, lane);
                    softmax_rows<4>(s[1], mrun[1], lrun[1], alpha[1], Ps + 16 * 72, 72, lane);
                    WAVE_SYNC();
                    if (wave_any((alpha[0][0] != 1.f) | (alpha[0][1] != 1.f) | (alpha[0][2] != 1.f) | (alpha[0][3] != 1.f) | (alpha[1][0] != 1.f) | (alpha[1][1] != 1.f) | (alpha[1][2] != 1.f) | (alpha[1][3] != 1.f))) {
#pragma unroll
                    for (int mt = 0; mt < 2; ++mt)
#pragma unroll
                        for (int nt = 0; nt < 4; ++nt)
#pragma unroll
                            for (int r = 0; r < 4; ++r) o[mt][nt][r] *= alpha[mt][r]; }
#pragma unroll
                    for (int k2 = 0; k2 < 2; ++k2) { const bf16x8 p0 = ld8(Ps + (lane & 15) * 72 + k2 * 32 + 8 * (lane >> 4)), p1 = ld8(Ps + (16 + (lane & 15)) * 72 + k2 * 32 + 8 * (lane >> 4));
#pragma unroll
                        for (int nt = 0; nt < 4; ++nt) { const bf16x8 vf = ldB_tr(Vs, 72, k2 * 32, nt * 16, lane); o[0][nt] = mfma16(p0, vf, o[0][nt]); o[1][nt] = mfma16(p1, vf, o[1][nt]); } }
                    WAVE_SYNC();
                }
                LDS_BARRIER();
            }
#undef AP_LOAD
#undef AP_STORE
#pragma unroll
            for (int mt = 0; mt < 2; ++mt)
#pragma unroll
                for (int nt = 0; nt < 4; ++nt)
#pragma unroll
                    for (int r = 0; r < 4; ++r) OCAT[(mb + rmin + 16 * mt + (lane >> 4) * 4 + r) * D + 512 + h * 64 + nt * 16 + (lane & 15)] = (bf16)f2bf(o[mt][nt][r] / lrun[mt][r]);
        }
    }
}

#ifndef HIPEMU
#define XB_TMO      128
#define XB_XCNT(j)  (256  + 64 * (j))
#define XB_XSUB(j)  (1280 + 64 * (j))
#define XB_XGEN(j)  (2304 + 64 * (j))
#define XB_TOP      3328
#define XB_TOPGEN   3392
#define XCD_BAR_WORDS 3456
#define XB_SPIN_CAP (1u << 22)
#define LAS __attribute__((address_space(3)))
__device__ __forceinline__ unsigned xb_ld(unsigned* p)              { return __hip_atomic_load(p, __ATOMIC_RELAXED, __HIP_MEMORY_SCOPE_AGENT); }
__device__ __forceinline__ unsigned xb_add(unsigned* p, unsigned v) { return __hip_atomic_fetch_add(p, v, __ATOMIC_RELAXED, __HIP_MEMORY_SCOPE_AGENT); }
__device__ __forceinline__ unsigned xb_xcc_id() { return (unsigned)__builtin_amdgcn_s_getreg((3 << 11) | 20) & 0xFu; }
#define XB_SPIN(cond, bar) do { unsigned _sp = 0; while (cond) { __builtin_amdgcn_s_sleep(1); \
    if ((++_sp & 255u) == 0u) { if (xb_ld(&(bar)[XB_TMO])) break; if (_sp > XB_SPIN_CAP) { atomicAdd(&(bar)[XB_TMO], 1u); break; } } } } while (0)
struct XcdBarrier { unsigned* bar; unsigned x; volatile LAS unsigned* st; bool t0; };
__device__ __forceinline__ XcdBarrier xcd_barrier_post(unsigned* bar, volatile LAS unsigned* st, bool t0) {
    XcdBarrier b; b.bar = bar; b.x = xb_xcc_id(); b.st = st; b.t0 = t0;
    if (t0) (void)xb_add(&bar[XB_XCNT(b.x)], 1u);
    return b;
}
__device__ __forceinline__ void xcd_barrier_complete(unsigned* bar, unsigned x, unsigned& nloc, unsigned& nx) {
    const unsigned G = gridDim.x * gridDim.y * gridDim.z;
    unsigned sum, cnt, mine, sp = 0u;
    for (;;) {
        sum = 0u; cnt = 0u; mine = 0u;
#pragma unroll
        for (unsigned j = 0; j < 16; ++j) { const unsigned c = xb_ld(&bar[XB_XCNT(j)]); sum += c; cnt += (c > 0u) ? 1u : 0u; mine = (j == x) ? c : mine; }
        if (sum == G) break;
        __builtin_amdgcn_s_sleep(1);
        if ((++sp & 255u) == 0u) { if (xb_ld(&bar[XB_TMO])) break; if (sp > XB_SPIN_CAP) { atomicAdd(&bar[XB_TMO], 1u); break; } }
    }
    nloc = mine > 0u ? mine : 1u; nx = cnt > 0u ? cnt : 1u;
}
__device__ __forceinline__ void xcd_barrier(const XcdBarrier& b) {
    asm volatile("s_waitcnt vmcnt(0)" ::: "memory");
    __syncthreads();
    if (b.t0) {
        unsigned* bar = b.bar;
        __builtin_amdgcn_s_waitcnt(0);
        unsigned nloc = b.st[0], nx = b.st[1];
        if (nloc == 0u) { xcd_barrier_complete(bar, b.x, nloc, nx); b.st[0] = nloc; b.st[1] = nx; }
        const unsigned old = xb_add(&bar[XB_XSUB(b.x)], 1u);
        const unsigned gen = old / nloc;
        if (old + 1u == (gen + 1u) * nloc) {
            __builtin_amdgcn_fence(__ATOMIC_RELEASE, "agent");
            asm volatile("s_waitcnt vmcnt(0)" ::: "memory");
            const unsigned og = xb_add(&bar[XB_TOP], 1u);
            const unsigned tg = og / nx;
            if (og + 1u == (tg + 1u) * nx) xb_add(&bar[XB_TOPGEN], 1u);
            else XB_SPIN(xb_ld(&bar[XB_TOPGEN]) == tg, bar);
            __builtin_amdgcn_fence(__ATOMIC_ACQUIRE, "agent");
            xb_add(&bar[XB_XGEN(b.x)], 1u);
            asm volatile("s_waitcnt vmcnt(0)" ::: "memory");
        } else {
            XB_SPIN(xb_ld(&bar[XB_XGEN(b.x)]) == gen, bar);
            __builtin_amdgcn_fence(__ATOMIC_ACQUIRE, "agent");
            asm volatile("s_waitcnt vmcnt(0)" ::: "memory");
        }
    }
    __syncthreads();
}
#endif

__global__ void __launch_bounds__(512, 2) mega_kernel(Params p) {
#ifdef HIPEMU
    unsigned char* lds = g_blk->smem;
#else
    extern __shared__ __attribute__((aligned(16))) unsigned char lds[];
#endif
    const int lo = p.ph_lo, hi = p.ph_hi;
#ifdef HIPEMU
    const int wave_s = threadIdx.x >> 6;
#define FRESH_LANE() ((int)(threadIdx.x & 63))
#define GRID_BAR(k) do { } while (0)
#else
    const int wave_s = __builtin_amdgcn_readfirstlane(threadIdx.x >> 6);
#define FRESH_LANE() ({ int l_; asm volatile("v_mbcnt_lo_u32_b32 %0, -1, 0\n\tv_mbcnt_hi_u32_b32 %0, -1, %0" : "=v"(l_)); l_; })
    { const int l0 = FRESH_LANE(); if (wave_s == 0) ((volatile LAS unsigned*)(lds + LDS_MISC))[l0] = 0u; }
    __syncthreads();
    if (hi - lo > 1) (void)xcd_barrier_post((unsigned*)(p.ws + WS_CTL), (volatile LAS unsigned*)(lds + LDS_MISC), wave_s == 0 && FRESH_LANE() == 0);
#define GRID_BAR(k) do { if (lo <= (k) && (k) + 1 < hi) { XcdBarrier bb_; bb_.bar = (unsigned*)(p.ws + WS_CTL); bb_.x = xb_xcc_id(); bb_.st = (volatile LAS unsigned*)(lds + LDS_MISC); bb_.t0 = (wave_s == 0 && FRESH_LANE() == 0); xcd_barrier(bb_); } } while (0)
#endif
#define MKCTX() Ctx c; c.p = &p; c.lds = lds; c.ws = p.ws; c.out = p.out; c.wave = wave_s; c.lane = FRESH_LANE(); c.tid = wave_s * 64 + c.lane; c.gw = blockIdx.x * 8 + wave_s; c.ngw = gridDim.x * 8;
#define IN(k) (lo <= (k) && (k) < hi)
#ifndef PROBE_MASK
#define PROBE_MASK 0u
#endif
#define NREP(k) (((PROBE_MASK >> (k)) & 1u) ? 2 : 1)
#ifndef PROBE_SUB
#define PROBE_SUB 0
#endif
#define SUB(id, ...) { MKCTX() __VA_ARGS__ } if (PROBE_SUB == (id)) { __syncthreads(); MKCTX() __VA_ARGS__ }
#define PHASE(k, ...) if (IN(k)) { { const int rep_ = 0; (void)rep_; MKCTX() __VA_ARGS__ } if (NREP(k) == 2) { const int rep_ = 1; (void)rep_; MKCTX() __VA_ARGS__ } }
#define X1 c.w<float>(WS_X1)
#define X2 c.w<float>(WS_X2)
#define P1 c.w<float>(WS_P1)
#define XN c.w<bf16>(WS_XN)
#define Hb c.w<bf16>(WS_H)
#define OCAT c.w<bf16>(WS_OCAT)

    PHASE(0,  phase_prologue(c); GRID_BAR(0); )
    PHASE(1,  run_gemm(c, XN, c.w<bf16>(WS_WINAB), M, LD1, D, EpiBf16<0>{c.w<bf16>(WS_P1), LD1}); GRID_BAR(1); )
    PHASE(2,  phase_prep0(c); GRID_BAR(2); )
    PHASE(3,          { run_gemm(c, c.w<bf16>(WS_CQN), c.w<bf16>(WS_WUQ), M, 768, 256, EpiStoreF32{c.w<float>(WS_QH), 768}); } { MKCTX() run_gemm(c, c.w<bf16>(WS_LATN), c.w<bf16>(WS_WUKV), MP, 1024, 256, EpiBf16<0>{c.w<bf16>(WS_KVP), 1024}); }         GRID_BAR(3); )
    PHASE(4,  { if ((blockIdx.x & 1) == 0) { MKCTX() phase_attn_sample2(c); } } __syncthreads(); { MKCTX() phase_gdn_prep(c); } __syncthreads();
               { if ((blockIdx.x & 1) != 0) { MKCTX() phase_attn_sample2(c); } } GRID_BAR(4); )
    PHASE(5,  SUB(4, phase_gdn_scan(c, blockIdx.x, gridDim.x);) __syncthreads(); SUB(5, phase_attn_sample_combine(c);) __syncthreads(); { MKCTX() phase_attn_prompt2(c, rep_ ? 6 : 0); } if (PROBE_SUB == 6) { __syncthreads(); MKCTX() phase_attn_prompt2(c, 5); } __syncthreads();
               SUB(9, const int NS_ = BATCH * 4; const int G_ = (int)gridDim.x; if (G_ > NS_ + 32) { if ((int)blockIdx.x >= NS_) { phase_gdn_naive(c, BATCH * 4, (int)blockIdx.x - NS_, G_ - NS_); } } else { phase_gdn_naive(c, BATCH * 4, (int)blockIdx.x, G_); }) __syncthreads();
               SUB(10, const int NS_ = BATCH * 4; const int G_ = (int)gridDim.x; if (G_ > NS_ + 32) { if ((int)blockIdx.x >= NS_) { phase_convert_late(c, c.gw - NS_ * 8, c.ngw - NS_ * 8); } } else { phase_convert_late(c, c.gw, c.ngw); }) GRID_BAR(5); )
    PHASE(6,  { run_gemm(c, OCAT, c.w<bf16>(WS_WOAB), MP, D, D, EpiResidF32{nullptr, c.in<float>(0), c.in<float>(1), X1}); } { MKCTX() run_gemm_sample_splitk(c, OCAT, c.w<bf16>(WS_WOAB), D, 256); } GRID_BAR(6); )
    PHASE(7,  phase_rmsnorm(c, X1, c.in<float>(9), nullptr, 4); GRID_BAR(7); )
    PHASE(8,  { run_gemm(c, XN, c.w<bf16>(WS_WUP0), M, FF, D, EpiBf16<1>{Hb, FF}); } __syncthreads();
               { MKCTX() const int NB_ = (M / 256 * (FF / 256)) % (int)gridDim.x, G_ = (int)gridDim.x;
                 if (NB_ > 0 && G_ - NB_ >= 32) { if ((int)blockIdx.x >= NB_) phase_convert_late2(c, c.gw - NB_ * 8, c.ngw - NB_ * 8); } else phase_convert_late2(c, c.gw, c.ngw); } GRID_BAR(8); )
    PHASE(9,  { run_gemm(c, Hb, c.w<bf16>(WS_WDN0), MP, D, FF, EpiResidF32{X1, nullptr, nullptr, X2}); } { MKCTX() run_gemm_sample_splitk(c, Hb, c.w<bf16>(WS_WDN0), FF, 256); } GRID_BAR(9); )
    PHASE(10,  phase_rmsnorm(c, X2, c.in<float>(8) + D, X1, 16); GRID_BAR(10); )
    PHASE(11,  run_gemm(c, XN, c.w<bf16>(WS_WINC), M, INC, D, EpiBf16<0>{c.w<bf16>(WS_P1), INC}); GRID_BAR(11); )
    PHASE(12,  SUB(7, phase_hgrn_prep(c);) GRID_BAR(12); )
    PHASE(13,  phase_hgrn_prefix(c); __syncthreads(); SUB(8, phase_hgrn_naive(c, BATCH * 8, (int)blockIdx.x, (int)gridDim.x);) GRID_BAR(13); )
    PHASE(14,  phase_hgrn_out(c); GRID_BAR(14); )
    PHASE(15,  { run_gemm(c, OCAT, c.w<bf16>(WS_WOC), MP, D, D, EpiResidF32{X2, nullptr, nullptr, X1}); } { MKCTX() run_gemm_sample_splitk(c, OCAT, c.w<bf16>(WS_WOC), D, 256); } GRID_BAR(15); )
    PHASE(16,  phase_rmsnorm(c, X1, c.in<float>(9) + D, X2, 4); GRID_BAR(16); )
    PHASE(17,  run_gemm(c, XN, c.w<bf16>(WS_WUP1), M, FF, D, EpiBf16<1>{Hb, FF}); GRID_BAR(17); )
    PHASE(18,  { run_gemm(c, Hb, c.w<bf16>(WS_WDN1), MP, D, FF, EpiResidF32{X1, nullptr, nullptr, X2}); } { MKCTX() run_gemm_sample_splitk(c, Hb, c.w<bf16>(WS_WDN1), FF, 256); } GRID_BAR(18); )
    PHASE(19,  phase_final(c, X2, c.in<float>(10), X1, 16); )
#undef IN
#undef X1
#undef X2
#undef P1
#undef XN
#undef Hb
#undef OCAT
}

#ifndef HIPEMU
extern "C" void kernel_launch(void* const* d_in, const int* in_sizes, int n_in, void* d_out, int out_size, void* d_ws, size_t ws_size, hipStream_t stream) {
    static int grid = 0;
    if (grid == 0) {
        if (n_in != 28 || (size_t)out_size != O_END || ws_size < WS_END) { fprintf(stderr, "kernel_launch: shape mismatch n_in %d out %d (want %zu) ws %zu (want %zu)\n", n_in, out_size, (size_t)O_END, ws_size, (size_t)WS_END); grid = -1; return; }
        int dev = 0, cus = 0, per_cu = 0;
        hipGetDevice(&dev); hipDeviceGetAttribute(&cus, hipDeviceAttributeMultiprocessorCount, dev);
        if (hipFuncSetAttribute((const void*)mega_kernel, hipFuncAttributeMaxDynamicSharedMemorySize, LDS_BYTES) != hipSuccess) { fprintf(stderr, "kernel_launch: hipFuncSetAttribute failed\n"); grid = -1; return; }
        if (hipOccupancyMaxActiveBlocksPerMultiprocessor(&per_cu, (const void*)mega_kernel, 512, LDS_BYTES) != hipSuccess || per_cu < 1) fprintf(stderr, "kernel_launch: occupancy query reports %d\n", per_cu);
        (void)hipGetLastError();
        grid = cus;
    }
    if (grid < 0) return;
    hipMemsetAsync((char*)d_ws + WS_CTL, 0, CTL_BYTES, stream);
    Params p{};
    for (int i = 0; i < 28; ++i) p.in[i] = d_in[i];
    p.out = (float*)d_out; p.ws = (unsigned char*)d_ws;
#if MK_N_LAUNCHES == 1
    p.ph_lo = 0; p.ph_hi = NPHASE;
    hipLaunchKernelGGL(mega_kernel, dim3(grid), dim3(512), LDS_BYTES, stream, p);
#else
    for (int k = 0; k < NPHASE; ++k) { p.ph_lo = k; p.ph_hi = k + 1; hipLaunchKernelGGL(mega_kernel, dim3(grid), dim3(512), LDS_BYTES, stream, p); }
#endif
}
#else
size_t emu_ws_bytes() { return WS_END; }
size_t emu_out_floats() { return O_END; }
void emu_forward(void* const* d_in, float* d_out, unsigned char* d_ws, int grid, int ph_from, int ph_to) {
    memset(d_ws + WS_CTL, 0, CTL_BYTES);
    Params p{};
    for (int i = 0; i < 28; ++i) p.in[i] = d_in[i];
    p.out = d_out; p.ws = d_ws;
    for (int k = ph_from; k < ph_to && k < NPHASE; ++k) { p.ph_lo = k; p.ph_hi = k + 1; fprintf(stderr, "[emu] phase %d\n", k); emu_launch(grid, 512, LDS_BYTES, [=]() { mega_kernel(p); }); }
}
struct EmuBuf { const char* name; size_t off; size_t bytes; int kind;   int ld; };
extern const EmuBuf emu_bufs[] = {
    {"P1", WS_P1, (size_t)M * 4096 * 4, 0, LD1}, {"XN", WS_XN, (size_t)M * D * 2, 1, D}, {"QH", WS_QH, (size_t)M * 768 * 4, 0, 768}, {"KVP", WS_KVP, (size_t)MP * 1024 * 2, 1, 1024},
    {"OCAT", WS_OCAT, (size_t)M * D * 2, 1, D}, {"ORAW", WS_ORAW, (size_t)M * D * 4, 0, D}, {"X1", WS_X1, (size_t)M * D * 4, 0, D}, {"X2", WS_X2, (size_t)M * D * 4, 0, D},
    {"H", WS_H, (size_t)M * FF * 2, 1, FF}, {"CQN", WS_CQN, (size_t)M * 256 * 2, 1, 256}, {"LATN", WS_LATN, (size_t)M * 256 * 2, 1, 256}, {nullptr, 0, 0, 0, 0}};
extern const int emu_cfg[8] = {BATCH, SEQ, DECB, PAST, MP, MS, MT, M};
#endif
```

```cpp
#ifdef HIPEMU
#include "hipemu.h"
#else
#include <hip/hip_runtime.h>
#endif
#include <cstdio>
#include <cstdint>

#ifndef CFG_BATCH
#define CFG_BATCH 8
#define CFG_SEQ 2048
#define CFG_DEC_BATCH 128
#define CFG_PAST_LEN 8192
#endif
#ifndef MK_N_LAUNCHES
#define MK_N_LAUNCHES 1
#endif

#define DEV __device__ __forceinline__
namespace pg8 {
#define PG8_LAS __attribute__((address_space(3)))
typedef unsigned short bf16_t;
typedef short bf16x8 __attribute__((ext_vector_type(8)));
typedef float f32x4 __attribute__((ext_vector_type(4)));
typedef unsigned u32x4 __attribute__((ext_vector_type(4)));
constexpr int BM = 256, BK = 64, HALF = 128, HTB = HALF * BK * 2  , STAGE_BYTES = 8 * HTB, NXCD = 8, WGM = 8;

__host__ __device__ __forceinline__ int lds_byte(int r, int c) { const int st = (r >> 4) * 2 + (c >> 5), rr = r & 15, cc = c & 31, ob = rr * 64 + cc * 2; return st * 1024 + (ob ^ (((ob >> 9) & 1) << 5)); }
__host__ __device__ __forceinline__ void stage_rc(int b, int& R, int& C) { const int st = b / 1024, sb = b % 1024, swz = sb ^ (((sb >> 9) & 1) << 5); R = (st >> 1) * 16 + swz / 64; C = (st & 1) * 32 + (swz % 64) / 2; }
__host__ __device__ __forceinline__ int perm32(int rho) { const int n = rho >> 4, i = rho & 15; return 8 * (i >> 2) + 4 * n + (i & 3); }

struct Unit { int pm, pn, kb; };
struct Gemm { const bf16_t* A; const bf16_t* Bt; int M, N, K, ld; };

struct StaticOrder {
    int nM, nN, nwg, G, c;
    __host__ __device__ void init(int M, int N, int G_, int c_) { nM = M / BM; nN = N / BM; nwg = nM * nN; G = G_; c = c_; }
    __host__ __device__ bool next(int i, Unit& u) const {
        const long L = (long)i * G + c; if (L >= nwg) return false;
        int wgid = (int)L; { const int q = nwg / NXCD, r = nwg % NXCD, xcd = wgid % NXCD, off = wgid / NXCD; wgid = (xcd < r ? xcd * (q + 1) : r * (q + 1) + (xcd - r) * q) + off; }
        const int nig = WGM * nN, gid = wgid / nig, fm = gid * WGM, gsz = (nM - fm) < WGM ? (nM - fm) : WGM;
        u.pm = fm + ((wgid % nig) % gsz); u.pn = (wgid % nig) / gsz; u.kb = 0; return true;
    }
    __device__ __forceinline__ void a_ready(const Unit&) const {}
    __device__ __forceinline__ void done(const Unit&) const {}
};

#ifndef HIPEMU
template <class Epi, class Sched, bool ALIGN_EPI = false, bool SP2 = false>
__device__ __forceinline__ void gemm_phase(PG8_LAS unsigned char* lds, const Gemm g, const Sched& S, const Epi& E, const int wid_in, const int lane_in) {
    const int wid = __builtin_amdgcn_readfirstlane(wid_in), lane = lane_in, tid = wid * 64 + lane, wr = wid >> 2, wc = wid & 3, fr = lane & 15, fq = lane >> 4;
    const int K = g.K, nt = K / BK, LDK = g.ld;
    unsigned voffA[2], voffB[2];
#pragma unroll
    for (int i = 0; i < 2; ++i) { int R, C; stage_rc(tid * 16 + i * 8192, R, C); const int Rb = Epi::PERM ? ((R & ~31) + perm32(R & 31)) : R;
        voffA[i] = (unsigned)(R * LDK + C) * 2u; voffB[i] = (unsigned)(Rb * LDK + C) * 2u; }
    const size_t kstep = (size_t)(BK * 2);
    const size_t hstep = (size_t)HALF * LDK * 2;
    const size_t tstep = 2 * hstep;
    const unsigned ldsw = (unsigned)wid * 1024u;
    const int aoff = lds_byte(wr * 64 + fr, fq * 8), boff = lds_byte(wc * 32 + fr, fq * 8);
#define PG8_SA(b, h) (((b) * 2 + (h)) * HTB)
#define PG8_SB(b, h) ((4 + (b) * 2 + (h)) * HTB)
#define PG8_STAGE(bufoff, gbase, voff) do { _Pragma("unroll") for (int _i = 0; _i < 2; ++_i) \
        __builtin_amdgcn_global_load_lds((const unsigned*)((const char*)(gbase) + (voff)[_i]), (PG8_LAS unsigned*)(lds + (bufoff) + ldsw + _i * 8192), 16, 0, 0); } while (0)
#define PG8_LDA(dst, b, h) do { _Pragma("unroll") for (int m = 0; m < 4; ++m) _Pragma("unroll") for (int k = 0; k < 2; ++k) dst[m][k] = *(const PG8_LAS bf16x8*)(lds + PG8_SA(b, h) + aoff + m * 2048 + k * 1024); } while (0)
#define PG8_LDB(dst, b, h) do { _Pragma("unroll") for (int n = 0; n < 2; ++n) _Pragma("unroll") for (int k = 0; k < 2; ++k) dst[n][k] = *(const PG8_LAS bf16x8*)(lds + PG8_SB(b, h) + boff + n * 2048 + k * 1024); } while (0)
#define PG8_MMA(ai, bj, At, Bt) do { __builtin_amdgcn_s_setprio(1); _Pragma("unroll") for (int m = 0; m < 4; ++m) _Pragma("unroll") for (int n = 0; n < 2; ++n) _Pragma("unroll") for (int k = 0; k < 2; ++k) \
        acc[ai][bj][m][n] = __builtin_amdgcn_mfma_f32_16x16x32_bf16(Bt[n][k], At[m][k], acc[ai][bj][m][n], 0, 0, 0); __builtin_amdgcn_s_setprio(0); } while (0)
#define PG8_WAIT_V(n) asm volatile("s_waitcnt vmcnt(" #n ")" ::: "memory")
#define PG8_WAIT_L(n) asm volatile("s_waitcnt lgkmcnt(" #n ")" ::: "memory")
#define PG8_BAR __builtin_amdgcn_s_barrier()
#define PG8_SCHED __builtin_amdgcn_sched_barrier(0)
    Unit cur, nxt; int ui = 0;
    if (!S.next(0, cur)) return;
    f32x4 acc[2][2][4][2];
#pragma unroll
    for (int a = 0; a < 2; ++a)
#pragma unroll
        for (int b = 0; b < 2; ++b)
#pragma unroll
            for (int m = 0; m < 4; ++m)
#pragma unroll
                for (int n = 0; n < 2; ++n) acc[a][b][m][n] = (f32x4){0.f, 0.f, 0.f, 0.f};
    bf16x8 At[4][2], B0[2][2], B1[2][2];
    const char* cA = (const char*)g.A + (size_t)cur.pm * tstep + (size_t)cur.kb * K * 2; const char* cB = (const char*)g.Bt + (size_t)cur.pn * tstep + (size_t)cur.kb * K * 2;
    S.a_ready(cur);
    if constexpr (SP2) {
        PG8_STAGE(PG8_SB(0, 0), cB, voffB); PG8_STAGE(PG8_SB(0, 1), cB + hstep, voffB); PG8_STAGE(PG8_SA(0, 0), cA, voffA); PG8_STAGE(PG8_SA(0, 1), cA + hstep, voffA);
        if (wr == 1) PG8_BAR;
        PG8_WAIT_V(2); PG8_BAR;
        PG8_STAGE(PG8_SB(1, 0), cB + kstep, voffB); PG8_STAGE(PG8_SA(1, 0), cA + kstep, voffA); PG8_STAGE(PG8_SB(1, 1), cB + hstep + kstep, voffB);
        PG8_WAIT_V(6); PG8_BAR;
    } else {
        PG8_STAGE(PG8_SB(0, 0), cB, voffB); PG8_STAGE(PG8_SA(0, 0), cA, voffA); PG8_STAGE(PG8_SB(0, 1), cB + hstep, voffB); PG8_STAGE(PG8_SA(0, 1), cA + hstep, voffA);
        if (wr == 1) PG8_BAR;
        PG8_WAIT_V(4); PG8_BAR;
        PG8_STAGE(PG8_SB(1, 0), cB + kstep, voffB); PG8_STAGE(PG8_SA(1, 0), cA + kstep, voffA); PG8_STAGE(PG8_SB(1, 1), cB + hstep + kstep, voffB);
        PG8_WAIT_V(6); PG8_BAR;
    }
    for (;;) {
        const bool has_next = S.next(ui + 1, nxt);
        const char* nA = has_next ? (const char*)g.A + (size_t)nxt.pm * tstep + (size_t)nxt.kb * K * 2 : cA; const char* nB = has_next ? (const char*)g.Bt + (size_t)nxt.pn * tstep + (size_t)nxt.kb * K * 2 : cB;
        for (int t = 0; t < nt; t += 2) {
            const bool last = (t == nt - 2);
            const char* a1 = cA + (size_t)(t + 1) * kstep;
            const char* a2 = last ? nA : cA + (size_t)(t + 2) * kstep; const char* b2 = last ? nB : cB + (size_t)(t + 2) * kstep;
            const char* a3 = a2 + kstep; const char* b3 = b2 + kstep;
            if (last && has_next) S.a_ready(nxt);
            if constexpr (SP2) {
            PG8_LDB(B0, 0, 0); PG8_LDB(B1, 0, 1); PG8_SCHED; PG8_LDA(At, 0, 0); PG8_STAGE(PG8_SA(1, 1), a1 + hstep, voffA);
            PG8_WAIT_V(8); PG8_WAIT_L(0); PG8_BAR; PG8_MMA(0, 0, At, B0); PG8_MMA(0, 1, At, B1); PG8_BAR; PG8_SCHED;
            PG8_LDA(At, 0, 1); PG8_STAGE(PG8_SB(0, 0), b2, voffB); PG8_STAGE(PG8_SB(0, 1), b2 + hstep, voffB); PG8_STAGE(PG8_SA(0, 0), a2, voffA);
            PG8_WAIT_V(8); PG8_WAIT_L(0); PG8_BAR; PG8_MMA(1, 0, At, B0); PG8_MMA(1, 1, At, B1); PG8_BAR; PG8_SCHED;
            PG8_LDB(B0, 1, 0); PG8_LDB(B1, 1, 1); PG8_SCHED; PG8_LDA(At, 1, 0); PG8_STAGE(PG8_SA(0, 1), a2 + hstep, voffA);
            PG8_WAIT_V(8); PG8_WAIT_L(0); PG8_BAR; PG8_MMA(0, 0, At, B0); PG8_MMA(0, 1, At, B1); PG8_BAR; PG8_SCHED;
            PG8_LDA(At, 1, 1); PG8_STAGE(PG8_SB(1, 0), b3, voffB); PG8_STAGE(PG8_SB(1, 1), b3 + hstep, voffB); PG8_STAGE(PG8_SA(1, 0), a3, voffA);
            PG8_WAIT_V(8); PG8_WAIT_L(0); PG8_BAR; PG8_MMA(1, 0, At, B0); PG8_MMA(1, 1, At, B1); PG8_BAR; PG8_SCHED;
            } else {
            PG8_LDB(B0, 0, 0); PG8_SCHED; PG8_LDA(At, 0, 0); PG8_STAGE(PG8_SA(1, 1), a1 + hstep, voffA);
            PG8_WAIT_L(8); PG8_BAR; PG8_WAIT_L(0); PG8_MMA(0, 0, At, B0); PG8_BAR; PG8_SCHED;
            PG8_LDB(B1, 0, 1); PG8_STAGE(PG8_SB(0, 0), b2, voffB);
            PG8_BAR; PG8_WAIT_L(0); PG8_MMA(0, 1, At, B1); PG8_BAR;
            PG8_LDA(At, 0, 1); PG8_STAGE(PG8_SA(0, 0), a2, voffA);
            PG8_BAR; PG8_WAIT_L(0); PG8_MMA(1, 0, At, B0); PG8_BAR; PG8_SCHED;
            PG8_STAGE(PG8_SB(0, 1), b2 + hstep, voffB);
            PG8_WAIT_V(6); PG8_BAR; PG8_MMA(1, 1, At, B1); PG8_BAR;
            PG8_LDB(B0, 1, 0); PG8_SCHED; PG8_LDA(At, 1, 0); PG8_STAGE(PG8_SA(0, 1), a2 + hstep, voffA);
            PG8_WAIT_L(8); PG8_BAR; PG8_WAIT_L(0); PG8_MMA(0, 0, At, B0); PG8_BAR; PG8_SCHED;
            PG8_LDB(B1, 1, 1); PG8_STAGE(PG8_SB(1, 0), b3, voffB);
            PG8_BAR; PG8_WAIT_L(0); PG8_MMA(0, 1, At, B1); PG8_BAR;
            PG8_LDA(At, 1, 1); PG8_STAGE(PG8_SA(1, 0), a3, voffA);
            PG8_BAR; PG8_WAIT_L(0); PG8_MMA(1, 0, At, B0); PG8_BAR; PG8_SCHED;
            PG8_STAGE(PG8_SB(1, 1), b3 + hstep, voffB);
            PG8_WAIT_V(6); PG8_BAR; PG8_MMA(1, 1, At, B1); PG8_BAR;
            }
        }
        if constexpr (ALIGN_EPI) { if (wr == 0) PG8_BAR; }
        if constexpr (!Epi::AFTER_DRAIN) { E(acc, cur, wr, wc, fr, fq); S.done(cur); }
        if (!has_next) break;
#pragma unroll
        for (int a = 0; a < 2; ++a)
#pragma unroll
            for (int b = 0; b < 2; ++b)
#pragma unroll
                for (int m = 0; m < 4; ++m)
#pragma unroll
                    for (int n = 0; n < 2; ++n) acc[a][b][m][n] = (f32x4){0.f, 0.f, 0.f, 0.f};
        cur = nxt; cA = nA; cB = nB; ++ui;
        if constexpr (ALIGN_EPI) { if (wr == 1) PG8_BAR; }
    }
    PG8_WAIT_V(0);
    if constexpr (!ALIGN_EPI) { if (wr == 0) PG8_BAR; }
    PG8_BAR;
    if constexpr (Epi::AFTER_DRAIN) { E.fused(acc, cur, wr, wc, fr, fq, lds, wid, lane); S.done(cur); }
#undef PG8_SA
#undef PG8_SB
#undef PG8_STAGE
#undef PG8_LDA
#undef PG8_LDB
#undef PG8_MMA
#undef PG8_WAIT_V
#undef PG8_WAIT_L
#undef PG8_BAR
#undef PG8_SCHED
}
}

#else
}
#endif

constexpr int D = 1024, BATCH = CFG_BATCH, SEQ = CFG_SEQ, DECB = CFG_DEC_BATCH, DECS = 8, PAST = CFG_PAST_LEN, PAGE = 128;
constexpr int MP = BATCH * SEQ, MS = DECB * DECS, MT = MP + MS, M = (MT + 255) / 256 * 256;
constexpr int NPAGES = PAST / PAGE;
constexpr int QKV_A = 1536, IN_AB = 2600, LD1 = 2816, FF = 4096, INC = 4096;
constexpr int C_Z = 1536, C_B = 2048, C_A = 2052, C_CQ = 2056, C_CKV = 2312, C_KPE = 2568;
constexpr float EPS = 1e-6f;
constexpr float MLA_SCALE = 0.10206207261596575f;
constexpr float DK_SCALE = 0.08838834764831845f;
static_assert(MP % 256 == 0 && SEQ % 128 == 0 && PAST % 128 == 0, "shape assumptions");

constexpr size_t O_YP = 0, O_YS = O_YP + (size_t)MP * D, O_GDNP = O_YS + (size_t)MS * D, O_CONVP = O_GDNP + (size_t)BATCH * 4 * 16384,
    O_LATP = O_CONVP + (size_t)BATCH * 3 * QKV_A, O_KPEP = O_LATP + (size_t)MP * 256, O_HGP = O_KPEP + (size_t)MP * 32,
    O_GDNS = O_HGP + (size_t)BATCH * 8 * 16384, O_CONVS = O_GDNS + (size_t)DECB * 4 * 16384, O_LATS = O_CONVS + (size_t)DECB * 3 * QKV_A,
    O_KPES = O_LATS + (size_t)MS * 256, O_HGS = O_KPES + (size_t)MS * 32, O_END = O_HGS + (size_t)DECB * 8 * 16384;

constexpr size_t al256(size_t x) { return (x + 255) & ~(size_t)255; }
constexpr size_t WS_CTL = 0, CTL_BYTES = 65536;
constexpr size_t WS_WINAB = CTL_BYTES,                      WS_WUP0 = WS_WINAB + (size_t)LD1 * D * 2,
    WS_WUP1 = WS_WUP0 + (size_t)FF * D * 2,                 WS_WDN0 = WS_WUP1 + (size_t)FF * D * 2,
    WS_WDN1 = WS_WDN0 + (size_t)FF * D * 2,                 WS_WINC = WS_WDN1 + (size_t)FF * D * 2,
    WS_WOAB = WS_WINC + (size_t)INC * D * 2,                WS_WOC = WS_WOAB + (size_t)D * D * 2,
    WS_WUQ = WS_WOC + (size_t)D * D * 2,                    WS_WUKV = WS_WUQ + (size_t)768 * 256 * 2,
    WS_ROPE = WS_WUKV + (size_t)1024 * 256 * 2,             WS_XN = al256(WS_ROPE + (size_t)(SEQ + 8) * 32 * 4),
    WS_P1 = WS_XN + (size_t)M * D * 2,                      WS_CQN = WS_P1 + (size_t)M * 4096 * 4,
    WS_LATN = WS_CQN + (size_t)M * 256 * 2,                 WS_QH = WS_LATN + (size_t)M * 256 * 2,
    WS_KVP = WS_QH + (size_t)M * 768 * 4,                   WS_OCAT = WS_KVP + (size_t)MP * 1024 * 2,
    WS_ORAW = WS_OCAT + (size_t)M * D * 2,                  WS_X1 = WS_ORAW + (size_t)M * D * 4,
    WS_X2 = WS_X1 + (size_t)M * D * 4,                      WS_H = WS_X2 + (size_t)M * D * 4,
    WS_WUKB = WS_H + (size_t)M * FF * 2,                    WS_PO = WS_WUKB + (size_t)256 * 512 * 2,
    WS_PM = WS_PO + (size_t)DECB * 2 * 64 * 256 * 4,        WS_PL = WS_PM + (size_t)DECB * 2 * 64 * 4,
    WS_KPEB = WS_PL + (size_t)DECB * 2 * 64 * 4,            WS_PART = al256(WS_KPEB + (size_t)MP * 32 * 2),
    WS_END = WS_PART + (size_t)16 * (M - MP) * D * 4;
constexpr size_t WS_H_END = WS_H + (size_t)M * FF * 2;

constexpr int LDS_BYTES = 155648;
constexpr int LDS_MISC = 155648 - 256;
constexpr int NPHASE = 20;

typedef unsigned short bf16;
typedef unsigned u32x4 __attribute__((ext_vector_type(4)));
typedef unsigned u32x2 __attribute__((ext_vector_type(2)));
#ifndef HIPEMU
typedef short bf16x8 __attribute__((ext_vector_type(8)));
typedef float f32x4 __attribute__((ext_vector_type(4)));
#endif

#ifdef HIPEMU
DEV unsigned f2bf(float f) { unsigned u = __float_as_uint(f); return (u + 0x7fffu + ((u >> 16) & 1u)) >> 16; }
#else
DEV unsigned f2bf(float f) { return (unsigned)__builtin_bit_cast(unsigned short, (__bf16)f); }
#endif
#ifdef HIPEMU
DEV unsigned pk2(float lo, float hi) { return f2bf(lo) | (f2bf(hi) << 16); }
#else
typedef float f32x2_t __attribute__((ext_vector_type(2))); typedef __bf16 bf16x2_t __attribute__((ext_vector_type(2)));
DEV unsigned pk2(float lo, float hi) { f32x2_t v = {lo, hi}; bf16x2_t b = __builtin_convertvector(v, bf16x2_t); return __builtin_bit_cast(unsigned, b); }
#endif
DEV float bf2f(bf16 b) { return __uint_as_float(((unsigned)b) << 16); }
DEV float sigmoidf_(float x) { return 1.0f / (1.0f + __expf(-x)); }
DEV float siluf_(float x) { return x / (1.0f + __expf(-x)); }
DEV float softplusf_(float x) { return fmaxf(x, 0.f) + log1pf(__expf(-fabsf(x))); }
#ifdef HIPEMU
DEV f32x4 mfma16(bf16x8 a, bf16x8 b, f32x4 c) { return emu_mfma16(a, b, c); }
#define WAVE_SYNC() emu_wave_sync()
#define OPAQUE_V(x) do { } while (0)
#define LDS_BARRIER() __syncthreads()
DEV s16x4 lds_tr(const unsigned short* p) { return emu_lds_tr((const void*)p); }
#else
typedef short s16x4 __attribute__((ext_vector_type(4)));
DEV s16x4 lds_tr(const unsigned short* p) { return __builtin_bit_cast(s16x4, __builtin_amdgcn_ds_read_tr16_b64_v4i16((__attribute__((address_space(3))) s16x4*)p)); }
DEV f32x4 mfma16(bf16x8 a, bf16x8 b, f32x4 c) { return __builtin_amdgcn_mfma_f32_16x16x32_bf16(a, b, c, 0, 0, 0); }
#define WAVE_SYNC() asm volatile("s_waitcnt lgkmcnt(0)" ::: "memory")
#define OPAQUE_V(x) asm volatile("" : "+v"(x))
#define LDS_BARRIER() asm volatile("s_waitcnt lgkmcnt(0)\n\ts_barrier" ::: "memory")
#endif
DEV f32x4 ld4bf(const unsigned short* p) { const u32x2 u = *(const u32x2*)p; return (f32x4){__uint_as_float(u.x << 16), __uint_as_float(u.x & 0xffff0000u), __uint_as_float(u.y << 16), __uint_as_float(u.y & 0xffff0000u)}; }
constexpr float QK_SCALE2 = MLA_SCALE * 1.4426950408889634f;
#ifdef HIPEMU
DEV float exp2f_(float x) { return exp2f(x); }
DEV bool wave_any(bool p) { int v = p ? 1 : 0;
    for (int o = 1; o < 64; o <<= 1) v |= __shfl_xor(v, o);
    return v != 0; }
#else
DEV float exp2f_(float x) { return __builtin_amdgcn_exp2f(x); }
DEV bool wave_any(bool p) { return __builtin_amdgcn_ballot_w64(p) != 0ull; }
#endif
#ifdef HIPEMU
DEV float wave_sum(float v) {
#pragma unroll
    for (int o = 1; o < 64; o <<= 1) v += __shfl_xor(v, o);
    return v;
}
DEV float grp16_max(float v) {
#pragma unroll
    for (int o = 1; o < 16; o <<= 1) v = fmaxf(v, __shfl_xor(v, o));
    return v;
}
DEV float grp16_sum(float v) {
#pragma unroll
    for (int o = 1; o < 16; o <<= 1) v += __shfl_xor(v, o);
    return v;
}
#else
template <int CTRL> DEV float dppf(float x) { return __builtin_bit_cast(float, __builtin_amdgcn_mov_dpp(__builtin_bit_cast(int, x), CTRL, 0xf, 0xf, true)); }
DEV float grp16_max(float v) { v = fmaxf(v, dppf<0xB1>(v)); v = fmaxf(v, dppf<0x4E>(v)); v = fmaxf(v, dppf<0x141>(v)); v = fmaxf(v, dppf<0x128>(v)); return v; }
DEV float grp16_sum(float v) { v += dppf<0xB1>(v); v += dppf<0x4E>(v); v += dppf<0x141>(v); v += dppf<0x128>(v); return v; }
DEV float wave_sum(float v) {
    v = grp16_sum(v);
    auto s = __builtin_amdgcn_permlane16_swap(__float_as_uint(v), __float_as_uint(v), false, false);
    v = __uint_as_float(s[0]) + __uint_as_float(s[1]);
    auto t = __builtin_amdgcn_permlane32_swap(__float_as_uint(v), __float_as_uint(v), false, false);
    return __uint_as_float(t[0]) + __uint_as_float(t[1]);
}
#endif

struct Params { const void* in[28]; float* out; unsigned char* ws; int ph_lo, ph_hi; };
struct Ctx {
    const Params* p; unsigned char* lds; unsigned char* ws; float* out;
    int tid, lane, wave, gw, ngw;
    template <class T> DEV const T* in(int i) const { return (const T*)p->in[i]; }
    template <class T> DEV T* w(size_t off) const { return (T*)(ws + off); }
};
DEV int queue_next(const Ctx& c, int q) {
    unsigned* cnt = (unsigned*)(c.ws + WS_CTL) + 4096 + 64 * q; volatile unsigned* slot = (volatile unsigned*)(c.lds + LDS_MISC + 128);
    __syncthreads();
    if (c.tid == 0) *slot = atomicAdd(cnt, 1u);
    __syncthreads();
    return (int)*slot;
}
DEV const float* xin_row(const Ctx& c, int m) { return m < MP ? c.in<float>(0) + (size_t)m * D : c.in<float>(1) + (size_t)(m - MP) * D; }

struct EpiStoreF32 {
    static constexpr bool PERM = false, AFTER_DRAIN = false;
    float* C; int ldc;
    DEV void operator()(const pg8::f32x4 (&acc)[2][2][4][2], const pg8::Unit& u, int wr, int wc, int fr, int fq) const {
        const int row0 = u.pm * 256 + wr * 64 + fr, col0 = u.pn * 256 + wc * 32 + 4 * fq;
#pragma unroll
        for (int ai = 0; ai < 2; ++ai)
#pragma unroll
            for (int m = 0; m < 4; ++m) { float* rowp = C + (size_t)(row0 + ai * 128 + m * 16) * ldc + col0;
#pragma unroll
                for (int bj = 0; bj < 2; ++bj)
#pragma unroll
                    for (int n = 0; n < 2; ++n) *(pg8::f32x4*)(rowp + bj * 128 + n * 16) = acc[ai][bj][m][n]; }
    }
};
struct EpiResidF32 {
    static constexpr bool PERM = false, AFTER_DRAIN = false;
    const float* base; const float* xp; const float* xs; float* out;
    DEV void operator()(const pg8::f32x4 (&acc)[2][2][4][2], const pg8::Unit& u, int wr, int wc, int fr, int fq) const {
        const int row0 = u.pm * 256 + wr * 64 + fr, col0 = u.pn * 256 + wc * 32 + 4 * fq;
#pragma unroll
        for (int ai = 0; ai < 2; ++ai)
#pragma unroll
            for (int m = 0; m < 4; ++m) { const int row = row0 + ai * 128 + m * 16;
                const float* rp = base ? base + (size_t)row * D : (row < MP ? xp + (size_t)row * D : xs + (size_t)(row - MP) * D);
                const bool ok = base != nullptr || row < MT;
                float* op = out + (size_t)row * D + col0;
#pragma unroll
                for (int bj = 0; bj < 2; ++bj)
#pragma unroll
                    for (int n = 0; n < 2; ++n) { pg8::f32x4 r = ok ? *(const pg8::f32x4*)(rp + col0 + bj * 128 + n * 16) : (pg8::f32x4){0.f, 0.f, 0.f, 0.f};
                        *(pg8::f32x4*)(op + bj * 128 + n * 16) = r + acc[ai][bj][m][n]; } }
    }
};
template <int ACT  > struct EpiBf16 {
    static constexpr bool PERM = true, AFTER_DRAIN = false;
    bf16* O; int ldc;
    DEV void operator()(const pg8::f32x4 (&acc)[2][2][4][2], const pg8::Unit& u, int wr, int wc, int fr, int fq) const {
        const int row0 = u.pm * 256 + wr * 64 + fr, col0 = u.pn * 256 + wc * 32 + 8 * fq;
#pragma unroll
        for (int ai = 0; ai < 2; ++ai)
#pragma unroll
            for (int m = 0; m < 4; ++m) { bf16* rowp = O + (size_t)(row0 + ai * 128 + m * 16) * ldc + col0;
#pragma unroll
                for (int bj = 0; bj < 2; ++bj) { pg8::f32x4 v0 = acc[ai][bj][m][0], v1 = acc[ai][bj][m][1];
                    if (ACT == 1) {
#pragma unroll
                        for (int j = 0; j < 4; ++j) { const float a = fmaxf(v0[j], 0.f), b = fmaxf(v1[j], 0.f); v0[j] = a * a; v1[j] = b * b; } }
                    u32x4 w; w.x = pk2(v0[0], v0[1]); w.y = pk2(v0[2], v0[3]); w.z = pk2(v1[0], v1[1]); w.w = pk2(v1[2], v1[3]);
                    *(u32x4*)(rowp + bj * 128) = w; } }
    }
};

struct SplitKOrder {
    int nM, nN, nS, pm0, G, c;
    DEV void init(int nM_, int nN_, int nS_, int pm0_, int G_, int c_) { nM = nM_; nN = nN_; nS = nS_; pm0 = pm0_; G = G_; c = c_; }
    DEV bool next(int i, pg8::Unit& u) const { const int L = i * G + c; if (L >= nM * nN * nS) return false; u.pm = pm0 + L % nM; const int r = L / nM; u.pn = r % nN; u.kb = r / nN; return true; }
    DEV void a_ready(const pg8::Unit&) const {}
    DEV void done(const pg8::Unit&) const {}
};
struct EpiPartF32 {
    static constexpr bool PERM = false, AFTER_DRAIN = false;
    float* P;
    DEV void operator()(const pg8::f32x4 (&acc)[2][2][4][2], const pg8::Unit& u, int wr, int wc, int fr, int fq) const {
        const int row0 = u.pm * 256 - MP + wr * 64 + fr, col0 = u.pn * 256 + wc * 32 + 4 * fq;
        float* base = P + (size_t)u.kb * (M - MP) * D;
#pragma unroll
        for (int ai = 0; ai < 2; ++ai)
#pragma unroll
            for (int m = 0; m < 4; ++m) { float* op = base + (size_t)(row0 + ai * 128 + m * 16) * D + col0;
#pragma unroll
                for (int bj = 0; bj < 2; ++bj)
#pragma unroll
                    for (int n = 0; n < 2; ++n) *(pg8::f32x4*)(op + bj * 128 + n * 16) = acc[ai][bj][m][n]; }
    }
};
template <class Epi, class Sched> DEV void run_gemm_s(const Ctx& c, const bf16* A, const bf16* Bt, int Mr, int N, int K, int ld, const Sched& S, const Epi& E) {
#ifndef HIPEMU
    asm volatile("" : "+s"(K));
    pg8::Gemm g{A, Bt, Mr, N, K, ld};
    pg8::gemm_phase<Epi, Sched, true, true>((PG8_LAS unsigned char*)c.lds, g, S, E, c.wave, c.lane);
#else
    const int wid = c.wave, lane = c.lane, wr = wid >> 2, wc = wid & 3, fr = lane & 15, fq = lane >> 4;
    pg8::Unit u;
    for (int ui = 0; S.next(ui, u); ++ui) {
        pg8::f32x4 acc[2][2][4][2];
        for (int ai = 0; ai < 2; ++ai) for (int bj = 0; bj < 2; ++bj) for (int m = 0; m < 4; ++m) for (int n = 0; n < 2; ++n) for (int j = 0; j < 4; ++j) {
            const int row = 256 * u.pm + 128 * ai + 64 * wr + 16 * m + fr;
            const int col = Epi::PERM ? 256 * u.pn + 128 * bj + 32 * wc + 8 * fq + 4 * n + j : 256 * u.pn + 128 * bj + 32 * wc + 16 * n + 4 * fq + j;
            const bf16* a = A + (size_t)row * ld + (size_t)u.kb * K; const bf16* b = Bt + (size_t)col * ld + (size_t)u.kb * K; float s = 0.f;
            for (int k = 0; k < K; ++k) s += bf2f(a[k]) * bf2f(b[k]);
            acc[ai][bj][m][n][j] = s; }
        E(acc, u, wr, wc, fr, fq);
    }
#endif
}
template <class Epi> DEV void run_gemm(const Ctx& c, const bf16* A, const bf16* Bt, int Mr, int N, int K, const Epi& E) {
    pg8::StaticOrder S; S.init(Mr, N, (int)gridDim.x, (int)blockIdx.x);
    run_gemm_s(c, A, Bt, Mr, N, K, K, S, E);
}
DEV void run_gemm_sample_splitk(const Ctx& c, const bf16* A, const bf16* Bt, int K, int KS) {
    SplitKOrder S; S.init((M - MP) / 256, D / 256, K / KS, MP / 256, (int)gridDim.x, (int)((blockIdx.x + 128) % gridDim.x));
    run_gemm_s(c, A, Bt, M, D, KS, K, S, EpiPartF32{c.w<float>(WS_PART)});
}

DEV void transpose_item(const float* W, int K, int N, bf16* WT, float* scr, int item, int nblk, int lane) {
    const int kb = item / nblk, nb = item % nblk, k0 = 64 * kb, n0 = 32 * nb;
    const int nn = n0 + (lane & 31);
    float tv[32];
#pragma unroll
    for (int i = 0; i < 32; ++i) { const int kk = 2 * i + (lane >> 5); tv[i] = nn < N ? W[(size_t)(k0 + kk) * N + nn] : 0.f; }
#pragma unroll
    for (int i = 0; i < 32; ++i) { const int kk = 2 * i + (lane >> 5); scr[kk * 33 + (lane & 31)] = tv[i]; }
    WAVE_SYNC();
    const int cq = lane & 7;
#pragma unroll
    for (int j = 0; j < 4; ++j) { const int n = (lane >> 3) + 8 * j; const float* s = scr + (8 * cq) * 33 + n;
        u32x4 o; o.x = pk2(s[0 * 33], s[1 * 33]); o.y = pk2(s[2 * 33], s[3 * 33]); o.z = pk2(s[4 * 33], s[5 * 33]); o.w = pk2(s[6 * 33], s[7 * 33]);
        *(u32x4*)(WT + (size_t)(n0 + n) * K + k0 + 8 * cq) = o; }
    WAVE_SYNC();
}
DEV void rms_row_to_bf16(const float* xrow, const float* gain, bf16* orow, int lane) {
    f32x4 v[4]; float s = 0.f;
#pragma unroll
    for (int j = 0; j < 4; ++j) { v[j] = *(const f32x4*)(xrow + 4 * lane + 256 * j); s += (v[j][0] * v[j][0] + v[j][1] * v[j][1]) + (v[j][2] * v[j][2] + v[j][3] * v[j][3]); }
    const float rstd = rsqrtf(wave_sum(s) * (1.f / D) + EPS);
#pragma unroll
    for (int j = 0; j < 4; ++j) { const f32x4 g = *(const f32x4*)(gain + 4 * lane + 256 * j);
        u32x2 o; o.x = pk2(v[j][0] * rstd * g[0], v[j][1] * rstd * g[1]); o.y = pk2(v[j][2] * rstd * g[2], v[j][3] * rstd * g[3]);
        *(u32x2*)(orow + 4 * lane + 256 * j) = o; }
}
DEV void zero_row_bf16(bf16* orow, int lane) {
#pragma unroll
    for (int j = 0; j < 4; ++j) { u32x2 o; o.x = 0u; o.y = 0u; *(u32x2*)(orow + 4 * lane + 256 * j) = o; }
}
#define TJOB(Wp, K_, N_, Npad_, wt_) do { const int nblk = (Npad_) / 32, nitems = ((K_) / 64) * nblk; bf16* WT = c.w<bf16>(wt_); const float* Wsrc = (Wp); \
        for (int it = gw0; it < nitems; it += ngw0) transpose_item(Wsrc, (K_), (N_), WT, scr, it, nblk, c.lane); } while (0)
DEV void phase_convert_late(const Ctx& c, int gw0, int ngw0) {
    float* scr = (float*)(c.lds + c.wave * 8704);
    TJOB(c.in<float>(23), D, D, D, WS_WOAB);
    TJOB(c.in<float>(11), D, FF, FF, WS_WUP0);
    TJOB(c.in<float>(12), FF, D, D, WS_WDN0);
}
DEV void phase_convert_late2(const Ctx& c, int gw0, int ngw0) {
    float* scr = (float*)(c.lds + c.wave * 8704);
    TJOB(c.in<float>(24), D, INC, INC, WS_WINC);
    TJOB(c.in<float>(27), D, D, D, WS_WOC);
    TJOB(c.in<float>(11) + (size_t)D * FF, D, FF, FF, WS_WUP1);
    TJOB(c.in<float>(12) + (size_t)D * FF, FF, D, D, WS_WDN1);
}
DEV void phase_prologue(const Ctx& c) {
    float* scr = (float*)(c.lds + c.wave * 8704);
    const int gw0 = c.gw, ngw0 = c.ngw;
    TJOB(c.in<float>(13), D, IN_AB, LD1, WS_WINAB);
    TJOB(c.in<float>(19), 256, 768, 768, WS_WUQ);
    TJOB(c.in<float>(21), 256, 512, 512, WS_WUKV); TJOB(c.in<float>(22), 256, 512, 512, WS_WUKV + (size_t)512 * 256 * 2);
#undef TJOB
    {
        const float* src = c.in<float>(21); bf16* dst = c.w<bf16>(WS_WUKB);
        for (int i = blockIdx.x * 512 + c.tid; i < 256 * 512 / 4; i += gridDim.x * 512) { const f32x4 v = *(const f32x4*)(src + 4 * i); u32x2 o; o.x = pk2(v[0], v[1]); o.y = pk2(v[2], v[3]); *(u32x2*)(dst + 4 * i) = o; }
    }
    float* rope = c.w<float>(WS_ROPE);
    for (int i = blockIdx.x * 512 + c.tid; i < (SEQ + 8) * 16; i += gridDim.x * 512) {
        const int e = i >> 4, f = i & 15; const double pos = e < SEQ ? (double)e : (double)(PAST + e - SEQ);
        const double ang = pos * pow(10000.0, -(double)f / 16.0);
        rope[e * 32 + f] = (float)cos(ang); rope[e * 32 + 16 + f] = (float)sin(ang);
    }
    bf16* XN = c.w<bf16>(WS_XN);
    for (int m = c.gw; m < M; m += c.ngw) {
        if (m < MT) rms_row_to_bf16(xin_row(c, m), c.in<float>(8), XN + (size_t)m * D, c.lane); else zero_row_bf16(XN + (size_t)m * D, c.lane);
    }
}
DEV void sample_row_sum(const Ctx& c, int m, const float* X_res, int nsp, f32x4 (&v)[4]) {
    const int lane = c.lane; const float* P = c.w<float>(WS_PART) + (size_t)(m - MP) * D;
#pragma unroll
    for (int j = 0; j < 4; ++j) {
        if (X_res) v[j] = *(const f32x4*)(X_res + (size_t)m * D + 4 * lane + 256 * j);
        else v[j] = m < MT ? *(const f32x4*)(c.in<float>(1) + (size_t)(m - MP) * D + 4 * lane + 256 * j) : (f32x4){0.f, 0.f, 0.f, 0.f}; }
    for (int s = 0; s < nsp; ++s) {
#pragma unroll
        for (int j = 0; j < 4; ++j) v[j] += *(const f32x4*)(P + (size_t)s * (M - MP) * D + 4 * lane + 256 * j); }
}
DEV void phase_rmsnorm(const Ctx& c, float* X, const float* gain, const float* X_res, int nsp) {
    bf16* XN = c.w<bf16>(WS_XN); const int lane = c.lane;
    for (int m = c.gw; m < M; m += c.ngw) {
        if (m < MP) { rms_row_to_bf16(X + (size_t)m * D, gain, XN + (size_t)m * D, lane); continue; }
        f32x4 v[4]; sample_row_sum(c, m, X_res, nsp, v);
        float s = 0.f;
#pragma unroll
        for (int j = 0; j < 4; ++j) { *(f32x4*)(X + (size_t)m * D + 4 * lane + 256 * j) = v[j]; s += (v[j][0] * v[j][0] + v[j][1] * v[j][1]) + (v[j][2] * v[j][2] + v[j][3] * v[j][3]); }
        const float rstd = rsqrtf(wave_sum(s) * (1.f / D) + EPS);
#pragma unroll
        for (int j = 0; j < 4; ++j) { const f32x4 g = *(const f32x4*)(gain + 4 * lane + 256 * j);
            u32x2 o; o.x = pk2(v[j][0] * rstd * g[0], v[j][1] * rstd * g[1]); o.y = pk2(v[j][2] * rstd * g[2], v[j][3] * rstd * g[3]);
            *(u32x2*)(XN + (size_t)m * D + 4 * lane + 256 * j) = o; }
    }
}
DEV void phase_copy_rows(const Ctx& c, float* dst, const float* src, int nrows) {
    for (int r = (int)(gridDim.x * 8) - 1 - c.gw; r < nrows; r += c.ngw) {
#pragma unroll
        for (int j = 0; j < 4; ++j) *(f32x4*)(dst + (size_t)r * D + 4 * c.lane + 256 * j) = *(const f32x4*)(src + (size_t)r * D + 4 * c.lane + 256 * j); }
}
DEV void phase_final(const Ctx& c, const float* X, const float* gain, const float* X_res, int nsp) {
    for (int m = c.gw; m < MT; m += c.ngw) {
        const float* xrow = X + (size_t)m * D; float* orow = c.out + (m < MP ? O_YP + (size_t)m * D : O_YS + (size_t)(m - MP) * D);
        f32x4 v[4]; float s = 0.f;
        if (m >= MP) sample_row_sum(c, m, X_res, nsp, v);
#pragma unroll
        for (int j = 0; j < 4; ++j) { if (m < MP) v[j] = *(const f32x4*)(xrow + 4 * c.lane + 256 * j); s += (v[j][0] * v[j][0] + v[j][1] * v[j][1]) + (v[j][2] * v[j][2] + v[j][3] * v[j][3]); }
        const float rstd = rsqrtf(wave_sum(s) * (1.f / D) + EPS);
#pragma unroll
        for (int j = 0; j < 4; ++j) { const f32x4 g = *(const f32x4*)(gain + 4 * c.lane + 256 * j); *(f32x4*)(orow + 4 * c.lane + 256 * j) = v[j] * rstd * g; }
    }
}

DEV void phase_prep0(const Ctx& c) {
    const bf16* P1 = c.w<bf16>(WS_P1); const float* rope = c.w<float>(WS_ROPE);
    bf16* CQN = c.w<bf16>(WS_CQN); bf16* LATN = c.w<bf16>(WS_LATN);
    const float* qg = c.in<float>(18); const float* kvg = c.in<float>(20);
    const int lane = c.lane;
    for (int m = c.gw; m < M; m += c.ngw) {
        if (m >= MT) { u32x2 z; z.x = 0u; z.y = 0u; *(u32x2*)(CQN + (size_t)m * 256 + 4 * lane) = z; *(u32x2*)(LATN + (size_t)m * 256 + 4 * lane) = z; continue; }
        const bf16* row = P1 + (size_t)m * LD1;
        const bool samp = m >= MP; const int b = samp ? (m - MP) / DECS : m / SEQ, t = samp ? (m - MP) % DECS : m % SEQ;
        {
            const f32x4 v = ld4bf(row + C_CQ + 4 * lane); const f32x4 g = *(const f32x4*)(qg + 4 * lane);
            const float r = rsqrtf(wave_sum((v[0] * v[0] + v[1] * v[1]) + (v[2] * v[2] + v[3] * v[3])) * (1.f / 256.f) + EPS);
            u32x2 o; o.x = pk2(v[0] * r * g[0], v[1] * r * g[1]); o.y = pk2(v[2] * r * g[2], v[3] * r * g[3]); *(u32x2*)(CQN + (size_t)m * 256 + 4 * lane) = o;
        }
        {
            const f32x4 v = ld4bf(row + C_CKV + 4 * lane); const f32x4 g = *(const f32x4*)(kvg + 4 * lane);
            const float r = rsqrtf(wave_sum((v[0] * v[0] + v[1] * v[1]) + (v[2] * v[2] + v[3] * v[3])) * (1.f / 256.f) + EPS);
            const f32x4 y = v * r * g;
            float* lo = c.out + (samp ? O_LATS + (size_t)(m - MP) * 256 : O_LATP + (size_t)m * 256);
            *(f32x4*)(lo + 4 * lane) = y;
            u32x2 o; o.x = pk2(y[0], y[1]); o.y = pk2(y[2], y[3]); *(u32x2*)(LATN + (size_t)m * 256 + 4 * lane) = o;
        }
        if (lane < 16) {
            const float* rt = rope + (size_t)(samp ? SEQ + t : t) * 32; const float cs = rt[lane], sn = rt[16 + lane];
            const float x1 = bf2f(row[C_KPE + lane]), x2 = bf2f(row[C_KPE + 16 + lane]);
            float* ko = c.out + (samp ? O_KPES + (size_t)(m - MP) * 32 : O_KPEP + (size_t)m * 32);
            ko[lane] = x1 * cs - x2 * sn; ko[16 + lane] = x2 * cs + x1 * sn;
            if (!samp) { bf16* kb = c.w<bf16>(WS_KPEB) + (size_t)m * 32; kb[lane] = (bf16)f2bf(x1 * cs - x2 * sn); kb[16 + lane] = (bf16)f2bf(x2 * cs + x1 * sn); }
        }
        const int T = samp ? DECS : SEQ;
        if (t >= T - 3) {
            float* co = c.out + (samp ? O_CONVS : O_CONVP) + ((size_t)b * 3 + (t - (T - 3))) * QKV_A;
#pragma unroll
            for (int j = 0; j < 6; ++j) *(f32x4*)(co + 4 * lane + 256 * j) = ld4bf(row + 4 * lane + 256 * j);
        }
    }
}

DEV void phase_gdn_naive(const Ctx& c, int u_begin, int wg_first, int wg_stride) {
    float* red = (float*)c.lds; float* red2 = red + 512; float* qs = red2 + 512; float* ks = qs + 128; float* vs = ks + 128; float* part = vs + 128; float* sc = part + 8;
    const bf16* P1 = c.w<bf16>(WS_P1); float* ORAW = c.w<float>(WS_ORAW); bf16* OCAT = c.w<bf16>(WS_OCAT);
    const float* convw = c.in<float>(14); const float* gn = c.in<float>(17);
    const int tid = c.tid, lane = c.lane, wave = c.wave;
    const int NU = (BATCH + DECB) * 4;
    for (int u = u_begin + wg_first; u < NU; u += wg_stride) {
        const bool samp = u >= BATCH * 4; const int b = samp ? (u - BATCH * 4) >> 2 : u >> 2, h = u & 3;
        const int T = samp ? DECS : SEQ; const size_t m0 = samp ? (size_t)MP + (size_t)b * DECS : (size_t)b * SEQ;
        const int e = tid & 127, dg = tid >> 7, d0 = dg * 32;
        float s[32];
        if (samp) { const float* S0 = c.in<float>(2) + ((size_t)(b * 4 + h) * 128 + d0) * 128 + e;
#pragma unroll
            for (int i = 0; i < 32; ++i) s[i] = S0[(size_t)i * 128]; }
        else {
#pragma unroll
            for (int i = 0; i < 32; ++i) s[i] = 0.f; }
        const int col = tid < 128 ? h * 128 + tid : (tid < 256 ? 512 + h * 128 + (tid - 128) : 1024 + h * 128 + (tid - 256));
        float w0 = 0.f, w1 = 0.f, w2 = 0.f, w3 = 0.f, x0 = 0.f, x1 = 0.f, x2 = 0.f, xn = 0.f;
        if (tid < 384) { w0 = convw[col]; w1 = convw[QKV_A + col]; w2 = convw[2 * QKV_A + col]; w3 = convw[3 * QKV_A + col];
            if (samp) { const float* cb = c.in<float>(3) + (size_t)b * 3 * QKV_A + col; x0 = cb[0]; x1 = cb[QKV_A]; x2 = cb[2 * QKV_A]; }
            xn = bf2f(P1[m0 * LD1 + col]); }
        const float Aexp = __expf(c.in<float>(15)[h]), dtb = c.in<float>(16)[h];
        for (int t = 0; t < T; ++t) {
            const size_t m = m0 + t;
            const float x3 = xn; if (t + 1 < T && tid < 384) xn = bf2f(P1[(m + 1) * LD1 + col]);
            float val = 0.f;
            if (tid < 384) { const float y = w0 * x0 + w1 * x1 + w2 * x2 + w3 * x3; val = siluf_(y); x0 = x1; x1 = x2; x2 = x3; }
            const float sq = wave_sum(tid < 256 ? val * val : 0.f);
            if (tid < 128) qs[tid] = val; else if (tid < 256) ks[tid - 128] = val; else if (tid < 384) vs[tid - 256] = val;
            if (lane == 0 && wave < 4) part[wave] = sq;
            if (tid == 384) { sc[0] = sigmoidf_(bf2f(P1[m * LD1 + C_B + h])); sc[1] = -Aexp * softplusf_(bf2f(P1[m * LD1 + C_A + h]) + dtb); }
            LDS_BARRIER();
            const float qn = rsqrtf(part[0] + part[1] + EPS), kn = rsqrtf(part[2] + part[3] + EPS), beta = sc[0], dec = __expf(sc[1]);
            float kp = 0.f;
#pragma unroll
            for (int i = 0; i < 32; ++i) { s[i] *= dec; kp += ks[d0 + i] * s[i]; }
            red[dg * 128 + e] = kp * kn;
            LDS_BARRIER();
            const float kS = (red[e] + red[128 + e]) + (red[256 + e] + red[384 + e]);
            const float delta = beta * (vs[e] - kS) * kn;
            float op = 0.f;
#pragma unroll
            for (int i = 0; i < 32; ++i) { s[i] += ks[d0 + i] * delta; op += qs[d0 + i] * s[i]; }
            red2[dg * 128 + e] = op * qn;
            LDS_BARRIER();
            if (dg == 0) ORAW[m * 512 + h * 128 + e] = ((red2[e] + red2[128 + e]) + (red2[256 + e] + red2[384 + e])) * DK_SCALE;
        }
        float* So = c.out + (samp ? O_GDNS : O_GDNP) + ((size_t)(b * 4 + h) * 128 + d0) * 128 + e;
#pragma unroll
        for (int i = 0; i < 32; ++i) So[(size_t)i * 128] = s[i];
        __syncthreads();
        for (int t = wave; t < T; t += 8) { const size_t m = m0 + t;
            const float v0 = ORAW[m * 512 + h * 128 + lane], v1 = ORAW[m * 512 + h * 128 + 64 + lane];
            const float r = rsqrtf(wave_sum(v0 * v0 + v1 * v1) * (1.f / 128.f) + EPS);
            const float z0 = bf2f(P1[m * LD1 + C_Z + h * 128 + lane]), z1 = bf2f(P1[m * LD1 + C_Z + h * 128 + 64 + lane]);
            OCAT[m * D + h * 128 + lane] = (bf16)f2bf(v0 * r * gn[lane] * siluf_(z0));
            OCAT[m * D + h * 128 + 64 + lane] = (bf16)f2bf(v1 * r * gn[64 + lane] * siluf_(z1)); }
        __syncthreads();
    }
}

DEV void phase_hgrn_naive(const Ctx& c, int u_begin, int wg_first, int wg_stride) {
    float* red = (float*)c.lds; float* qs = red + 512; float* fs = qs + 128;
    const bf16* PC = c.w<bf16>(WS_P1); float* ORAW = c.w<float>(WS_ORAW); bf16* OC = c.w<bf16>(WS_OCAT);
    const float* lbl = c.in<float>(25); const float* gn = c.in<float>(26);
    const int tid = c.tid, lane = c.lane, wave = c.wave;
    const int NU = (BATCH + DECB) * 8;
    for (int u = u_begin + wg_first; u < NU; u += wg_stride) {
        const bool samp = u >= BATCH * 8; const int b = samp ? (u - BATCH * 8) >> 3 : u >> 3, h = u & 7;
        const int T = samp ? DECS : SEQ; const size_t m0 = samp ? (size_t)MP + (size_t)b * DECS : (size_t)b * SEQ;
        const int e = tid & 127, dg = tid >> 7, d0 = dg * 32;
        float s[32];
        if (samp) { const float* S0 = c.in<float>(6) + ((size_t)(b * 8 + h) * 128 + d0) * 128 + e;
#pragma unroll
            for (int i = 0; i < 32; ++i) s[i] = S0[(size_t)i * 128]; }
        else {
#pragma unroll
            for (int i = 0; i < 32; ++i) s[i] = 0.f; }
        float lb = 0.f; if (tid < 128) lb = sigmoidf_(lbl[1024 + h * 128 + tid] - lbl[h * 128 + tid]);
        bf16 nq = 0, nf = 0, nv = 0;
        { const bf16* row = PC + m0 * INC; if (tid < 128) { nq = row[h * 128 + tid]; nf = row[1024 + h * 128 + tid]; } nv = row[2048 + h * 128 + e]; }
        for (int t = 0; t < T; ++t) {
            const size_t m = m0 + t;
            if (tid < 128) { qs[tid] = siluf_(bf2f(nq)); fs[tid] = lb + (1.f - lb) * sigmoidf_(bf2f(nf)); }
            const float v = bf2f(nv);
            if (t + 1 < T) { const bf16* row = PC + (m + 1) * INC; if (tid < 128) { nq = row[h * 128 + tid]; nf = row[1024 + h * 128 + tid]; } nv = row[2048 + h * 128 + e]; }
            LDS_BARRIER();
            float op = 0.f;
#pragma unroll
            for (int i = 0; i < 32; ++i) { const float f = fs[d0 + i]; s[i] = f * s[i] + (1.f - f) * v; op += qs[d0 + i] * s[i]; }
            red[dg * 128 + e] = op;
            LDS_BARRIER();
            if (dg == 0) ORAW[m * D + h * 128 + e] = ((red[e] + red[128 + e]) + (red[256 + e] + red[384 + e])) * DK_SCALE;
        }
        float* So = c.out + (samp ? O_HGS : O_HGP) + ((size_t)(b * 8 + h) * 128 + d0) * 128 + e;
#pragma unroll
        for (int i = 0; i < 32; ++i) So[(size_t)i * 128] = s[i];
        __syncthreads();
        for (int t = wave; t < T; t += 8) { const size_t m = m0 + t;
            const float v0 = ORAW[m * D + h * 128 + lane], v1 = ORAW[m * D + h * 128 + 64 + lane];
            const float r = rsqrtf(wave_sum(v0 * v0 + v1 * v1) * (1.f / 128.f) + EPS);
            const float z0 = bf2f(PC[m * INC + 3072 + h * 128 + lane]), z1 = bf2f(PC[m * INC + 3072 + h * 128 + 64 + lane]);
            OC[m * D + h * 128 + lane] = (bf16)f2bf(v0 * r * gn[lane] * siluf_(z0));
            OC[m * D + h * 128 + 64 + lane] = (bf16)f2bf(v1 * r * gn[64 + lane] * siluf_(z1)); }
        __syncthreads();
    }
}

DEV bf16x8 ld8(const bf16* p) { return *(const bf16x8*)p; }
DEV void softmax_strip(f32x4 (&s)[4], float (&mrun)[4], float (&lrun)[4], float (&alpha)[4], bf16* Ps, int lane) {
#pragma unroll
    for (int r = 0; r < 4; ++r) {
        float mx = fmaxf(fmaxf(s[0][r], s[1][r]), fmaxf(s[2][r], s[3][r])); mx = grp16_max(mx);
        const float mn = fmaxf(mrun[r], mx);
        alpha[r] = __expf(mrun[r] - mn); mrun[r] = mn;
        float sum = 0.f;
#pragma unroll
        for (int nt = 0; nt < 4; ++nt) { const float p = __expf(s[nt][r] - mn); s[nt][r] = p; sum += p; }
        sum = grp16_sum(sum); lrun[r] = lrun[r] * alpha[r] + sum;
    }
#pragma unroll
    for (int nt = 0; nt < 4; ++nt)
#pragma unroll
        for (int r = 0; r < 4; ++r) Ps[((lane >> 4) * 4 + r) * 72 + nt * 16 + (lane & 15)] = (bf16)f2bf(s[nt][r]);
}
DEV void phase_attn_prompt(const Ctx& c) {
    bf16* Qs = (bf16*)c.lds;
    bf16* Ks = Qs + 128 * 104;
    bf16* Vt = Ks + 64 * 104;
    bf16* Psb = Vt + 64 * 72;
    const float* QH = c.w<float>(WS_QH); const bf16* KVP = c.w<bf16>(WS_KVP); const float* rope = c.w<float>(WS_ROPE); bf16* OCAT = c.w<bf16>(WS_OCAT);
    const float* kpe = c.out + O_KPEP;
    const int tid = c.tid, lane = c.lane, w = c.wave;
    bf16* Ps = Psb + w * 16 * 72;
    constexpr int NQB = SEQ / 128, NU = BATCH * 8 * NQB;
    for (int u = blockIdx.x; u < NU; u += gridDim.x) {
        const int qb = NQB - 1 - u / (BATCH * 8), bh = u % (BATCH * 8), b = bh >> 3, h = bh & 7;
        const int q0 = qb * 128; const size_t mb = (size_t)b * SEQ;
        __syncthreads();
        for (int idx = tid; idx < 128 * 80; idx += 512) {
            const int r = idx / 80, j = idx % 80; const float* qrow = QH + (mb + q0 + r) * 768 + h * 96;
            if (j < 64) Qs[r * 104 + j] = (bf16)f2bf(qrow[j] * MLA_SCALE);
            else { const int f = j - 64; const float* rt = rope + (size_t)(q0 + r) * 32; const float cs = rt[f], sn = rt[16 + f], x1 = qrow[64 + f], x2 = qrow[80 + f];
                Qs[r * 104 + 64 + f] = (bf16)f2bf((x1 * cs - x2 * sn) * MLA_SCALE); Qs[r * 104 + 80 + f] = (bf16)f2bf((x2 * cs + x1 * sn) * MLA_SCALE); }
        }
        __syncthreads();
        bf16x8 qf[3];
#pragma unroll
        for (int ks = 0; ks < 3; ++ks) qf[ks] = ld8(Qs + (w * 16 + (lane & 15)) * 104 + ks * 32 + 8 * (lane >> 4));
        float mrun[4], lrun[4], alpha[4]; f32x4 o[4];
#pragma unroll
        for (int r = 0; r < 4; ++r) { mrun[r] = -INFINITY; lrun[r] = 0.f; }
#pragma unroll
        for (int nt = 0; nt < 4; ++nt) o[nt] = (f32x4){0.f, 0.f, 0.f, 0.f};
        const int nkt = 2 * qb + 2;
        for (int kt = 0; kt < nkt; ++kt) {
            const int k0 = kt * 64;
            __syncthreads();
            for (int idx = tid; idx < 64 * 8; idx += 512) {
                const int key = idx >> 3, ch = idx & 7; *(u32x4*)(Ks + key * 104 + ch * 8) = *(const u32x4*)(KVP + (mb + k0 + key) * 1024 + h * 64 + ch * 8); }
            for (int idx = tid; idx < 64 * 32; idx += 512) { const int key = idx >> 5, f = idx & 31; Ks[key * 104 + 64 + f] = (bf16)f2bf(kpe[(mb + k0 + key) * 32 + f]); }
            for (int idx = tid; idx < 64 * 64; idx += 512) { const int key = idx >> 6, d = idx & 63; Vt[d * 72 + key] = KVP[(mb + k0 + key) * 1024 + 512 + h * 64 + d]; }
            __syncthreads();
            f32x4 s[4];
#pragma unroll
            for (int nt = 0; nt < 4; ++nt) { s[nt] = (f32x4){0.f, 0.f, 0.f, 0.f};
#pragma unroll
                for (int ks = 0; ks < 3; ++ks) s[nt] = mfma16(qf[ks], ld8(Ks + (nt * 16 + (lane & 15)) * 104 + ks * 32 + 8 * (lane >> 4)), s[nt]); }
            if (kt >= 2 * qb) {
#pragma unroll
                for (int nt = 0; nt < 4; ++nt)
#pragma unroll
                    for (int r = 0; r < 4; ++r) { const int qpos = q0 + w * 16 + (lane >> 4) * 4 + r, kpos = k0 + nt * 16 + (lane & 15); if (kpos > qpos) s[nt][r] = -INFINITY; }
            }
            softmax_strip(s, mrun, lrun, alpha, Ps, lane);
            WAVE_SYNC();
#pragma unroll
            for (int nt = 0; nt < 4; ++nt) {
#pragma unroll
                for (int r = 0; r < 4; ++r) o[nt][r] *= alpha[r];
#pragma unroll
                for (int k2 = 0; k2 < 2; ++k2) o[nt] = mfma16(ld8(Ps + (lane & 15) * 72 + k2 * 32 + 8 * (lane >> 4)), ld8(Vt + (nt * 16 + (lane & 15)) * 72 + k2 * 32 + 8 * (lane >> 4)), o[nt]); }
            WAVE_SYNC();
        }
#pragma unroll
        for (int nt = 0; nt < 4; ++nt)
#pragma unroll
            for (int r = 0; r < 4; ++r) OCAT[(mb + q0 + w * 16 + (lane >> 4) * 4 + r) * D + 512 + h * 64 + nt * 16 + (lane & 15)] = (bf16)f2bf(o[nt][r] / lrun[r]);
    }
}

DEV void phase_attn_sample(const Ctx& c) {
    bf16* Qs = (bf16*)c.lds;
    bf16* Ks = Qs + 64 * 296;
    bf16* Lt = Ks + 64 * 296;
    float* Sf = (float*)(Lt + 256 * 72);
    bf16* Psb = (bf16*)(Sf + 64 * 68);
    float* Of = (float*)Ks;
    const float* QH = c.w<float>(WS_QH); const float* rope = c.w<float>(WS_ROPE); bf16* OCAT = c.w<bf16>(WS_OCAT);
    const float* wuk = c.in<float>(21); const float* wuv = c.in<float>(22);
    const float* clat = c.in<float>(4); const float* ckr = c.in<float>(5); const int* ptab = c.in<int>(7);
    const int tid = c.tid, lane = c.lane, w = c.wave;
    bf16* Ps = Psb + w * 16 * 72;
    for (int b = blockIdx.x; b < DECB; b += gridDim.x) {
        const size_t mb = (size_t)MP + (size_t)b * DECS;
        __syncthreads();
        for (int idx = tid; idx < 64 * 64; idx += 512) { const int r = idx >> 6, d = idx & 63, t = r >> 3, h = r & 7; Sf[r * 68 + d] = QH[(mb + t) * 768 + h * 96 + d]; }
        for (int idx = tid; idx < 64 * 16; idx += 512) { const int r = idx >> 4, f = idx & 15, t = r >> 3, h = r & 7; const float* qrow = QH + (mb + t) * 768 + h * 96 + 64;
            const float* rt = rope + (size_t)(SEQ + t) * 32; const float cs = rt[f], sn = rt[16 + f], x1 = qrow[f], x2 = qrow[16 + f];
            Qs[r * 296 + 256 + f] = (bf16)f2bf((x1 * cs - x2 * sn) * MLA_SCALE); Qs[r * 296 + 272 + f] = (bf16)f2bf((x2 * cs + x1 * sn) * MLA_SCALE); }
        __syncthreads();
        {
            const int l = tid & 255, th = tid >> 8;
            for (int h = 0; h < 8; ++h) {
                float a0 = 0.f, a1 = 0.f, a2 = 0.f, a3 = 0.f; const float* wr = wuk + (size_t)l * 512 + h * 64;
                const float* q0 = Sf + ((th * 4 + 0) * 8 + h) * 68; const float* q1 = Sf + ((th * 4 + 1) * 8 + h) * 68; const float* q2 = Sf + ((th * 4 + 2) * 8 + h) * 68; const float* q3 = Sf + ((th * 4 + 3) * 8 + h) * 68;
#pragma unroll 4
                for (int d4 = 0; d4 < 16; ++d4) { const f32x4 wv = *(const f32x4*)(wr + 4 * d4);
#pragma unroll
                    for (int j = 0; j < 4; ++j) { a0 += q0[4 * d4 + j] * wv[j]; a1 += q1[4 * d4 + j] * wv[j]; a2 += q2[4 * d4 + j] * wv[j]; a3 += q3[4 * d4 + j] * wv[j]; } }
                Qs[((th * 4 + 0) * 8 + h) * 296 + l] = (bf16)f2bf(a0 * MLA_SCALE); Qs[((th * 4 + 1) * 8 + h) * 296 + l] = (bf16)f2bf(a1 * MLA_SCALE);
                Qs[((th * 4 + 2) * 8 + h) * 296 + l] = (bf16)f2bf(a2 * MLA_SCALE); Qs[((th * 4 + 3) * 8 + h) * 296 + l] = (bf16)f2bf(a3 * MLA_SCALE);
            }
        }
        __syncthreads();
        const int rt = w & 3, hh = w >> 2;
        bf16x8 qf[9];
#pragma unroll
        for (int ks = 0; ks < 9; ++ks) qf[ks] = ld8(Qs + (rt * 16 + (lane & 15)) * 296 + ks * 32 + 8 * (lane >> 4));
        float mrun[4], lrun[4], alpha[4]; f32x4 o[8];
#pragma unroll
        for (int r = 0; r < 4; ++r) { mrun[r] = -INFINITY; lrun[r] = 0.f; }
#pragma unroll
        for (int nt = 0; nt < 8; ++nt) o[nt] = (f32x4){0.f, 0.f, 0.f, 0.f};
        constexpr int NT = PAST / 64 + 1;
        for (int kt = 0; kt < NT; ++kt) {
            const bool fresh = kt == NT - 1;
            __syncthreads();
            if (!fresh) {
                const int k0 = kt * 64; const size_t rowbase = (size_t)ptab[b * NPAGES + (k0 >> 7)] * PAGE + (k0 & 127);
#pragma unroll 2
                for (int j = 0; j < 8; ++j) { const int idx = tid + 512 * j, key = idx >> 6, l4 = idx & 63;
                    const f32x4 v = *(const f32x4*)(clat + (rowbase + key) * 256 + 4 * l4);
                    u32x2 pk; pk.x = pk2(v[0], v[1]); pk.y = pk2(v[2], v[3]); *(u32x2*)(Ks + key * 296 + 4 * l4) = pk;
                    Lt[(4 * l4 + 0) * 72 + key] = (bf16)f2bf(v[0]); Lt[(4 * l4 + 1) * 72 + key] = (bf16)f2bf(v[1]); Lt[(4 * l4 + 2) * 72 + key] = (bf16)f2bf(v[2]); Lt[(4 * l4 + 3) * 72 + key] = (bf16)f2bf(v[3]); }
                { const int key = tid >> 3, i4 = tid & 7; const f32x4 v = *(const f32x4*)(ckr + (rowbase + key) * 32 + 4 * i4);
                    u32x2 pk; pk.x = pk2(v[0], v[1]); pk.y = pk2(v[2], v[3]); *(u32x2*)(Ks + key * 296 + 256 + 4 * i4) = pk; }
            } else {
                const float* nl = c.out + O_LATS + (size_t)b * DECS * 256; const float* nk = c.out + O_KPES + (size_t)b * DECS * 32;
                for (int idx = tid; idx < 64 * 256; idx += 512) { const int key = idx >> 8, l = idx & 255; const bf16 v = key < DECS ? (bf16)f2bf(nl[key * 256 + l]) : (bf16)0; Ks[key * 296 + l] = v; Lt[l * 72 + key] = v; }
                for (int idx = tid; idx < 64 * 32; idx += 512) { const int key = idx >> 5, f = idx & 31; Ks[key * 296 + 256 + f] = key < DECS ? (bf16)f2bf(nk[key * 32 + f]) : (bf16)0; }
            }
            __syncthreads();
#pragma unroll
            for (int n2 = 0; n2 < 2; ++n2) { const int nt = 2 * hh + n2; f32x4 s = (f32x4){0.f, 0.f, 0.f, 0.f};
#pragma unroll
                for (int ks = 0; ks < 9; ++ks) s = mfma16(qf[ks], ld8(Ks + (nt * 16 + (lane & 15)) * 296 + ks * 32 + 8 * (lane >> 4)), s);
#pragma unroll
                for (int r = 0; r < 4; ++r) { const int row = rt * 16 + (lane >> 4) * 4 + r, key = nt * 16 + (lane & 15); float v = s[r];
                    if (fresh && (key >= DECS || key > (row >> 3))) v = -INFINITY;
                    Sf[row * 68 + key] = v; } }
            __syncthreads();
            f32x4 s[4];
#pragma unroll
            for (int nt = 0; nt < 4; ++nt)
#pragma unroll
                for (int r = 0; r < 4; ++r) s[nt][r] = Sf[(rt * 16 + (lane >> 4) * 4 + r) * 68 + nt * 16 + (lane & 15)];
            softmax_strip(s, mrun, lrun, alpha, Ps, lane);
            WAVE_SYNC();
#pragma unroll
            for (int nt = 0; nt < 8; ++nt) {
#pragma unroll
                for (int r = 0; r < 4; ++r) o[nt][r] *= alpha[r];
#pragma unroll
                for (int k2 = 0; k2 < 2; ++k2) o[nt] = mfma16(ld8(Ps + (lane & 15) * 72 + k2 * 32 + 8 * (lane >> 4)), ld8(Lt + (hh * 128 + nt * 16 + (lane & 15)) * 72 + k2 * 32 + 8 * (lane >> 4)), o[nt]); }
            WAVE_SYNC();
        }
        __syncthreads();
#pragma unroll
        for (int nt = 0; nt < 8; ++nt)
#pragma unroll
            for (int r = 0; r < 4; ++r) Of[(rt * 16 + (lane >> 4) * 4 + r) * 260 + hh * 128 + nt * 16 + (lane & 15)] = o[nt][r] / lrun[r];
        __syncthreads();
        {
            const int d = tid & 63, h = tid >> 6; float a[8];
#pragma unroll
            for (int t = 0; t < 8; ++t) a[t] = 0.f;
            for (int l = 0; l < 256; ++l) { const float wv = wuv[(size_t)l * 512 + h * 64 + d];
#pragma unroll
                for (int t = 0; t < 8; ++t) a[t] += Of[(t * 8 + h) * 260 + l] * wv; }
#pragma unroll
            for (int t = 0; t < 8; ++t) OCAT[(mb + t) * D + 512 + h * 64 + d] = (bf16)f2bf(a[t]);
        }
    }
}

constexpr int NCH = SEQ / 64;
constexpr size_t HC_QG = WS_H, HC_BNT = HC_QG + (size_t)BATCH * 8 * NCH * 64 * 128 * 2,
    HC_A = HC_BNT + (size_t)BATCH * 8 * NCH * 128 * 128 * 2, HC_END = HC_A + (size_t)BATCH * 8 * NCH * 128 * 4;
constexpr size_t HC_SNT = WS_QH;
static_assert(HC_END <= WS_H_END && HC_SNT + (size_t)BATCH * 8 * NCH * 128 * 128 * 2 <= WS_OCAT, "hgrn scratch fits");
DEV u32x4 pack8(const float* v) { u32x4 o; o.x = pk2(v[0], v[1]); o.y = pk2(v[2], v[3]); o.z = pk2(v[4], v[5]); o.w = pk2(v[6], v[7]); return o; }

DEV void phase_hgrn_prep(const Ctx& c) {
    bf16* qt = (bf16*)c.lds;
    bf16* kt = qt + 64 * 136;
    bf16* vT = kt + 160 * 136;
    bf16* Ab = vT + 128 * 72;
    float* tot = (float*)(Ab + 64 * 72);
    bf16* kgl = (bf16*)(tot + 512);
    const bf16* PC = c.w<bf16>(WS_P1); float* ORAW = c.w<float>(WS_ORAW);
    bf16* QG = c.w<bf16>(HC_QG); bf16* BNT = c.w<bf16>(HC_BNT); float* Ag = c.w<float>(HC_A);
    const float* lbl = c.in<float>(25);
    const int tid = c.tid, lane = c.lane, w = c.wave;
    const int d = tid & 127, tq = tid >> 7;
    constexpr int NU = BATCH * 8 * NCH;
    bf16 rq[16], rf[16], rv[16];
#define HP_LOAD(u_) do { const int u__ = (u_); const int bh_ = u__ / NCH, n_ = u__ % NCH; const bf16* row_ = PC + ((size_t)(bh_ >> 3) * SEQ + (size_t)n_ * 64 + 16 * tq) * INC + (bh_ & 7) * 128 + d; \
        _Pragma("unroll") for (int i = 0; i < 16; ++i) { rq[i] = row_[(size_t)i * INC]; rf[i] = row_[(size_t)i * INC + 1024]; rv[i] = row_[(size_t)i * INC + 2048]; } } while (0)
    if ((int)blockIdx.x < NU) HP_LOAD(blockIdx.x);
    for (int u = blockIdx.x; u < NU; u += gridDim.x) {
        const int bh = u / NCH, n = u % NCH, b = bh >> 3, h = bh & 7;
        const size_t m0 = (size_t)b * SEQ + (size_t)n * 64;
        const float lb = sigmoidf_(lbl[1024 + h * 128 + d] - lbl[h * 128 + d]);
        float gcl[16], kk[16], qq[16], vv[16];
        float run = 0.f;
#pragma unroll
        for (int i = 0; i < 16; ++i) {
            const float f = lb + (1.f - lb) * sigmoidf_(bf2f(rf[i]));
            kk[i] = 1.f - f; run += __logf(f); gcl[i] = run;
            qq[i] = siluf_(bf2f(rq[i])) * DK_SCALE; vv[i] = bf2f(rv[i]);
        }
        if (u + (int)gridDim.x < NU) HP_LOAD(u + (int)gridDim.x);
        tot[tq * 128 + d] = run;
        { const u32x4 p0 = pack8(vv), p1 = pack8(vv + 8);
          *(u32x4*)(vT + d * 72 + 16 * tq) = p0; *(u32x4*)(vT + d * 72 + 16 * tq + 8) = p1; }
        for (int i = tid; i < 64 * 72 / 8; i += 512) { u32x4 z; z.x = z.y = z.z = z.w = 0u; *(u32x4*)(Ab + 8 * i) = z; }
        LDS_BARRIER();
        const float t0 = tot[d], t1 = tot[128 + d], t2 = tot[256 + d], t3 = tot[384 + d];
        const float rI[4] = {0.f, t0, t0 + t1, t0 + t1 + t2}; const float glast = (t0 + t1) + (t2 + t3);
        const float pre = tq == 0 ? rI[0] : (tq == 1 ? rI[1] : (tq == 2 ? rI[2] : rI[3]));
        float kg[16];
#pragma unroll
        for (int i = 0; i < 16; ++i) {
            const float gc = pre + gcl[i];
            qt[(16 * tq + i) * 136 + d] = (bf16)f2bf(qq[i] * __expf(gcl[i]));
            QG[((size_t)u * 64 + 16 * tq + i) * 128 + d] = (bf16)f2bf(qq[i] * __expf(gc));
            kg[i] = kk[i] * __expf(glast - gc);
#pragma unroll
            for (int I = 0; I < 4; ++I) if (I >= tq) { const int base = I == 0 ? 0 : (I == 1 ? 16 : (I == 2 ? 48 : 96));
                kt[(base + 16 * tq + i) * 136 + d] = (bf16)f2bf(kk[i] * __expf(rI[I] - gc)); }
        }
        { bf16* g = kgl + d * 72 + 16 * tq; *(u32x4*)g = pack8(kg); *(u32x4*)(g + 8) = pack8(kg + 8); }
        if (tq == 0) Ag[(size_t)u * 128 + d] = __expf(glast);
        LDS_BARRIER();
        for (int ti = w; ti < 10; ti += 8) {
            const int I = ti == 0 ? 0 : (ti < 3 ? 1 : (ti < 6 ? 2 : 3)); const int J = ti - (I == 0 ? 0 : (I == 1 ? 1 : (I == 2 ? 3 : 6)));
            const int base = I == 0 ? 0 : (I == 1 ? 16 : (I == 2 ? 48 : 96));
            f32x4 acc = (f32x4){0.f, 0.f, 0.f, 0.f};
#pragma unroll
            for (int ks = 0; ks < 4; ++ks) acc = mfma16(ld8(qt + (16 * I + (lane & 15)) * 136 + ks * 32 + 8 * (lane >> 4)), ld8(kt + (base + 16 * J + (lane & 15)) * 136 + ks * 32 + 8 * (lane >> 4)), acc);
#pragma unroll
            for (int r = 0; r < 4; ++r) { const int i = 16 * I + (lane >> 4) * 4 + r, j = 16 * J + (lane & 15); Ab[i * 72 + j] = (bf16)f2bf((J < I || j <= i) ? acc[r] : 0.f); }
        }
        LDS_BARRIER();
        { const int it = w & 3;
          f32x4 acc[4];
#pragma unroll
          for (int e4 = 0; e4 < 4; ++e4) acc[e4] = (f32x4){0.f, 0.f, 0.f, 0.f};
#pragma unroll
          for (int ks = 0; ks < 2; ++ks) { const bf16x8 af = ld8(Ab + (16 * it + (lane & 15)) * 72 + ks * 32 + 8 * (lane >> 4)); bf16x8 vf[4];
#pragma unroll
            for (int e4 = 0; e4 < 4; ++e4) vf[e4] = ld8(vT + (16 * ((w >> 2) * 4 + e4) + (lane & 15)) * 72 + ks * 32 + 8 * (lane >> 4));
#pragma unroll
            for (int e4 = 0; e4 < 4; ++e4) acc[e4] = mfma16(af, vf[e4], acc[e4]); }
#pragma unroll
          for (int e4 = 0; e4 < 4; ++e4) { const int et = (w >> 2) * 4 + e4;
#pragma unroll
            for (int r = 0; r < 4; ++r) ORAW[(m0 + 16 * it + (lane >> 4) * 4 + r) * D + h * 128 + 16 * et + (lane & 15)] = acc[e4][r]; } }
        {
            bf16x8 ka[2];
#pragma unroll
            for (int ks = 0; ks < 2; ++ks) ka[ks] = ld8(kgl + (16 * w + (lane & 15)) * 72 + ks * 32 + 8 * (lane >> 4));
            bf16* g = BNT + (size_t)u * 16384;
            f32x4 acc[8];
#pragma unroll
            for (int et = 0; et < 8; ++et) acc[et] = (f32x4){0.f, 0.f, 0.f, 0.f};
#pragma unroll
            for (int ks = 0; ks < 2; ++ks) { bf16x8 vf[8];
#pragma unroll
                for (int et = 0; et < 8; ++et) vf[et] = ld8(vT + (16 * et + (lane & 15)) * 72 + ks * 32 + 8 * (lane >> 4));
#pragma unroll
                for (int et = 0; et < 8; ++et) acc[et] = mfma16(ka[ks], vf[et], acc[et]); }
#pragma unroll
            for (int et = 0; et < 8; ++et) { u32x2 o; o.x = pk2(acc[et][0], acc[et][1]); o.y = pk2(acc[et][2], acc[et][3]); *(u32x2*)(g + (16 * et + (lane & 15)) * 128 + 16 * w + 4 * (lane >> 4)) = o; }
        }
        LDS_BARRIER();
    }
}

#undef HP_LOAD
DEV void phase_hgrn_prefix(const Ctx& c) {
    const bf16* BNT = c.w<bf16>(HC_BNT); const float* Ag = c.w<float>(HC_A); bf16* SNT = c.w<bf16>(HC_SNT);
    constexpr int NV = BATCH * 8 * 2048;
    for (int v = blockIdx.x * 512 + c.tid; v < NV; v += gridDim.x * 512) {
        const int bh = v >> 11, x8 = (v & 2047) * 8, d0 = x8 & 127, e = x8 >> 7;
        float S[8];
#pragma unroll
        for (int j = 0; j < 8; ++j) S[j] = 0.f;
        const size_t base = (size_t)bh * NCH * 16384 + x8;
        constexpr int PFD = NCH < 8 ? NCH : 8;
        u32x4 bq[PFD]; f32x4 aq0[PFD], aq1[PFD];
#pragma unroll
        for (int j = 0; j < PFD; ++j) { bq[j] = *(const u32x4*)(BNT + base + (size_t)j * 16384); aq0[j] = *(const f32x4*)(Ag + ((size_t)bh * NCH + j) * 128 + d0); aq1[j] = *(const f32x4*)(Ag + ((size_t)bh * NCH + j) * 128 + d0 + 4); }
#pragma unroll
        for (int n = 0; n < NCH; ++n) {
            const u32x4 bv = bq[n % PFD]; const f32x4 a0 = aq0[n % PFD], a1 = aq1[n % PFD];
            if (n + PFD < NCH) { bq[n % PFD] = *(const u32x4*)(BNT + base + (size_t)(n + PFD) * 16384); aq0[n % PFD] = *(const f32x4*)(Ag + ((size_t)bh * NCH + n + PFD) * 128 + d0); aq1[n % PFD] = *(const f32x4*)(Ag + ((size_t)bh * NCH + n + PFD) * 128 + d0 + 4); }
            *(u32x4*)(SNT + base + (size_t)n * 16384) = pack8(S);
            S[0] = a0[0] * S[0] + __uint_as_float(bv.x << 16); S[1] = a0[1] * S[1] + __uint_as_float(bv.x & 0xffff0000u);
            S[2] = a0[2] * S[2] + __uint_as_float(bv.y << 16); S[3] = a0[3] * S[3] + __uint_as_float(bv.y & 0xffff0000u);
            S[4] = a1[0] * S[4] + __uint_as_float(bv.z << 16); S[5] = a1[1] * S[5] + __uint_as_float(bv.z & 0xffff0000u);
            S[6] = a1[2] * S[6] + __uint_as_float(bv.w << 16); S[7] = a1[3] * S[7] + __uint_as_float(bv.w & 0xffff0000u);
        }
        float* So = c.out + O_HGP + (size_t)bh * 16384;
#pragma unroll
        for (int j = 0; j < 8; ++j) So[(size_t)(d0 + j) * 128 + e] = S[j];
    }
}

DEV void phase_hgrn_out(const Ctx& c) {
    bf16* qg = (bf16*)c.lds;
    bf16* StT = qg + 64 * 136;
    float* ob = (float*)(StT + 128 * 136);
    const bf16* PC = c.w<bf16>(WS_P1); const float* ORAW = c.w<float>(WS_ORAW); bf16* OC = c.w<bf16>(WS_OCAT);
    const bf16* QG = c.w<bf16>(HC_QG); const bf16* SNT = c.w<bf16>(HC_SNT);
    const float* gn = c.in<float>(26);
    const int tid = c.tid, lane = c.lane, w = c.wave;
    const float gn0 = gn[lane], gn1 = gn[64 + lane];
    constexpr int NU = BATCH * 8 * NCH;
    u32x4 pq[2], ps[4]; float or0n[8], or1n[8]; bf16 zz0n[8], zz1n[8];
#define HO_LOAD(u_) do { const int u__ = (u_); const int bh_ = u__ / NCH, n_ = u__ % NCH, b_ = bh_ >> 3, h_ = bh_ & 7; const size_t m0_ = (size_t)b_ * SEQ + (size_t)n_ * 64; \
        _Pragma("unroll") for (int j = 0; j < 2; ++j) pq[j] = *(const u32x4*)(QG + (size_t)u__ * 8192 + 8 * (tid + 512 * j)); \
        _Pragma("unroll") for (int j = 0; j < 4; ++j) ps[j] = *(const u32x4*)(SNT + (size_t)u__ * 16384 + 8 * (tid + 512 * j)); \
        _Pragma("unroll") for (int i8 = 0; i8 < 8; ++i8) { const size_t m = m0_ + w * 8 + i8; or0n[i8] = ORAW[m * D + h_ * 128 + lane]; or1n[i8] = ORAW[m * D + h_ * 128 + 64 + lane]; \
            zz0n[i8] = PC[m * INC + 3072 + h_ * 128 + lane]; zz1n[i8] = PC[m * INC + 3072 + h_ * 128 + 64 + lane]; } } while (0)
    if ((int)blockIdx.x < NU) HO_LOAD(blockIdx.x);
    for (int u = blockIdx.x; u < NU; u += gridDim.x) {
        const int bh = u / NCH, n = u % NCH, b = bh >> 3, h = bh & 7; const size_t m0 = (size_t)b * SEQ + (size_t)n * 64;
        float or0[8], or1[8], zz0[8], zz1[8];
#pragma unroll
        for (int i8 = 0; i8 < 8; ++i8) { or0[i8] = or0n[i8]; or1[i8] = or1n[i8]; zz0[i8] = bf2f(zz0n[i8]); zz1[i8] = bf2f(zz1n[i8]); }
        LDS_BARRIER();
#pragma unroll
        for (int j = 0; j < 2; ++j) { const int idx = tid + 512 * j; *(u32x4*)(qg + (idx >> 4) * 136 + (idx & 15) * 8) = pq[j]; }
#pragma unroll
        for (int j = 0; j < 4; ++j) { const int idx = tid + 512 * j; *(u32x4*)(StT + (idx >> 4) * 136 + (idx & 15) * 8) = ps[j]; }
        if (u + (int)gridDim.x < NU) HO_LOAD(u + (int)gridDim.x);
        LDS_BARRIER();
        { const int it = w & 3; bf16x8 qa[4];
#pragma unroll
          for (int ks = 0; ks < 4; ++ks) qa[ks] = ld8(qg + (16 * it + (lane & 15)) * 136 + ks * 32 + 8 * (lane >> 4));
          f32x4 acc[4];
#pragma unroll
          for (int e4 = 0; e4 < 4; ++e4) acc[e4] = (f32x4){0.f, 0.f, 0.f, 0.f};
#pragma unroll
          for (int ks = 0; ks < 4; ++ks) { bf16x8 bs[4];
#pragma unroll
            for (int e4 = 0; e4 < 4; ++e4) bs[e4] = ld8(StT + (16 * ((w >> 2) * 4 + e4) + (lane & 15)) * 136 + ks * 32 + 8 * (lane >> 4));
#pragma unroll
            for (int e4 = 0; e4 < 4; ++e4) acc[e4] = mfma16(qa[ks], bs[e4], acc[e4]); }
#pragma unroll
          for (int e4 = 0; e4 < 4; ++e4) { const int et = (w >> 2) * 4 + e4;
#pragma unroll
            for (int r = 0; r < 4; ++r) ob[(16 * it + (lane >> 4) * 4 + r) * 132 + 16 * et + (lane & 15)] = acc[e4][r]; } }
        LDS_BARRIER();
        { float ss[8];
#pragma unroll
          for (int i8 = 0; i8 < 8; ++i8) { const int i = w * 8 + i8; or0[i8] += ob[i * 132 + lane]; or1[i8] += ob[i * 132 + 64 + lane]; ss[i8] = or0[i8] * or0[i8] + or1[i8] * or1[i8]; }
#pragma unroll
              for (int i8 = 0; i8 < 8; ++i8) ss[i8] = wave_sum(ss[i8]);
#pragma unroll
          for (int i8 = 0; i8 < 8; ++i8) { const size_t m = m0 + w * 8 + i8; const float r = rsqrtf(ss[i8] * (1.f / 128.f) + EPS);
            OC[m * D + h * 128 + lane] = (bf16)f2bf(or0[i8] * r * gn0 * siluf_(zz0[i8])); OC[m * D + h * 128 + 64 + lane] = (bf16)f2bf(or1[i8] * r * gn1 * siluf_(zz1[i8])); } }
    }
}


constexpr int NUG = BATCH * 4 * NCH;
constexpr size_t GC_W = WS_H, GC_UT = GC_W + (size_t)NUG * 64 * 128 * 2, GC_QG = GC_UT + (size_t)NUG * 128 * 64 * 4, GC_KGT = GC_QG + (size_t)NUG * 64 * 128 * 2,
    GC_AQK = GC_KGT + (size_t)NUG * 128 * 64 * 2, GC_GL = GC_AQK + (size_t)NUG * 64 * 64 * 2, GC_END = GC_GL + (size_t)NUG * 4;
static_assert(GC_END <= WS_H_END, "gdn scratch fits in H");

DEV void phase_gdn_prep(const Ctx& c) {
    bf16* qb = (bf16*)c.lds;
    bf16* kb = qb + 64 * 136;
    float* Lm = (float*)(kb + 64 * 136);
    float* part = Lm + 64 * 68;
    float* gl = part + 256; float* gcs = gl + 64; float* bet = gcs + 64; float* eg = bet + 64; float* egl = eg + 64; float* qn = egl + 64; float* kn = qn + 64;
    float* sqb = kn + 64;
    const bf16* P1 = c.w<bf16>(WS_P1);
    bf16* Wg = c.w<bf16>(GC_W); float* UTg = c.w<float>(GC_UT); bf16* QGg = c.w<bf16>(GC_QG); bf16* KGTg = c.w<bf16>(GC_KGT); bf16* AQKg = c.w<bf16>(GC_AQK); float* GLg = c.w<float>(GC_GL);
    const float* convw = c.in<float>(14);
    const int tid = c.tid, lane = c.lane, w = c.wave;
    const int role = tid >> 7, cc = tid & 127;
    for (int u = blockIdx.x; u < NUG; u += gridDim.x) {
        const int bh = u / NCH, n = u % NCH, b = bh >> 2, h = bh & 3;
        const size_t m0 = (size_t)b * SEQ + (size_t)n * 64;
        float x[64];
        if (role < 3) {
            const int col = role * 512 + h * 128 + cc;
            const float w0 = convw[col], w1 = convw[QKV_A + col], w2 = convw[2 * QKV_A + col], w3 = convw[3 * QKV_A + col];
            const bf16* src = P1 + m0 * LD1 + col;
            float p0 = 0.f, p1 = 0.f, p2 = 0.f;
            if (n > 0) { p0 = bf2f(src[-3 * (long)LD1]); p1 = bf2f(src[-2 * (long)LD1]); p2 = bf2f(src[-1 * (long)LD1]); }
#pragma unroll
            for (int j = 0; j < 64; ++j) x[j] = bf2f(src[(size_t)j * LD1]);
#pragma unroll
            for (int j = 0; j < 64; ++j) { const float cur = x[j]; const float y = w0 * p0 + w1 * p1 + w2 * p2 + w3 * cur; x[j] = siluf_(y); p0 = p1; p1 = p2; p2 = cur; }
            if (role < 2) {
#pragma unroll
                for (int j4 = 0; j4 < 16; ++j4) *(f32x4*)(sqb + tid * 68 + 4 * j4) = (f32x4){x[4 * j4] * x[4 * j4], x[4 * j4 + 1] * x[4 * j4 + 1], x[4 * j4 + 2] * x[4 * j4 + 2], x[4 * j4 + 3] * x[4 * j4 + 3]};
            }
        } else if (cc < 64) {
            const float Aexp = __expf(c.in<float>(15)[h]), dtb = c.in<float>(16)[h];
            bet[cc] = sigmoidf_(bf2f(P1[(m0 + cc) * LD1 + C_B + h]));
            gl[cc] = -Aexp * softplusf_(bf2f(P1[(m0 + cc) * LD1 + C_A + h]) + dtb);
        }
        __syncthreads();
        if (role == 3) {
            if (cc < 64) { float acc = 0.f, totl = 0.f;
                for (int i = 0; i < 64; ++i) { const float g = gl[i]; totl += g; if (i <= cc) acc += g; }
                gcs[cc] = acc; eg[cc] = __expf(acc); egl[cc] = __expf(totl - acc);
                if (cc == 0) GLg[u] = __expf(totl);
            } else { const int j = cc - 64; float sq = 0.f, sk = 0.f;
#pragma unroll 16
                for (int cx = 0; cx < 128; ++cx) { sq += sqb[cx * 68 + j]; sk += sqb[(128 + cx) * 68 + j]; }
                qn[j] = rsqrtf(sq + EPS); kn[j] = rsqrtf(sk + EPS); }
        }
        __syncthreads();
        if (role == 0) {
#pragma unroll
            for (int j = 0; j < 64; ++j) { const float qh = x[j] * qn[j]; qb[j * 136 + cc] = (bf16)f2bf(qh); QGg[((size_t)u * 64 + j) * 128 + cc] = (bf16)f2bf(qh * DK_SCALE * eg[j]); }
        } else if (role == 1) {
            bf16* g = KGTg + ((size_t)u * 128 + cc) * 64;
#pragma unroll
            for (int j8 = 0; j8 < 8; ++j8) { float t[8];
#pragma unroll
                for (int q = 0; q < 8; ++q) { const int j = 8 * j8 + q; const float kh = x[j] * kn[j]; kb[j * 136 + cc] = (bf16)f2bf(kh); t[q] = kh * egl[j]; x[j] = kh * bet[j] * eg[j]; }
                *(u32x4*)(g + 8 * j8) = pack8(t); }
        } else if (role == 2) {
#pragma unroll
            for (int j = 0; j < 64; ++j) x[j] *= bet[j];
        }
        __syncthreads();
        for (int ti = w; ti < 32; ti += 8) {
            const bool isq = ti >= 16; const int I = (ti & 15) >> 2, J = ti & 3;
            if (J > I) { if (isq) {
#pragma unroll
                    for (int r = 0; r < 4; ++r) AQKg[((size_t)u * 64 + 16 * I + (lane >> 4) * 4 + r) * 64 + 16 * J + (lane & 15)] = (bf16)0; }
                continue; }
            const bf16* Ab = isq ? qb : kb;
            f32x4 acc = (f32x4){0.f, 0.f, 0.f, 0.f};
#pragma unroll
            for (int ks = 0; ks < 4; ++ks) acc = mfma16(ld8(Ab + (16 * I + (lane & 15)) * 136 + ks * 32 + 8 * (lane >> 4)), ld8(kb + (16 * J + (lane & 15)) * 136 + ks * 32 + 8 * (lane >> 4)), acc);
#pragma unroll
            for (int r = 0; r < 4; ++r) { const int i = 16 * I + (lane >> 4) * 4 + r, j = 16 * J + (lane & 15);
                const float dcy = __expf(fminf(gcs[i] - gcs[j], 0.f));
                if (isq) AQKg[((size_t)u * 64 + i) * 64 + j] = (bf16)f2bf(i >= j ? acc[r] * DK_SCALE * dcy : 0.f);
                else Lm[i * 68 + j] = i > j ? bet[i] * acc[r] * dcy : 0.f; }
        }
        __syncthreads();
        if (role == 1 || role == 2) {
#pragma unroll
            for (int i = 1; i < 64; ++i) { float acc = x[i];
#pragma unroll
                for (int j = 0; j < i; ++j) acc -= Lm[i * 68 + j] * x[j];
                x[i] = acc; }
            if (role == 1) {
#pragma unroll
                for (int i = 0; i < 64; ++i) Wg[((size_t)u * 64 + i) * 128 + cc] = (bf16)f2bf(x[i]);
            } else { float* g = UTg + ((size_t)u * 128 + cc) * 64;
#pragma unroll
                for (int i4 = 0; i4 < 16; ++i4) *(f32x4*)(g + 4 * i4) = (f32x4){x[4 * i4], x[4 * i4 + 1], x[4 * i4 + 2], x[4 * i4 + 3]}; }
        }
        __syncthreads();
    }
}

DEV void phase_gdn_scan(const Ctx& c, int u_first, int u_stride) {
    bf16* wl = (bf16*)c.lds;
    bf16* qgl = wl + 64 * 136;
    bf16* kgT = qgl + 64 * 136;
    bf16* aqk = kgT + 128 * 72;
    bf16* StT = aqk + 64 * 72;
    bf16* vnT = StT + 128 * 136;
    float* ob = (float*)(vnT + 128 * 72);
    const bf16* P1 = c.w<bf16>(WS_P1); bf16* OCAT = c.w<bf16>(WS_OCAT);
    const bf16* Wg = c.w<bf16>(GC_W); const float* UTg = c.w<float>(GC_UT); const bf16* QGg = c.w<bf16>(GC_QG); const bf16* KGTg = c.w<bf16>(GC_KGT); const bf16* AQKg = c.w<bf16>(GC_AQK); const float* GLg = c.w<float>(GC_GL);
    const float* gn = c.in<float>(17);
    const int tid = c.tid, lane = c.lane, w = c.wave;
    constexpr int NU = BATCH * 4;
    for (int u = u_first; u < NU; u += u_stride) {
        const int b = u >> 2, h = u & 3; const size_t mb = (size_t)b * SEQ;
        f32x4 S[8];
#pragma unroll
        for (int et = 0; et < 8; ++et) S[et] = (f32x4){0.f, 0.f, 0.f, 0.f};
        __syncthreads();
        for (int i = tid; i < 128 * 136 / 8; i += 512) { u32x4 z; z.x = z.y = z.z = z.w = 0u; *(u32x4*)(StT + 8 * i) = z; }
        u32x4 pw[2], pq[2], pk[2], pa;
        const size_t cu0 = (size_t)u * NCH;
#define GD_LOAD(n_) do { const bf16* g0 = Wg + (cu0 + (n_)) * 64 * 128; const bf16* g1 = QGg + (cu0 + (n_)) * 64 * 128; const bf16* g2 = KGTg + (cu0 + (n_)) * 128 * 64; const bf16* g3 = AQKg + (cu0 + (n_)) * 64 * 64; \
            _Pragma("unroll") for (int j = 0; j < 2; ++j) { const int idx = tid + 512 * j; pw[j] = *(const u32x4*)(g0 + 8 * idx); pq[j] = *(const u32x4*)(g1 + 8 * idx); pk[j] = *(const u32x4*)(g2 + 8 * idx); } \
            pa = *(const u32x4*)(g3 + 8 * tid); } while (0)
#define GD_STORE_WQ() do { _Pragma("unroll") for (int j = 0; j < 2; ++j) { const int idx = tid + 512 * j; *(u32x4*)(wl + (idx >> 4) * 136 + (idx & 15) * 8) = pw[j]; *(u32x4*)(qgl + (idx >> 4) * 136 + (idx & 15) * 8) = pq[j]; } } while (0)
#define GD_STORE_KA() do { _Pragma("unroll") for (int j = 0; j < 2; ++j) { const int idx = tid + 512 * j; *(u32x4*)(kgT + (idx >> 3) * 72 + (idx & 7) * 8) = pk[j]; } \
            *(u32x4*)(aqk + (tid >> 3) * 72 + (tid & 7) * 8) = pa; } while (0)
        GD_LOAD(0); GD_STORE_WQ(); GD_STORE_KA();
        __syncthreads();
        const int it = w & 3;
        const float gn0 = gn[lane], gn1 = gn[64 + lane];
        f32x4 u4[4]; float dec, decn;
#define GD_LOADU(dst, dd, n_) do { _Pragma("unroll") for (int e4 = 0; e4 < 4; ++e4) { const int et = (w >> 2) * 4 + e4; dst[e4] = *(const f32x4*)(UTg + ((cu0 + (n_)) * 128 + 16 * et + (lane & 15)) * 64 + 16 * it + 4 * (lane >> 4)); } dd = GLg[cu0 + (n_)]; } while (0)
        GD_LOADU(u4, decn, 0);
        for (int n = 0; n < NCH; ++n) {
            dec = decn;
            if (n + 1 < NCH) GD_LOAD(n + 1);
            f32x4 ao[4], av[4];
#pragma unroll
            for (int e4 = 0; e4 < 4; ++e4) { ao[e4] = (f32x4){0.f, 0.f, 0.f, 0.f}; av[e4] = (f32x4){0.f, 0.f, 0.f, 0.f}; }
#pragma unroll
            for (int ks = 0; ks < 4; ++ks) {
                const bf16x8 wa = ld8(wl + (16 * it + (lane & 15)) * 136 + ks * 32 + 8 * (lane >> 4)), qa = ld8(qgl + (16 * it + (lane & 15)) * 136 + ks * 32 + 8 * (lane >> 4));
                bf16x8 bs[4];
#pragma unroll
                for (int e4 = 0; e4 < 4; ++e4) bs[e4] = ld8(StT + (16 * ((w >> 2) * 4 + e4) + (lane & 15)) * 136 + ks * 32 + 8 * (lane >> 4));
#pragma unroll
                for (int e4 = 0; e4 < 4; ++e4) { av[e4] = mfma16(wa, bs[e4], av[e4]); ao[e4] = mfma16(qa, bs[e4], ao[e4]); }
            }
#pragma unroll
            for (int e4 = 0; e4 < 4; ++e4) { const int et = (w >> 2) * 4 + e4; const f32x4 vn = u4[e4] - av[e4];
                u32x2 o; o.x = pk2(vn[0], vn[1]); o.y = pk2(vn[2], vn[3]); *(u32x2*)(vnT + (16 * et + (lane & 15)) * 72 + 16 * it + 4 * (lane >> 4)) = o; }
            if (n + 1 < NCH) GD_LOADU(u4, decn, n + 1);
            LDS_BARRIER();
            float zz0[8], zz1[8];
#pragma unroll
            for (int i8 = 0; i8 < 8; ++i8) { const size_t m = mb + (size_t)n * 64 + w * 8 + i8; zz0[i8] = bf2f(P1[m * LD1 + C_Z + h * 128 + lane]); zz1[i8] = bf2f(P1[m * LD1 + C_Z + h * 128 + 64 + lane]); }
#pragma unroll
            for (int et = 0; et < 8; ++et) S[et] = S[et] * dec;
#pragma unroll
            for (int ks = 0; ks < 2; ++ks) {
                const bf16x8 aa = ld8(aqk + (16 * it + (lane & 15)) * 72 + ks * 32 + 8 * (lane >> 4)), ka = ld8(kgT + (16 * w + (lane & 15)) * 72 + ks * 32 + 8 * (lane >> 4));
                bf16x8 vf[8];
#pragma unroll
                for (int et = 0; et < 8; ++et) vf[et] = ld8(vnT + (16 * et + (lane & 15)) * 72 + ks * 32 + 8 * (lane >> 4));
#pragma unroll
                for (int e4 = 0; e4 < 4; ++e4) ao[e4] = mfma16(aa, (w >> 2) ? vf[4 + e4] : vf[e4], ao[e4]);
#pragma unroll
                for (int et = 0; et < 8; ++et) S[et] = mfma16(ka, vf[et], S[et]);
            }
#pragma unroll
            for (int e4 = 0; e4 < 4; ++e4) { const int et = (w >> 2) * 4 + e4;
#pragma unroll
                for (int r = 0; r < 4; ++r) ob[(16 * it + (lane >> 4) * 4 + r) * 132 + 16 * et + (lane & 15)] = ao[e4][r]; }
#pragma unroll
            for (int et = 0; et < 8; ++et) { u32x2 o; o.x = pk2(S[et][0], S[et][1]); o.y = pk2(S[et][2], S[et][3]); *(u32x2*)(StT + (16 * et + (lane & 15)) * 136 + 16 * w + (lane >> 4) * 4) = o; }
            if (n + 1 < NCH) GD_STORE_WQ();
            LDS_BARRIER();
            { float ss[8], v0[8], v1[8];
#pragma unroll
              for (int i8 = 0; i8 < 8; ++i8) { const int i = w * 8 + i8; v0[i8] = ob[i * 132 + lane]; v1[i8] = ob[i * 132 + 64 + lane]; ss[i8] = v0[i8] * v0[i8] + v1[i8] * v1[i8]; }
#pragma unroll
              for (int i8 = 0; i8 < 8; ++i8) ss[i8] = wave_sum(ss[i8]);
#pragma unroll
              for (int i8 = 0; i8 < 8; ++i8) { const size_t m = mb + (size_t)n * 64 + w * 8 + i8; const float r = rsqrtf(ss[i8] * (1.f / 128.f) + EPS);
                OCAT[m * D + h * 128 + lane] = (bf16)f2bf(v0[i8] * r * gn0 * siluf_(zz0[i8])); OCAT[m * D + h * 128 + 64 + lane] = (bf16)f2bf(v1[i8] * r * gn1 * siluf_(zz1[i8])); } }
            if (n + 1 < NCH) GD_STORE_KA();
        }
#undef GD_LOAD
#undef GD_LOADU
#undef GD_STORE_WQ
#undef GD_STORE_KA
        int lane3 = lane; OPAQUE_V(lane3);
        float* So = c.out + O_GDNP + (size_t)(b * 4 + h) * 16384;
#pragma unroll
        for (int et = 0; et < 8; ++et)
#pragma unroll
            for (int r = 0; r < 4; ++r) So[(size_t)(16 * w + (lane3 >> 4) * 4 + r) * 128 + 16 * et + (lane3 & 15)] = S[et][r];
    }
}


template <int NT> DEV void softmax_rows(f32x4 (&s)[NT], float (&mrun)[4], float (&lrun)[4], float (&alpha)[4], bf16* Ps, int pitch, int lane) {
#pragma unroll
    for (int r = 0; r < 4; ++r) {
        float mx = s[0][r];
#pragma unroll
        for (int nt = 1; nt < NT; ++nt) mx = fmaxf(mx, s[nt][r]);
        mx = grp16_max(mx);
        const float mn = fmaxf(mrun[r], mx);
        alpha[r] = exp2f_(mrun[r] - mn); mrun[r] = mn;
        float sum = 0.f;
#pragma unroll
        for (int nt = 0; nt < NT; ++nt) { const float p = exp2f_(s[nt][r] - mn); s[nt][r] = p; sum += p; }
        sum = grp16_sum(sum); lrun[r] = lrun[r] * alpha[r] + sum;
    }
#pragma unroll
    for (int nt = 0; nt < NT; ++nt)
#pragma unroll
        for (int r = 0; r < 4; ++r) Ps[((lane >> 4) * 4 + r) * pitch + nt * 16 + (lane & 15)] = (bf16)f2bf(s[nt][r]);
}
DEV bf16x8 ldB_tr(const bf16* T, int pitch, int k0, int n0, int lane) {
    const bf16* p = T + (size_t)(k0 + 8 * (lane >> 4) + ((lane & 15) >> 2)) * pitch + n0 + 4 * (lane & 3);
    const s16x4 a = lds_tr(p), b = lds_tr(p + 4 * pitch);
    bf16x8 r; r[0] = a[0]; r[1] = a[1]; r[2] = a[2]; r[3] = a[3]; r[4] = b[0]; r[5] = b[1]; r[6] = b[2]; r[7] = b[3]; return r;
}
constexpr int AS_NSP = 2;
DEV void phase_attn_sample2(const Ctx& c) {
    bf16* Qs = (bf16*)c.lds;
    bf16* Kt0 = Qs + 64 * 296;
    bf16* Psb = Kt0 + 2 * 32 * 296;
    bf16* qtmp = Kt0;
    float* Xo = (float*)c.lds;
    float* Xm = Xo + 64 * 256; float* Xl = Xm + 64;
    const float* QH = c.w<float>(WS_QH); const float* rope = c.w<float>(WS_ROPE); const bf16* WUKB = c.w<bf16>(WS_WUKB);
    float* PO = c.w<float>(WS_PO); float* PM = c.w<float>(WS_PM); float* PL = c.w<float>(WS_PL);
    const float* clat = c.in<float>(4); const float* ckr = c.in<float>(5); const int* ptab = c.in<int>(7);
    const int tid = c.tid, lane = c.lane, w = c.wave, grp = w >> 2, wq = w & 3, gt = tid & 255;
    bf16* Kt = Kt0 + grp * 32 * 296; bf16* Ps = Psb + w * 16 * 40;
    constexpr int NPT32 = PAST / 32, TPS = NPT32 / AS_NSP;
    static_assert(NPT32 % (2 * AS_NSP) == 0, "tiles per split must be even");
    for (int u = blockIdx.x; u < DECB * AS_NSP; u += gridDim.x) {
        const int b = u / AS_NSP, sp = u % AS_NSP; const size_t mb = (size_t)MP + (size_t)b * DECS;
        __syncthreads();
        for (int idx = tid; idx < 64 * 8; idx += 512) { const int r = idx >> 3, ch = idx & 7, t = r >> 3, h = r & 7; const float* q = QH + (mb + t) * 768 + h * 96 + ch * 8;
            const f32x4 a = *(const f32x4*)q, bq = *(const f32x4*)(q + 4); u32x4 o; o.x = pk2(a[0], a[1]); o.y = pk2(a[2], a[3]); o.z = pk2(bq[0], bq[1]); o.w = pk2(bq[2], bq[3]); *(u32x4*)(qtmp + r * 72 + ch * 8) = o; }
        for (int idx = tid; idx < 64 * 16; idx += 512) { const int r = idx >> 4, f = idx & 15, t = r >> 3, h = r & 7; const float* qrow = QH + (mb + t) * 768 + h * 96 + 64;
            const float* rt = rope + (size_t)(SEQ + t) * 32; const float cs = rt[f], sn = rt[16 + f], x1 = qrow[f], x2 = qrow[16 + f];
            Qs[r * 296 + 256 + f] = (bf16)f2bf((x1 * cs - x2 * sn) * QK_SCALE2); Qs[r * 296 + 272 + f] = (bf16)f2bf((x2 * cs + x1 * sn) * QK_SCALE2); }
        __syncthreads();
        {
            const int h = w; bf16x8 af[2];
#pragma unroll
            for (int ks = 0; ks < 2; ++ks) af[ks] = ld8(qtmp + (((lane & 7)) * 8 + h) * 72 + ks * 32 + 8 * (lane >> 4));
#pragma unroll 4
            for (int nt = 0; nt < 16; ++nt) { f32x4 acc = (f32x4){0.f, 0.f, 0.f, 0.f};
#pragma unroll
                for (int ks = 0; ks < 2; ++ks) acc = mfma16(af[ks], ld8(WUKB + (size_t)(nt * 16 + (lane & 15)) * 512 + h * 64 + ks * 32 + 8 * (lane >> 4)), acc);
                if ((lane >> 4) < 2) {
#pragma unroll
                    for (int r = 0; r < 4; ++r) Qs[(((lane >> 4) * 4 + r) * 8 + h) * 296 + nt * 16 + (lane & 15)] = (bf16)f2bf(acc[r] * QK_SCALE2); } }
        }
        __syncthreads();
        float mrun[4], lrun[4], alpha[4]; f32x4 o[16];
#pragma unroll
        for (int r = 0; r < 4; ++r) { mrun[r] = -INFINITY; lrun[r] = 0.f; }
#pragma unroll
        for (int nt = 0; nt < 16; ++nt) o[nt] = (f32x4){0.f, 0.f, 0.f, 0.f};
        const int t_begin = sp * TPS, t_end = t_begin + TPS + (sp == AS_NSP - 1 ? 1 : 0);
        const int NI = (t_end - t_begin + 1) / 2;
        static_assert(NPAGES <= 64, "page table of one batch row is held one entry per lane");
        const int ptv = lane < NPAGES ? ptab[b * NPAGES + lane] : 0;
#ifdef HIPEMU
#define PT_LOOKUP(pg_) __shfl(ptv, (pg_))
#else
#define PT_LOOKUP(pg_) __builtin_amdgcn_readlane(ptv, (pg_))
#endif
        f32x4 plA[8], prA, plB[8], prB;
        const float* nl = c.out + O_LATS + (size_t)b * DECS * 256; const float* nk = c.out + O_KPES + (size_t)b * DECS * 32;
#define AS_LOAD(pl, pr, tile_) do { const int tl_ = (tile_); \
            if (tl_ < NPT32) { const int k0_ = tl_ * 32; const size_t rb_ = (size_t)PT_LOOKUP(k0_ >> 7) * PAGE + (k0_ & 127); \
                _Pragma("unroll") for (int j = 0; j < 8; ++j) { const int idx = gt + 256 * j; pl[j] = *(const f32x4*)(clat + (rb_ + (idx >> 6)) * 256 + 4 * (idx & 63)); } \
                pr = *(const f32x4*)(ckr + (rb_ + (gt >> 3)) * 32 + 4 * (gt & 7)); } \
            else if (tl_ == NPT32) { \
                _Pragma("unroll") for (int j = 0; j < 8; ++j) { const int idx = gt + 256 * j, key = idx >> 6; pl[j] = key < DECS ? *(const f32x4*)(nl + key * 256 + 4 * (idx & 63)) : (f32x4){0.f, 0.f, 0.f, 0.f}; } \
                pr = (gt >> 3) < DECS ? *(const f32x4*)(nk + (gt >> 3) * 32 + 4 * (gt & 7)) : (f32x4){0.f, 0.f, 0.f, 0.f}; } } while (0)
#define AS_ITER(pl, pr, it_) do { \
            const int tile = t_begin + 2 * (it_) + grp; const bool valid = tile < t_end; \
            if (valid) { \
                _Pragma("unroll") for (int j = 0; j < 8; ++j) { const int idx = gt + 256 * j; u32x2 pk; pk.x = pk2(pl[j][0], pl[j][1]); pk.y = pk2(pl[j][2], pl[j][3]); *(u32x2*)(Kt + (idx >> 6) * 296 + 4 * (idx & 63)) = pk; } \
                { u32x2 pk; pk.x = pk2(pr[0], pr[1]); pk.y = pk2(pr[2], pr[3]); *(u32x2*)(Kt + (gt >> 3) * 296 + 256 + 4 * (gt & 7)) = pk; } \
            } \
            { const int nt_ = tile + 4; AS_LOAD(pl, pr, nt_ < t_end ? nt_ : NPT32 + 1); } \
            LDS_BARRIER(); \
            if (valid) { \
                f32x4 s[2], s2_[2]; \
                _Pragma("unroll") for (int nt = 0; nt < 2; ++nt) { s[nt] = (f32x4){0.f, 0.f, 0.f, 0.f}; s2_[nt] = (f32x4){0.f, 0.f, 0.f, 0.f}; } \
                _Pragma("unroll") for (int ks = 0; ks < 9; ++ks) {   \
                    const bf16x8 qa_ = ld8(Qs + (wq * 16 + (lane & 15)) * 296 + ks * 32 + 8 * (lane >> 4)); \
                    const bf16x8 k0_ = ld8(Kt + ((lane & 15)) * 296 + ks * 32 + 8 * (lane >> 4)), k1_ = ld8(Kt + (16 + (lane & 15)) * 296 + ks * 32 + 8 * (lane >> 4)); \
                    if (ks & 1) { s2_[0] = mfma16(qa_, k0_, s2_[0]); s2_[1] = mfma16(qa_, k1_, s2_[1]); } else { s[0] = mfma16(qa_, k0_, s[0]); s[1] = mfma16(qa_, k1_, s[1]); } } \
                s[0] += s2_[0]; s[1] += s2_[1]; \
                if (tile == NPT32) { \
                    _Pragma("unroll") for (int nt = 0; nt < 2; ++nt) \
                        _Pragma("unroll") for (int r = 0; r < 4; ++r) { const int row = wq * 16 + (lane >> 4) * 4 + r, key = nt * 16 + (lane & 15); if (key >= DECS || key > (row >> 3)) s[nt][r] = -INFINITY; } \
                } \
                softmax_rows<2>(s, mrun, lrun, alpha, Ps, 40, lane); \
                WAVE_SYNC(); \
                const bf16x8 pf = ld8(Ps + (lane & 15) * 40 + 8 * (lane >> 4)); \
                if (wave_any((alpha[0] != 1.f) | (alpha[1] != 1.f) | (alpha[2] != 1.f) | (alpha[3] != 1.f))) { \
                    _Pragma("unroll") for (int nt = 0; nt < 16; ++nt) \
                        _Pragma("unroll") for (int r = 0; r < 4; ++r) o[nt][r] *= alpha[r]; } \
                _Pragma("unroll") for (int nt = 0; nt < 16; ++nt) o[nt] = mfma16(pf, ldB_tr(Kt, 296, 0, nt * 16, lane), o[nt]); \
            } \
            LDS_BARRIER(); } while (0)
        AS_LOAD(plA, prA, t_begin + grp < t_end ? t_begin + grp : NPT32 + 1);
        AS_LOAD(plB, prB, t_begin + 2 + grp < t_end ? t_begin + 2 + grp : NPT32 + 1);
#pragma unroll 1
        for (int it = 0; it < NI; it += 2) {
            AS_ITER(plA, prA, it);
            if (it + 1 < NI) AS_ITER(plB, prB, it + 1);
        }
#undef AS_ITER
#undef PT_LOOKUP
#undef AS_LOAD
        int lane2 = lane; OPAQUE_V(lane2);
        if (grp == 1) {
#pragma unroll
            for (int nt = 0; nt < 16; ++nt)
#pragma unroll
                for (int r = 0; r < 4; ++r) Xo[(wq * 16 + (lane2 >> 4) * 4 + r) * 256 + nt * 16 + (lane2 & 15)] = o[nt][r];
            if ((lane2 & 15) == 0) {
#pragma unroll
                for (int r = 0; r < 4; ++r) { Xm[wq * 16 + (lane2 >> 4) * 4 + r] = mrun[r]; Xl[wq * 16 + (lane2 >> 4) * 4 + r] = lrun[r]; } }
        }
        __syncthreads();
        if (grp == 0) {
            float a1[4], a2[4];
#pragma unroll
            for (int r = 0; r < 4; ++r) { const int row = wq * 16 + (lane2 >> 4) * 4 + r; const float m2 = Xm[row], l2 = Xl[row]; const float mm = fmaxf(mrun[r], m2);
                a1[r] = exp2f_(mrun[r] - mm); a2[r] = exp2f_(m2 - mm); lrun[r] = lrun[r] * a1[r] + l2 * a2[r]; mrun[r] = mm;
                if ((lane2 & 15) == 0) { PM[(size_t)u * 64 + row] = mm; PL[(size_t)u * 64 + row] = lrun[r]; } }
#pragma unroll
            for (int nt = 0; nt < 16; ++nt)
#pragma unroll
                for (int r = 0; r < 4; ++r) { const int row = wq * 16 + (lane2 >> 4) * 4 + r, col = nt * 16 + (lane2 & 15); PO[((size_t)u * 64 + row) * 256 + col] = o[nt][r] * a1[r] + Xo[row * 256 + col] * a2[r]; }
        }
    }
}
DEV void phase_attn_sample_combine(const Ctx& c) {
    bf16* Ol = (bf16*)c.lds;
    const float* PO = c.w<float>(WS_PO); const float* PM = c.w<float>(WS_PM); const float* PL = c.w<float>(WS_PL);
    const bf16* WUV = c.w<bf16>(WS_WUKV) + (size_t)512 * 256; bf16* OCAT = c.w<bf16>(WS_OCAT);
    const int tid = c.tid, lane = c.lane, w = c.wave;
    for (int b = (int)gridDim.x - 1 - (int)blockIdx.x; b < DECB; b += gridDim.x) {
        const size_t mb = (size_t)MP + (size_t)b * DECS;
        __syncthreads();
        for (int idx = tid; idx < 64 * 64; idx += 512) { const int row = idx >> 6, c4 = idx & 63;
            float mm = -INFINITY;
#pragma unroll
            for (int s = 0; s < AS_NSP; ++s) mm = fmaxf(mm, PM[((size_t)b * AS_NSP + s) * 64 + row]);
            float lt = 0.f; f32x4 acc = (f32x4){0.f, 0.f, 0.f, 0.f};
#pragma unroll
            for (int s = 0; s < AS_NSP; ++s) { const size_t ur = ((size_t)b * AS_NSP + s) * 64 + row; const float a = exp2f_(PM[ur] - mm); lt += PL[ur] * a; acc += *(const f32x4*)(PO + ur * 256 + 4 * c4) * a; }
            const float inv = 1.f / lt; u32x2 o; o.x = pk2(acc[0] * inv, acc[1] * inv); o.y = pk2(acc[2] * inv, acc[3] * inv); *(u32x2*)(Ol + row * 264 + 4 * c4) = o; }
        __syncthreads();
        { const int h = w;
#pragma unroll
          for (int nt = 0; nt < 4; ++nt) { f32x4 acc = (f32x4){0.f, 0.f, 0.f, 0.f};
#pragma unroll
            for (int ks = 0; ks < 8; ++ks) acc = mfma16(ld8(Ol + ((lane & 7) * 8 + h) * 264 + ks * 32 + 8 * (lane >> 4)), ld8(WUV + (size_t)(h * 64 + nt * 16 + (lane & 15)) * 256 + ks * 32 + 8 * (lane >> 4)), acc);
            if ((lane >> 4) < 2) {
#pragma unroll
                for (int r = 0; r < 4; ++r) OCAT[(mb + (lane >> 4) * 4 + r) * D + 512 + h * 64 + nt * 16 + (lane & 15)] = (bf16)f2bf(acc[r]); } } }
    }
}

DEV bf16x8 cvt8(const f32x4 a, const f32x4 b, float sc) { bf16x8 r; const u32x4 p = {pk2(a[0] * sc, a[1] * sc), pk2(a[2] * sc, a[3] * sc), pk2(b[0] * sc, b[1] * sc), pk2(b[2] * sc, b[3] * sc)};
    r = __builtin_bit_cast(bf16x8, p); return r; }
DEV void phase_attn_prompt2(const Ctx& c, int qid = 0) {
    bf16* KV0 = (bf16*)c.lds;
    constexpr int KVB = 64 * 104 + 64 * 72;
    bf16* Psb = KV0 + 2 * KVB;
    const float* QH = c.w<float>(WS_QH); const bf16* KVP = c.w<bf16>(WS_KVP); const bf16* KPEB = c.w<bf16>(WS_KPEB); const float* rope = c.w<float>(WS_ROPE); bf16* OCAT = c.w<bf16>(WS_OCAT);
    const int tid = c.tid, lane = c.lane, w = c.wave;
    bf16* Ps = Psb + w * 32 * 72;
    constexpr int NQB = SEQ / 256, NPU = NQB * BATCH * 8;
    for (;;) {
        const int pu = queue_next(c, qid);
        if (pu >= NPU) break;
        const int qb = NQB - 1 - pu / (BATCH * 8), bh = pu % (BATCH * 8), b = bh >> 3, h = bh & 7; const size_t mb = (size_t)b * SEQ;
        {
            const int q0 = qb * 256, rmin = q0 + 32 * w;
            bf16x8 qf[2][3];
#pragma unroll
            for (int mt = 0; mt < 2; ++mt) { const int qr = rmin + 16 * mt + (lane & 15); const float* qrow = QH + (mb + qr) * 768 + h * 96; const int g = lane >> 4;
#pragma unroll
                for (int ks = 0; ks < 2; ++ks) qf[mt][ks] = cvt8(*(const f32x4*)(qrow + ks * 32 + 8 * g), *(const f32x4*)(qrow + ks * 32 + 8 * g + 4), QK_SCALE2);
                const int f0 = 8 * (g & 1); const float* rt = rope + (size_t)qr * 32;
                const f32x4 x1a = *(const f32x4*)(qrow + 64 + f0), x1b = *(const f32x4*)(qrow + 64 + f0 + 4), x2a = *(const f32x4*)(qrow + 80 + f0), x2b = *(const f32x4*)(qrow + 80 + f0 + 4);
                const f32x4 ca = *(const f32x4*)(rt + f0), cb = *(const f32x4*)(rt + f0 + 4), sa = *(const f32x4*)(rt + 16 + f0), sb = *(const f32x4*)(rt + 16 + f0 + 4);
                const f32x4 ya = g < 2 ? x1a * ca - x2a * sa : x2a * ca + x1a * sa, yb = g < 2 ? x1b * cb - x2b * sb : x2b * cb + x1b * sb;
                qf[mt][2] = cvt8(ya, yb, QK_SCALE2); }
            float mrun[2][4], lrun[2][4], alpha[2][4]; f32x4 o[2][4];
#pragma unroll
            for (int mt = 0; mt < 2; ++mt) {
#pragma unroll
                for (int r = 0; r < 4; ++r) { mrun[mt][r] = -INFINITY; lrun[mt][r] = 0.f; }
#pragma unroll
                for (int nt = 0; nt < 4; ++nt) o[mt][nt] = (f32x4){0.f, 0.f, 0.f, 0.f}; }
            const int nkt = 4 * qb + 4;
            u32x4 pk_, pp_, pv_;
#define AP_LOAD(kt_) do { const size_t kr_ = mb + (size_t)(kt_) * 64; \
                pk_ = *(const u32x4*)(KVP + (kr_ + (tid >> 3)) * 1024 + h * 64 + (tid & 7) * 8); \
                pv_ = *(const u32x4*)(KVP + (kr_ + (tid >> 3)) * 1024 + 512 + h * 64 + (tid & 7) * 8); \
                if (tid < 256) pp_ = *(const u32x4*)(KPEB + (kr_ + (tid >> 2)) * 32 + (tid & 3) * 8); } while (0)
#define AP_STORE(buf_) do { bf16* Kb_ = KV0 + (buf_) * KVB; bf16* Vb_ = Kb_ + 64 * 104; \
                *(u32x4*)(Kb_ + (tid >> 3) * 104 + (tid & 7) * 8) = pk_; *(u32x4*)(Vb_ + (tid >> 3) * 72 + (tid & 7) * 8) = pv_; \
                if (tid < 256) *(u32x4*)(Kb_ + (tid >> 2) * 104 + 64 + (tid & 3) * 8) = pp_; } while (0)
            __syncthreads();
            AP_LOAD(0); AP_STORE(0);
            if (nkt > 1) AP_LOAD(1);
            __syncthreads();
            for (int kt = 0; kt < nkt; ++kt) {
                const bf16* Ks = KV0 + (kt & 1) * KVB; const bf16* Vs = Ks + 64 * 104;
                if (kt + 1 < nkt) AP_STORE((kt + 1) & 1);
                if (kt + 2 < nkt) AP_LOAD(kt + 2);
                const int k0 = kt * 64;
                if (k0 <= rmin + 31) {
                    f32x4 s[2][4];
#pragma unroll
                    for (int nt = 0; nt < 4; ++nt) { s[0][nt] = (f32x4){0.f, 0.f, 0.f, 0.f}; s[1][nt] = (f32x4){0.f, 0.f, 0.f, 0.f}; }
#pragma unroll
                    for (int ks = 0; ks < 3; ++ks) {
                        bf16x8 kf[4];
#pragma unroll
                        for (int nt = 0; nt < 4; ++nt) kf[nt] = ld8(Ks + (nt * 16 + (lane & 15)) * 104 + ks * 32 + 8 * (lane >> 4));
#pragma unroll
                        for (int nt = 0; nt < 4; ++nt) { s[0][nt] = mfma16(qf[0][ks], kf[nt], s[0][nt]); s[1][nt] = mfma16(qf[1][ks], kf[nt], s[1][nt]); } }
                    if (k0 + 63 > rmin) {
#pragma unroll
                        for (int mt = 0; mt < 2; ++mt)
#pragma unroll
                            for (int nt = 0; nt < 4; ++nt)
#pragma unroll
                                for (int r = 0; r < 4; ++r) { const int qpos = rmin + 16 * mt + (lane >> 4) * 4 + r, kpos = k0 + nt * 16 + (lane & 15); if (kpos > qpos) s[mt][nt][r] = -INFINITY; }
                    }
                    softmax_rows<4>(s[0], mrun[0], lrun[0], alpha[0], Ps, 72, lane);
                    softmax_rows<4>(s[1], mrun[1], lrun[1], alpha[1], Ps + 16 * 72, 72, lane);
                    WAVE_SYNC();
                    if (wave_any((alpha[0][0] != 1.f) | (alpha[0][1] != 1.f) | (alpha[0][2] != 1.f) | (alpha[0][3] != 1.f) | (alpha[1][0] != 1.f) | (alpha[1][1] != 1.f) | (alpha[1][2] != 1.f) | (alpha[1][3] != 1.f))) {
#pragma unroll
                    for (int mt = 0; mt < 2; ++mt)
#pragma unroll
                        for (int nt = 0; nt < 4; ++nt)
#pragma unroll
                            for (int r = 0; r < 4; ++r) o[mt][nt][r] *= alpha[mt][r]; }
#pragma unroll
                    for (int k2 = 0; k2 < 2; ++k2) { const bf16x8 p0 = ld8(Ps + (lane & 15) * 72 + k2 * 32 + 8 * (lane >> 4)), p1 = ld8(Ps + (16 + (lane & 15)) * 72 + k2 * 32 + 8 * (lane >> 4));
                        bf16x8 vf[4];
#pragma unroll
                        for (int nt = 0; nt < 4; ++nt) vf[nt] = ldB_tr(Vs, 72, k2 * 32, nt * 16, lane);
#pragma unroll
                        for (int nt = 0; nt < 4; ++nt) { o[0][nt] = mfma16(p0, vf[nt], o[0][nt]); o[1][nt] = mfma16(p1, vf[nt], o[1][nt]); } }
                    WAVE_SYNC();
                }
                LDS_BARRIER();
            }
#undef AP_LOAD
#undef AP_STORE
#pragma unroll
            for (int mt = 0; mt < 2; ++mt)
#pragma unroll
                for (int nt = 0; nt < 4; ++nt)
#pragma unroll
                    for (int r = 0; r < 4; ++r) OCAT[(mb + rmin + 16 * mt + (lane >> 4) * 4 + r) * D + 512 + h * 64 + nt * 16 + (lane & 15)] = (bf16)f2bf(o[mt][nt][r] / lrun[mt][r]);
        }
    }
}

#ifndef HIPEMU
#define XB_TMO      128
#define XB_XCNT(j)  (256  + 64 * (j))
#define XB_XSUB(j)  (1280 + 64 * (j))
#define XB_XGEN(j)  (2304 + 64 * (j))
#define XB_TOP      3328
#define XB_TOPGEN   3392
#define XCD_BAR_WORDS 3456
#define XB_SPIN_CAP (1u << 22)
#define LAS __attribute__((address_space(3)))
__device__ __forceinline__ unsigned xb_ld(unsigned* p)              { return __hip_atomic_load(p, __ATOMIC_RELAXED, __HIP_MEMORY_SCOPE_AGENT); }
__device__ __forceinline__ unsigned xb_add(unsigned* p, unsigned v) { return __hip_atomic_fetch_add(p, v, __ATOMIC_RELAXED, __HIP_MEMORY_SCOPE_AGENT); }
__device__ __forceinline__ unsigned xb_xcc_id() { return (unsigned)__builtin_amdgcn_s_getreg((3 << 11) | 20) & 0xFu; }
#define XB_SPIN(cond, bar) do { unsigned _sp = 0; while (cond) { __builtin_amdgcn_s_sleep(1); \
    if ((++_sp & 255u) == 0u) { if (xb_ld(&(bar)[XB_TMO])) break; if (_sp > XB_SPIN_CAP) { atomicAdd(&(bar)[XB_TMO], 1u); break; } } } } while (0)
struct XcdBarrier { unsigned* bar; unsigned x; volatile LAS unsigned* st; bool t0; };
__device__ __forceinline__ XcdBarrier xcd_barrier_post(unsigned* bar, volatile LAS unsigned* st, bool t0) {
    XcdBarrier b; b.bar = bar; b.x = xb_xcc_id(); b.st = st; b.t0 = t0;
    if (t0) (void)xb_add(&bar[XB_XCNT(b.x)], 1u);
    return b;
}
__device__ __forceinline__ void xcd_barrier_complete(unsigned* bar, unsigned x, unsigned& nloc, unsigned& nx) {
    const unsigned G = gridDim.x * gridDim.y * gridDim.z;
    unsigned sum, cnt, mine, sp = 0u;
    for (;;) {
        sum = 0u; cnt = 0u; mine = 0u;
#pragma unroll
        for (unsigned j = 0; j < 16; ++j) { const unsigned c = xb_ld(&bar[XB_XCNT(j)]); sum += c; cnt += (c > 0u) ? 1u : 0u; mine = (j == x) ? c : mine; }
        if (sum == G) break;
        __builtin_amdgcn_s_sleep(1);
        if ((++sp & 255u) == 0u) { if (xb_ld(&bar[XB_TMO])) break; if (sp > XB_SPIN_CAP) { atomicAdd(&bar[XB_TMO], 1u); break; } }
    }
    nloc = mine > 0u ? mine : 1u; nx = cnt > 0u ? cnt : 1u;
}
__device__ __forceinline__ void xcd_barrier(const XcdBarrier& b) {
    asm volatile("s_waitcnt vmcnt(0)" ::: "memory");
    __syncthreads();
    if (b.t0) {
        unsigned* bar = b.bar;
        __builtin_amdgcn_s_waitcnt(0);
        unsigned nloc = b.st[0], nx = b.st[1];
        if (nloc == 0u) { xcd_barrier_complete(bar, b.x, nloc, nx); b.st[0] = nloc; b.st[1] = nx; }
        const unsigned old = xb_add(&bar[XB_XSUB(b.x)], 1u);
        const unsigned gen = old / nloc;
        if (old + 1u == (gen + 1u) * nloc) {
            __builtin_amdgcn_fence(__ATOMIC_RELEASE, "agent");
            asm volatile("s_waitcnt vmcnt(0)" ::: "memory");
            const unsigned og = xb_add(&bar[XB_TOP], 1u);
            const unsigned tg = og / nx;
            if (og + 1u == (tg + 1u) * nx) xb_add(&bar[XB_TOPGEN], 1u);
            else XB_SPIN(xb_ld(&bar[XB_TOPGEN]) == tg, bar);
            __builtin_amdgcn_fence(__ATOMIC_ACQUIRE, "agent");
            xb_add(&bar[XB_XGEN(b.x)], 1u);
            asm volatile("s_waitcnt vmcnt(0)" ::: "memory");
        } else {
            XB_SPIN(xb_ld(&bar[XB_XGEN(b.x)]) == gen, bar);
            __builtin_amdgcn_fence(__ATOMIC_ACQUIRE, "agent");
            asm volatile("s_waitcnt vmcnt(0)" ::: "memory");
        }
    }
    __syncthreads();
}
#endif

__global__ void __launch_bounds__(512, 2) mega_kernel(Params p) {
#ifdef HIPEMU
    unsigned char* lds = g_blk->smem;
#else
    extern __shared__ __attribute__((aligned(16))) unsigned char lds[];
#endif
    const int lo = p.ph_lo, hi = p.ph_hi;
#ifdef HIPEMU
    const int wave_s = threadIdx.x >> 6;
#define FRESH_LANE() ((int)(threadIdx.x & 63))
#define GRID_BAR(k) do { } while (0)
#else
    const int wave_s = __builtin_amdgcn_readfirstlane(threadIdx.x >> 6);
#define FRESH_LANE() ({ int l_; asm volatile("v_mbcnt_lo_u32_b32 %0, -1, 0\n\tv_mbcnt_hi_u32_b32 %0, -1, %0" : "=v"(l_)); l_; })
    { const int l0 = FRESH_LANE(); if (wave_s == 0) ((volatile LAS unsigned*)(lds + LDS_MISC))[l0] = 0u; }
    __syncthreads();
    if (hi - lo > 1) (void)xcd_barrier_post((unsigned*)(p.ws + WS_CTL), (volatile LAS unsigned*)(lds + LDS_MISC), wave_s == 0 && FRESH_LANE() == 0);
#define GRID_BAR(k) do { if (lo <= (k) && (k) + 1 < hi) { XcdBarrier bb_; bb_.bar = (unsigned*)(p.ws + WS_CTL); bb_.x = xb_xcc_id(); bb_.st = (volatile LAS unsigned*)(lds + LDS_MISC); bb_.t0 = (wave_s == 0 && FRESH_LANE() == 0); xcd_barrier(bb_); } } while (0)
#endif
#define MKCTX() Ctx c; c.p = &p; c.lds = lds; c.ws = p.ws; c.out = p.out; c.wave = wave_s; c.lane = FRESH_LANE(); c.tid = wave_s * 64 + c.lane; c.gw = blockIdx.x * 8 + wave_s; c.ngw = gridDim.x * 8;
#define IN(k) (lo <= (k) && (k) < hi)
#ifndef PROBE_MASK
#define PROBE_MASK 0u
#endif
#define NREP(k) (((PROBE_MASK >> (k)) & 1u) ? 2 : 1)
#ifndef PROBE_SUB
#define PROBE_SUB 0
#endif
#define SUB(id, ...) { MKCTX() __VA_ARGS__ } if (PROBE_SUB == (id)) { __syncthreads(); MKCTX() __VA_ARGS__ }
#define PHASE(k, ...) if (IN(k)) { { const int rep_ = 0; (void)rep_; MKCTX() __VA_ARGS__ } if (NREP(k) == 2) { const int rep_ = 1; (void)rep_; MKCTX() __VA_ARGS__ } }
#define X1 c.w<float>(WS_X1)
#define X2 c.w<float>(WS_X2)
#define P1 c.w<float>(WS_P1)
#define XN c.w<bf16>(WS_XN)
#define Hb c.w<bf16>(WS_H)
#define OCAT c.w<bf16>(WS_OCAT)

    PHASE(0,  phase_prologue(c); GRID_BAR(0); )
    PHASE(1,  run_gemm(c, XN, c.w<bf16>(WS_WINAB), M, LD1, D, EpiBf16<0>{c.w<bf16>(WS_P1), LD1}); GRID_BAR(1); )
    PHASE(2,  phase_prep0(c); GRID_BAR(2); )
    PHASE(3,          { run_gemm(c, c.w<bf16>(WS_CQN), c.w<bf16>(WS_WUQ), M, 768, 256, EpiStoreF32{c.w<float>(WS_QH), 768}); } { MKCTX() run_gemm(c, c.w<bf16>(WS_LATN), c.w<bf16>(WS_WUKV), MP, 1024, 256, EpiBf16<0>{c.w<bf16>(WS_KVP), 1024}); }         GRID_BAR(3); )
    PHASE(4,  { if ((blockIdx.x & 1) == 0) { MKCTX() phase_attn_sample2(c); } } __syncthreads(); { MKCTX() phase_gdn_prep(c); } __syncthreads();
               { if ((blockIdx.x & 1) != 0) { MKCTX() phase_attn_sample2(c); } } GRID_BAR(4); )
    PHASE(5,  SUB(4, phase_gdn_scan(c, blockIdx.x, gridDim.x);) __syncthreads(); SUB(5, phase_attn_sample_combine(c);) __syncthreads(); { MKCTX() phase_attn_prompt2(c, rep_ ? 6 : 0); } if (PROBE_SUB == 6) { __syncthreads(); MKCTX() phase_attn_prompt2(c, 5); } __syncthreads();
               SUB(9, const int NS_ = BATCH * 4; const int G_ = (int)gridDim.x; if (G_ > NS_ + 32) { if ((int)blockIdx.x >= NS_) { phase_gdn_naive(c, BATCH * 4, (int)blockIdx.x - NS_, G_ - NS_); } } else { phase_gdn_naive(c, BATCH * 4, (int)blockIdx.x, G_); }) __syncthreads();
               SUB(10, const int NS_ = BATCH * 4; const int G_ = (int)gridDim.x; if (G_ > NS_ + 32) { if ((int)blockIdx.x >= NS_) { phase_convert_late(c, c.gw - NS_ * 8, c.ngw - NS_ * 8); } } else { phase_convert_late(c, c.gw, c.ngw); }) GRID_BAR(5); )
    PHASE(6,  { run_gemm(c, OCAT, c.w<bf16>(WS_WOAB), MP, D, D, EpiResidF32{nullptr, c.in<float>(0), c.in<float>(1), X1}); } { MKCTX() run_gemm_sample_splitk(c, OCAT, c.w<bf16>(WS_WOAB), D, 256); } GRID_BAR(6); )
    PHASE(7,  phase_rmsnorm(c, X1, c.in<float>(9), nullptr, 4); GRID_BAR(7); )
    PHASE(8,  { run_gemm(c, XN, c.w<bf16>(WS_WUP0), M, FF, D, EpiBf16<1>{Hb, FF}); } __syncthreads();
               { MKCTX() const int NB_ = (M / 256 * (FF / 256)) % (int)gridDim.x, G_ = (int)gridDim.x;
                 if (NB_ > 0 && G_ - NB_ >= 32) { if ((int)blockIdx.x >= NB_) phase_convert_late2(c, c.gw - NB_ * 8, c.ngw - NB_ * 8); } else phase_convert_late2(c, c.gw, c.ngw); } GRID_BAR(8); )
    PHASE(9,  { run_gemm(c, Hb, c.w<bf16>(WS_WDN0), MP, D, FF, EpiResidF32{X1, nullptr, nullptr, X2}); } { MKCTX() run_gemm_sample_splitk(c, Hb, c.w<bf16>(WS_WDN0), FF, 256); } GRID_BAR(9); )
    PHASE(10,  phase_rmsnorm(c, X2, c.in<float>(8) + D, X1, 16); GRID_BAR(10); )
    PHASE(11,  run_gemm(c, XN, c.w<bf16>(WS_WINC), M, INC, D, EpiBf16<0>{c.w<bf16>(WS_P1), INC}); GRID_BAR(11); )
    PHASE(12,  SUB(7, phase_hgrn_prep(c);) GRID_BAR(12); )
    PHASE(13,  phase_hgrn_prefix(c); __syncthreads(); SUB(8, phase_hgrn_naive(c, BATCH * 8, (int)blockIdx.x, (int)gridDim.x);) GRID_BAR(13); )
    PHASE(14,  phase_hgrn_out(c); GRID_BAR(14); )
    PHASE(15,  { run_gemm(c, OCAT, c.w<bf16>(WS_WOC), MP, D, D, EpiResidF32{X2, nullptr, nullptr, X1}); } { MKCTX() run_gemm_sample_splitk(c, OCAT, c.w<bf16>(WS_WOC), D, 256); } GRID_BAR(15); )
    PHASE(16,  phase_rmsnorm(c, X1, c.in<float>(9) + D, X2, 4); GRID_BAR(16); )
    PHASE(17,  run_gemm(c, XN, c.w<bf16>(WS_WUP1), M, FF, D, EpiBf16<1>{Hb, FF}); GRID_BAR(17); )
    PHASE(18,  { run_gemm(c, Hb, c.w<bf16>(WS_WDN1), MP, D, FF, EpiResidF32{X1, nullptr, nullptr, X2}); } { MKCTX() run_gemm_sample_splitk(c, Hb, c.w<bf16>(WS_WDN1), FF, 256); } GRID_BAR(18); )
    PHASE(19,  phase_final(c, X2, c.in<float>(10), X1, 16); )
#undef IN
#undef X1
#undef X2
#undef P1
#undef XN
#undef Hb
#undef OCAT
}

#ifndef HIPEMU
extern "C" void kernel_launch(void* const* d_in, const int* in_sizes, int n_in, void* d_out, int out_size, void* d_ws, size_t ws_size, hipStream_t stream) {
    static int grid = 0;
    if (grid == 0) {
        if (n_in != 28 || (size_t)out_size != O_END || ws_size < WS_END) { fprintf(stderr, "kernel_launch: shape mismatch n_in %d out %d (want %zu) ws %zu (want %zu)\n", n_in, out_size, (size_t)O_END, ws_size, (size_t)WS_END); grid = -1; return; }
        int dev = 0, cus = 0, per_cu = 0;
        hipGetDevice(&dev); hipDeviceGetAttribute(&cus, hipDeviceAttributeMultiprocessorCount, dev);
        if (hipFuncSetAttribute((const void*)mega_kernel, hipFuncAttributeMaxDynamicSharedMemorySize, LDS_BYTES) != hipSuccess) { fprintf(stderr, "kernel_launch: hipFuncSetAttribute failed\n"); grid = -1; return; }
        if (hipOccupancyMaxActiveBlocksPerMultiprocessor(&per_cu, (const void*)mega_kernel, 512, LDS_BYTES) != hipSuccess || per_cu < 1) fprintf(stderr, "kernel_launch: occupancy query reports %d\n", per_cu);
        (void)hipGetLastError();
        grid = cus;
    }
    if (grid < 0) return;
    hipMemsetAsync((char*)d_ws + WS_CTL, 0, CTL_BYTES, stream);
    Params p{};
    for (int i = 0; i < 28; ++i) p.in[i] = d_in[i];
    p.out = (float*)d_out; p.ws = (unsigned char*)d_ws;
#if MK_N_LAUNCHES == 1
    p.ph_lo = 0; p.ph_hi = NPHASE;
    hipLaunchKernelGGL(mega_kernel, dim3(grid), dim3(512), LDS_BYTES, stream, p);
#else
    for (int k = 0; k < NPHASE; ++k) { p.ph_lo = k; p.ph_hi = k + 1; hipLaunchKernelGGL(mega_kernel, dim3(grid), dim3(512), LDS_BYTES, stream, p); }
#endif
}
#else
size_t emu_ws_bytes() { return WS_END; }
size_t emu_out_floats() { return O_END; }
void emu_forward(void* const* d_in, float* d_out, unsigned char* d_ws, int grid, int ph_from, int ph_to) {
    memset(d_ws + WS_CTL, 0, CTL_BYTES);
    Params p{};
    for (int i = 0; i < 28; ++i) p.in[i] = d_in[i];
    p.out = d_out; p.ws = d_ws;
    for (int k = ph_from; k < ph_to && k < NPHASE; ++k) { p.ph_lo = k; p.ph_hi = k + 1; fprintf(stderr, "[emu] phase %d\n", k); emu_launch(grid, 512, LDS_BYTES, [=]() { mega_kernel(p); }); }
}
struct EmuBuf { const char* name; size_t off; size_t bytes; int kind;   int ld; };
extern const EmuBuf emu_bufs[] = {
    {"P1", WS_P1, (size_t)M * 4096 * 4, 0, LD1}, {"XN", WS_XN, (size_t)M * D * 2, 1, D}, {"QH", WS_QH, (size_t)M * 768 * 4, 0, 768}, {"KVP", WS_KVP, (size_t)MP * 1024 * 2, 1, 1024},
    {"OCAT", WS_OCAT, (size_t)M * D * 2, 1, D}, {"ORAW", WS_ORAW, (size_t)M * D * 4, 0, D}, {"X1", WS_X1, (size_t)M * D * 4, 0, D}, {"X2", WS_X2, (size_t)M * D * 4, 0, D},
    {"H", WS_H, (size_t)M * FF * 2, 1, FF}, {"CQN", WS_CQN, (size_t)M * 256 * 2, 1, 256}, {"LATN", WS_LATN, (size_t)M * 256 * 2, 1, 256}, {nullptr, 0, 0, 0, 0}};
extern const int emu_cfg[8] = {BATCH, SEQ, DECB, PAST, MP, MS, MT, M};
#endif
```

```cpp
#ifdef HIPEMU
#include "hipemu.h"
#else
#include <hip/hip_runtime.h>
#endif
#include <cstdio>
#include <cstdint>

#ifndef CFG_BATCH
#define CFG_BATCH 8
#define CFG_SEQ 2048
#define CFG_DEC_BATCH 128
#define CFG_PAST_LEN 8192
#endif
#ifndef MK_N_LAUNCHES
#define MK_N_LAUNCHES 1
#endif

#define DEV __device__ __forceinline__
namespace pg8 {
#define PG8_LAS __attribute__((address_space(3)))
typedef unsigned short bf16_t;
typedef short bf16x8 __attribute__((ext_vector_type(8)));
typedef float f32x4 __attribute__((ext_vector_type(4)));
typedef unsigned u32x4 __attribute__((ext_vector_type(4)));
constexpr int BM = 256, BK = 64, HALF = 128, HTB = HALF * BK * 2  , STAGE_BYTES = 8 * HTB, NXCD = 8, WGM = 8;

__host__ __device__ __forceinline__ int lds_byte(int r, int c) { const int st = (r >> 4) * 2 + (c >> 5), rr = r & 15, cc = c & 31, ob = rr * 64 + cc * 2; return st * 1024 + (ob ^ (((ob >> 9) & 1) << 5)); }
__host__ __device__ __forceinline__ void stage_rc(int b, int& R, int& C) { const int st = b / 1024, sb = b % 1024, swz = sb ^ (((sb >> 9) & 1) << 5); R = (st >> 1) * 16 + swz / 64; C = (st & 1) * 32 + (swz % 64) / 2; }
__host__ __device__ __forceinline__ int perm32(int rho) { const int n = rho >> 4, i = rho & 15; return 8 * (i >> 2) + 4 * n + (i & 3); }

struct Unit { int pm, pn, kb; };
struct Gemm { const bf16_t* A; const bf16_t* Bt; int M, N, K, ld; };

struct StaticOrder {
    int nM, nN, nwg, G, c;
    __host__ __device__ void init(int M, int N, int G_, int c_) { nM = M / BM; nN = N / BM; nwg = nM * nN; G = G_; c = c_; }
    __host__ __device__ bool next(int i, Unit& u) const {
        const long L = (long)i * G + c; if (L >= nwg) return false;
        int wgid = (int)L; { const int q = nwg / NXCD, r = nwg % NXCD, xcd = wgid % NXCD, off = wgid / NXCD; wgid = (xcd < r ? xcd * (q + 1) : r * (q + 1) + (xcd - r) * q) + off; }
        const int nig = WGM * nN, gid = wgid / nig, fm = gid * WGM, gsz = (nM - fm) < WGM ? (nM - fm) : WGM;
        u.pm = fm + ((wgid % nig) % gsz); u.pn = (wgid % nig) / gsz; u.kb = 0; return true;
    }
    __device__ __forceinline__ void a_ready(const Unit&) const {}
    __device__ __forceinline__ void done(const Unit&) const {}
};

#ifndef HIPEMU
template <class Epi, class Sched, bool ALIGN_EPI = false, bool SP2 = false>
__device__ __forceinline__ void gemm_phase(PG8_LAS unsigned char* lds, const Gemm g, const Sched& S, const Epi& E, const int wid_in, const int lane_in) {
    const int wid = __builtin_amdgcn_readfirstlane(wid_in), lane = lane_in, tid = wid * 64 + lane, wr = wid >> 2, wc = wid & 3, fr = lane & 15, fq = lane >> 4;
    const int K = g.K, nt = K / BK, LDK = g.ld;
    unsigned voffA[2], voffB[2];
#pragma unroll
    for (int i = 0; i < 2; ++i) { int R, C; stage_rc(tid * 16 + i * 8192, R, C); const int Rb = Epi::PERM ? ((R & ~31) + perm32(R & 31)) : R;
        voffA[i] = (unsigned)(R * LDK + C) * 2u; voffB[i] = (unsigned)(Rb * LDK + C) * 2u; }
    const size_t kstep = (size_t)(BK * 2);
    const size_t hstep = (size_t)HALF * LDK * 2;
    const size_t tstep = 2 * hstep;
    const unsigned ldsw = (unsigned)wid * 1024u;
    const int aoff = lds_byte(wr * 64 + fr, fq * 8), boff = lds_byte(wc * 32 + fr, fq * 8);
#define PG8_SA(b, h) (((b) * 2 + (h)) * HTB)
#define PG8_SB(b, h) ((4 + (b) * 2 + (h)) * HTB)
#define PG8_STAGE(bufoff, gbase, voff) do { _Pragma("unroll") for (int _i = 0; _i < 2; ++_i) \
        __builtin_amdgcn_global_load_lds((const unsigned*)((const char*)(gbase) + (voff)[_i]), (PG8_LAS unsigned*)(lds + (bufoff) + ldsw + _i * 8192), 16, 0, 0); } while (0)
#define PG8_LDA(dst, b, h) do { _Pragma("unroll") for (int m = 0; m < 4; ++m) _Pragma("unroll") for (int k = 0; k < 2; ++k) dst[m][k] = *(const PG8_LAS bf16x8*)(lds + PG8_SA(b, h) + aoff + m * 2048 + k * 1024); } while (0)
#define PG8_LDB(dst, b, h) do { _Pragma("unroll") for (int n = 0; n < 2; ++n) _Pragma("unroll") for (int k = 0; k < 2; ++k) dst[n][k] = *(const PG8_LAS bf16x8*)(lds + PG8_SB(b, h) + boff + n * 2048 + k * 1024); } while (0)
#define PG8_MMA(ai, bj, At, Bt) do { __builtin_amdgcn_s_setprio(1); _Pragma("unroll") for (int m = 0; m < 4; ++m) _Pragma("unroll") for (int n = 0; n < 2; ++n) _Pragma("unroll") for (int k = 0; k < 2; ++k) \
        acc[ai][bj][m][n] = __builtin_amdgcn_mfma_f32_16x16x32_bf16(Bt[n][k], At[m][k], acc[ai][bj][m][n], 0, 0, 0); __builtin_amdgcn_s_setprio(0); } while (0)
#define PG8_WAIT_V(n) asm volatile("s_waitcnt vmcnt(" #n ")" ::: "memory")
#define PG8_WAIT_L(n) asm volatile("s_waitcnt lgkmcnt(" #n ")" ::: "memory")
#define PG8_BAR __builtin_amdgcn_s_barrier()
#define PG8_SCHED __builtin_amdgcn_sched_barrier(0)
    Unit cur, nxt; int ui = 0;
    if (!S.next(0, cur)) return;
    f32x4 acc[2][2][4][2];
#pragma unroll
    for (int a = 0; a < 2; ++a)
#pragma unroll
        for (int b = 0; b < 2; ++b)
#pragma unroll
            for (int m = 0; m < 4; ++m)
#pragma unroll
                for (int n = 0; n < 2; ++n) acc[a][b][m][n] = (f32x4){0.f, 0.f, 0.f, 0.f};
    bf16x8 At[4][2], B0[2][2], B1[2][2];
    const char* cA = (const char*)g.A + (size_t)cur.pm * tstep + (size_t)cur.kb * K * 2; const char* cB = (const char*)g.Bt + (size_t)cur.pn * tstep + (size_t)cur.kb * K * 2;
    S.a_ready(cur);
    if constexpr (SP2) {
        PG8_STAGE(PG8_SB(0, 0), cB, voffB); PG8_STAGE(PG8_SB(0, 1), cB + hstep, voffB); PG8_STAGE(PG8_SA(0, 0), cA, voffA); PG8_STAGE(PG8_SA(0, 1), cA + hstep, voffA);
        if (wr == 1) PG8_BAR;
        PG8_WAIT_V(2); PG8_BAR;
        PG8_STAGE(PG8_SB(1, 0), cB + kstep, voffB); PG8_STAGE(PG8_SA(1, 0), cA + kstep, voffA); PG8_STAGE(PG8_SB(1, 1), cB + hstep + kstep, voffB);
        PG8_WAIT_V(6); PG8_BAR;
    } else {
        PG8_STAGE(PG8_SB(0, 0), cB, voffB); PG8_STAGE(PG8_SA(0, 0), cA, voffA); PG8_STAGE(PG8_SB(0, 1), cB + hstep, voffB); PG8_STAGE(PG8_SA(0, 1), cA + hstep, voffA);
        if (wr == 1) PG8_BAR;
        PG8_WAIT_V(4); PG8_BAR;
        PG8_STAGE(PG8_SB(1, 0), cB + kstep, voffB); PG8_STAGE(PG8_SA(1, 0), cA + kstep, voffA); PG8_STAGE(PG8_SB(1, 1), cB + hstep + kstep, voffB);
        PG8_WAIT_V(6); PG8_BAR;
    }
    for (;;) {
        const bool has_next = S.next(ui + 1, nxt);
        const char* nA = has_next ? (const char*)g.A + (size_t)nxt.pm * tstep + (size_t)nxt.kb * K * 2 : cA; const char* nB = has_next ? (const char*)g.Bt + (size_t)nxt.pn * tstep + (size_t)nxt.kb * K * 2 : cB;
        for (int t = 0; t < nt; t += 2) {
            const bool last = (t == nt - 2);
            const char* a1 = cA + (size_t)(t + 1) * kstep;
            const char* a2 = last ? nA : cA + (size_t)(t + 2) * kstep; const char* b2 = last ? nB : cB + (size_t)(t + 2) * kstep;
            const char* a3 = a2 + kstep; const char* b3 = b2 + kstep;
            if (last && has_next) S.a_ready(nxt);
            if constexpr (SP2) {
            PG8_LDB(B0, 0, 0); PG8_LDB(B1, 0, 1); PG8_SCHED; PG8_LDA(At, 0, 0); PG8_STAGE(PG8_SA(1, 1), a1 + hstep, voffA);
            PG8_WAIT_V(8); PG8_WAIT_L(0); PG8_BAR; PG8_MMA(0, 0, At, B0); PG8_MMA(0, 1, At, B1); PG8_BAR; PG8_SCHED;
            PG8_LDA(At, 0, 1); PG8_STAGE(PG8_SB(0, 0), b2, voffB); PG8_STAGE(PG8_SB(0, 1), b2 + hstep, voffB); PG8_STAGE(PG8_SA(0, 0), a2, voffA);
            PG8_WAIT_V(8); PG8_WAIT_L(0); PG8_BAR; PG8_MMA(1, 0, At, B0); PG8_MMA(1, 1, At, B1); PG8_BAR; PG8_SCHED;
            PG8_LDB(B0, 1, 0); PG8_LDB(B1, 1, 1); PG8_SCHED; PG8_LDA(At, 1, 0); PG8_STAGE(PG8_SA(0, 1), a2 + hstep, voffA);
            PG8_WAIT_V(8); PG8_WAIT_L(0); PG8_BAR; PG8_MMA(0, 0, At, B0); PG8_MMA(0, 1, At, B1); PG8_BAR; PG8_SCHED;
            PG8_LDA(At, 1, 1); PG8_STAGE(PG8_SB(1, 0), b3, voffB); PG8_STAGE(PG8_SB(1, 1), b3 + hstep, voffB); PG8_STAGE(PG8_SA(1, 0), a3, voffA);
            PG8_WAIT_V(8); PG8_WAIT_L(0); PG8_BAR; PG8_MMA(1, 0, At, B0); PG8_MMA(1, 1, At, B1); PG8_BAR; PG8_SCHED;
            } else {
            PG8_LDB(B0, 0, 0); PG8_SCHED; PG8_LDA(At, 0, 0); PG8_STAGE(PG8_SA(1, 1), a1 + hstep, voffA);
            PG8_WAIT_L(8); PG8_BAR; PG8_WAIT_L(0); PG8_MMA(0, 0, At, B0); PG8_BAR; PG8_SCHED;
            PG8_LDB(B1, 0, 1); PG8_STAGE(PG8_SB(0, 0), b2, voffB);
            PG8_BAR; PG8_WAIT_L(0); PG8_MMA(0, 1, At, B1); PG8_BAR;
            PG8_LDA(At, 0, 1); PG8_STAGE(PG8_SA(0, 0), a2, voffA);
            PG8_BAR; PG8_WAIT_L(0); PG8_MMA(1, 0, At, B0); PG8_BAR; PG8_SCHED;
            PG8_STAGE(PG8_SB(0, 1), b2 + hstep, voffB);
            PG8_WAIT_V(6); PG8_BAR; PG8_MMA(1, 1, At, B1); PG8_BAR;
            PG8_LDB(B0, 1, 0); PG8_SCHED; PG8_LDA(At, 1, 0); PG8_STAGE(PG8_SA(0, 1), a2 + hstep, voffA);
            PG8_WAIT_L(8); PG8_BAR; PG8_WAIT_L(0); PG8_MMA(0, 0, At, B0); PG8_BAR; PG8_SCHED;
            PG8_LDB(B1, 1, 1); PG8_STAGE(PG8_SB(1, 0), b3, voffB);
            PG8_BAR; PG8_WAIT_L(0); PG8_MMA(0, 1, At, B1); PG8_BAR;
            PG8_LDA(At, 1, 1); PG8_STAGE(PG8_SA(1, 0), a3, voffA);
            PG8_BAR; PG8_WAIT_L(0); PG8_MMA(1, 0, At, B0); PG8_BAR; PG8_SCHED;
            PG8_STAGE(PG8_SB(1, 1), b3 + hstep, voffB);
            PG8_WAIT_V(6); PG8_BAR; PG8_MMA(1, 1, At, B1); PG8_BAR;
            }
        }
        if constexpr (ALIGN_EPI) { if (wr == 0) PG8_BAR; }
        if constexpr (!Epi::AFTER_DRAIN) { E(acc, cur, wr, wc, fr, fq); S.done(cur); }
        if (!has_next) break;
#pragma unroll
        for (int a = 0; a < 2; ++a)
#pragma unroll
            for (int b = 0; b < 2; ++b)
#pragma unroll
                for (int m = 0; m < 4; ++m)
#pragma unroll
                    for (int n = 0; n < 2; ++n) acc[a][b][m][n] = (f32x4){0.f, 0.f, 0.f, 0.f};
        cur = nxt; cA = nA; cB = nB; ++ui;
        if constexpr (ALIGN_EPI) { if (wr == 1) PG8_BAR; }
    }
    PG8_WAIT_V(0);
    if constexpr (!ALIGN_EPI) { if (wr == 0) PG8_BAR; }
    PG8_BAR;
    if constexpr (Epi::AFTER_DRAIN) { E.fused(acc, cur, wr, wc, fr, fq, lds, wid, lane); S.done(cur); }
#undef PG8_SA
#undef PG8_SB
#undef PG8_STAGE
#undef PG8_LDA
#undef PG8_LDB
#undef PG8_MMA
#undef PG8_WAIT_V
#undef PG8_WAIT_L
#undef PG8_BAR
#undef PG8_SCHED
}
}

#else
}
#endif

constexpr int D = 1024, BATCH = CFG_BATCH, SEQ = CFG_SEQ, DECB = CFG_DEC_BATCH, DECS = 8, PAST = CFG_PAST_LEN, PAGE = 128;
constexpr int MP = BATCH * SEQ, MS = DECB * DECS, MT = MP + MS, M = (MT + 255) / 256 * 256;
constexpr int NPAGES = PAST / PAGE;
constexpr int QKV_A = 1536, IN_AB = 2600, LD1 = 2816, FF = 4096, INC = 4096;
constexpr int C_Z = 1536, C_B = 2048, C_A = 2052, C_CQ = 2056, C_CKV = 2312, C_KPE = 2568;
constexpr float EPS = 1e-6f;
constexpr float MLA_SCALE = 0.10206207261596575f;
constexpr float DK_SCALE = 0.08838834764831845f;
static_assert(MP % 256 == 0 && SEQ % 128 == 0 && PAST % 128 == 0, "shape assumptions");

constexpr size_t O_YP = 0, O_YS = O_YP + (size_t)MP * D, O_GDNP = O_YS + (size_t)MS * D, O_CONVP = O_GDNP + (size_t)BATCH * 4 * 16384,
    O_LATP = O_CONVP + (size_t)BATCH * 3 * QKV_A, O_KPEP = O_LATP + (size_t)MP * 256, O_HGP = O_KPEP + (size_t)MP * 32,
    O_GDNS = O_HGP + (size_t)BATCH * 8 * 16384, O_CONVS = O_GDNS + (size_t)DECB * 4 * 16384, O_LATS = O_CONVS + (size_t)DECB * 3 * QKV_A,
    O_KPES = O_LATS + (size_t)MS * 256, O_HGS = O_KPES + (size_t)MS * 32, O_END = O_HGS + (size_t)DECB * 8 * 16384;

constexpr size_t al256(size_t x) { return (x + 255) & ~(size_t)255; }
constexpr size_t WS_CTL = 0, CTL_BYTES = 65536;
constexpr size_t WS_WINAB = CTL_BYTES,                      WS_WUP0 = WS_WINAB + (size_t)LD1 * D * 2,
    WS_WUP1 = WS_WUP0 + (size_t)FF * D * 2,                 WS_WDN0 = WS_WUP1 + (size_t)FF * D * 2,
    WS_WDN1 = WS_WDN0 + (size_t)FF * D * 2,                 WS_WINC = WS_WDN1 + (size_t)FF * D * 2,
    WS_WOAB = WS_WINC + (size_t)INC * D * 2,                WS_WOC = WS_WOAB + (size_t)D * D * 2,
    WS_WUQ = WS_WOC + (size_t)D * D * 2,                    WS_WUKV = WS_WUQ + (size_t)768 * 256 * 2,
    WS_ROPE = WS_WUKV + (size_t)1024 * 256 * 2,             WS_XN = al256(WS_ROPE + (size_t)(SEQ + 8) * 32 * 4),
    WS_P1 = WS_XN + (size_t)M * D * 2,                      WS_CQN = WS_P1 + (size_t)M * 4096 * 4,
    WS_LATN = WS_CQN + (size_t)M * 256 * 2,                 WS_QH = WS_LATN + (size_t)M * 256 * 2,
    WS_KVP = WS_QH + (size_t)M * 768 * 4,                   WS_OCAT = WS_KVP + (size_t)MP * 1024 * 2,
    WS_ORAW = WS_OCAT + (size_t)M * D * 2,                  WS_X1 = WS_ORAW + (size_t)M * D * 4,
    WS_X2 = WS_X1 + (size_t)M * D * 4,                      WS_H = WS_X2 + (size_t)M * D * 4,
    WS_WUKB = WS_H + (size_t)M * FF * 2,                    WS_PO = WS_WUKB + (size_t)256 * 512 * 2,
    WS_PM = WS_PO + (size_t)DECB * 2 * 64 * 256 * 4,        WS_PL = WS_PM + (size_t)DECB * 2 * 64 * 4,
    WS_KPEB = WS_PL + (size_t)DECB * 2 * 64 * 4,            WS_PART = al256(WS_KPEB + (size_t)MP * 32 * 2),
    WS_END = WS_PART + (size_t)16 * (M - MP) * D * 4;
constexpr size_t WS_H_END = WS_H + (size_t)M * FF * 2;

constexpr int LDS_BYTES = 155648;
constexpr int LDS_MISC = 155648 - 256;
constexpr int NPHASE = 20;

typedef unsigned short bf16;
typedef unsigned u32x4 __attribute__((ext_vector_type(4)));
typedef unsigned u32x2 __attribute__((ext_vector_type(2)));
#ifndef HIPEMU
typedef short bf16x8 __attribute__((ext_vector_type(8)));
typedef float f32x4 __attribute__((ext_vector_type(4)));
#endif

#ifdef HIPEMU
DEV unsigned f2bf(float f) { unsigned u = __float_as_uint(f); return (u + 0x7fffu + ((u >> 16) & 1u)) >> 16; }
#else
DEV unsigned f2bf(float f) { return (unsigned)__builtin_bit_cast(unsigned short, (__bf16)f); }
#endif
#ifdef HIPEMU
DEV unsigned pk2(float lo, float hi) { return f2bf(lo) | (f2bf(hi) << 16); }
#else
typedef float f32x2_t __attribute__((ext_vector_type(2))); typedef __bf16 bf16x2_t __attribute__((ext_vector_type(2)));
DEV unsigned pk2(float lo, float hi) { f32x2_t v = {lo, hi}; bf16x2_t b = __builtin_convertvector(v, bf16x2_t); return __builtin_bit_cast(unsigned, b); }
#endif
DEV float bf2f(bf16 b) { return __uint_as_float(((unsigned)b) << 16); }
DEV float sigmoidf_(float x) { return 1.0f / (1.0f + __expf(-x)); }
DEV float siluf_(float x) { return x / (1.0f + __expf(-x)); }
DEV float softplusf_(float x) { return fmaxf(x, 0.f) + log1pf(__expf(-fabsf(x))); }
#ifdef HIPEMU
DEV f32x4 mfma16(bf16x8 a, bf16x8 b, f32x4 c) { return emu_mfma16(a, b, c); }
#define WAVE_SYNC() emu_wave_sync()
#define OPAQUE_V(x) do { } while (0)
#define LDS_BARRIER() __syncthreads()
DEV s16x4 lds_tr(const unsigned short* p) { return emu_lds_tr((const void*)p); }
#else
typedef short s16x4 __attribute__((ext_vector_type(4)));
DEV s16x4 lds_tr(const unsigned short* p) { return __builtin_bit_cast(s16x4, __builtin_amdgcn_ds_read_tr16_b64_v4i16((__attribute__((address_space(3))) s16x4*)p)); }
DEV f32x4 mfma16(bf16x8 a, bf16x8 b, f32x4 c) { return __builtin_amdgcn_mfma_f32_16x16x32_bf16(a, b, c, 0, 0, 0); }
#define WAVE_SYNC() asm volatile("s_waitcnt lgkmcnt(0)" ::: "memory")
#define OPAQUE_V(x) asm volatile("" : "+v"(x))
#define LDS_BARRIER() asm volatile("s_waitcnt lgkmcnt(0)\n\ts_barrier" ::: "memory")
#endif
DEV f32x4 ld4bf(const unsigned short* p) { const u32x2 u = *(const u32x2*)p; return (f32x4){__uint_as_float(u.x << 16), __uint_as_float(u.x & 0xffff0000u), __uint_as_float(u.y << 16), __uint_as_float(u.y & 0xffff0000u)}; }
constexpr float QK_SCALE2 = MLA_SCALE * 1.4426950408889634f;
#ifdef HIPEMU
DEV float exp2f_(float x) { return exp2f(x); }
DEV bool wave_any(bool p) { int v = p ? 1 : 0;
    for (int o = 1; o < 64; o <<= 1) v |= __shfl_xor(v, o);
    return v != 0; }
#else
DEV float exp2f_(float x) { return __builtin_amdgcn_exp2f(x); }
DEV bool wave_any(bool p) { return __builtin_amdgcn_ballot_w64(p) != 0ull; }
#endif
#ifdef HIPEMU
DEV float wave_sum(float v) {
#pragma unroll
    for (int o = 1; o < 64; o <<= 1) v += __shfl_xor(v, o);
    return v;
}
DEV float grp16_max(float v) {
#pragma unroll
    for (int o = 1; o < 16; o <<= 1) v = fmaxf(v, __shfl_xor(v, o));
    return v;
}
DEV float grp16_sum(float v) {
#pragma unroll
    for (int o = 1; o < 16; o <<= 1) v += __shfl_xor(v, o);
    return v;
}
#else
template <int CTRL> DEV float dppf(float x) { return __builtin_bit_cast(float, __builtin_amdgcn_mov_dpp(__builtin_bit_cast(int, x), CTRL, 0xf, 0xf, true)); }
DEV float grp16_max(float v) { v = fmaxf(v, dppf<0xB1>(v)); v = fmaxf(v, dppf<0x4E>(v)); v = fmaxf(v, dppf<0x141>(v)); v = fmaxf(v, dppf<0x128>(v)); return v; }
DEV float grp16_sum(float v) { v += dppf<0xB1>(v); v += dppf<0x4E>(v); v += dppf<0x141>(v); v += dppf<0x128>(v); return v; }
DEV float wave_sum(float v) {
    v = grp16_sum(v);
    auto s = __builtin_amdgcn_permlane16_swap(__float_as_uint(v), __float_as_uint(v), false, false);
    v = __uint_as_float(s[0]) + __uint_as_float(s[1]);
    auto t = __builtin_amdgcn_permlane32_swap(__float_as_uint(v), __float_as_uint(v), false, false);
    return __uint_as_float(t[0]) + __uint_as_float(t[1]);
}
#endif

struct Params { const void* in[28]; float* out; unsigned char* ws; int ph_lo, ph_hi; };
struct Ctx {
    const Params* p; unsigned char* lds; unsigned char* ws; float* out;
    int tid, lane, wave, gw, ngw;
    template <class T> DEV const T* in(int i) const { return (const T*)p->in[i]; }
    template <class T> DEV T* w(size_t off) const { return (T*)(ws + off); }
};
DEV int queue_next(const Ctx& c, int q) {
    unsigned* cnt = (unsigned*)(c.ws + WS_CTL) + 4096 + 64 * q; volatile unsigned* slot = (volatile unsigned*)(c.lds + LDS_MISC + 128);
    __syncthreads();
    if (c.tid == 0) *slot = atomicAdd(cnt, 1u);
    __syncthreads();
    return (int)*slot;
}
DEV const float* xin_row(const Ctx& c, int m) { return m < MP ? c.in<float>(0) + (size_t)m * D : c.in<float>(1) + (size_t)(m - MP) * D; }

struct EpiStoreF32 {
    static constexpr bool PERM = false, AFTER_DRAIN = false;
    float* C; int ldc;
    DEV void operator()(const pg8::f32x4 (&acc)[2][2][4][2], const pg8::Unit& u, int wr, int wc, int fr, int fq) const {
        const int row0 = u.pm * 256 + wr * 64 + fr, col0 = u.pn * 256 + wc * 32 + 4 * fq;
#pragma unroll
        for (int ai = 0; ai < 2; ++ai)
#pragma unroll
            for (int m = 0; m < 4; ++m) { float* rowp = C + (size_t)(row0 + ai * 128 + m * 16) * ldc + col0;
#pragma unroll
                for (int bj = 0; bj < 2; ++bj)
#pragma unroll
                    for (int n = 0; n < 2; ++n) *(pg8::f32x4*)(rowp + bj * 128 + n * 16) = acc[ai][bj][m][n]; }
    }
};
struct EpiResidF32 {
    static constexpr bool PERM = false, AFTER_DRAIN = false;
    const float* base; const float* xp; const float* xs; float* out;
    DEV void operator()(const pg8::f32x4 (&acc)[2][2][4][2], const pg8::Unit& u, int wr, int wc, int fr, int fq) const {
        const int row0 = u.pm * 256 + wr * 64 + fr, col0 = u.pn * 256 + wc * 32 + 4 * fq;
#pragma unroll
        for (int ai = 0; ai < 2; ++ai)
#pragma unroll
            for (int m = 0; m < 4; ++m) { const int row = row0 + ai * 128 + m * 16;
                const float* rp = base ? base + (size_t)row * D : (row < MP ? xp + (size_t)row * D : xs + (size_t)(row - MP) * D);
                const bool ok = base != nullptr || row < MT;
                float* op = out + (size_t)row * D + col0;
#pragma unroll
                for (int bj = 0; bj < 2; ++bj)
#pragma unroll
                    for (int n = 0; n < 2; ++n) { pg8::f32x4 r = ok ? *(const pg8::f32x4*)(rp + col0 + bj * 128 + n * 16) : (pg8::f32x4){0.f, 0.f, 0.f, 0.f};
                        *(pg8::f32x4*)(op + bj * 128 + n * 16) = r + acc[ai][bj][m][n]; } }
    }
};
template <int ACT  > struct EpiBf16 {
    static constexpr bool PERM = true, AFTER_DRAIN = false;
    bf16* O; int ldc;
    DEV void operator()(const pg8::f32x4 (&acc)[2][2][4][2], const pg8::Unit& u, int wr, int wc, int fr, int fq) const {
        const int row0 = u.pm * 256 + wr * 64 + fr, col0 = u.pn * 256 + wc * 32 + 8 * fq;
#pragma unroll
        for (int ai = 0; ai < 2; ++ai)
#pragma unroll
            for (int m = 0; m < 4; ++m) { bf16* rowp = O + (size_t)(row0 + ai * 128 + m * 16) * ldc + col0;
#pragma unroll
                for (int bj = 0; bj < 2; ++bj) { pg8::f32x4 v0 = acc[ai][bj][m][0], v1 = acc[ai][bj][m][1];
                    if (ACT == 1) {
#pragma unroll
                        for (int j = 0; j < 4; ++j) { const float a = fmaxf(v0[j], 0.f), b = fmaxf(v1[j], 0.f); v0[j] = a * a; v1[j] = b * b; } }
                    u32x4 w; w.x = pk2(v0[0], v0[1]); w.y = pk2(v0[2], v0[3]); w.z = pk2(v1[0], v1[1]); w.w = pk2(v1[2], v1[3]);
                    *(u32x4*)(rowp + bj * 128) = w; } }
    }
};

struct SplitKOrder {
    int nM, nN, nS, pm0, G, c;
    DEV void init(int nM_, int nN_, int nS_, int pm0_, int G_, int c_) { nM = nM_; nN = nN_; nS = nS_; pm0 = pm0_; G = G_; c = c_; }
    DEV bool next(int i, pg8::Unit& u) const { const int L = i * G + c; if (L >= nM * nN * nS) return false; u.pm = pm0 + L % nM; const int r = L / nM; u.pn = r % nN; u.kb = r / nN; return true; }
    DEV void a_ready(const pg8::Unit&) const {}
    DEV void done(const pg8::Unit&) const {}
};
struct EpiPartF32 {
    static constexpr bool PERM = false, AFTER_DRAIN = false;
    float* P;
    DEV void operator()(const pg8::f32x4 (&acc)[2][2][4][2], const pg8::Unit& u, int wr, int wc, int fr, int fq) const {
        const int row0 = u.pm * 256 - MP + wr * 64 + fr, col0 = u.pn * 256 + wc * 32 + 4 * fq;
        float* base = P + (size_t)u.kb * (M - MP) * D;
#pragma unroll
        for (int ai = 0; ai < 2; ++ai)
#pragma unroll
            for (int m = 0; m < 4; ++m) { float* op = base + (size_t)(row0 + ai * 128 + m * 16) * D + col0;
#pragma unroll
                for (int bj = 0; bj < 2; ++bj)
#pragma unroll
                    for (int n = 0; n < 2; ++n) *(pg8::f32x4*)(op + bj * 128 + n * 16) = acc[ai][bj][m][n]; }
    }
};
template <class Epi, class Sched> DEV void run_gemm_s(const Ctx& c, const bf16* A, const bf16* Bt, int Mr, int N, int K, int ld, const Sched& S, const Epi& E) {
#ifndef HIPEMU
    asm volatile("" : "+s"(K));
    pg8::Gemm g{A, Bt, Mr, N, K, ld};
    pg8::gemm_phase<Epi, Sched, true, true>((PG8_LAS unsigned char*)c.lds, g, S, E, c.wave, c.lane);
#else
    const int wid = c.wave, lane = c.lane, wr = wid >> 2, wc = wid & 3, fr = lane & 15, fq = lane >> 4;
    pg8::Unit u;
    for (int ui = 0; S.next(ui, u); ++ui) {
        pg8::f32x4 acc[2][2][4][2];
        for (int ai = 0; ai < 2; ++ai) for (int bj = 0; bj < 2; ++bj) for (int m = 0; m < 4; ++m) for (int n = 0; n < 2; ++n) for (int j = 0; j < 4; ++j) {
            const int row = 256 * u.pm + 128 * ai + 64 * wr + 16 * m + fr;
            const int col = Epi::PERM ? 256 * u.pn + 128 * bj + 32 * wc + 8 * fq + 4 * n + j : 256 * u.pn + 128 * bj + 32 * wc + 16 * n + 4 * fq + j;
            const bf16* a = A + (size_t)row * ld + (size_t)u.kb * K; const bf16* b = Bt + (size_t)col * ld + (size_t)u.kb * K; float s = 0.f;
            for (int k = 0; k < K; ++k) s += bf2f(a[k]) * bf2f(b[k]);
            acc[ai][bj][m][n][j] = s; }
        E(acc, u, wr, wc, fr, fq);
    }
#endif
}
template <class Epi> DEV void run_gemm(const Ctx& c, const bf16* A, const bf16* Bt, int Mr, int N, int K, const Epi& E) {
    pg8::StaticOrder S; S.init(Mr, N, (int)gridDim.x, (int)blockIdx.x);
    run_gemm_s(c, A, Bt, Mr, N, K, K, S, E);
}
DEV void run_gemm_sample_splitk(const Ctx& c, const bf16* A, const bf16* Bt, int K, int KS) {
    SplitKOrder S; S.init((M - MP) / 256, D / 256, K / KS, MP / 256, (int)gridDim.x, (int)((blockIdx.x + 128) % gridDim.x));
    run_gemm_s(c, A, Bt, M, D, KS, K, S, EpiPartF32{c.w<float>(WS_PART)});
}

DEV void transpose_item(const float* W, int K, int N, bf16* WT, float* scr, int item, int nblk, int lane) {
    const int kb = item / nblk, nb = item % nblk, k0 = 64 * kb, n0 = 32 * nb;
    const int nn = n0 + (lane & 31);
    float tv[32];
#pragma unroll
    for (int i = 0; i < 32; ++i) { const int kk = 2 * i + (lane >> 5); tv[i] = nn < N ? W[(size_t)(k0 + kk) * N + nn] : 0.f; }
#pragma unroll
    for (int i = 0; i < 32; ++i) { const int kk = 2 * i + (lane >> 5); scr[kk * 33 + (lane & 31)] = tv[i]; }
    WAVE_SYNC();
    const int cq = lane & 7;
#pragma unroll
    for (int j = 0; j < 4; ++j) { const int n = (lane >> 3) + 8 * j; const float* s = scr + (8 * cq) * 33 + n;
        u32x4 o; o.x = pk2(s[0 * 33], s[1 * 33]); o.y = pk2(s[2 * 33], s[3 * 33]); o.z = pk2(s[4 * 33], s[5 * 33]); o.w = pk2(s[6 * 33], s[7 * 33]);
        *(u32x4*)(WT + (size_t)(n0 + n) * K + k0 + 8 * cq) = o; }
    WAVE_SYNC();
}
DEV void rms_row_to_bf16(const float* xrow, const float* gain, bf16* orow, int lane) {
    f32x4 v[4]; float s = 0.f;
#pragma unroll
    for (int j = 0; j < 4; ++j) { v[j] = *(const f32x4*)(xrow + 4 * lane + 256 * j); s += (v[j][0] * v[j][0] + v[j][1] * v[j][1]) + (v[j][2] * v[j][2] + v[j][3] * v[j][3]); }
    const float rstd = rsqrtf(wave_sum(s) * (1.f / D) + EPS);
#pragma unroll
    for (int j = 0; j < 4; ++j) { const f32x4 g = *(const f32x4*)(gain + 4 * lane + 256 * j);
        u32x2 o; o.x = pk2(v[j][0] * rstd * g[0], v[j][1] * rstd * g[1]); o.y = pk2(v[j][2] * rstd * g[2], v[j][3] * rstd * g[3]);
        *(u32x2*)(orow + 4 * lane + 256 * j) = o; }
}
DEV void zero_row_bf16(bf16* orow, int lane) {
#pragma unroll
    for (int j = 0; j < 4; ++j) { u32x2 o; o.x = 0u; o.y = 0u; *(u32x2*)(orow + 4 * lane + 256 * j) = o; }
}
#define TJOB(Wp, K_, N_, Npad_, wt_) do { const int nblk = (Npad_) / 32, nitems = ((K_) / 64) * nblk; bf16* WT = c.w<bf16>(wt_); const float* Wsrc = (Wp); \
        for (int it = gw0; it < nitems; it += ngw0) transpose_item(Wsrc, (K_), (N_), WT, scr, it, nblk, c.lane); } while (0)
DEV void phase_convert_late(const Ctx& c, int gw0, int ngw0) {
    float* scr = (float*)(c.lds + c.wave * 8704);
    TJOB(c.in<float>(23), D, D, D, WS_WOAB);
    TJOB(c.in<float>(11), D, FF, FF, WS_WUP0);
    TJOB(c.in<float>(12), FF, D, D, WS_WDN0);
}
DEV void phase_convert_late2(const Ctx& c, int gw0, int ngw0) {
    float* scr = (float*)(c.lds + c.wave * 8704);
    TJOB(c.in<float>(24), D, INC, INC, WS_WINC);
    TJOB(c.in<float>(27), D, D, D, WS_WOC);
    TJOB(c.in<float>(11) + (size_t)D * FF, D, FF, FF, WS_WUP1);
    TJOB(c.in<float>(12) + (size_t)D * FF, FF, D, D, WS_WDN1);
}
DEV void phase_prologue(const Ctx& c) {
    float* scr = (float*)(c.lds + c.wave * 8704);
    const int gw0 = c.gw, ngw0 = c.ngw;
    TJOB(c.in<float>(13), D, IN_AB, LD1, WS_WINAB);
    TJOB(c.in<float>(19), 256, 768, 768, WS_WUQ);
    TJOB(c.in<float>(21), 256, 512, 512, WS_WUKV); TJOB(c.in<float>(22), 256, 512, 512, WS_WUKV + (size_t)512 * 256 * 2);
#undef TJOB
    {
        const float* src = c.in<float>(21); bf16* dst = c.w<bf16>(WS_WUKB);
        for (int i = blockIdx.x * 512 + c.tid; i < 256 * 512 / 4; i += gridDim.x * 512) { const f32x4 v = *(const f32x4*)(src + 4 * i); u32x2 o; o.x = pk2(v[0], v[1]); o.y = pk2(v[2], v[3]); *(u32x2*)(dst + 4 * i) = o; }
    }
    float* rope = c.w<float>(WS_ROPE);
    for (int i = blockIdx.x * 512 + c.tid; i < (SEQ + 8) * 16; i += gridDim.x * 512) {
        const int e = i >> 4, f = i & 15; const double pos = e < SEQ ? (double)e : (double)(PAST + e - SEQ);
        const double ang = pos * pow(10000.0, -(double)f / 16.0);
        rope[e * 32 + f] = (float)cos(ang); rope[e * 32 + 16 + f] = (float)sin(ang);
    }
    bf16* XN = c.w<bf16>(WS_XN);
    for (int m = c.gw; m < M; m += c.ngw) {
        if (m < MT) rms_row_to_bf16(xin_row(c, m), c.in<float>(8), XN + (size_t)m * D, c.lane); else zero_row_bf16(XN + (size_t)m * D, c.lane);
    }
}
DEV void sample_row_sum(const Ctx& c, int m, const float* X_res, int nsp, f32x4 (&v)[4]) {
    const int lane = c.lane; const float* P = c.w<float>(WS_PART) + (size_t)(m - MP) * D;
#pragma unroll
    for (int j = 0; j < 4; ++j) {
        if (X_res) v[j] = *(const f32x4*)(X_res + (size_t)m * D + 4 * lane + 256 * j);
        else v[j] = m < MT ? *(const f32x4*)(c.in<float>(1) + (size_t)(m - MP) * D + 4 * lane + 256 * j) : (f32x4){0.f, 0.f, 0.f, 0.f}; }
    for (int s = 0; s < nsp; ++s) {
#pragma unroll
        for (int j = 0; j < 4; ++j) v[j] += *(const f32x4*)(P + (size_t)s * (M - MP) * D + 4 * lane + 256 * j); }
}
DEV void phase_rmsnorm(const Ctx& c, float* X, const float* gain, const float* X_res, int nsp) {
    bf16* XN = c.w<bf16>(WS_XN); const int lane = c.lane;
    for (int m = c.gw; m < M; m += c.ngw) {
        if (m < MP) { rms_row_to_bf16(X + (size_t)m * D, gain, XN + (size_t)m * D, lane); continue; }
        f32x4 v[4]; sample_row_sum(c, m, X_res, nsp, v);
        float s = 0.f;
#pragma unroll
        for (int j = 0; j < 4; ++j) { *(f32x4*)(X + (size_t)m * D + 4 * lane + 256 * j) = v[j]; s += (v[j][0] * v[j][0] + v[j][1] * v[j][1]) + (v[j][2] * v[j][2] + v[j][3] * v[j][3]); }
        const float rstd = rsqrtf(wave_sum(s) * (1.f / D) + EPS);
#pragma unroll
        for (int j = 0; j < 4; ++j) { const f32x4 g = *(const f32x4*)(gain + 4 * lane + 256 * j);
            u32x2 o; o.x = pk2(v[j][0] * rstd * g[0], v[j][1] * rstd * g[1]); o.y = pk2(v[j][2] * rstd * g[2], v[j][3] * rstd * g[3]);
            *(u32x2*)(XN + (size_t)m * D + 4 * lane + 256 * j) = o; }
    }
}
DEV void phase_copy_rows(const Ctx& c, float* dst, const float* src, int nrows) {
    for (int r = (int)(gridDim.x * 8) - 1 - c.gw; r < nrows; r += c.ngw) {
#pragma unroll
        for (int j = 0; j < 4; ++j) *(f32x4*)(dst + (size_t)r * D + 4 * c.lane + 256 * j) = *(const f32x4*)(src + (size_t)r * D + 4 * c.lane + 256 * j); }
}
DEV void phase_final(const Ctx& c, const float* X, const float* gain, const float* X_res, int nsp) {
    for (int m = c.gw; m < MT; m += c.ngw) {
        const float* xrow = X + (size_t)m * D; float* orow = c.out + (m < MP ? O_YP + (size_t)m * D : O_YS + (size_t)(m - MP) * D);
        f32x4 v[4]; float s = 0.f;
        if (m >= MP) sample_row_sum(c, m, X_res, nsp, v);
#pragma unroll
        for (int j = 0; j < 4; ++j) { if (m < MP) v[j] = *(const f32x4*)(xrow + 4 * c.lane + 256 * j); s += (v[j][0] * v[j][0] + v[j][1] * v[j][1]) + (v[j][2] * v[j][2] + v[j][3] * v[j][3]); }
        const float rstd = rsqrtf(wave_sum(s) * (1.f / D) + EPS);
#pragma unroll
        for (int j = 0; j < 4; ++j) { const f32x4 g = *(const f32x4*)(gain + 4 * c.lane + 256 * j); *(f32x4*)(orow + 4 * c.lane + 256 * j) = v[j] * rstd * g; }
    }
}

DEV void phase_prep0(const Ctx& c) {
    const bf16* P1 = c.w<bf16>(WS_P1); const float* rope = c.w<float>(WS_ROPE);
    bf16* CQN = c.w<bf16>(WS_CQN); bf16* LATN = c.w<bf16>(WS_LATN);
    const float* qg = c.in<float>(18); const float* kvg = c.in<float>(20);
    const int lane = c.lane;
    for (int m = c.gw; m < M; m += c.ngw) {
        if (m >= MT) { u32x2 z; z.x = 0u; z.y = 0u; *(u32x2*)(CQN + (size_t)m * 256 + 4 * lane) = z; *(u32x2*)(LATN + (size_t)m * 256 + 4 * lane) = z; continue; }
        const bf16* row = P1 + (size_t)m * LD1;
        const bool samp = m >= MP; const int b = samp ? (m - MP) / DECS : m / SEQ, t = samp ? (m - MP) % DECS : m % SEQ;
        {
            const f32x4 v = ld4bf(row + C_CQ + 4 * lane); const f32x4 g = *(const f32x4*)(qg + 4 * lane);
            const float r = rsqrtf(wave_sum((v[0] * v[0] + v[1] * v[1]) + (v[2] * v[2] + v[3] * v[3])) * (1.f / 256.f) + EPS);
            u32x2 o; o.x = pk2(v[0] * r * g[0], v[1] * r * g[1]); o.y = pk2(v[2] * r * g[2], v[3] * r * g[3]); *(u32x2*)(CQN + (size_t)m * 256 + 4 * lane) = o;
        }
        {
            const f32x4 v = ld4bf(row + C_CKV + 4 * lane); const f32x4 g = *(const f32x4*)(kvg + 4 * lane);
            const float r = rsqrtf(wave_sum((v[0] * v[0] + v[1] * v[1]) + (v[2] * v[2] + v[3] * v[3])) * (1.f / 256.f) + EPS);
            const f32x4 y = v * r * g;
            float* lo = c.out + (samp ? O_LATS + (size_t)(m - MP) * 256 : O_LATP + (size_t)m * 256);
            *(f32x4*)(lo + 4 * lane) = y;
            u32x2 o; o.x = pk2(y[0], y[1]); o.y = pk2(y[2], y[3]); *(u32x2*)(LATN + (size_t)m * 256 + 4 * lane) = o;
        }
        if (lane < 16) {
            const float* rt = rope + (size_t)(samp ? SEQ + t : t) * 32; const float cs = rt[lane], sn = rt[16 + lane];
            const float x1 = bf2f(row[C_KPE + lane]), x2 = bf2f(row[C_KPE + 16 + lane]);
            float* ko = c.out + (samp ? O_KPES + (size_t)(m - MP) * 32 : O_KPEP + (size_t)m * 32);
            ko[lane] = x1 * cs - x2 * sn; ko[16 + lane] = x2 * cs + x1 * sn;
            if (!samp) { bf16* kb = c.w<bf16>(WS_KPEB) + (size_t)m * 32; kb[lane] = (bf16)f2bf(x1 * cs - x2 * sn); kb[16 + lane] = (bf16)f2bf(x2 * cs + x1 * sn); }
        }
        const int T = samp ? DECS : SEQ;
        if (t >= T - 3) {
            float* co = c.out + (samp ? O_CONVS : O_CONVP) + ((size_t)b * 3 + (t - (T - 3))) * QKV_A;
#pragma unroll
            for (int j = 0; j < 6; ++j) *(f32x4*)(co + 4 * lane + 256 * j) = ld4bf(row + 4 * lane + 256 * j);
        }
    }
}

DEV void phase_gdn_naive(const Ctx& c, int u_begin, int wg_first, int wg_stride) {
    float* red = (float*)c.lds; float* red2 = red + 512; float* qs = red2 + 512; float* ks = qs + 128; float* vs = ks + 128; float* part = vs + 128; float* sc = part + 8;
    const bf16* P1 = c.w<bf16>(WS_P1); float* ORAW = c.w<float>(WS_ORAW); bf16* OCAT = c.w<bf16>(WS_OCAT);
    const float* convw = c.in<float>(14); const float* gn = c.in<float>(17);
    const int tid = c.tid, lane = c.lane, wave = c.wave;
    const int NU = (BATCH + DECB) * 4;
    for (int u = u_begin + wg_first; u < NU; u += wg_stride) {
        const bool samp = u >= BATCH * 4; const int b = samp ? (u - BATCH * 4) >> 2 : u >> 2, h = u & 3;
        const int T = samp ? DECS : SEQ; const size_t m0 = samp ? (size_t)MP + (size_t)b * DECS : (size_t)b * SEQ;
        const int e = tid & 127, dg = tid >> 7, d0 = dg * 32;
        float s[32];
        if (samp) { const float* S0 = c.in<float>(2) + ((size_t)(b * 4 + h) * 128 + d0) * 128 + e;
#pragma unroll
            for (int i = 0; i < 32; ++i) s[i] = S0[(size_t)i * 128]; }
        else {
#pragma unroll
            for (int i = 0; i < 32; ++i) s[i] = 0.f; }
        const int col = tid < 128 ? h * 128 + tid : (tid < 256 ? 512 + h * 128 + (tid - 128) : 1024 + h * 128 + (tid - 256));
        float w0 = 0.f, w1 = 0.f, w2 = 0.f, w3 = 0.f, x0 = 0.f, x1 = 0.f, x2 = 0.f, xn = 0.f;
        if (tid < 384) { w0 = convw[col]; w1 = convw[QKV_A + col]; w2 = convw[2 * QKV_A + col]; w3 = convw[3 * QKV_A + col];
            if (samp) { const float* cb = c.in<float>(3) + (size_t)b * 3 * QKV_A + col; x0 = cb[0]; x1 = cb[QKV_A]; x2 = cb[2 * QKV_A]; }
            xn = bf2f(P1[m0 * LD1 + col]); }
        const float Aexp = __expf(c.in<float>(15)[h]), dtb = c.in<float>(16)[h];
        for (int t = 0; t < T; ++t) {
            const size_t m = m0 + t;
            const float x3 = xn; if (t + 1 < T && tid < 384) xn = bf2f(P1[(m + 1) * LD1 + col]);
            float val = 0.f;
            if (tid < 384) { const float y = w0 * x0 + w1 * x1 + w2 * x2 + w3 * x3; val = siluf_(y); x0 = x1; x1 = x2; x2 = x3; }
            const float sq = wave_sum(tid < 256 ? val * val : 0.f);
            if (tid < 128) qs[tid] = val; else if (tid < 256) ks[tid - 128] = val; else if (tid < 384) vs[tid - 256] = val;
            if (lane == 0 && wave < 4) part[wave] = sq;
            if (tid == 384) { sc[0] = sigmoidf_(bf2f(P1[m * LD1 + C_B + h])); sc[1] = -Aexp * softplusf_(bf2f(P1[m * LD1 + C_A + h]) + dtb); }
            LDS_BARRIER();
            const float qn = rsqrtf(part[0] + part[1] + EPS), kn = rsqrtf(part[2] + part[3] + EPS), beta = sc[0], dec = __expf(sc[1]);
            float kp = 0.f;
#pragma unroll
            for (int i = 0; i < 32; ++i) { s[i] *= dec; kp += ks[d0 + i] * s[i]; }
            red[dg * 128 + e] = kp * kn;
            LDS_BARRIER();
            const float kS = (red[e] + red[128 + e]) + (red[256 + e] + red[384 + e]);
            const float delta = beta * (vs[e] - kS) * kn;
            float op = 0.f;
#pragma unroll
            for (int i = 0; i < 32; ++i) { s[i] += ks[d0 + i] * delta; op += qs[d0 + i] * s[i]; }
            red2[dg * 128 + e] = op * qn;
            LDS_BARRIER();
            if (dg == 0) ORAW[m * 512 + h * 128 + e] = ((red2[e] + red2[128 + e]) + (red2[256 + e] + red2[384 + e])) * DK_SCALE;
        }
        float* So = c.out + (samp ? O_GDNS : O_GDNP) + ((size_t)(b * 4 + h) * 128 + d0) * 128 + e;
#pragma unroll
        for (int i = 0; i < 32; ++i) So[(size_t)i * 128] = s[i];
        __syncthreads();
        for (int t = wave; t < T; t += 8) { const size_t m = m0 + t;
            const float v0 = ORAW[m * 512 + h * 128 + lane], v1 = ORAW[m * 512 + h * 128 + 64 + lane];
            const float r = rsqrtf(wave_sum(v0 * v0 + v1 * v1) * (1.f / 128.f) + EPS);
            const float z0 = bf2f(P1[m * LD1 + C_Z + h * 128 + lane]), z1 = bf2f(P1[m * LD1 + C_Z + h * 128 + 64 + lane]);
            OCAT[m * D + h * 128 + lane] = (bf16)f2bf(v0 * r * gn[lane] * siluf_(z0));
            OCAT[m * D + h * 128 + 64 + lane] = (bf16)f2bf(v1 * r * gn[64 + lane] * siluf_(z1)); }
        __syncthreads();
    }
}

DEV void phase_hgrn_naive(const Ctx& c, int u_begin, int wg_first, int wg_stride) {
    float* red = (float*)c.lds; float* qs = red + 512; float* fs = qs + 128;
    const bf16* PC = c.w<bf16>(WS_P1); float* ORAW = c.w<float>(WS_ORAW); bf16* OC = c.w<bf16>(WS_OCAT);
    const float* lbl = c.in<float>(25); const float* gn = c.in<float>(26);
    const int tid = c.tid, lane = c.lane, wave = c.wave;
    const int NU = (BATCH + DECB) * 8;
    for (int u = u_begin + wg_first; u < NU; u += wg_stride) {
        const bool samp = u >= BATCH * 8; const int b = samp ? (u - BATCH * 8) >> 3 : u >> 3, h = u & 7;
        const int T = samp ? DECS : SEQ; const size_t m0 = samp ? (size_t)MP + (size_t)b * DECS : (size_t)b * SEQ;
        const int e = tid & 127, dg = tid >> 7, d0 = dg * 32;
        float s[32];
        if (samp) { const float* S0 = c.in<float>(6) + ((size_t)(b * 8 + h) * 128 + d0) * 128 + e;
#pragma unroll
            for (int i = 0; i < 32; ++i) s[i] = S0[(size_t)i * 128]; }
        else {
#pragma unroll
            for (int i = 0; i < 32; ++i) s[i] = 0.f; }
        float lb = 0.f; if (tid < 128) lb = sigmoidf_(lbl[1024 + h * 128 + tid] - lbl[h * 128 + tid]);
        bf16 nq = 0, nf = 0, nv = 0;
        { const bf16* row = PC + m0 * INC; if (tid < 128) { nq = row[h * 128 + tid]; nf = row[1024 + h * 128 + tid]; } nv = row[2048 + h * 128 + e]; }
        for (int t = 0; t < T; ++t) {
            const size_t m = m0 + t;
            if (tid < 128) { qs[tid] = siluf_(bf2f(nq)); fs[tid] = lb + (1.f - lb) * sigmoidf_(bf2f(nf)); }
            const float v = bf2f(nv);
            if (t + 1 < T) { const bf16* row = PC + (m + 1) * INC; if (tid < 128) { nq = row[h * 128 + tid]; nf = row[1024 + h * 128 + tid]; } nv = row[2048 + h * 128 + e]; }
            LDS_BARRIER();
            float op = 0.f;
#pragma unroll
            for (int i = 0; i < 32; ++i) { const float f = fs[d0 + i]; s[i] = f * s[i] + (1.f - f) * v; op += qs[d0 + i] * s[i]; }
            red[dg * 128 + e] = op;
            LDS_BARRIER();
            if (dg == 0) ORAW[m * D + h * 128 + e] = ((red[e] + red[128 + e]) + (red[256 + e] + red[384 + e])) * DK_SCALE;
        }
        float* So = c.out + (samp ? O_HGS : O_HGP) + ((size_t)(b * 8 + h) * 128 + d0) * 128 + e;
#pragma unroll
        for (int i = 0; i < 32; ++i) So[(size_t)i * 128] = s[i];
        __syncthreads();
        for (int t = wave; t < T; t += 8) { const size_t m = m0 + t;
            const float v0 = ORAW[m * D + h * 128 + lane], v1 = ORAW[m * D + h * 128 + 64 + lane];
            const float r = rsqrtf(wave_sum(v0 * v0 + v1 * v1) * (1.f / 128.f) + EPS);
            const float z0 = bf2f(PC[m * INC + 3072 + h * 128 + lane]), z1 = bf2f(PC[m * INC + 3072 + h * 128 + 64 + lane]);
            OC[m * D + h * 128 + lane] = (bf16)f2bf(v0 * r * gn[lane] * siluf_(z0));
            OC[m * D + h * 128 + 64 + lane] = (bf16)f2bf(v1 * r * gn[64 + lane] * siluf_(z1)); }
        __syncthreads();
    }
}

DEV bf16x8 ld8(const bf16* p) { return *(const bf16x8*)p; }
DEV void softmax_strip(f32x4 (&s)[4], float (&mrun)[4], float (&lrun)[4], float (&alpha)[4], bf16* Ps, int lane) {
#pragma unroll
    for (int r = 0; r < 4; ++r) {
        float mx = fmaxf(fmaxf(s[0][r], s[1][r]), fmaxf(s[2][r], s[3][r])); mx = grp16_max(mx);
        const float mn = fmaxf(mrun[r], mx);
        alpha[r] = __expf(mrun[r] - mn); mrun[r] = mn;
        float sum = 0.f;
#pragma unroll
        for (int nt = 0; nt < 4; ++nt) { const float p = __expf(s[nt][r] - mn); s[nt][r] = p; sum += p; }
        sum = grp16_sum(sum); lrun[r] = lrun[r] * alpha[r] + sum;
    }
#pragma unroll
    for (int nt = 0; nt < 4; ++nt)
#pragma unroll
        for (int r = 0; r < 4; ++r) Ps[((lane >> 4) * 4 + r) * 72 + nt * 16 + (lane & 15)] = (bf16)f2bf(s[nt][r]);
}
DEV void phase_attn_prompt(const Ctx& c) {
    bf16* Qs = (bf16*)c.lds;
    bf16* Ks = Qs + 128 * 104;
    bf16* Vt = Ks + 64 * 104;
    bf16* Psb = Vt + 64 * 72;
    const float* QH = c.w<float>(WS_QH); const bf16* KVP = c.w<bf16>(WS_KVP); const float* rope = c.w<float>(WS_ROPE); bf16* OCAT = c.w<bf16>(WS_OCAT);
    const float* kpe = c.out + O_KPEP;
    const int tid = c.tid, lane = c.lane, w = c.wave;
    bf16* Ps = Psb + w * 16 * 72;
    constexpr int NQB = SEQ / 128, NU = BATCH * 8 * NQB;
    for (int u = blockIdx.x; u < NU; u += gridDim.x) {
        const int qb = NQB - 1 - u / (BATCH * 8), bh = u % (BATCH * 8), b = bh >> 3, h = bh & 7;
        const int q0 = qb * 128; const size_t mb = (size_t)b * SEQ;
        __syncthreads();
        for (int idx = tid; idx < 128 * 80; idx += 512) {
            const int r = idx / 80, j = idx % 80; const float* qrow = QH + (mb + q0 + r) * 768 + h * 96;
            if (j < 64) Qs[r * 104 + j] = (bf16)f2bf(qrow[j] * MLA_SCALE);
            else { const int f = j - 64; const float* rt = rope + (size_t)(q0 + r) * 32; const float cs = rt[f], sn = rt[16 + f], x1 = qrow[64 + f], x2 = qrow[80 + f];
                Qs[r * 104 + 64 + f] = (bf16)f2bf((x1 * cs - x2 * sn) * MLA_SCALE); Qs[r * 104 + 80 + f] = (bf16)f2bf((x2 * cs + x1 * sn) * MLA_SCALE); }
        }
        __syncthreads();
        bf16x8 qf[3];
#pragma unroll
        for (int ks = 0; ks < 3; ++ks) qf[ks] = ld8(Qs + (w * 16 + (lane & 15)) * 104 + ks * 32 + 8 * (lane >> 4));
        float mrun[4], lrun[4], alpha[4]; f32x4 o[4];
#pragma unroll
        for (int r = 0; r < 4; ++r) { mrun[r] = -INFINITY; lrun[r] = 0.f; }
#pragma unroll
        for (int nt = 0; nt < 4; ++nt) o[nt] = (f32x4){0.f, 0.f, 0.f, 0.f};
        const int nkt = 2 * qb + 2;
        for (int kt = 0; kt < nkt; ++kt) {
            const int k0 = kt * 64;
            __syncthreads();
            for (int idx = tid; idx < 64 * 8; idx += 512) {
                const int key = idx >> 3, ch = idx & 7; *(u32x4*)(Ks + key * 104 + ch * 8) = *(const u32x4*)(KVP + (mb + k0 + key) * 1024 + h * 64 + ch * 8); }
            for (int idx = tid; idx < 64 * 32; idx += 512) { const int key = idx >> 5, f = idx & 31; Ks[key * 104 + 64 + f] = (bf16)f2bf(kpe[(mb + k0 + key) * 32 + f]); }
            for (int idx = tid; idx < 64 * 64; idx += 512) { const int key = idx >> 6, d = idx & 63; Vt[d * 72 + key] = KVP[(mb + k0 + key) * 1024 + 512 + h * 64 + d]; }
            __syncthreads();
            f32x4 s[4];
#pragma unroll
            for (int nt = 0; nt < 4; ++nt) { s[nt] = (f32x4){0.f, 0.f, 0.f, 0.f};
#pragma unroll
                for (int ks = 0; ks < 3; ++ks) s[nt] = mfma16(qf[ks], ld8(Ks + (nt * 16 + (lane & 15)) * 104 + ks * 32 + 8 * (lane >> 4)), s[nt]); }
            if (kt >= 2 * qb) {
#pragma unroll
                for (int nt = 0; nt < 4; ++nt)
#pragma unroll
                    for (int r = 0; r < 4; ++r) { const int qpos = q0 + w * 16 + (lane >> 4) * 4 + r, kpos = k0 + nt * 16 + (lane & 15); if (kpos > qpos) s[nt][r] = -INFINITY; }
            }
            softmax_strip(s, mrun, lrun, alpha, Ps, lane);
            WAVE_SYNC();
#pragma unroll
            for (int nt = 0; nt < 4; ++nt) {
#pragma unroll
                for (int r = 0; r < 4; ++r) o[nt][r] *= alpha[r];
#pragma unroll
                for (int k2 = 0; k2 < 2; ++k2) o[nt] = mfma16(ld8(Ps + (lane & 15) * 72 + k2 * 32 + 8 * (lane >> 4)), ld8(Vt + (nt * 16 + (lane & 15)) * 72 + k2 * 32 + 8 * (lane >> 4)), o[nt]); }
            WAVE_SYNC();
        }
#pragma unroll
        for (int nt = 0; nt < 4; ++nt)
#pragma unroll
            for (int r = 0; r < 4; ++r) OCAT[(mb + q0 + w * 16 + (lane >> 4) * 4 + r) * D + 512 + h * 64 + nt * 16 + (lane & 15)] = (bf16)f2bf(o[nt][r] / lrun[r]);
    }
}

DEV void phase_attn_sample(const Ctx& c) {
    bf16* Qs = (bf16*)c.lds;
    bf16* Ks = Qs + 64 * 296;
    bf16* Lt = Ks + 64 * 296;
    float* Sf = (float*)(Lt + 256 * 72);
    bf16* Psb = (bf16*)(Sf + 64 * 68);
    float* Of = (float*)Ks;
    const float* QH = c.w<float>(WS_QH); const float* rope = c.w<float>(WS_ROPE); bf16* OCAT = c.w<bf16>(WS_OCAT);
    const float* wuk = c.in<float>(21); const float* wuv = c.in<float>(22);
    const float* clat = c.in<float>(4); const float* ckr = c.in<float>(5); const int* ptab = c.in<int>(7);
    const int tid = c.tid, lane = c.lane, w = c.wave;
    bf16* Ps = Psb + w * 16 * 72;
    for (int b = blockIdx.x; b < DECB; b += gridDim.x) {
        const size_t mb = (size_t)MP + (size_t)b * DECS;
        __syncthreads();
        for (int idx = tid; idx < 64 * 64; idx += 512) { const int r = idx >> 6, d = idx & 63, t = r >> 3, h = r & 7; Sf[r * 68 + d] = QH[(mb + t) * 768 + h * 96 + d]; }
        for (int idx = tid; idx < 64 * 16; idx += 512) { const int r = idx >> 4, f = idx & 15, t = r >> 3, h = r & 7; const float* qrow = QH + (mb + t) * 768 + h * 96 + 64;
            const float* rt = rope + (size_t)(SEQ + t) * 32; const float cs = rt[f], sn = rt[16 + f], x1 = qrow[f], x2 = qrow[16 + f];
            Qs[r * 296 + 256 + f] = (bf16)f2bf((x1 * cs - x2 * sn) * MLA_SCALE); Qs[r * 296 + 272 + f] = (bf16)f2bf((x2 * cs + x1 * sn) * MLA_SCALE); }
        __syncthreads();
        {
            const int l = tid & 255, th = tid >> 8;
            for (int h = 0; h < 8; ++h) {
                float a0 = 0.f, a1 = 0.f, a2 = 0.f, a3 = 0.f; const float* wr = wuk + (size_t)l * 512 + h * 64;
                const float* q0 = Sf + ((th * 4 + 0) * 8 + h) * 68; const float* q1 = Sf + ((th * 4 + 1) * 8 + h) * 68; const float* q2 = Sf + ((th * 4 + 2) * 8 + h) * 68; const float* q3 = Sf + ((th * 4 + 3) * 8 + h) * 68;
#pragma unroll 4
                for (int d4 = 0; d4 < 16; ++d4) { const f32x4 wv = *(const f32x4*)(wr + 4 * d4);
#pragma unroll
                    for (int j = 0; j < 4; ++j) { a0 += q0[4 * d4 + j] * wv[j]; a1 += q1[4 * d4 + j] * wv[j]; a2 += q2[4 * d4 + j] * wv[j]; a3 += q3[4 * d4 + j] * wv[j]; } }
                Qs[((th * 4 + 0) * 8 + h) * 296 + l] = (bf16)f2bf(a0 * MLA_SCALE); Qs[((th * 4 + 1) * 8 + h) * 296 + l] = (bf16)f2bf(a1 * MLA_SCALE);
                Qs[((th * 4 + 2) * 8 + h) * 296 + l] = (bf16)f2bf(a2 * MLA_SCALE); Qs[((th * 4 + 3) * 8 + h) * 296 + l] = (bf16)f2bf(a3 * MLA_SCALE);
            }
        }
        __syncthreads();
        const int rt = w & 3, hh = w >> 2;
        bf16x8 qf[9];
#pragma unroll
        for (int ks = 0; ks < 9; ++ks) qf[ks] = ld8(Qs + (rt * 16 + (lane & 15)) * 296 + ks * 32 + 8 * (lane >> 4));
        float mrun[4], lrun[4], alpha[4]; f32x4 o[8];
#pragma unroll
        for (int r = 0; r < 4; ++r) { mrun[r] = -INFINITY; lrun[r] = 0.f; }
#pragma unroll
        for (int nt = 0; nt < 8; ++nt) o[nt] = (f32x4){0.f, 0.f, 0.f, 0.f};
        constexpr int NT = PAST / 64 + 1;
        for (int kt = 0; kt < NT; ++kt) {
            const bool fresh = kt == NT - 1;
            __syncthreads();
            if (!fresh) {
                const int k0 = kt * 64; const size_t rowbase = (size_t)ptab[b * NPAGES + (k0 >> 7)] * PAGE + (k0 & 127);
#pragma unroll 2
                for (int j = 0; j < 8; ++j) { const int idx = tid + 512 * j, key = idx >> 6, l4 = idx & 63;
                    const f32x4 v = *(const f32x4*)(clat + (rowbase + key) * 256 + 4 * l4);
                    u32x2 pk; pk.x = pk2(v[0], v[1]); pk.y = pk2(v[2], v[3]); *(u32x2*)(Ks + key * 296 + 4 * l4) = pk;
                    Lt[(4 * l4 + 0) * 72 + key] = (bf16)f2bf(v[0]); Lt[(4 * l4 + 1) * 72 + key] = (bf16)f2bf(v[1]); Lt[(4 * l4 + 2) * 72 + key] = (bf16)f2bf(v[2]); Lt[(4 * l4 + 3) * 72 + key] = (bf16)f2bf(v[3]); }
                { const int key = tid >> 3, i4 = tid & 7; const f32x4 v = *(const f32x4*)(ckr + (rowbase + key) * 32 + 4 * i4);
                    u32x2 pk; pk.x = pk2(v[0], v[1]); pk.y = pk2(v[2], v[3]); *(u32x2*)(Ks + key * 296 + 256 + 4 * i4) = pk; }
            } else {
                const float* nl = c.out + O_LATS + (size_t)b * DECS * 256; const float* nk = c.out + O_KPES + (size_t)b * DECS * 32;
                for (int idx = tid; idx < 64 * 256; idx += 512) { const int key = idx >> 8, l = idx & 255; const bf16 v = key < DECS ? (bf16)f2bf(nl[key * 256 + l]) : (bf16)0; Ks[key * 296 + l] = v; Lt[l * 72 + key] = v; }
                for (int idx = tid; idx < 64 * 32; idx += 512) { const int key = idx >> 5, f = idx & 31; Ks[key * 296 + 256 + f] = key < DECS ? (bf16)f2bf(nk[key * 32 + f]) : (bf16)0; }
            }
            __syncthreads();
#pragma unroll
            for (int n2 = 0; n2 < 2; ++n2) { const int nt = 2 * hh + n2; f32x4 s = (f32x4){0.f, 0.f, 0.f, 0.f};
#pragma unroll
                for (int ks = 0; ks < 9; ++ks) s = mfma16(qf[ks], ld8(Ks + (nt * 16 + (lane & 15)) * 296 + ks * 32 + 8 * (lane >> 4)), s);
#pragma unroll
                for (int r = 0; r < 4; ++r) { const int row = rt * 16 + (lane >> 4) * 4 + r, key = nt * 16 + (lane & 15); float v = s[r];
                    if (fresh && (key >= DECS || key > (row >> 3))) v = -INFINITY;
                    Sf[row * 68 + key] = v; } }
            __syncthreads();
            f32x4 s[4];
#pragma unroll
            for (int nt = 0; nt < 4; ++nt)
#pragma unroll
                for (int r = 0; r < 4; ++r) s[nt][r] = Sf[(rt * 16 + (lane >> 4) * 4 + r) * 68 + nt * 16 + (lane & 15)];
            softmax_strip(s, mrun, lrun, alpha, Ps, lane);
            WAVE_SYNC();
#pragma unroll
            for (int nt = 0; nt < 8; ++nt) {
#pragma unroll
                for (int r = 0; r < 4; ++r) o[nt][r] *= alpha[r];
#pragma unroll
                for (int k2 = 0; k2 < 2; ++k2) o[nt] = mfma16(ld8(Ps + (lane & 15) * 72 + k2 * 32 + 8 * (lane >> 4)), ld8(Lt + (hh * 128 + nt * 16 + (lane & 15)) * 72 + k2 * 32 + 8 * (lane >> 4)), o[nt]); }
            WAVE_SYNC();
        }
        __syncthreads();
#pragma unroll
        for (int nt = 0; nt < 8; ++nt)
#pragma unroll
            for (int r = 0; r < 4; ++r) Of[(rt * 16 + (lane >> 4) * 4 + r) * 260 + hh * 128 + nt * 16 + (lane & 15)] = o[nt][r] / lrun[r];
        __syncthreads();
        {
            const int d = tid & 63, h = tid >> 6; float a[8];
#pragma unroll
            for (int t = 0; t < 8; ++t) a[t] = 0.f;
            for (int l = 0; l < 256; ++l) { const float wv = wuv[(size_t)l * 512 + h * 64 + d];
#pragma unroll
                for (int t = 0; t < 8; ++t) a[t] += Of[(t * 8 + h) * 260 + l] * wv; }
#pragma unroll
            for (int t = 0; t < 8; ++t) OCAT[(mb + t) * D + 512 + h * 64 + d] = (bf16)f2bf(a[t]);
        }
    }
}

constexpr int NCH = SEQ / 64;
constexpr size_t HC_QG = WS_H, HC_BNT = HC_QG + (size_t)BATCH * 8 * NCH * 64 * 128 * 2,
    HC_A = HC_BNT + (size_t)BATCH * 8 * NCH * 128 * 128 * 2, HC_END = HC_A + (size_t)BATCH * 8 * NCH * 128 * 4;
constexpr size_t HC_SNT = WS_QH;
static_assert(HC_END <= WS_H_END && HC_SNT + (size_t)BATCH * 8 * NCH * 128 * 128 * 2 <= WS_OCAT, "hgrn scratch fits");
DEV u32x4 pack8(const float* v) { u32x4 o; o.x = pk2(v[0], v[1]); o.y = pk2(v[2], v[3]); o.z = pk2(v[4], v[5]); o.w = pk2(v[6], v[7]); return o; }

DEV void phase_hgrn_prep(const Ctx& c) {
    bf16* qt = (bf16*)c.lds;
    bf16* kt = qt + 64 * 136;
    bf16* vT = kt + 160 * 136;
    bf16* Ab = vT + 128 * 72;
    float* tot = (float*)(Ab + 64 * 72);
    bf16* kgl = (bf16*)(tot + 512);
    const bf16* PC = c.w<bf16>(WS_P1); float* ORAW = c.w<float>(WS_ORAW);
    bf16* QG = c.w<bf16>(HC_QG); bf16* BNT = c.w<bf16>(HC_BNT); float* Ag = c.w<float>(HC_A);
    const float* lbl = c.in<float>(25);
    const int tid = c.tid, lane = c.lane, w = c.wave;
    const int d = tid & 127, tq = tid >> 7;
    constexpr int NU = BATCH * 8 * NCH;
    bf16 rq[16], rf[16], rv[16];
#define HP_LOAD(u_) do { const int u__ = (u_); const int bh_ = u__ / NCH, n_ = u__ % NCH; const bf16* row_ = PC + ((size_t)(bh_ >> 3) * SEQ + (size_t)n_ * 64 + 16 * tq) * INC + (bh_ & 7) * 128 + d; \
        _Pragma("unroll") for (int i = 0; i < 16; ++i) { rq[i] = row_[(size_t)i * INC]; rf[i] = row_[(size_t)i * INC + 1024]; rv[i] = row_[(size_t)i * INC + 2048]; } } while (0)
    if ((int)blockIdx.x < NU) HP_LOAD(blockIdx.x);
    for (int u = blockIdx.x; u < NU; u += gridDim.x) {
        const int bh = u / NCH, n = u % NCH, b = bh >> 3, h = bh & 7;
        const size_t m0 = (size_t)b * SEQ + (size_t)n * 64;
        const float lb = sigmoidf_(lbl[1024 + h * 128 + d] - lbl[h * 128 + d]);
        float gcl[16], kk[16], qq[16], vv[16];
        float run = 0.f;
#pragma unroll
        for (int i = 0; i < 16; ++i) {
            const float f = lb + (1.f - lb) * sigmoidf_(bf2f(rf[i]));
            kk[i] = 1.f - f; run += __logf(f); gcl[i] = run;
            qq[i] = siluf_(bf2f(rq[i])) * DK_SCALE; vv[i] = bf2f(rv[i]);
        }
        if (u + (int)gridDim.x < NU) HP_LOAD(u + (int)gridDim.x);
        tot[tq * 128 + d] = run;
        { const u32x4 p0 = pack8(vv), p1 = pack8(vv + 8);
          *(u32x4*)(vT + d * 72 + 16 * tq) = p0; *(u32x4*)(vT + d * 72 + 16 * tq + 8) = p1; }
        for (int i = tid; i < 64 * 72 / 8; i += 512) { u32x4 z; z.x = z.y = z.z = z.w = 0u; *(u32x4*)(Ab + 8 * i) = z; }
        LDS_BARRIER();
        const float t0 = tot[d], t1 = tot[128 + d], t2 = tot[256 + d], t3 = tot[384 + d];
        const float rI[4] = {0.f, t0, t0 + t1, t0 + t1 + t2}; const float glast = (t0 + t1) + (t2 + t3);
        const float pre = tq == 0 ? rI[0] : (tq == 1 ? rI[1] : (tq == 2 ? rI[2] : rI[3]));
        float kg[16];
#pragma unroll
        for (int i = 0; i < 16; ++i) {
            const float gc = pre + gcl[i];
            qt[(16 * tq + i) * 136 + d] = (bf16)f2bf(qq[i] * __expf(gcl[i]));
            QG[((size_t)u * 64 + 16 * tq + i) * 128 + d] = (bf16)f2bf(qq[i] * __expf(gc));
            kg[i] = kk[i] * __expf(glast - gc);
#pragma unroll
            for (int I = 0; I < 4; ++I) if (I >= tq) { const int base = I == 0 ? 0 : (I == 1 ? 16 : (I == 2 ? 48 : 96));
                kt[(base + 16 * tq + i) * 136 + d] = (bf16)f2bf(kk[i] * __expf(rI[I] - gc)); }
        }
        { bf16* g = kgl + d * 72 + 16 * tq; *(u32x4*)g = pack8(kg); *(u32x4*)(g + 8) = pack8(kg + 8); }
        if (tq == 0) Ag[(size_t)u * 128 + d] = __expf(glast);
        LDS_BARRIER();
        for (int ti = w; ti < 10; ti += 8) {
            const int I = ti == 0 ? 0 : (ti < 3 ? 1 : (ti < 6 ? 2 : 3)); const int J = ti - (I == 0 ? 0 : (I == 1 ? 1 : (I == 2 ? 3 : 6)));
            const int base = I == 0 ? 0 : (I == 1 ? 16 : (I == 2 ? 48 : 96));
            f32x4 acc = (f32x4){0.f, 0.f, 0.f, 0.f};
#pragma unroll
            for (int ks = 0; ks < 4; ++ks) acc = mfma16(ld8(qt + (16 * I + (lane & 15)) * 136 + ks * 32 + 8 * (lane >> 4)), ld8(kt + (base + 16 * J + (lane & 15)) * 136 + ks * 32 + 8 * (lane >> 4)), acc);
#pragma unroll
            for (int r = 0; r < 4; ++r) { const int i = 16 * I + (lane >> 4) * 4 + r, j = 16 * J + (lane & 15); Ab[i * 72 + j] = (bf16)f2bf((J < I || j <= i) ? acc[r] : 0.f); }
        }
        LDS_BARRIER();
        { const int it = w & 3;
          f32x4 acc[4];
#pragma unroll
          for (int e4 = 0; e4 < 4; ++e4) acc[e4] = (f32x4){0.f, 0.f, 0.f, 0.f};
#pragma unroll
          for (int ks = 0; ks < 2; ++ks) { const bf16x8 af = ld8(Ab + (16 * it + (lane & 15)) * 72 + ks * 32 + 8 * (lane >> 4)); bf16x8 vf[4];
#pragma unroll
            for (int e4 = 0; e4 < 4; ++e4) vf[e4] = ld8(vT + (16 * ((w >> 2) * 4 + e4) + (lane & 15)) * 72 + ks * 32 + 8 * (lane >> 4));
#pragma unroll
            for (int e4 = 0; e4 < 4; ++e4) acc[e4] = mfma16(af, vf[e4], acc[e4]); }
#pragma unroll
          for (int e4 = 0; e4 < 4; ++e4) { const int et = (w >> 2) * 4 + e4;
#pragma unroll
            for (int r = 0; r < 4; ++r) ORAW[(m0 + 16 * it + (lane >> 4) * 4 + r) * D + h * 128 + 16 * et + (lane & 15)] = acc[e4][r]; } }
        {
            bf16x8 ka[2];
#pragma unroll
            for (int ks = 0; ks < 2; ++ks) ka[ks] = ld8(kgl + (16 * w + (lane & 15)) * 72 + ks * 32 + 8 * (lane >> 4));
            bf16* g = BNT + (size_t)u * 16384;
            f32x4 acc[8];
#pragma unroll
            for (int et = 0; et < 8; ++et) acc[et] = (f32x4){0.f, 0.f, 0.f, 0.f};
#pragma unroll
            for (int ks = 0; ks < 2; ++ks) { bf16x8 vf[8];
#pragma unroll
                for (int et = 0; et < 8; ++et) vf[et] = ld8(vT + (16 * et + (lane & 15)) * 72 + ks * 32 + 8 * (lane >> 4));
#pragma unroll
                for (int et = 0; et < 8; ++et) acc[et] = mfma16(ka[ks], vf[et], acc[et]); }
#pragma unroll
            for (int et = 0; et < 8; ++et) { u32x2 o; o.x = pk2(acc[et][0], acc[et][1]); o.y = pk2(acc[et][2], acc[et][3]); *(u32x2*)(g + (16 * et + (lane & 15)) * 128 + 16 * w + 4 * (lane >> 4)) = o; }
        }
        LDS_BARRIER();
    }
}

#undef HP_LOAD
DEV void phase_hgrn_prefix(const Ctx& c) {
    const bf16* BNT = c.w<bf16>(HC_BNT); const float* Ag = c.w<float>(HC_A); bf16* SNT = c.w<bf16>(HC_SNT);
    constexpr int NV = BATCH * 8 * 2048;
    for (int v = blockIdx.x * 512 + c.tid; v < NV; v += gridDim.x * 512) {
        const int bh = v >> 11, x8 = (v & 2047) * 8, d0 = x8 & 127, e = x8 >> 7;
        float S[8];
#pragma unroll
        for (int j = 0; j < 8; ++j) S[j] = 0.f;
        const size_t base = (size_t)bh * NCH * 16384 + x8;
        constexpr int PFD = NCH < 8 ? NCH : 8;
        u32x4 bq[PFD]; f32x4 aq0[PFD], aq1[PFD];
#pragma unroll
        for (int j = 0; j < PFD; ++j) { bq[j] = *(const u32x4*)(BNT + base + (size_t)j * 16384); aq0[j] = *(const f32x4*)(Ag + ((size_t)bh * NCH + j) * 128 + d0); aq1[j] = *(const f32x4*)(Ag + ((size_t)bh * NCH + j) * 128 + d0 + 4); }
#pragma unroll
        for (int n = 0; n < NCH; ++n) {
            const u32x4 bv = bq[n % PFD]; const f32x4 a0 = aq0[n % PFD], a1 = aq1[n % PFD];
            if (n + PFD < NCH) { bq[n % PFD] = *(const u32x4*)(BNT + base + (size_t)(n + PFD) * 16384); aq0[n % PFD] = *(const f32x4*)(Ag + ((size_t)bh * NCH + n + PFD) * 128 + d0); aq1[n % PFD] = *(const f32x4*)(Ag + ((size_t)bh * NCH + n + PFD) * 128 + d0 + 4); }
            *(u32x4*)(SNT + base + (size_t)n * 16384) = pack8(S);
            S[0] = a0[0] * S[0] + __uint_as_float(bv.x << 16); S[1] = a0[1] * S[1] + __uint_as_float(bv.x & 0xffff0000u);
            S[2] = a0[2] * S[2] + __uint_as_float(bv.y << 16); S[3] = a0[3] * S[3] + __uint_as_float(bv.y & 0xffff0000u);
            S[4] = a1[0] * S[4] + __uint_as_float(bv.z << 16); S[5] = a1[1] * S[5] + __uint_as_float(bv.z & 0xffff0000u);
            S[6] = a1[2] * S[6] + __uint_as_float(bv.w << 16); S[7] = a1[3] * S[7] + __uint_as_float(bv.w & 0xffff0000u);
        }
        float* So = c.out + O_HGP + (size_t)bh * 16384;
#pragma unroll
        for (int j = 0; j < 8; ++j) So[(size_t)(d0 + j) * 128 + e] = S[j];
    }
}

DEV void phase_hgrn_out(const Ctx& c) {
    bf16* qg = (bf16*)c.lds;
    bf16* StT = qg + 64 * 136;
    float* ob = (float*)(StT + 128 * 136);
    const bf16* PC = c.w<bf16>(WS_P1); const float* ORAW = c.w<float>(WS_ORAW); bf16* OC = c.w<bf16>(WS_OCAT);
    const bf16* QG = c.w<bf16>(HC_QG); const bf16* SNT = c.w<bf16>(HC_SNT);
    const float* gn = c.in<float>(26);
    const int tid = c.tid, lane = c.lane, w = c.wave;
    const float gn0 = gn[lane], gn1 = gn[64 + lane];
    constexpr int NU = BATCH * 8 * NCH;
    u32x4 pq[2], ps[4]; float or0n[8], or1n[8]; bf16 zz0n[8], zz1n[8];
#define HO_LOAD(u_) do { const int u__ = (u_); const int bh_ = u__ / NCH, n_ = u__ % NCH, b_ = bh_ >> 3, h_ = bh_ & 7; const size_t m0_ = (size_t)b_ * SEQ + (size_t)n_ * 64; \
        _Pragma("unroll") for (int j = 0; j < 2; ++j) pq[j] = *(const u32x4*)(QG + (size_t)u__ * 8192 + 8 * (tid + 512 * j)); \
        _Pragma("unroll") for (int j = 0; j < 4; ++j) ps[j] = *(const u32x4*)(SNT + (size_t)u__ * 16384 + 8 * (tid + 512 * j)); \
        _Pragma("unroll") for (int i8 = 0; i8 < 8; ++i8) { const size_t m = m0_ + w * 8 + i8; or0n[i8] = ORAW[m * D + h_ * 128 + lane]; or1n[i8] = ORAW[m * D + h_ * 128 + 64 + lane]; \
            zz0n[i8] = PC[m * INC + 3072 + h_ * 128 + lane]; zz1n[i8] = PC[m * INC + 3072 + h_ * 128 + 64 + lane]; } } while (0)
    if ((int)blockIdx.x < NU) HO_LOAD(blockIdx.x);
    for (int u = blockIdx.x; u < NU; u += gridDim.x) {
        const int bh = u / NCH, n = u % NCH, b = bh >> 3, h = bh & 7; const size_t m0 = (size_t)b * SEQ + (size_t)n * 64;
        float or0[8], or1[8], zz0[8], zz1[8];
#pragma unroll
        for (int i8 = 0; i8 < 8; ++i8) { or0[i8] = or0n[i8]; or1[i8] = or1n[i8]; zz0[i8] = bf2f(zz0n[i8]); zz1[i8] = bf2f(zz1n[i8]); }
        LDS_BARRIER();
#pragma unroll
        for (int j = 0; j < 2; ++j) { const int idx = tid + 512 * j; *(u32x4*)(qg + (idx >> 4) * 136 + (idx & 15) * 8) = pq[j]; }
#pragma unroll
        for (int j = 0; j < 4; ++j) { const int idx = tid + 512 * j; *(u32x4*)(StT + (idx >> 4) * 136 + (idx & 15) * 8) = ps[j]; }
        if (u + (int)gridDim.x < NU) HO_LOAD(u + (int)gridDim.x);
        LDS_BARRIER();
        { const int it = w & 3; bf16x8 qa[4];
#pragma unroll
          for (int ks = 0; ks < 4; ++ks) qa[ks] = ld8(qg + (16 * it + (lane & 15)) * 136 + ks * 32 + 8 * (lane >> 4));
          f32x4 acc[4];
#pragma unroll
          for (int e4 = 0; e4 < 4; ++e4) acc[e4] = (f32x4){0.f, 0.f, 0.f, 0.f};
#pragma unroll
          for (int ks = 0; ks < 4; ++ks) { bf16x8 bs[4];
#pragma unroll
            for (int e4 = 0; e4 < 4; ++e4) bs[e4] = ld8(StT + (16 * ((w >> 2) * 4 + e4) + (lane & 15)) * 136 + ks * 32 + 8 * (lane >> 4));
#pragma unroll
            for (int e4 = 0; e4 < 4; ++e4) acc[e4] = mfma16(qa[ks], bs[e4], acc[e4]); }
#pragma unroll
          for (int e4 = 0; e4 < 4; ++e4) { const int et = (w >> 2) * 4 + e4;
#pragma unroll
            for (int r = 0; r < 4; ++r) ob[(16 * it + (lane >> 4) * 4 + r) * 132 + 16 * et + (lane & 15)] = acc[e4][r]; } }
        LDS_BARRIER();
        { float ss[8];
#pragma unroll
          for (int i8 = 0; i8 < 8; ++i8) { const int i = w * 8 + i8; or0[i8] += ob[i * 132 + lane]; or1[i8] += ob[i * 132 + 64 + lane]; ss[i8] = or0[i8] * or0[i8] + or1[i8] * or1[i8]; }
#pragma unroll
              for (int i8 = 0; i8 < 8; ++i8) ss[i8] = wave_sum(ss[i8]);
#pragma unroll
          for (int i8 = 0; i8 < 8; ++i8) { const size_t m = m0 + w * 8 + i8; const float r = rsqrtf(ss[i8] * (1.f / 128.f) + EPS);
            OC[m * D + h * 128 + lane] = (bf16)f2bf(or0[i8] * r * gn0 * siluf_(zz0[i8])); OC[m * D + h * 128 + 64 + lane] = (bf16)f2bf(or1[i8] * r * gn1 * siluf_(zz1[i8])); } }
    }
}


constexpr int NUG = BATCH * 4 * NCH;
constexpr size_t GC_W = WS_H, GC_UT = GC_W + (size_t)NUG * 64 * 128 * 2, GC_QG = GC_UT + (size_t)NUG * 128 * 64 * 4, GC_KGT = GC_QG + (size_t)NUG * 64 * 128 * 2,
    GC_AQK = GC_KGT + (size_t)NUG * 128 * 64 * 2, GC_GL = GC_AQK + (size_t)NUG * 64 * 64 * 2, GC_END = GC_GL + (size_t)NUG * 4;
static_assert(GC_END <= WS_H_END, "gdn scratch fits in H");

DEV void phase_gdn_prep(const Ctx& c) {
    bf16* qb = (bf16*)c.lds;
    bf16* kb = qb + 64 * 136;
    float* Lm = (float*)(kb + 64 * 136);
    float* part = Lm + 64 * 68;
    float* gl = part + 256; float* gcs = gl + 64; float* bet = gcs + 64; float* eg = bet + 64; float* egl = eg + 64; float* qn = egl + 64; float* kn = qn + 64;
    float* sqb = kn + 64;
    const bf16* P1 = c.w<bf16>(WS_P1);
    bf16* Wg = c.w<bf16>(GC_W); float* UTg = c.w<float>(GC_UT); bf16* QGg = c.w<bf16>(GC_QG); bf16* KGTg = c.w<bf16>(GC_KGT); bf16* AQKg = c.w<bf16>(GC_AQK); float* GLg = c.w<float>(GC_GL);
    const float* convw = c.in<float>(14);
    const int tid = c.tid, lane = c.lane, w = c.wave;
    const int role = tid >> 7, cc = tid & 127;
    for (int u = blockIdx.x; u < NUG; u += gridDim.x) {
        const int bh = u / NCH, n = u % NCH, b = bh >> 2, h = bh & 3;
        const size_t m0 = (size_t)b * SEQ + (size_t)n * 64;
        float x[64];
        if (role < 3) {
            const int col = role * 512 + h * 128 + cc;
            const float w0 = convw[col], w1 = convw[QKV_A + col], w2 = convw[2 * QKV_A + col], w3 = convw[3 * QKV_A + col];
            const bf16* src = P1 + m0 * LD1 + col;
            float p0 = 0.f, p1 = 0.f, p2 = 0.f;
            if (n > 0) { p0 = bf2f(src[-3 * (long)LD1]); p1 = bf2f(src[-2 * (long)LD1]); p2 = bf2f(src[-1 * (long)LD1]); }
#pragma unroll
            for (int j = 0; j < 64; ++j) x[j] = bf2f(src[(size_t)j * LD1]);
#pragma unroll
            for (int j = 0; j < 64; ++j) { const float cur = x[j]; const float y = w0 * p0 + w1 * p1 + w2 * p2 + w3 * cur; x[j] = siluf_(y); p0 = p1; p1 = p2; p2 = cur; }
            if (role < 2) {
#pragma unroll
                for (int j4 = 0; j4 < 16; ++j4) *(f32x4*)(sqb + tid * 68 + 4 * j4) = (f32x4){x[4 * j4] * x[4 * j4], x[4 * j4 + 1] * x[4 * j4 + 1], x[4 * j4 + 2] * x[4 * j4 + 2], x[4 * j4 + 3] * x[4 * j4 + 3]};
            }
        } else if (cc < 64) {
            const float Aexp = __expf(c.in<float>(15)[h]), dtb = c.in<float>(16)[h];
            bet[cc] = sigmoidf_(bf2f(P1[(m0 + cc) * LD1 + C_B + h]));
            gl[cc] = -Aexp * softplusf_(bf2f(P1[(m0 + cc) * LD1 + C_A + h]) + dtb);
        }
        __syncthreads();
        if (role == 3) {
            if (cc < 64) { float acc = 0.f, totl = 0.f;
                for (int i = 0; i < 64; ++i) { const float g = gl[i]; totl += g; if (i <= cc) acc += g; }
                gcs[cc] = acc; eg[cc] = __expf(acc); egl[cc] = __expf(totl - acc);
                if (cc == 0) GLg[u] = __expf(totl);
            } else { const int j = cc - 64; float sq = 0.f, sk = 0.f;
#pragma unroll 16
                for (int cx = 0; cx < 128; ++cx) { sq += sqb[cx * 68 + j]; sk += sqb[(128 + cx) * 68 + j]; }
                qn[j] = rsqrtf(sq + EPS); kn[j] = rsqrtf(sk + EPS); }
        }
        __syncthreads();
        if (role == 0) {
#pragma unroll
            for (int j = 0; j < 64; ++j) { const float qh = x[j] * qn[j]; qb[j * 136 + cc] = (bf16)f2bf(qh); QGg[((size_t)u * 64 + j) * 128 + cc] = (bf16)f2bf(qh * DK_SCALE * eg[j]); }
        } else if (role == 1) {
            bf16* g = KGTg + ((size_t)u * 128 + cc) * 64;
#pragma unroll
            for (int j8 = 0; j8 < 8; ++j8) { float t[8];
#pragma unroll
                for (int q = 0; q < 8; ++q) { const int j = 8 * j8 + q; const float kh = x[j] * kn[j]; kb[j * 136 + cc] = (bf16)f2bf(kh); t[q] = kh * egl[j]; x[j] = kh * bet[j] * eg[j]; }
                *(u32x4*)(g + 8 * j8) = pack8(t); }
        } else if (role == 2) {
#pragma unroll
            for (int j = 0; j < 64; ++j) x[j] *= bet[j];
        }
        __syncthreads();
        for (int ti = w; ti < 32; ti += 8) {
            const bool isq = ti >= 16; const int I = (ti & 15) >> 2, J = ti & 3;
            if (J > I) { if (isq) {
#pragma unroll
                    for (int r = 0; r < 4; ++r) AQKg[((size_t)u * 64 + 16 * I + (lane >> 4) * 4 + r) * 64 + 16 * J + (lane & 15)] = (bf16)0; }
                continue; }
            const bf16* Ab = isq ? qb : kb;
            f32x4 acc = (f32x4){0.f, 0.f, 0.f, 0.f};
#pragma unroll
            for (int ks = 0; ks < 4; ++ks) acc = mfma16(ld8(Ab + (16 * I + (lane & 15)) * 136 + ks * 32 + 8 * (lane >> 4)), ld8(kb + (16 * J + (lane & 15)) * 136 + ks * 32 + 8 * (lane >> 4)), acc);
#pragma unroll
            for (int r = 0; r < 4; ++r) { const int i = 16 * I + (lane >> 4) * 4 + r, j = 16 * J + (lane & 15);
                const float dcy = __expf(fminf(gcs[i] - gcs[j], 0.f));
                if (isq) AQKg[((size_t)u * 64 + i) * 64 + j] = (bf16)f2bf(i >= j ? acc[r] * DK_SCALE * dcy : 0.f);
                else Lm[i * 68 + j] = i > j ? bet[i] * acc[r] * dcy : 0.f; }
        }
        __syncthreads();
        if (role == 1 || role == 2) {
#pragma unroll
            for (int i = 1; i < 64; ++i) { float acc = x[i];
#pragma unroll
                for (int j = 0; j < i; ++j) acc -= Lm[i * 68 + j] * x[j];
                x[i] = acc; }
            if (role == 1) {
#pragma unroll
                for (int i = 0; i < 64; ++i) Wg[((size_t)u * 64 + i) * 128 + cc] = (bf16)f2bf(x[i]);
            } else { float* g = UTg + ((size_t)u * 128 + cc) * 64;
#pragma unroll
                for (int i4 = 0; i4 < 16; ++i4) *(f32x4*)(g + 4 * i4) = (f32x4){x[4 * i4], x[4 * i4 + 1], x[4 * i4 + 2], x[4 * i4 + 3]}; }
        }
        __syncthreads();
    }
}

DEV void phase_gdn_scan(const Ctx& c, int u_first, int u_stride) {
    bf16* wl = (bf16*)c.lds;
    bf16* qgl = wl + 64 * 136;
    bf16* kgT = qgl + 64 * 136;
    bf16* aqk = kgT + 128 * 72;
    bf16* StT = aqk + 64 * 72;
    bf16* vnT = StT + 128 * 136;
    float* ob = (float*)(vnT + 128 * 72);
    const bf16* P1 = c.w<bf16>(WS_P1); bf16* OCAT = c.w<bf16>(WS_OCAT);
    const bf16* Wg = c.w<bf16>(GC_W); const float* UTg = c.w<float>(GC_UT); const bf16* QGg = c.w<bf16>(GC_QG); const bf16* KGTg = c.w<bf16>(GC_KGT); const bf16* AQKg = c.w<bf16>(GC_AQK); const float* GLg = c.w<float>(GC_GL);
    const float* gn = c.in<float>(17);
    const int tid = c.tid, lane = c.lane, w = c.wave;
    constexpr int NU = BATCH * 4;
    for (int u = u_first; u < NU; u += u_stride) {
        const int b = u >> 2, h = u & 3; const size_t mb = (size_t)b * SEQ;
        f32x4 S[8];
#pragma unroll
        for (int et = 0; et < 8; ++et) S[et] = (f32x4){0.f, 0.f, 0.f, 0.f};
        __syncthreads();
        for (int i = tid; i < 128 * 136 / 8; i += 512) { u32x4 z; z.x = z.y = z.z = z.w = 0u; *(u32x4*)(StT + 8 * i) = z; }
        u32x4 pw[2], pq[2], pk[2], pa;
        const size_t cu0 = (size_t)u * NCH;
#define GD_LOAD(n_) do { const bf16* g0 = Wg + (cu0 + (n_)) * 64 * 128; const bf16* g1 = QGg + (cu0 + (n_)) * 64 * 128; const bf16* g2 = KGTg + (cu0 + (n_)) * 128 * 64; const bf16* g3 = AQKg + (cu0 + (n_)) * 64 * 64; \
            _Pragma("unroll") for (int j = 0; j < 2; ++j) { const int idx = tid + 512 * j; pw[j] = *(const u32x4*)(g0 + 8 * idx); pq[j] = *(const u32x4*)(g1 + 8 * idx); pk[j] = *(const u32x4*)(g2 + 8 * idx); } \
            pa = *(const u32x4*)(g3 + 8 * tid); } while (0)
#define GD_STORE_WQ() do { _Pragma("unroll") for (int j = 0; j < 2; ++j) { const int idx = tid + 512 * j; *(u32x4*)(wl + (idx >> 4) * 136 + (idx & 15) * 8) = pw[j]; *(u32x4*)(qgl + (idx >> 4) * 136 + (idx & 15) * 8) = pq[j]; } } while (0)
#define GD_STORE_KA() do { _Pragma("unroll") for (int j = 0; j < 2; ++j) { const int idx = tid + 512 * j; *(u32x4*)(kgT + (idx >> 3) * 72 + (idx & 7) * 8) = pk[j]; } \
            *(u32x4*)(aqk + (tid >> 3) * 72 + (tid & 7) * 8) = pa; } while (0)
        GD_LOAD(0); GD_STORE_WQ(); GD_STORE_KA();
        __syncthreads();
        const int it = w & 3;
        const float gn0 = gn[lane], gn1 = gn[64 + lane];
        f32x4 u4[4]; float dec, decn;
#define GD_LOADU(dst, dd, n_) do { _Pragma("unroll") for (int e4 = 0; e4 < 4; ++e4) { const int et = (w >> 2) * 4 + e4; dst[e4] = *(const f32x4*)(UTg + ((cu0 + (n_)) * 128 + 16 * et + (lane & 15)) * 64 + 16 * it + 4 * (lane >> 4)); } dd = GLg[cu0 + (n_)]; } while (0)
        GD_LOADU(u4, decn, 0);
        for (int n = 0; n < NCH; ++n) {
            dec = decn;
            if (n + 1 < NCH) GD_LOAD(n + 1);
            f32x4 ao[4], av[4];
#pragma unroll
            for (int e4 = 0; e4 < 4; ++e4) { ao[e4] = (f32x4){0.f, 0.f, 0.f, 0.f}; av[e4] = (f32x4){0.f, 0.f, 0.f, 0.f}; }
#pragma unroll
            for (int ks = 0; ks < 4; ++ks) {
                const bf16x8 wa = ld8(wl + (16 * it + (lane & 15)) * 136 + ks * 32 + 8 * (lane >> 4)), qa = ld8(qgl + (16 * it + (lane & 15)) * 136 + ks * 32 + 8 * (lane >> 4));
                bf16x8 bs[4];
#pragma unroll
                for (int e4 = 0; e4 < 4; ++e4) bs[e4] = ld8(StT + (16 * ((w >> 2) * 4 + e4) + (lane & 15)) * 136 + ks * 32 + 8 * (lane >> 4));
#pragma unroll
                for (int e4 = 0; e4 < 4; ++e4) { av[e4] = mfma16(wa, bs[e4], av[e4]); ao[e4] = mfma16(qa, bs[e4], ao[e4]); }
            }
#pragma unroll
            for (int e4 = 0; e4 < 4; ++e4) { const int et = (w >> 2) * 4 + e4; const f32x4 vn = u4[e4] - av[e4];
                u32x2 o; o.x = pk2(vn[0], vn[1]); o.y = pk2(vn[2], vn[3]); *(u32x2*)(vnT + (16 * et + (lane & 15)) * 72 + 16 * it + 4 * (lane >> 4)) = o; }
            if (n + 1 < NCH) GD_LOADU(u4, decn, n + 1);
            LDS_BARRIER();
            float zz0[8], zz1[8];
#pragma unroll
            for (int i8 = 0; i8 < 8; ++i8) { const size_t m = mb + (size_t)n * 64 + w * 8 + i8; zz0[i8] = bf2f(P1[m * LD1 + C_Z + h * 128 + lane]); zz1[i8] = bf2f(P1[m * LD1 + C_Z + h * 128 + 64 + lane]); }
#pragma unroll
            for (int et = 0; et < 8; ++et) S[et] = S[et] * dec;
#pragma unroll
            for (int ks = 0; ks < 2; ++ks) {
                const bf16x8 aa = ld8(aqk + (16 * it + (lane & 15)) * 72 + ks * 32 + 8 * (lane >> 4)), ka = ld8(kgT + (16 * w + (lane & 15)) * 72 + ks * 32 + 8 * (lane >> 4));
                bf16x8 vf[8];
#pragma unroll
                for (int et = 0; et < 8; ++et) vf[et] = ld8(vnT + (16 * et + (lane & 15)) * 72 + ks * 32 + 8 * (lane >> 4));
#pragma unroll
                for (int e4 = 0; e4 < 4; ++e4) ao[e4] = mfma16(aa, (w >> 2) ? vf[4 + e4] : vf[e4], ao[e4]);
#pragma unroll
                for (int et = 0; et < 8; ++et) S[et] = mfma16(ka, vf[et], S[et]);
            }
#pragma unroll
            for (int e4 = 0; e4 < 4; ++e4) { const int et = (w >> 2) * 4 + e4;
#pragma unroll
                for (int r = 0; r < 4; ++r) ob[(16 * it + (lane >> 4) * 4 + r) * 132 + 16 * et + (lane & 15)] = ao[e4][r]; }
#pragma unroll
            for (int et = 0; et < 8; ++et) { u32x2 o; o.x = pk2(S[et][0], S[et][1]); o.y = pk2(S[et][2], S[et][3]); *(u32x2*)(StT + (16 * et + (lane & 15)) * 136 + 16 * w + (lane >> 4) * 4) = o; }
            if (n + 1 < NCH) GD_STORE_WQ();
            LDS_BARRIER();
            { float ss[8], v0[8], v1[8];
#pragma unroll
              for (int i8 = 0; i8 < 8; ++i8) { const int i = w * 8 + i8; v0[i8] = ob[i * 132 + lane]; v1[i8] = ob[i * 132 + 64 + lane]; ss[i8] = v0[i8] * v0[i8] + v1[i8] * v1[i8]; }
#pragma unroll
              for (int i8 = 0; i8 < 8; ++i8) ss[i8] = wave_sum(ss[i8]);
#pragma unroll
              for (int i8 = 0; i8 < 8; ++i8) { const size_t m = mb + (size_t)n * 64 + w * 8 + i8; const float r = rsqrtf(ss[i8] * (1.f / 128.f) + EPS);
                OCAT[m * D + h * 128 + lane] = (bf16)f2bf(v0[i8] * r * gn0 * siluf_(zz0[i8])); OCAT[m * D + h * 128 + 64 + lane] = (bf16)f2bf(v1[i8] * r * gn1 * siluf_(zz1[i8])); } }
            if (n + 1 < NCH) GD_STORE_KA();
        }
#undef GD_LOAD
#undef GD_LOADU
#undef GD_STORE_WQ
#undef GD_STORE_KA
        int lane3 = lane; OPAQUE_V(lane3);
        float* So = c.out + O_GDNP + (size_t)(b * 4 + h) * 16384;
#pragma unroll
        for (int et = 0; et < 8; ++et)
#pragma unroll
            for (int r = 0; r < 4; ++r) So[(size_t)(16 * w + (lane3 >> 4) * 4 + r) * 128 + 16 * et + (lane3 & 15)] = S[et][r];
    }
}


template <int NT> DEV void softmax_rows(f32x4 (&s)[NT], float (&mrun)[4], float (&lrun)[4], float (&alpha)[4], bf16* Ps, int pitch, int lane) {
#pragma unroll
    for (int r = 0; r < 4; ++r) {
        float mx = s[0][r];
#pragma unroll
        for (int nt = 1; nt < NT; ++nt) mx = fmaxf(mx, s[nt][r]);
        mx = grp16_max(mx);
        const float mn = fmaxf(mrun[r], mx);
        alpha[r] = exp2f_(mrun[r] - mn); mrun[r] = mn;
        float sum = 0.f;
#pragma unroll
        for (int nt = 0; nt < NT; ++nt) { const float p = exp2f_(s[nt][r] - mn); s[nt][r] = p; sum += p; }
        sum = grp16_sum(sum); lrun[r] = lrun[r] * alpha[r] + sum;
    }
#pragma unroll
    for (int nt = 0; nt < NT; ++nt)
#pragma unroll
        for (int r = 0; r < 4; ++r) Ps[((lane >> 4) * 4 + r) * pitch + nt * 16 + (lane & 15)] = (bf16)f2bf(s[nt][r]);
}
DEV bf16x8 ldB_tr(const bf16* T, int pitch, int k0, int n0, int lane) {
    const bf16* p = T + (size_t)(k0 + 8 * (lane >> 4) + ((lane & 15) >> 2)) * pitch + n0 + 4 * (lane & 3);
    const s16x4 a = lds_tr(p), b = lds_tr(p + 4 * pitch);
    bf16x8 r; r[0] = a[0]; r[1] = a[1]; r[2] = a[2]; r[3] = a[3]; r[4] = b[0]; r[5] = b[1]; r[6] = b[2]; r[7] = b[3]; return r;
}
constexpr int AS_NSP = 2;
DEV void phase_attn_sample2(const Ctx& c) {
    bf16* Qs = (bf16*)c.lds;
    bf16* Kt0 = Qs + 64 * 296;
    bf16* Psb = Kt0 + 2 * 32 * 296;
    bf16* qtmp = Kt0;
    float* Xo = (float*)c.lds;
    float* Xm = Xo + 64 * 256; float* Xl = Xm + 64;
    const float* QH = c.w<float>(WS_QH); const float* rope = c.w<float>(WS_ROPE); const bf16* WUKB = c.w<bf16>(WS_WUKB);
    float* PO = c.w<float>(WS_PO); float* PM = c.w<float>(WS_PM); float* PL = c.w<float>(WS_PL);
    const float* clat = c.in<float>(4); const float* ckr = c.in<float>(5); const int* ptab = c.in<int>(7);
    const int tid = c.tid, lane = c.lane, w = c.wave, grp = w >> 2, wq = w & 3, gt = tid & 255;
    bf16* Kt = Kt0 + grp * 32 * 296; bf16* Ps = Psb + w * 16 * 40;
    constexpr int NPT32 = PAST / 32, TPS = NPT32 / AS_NSP;
    static_assert(NPT32 % (2 * AS_NSP) == 0, "tiles per split must be even");
    for (int u = blockIdx.x; u < DECB * AS_NSP; u += gridDim.x) {
        const int b = u / AS_NSP, sp = u % AS_NSP; const size_t mb = (size_t)MP + (size_t)b * DECS;
        __syncthreads();
        for (int idx = tid; idx < 64 * 8; idx += 512) { const int r = idx >> 3, ch = idx & 7, t = r >> 3, h = r & 7; const float* q = QH + (mb + t) * 768 + h * 96 + ch * 8;
            const f32x4 a = *(const f32x4*)q, bq = *(const f32x4*)(q + 4); u32x4 o; o.x = pk2(a[0], a[1]); o.y = pk2(a[2], a[3]); o.z = pk2(bq[0], bq[1]); o.w = pk2(bq[2], bq[3]); *(u32x4*)(qtmp + r * 72 + ch * 8) = o; }
        for (int idx = tid; idx < 64 * 16; idx += 512) { const int r = idx >> 4, f = idx & 15, t = r >> 3, h = r & 7; const float* qrow = QH + (mb + t) * 768 + h * 96 + 64;
            const float* rt = rope + (size_t)(SEQ + t) * 32; const float cs = rt[f], sn = rt[16 + f], x1 = qrow[f], x2 = qrow[16 + f];
            Qs[r * 296 + 256 + f] = (bf16)f2bf((x1 * cs - x2 * sn) * QK_SCALE2); Qs[r * 296 + 272 + f] = (bf16)f2bf((x2 * cs + x1 * sn) * QK_SCALE2); }
        __syncthreads();
        {
            const int h = w; bf16x8 af[2];
#pragma unroll
            for (int ks = 0; ks < 2; ++ks) af[ks] = ld8(qtmp + (((lane & 7)) * 8 + h) * 72 + ks * 32 + 8 * (lane >> 4));
#pragma unroll 4
            for (int nt = 0; nt < 16; ++nt) { f32x4 acc = (f32x4){0.f, 0.f, 0.f, 0.f};
#pragma unroll
                for (int ks = 0; ks < 2; ++ks) acc = mfma16(af[ks], ld8(WUKB + (size_t)(nt * 16 + (lane & 15)) * 512 + h * 64 + ks * 32 + 8 * (lane >> 4)), acc);
                if ((lane >> 4) < 2) {
#pragma unroll
                    for (int r = 0; r < 4; ++r) Qs[(((lane >> 4) * 4 + r) * 8 + h) * 296 + nt * 16 + (lane & 15)] = (bf16)f2bf(acc[r] * QK_SCALE2); } }
        }
        __syncthreads();
        float mrun[4], lrun[4], alpha[4]; f32x4 o[16];
#pragma unroll
        for (int r = 0; r < 4; ++r) { mrun[r] = -INFINITY; lrun[r] = 0.f; }
#pragma unroll
        for (int nt = 0; nt < 16; ++nt) o[nt] = (f32x4){0.f, 0.f, 0.f, 0.f};
        const int t_begin = sp * TPS, t_end = t_begin + TPS + (sp == AS_NSP - 1 ? 1 : 0);
        const int NI = (t_end - t_begin + 1) / 2;
        static_assert(NPAGES <= 64, "page table of one batch row is held one entry per lane");
        const int ptv = lane < NPAGES ? ptab[b * NPAGES + lane] : 0;
#ifdef HIPEMU
#define PT_LOOKUP(pg_) __shfl(ptv, (pg_))
#else
#define PT_LOOKUP(pg_) __builtin_amdgcn_readlane(ptv, (pg_))
#endif
        f32x4 plA[8], prA, plB[8], prB;
        const float* nl = c.out + O_LATS + (size_t)b * DECS * 256; const float* nk = c.out + O_KPES + (size_t)b * DECS * 32;
#define AS_LOAD(pl, pr, tile_) do { const int tl_ = (tile_); \
            if (tl_ < NPT32) { const int k0_ = tl_ * 32; const size_t rb_ = (size_t)PT_LOOKUP(k0_ >> 7) * PAGE + (k0_ & 127); \
                _Pragma("unroll") for (int j = 0; j < 8; ++j) { const int idx = gt + 256 * j; pl[j] = *(const f32x4*)(clat + (rb_ + (idx >> 6)) * 256 + 4 * (idx & 63)); } \
                pr = *(const f32x4*)(ckr + (rb_ + (gt >> 3)) * 32 + 4 * (gt & 7)); } \
            else if (tl_ == NPT32) { \
                _Pragma("unroll") for (int j = 0; j < 8; ++j) { const int idx = gt + 256 * j, key = idx >> 6; pl[j] = key < DECS ? *(const f32x4*)(nl + key * 256 + 4 * (idx & 63)) : (f32x4){0.f, 0.f, 0.f, 0.f}; } \
                pr = (gt >> 3) < DECS ? *(const f32x4*)(nk + (gt >> 3) * 32 + 4 * (gt & 7)) : (f32x4){0.f, 0.f, 0.f, 0.f}; } } while (0)
#define AS_ITER(pl, pr, it_) do { \
            const int tile = t_begin + 2 * (it_) + grp; const bool valid = tile < t_end; \
            if (valid) { \
                _Pragma("unroll") for (int j = 0; j < 8; ++j) { const int idx = gt + 256 * j; u32x2 pk; pk.x = pk2(pl[j][0], pl[j][1]); pk.y = pk2(pl[j][2], pl[j][3]); *(u32x2*)(Kt + (idx >> 6) * 296 + 4 * (idx & 63)) = pk; } \
                { u32x2 pk; pk.x = pk2(pr[0], pr[1]); pk.y = pk2(pr[2], pr[3]); *(u32x2*)(Kt + (gt >> 3) * 296 + 256 + 4 * (gt & 7)) = pk; } \
            } \
            { const int nt_ = tile + 4; AS_LOAD(pl, pr, nt_ < t_end ? nt_ : NPT32 + 1); } \
            LDS_BARRIER(); \
            if (valid) { \
                f32x4 s[2], s2_[2]; \
                _Pragma("unroll") for (int nt = 0; nt < 2; ++nt) { s[nt] = (f32x4){0.f, 0.f, 0.f, 0.f}; s2_[nt] = (f32x4){0.f, 0.f, 0.f, 0.f}; } \
                _Pragma("unroll") for (int ks = 0; ks < 9; ++ks) {   \
                    const bf16x8 qa_ = ld8(Qs + (wq * 16 + (lane & 15)) * 296 + ks * 32 + 8 * (lane >> 4)); \
                    const bf16x8 k0_ = ld8(Kt + ((lane & 15)) * 296 + ks * 32 + 8 * (lane >> 4)), k1_ = ld8(Kt + (16 + (lane & 15)) * 296 + ks * 32 + 8 * (lane >> 4)); \
                    if (ks & 1) { s2_[0] = mfma16(qa_, k0_, s2_[0]); s2_[1] = mfma16(qa_, k1_, s2_[1]); } else { s[0] = mfma16(qa_, k0_, s[0]); s[1] = mfma16(qa_, k1_, s[1]); } } \
                s[0] += s2_[0]; s[1] += s2_[1]; \
                if (tile == NPT32) { \
                    _Pragma("unroll") for (int nt = 0; nt < 2; ++nt) \
                        _Pragma("unroll") for (int r = 0; r < 4; ++r) { const int row = wq * 16 + (lane >> 4) * 4 + r, key = nt * 16 + (lane & 15); if (key >= DECS || key > (row >> 3)) s[nt][r] = -INFINITY; } \
                } \
                softmax_rows<2>(s, mrun, lrun, alpha, Ps, 40, lane); \
                WAVE_SYNC(); \
                const bf16x8 pf = ld8(Ps + (lane & 15) * 40 + 8 * (lane >> 4)); \
                if (wave_any((alpha[0] != 1.f) | (alpha[1] != 1.f) | (alpha[2] != 1.f) | (alpha[3] != 1.f))) { \
                    _Pragma("unroll") for (int nt = 0; nt < 16; ++nt) \
                        _Pragma("unroll") for (int r = 0; r < 4; ++r) o[nt][r] *= alpha[r]; } \
                _Pragma("unroll") for (int nt = 0; nt < 16; ++nt) o[nt] = mfma16(pf, ldB_tr(Kt, 296, 0, nt * 16, lane), o[nt]); \
            } \
            LDS_BARRIER(); } while (0)
        AS_LOAD(plA, prA, t_begin + grp < t_end ? t_begin + grp : NPT32 + 1);
        AS_LOAD(plB, prB, t_begin + 2 + grp < t_end ? t_begin + 2 + grp : NPT32 + 1);
#pragma unroll 1
        for (int it = 0; it < NI; it += 2) {
            AS_ITER(plA, prA, it);
            if (it + 1 < NI) AS_ITER(plB, prB, it + 1);
        }
#undef AS_ITER
#undef PT_LOOKUP
#undef AS_LOAD
        int lane2 = lane; OPAQUE_V(lane2);
        if (grp == 1) {
#pragma unroll
            for (int nt = 0; nt < 16; ++nt)
#pragma unroll
                for (int r = 0; r < 4; ++r) Xo[(wq * 16 + (lane2 >> 4) * 4 + r) * 256 + nt * 16 + (lane2 & 15)] = o[nt][r];
            if ((lane2 & 15) == 0) {
#pragma unroll
                for (int r = 0; r < 4; ++r) { Xm[wq * 16 + (lane2 >> 4) * 4 + r] = mrun[r]; Xl[wq * 16 + (lane2 >> 4) * 4 + r] = lrun[r]; } }
        }
        __syncthreads();
        if (grp == 0) {
            float a1[4], a2[4];
#pragma unroll
            for (int r = 0; r < 4; ++r) { const int row = wq * 16 + (lane2 >> 4) * 4 + r; const float m2 = Xm[row], l2 = Xl[row]; const float mm = fmaxf(mrun[r], m2);
                a1[r] = exp2f_(mrun[r] - mm); a2[r] = exp2f_(m2 - mm); lrun[r] = lrun[r] * a1[r] + l2 * a2[r]; mrun[r] = mm;
                if ((lane2 & 15) == 0) { PM[(size_t)u * 64 + row] = mm; PL[(size_t)u * 64 + row] = lrun[r]; } }
#pragma unroll
            for (int nt = 0; nt < 16; ++nt)
#pragma unroll
                for (int r = 0; r < 4; ++r) { const int row = wq * 16 + (lane2 >> 4) * 4 + r, col = nt * 16 + (lane2 & 15); PO[((size_t)u * 64 + row) * 256 + col] = o[nt][r] * a1[r] + Xo[row * 256 + col] * a2[r]; }
        }
    }
}
DEV void phase_attn_sample_combine(const Ctx& c) {
    bf16* Ol = (bf16*)c.lds;
    const float* PO = c.w<float>(WS_PO); const float* PM = c.w<float>(WS_PM); const float* PL = c.w<float>(WS_PL);
    const bf16* WUV = c.w<bf16>(WS_WUKV) + (size_t)512 * 256; bf16* OCAT = c.w<bf16>(WS_OCAT);
    const int tid = c.tid, lane = c.lane, w = c.wave;
    for (int b = (int)gridDim.x - 1 - (int)blockIdx.x; b < DECB; b += gridDim.x) {
        const size_t mb = (size_t)MP + (size_t)b * DECS;
        __syncthreads();
        for (int idx = tid; idx < 64 * 64; idx += 512) { const int row = idx >> 6, c4 = idx & 63;
            float mm = -INFINITY;
#pragma unroll
            for (int s = 0; s < AS_NSP; ++s) mm = fmaxf(mm, PM[((size_t)b * AS_NSP + s) * 64 + row]);
            float lt = 0.f; f32x4 acc = (f32x4){0.f, 0.f, 0.f, 0.f};
#pragma unroll
            for (int s = 0; s < AS_NSP; ++s) { const size_t ur = ((size_t)b * AS_NSP + s) * 64 + row; const float a = exp2f_(PM[ur] - mm); lt += PL[ur] * a; acc += *(const f32x4*)(PO + ur * 256 + 4 * c4) * a; }
            const float inv = 1.f / lt; u32x2 o; o.x = pk2(acc[0] * inv, acc[1] * inv); o.y = pk2(acc[2] * inv, acc[3] * inv); *(u32x2*)(Ol + row * 264 + 4 * c4) = o; }
        __syncthreads();
        { const int h = w;
#pragma unroll
          for (int nt = 0; nt < 4; ++nt) { f32x4 acc = (f32x4){0.f, 0.f, 0.f, 0.f};
#pragma unroll
            for (int ks = 0; ks < 8; ++ks) acc = mfma16(ld8(Ol + ((lane & 7) * 8 + h) * 264 + ks * 32 + 8 * (lane >> 4)), ld8(WUV + (size_t)(h * 64 + nt * 16 + (lane & 15)) * 256 + ks * 32 + 8 * (lane >> 4)), acc);
            if ((lane >> 4) < 2) {
#pragma unroll
                for (int r = 0; r < 4; ++r) OCAT[(mb + (lane >> 4) * 4 + r) * D + 512 + h * 64 + nt * 16 + (lane & 15)] = (bf16)f2bf(acc[r]); } } }
    }
}

DEV bf16x8 cvt8(const f32x4 a, const f32x4 b, float sc) { bf16x8 r; const u32x4 p = {pk2(a[0] * sc, a[1] * sc), pk2(a[2] * sc, a[3] * sc), pk2(b[0] * sc, b[1] * sc), pk2(b[2] * sc, b[3] * sc)};
    r = __builtin_bit_cast(bf16x8, p); return r; }
DEV void phase_attn_prompt2(const Ctx& c, int qid = 0) {
    bf16* KV0 = (bf16*)c.lds;
    constexpr int KVB = 64 * 104 + 64 * 72;
    bf16* Psb = KV0 + 2 * KVB;
    const float* QH = c.w<float>(WS_QH); const bf16* KVP = c.w<bf16>(WS_KVP); const bf16* KPEB = c.w<bf16>(WS_KPEB); const float* rope = c.w<float>(WS_ROPE); bf16* OCAT = c.w<bf16>(WS_OCAT);
    const int tid = c.tid, lane = c.lane, w = c.wave;
    bf16* Ps = Psb + w * 32 * 72;
    constexpr int NQB = SEQ / 256, NPU = NQB * BATCH * 8;
    for (;;) {
        const int pu = queue_next(c, qid);
        if (pu >= NPU) break;
        const int qb = NQB - 1 - pu / (BATCH * 8), bh = pu % (BATCH * 8), b = bh >> 3, h = bh & 7; const size_t mb = (size_t)b * SEQ;
        {
            const int q0 = qb * 256, rmin = q0 + 32 * w;
            bf16x8 qf[2][3];
#pragma unroll
            for (int mt = 0; mt < 2; ++mt) { const int qr = rmin + 16 * mt + (lane & 15); const float* qrow = QH + (mb + qr) * 768 + h * 96; const int g = lane >> 4;
#pragma unroll
                for (int ks = 0; ks < 2; ++ks) qf[mt][ks] = cvt8(*(const f32x4*)(qrow + ks * 32 + 8 * g), *(const f32x4*)(qrow + ks * 32 + 8 * g + 4), QK_SCALE2);
                const int f0 = 8 * (g & 1); const float* rt = rope + (size_t)qr * 32;
                const f32x4 x1a = *(const f32x4*)(qrow + 64 + f0), x1b = *(const f32x4*)(qrow + 64 + f0 + 4), x2a = *(const f32x4*)(qrow + 80 + f0), x2b = *(const f32x4*)(qrow + 80 + f0 + 4);
                const f32x4 ca = *(const f32x4*)(rt + f0), cb = *(const f32x4*)(rt + f0 + 4), sa = *(const f32x4*)(rt + 16 + f0), sb = *(const f32x4*)(rt + 16 + f0 + 4);
                const f32x4 ya = g < 2 ? x1a * ca - x2a * sa : x2a * ca + x1a * sa, yb = g < 2 ? x1b * cb - x2b * sb : x2b * cb + x1b * sb;
                qf[mt][2] = cvt8(ya, yb, QK_SCALE2); }
            float mrun[2][4], lrun[2][4], alpha[2][4]; f32x4 o[2][4];
#pragma unroll
            for (int mt = 0; mt < 2; ++mt) {
#pragma unroll
                for (int r = 0; r < 4; ++r) { mrun[mt][r] = -INFINITY; lrun[mt][r] = 0.f; }
#pragma unroll
                for (int nt = 0; nt < 4; ++nt) o[mt][nt] = (f32x4){0.f, 0.f, 0.f, 0.f}; }
            const int nkt = 4 * qb + 4;
            u32x4 pk_, pp_, pv_;
#define AP_LOAD(kt_) do { const size_t kr_ = mb + (size_t)(kt_) * 64; \
                pk_ = *(const u32x4*)(KVP + (kr_ + (tid >> 3)) * 1024 + h * 64 + (tid & 7) * 8); \
                pv_ = *(const u32x4*)(KVP + (kr_ + (tid >> 3)) * 1024 + 512 + h * 64 + (tid & 7) * 8); \
                if (tid < 256) pp_ = *(const u32x4*)(KPEB + (kr_ + (tid >> 2)) * 32 + (tid & 3) * 8); } while (0)
#define AP_STORE(buf_) do { bf16* Kb_ = KV0 + (buf_) * KVB; bf16* Vb_ = Kb_ + 64 * 104; \
                *(u32x4*)(Kb_ + (tid >> 3) * 104 + (tid & 7) * 8) = pk_; *(u32x4*)(Vb_ + (tid >> 3) * 72 + (tid & 7) * 8) = pv_; \
                if (tid < 256) *(u32x4*)(Kb_ + (tid >> 2) * 104 + 64 + (tid & 3) * 8) = pp_; } while (0)
            __syncthreads();
            AP_LOAD(0); AP_STORE(0);
            if (nkt > 1) AP_LOAD(1);
            __syncthreads();
            for (int kt = 0; kt < nkt; ++kt) {
                const bf16* Ks = KV0 + (kt & 1) * KVB; const bf16* Vs = Ks + 64 * 104;
                if (kt + 1 < nkt) AP_STORE((kt + 1) & 1);
                if (kt + 2 < nkt) AP_LOAD(kt + 2);
                const int k0 = kt * 64;
                if (k0 <= rmin + 31) {
                    f32x4 s[2][4];
#pragma unroll
                    for (int nt = 0; nt < 4; ++nt) { s[0][nt] = (f32x4){0.f, 0.f, 0.f, 0.f}; s[1][nt] = (f32x4){0.f, 0.f, 0.f, 0.f}; }
#pragma unroll
                    for (int ks = 0; ks < 3; ++ks) {
                        bf16x8 kf[4];
#pragma unroll
                        for (int nt = 0; nt < 4; ++nt) kf[nt] = ld8(Ks + (nt * 16 + (lane & 15)) * 104 + ks * 32 + 8 * (lane >> 4));
#pragma unroll
                        for (int nt = 0; nt < 4; ++nt) { s[0][nt] = mfma16(qf[0][ks], kf[nt], s[0][nt]); s[1][nt] = mfma16(qf[1][ks], kf[nt], s[1][nt]); } }
                    if (k0 + 63 > rmin) {
#pragma unroll
                        for (int mt = 0; mt < 2; ++mt)
#pragma unroll
                            for (int nt = 0; nt < 4; ++nt)
#pragma unroll
                                for (int r = 0; r < 4; ++r) { const int qpos = rmin + 16 * mt + (lane >> 4) * 4 + r, kpos = k0 + nt * 16 + (lane & 15); if (kpos > qpos) s[mt][nt][r] = -INFINITY; }
                    }
                    softmax_rows<4>(s[0], mrun[0], lrun[0], alpha[0], Ps, 72, lane);
                    softmax_rows<4>(s[1], mrun[1], lrun[1], alpha[1], Ps + 16 * 72, 72, lane);
                    WAVE_SYNC();
                    if (wave_any((alpha[0][0] != 1.f) | (alpha[0][1] != 1.f) | (alpha[0][2] != 1.f) | (alpha[0][3] != 1.f) | (alpha[1][0] != 1.f) | (alpha[1][1] != 1.f) | (alpha[1][2] != 1.f) | (alpha[1][3] != 1.f))) {
#pragma unroll
                    for (int mt = 0; mt < 2; ++mt)
#pragma unroll
                        for (int nt = 0; nt < 4; ++nt)
#pragma unroll
                            for (int r = 0; r < 4; ++r) o[mt][nt][r] *= alpha[mt][r]; }
#pragma unroll
                    for (int k2 = 0; k2 < 2; ++k2) { const bf16x8 p0 = ld8(Ps + (lane & 15) * 72 + k2 * 32 + 8 * (lane >> 4)), p1 = ld8(Ps + (16 + (lane & 15)) * 72 + k2 * 32 + 8 * (lane >> 4));
                        bf16x8 vf[4];
#pragma unroll
                        for (int nt = 0; nt < 4; ++nt) vf[nt] = ldB_tr(Vs, 72, k2 * 32, nt * 16, lane);
#pragma unroll
                        for (int nt = 0; nt < 4; ++nt) { o[0][nt] = mfma16(p0, vf[nt], o[0][nt]); o[1][nt] = mfma16(p1, vf[nt], o[1][nt]); } }
                    WAVE_SYNC();
                }
                LDS_BARRIER();
            }
#undef AP_LOAD
#undef AP_STORE
#pragma unroll
            for (int mt = 0; mt < 2; ++mt)
#pragma unroll
                for (int nt = 0; nt < 4; ++nt)
#pragma unroll
                    for (int r = 0; r < 4; ++r) OCAT[(mb + rmin + 16 * mt + (lane >> 4) * 4 + r) * D + 512 + h * 64 + nt * 16 + (lane & 15)] = (bf16)f2bf(o[mt][nt][r] / lrun[mt][r]);
        }
    }
}

DEV void phase_gdn_sample(const Ctx& c, int wg_first, int wg_stride) {
    float* red = (float*)c.lds; float* red2 = red + 512; float* qs = red2 + 512; float* ks = qs + 128; float* vs = ks + 128; float* part = vs + 128;
    float* scb = part + 8; float* scg = scb + 8; float* obuf = scg + 8;
    const bf16* P1 = c.w<bf16>(WS_P1); bf16* OCAT = c.w<bf16>(WS_OCAT);
    const float* convw = c.in<float>(14); const float* gn = c.in<float>(17);
    const int tid = c.tid, lane = c.lane, wave = c.wave;
    const int e = tid & 127, dg = tid >> 7, d0 = dg * 32;
    for (int u = wg_first; u < DECB * 4; u += wg_stride) {
        const int b = u >> 2, h = u & 3; const size_t m0 = (size_t)MP + (size_t)b * DECS;
        float s[32];
        { const float* S0 = c.in<float>(2) + ((size_t)(b * 4 + h) * 128 + d0) * 128 + e;
#pragma unroll
          for (int i = 0; i < 32; ++i) s[i] = S0[(size_t)i * 128]; }
        const int col = tid < 128 ? h * 128 + tid : (tid < 256 ? 512 + h * 128 + (tid - 128) : 1024 + h * 128 + (tid - 256));
        float w0 = 0.f, w1 = 0.f, w2 = 0.f, w3 = 0.f, x0 = 0.f, x1 = 0.f, x2 = 0.f; bf16 xs[8];
#pragma unroll
        for (int t = 0; t < 8; ++t) xs[t] = 0;
        if (tid < 384) { w0 = convw[col]; w1 = convw[QKV_A + col]; w2 = convw[2 * QKV_A + col]; w3 = convw[3 * QKV_A + col];
            const float* cb = c.in<float>(3) + (size_t)b * 3 * QKV_A + col; x0 = cb[0]; x1 = cb[QKV_A]; x2 = cb[2 * QKV_A];
#pragma unroll
            for (int t = 0; t < 8; ++t) xs[t] = P1[(m0 + t) * LD1 + col]; }
        else if (tid < 392) { const int t = tid - 384; const float Aexp = __expf(c.in<float>(15)[h]), dtb = c.in<float>(16)[h];
            scb[t] = sigmoidf_(bf2f(P1[(m0 + t) * LD1 + C_B + h])); scg[t] = __expf(-Aexp * softplusf_(bf2f(P1[(m0 + t) * LD1 + C_A + h]) + dtb)); }
        const bf16 zr0 = P1[(m0 + wave) * LD1 + C_Z + h * 128 + lane], zr1 = P1[(m0 + wave) * LD1 + C_Z + h * 128 + 64 + lane];
#pragma unroll
        for (int t = 0; t < 8; ++t) {
            float val = 0.f;
            if (tid < 384) { const float x3 = bf2f(xs[t]); const float y = w0 * x0 + w1 * x1 + w2 * x2 + w3 * x3; val = siluf_(y); x0 = x1; x1 = x2; x2 = x3; }
            const float sq = wave_sum(tid < 256 ? val * val : 0.f);
            if (tid < 128) qs[tid] = val; else if (tid < 256) ks[tid - 128] = val; else if (tid < 384) vs[tid - 256] = val;
            if (lane == 0 && wave < 4) part[wave] = sq;
            LDS_BARRIER();
            const float qn = rsqrtf(part[0] + part[1] + EPS), kn = rsqrtf(part[2] + part[3] + EPS), beta = scb[t], dec = scg[t];
            float kp = 0.f;
#pragma unroll
            for (int i = 0; i < 32; ++i) { s[i] *= dec; kp += ks[d0 + i] * s[i]; }
            red[dg * 128 + e] = kp * kn;
            LDS_BARRIER();
            const float kS = (red[e] + red[128 + e]) + (red[256 + e] + red[384 + e]);
            const float delta = beta * (vs[e] - kS) * kn;
            float op = 0.f;
#pragma unroll
            for (int i = 0; i < 32; ++i) { s[i] += ks[d0 + i] * delta; op += qs[d0 + i] * s[i]; }
            red2[dg * 128 + e] = op * qn;
            LDS_BARRIER();
            if (dg == 0) obuf[t * 128 + e] = ((red2[e] + red2[128 + e]) + (red2[256 + e] + red2[384 + e])) * DK_SCALE;
        }
        float* So = c.out + O_GDNS + ((size_t)(b * 4 + h) * 128 + d0) * 128 + e;
#pragma unroll
        for (int i = 0; i < 32; ++i) So[(size_t)i * 128] = s[i];
        LDS_BARRIER();
        {
            const size_t m = m0 + wave; const float v0 = obuf[wave * 128 + lane], v1 = obuf[wave * 128 + 64 + lane];
            const float r = rsqrtf(wave_sum(v0 * v0 + v1 * v1) * (1.f / 128.f) + EPS);
            OCAT[m * D + h * 128 + lane] = (bf16)f2bf(v0 * r * gn[lane] * siluf_(bf2f(zr0)));
            OCAT[m * D + h * 128 + 64 + lane] = (bf16)f2bf(v1 * r * gn[64 + lane] * siluf_(bf2f(zr1))); }
        LDS_BARRIER();
    }
}
DEV void phase_hgrn_sample(const Ctx& c, int wg_first, int wg_stride) {
    float* red = (float*)c.lds; float* qs = red + 512; float* fs = qs + 128; float* obuf = fs + 128;
    const bf16* PC = c.w<bf16>(WS_P1); bf16* OC = c.w<bf16>(WS_OCAT);
    const float* lbl = c.in<float>(25); const float* gn = c.in<float>(26);
    const int tid = c.tid, lane = c.lane, wave = c.wave;
    const int e = tid & 127, dg = tid >> 7, d0 = dg * 32;
    for (int u = wg_first; u < DECB * 8; u += wg_stride) {
        const int b = u >> 3, h = u & 7; const size_t m0 = (size_t)MP + (size_t)b * DECS;
        float s[32];
        { const float* S0 = c.in<float>(6) + ((size_t)(b * 8 + h) * 128 + d0) * 128 + e;
#pragma unroll
          for (int i = 0; i < 32; ++i) s[i] = S0[(size_t)i * 128]; }
        bf16 rq[8], rf[8], rv[8]; float lb = 0.f;
#pragma unroll
        for (int t = 0; t < 8; ++t) { rq[t] = 0; rf[t] = 0; rv[t] = PC[(m0 + t) * INC + 2048 + h * 128 + e]; }
        if (tid < 128) { lb = sigmoidf_(lbl[1024 + h * 128 + tid] - lbl[h * 128 + tid]);
#pragma unroll
            for (int t = 0; t < 8; ++t) { rq[t] = PC[(m0 + t) * INC + h * 128 + tid]; rf[t] = PC[(m0 + t) * INC + 1024 + h * 128 + tid]; } }
        const bf16 zr0 = PC[(m0 + wave) * INC + 3072 + h * 128 + lane], zr1 = PC[(m0 + wave) * INC + 3072 + h * 128 + 64 + lane];
#pragma unroll
        for (int t = 0; t < 8; ++t) {
            if (tid < 128) { qs[tid] = siluf_(bf2f(rq[t])); fs[tid] = lb + (1.f - lb) * sigmoidf_(bf2f(rf[t])); }
            const float v = bf2f(rv[t]);
            LDS_BARRIER();
            float op = 0.f;
#pragma unroll
            for (int i = 0; i < 32; ++i) { const float f = fs[d0 + i]; s[i] = f * s[i] + (1.f - f) * v; op += qs[d0 + i] * s[i]; }
            red[dg * 128 + e] = op;
            LDS_BARRIER();
            if (dg == 0) obuf[t * 128 + e] = ((red[e] + red[128 + e]) + (red[256 + e] + red[384 + e])) * DK_SCALE;
        }
        float* So = c.out + O_HGS + ((size_t)(b * 8 + h) * 128 + d0) * 128 + e;
#pragma unroll
        for (int i = 0; i < 32; ++i) So[(size_t)i * 128] = s[i];
        LDS_BARRIER();
        { const size_t m = m0 + wave; const float v0 = obuf[wave * 128 + lane], v1 = obuf[wave * 128 + 64 + lane];
          const float r = rsqrtf(wave_sum(v0 * v0 + v1 * v1) * (1.f / 128.f) + EPS);
          OC[m * D + h * 128 + lane] = (bf16)f2bf(v0 * r * gn[lane] * siluf_(bf2f(zr0)));
          OC[m * D + h * 128 + 64 + lane] = (bf16)f2bf(v1 * r * gn[64 + lane] * siluf_(bf2f(zr1))); }
        LDS_BARRIER();
    }
}

#ifndef HIPEMU
#define XB_TMO      128
#define XB_XCNT(j)  (256  + 64 * (j))
#define XB_XSUB(j)  (1280 + 64 * (j))
#define XB_XGEN(j)  (2304 + 64 * (j))
#define XB_TOP      3328
#define XB_TOPGEN   3392
#define XCD_BAR_WORDS 3456
#define XB_SPIN_CAP (1u << 22)
#define LAS __attribute__((address_space(3)))
__device__ __forceinline__ unsigned xb_ld(unsigned* p)              { return __hip_atomic_load(p, __ATOMIC_RELAXED, __HIP_MEMORY_SCOPE_AGENT); }
__device__ __forceinline__ unsigned xb_add(unsigned* p, unsigned v) { return __hip_atomic_fetch_add(p, v, __ATOMIC_RELAXED, __HIP_MEMORY_SCOPE_AGENT); }
__device__ __forceinline__ unsigned xb_xcc_id() { return (unsigned)__builtin_amdgcn_s_getreg((3 << 11) | 20) & 0xFu; }
#define XB_SPIN(cond, bar) do { unsigned _sp = 0; while (cond) { __builtin_amdgcn_s_sleep(1); \
    if ((++_sp & 255u) == 0u) { if (xb_ld(&(bar)[XB_TMO])) break; if (_sp > XB_SPIN_CAP) { atomicAdd(&(bar)[XB_TMO], 1u); break; } } } } while (0)
struct XcdBarrier { unsigned* bar; unsigned x; volatile LAS unsigned* st; bool t0; };
__device__ __forceinline__ XcdBarrier xcd_barrier_post(unsigned* bar, volatile LAS unsigned* st, bool t0) {
    XcdBarrier b; b.bar = bar; b.x = xb_xcc_id(); b.st = st; b.t0 = t0;
    if (t0) (void)xb_add(&bar[XB_XCNT(b.x)], 1u);
    return b;
}
__device__ __forceinline__ void xcd_barrier_complete(unsigned* bar, unsigned x, unsigned& nloc, unsigned& nx) {
    const unsigned G = gridDim.x * gridDim.y * gridDim.z;
    unsigned sum, cnt, mine, sp = 0u;
    for (;;) {
        sum = 0u; cnt = 0u; mine = 0u;
#pragma unroll
        for (unsigned j = 0; j < 16; ++j) { const unsigned c = xb_ld(&bar[XB_XCNT(j)]); sum += c; cnt += (c > 0u) ? 1u : 0u; mine = (j == x) ? c : mine; }
        if (sum == G) break;
        __builtin_amdgcn_s_sleep(1);
        if ((++sp & 255u) == 0u) { if (xb_ld(&bar[XB_TMO])) break; if (sp > XB_SPIN_CAP) { atomicAdd(&bar[XB_TMO], 1u); break; } }
    }
    nloc = mine > 0u ? mine : 1u; nx = cnt > 0u ? cnt : 1u;
}
__device__ __forceinline__ void xcd_barrier(const XcdBarrier& b) {
    asm volatile("s_waitcnt vmcnt(0)" ::: "memory");
    __syncthreads();
    if (b.t0) {
        unsigned* bar = b.bar;
        __builtin_amdgcn_s_waitcnt(0);
        unsigned nloc = b.st[0], nx = b.st[1];
        if (nloc == 0u) { xcd_barrier_complete(bar, b.x, nloc, nx); b.st[0] = nloc; b.st[1] = nx; }
        const unsigned old = xb_add(&bar[XB_XSUB(b.x)], 1u);
        const unsigned gen = old / nloc;
        if (old + 1u == (gen + 1u) * nloc) {
            __builtin_amdgcn_fence(__ATOMIC_RELEASE, "agent");
            asm volatile("s_waitcnt vmcnt(0)" ::: "memory");
            const unsigned og = xb_add(&bar[XB_TOP], 1u);
            const unsigned tg = og / nx;
            if (og + 1u == (tg + 1u) * nx) xb_add(&bar[XB_TOPGEN], 1u);
            else XB_SPIN(xb_ld(&bar[XB_TOPGEN]) == tg, bar);
            __builtin_amdgcn_fence(__ATOMIC_ACQUIRE, "agent");
            xb_add(&bar[XB_XGEN(b.x)], 1u);
            asm volatile("s_waitcnt vmcnt(0)" ::: "memory");
        } else {
            XB_SPIN(xb_ld(&bar[XB_XGEN(b.x)]) == gen, bar);
            __builtin_amdgcn_fence(__ATOMIC_ACQUIRE, "agent");
            asm volatile("s_waitcnt vmcnt(0)" ::: "memory");
        }
    }
    __syncthreads();
}
#endif

__global__ void __launch_bounds__(512, 2) mega_kernel(Params p) {
#ifdef HIPEMU
    unsigned char* lds = g_blk->smem;
#else
    extern __shared__ __attribute__((aligned(16))) unsigned char lds[];
#endif
    const int lo = p.ph_lo, hi = p.ph_hi;
#ifdef HIPEMU
    const int wave_s = threadIdx.x >> 6;
#define FRESH_LANE() ((int)(threadIdx.x & 63))
#define GRID_BAR(k) do { } while (0)
#else
    const int wave_s = __builtin_amdgcn_readfirstlane(threadIdx.x >> 6);
#define FRESH_LANE() ({ int l_; asm volatile("v_mbcnt_lo_u32_b32 %0, -1, 0\n\tv_mbcnt_hi_u32_b32 %0, -1, %0" : "=v"(l_)); l_; })
    { const int l0 = FRESH_LANE(); if (wave_s == 0) ((volatile LAS unsigned*)(lds + LDS_MISC))[l0] = 0u; }
    __syncthreads();
    if (hi - lo > 1) (void)xcd_barrier_post((unsigned*)(p.ws + WS_CTL), (volatile LAS unsigned*)(lds + LDS_MISC), wave_s == 0 && FRESH_LANE() == 0);
#define GRID_BAR(k) do { if (lo <= (k) && (k) + 1 < hi) { XcdBarrier bb_; bb_.bar = (unsigned*)(p.ws + WS_CTL); bb_.x = xb_xcc_id(); bb_.st = (volatile LAS unsigned*)(lds + LDS_MISC); bb_.t0 = (wave_s == 0 && FRESH_LANE() == 0); xcd_barrier(bb_); } } while (0)
#endif
#define MKCTX() Ctx c; c.p = &p; c.lds = lds; c.ws = p.ws; c.out = p.out; c.wave = wave_s; c.lane = FRESH_LANE(); c.tid = wave_s * 64 + c.lane; c.gw = blockIdx.x * 8 + wave_s; c.ngw = gridDim.x * 8;
#define IN(k) (lo <= (k) && (k) < hi)
#ifndef PROBE_MASK
#define PROBE_MASK 0u
#endif
#define NREP(k) (((PROBE_MASK >> (k)) & 1u) ? 2 : 1)
#ifndef PROBE_SUB
#define PROBE_SUB 0
#endif
#define SUB(id, ...) { MKCTX() __VA_ARGS__ } if (PROBE_SUB == (id)) { __syncthreads(); MKCTX() __VA_ARGS__ }
#define PHASE(k, ...) if (IN(k)) { { const int rep_ = 0; (void)rep_; MKCTX() __VA_ARGS__ } if (NREP(k) == 2) { const int rep_ = 1; (void)rep_; MKCTX() __VA_ARGS__ } }
#define X1 c.w<float>(WS_X1)
#define X2 c.w<float>(WS_X2)
#define P1 c.w<float>(WS_P1)
#define XN c.w<bf16>(WS_XN)
#define Hb c.w<bf16>(WS_H)
#define OCAT c.w<bf16>(WS_OCAT)

    PHASE(0,  phase_prologue(c); GRID_BAR(0); )
    PHASE(1,  run_gemm(c, XN, c.w<bf16>(WS_WINAB), M, LD1, D, EpiBf16<0>{c.w<bf16>(WS_P1), LD1}); GRID_BAR(1); )
    PHASE(2,  phase_prep0(c); GRID_BAR(2); )
    PHASE(3,          { run_gemm(c, c.w<bf16>(WS_CQN), c.w<bf16>(WS_WUQ), M, 768, 256, EpiStoreF32{c.w<float>(WS_QH), 768}); } { MKCTX() run_gemm(c, c.w<bf16>(WS_LATN), c.w<bf16>(WS_WUKV), MP, 1024, 256, EpiBf16<0>{c.w<bf16>(WS_KVP), 1024}); }         GRID_BAR(3); )
    PHASE(4,  { if ((blockIdx.x & 1) == 0) { MKCTX() phase_attn_sample2(c); } } __syncthreads(); { MKCTX() phase_gdn_prep(c); } __syncthreads();
               { if ((blockIdx.x & 1) != 0) { MKCTX() phase_attn_sample2(c); } } GRID_BAR(4); )
    PHASE(5,  SUB(4, phase_gdn_scan(c, blockIdx.x, gridDim.x);) __syncthreads(); SUB(5, phase_attn_sample_combine(c);) __syncthreads(); { MKCTX() phase_attn_prompt2(c, rep_ ? 6 : 0); } if (PROBE_SUB == 6) { __syncthreads(); MKCTX() phase_attn_prompt2(c, 5); } __syncthreads();
               SUB(9, const int NS_ = BATCH * 4; const int G_ = (int)gridDim.x; if (G_ > NS_ + 32) { if ((int)blockIdx.x >= NS_) { phase_gdn_sample(c, (int)blockIdx.x - NS_, G_ - NS_); } } else { phase_gdn_sample(c, (int)blockIdx.x, G_); }) __syncthreads();
               SUB(10, const int NS_ = BATCH * 4; const int G_ = (int)gridDim.x; if (G_ > NS_ + 32) { if ((int)blockIdx.x >= NS_) { phase_convert_late(c, c.gw - NS_ * 8, c.ngw - NS_ * 8); } } else { phase_convert_late(c, c.gw, c.ngw); }) GRID_BAR(5); )
    PHASE(6,  { run_gemm(c, OCAT, c.w<bf16>(WS_WOAB), MP, D, D, EpiResidF32{nullptr, c.in<float>(0), c.in<float>(1), X1}); } { MKCTX() run_gemm_sample_splitk(c, OCAT, c.w<bf16>(WS_WOAB), D, 256); } GRID_BAR(6); )
    PHASE(7,  phase_rmsnorm(c, X1, c.in<float>(9), nullptr, 4); GRID_BAR(7); )
    PHASE(8,  { run_gemm(c, XN, c.w<bf16>(WS_WUP0), M, FF, D, EpiBf16<1>{Hb, FF}); } __syncthreads();
               { MKCTX() const int NB_ = (M / 256 * (FF / 256)) % (int)gridDim.x, G_ = (int)gridDim.x;
                 if (NB_ > 0 && G_ - NB_ >= 32) { if ((int)blockIdx.x >= NB_) phase_convert_late2(c, c.gw - NB_ * 8, c.ngw - NB_ * 8); } else phase_convert_late2(c, c.gw, c.ngw); } GRID_BAR(8); )
    PHASE(9,  { run_gemm(c, Hb, c.w<bf16>(WS_WDN0), MP, D, FF, EpiResidF32{X1, nullptr, nullptr, X2}); } { MKCTX() run_gemm_sample_splitk(c, Hb, c.w<bf16>(WS_WDN0), FF, 256); } GRID_BAR(9); )
    PHASE(10,  phase_rmsnorm(c, X2, c.in<float>(8) + D, X1, 16); GRID_BAR(10); )
    PHASE(11,  run_gemm(c, XN, c.w<bf16>(WS_WINC), M, INC, D, EpiBf16<0>{c.w<bf16>(WS_P1), INC}); GRID_BAR(11); )
    PHASE(12,  SUB(7, phase_hgrn_prep(c);) GRID_BAR(12); )
    PHASE(13,  phase_hgrn_prefix(c); __syncthreads(); SUB(8, phase_hgrn_sample(c, (int)blockIdx.x, (int)gridDim.x);) GRID_BAR(13); )
    PHASE(14,  phase_hgrn_out(c); GRID_BAR(14); )
    PHASE(15,  { run_gemm(c, OCAT, c.w<bf16>(WS_WOC), MP, D, D, EpiResidF32{X2, nullptr, nullptr, X1}); } { MKCTX() run_gemm_sample_splitk(c, OCAT, c.w<bf16>(WS_WOC), D, 256); } GRID_BAR(15); )
    PHASE(16,  phase_rmsnorm(c, X1, c.in<float>(9) + D, X2, 4); GRID_BAR(16); )
    PHASE(17,  run_gemm(c, XN, c.w<bf16>(WS_WUP1), M, FF, D, EpiBf16<1>{Hb, FF}); GRID_BAR(17); )
    PHASE(18,  { run_gemm(c, Hb, c.w<bf16>(WS_WDN1), MP, D, FF, EpiResidF32{X1, nullptr, nullptr, X2}); } { MKCTX() run_gemm_sample_splitk(c, Hb, c.w<bf16>(WS_WDN1), FF, 256); } GRID_BAR(18); )
    PHASE(19,  phase_final(c, X2, c.in<float>(10), X1, 16); )
#undef IN
#undef X1
#undef X2
#undef P1
#undef XN
#undef Hb
#undef OCAT
}

#ifndef HIPEMU
extern "C" void kernel_launch(void* const* d_in, const int* in_sizes, int n_in, void* d_out, int out_size, void* d_ws, size_t ws_size, hipStream_t stream) {
    static int grid = 0;
    if (grid == 0) {
        if (n_in != 28 || (size_t)out_size != O_END || ws_size < WS_END) { fprintf(stderr, "kernel_launch: shape mismatch n_in %d out %d (want %zu) ws %zu (want %zu)\n", n_in, out_size, (size_t)O_END, ws_size, (size_t)WS_END); grid = -1; return; }
        int dev = 0, cus = 0, per_cu = 0;
        hipGetDevice(&dev); hipDeviceGetAttribute(&cus, hipDeviceAttributeMultiprocessorCount, dev);
        if (hipFuncSetAttribute((const void*)mega_kernel, hipFuncAttributeMaxDynamicSharedMemorySize, LDS_BYTES) != hipSuccess) { fprintf(stderr, "kernel_launch: hipFuncSetAttribute failed\n"); grid = -1; return; }
        if (hipOccupancyMaxActiveBlocksPerMultiprocessor(&per_cu, (const void*)mega_kernel, 512, LDS_BYTES) != hipSuccess || per_cu < 1) fprintf(stderr, "kernel_launch: occupancy query reports %d\n", per_cu);
        (void)hipGetLastError();
        grid = cus;
    }
    if (grid < 0) return;
    hipMemsetAsync((char*)d_ws + WS_CTL, 0, CTL_BYTES, stream);
    Params p{};
    for (int i = 0; i < 28; ++i) p.in[i] = d_in[i];
    p.out = (float*)d_out; p.ws = (unsigned char*)d_ws;
#if MK_N_LAUNCHES == 1
    p.ph_lo = 0; p.ph_hi = NPHASE;
    hipLaunchKernelGGL(mega_kernel, dim3(grid), dim3(512), LDS_BYTES, stream, p);
#else
    for (int k = 0; k < NPHASE; ++k) { p.ph_lo = k; p.ph_hi = k + 1; hipLaunchKernelGGL(mega_kernel, dim3(grid), dim3(512), LDS_BYTES, stream, p); }
#endif
}
#else
size_t emu_ws_bytes() { return WS_END; }
size_t emu_out_floats() { return O_END; }
void emu_forward(void* const* d_in, float* d_out, unsigned char* d_ws, int grid, int ph_from, int ph_to) {
    memset(d_ws + WS_CTL, 0, CTL_BYTES);
    Params p{};
    for (int i = 0; i < 28; ++i) p.in[i] = d_in[i];
    p.out = d_out; p.ws = d_ws;
    for (int k = ph_from; k < ph_to && k < NPHASE; ++k) { p.ph_lo = k; p.ph_hi = k + 1; fprintf(stderr, "[emu] phase %d\n", k); emu_launch(grid, 512, LDS_BYTES, [=]() { mega_kernel(p); }); }
}
struct EmuBuf { const char* name; size_t off; size_t bytes; int kind;   int ld; };
extern const EmuBuf emu_bufs[] = {
    {"P1", WS_P1, (size_t)M * 4096 * 4, 0, LD1}, {"XN", WS_XN, (size_t)M * D * 2, 1, D}, {"QH", WS_QH, (size_t)M * 768 * 4, 0, 768}, {"KVP", WS_KVP, (size_t)MP * 1024 * 2, 1, 1024},
    {"OCAT", WS_OCAT, (size_t)M * D * 2, 1, D}, {"ORAW", WS_ORAW, (size_t)M * D * 4, 0, D}, {"X1", WS_X1, (size_t)M * D * 4, 0, D}, {"X2", WS_X2, (size_t)M * D * 4, 0, D},
    {"H", WS_H, (size_t)M * FF * 2, 1, FF}, {"CQN", WS_CQN, (size_t)M * 256 * 2, 1, 256}, {"LATN", WS_LATN, (size_t)M * 256 * 2, 1, 256}, {nullptr, 0, 0, 0, 0}};
extern const int emu_cfg[8] = {BATCH, SEQ, DECB, PAST, MP, MS, MT, M};
#endif
```

```cpp
#ifdef HIPEMU
#include "hipemu.h"
#else
#include <hip/hip_runtime.h>
#endif
#include <cstdio>
#include <cstdint>

#ifndef CFG_BATCH
#define CFG_BATCH 8
#define CFG_SEQ 2048
#define CFG_DEC_BATCH 128
#define CFG_PAST_LEN 8192
#endif
#ifndef MK_N_LAUNCHES
#define MK_N_LAUNCHES 1
#endif

#define DEV __device__ __forceinline__
namespace pg8 {
#define PG8_LAS __attribute__((address_space(3)))
typedef unsigned short bf16_t;
typedef short bf16x8 __attribute__((ext_vector_type(8)));
typedef float f32x4 __attribute__((ext_vector_type(4)));
typedef unsigned u32x4 __attribute__((ext_vector_type(4)));
constexpr int BM = 256, BK = 64, HALF = 128, HTB = HALF * BK * 2  , STAGE_BYTES = 8 * HTB, NXCD = 8, WGM = 8;

__host__ __device__ __forceinline__ int lds_byte(int r, int c) { const int st = (r >> 4) * 2 + (c >> 5), rr = r & 15, cc = c & 31, ob = rr * 64 + cc * 2; return st * 1024 + (ob ^ (((ob >> 9) & 1) << 5)); }
__host__ __device__ __forceinline__ void stage_rc(int b, int& R, int& C) { const int st = b / 1024, sb = b % 1024, swz = sb ^ (((sb >> 9) & 1) << 5); R = (st >> 1) * 16 + swz / 64; C = (st & 1) * 32 + (swz % 64) / 2; }
__host__ __device__ __forceinline__ int perm32(int rho) { const int n = rho >> 4, i = rho & 15; return 8 * (i >> 2) + 4 * n + (i & 3); }

struct Unit { int pm, pn, kb; };
struct Gemm { const bf16_t* A; const bf16_t* Bt; int M, N, K, ld; };

struct StaticOrder {
    int nM, nN, nwg, G, c;
    __host__ __device__ void init(int M, int N, int G_, int c_) { nM = M / BM; nN = N / BM; nwg = nM * nN; G = G_; c = c_; }
    __host__ __device__ bool next(int i, Unit& u) const {
        const long L = (long)i * G + c; if (L >= nwg) return false;
        int wgid = (int)L; { const int q = nwg / NXCD, r = nwg % NXCD, xcd = wgid % NXCD, off = wgid / NXCD; wgid = (xcd < r ? xcd * (q + 1) : r * (q + 1) + (xcd - r) * q) + off; }
        const int nig = WGM * nN, gid = wgid / nig, fm = gid * WGM, gsz = (nM - fm) < WGM ? (nM - fm) : WGM;
        u.pm = fm + ((wgid % nig) % gsz); u.pn = (wgid % nig) / gsz; u.kb = 0; return true;
    }
    __device__ __forceinline__ void a_ready(const Unit&) const {}
    __device__ __forceinline__ void done(const Unit&) const {}
};

#ifndef HIPEMU
template <class Epi, class Sched, bool ALIGN_EPI = false, bool SP2 = false>
__device__ __forceinline__ void gemm_phase(PG8_LAS unsigned char* lds, const Gemm g, const Sched& S, const Epi& E, const int wid_in, const int lane_in) {
    const int wid = __builtin_amdgcn_readfirstlane(wid_in), lane = lane_in, tid = wid * 64 + lane, wr = wid >> 2, wc = wid & 3, fr = lane & 15, fq = lane >> 4;
    const int K = g.K, nt = K / BK, LDK = g.ld;
    unsigned voffA[2], voffB[2];
#pragma unroll
    for (int i = 0; i < 2; ++i) { int R, C; stage_rc(tid * 16 + i * 8192, R, C); const int Rb = Epi::PERM ? ((R & ~31) + perm32(R & 31)) : R;
        voffA[i] = (unsigned)(R * LDK + C) * 2u; voffB[i] = (unsigned)(Rb * LDK + C) * 2u; }
    const size_t kstep = (size_t)(BK * 2);
    const size_t hstep = (size_t)HALF * LDK * 2;
    const size_t tstep = 2 * hstep;
    const unsigned ldsw = (unsigned)wid * 1024u;
    const int aoff = lds_byte(wr * 64 + fr, fq * 8), boff = lds_byte(wc * 32 + fr, fq * 8);
#define PG8_SA(b, h) (((b) * 2 + (h)) * HTB)
#define PG8_SB(b, h) ((4 + (b) * 2 + (h)) * HTB)
#define PG8_STAGE(bufoff, gbase, voff) do { _Pragma("unroll") for (int _i = 0; _i < 2; ++_i) \
        __builtin_amdgcn_global_load_lds((const unsigned*)((const char*)(gbase) + (voff)[_i]), (PG8_LAS unsigned*)(lds + (bufoff) + ldsw + _i * 8192), 16, 0, 0); } while (0)
#define PG8_LDA(dst, b, h) do { _Pragma("unroll") for (int m = 0; m < 4; ++m) _Pragma("unroll") for (int k = 0; k < 2; ++k) dst[m][k] = *(const PG8_LAS bf16x8*)(lds + PG8_SA(b, h) + aoff + m * 2048 + k * 1024); } while (0)
#define PG8_LDB(dst, b, h) do { _Pragma("unroll") for (int n = 0; n < 2; ++n) _Pragma("unroll") for (int k = 0; k < 2; ++k) dst[n][k] = *(const PG8_LAS bf16x8*)(lds + PG8_SB(b, h) + boff + n * 2048 + k * 1024); } while (0)
#define PG8_MMA(ai, bj, At, Bt) do { __builtin_amdgcn_s_setprio(1); _Pragma("unroll") for (int m = 0; m < 4; ++m) _Pragma("unroll") for (int n = 0; n < 2; ++n) _Pragma("unroll") for (int k = 0; k < 2; ++k) \
        acc[ai][bj][m][n] = __builtin_amdgcn_mfma_f32_16x16x32_bf16(Bt[n][k], At[m][k], acc[ai][bj][m][n], 0, 0, 0); __builtin_amdgcn_s_setprio(0); } while (0)
#define PG8_WAIT_V(n) asm volatile("s_waitcnt vmcnt(" #n ")" ::: "memory")
#define PG8_WAIT_L(n) asm volatile("s_waitcnt lgkmcnt(" #n ")" ::: "memory")
#define PG8_BAR __builtin_amdgcn_s_barrier()
#define PG8_SCHED __builtin_amdgcn_sched_barrier(0)
    Unit cur, nxt; int ui = 0;
    if (!S.next(0, cur)) return;
    f32x4 acc[2][2][4][2];
#pragma unroll
    for (int a = 0; a < 2; ++a)
#pragma unroll
        for (int b = 0; b < 2; ++b)
#pragma unroll
            for (int m = 0; m < 4; ++m)
#pragma unroll
                for (int n = 0; n < 2; ++n) acc[a][b][m][n] = (f32x4){0.f, 0.f, 0.f, 0.f};
    bf16x8 At[4][2], B0[2][2], B1[2][2];
    const char* cA = (const char*)g.A + (size_t)cur.pm * tstep + (size_t)cur.kb * K * 2; const char* cB = (const char*)g.Bt + (size_t)cur.pn * tstep + (size_t)cur.kb * K * 2;
    S.a_ready(cur);
    if constexpr (SP2) {
        PG8_STAGE(PG8_SB(0, 0), cB, voffB); PG8_STAGE(PG8_SB(0, 1), cB + hstep, voffB); PG8_STAGE(PG8_SA(0, 0), cA, voffA); PG8_STAGE(PG8_SA(0, 1), cA + hstep, voffA);
        if (wr == 1) PG8_BAR;
        PG8_WAIT_V(2); PG8_BAR;
        PG8_STAGE(PG8_SB(1, 0), cB + kstep, voffB); PG8_STAGE(PG8_SA(1, 0), cA + kstep, voffA); PG8_STAGE(PG8_SB(1, 1), cB + hstep + kstep, voffB);
        PG8_WAIT_V(6); PG8_BAR;
    } else {
        PG8_STAGE(PG8_SB(0, 0), cB, voffB); PG8_STAGE(PG8_SA(0, 0), cA, voffA); PG8_STAGE(PG8_SB(0, 1), cB + hstep, voffB); PG8_STAGE(PG8_SA(0, 1), cA + hstep, voffA);
        if (wr == 1) PG8_BAR;
        PG8_WAIT_V(4); PG8_BAR;
        PG8_STAGE(PG8_SB(1, 0), cB + kstep, voffB); PG8_STAGE(PG8_SA(1, 0), cA + kstep, voffA); PG8_STAGE(PG8_SB(1, 1), cB + hstep + kstep, voffB);
        PG8_WAIT_V(6); PG8_BAR;
    }
    for (;;) {
        const bool has_next = S.next(ui + 1, nxt);
        const char* nA = has_next ? (const char*)g.A + (size_t)nxt.pm * tstep + (size_t)nxt.kb * K * 2 : cA; const char* nB = has_next ? (const char*)g.Bt + (size_t)nxt.pn * tstep + (size_t)nxt.kb * K * 2 : cB;
        for (int t = 0; t < nt; t += 2) {
            const bool last = (t == nt - 2);
            const char* a1 = cA + (size_t)(t + 1) * kstep;
            const char* a2 = last ? nA : cA + (size_t)(t + 2) * kstep; const char* b2 = last ? nB : cB + (size_t)(t + 2) * kstep;
            const char* a3 = a2 + kstep; const char* b3 = b2 + kstep;
            if (last && has_next) S.a_ready(nxt);
            if constexpr (SP2) {
            PG8_LDB(B0, 0, 0); PG8_LDB(B1, 0, 1); PG8_SCHED; PG8_LDA(At, 0, 0); PG8_STAGE(PG8_SA(1, 1), a1 + hstep, voffA);
            PG8_WAIT_V(8); PG8_WAIT_L(0); PG8_BAR; PG8_MMA(0, 0, At, B0); PG8_MMA(0, 1, At, B1); PG8_BAR; PG8_SCHED;
            PG8_LDA(At, 0, 1); PG8_STAGE(PG8_SB(0, 0), b2, voffB); PG8_STAGE(PG8_SB(0, 1), b2 + hstep, voffB); PG8_STAGE(PG8_SA(0, 0), a2, voffA);
            PG8_WAIT_V(8); PG8_WAIT_L(0); PG8_BAR; PG8_MMA(1, 0, At, B0); PG8_MMA(1, 1, At, B1); PG8_BAR; PG8_SCHED;
            PG8_LDB(B0, 1, 0); PG8_LDB(B1, 1, 1); PG8_SCHED; PG8_LDA(At, 1, 0); PG8_STAGE(PG8_SA(0, 1), a2 + hstep, voffA);
            PG8_WAIT_V(8); PG8_WAIT_L(0); PG8_BAR; PG8_MMA(0, 0, At, B0); PG8_MMA(0, 1, At, B1); PG8_BAR; PG8_SCHED;
            PG8_LDA(At, 1, 1); PG8_STAGE(PG8_SB(1, 0), b3, voffB); PG8_STAGE(PG8_SB(1, 1), b3 + hstep, voffB); PG8_STAGE(PG8_SA(1, 0), a3, voffA);
            PG8_WAIT_V(8); PG8_WAIT_L(0); PG8_BAR; PG8_MMA(1, 0, At, B0); PG8_MMA(1, 1, At, B1); PG8_BAR; PG8_SCHED;
            } else {
            PG8_LDB(B0, 0, 0); PG8_SCHED; PG8_LDA(At, 0, 0); PG8_STAGE(PG8_SA(1, 1), a1 + hstep, voffA);
            PG8_WAIT_L(8); PG8_BAR; PG8_WAIT_L(0); PG8_MMA(0, 0, At, B0); PG8_BAR; PG8_SCHED;
            PG8_LDB(B1, 0, 1); PG8_STAGE(PG8_SB(0, 0), b2, voffB);
            PG8_BAR; PG8_WAIT_L(0); PG8_MMA(0, 1, At, B1); PG8_BAR;
            PG8_LDA(At, 0, 1); PG8_STAGE(PG8_SA(0, 0), a2, voffA);
            PG8_BAR; PG8_WAIT_L(0); PG8_MMA(1, 0, At, B0); PG8_BAR; PG8_SCHED;
            PG8_STAGE(PG8_SB(0, 1), b2 + hstep, voffB);
            PG8_WAIT_V(6); PG8_BAR; PG8_MMA(1, 1, At, B1); PG8_BAR;
            PG8_LDB(B0, 1, 0); PG8_SCHED; PG8_LDA(At, 1, 0); PG8_STAGE(PG8_SA(0, 1), a2 + hstep, voffA);
            PG8_WAIT_L(8); PG8_BAR; PG8_WAIT_L(0); PG8_MMA(0, 0, At, B0); PG8_BAR; PG8_SCHED;
            PG8_LDB(B1, 1, 1); PG8_STAGE(PG8_SB(1, 0), b3, voffB);
            PG8_BAR; PG8_WAIT_L(0); PG8_MMA(0, 1, At, B1); PG8_BAR;
            PG8_LDA(At, 1, 1); PG8_STAGE(PG8_SA(1, 0), a3, voffA);
            PG8_BAR; PG8_WAIT_L(0); PG8_MMA(1, 0, At, B0); PG8_BAR; PG8_SCHED;
            PG8_STAGE(PG8_SB(1, 1), b3 + hstep, voffB);
            PG8_WAIT_V(6); PG8_BAR; PG8_MMA(1, 1, At, B1); PG8_BAR;
            }
        }
        if constexpr (ALIGN_EPI) { if (wr == 0) PG8_BAR; }
        if constexpr (!Epi::AFTER_DRAIN) { E(acc, cur, wr, wc, fr, fq); S.done(cur); }
        if (!has_next) break;
#pragma unroll
        for (int a = 0; a < 2; ++a)
#pragma unroll
            for (int b = 0; b < 2; ++b)
#pragma unroll
                for (int m = 0; m < 4; ++m)
#pragma unroll
                    for (int n = 0; n < 2; ++n) acc[a][b][m][n] = (f32x4){0.f, 0.f, 0.f, 0.f};
        cur = nxt; cA = nA; cB = nB; ++ui;
        if constexpr (ALIGN_EPI) { if (wr == 1) PG8_BAR; }
    }
    PG8_WAIT_V(0);
    if constexpr (!ALIGN_EPI) { if (wr == 0) PG8_BAR; }
    PG8_BAR;
    if constexpr (Epi::AFTER_DRAIN) { E.fused(acc, cur, wr, wc, fr, fq, lds, wid, lane); S.done(cur); }
#undef PG8_SA
#undef PG8_SB
#undef PG8_STAGE
#undef PG8_LDA
#undef PG8_LDB
#undef PG8_MMA
#undef PG8_WAIT_V
#undef PG8_WAIT_L
#undef PG8_BAR
#undef PG8_SCHED
}
}

#else
}
#endif

constexpr int D = 1024, BATCH = CFG_BATCH, SEQ = CFG_SEQ, DECB = CFG_DEC_BATCH, DECS = 8, PAST = CFG_PAST_LEN, PAGE = 128;
constexpr int MP = BATCH * SEQ, MS = DECB * DECS, MT = MP + MS, M = (MT + 255) / 256 * 256;
constexpr int NPAGES = PAST / PAGE;
constexpr int QKV_A = 1536, IN_AB = 2600, LD1 = 2816, FF = 4096, INC = 4096;
constexpr int C_Z = 1536, C_B = 2048, C_A = 2052, C_CQ = 2056, C_CKV = 2312, C_KPE = 2568;
constexpr float EPS = 1e-6f;
constexpr float MLA_SCALE = 0.10206207261596575f;
constexpr float DK_SCALE = 0.08838834764831845f;
static_assert(MP % 256 == 0 && SEQ % 128 == 0 && PAST % 128 == 0, "shape assumptions");

constexpr size_t O_YP = 0, O_YS = O_YP + (size_t)MP * D, O_GDNP = O_YS + (size_t)MS * D, O_CONVP = O_GDNP + (size_t)BATCH * 4 * 16384,
    O_LATP = O_CONVP + (size_t)BATCH * 3 * QKV_A, O_KPEP = O_LATP + (size_t)MP * 256, O_HGP = O_KPEP + (size_t)MP * 32,
    O_GDNS = O_HGP + (size_t)BATCH * 8 * 16384, O_CONVS = O_GDNS + (size_t)DECB * 4 * 16384, O_LATS = O_CONVS + (size_t)DECB * 3 * QKV_A,
    O_KPES = O_LATS + (size_t)MS * 256, O_HGS = O_KPES + (size_t)MS * 32, O_END = O_HGS + (size_t)DECB * 8 * 16384;

constexpr size_t al256(size_t x) { return (x + 255) & ~(size_t)255; }
constexpr size_t WS_CTL = 0, CTL_BYTES = 65536;
constexpr size_t WS_WINAB = CTL_BYTES,                      WS_WUP0 = WS_WINAB + (size_t)LD1 * D * 2,
    WS_WUP1 = WS_WUP0 + (size_t)FF * D * 2,                 WS_WDN0 = WS_WUP1 + (size_t)FF * D * 2,
    WS_WDN1 = WS_WDN0 + (size_t)FF * D * 2,                 WS_WINC = WS_WDN1 + (size_t)FF * D * 2,
    WS_WOAB = WS_WINC + (size_t)INC * D * 2,                WS_WOC = WS_WOAB + (size_t)D * D * 2,
    WS_WUQ = WS_WOC + (size_t)D * D * 2,                    WS_WUKV = WS_WUQ + (size_t)768 * 256 * 2,
    WS_ROPE = WS_WUKV + (size_t)1024 * 256 * 2,             WS_XN = al256(WS_ROPE + (size_t)(SEQ + 8) * 32 * 4),
    WS_P1 = WS_XN + (size_t)M * D * 2,                      WS_CQN = WS_P1 + (size_t)M * 4096 * 4,
    WS_LATN = WS_CQN + (size_t)M * 256 * 2,                 WS_QH = WS_LATN + (size_t)M * 256 * 2,
    WS_KVP = WS_QH + (size_t)M * 768 * 4,                   WS_OCAT = WS_KVP + (size_t)MP * 1024 * 2,
    WS_ORAW = WS_OCAT + (size_t)M * D * 2,                  WS_X1 = WS_ORAW + (size_t)M * D * 4,
    WS_X2 = WS_X1 + (size_t)M * D * 4,                      WS_H = WS_X2 + (size_t)M * D * 4,
    WS_WUKB = WS_H + (size_t)M * FF * 2,                    WS_PO = WS_WUKB + (size_t)256 * 512 * 2,
    WS_PM = WS_PO + (size_t)DECB * 2 * 64 * 256 * 4,        WS_PL = WS_PM + (size_t)DECB * 2 * 64 * 4,
    WS_KPEB = WS_PL + (size_t)DECB * 2 * 64 * 4,            WS_PART = al256(WS_KPEB + (size_t)MP * 32 * 2),
    WS_END = WS_PART + (size_t)16 * (M - MP) * D * 4;
constexpr size_t WS_H_END = WS_H + (size_t)M * FF * 2;

constexpr int LDS_BYTES = 155648;
constexpr int LDS_MISC = 155648 - 256;
constexpr int NPHASE = 20;

typedef unsigned short bf16;
typedef unsigned u32x4 __attribute__((ext_vector_type(4)));
typedef unsigned u32x2 __attribute__((ext_vector_type(2)));
#ifndef HIPEMU
typedef short bf16x8 __attribute__((ext_vector_type(8)));
typedef float f32x4 __attribute__((ext_vector_type(4)));
#endif

#ifdef HIPEMU
DEV unsigned f2bf(float f) { unsigned u = __float_as_uint(f); return (u + 0x7fffu + ((u >> 16) & 1u)) >> 16; }
#else
DEV unsigned f2bf(float f) { return (unsigned)__builtin_bit_cast(unsigned short, (__bf16)f); }
#endif
#ifdef HIPEMU
DEV unsigned pk2(float lo, float hi) { return f2bf(lo) | (f2bf(hi) << 16); }
#else
typedef float f32x2_t __attribute__((ext_vector_type(2))); typedef __bf16 bf16x2_t __attribute__((ext_vector_type(2)));
DEV unsigned pk2(float lo, float hi) { f32x2_t v = {lo, hi}; bf16x2_t b = __builtin_convertvector(v, bf16x2_t); return __builtin_bit_cast(unsigned, b); }
#endif
DEV float bf2f(bf16 b) { return __uint_as_float(((unsigned)b) << 16); }
#ifdef HIPEMU
DEV float rcpf_(float x) { return 1.0f / x; }
#else
DEV float rcpf_(float x) { return __builtin_amdgcn_rcpf(x); }
#endif
DEV float sigmoidf_(float x) { return 1.0f / (1.0f + __expf(-x)); }
DEV float siluf_(float x) { return x / (1.0f + __expf(-x)); }
DEV float softplusf_(float x) { return fmaxf(x, 0.f) + log1pf(__expf(-fabsf(x))); }
#ifdef HIPEMU
DEV f32x4 mfma16(bf16x8 a, bf16x8 b, f32x4 c) { return emu_mfma16(a, b, c); }
#define WAVE_SYNC() emu_wave_sync()
#define OPAQUE_V(x) do { } while (0)
#define LDS_BARRIER() __syncthreads()
DEV s16x4 lds_tr(const unsigned short* p) { return emu_lds_tr((const void*)p); }
#else
typedef short s16x4 __attribute__((ext_vector_type(4)));
DEV s16x4 lds_tr(const unsigned short* p) { return __builtin_bit_cast(s16x4, __builtin_amdgcn_ds_read_tr16_b64_v4i16((__attribute__((address_space(3))) s16x4*)p)); }
DEV f32x4 mfma16(bf16x8 a, bf16x8 b, f32x4 c) { return __builtin_amdgcn_mfma_f32_16x16x32_bf16(a, b, c, 0, 0, 0); }
#define WAVE_SYNC() asm volatile("s_waitcnt lgkmcnt(0)" ::: "memory")
#define OPAQUE_V(x) asm volatile("" : "+v"(x))
#define LDS_BARRIER() asm volatile("s_waitcnt lgkmcnt(0)\n\ts_barrier" ::: "memory")
#endif
DEV f32x4 ld4bf(const unsigned short* p) { const u32x2 u = *(const u32x2*)p; return (f32x4){__uint_as_float(u.x << 16), __uint_as_float(u.x & 0xffff0000u), __uint_as_float(u.y << 16), __uint_as_float(u.y & 0xffff0000u)}; }
constexpr float QK_SCALE2 = MLA_SCALE * 1.4426950408889634f;
#ifdef HIPEMU
DEV float exp2f_(float x) { return exp2f(x); }
DEV bool wave_any(bool p) { int v = p ? 1 : 0;
    for (int o = 1; o < 64; o <<= 1) v |= __shfl_xor(v, o);
    return v != 0; }
#else
DEV float exp2f_(float x) { return __builtin_amdgcn_exp2f(x); }
DEV bool wave_any(bool p) { return __builtin_amdgcn_ballot_w64(p) != 0ull; }
#endif
#ifdef HIPEMU
DEV float wave_sum(float v) {
#pragma unroll
    for (int o = 1; o < 64; o <<= 1) v += __shfl_xor(v, o);
    return v;
}
DEV float grp16_max(float v) {
#pragma unroll
    for (int o = 1; o < 16; o <<= 1) v = fmaxf(v, __shfl_xor(v, o));
    return v;
}
DEV float grp16_sum(float v) {
#pragma unroll
    for (int o = 1; o < 16; o <<= 1) v += __shfl_xor(v, o);
    return v;
}
#else
template <int CTRL> DEV float dppf(float x) { return __builtin_bit_cast(float, __builtin_amdgcn_mov_dpp(__builtin_bit_cast(int, x), CTRL, 0xf, 0xf, true)); }
DEV float grp16_max(float v) { v = fmaxf(v, dppf<0xB1>(v)); v = fmaxf(v, dppf<0x4E>(v)); v = fmaxf(v, dppf<0x141>(v)); v = fmaxf(v, dppf<0x128>(v)); return v; }
DEV float grp16_sum(float v) { v += dppf<0xB1>(v); v += dppf<0x4E>(v); v += dppf<0x141>(v); v += dppf<0x128>(v); return v; }
DEV float wave_sum(float v) {
    v = grp16_sum(v);
    auto s = __builtin_amdgcn_permlane16_swap(__float_as_uint(v), __float_as_uint(v), false, false);
    v = __uint_as_float(s[0]) + __uint_as_float(s[1]);
    auto t = __builtin_amdgcn_permlane32_swap(__float_as_uint(v), __float_as_uint(v), false, false);
    return __uint_as_float(t[0]) + __uint_as_float(t[1]);
}
#endif

struct Params { const void* in[28]; float* out; unsigned char* ws; int ph_lo, ph_hi; };
struct Ctx {
    const Params* p; unsigned char* lds; unsigned char* ws; float* out;
    int tid, lane, wave, gw, ngw;
    template <class T> DEV const T* in(int i) const { return (const T*)p->in[i]; }
    template <class T> DEV T* w(size_t off) const { return (T*)(ws + off); }
};
DEV int queue_next(const Ctx& c, int q) {
    unsigned* cnt = (unsigned*)(c.ws + WS_CTL) + 4096 + 64 * q; volatile unsigned* slot = (volatile unsigned*)(c.lds + LDS_MISC + 128);
    __syncthreads();
    if (c.tid == 0) *slot = atomicAdd(cnt, 1u);
    __syncthreads();
    return (int)*slot;
}
DEV const float* xin_row(const Ctx& c, int m) { return m < MP ? c.in<float>(0) + (size_t)m * D : c.in<float>(1) + (size_t)(m - MP) * D; }

struct EpiStoreF32 {
    static constexpr bool PERM = false, AFTER_DRAIN = false;
    float* C; int ldc;
    DEV void operator()(const pg8::f32x4 (&acc)[2][2][4][2], const pg8::Unit& u, int wr, int wc, int fr, int fq) const {
        const int row0 = u.pm * 256 + wr * 64 + fr, col0 = u.pn * 256 + wc * 32 + 4 * fq;
#pragma unroll
        for (int ai = 0; ai < 2; ++ai)
#pragma unroll
            for (int m = 0; m < 4; ++m) { float* rowp = C + (size_t)(row0 + ai * 128 + m * 16) * ldc + col0;
#pragma unroll
                for (int bj = 0; bj < 2; ++bj)
#pragma unroll
                    for (int n = 0; n < 2; ++n) *(pg8::f32x4*)(rowp + bj * 128 + n * 16) = acc[ai][bj][m][n]; }
    }
};
struct EpiResidF32 {
    static constexpr bool PERM = false, AFTER_DRAIN = false;
    const float* base; const float* xp; const float* xs; float* out;
    DEV void operator()(const pg8::f32x4 (&acc)[2][2][4][2], const pg8::Unit& u, int wr, int wc, int fr, int fq) const {
        const int row0 = u.pm * 256 + wr * 64 + fr, col0 = u.pn * 256 + wc * 32 + 4 * fq;
#pragma unroll
        for (int ai = 0; ai < 2; ++ai)
#pragma unroll
            for (int m = 0; m < 4; ++m) { const int row = row0 + ai * 128 + m * 16;
                const float* rp = base ? base + (size_t)row * D : (row < MP ? xp + (size_t)row * D : xs + (size_t)(row - MP) * D);
                const bool ok = base != nullptr || row < MT;
                float* op = out + (size_t)row * D + col0;
#pragma unroll
                for (int bj = 0; bj < 2; ++bj)
#pragma unroll
                    for (int n = 0; n < 2; ++n) { pg8::f32x4 r = ok ? *(const pg8::f32x4*)(rp + col0 + bj * 128 + n * 16) : (pg8::f32x4){0.f, 0.f, 0.f, 0.f};
                        *(pg8::f32x4*)(op + bj * 128 + n * 16) = r + acc[ai][bj][m][n]; } }
    }
};
template <int ACT  > struct EpiBf16 {
    static constexpr bool PERM = true, AFTER_DRAIN = false;
    bf16* O; int ldc;
    DEV void operator()(const pg8::f32x4 (&acc)[2][2][4][2], const pg8::Unit& u, int wr, int wc, int fr, int fq) const {
        const int row0 = u.pm * 256 + wr * 64 + fr, col0 = u.pn * 256 + wc * 32 + 8 * fq;
#pragma unroll
        for (int ai = 0; ai < 2; ++ai)
#pragma unroll
            for (int m = 0; m < 4; ++m) { bf16* rowp = O + (size_t)(row0 + ai * 128 + m * 16) * ldc + col0;
#pragma unroll
                for (int bj = 0; bj < 2; ++bj) { pg8::f32x4 v0 = acc[ai][bj][m][0], v1 = acc[ai][bj][m][1];
                    if (ACT == 1) {
#pragma unroll
                        for (int j = 0; j < 4; ++j) { const float a = fmaxf(v0[j], 0.f), b = fmaxf(v1[j], 0.f); v0[j] = a * a; v1[j] = b * b; } }
                    u32x4 w; w.x = pk2(v0[0], v0[1]); w.y = pk2(v0[2], v0[3]); w.z = pk2(v1[0], v1[1]); w.w = pk2(v1[2], v1[3]);
                    *(u32x4*)(rowp + bj * 128) = w; } }
    }
};

struct SplitKOrder {
    int nM, nN, nS, pm0, G, c;
    DEV void init(int nM_, int nN_, int nS_, int pm0_, int G_, int c_) { nM = nM_; nN = nN_; nS = nS_; pm0 = pm0_; G = G_; c = c_; }
    DEV bool next(int i, pg8::Unit& u) const { const int L = i * G + c; if (L >= nM * nN * nS) return false; u.pm = pm0 + L % nM; const int r = L / nM; u.pn = r % nN; u.kb = r / nN; return true; }
    DEV void a_ready(const pg8::Unit&) const {}
    DEV void done(const pg8::Unit&) const {}
};
struct EpiPartF32 {
    static constexpr bool PERM = false, AFTER_DRAIN = false;
    float* P;
    DEV void operator()(const pg8::f32x4 (&acc)[2][2][4][2], const pg8::Unit& u, int wr, int wc, int fr, int fq) const {
        const int row0 = u.pm * 256 - MP + wr * 64 + fr, col0 = u.pn * 256 + wc * 32 + 4 * fq;
        float* base = P + (size_t)u.kb * (M - MP) * D;
#pragma unroll
        for (int ai = 0; ai < 2; ++ai)
#pragma unroll
            for (int m = 0; m < 4; ++m) { float* op = base + (size_t)(row0 + ai * 128 + m * 16) * D + col0;
#pragma unroll
                for (int bj = 0; bj < 2; ++bj)
#pragma unroll
                    for (int n = 0; n < 2; ++n) *(pg8::f32x4*)(op + bj * 128 + n * 16) = acc[ai][bj][m][n]; }
    }
};
template <class Epi, class Sched> DEV void run_gemm_s(const Ctx& c, const bf16* A, const bf16* Bt, int Mr, int N, int K, int ld, const Sched& S, const Epi& E) {
#ifndef HIPEMU
    asm volatile("" : "+s"(K));
    pg8::Gemm g{A, Bt, Mr, N, K, ld};
    pg8::gemm_phase<Epi, Sched, true, true>((PG8_LAS unsigned char*)c.lds, g, S, E, c.wave, c.lane);
#else
    const int wid = c.wave, lane = c.lane, wr = wid >> 2, wc = wid & 3, fr = lane & 15, fq = lane >> 4;
    pg8::Unit u;
    for (int ui = 0; S.next(ui, u); ++ui) {
        pg8::f32x4 acc[2][2][4][2];
        for (int ai = 0; ai < 2; ++ai) for (int bj = 0; bj < 2; ++bj) for (int m = 0; m < 4; ++m) for (int n = 0; n < 2; ++n) for (int j = 0; j < 4; ++j) {
            const int row = 256 * u.pm + 128 * ai + 64 * wr + 16 * m + fr;
            const int col = Epi::PERM ? 256 * u.pn + 128 * bj + 32 * wc + 8 * fq + 4 * n + j : 256 * u.pn + 128 * bj + 32 * wc + 16 * n + 4 * fq + j;
            const bf16* a = A + (size_t)row * ld + (size_t)u.kb * K; const bf16* b = Bt + (size_t)col * ld + (size_t)u.kb * K; float s = 0.f;
            for (int k = 0; k < K; ++k) s += bf2f(a[k]) * bf2f(b[k]);
            acc[ai][bj][m][n][j] = s; }
        E(acc, u, wr, wc, fr, fq);
    }
#endif
}
template <class Epi> DEV void run_gemm(const Ctx& c, const bf16* A, const bf16* Bt, int Mr, int N, int K, const Epi& E) {
    pg8::StaticOrder S; S.init(Mr, N, (int)gridDim.x, (int)blockIdx.x);
    run_gemm_s(c, A, Bt, Mr, N, K, K, S, E);
}
DEV void run_gemm_sample_splitk(const Ctx& c, const bf16* A, const bf16* Bt, int K, int KS) {
    SplitKOrder S; S.init((M - MP) / 256, D / 256, K / KS, MP / 256, (int)gridDim.x, (int)((blockIdx.x + 128) % gridDim.x));
    run_gemm_s(c, A, Bt, M, D, KS, K, S, EpiPartF32{c.w<float>(WS_PART)});
}

DEV void transpose_item(const float* W, int K, int N, bf16* WT, float* scr, int item, int nblk, int lane) {
    const int kb = item / nblk, nb = item % nblk, k0 = 64 * kb, n0 = 32 * nb;
    const int nn = n0 + (lane & 31);
    float tv[32];
#pragma unroll
    for (int i = 0; i < 32; ++i) { const int kk = 2 * i + (lane >> 5); tv[i] = nn < N ? W[(size_t)(k0 + kk) * N + nn] : 0.f; }
#pragma unroll
    for (int i = 0; i < 32; ++i) { const int kk = 2 * i + (lane >> 5); scr[kk * 33 + (lane & 31)] = tv[i]; }
    WAVE_SYNC();
    const int cq = lane & 7;
#pragma unroll
    for (int j = 0; j < 4; ++j) { const int n = (lane >> 3) + 8 * j; const float* s = scr + (8 * cq) * 33 + n;
        u32x4 o; o.x = pk2(s[0 * 33], s[1 * 33]); o.y = pk2(s[2 * 33], s[3 * 33]); o.z = pk2(s[4 * 33], s[5 * 33]); o.w = pk2(s[6 * 33], s[7 * 33]);
        *(u32x4*)(WT + (size_t)(n0 + n) * K + k0 + 8 * cq) = o; }
    WAVE_SYNC();
}
DEV void rms_row_to_bf16(const float* xrow, const float* gain, bf16* orow, int lane) {
    f32x4 v[4]; float s = 0.f;
#pragma unroll
    for (int j = 0; j < 4; ++j) { v[j] = *(const f32x4*)(xrow + 4 * lane + 256 * j); s += (v[j][0] * v[j][0] + v[j][1] * v[j][1]) + (v[j][2] * v[j][2] + v[j][3] * v[j][3]); }
    const float rstd = rsqrtf(wave_sum(s) * (1.f / D) + EPS);
#pragma unroll
    for (int j = 0; j < 4; ++j) { const f32x4 g = *(const f32x4*)(gain + 4 * lane + 256 * j);
        u32x2 o; o.x = pk2(v[j][0] * rstd * g[0], v[j][1] * rstd * g[1]); o.y = pk2(v[j][2] * rstd * g[2], v[j][3] * rstd * g[3]);
        *(u32x2*)(orow + 4 * lane + 256 * j) = o; }
}
DEV void zero_row_bf16(bf16* orow, int lane) {
#pragma unroll
    for (int j = 0; j < 4; ++j) { u32x2 o; o.x = 0u; o.y = 0u; *(u32x2*)(orow + 4 * lane + 256 * j) = o; }
}
#define TJOB(Wp, K_, N_, Npad_, wt_) do { const int nblk = (Npad_) / 32, nitems = ((K_) / 64) * nblk; bf16* WT = c.w<bf16>(wt_); const float* Wsrc = (Wp); \
        for (int it = gw0; it < nitems; it += ngw0) transpose_item(Wsrc, (K_), (N_), WT, scr, it, nblk, c.lane); } while (0)
DEV void phase_convert_late(const Ctx& c, int gw0, int ngw0) {
    float* scr = (float*)(c.lds + c.wave * 8704);
    TJOB(c.in<float>(23), D, D, D, WS_WOAB);
    TJOB(c.in<float>(11), D, FF, FF, WS_WUP0);
    TJOB(c.in<float>(12), FF, D, D, WS_WDN0);
}
DEV void phase_convert_late2(const Ctx& c, int gw0, int ngw0) {
    float* scr = (float*)(c.lds + c.wave * 8704);
    TJOB(c.in<float>(24), D, INC, INC, WS_WINC);
    TJOB(c.in<float>(27), D, D, D, WS_WOC);
    TJOB(c.in<float>(11) + (size_t)D * FF, D, FF, FF, WS_WUP1);
    TJOB(c.in<float>(12) + (size_t)D * FF, FF, D, D, WS_WDN1);
}
DEV void phase_prologue(const Ctx& c) {
    float* scr = (float*)(c.lds + c.wave * 8704);
    const int gw0 = c.gw, ngw0 = c.ngw;
    TJOB(c.in<float>(13), D, IN_AB, LD1, WS_WINAB);
    TJOB(c.in<float>(19), 256, 768, 768, WS_WUQ);
    TJOB(c.in<float>(21), 256, 512, 512, WS_WUKV); TJOB(c.in<float>(22), 256, 512, 512, WS_WUKV + (size_t)512 * 256 * 2);
#undef TJOB
    {
        const float* src = c.in<float>(21); bf16* dst = c.w<bf16>(WS_WUKB);
        for (int i = blockIdx.x * 512 + c.tid; i < 256 * 512 / 4; i += gridDim.x * 512) { const f32x4 v = *(const f32x4*)(src + 4 * i); u32x2 o; o.x = pk2(v[0], v[1]); o.y = pk2(v[2], v[3]); *(u32x2*)(dst + 4 * i) = o; }
    }
    float* rope = c.w<float>(WS_ROPE);
    for (int i = blockIdx.x * 512 + c.tid; i < (SEQ + 8) * 16; i += gridDim.x * 512) {
        const int e = i >> 4, f = i & 15; const double pos = e < SEQ ? (double)e : (double)(PAST + e - SEQ);
        const double ang = pos * pow(10000.0, -(double)f / 16.0);
        rope[e * 32 + f] = (float)cos(ang); rope[e * 32 + 16 + f] = (float)sin(ang);
    }
    bf16* XN = c.w<bf16>(WS_XN);
    for (int m = c.gw; m < M; m += c.ngw) {
        if (m < MT) rms_row_to_bf16(xin_row(c, m), c.in<float>(8), XN + (size_t)m * D, c.lane); else zero_row_bf16(XN + (size_t)m * D, c.lane);
    }
}
DEV void sample_row_sum(const Ctx& c, int m, const float* X_res, int nsp, f32x4 (&v)[4]) {
    const int lane = c.lane; const float* P = c.w<float>(WS_PART) + (size_t)(m - MP) * D;
#pragma unroll
    for (int j = 0; j < 4; ++j) {
        if (X_res) v[j] = *(const f32x4*)(X_res + (size_t)m * D + 4 * lane + 256 * j);
        else v[j] = m < MT ? *(const f32x4*)(c.in<float>(1) + (size_t)(m - MP) * D + 4 * lane + 256 * j) : (f32x4){0.f, 0.f, 0.f, 0.f}; }
    for (int s = 0; s < nsp; ++s) {
#pragma unroll
        for (int j = 0; j < 4; ++j) v[j] += *(const f32x4*)(P + (size_t)s * (M - MP) * D + 4 * lane + 256 * j); }
}
DEV void phase_rmsnorm(const Ctx& c, float* X, const float* gain, const float* X_res, int nsp) {
    bf16* XN = c.w<bf16>(WS_XN); const int lane = c.lane;
    for (int m = c.gw; m < M; m += c.ngw) {
        if (m < MP) { rms_row_to_bf16(X + (size_t)m * D, gain, XN + (size_t)m * D, lane); continue; }
        f32x4 v[4]; sample_row_sum(c, m, X_res, nsp, v);
        float s = 0.f;
#pragma unroll
        for (int j = 0; j < 4; ++j) { *(f32x4*)(X + (size_t)m * D + 4 * lane + 256 * j) = v[j]; s += (v[j][0] * v[j][0] + v[j][1] * v[j][1]) + (v[j][2] * v[j][2] + v[j][3] * v[j][3]); }
        const float rstd = rsqrtf(wave_sum(s) * (1.f / D) + EPS);
#pragma unroll
        for (int j = 0; j < 4; ++j) { const f32x4 g = *(const f32x4*)(gain + 4 * lane + 256 * j);
            u32x2 o; o.x = pk2(v[j][0] * rstd * g[0], v[j][1] * rstd * g[1]); o.y = pk2(v[j][2] * rstd * g[2], v[j][3] * rstd * g[3]);
            *(u32x2*)(XN + (size_t)m * D + 4 * lane + 256 * j) = o; }
    }
}
DEV void phase_copy_rows(const Ctx& c, float* dst, const float* src, int nrows) {
    for (int r = (int)(gridDim.x * 8) - 1 - c.gw; r < nrows; r += c.ngw) {
#pragma unroll
        for (int j = 0; j < 4; ++j) *(f32x4*)(dst + (size_t)r * D + 4 * c.lane + 256 * j) = *(const f32x4*)(src + (size_t)r * D + 4 * c.lane + 256 * j); }
}
DEV void phase_final(const Ctx& c, const float* X, const float* gain, const float* X_res, int nsp) {
    for (int m = c.gw; m < MT; m += c.ngw) {
        const float* xrow = X + (size_t)m * D; float* orow = c.out + (m < MP ? O_YP + (size_t)m * D : O_YS + (size_t)(m - MP) * D);
        f32x4 v[4]; float s = 0.f;
        if (m >= MP) sample_row_sum(c, m, X_res, nsp, v);
#pragma unroll
        for (int j = 0; j < 4; ++j) { if (m < MP) v[j] = *(const f32x4*)(xrow + 4 * c.lane + 256 * j); s += (v[j][0] * v[j][0] + v[j][1] * v[j][1]) + (v[j][2] * v[j][2] + v[j][3] * v[j][3]); }
        const float rstd = rsqrtf(wave_sum(s) * (1.f / D) + EPS);
#pragma unroll
        for (int j = 0; j < 4; ++j) { const f32x4 g = *(const f32x4*)(gain + 4 * c.lane + 256 * j); *(f32x4*)(orow + 4 * c.lane + 256 * j) = v[j] * rstd * g; }
    }
}

DEV void phase_prep0(const Ctx& c) {
    const bf16* P1 = c.w<bf16>(WS_P1); const float* rope = c.w<float>(WS_ROPE);
    bf16* CQN = c.w<bf16>(WS_CQN); bf16* LATN = c.w<bf16>(WS_LATN);
    const float* qg = c.in<float>(18); const float* kvg = c.in<float>(20);
    const int lane = c.lane;
    for (int m = c.gw; m < M; m += c.ngw) {
        if (m >= MT) { u32x2 z; z.x = 0u; z.y = 0u; *(u32x2*)(CQN + (size_t)m * 256 + 4 * lane) = z; *(u32x2*)(LATN + (size_t)m * 256 + 4 * lane) = z; continue; }
        const bf16* row = P1 + (size_t)m * LD1;
        const bool samp = m >= MP; const int b = samp ? (m - MP) / DECS : m / SEQ, t = samp ? (m - MP) % DECS : m % SEQ;
        {
            const f32x4 v = ld4bf(row + C_CQ + 4 * lane); const f32x4 g = *(const f32x4*)(qg + 4 * lane);
            const float r = rsqrtf(wave_sum((v[0] * v[0] + v[1] * v[1]) + (v[2] * v[2] + v[3] * v[3])) * (1.f / 256.f) + EPS);
            u32x2 o; o.x = pk2(v[0] * r * g[0], v[1] * r * g[1]); o.y = pk2(v[2] * r * g[2], v[3] * r * g[3]); *(u32x2*)(CQN + (size_t)m * 256 + 4 * lane) = o;
        }
        {
            const f32x4 v = ld4bf(row + C_CKV + 4 * lane); const f32x4 g = *(const f32x4*)(kvg + 4 * lane);
            const float r = rsqrtf(wave_sum((v[0] * v[0] + v[1] * v[1]) + (v[2] * v[2] + v[3] * v[3])) * (1.f / 256.f) + EPS);
            const f32x4 y = v * r * g;
            float* lo = c.out + (samp ? O_LATS + (size_t)(m - MP) * 256 : O_LATP + (size_t)m * 256);
            *(f32x4*)(lo + 4 * lane) = y;
            u32x2 o; o.x = pk2(y[0], y[1]); o.y = pk2(y[2], y[3]); *(u32x2*)(LATN + (size_t)m * 256 + 4 * lane) = o;
        }
        if (lane < 16) {
            const float* rt = rope + (size_t)(samp ? SEQ + t : t) * 32; const float cs = rt[lane], sn = rt[16 + lane];
            const float x1 = bf2f(row[C_KPE + lane]), x2 = bf2f(row[C_KPE + 16 + lane]);
            float* ko = c.out + (samp ? O_KPES + (size_t)(m - MP) * 32 : O_KPEP + (size_t)m * 32);
            ko[lane] = x1 * cs - x2 * sn; ko[16 + lane] = x2 * cs + x1 * sn;
            if (!samp) { bf16* kb = c.w<bf16>(WS_KPEB) + (size_t)m * 32; kb[lane] = (bf16)f2bf(x1 * cs - x2 * sn); kb[16 + lane] = (bf16)f2bf(x2 * cs + x1 * sn); }
        }
        const int T = samp ? DECS : SEQ;
        if (t >= T - 3) {
            float* co = c.out + (samp ? O_CONVS : O_CONVP) + ((size_t)b * 3 + (t - (T - 3))) * QKV_A;
#pragma unroll
            for (int j = 0; j < 6; ++j) *(f32x4*)(co + 4 * lane + 256 * j) = ld4bf(row + 4 * lane + 256 * j);
        }
    }
}

DEV void phase_gdn_naive(const Ctx& c, int u_begin, int wg_first, int wg_stride) {
    float* red = (float*)c.lds; float* red2 = red + 512; float* qs = red2 + 512; float* ks = qs + 128; float* vs = ks + 128; float* part = vs + 128; float* sc = part + 8;
    const bf16* P1 = c.w<bf16>(WS_P1); float* ORAW = c.w<float>(WS_ORAW); bf16* OCAT = c.w<bf16>(WS_OCAT);
    const float* convw = c.in<float>(14); const float* gn = c.in<float>(17);
    const int tid = c.tid, lane = c.lane, wave = c.wave;
    const int NU = (BATCH + DECB) * 4;
    for (int u = u_begin + wg_first; u < NU; u += wg_stride) {
        const bool samp = u >= BATCH * 4; const int b = samp ? (u - BATCH * 4) >> 2 : u >> 2, h = u & 3;
        const int T = samp ? DECS : SEQ; const size_t m0 = samp ? (size_t)MP + (size_t)b * DECS : (size_t)b * SEQ;
        const int e = tid & 127, dg = tid >> 7, d0 = dg * 32;
        float s[32];
        if (samp) { const float* S0 = c.in<float>(2) + ((size_t)(b * 4 + h) * 128 + d0) * 128 + e;
#pragma unroll
            for (int i = 0; i < 32; ++i) s[i] = S0[(size_t)i * 128]; }
        else {
#pragma unroll
            for (int i = 0; i < 32; ++i) s[i] = 0.f; }
        const int col = tid < 128 ? h * 128 + tid : (tid < 256 ? 512 + h * 128 + (tid - 128) : 1024 + h * 128 + (tid - 256));
        float w0 = 0.f, w1 = 0.f, w2 = 0.f, w3 = 0.f, x0 = 0.f, x1 = 0.f, x2 = 0.f, xn = 0.f;
        if (tid < 384) { w0 = convw[col]; w1 = convw[QKV_A + col]; w2 = convw[2 * QKV_A + col]; w3 = convw[3 * QKV_A + col];
            if (samp) { const float* cb = c.in<float>(3) + (size_t)b * 3 * QKV_A + col; x0 = cb[0]; x1 = cb[QKV_A]; x2 = cb[2 * QKV_A]; }
            xn = bf2f(P1[m0 * LD1 + col]); }
        const float Aexp = __expf(c.in<float>(15)[h]), dtb = c.in<float>(16)[h];
        for (int t = 0; t < T; ++t) {
            const size_t m = m0 + t;
            const float x3 = xn; if (t + 1 < T && tid < 384) xn = bf2f(P1[(m + 1) * LD1 + col]);
            float val = 0.f;
            if (tid < 384) { const float y = w0 * x0 + w1 * x1 + w2 * x2 + w3 * x3; val = siluf_(y); x0 = x1; x1 = x2; x2 = x3; }
            const float sq = wave_sum(tid < 256 ? val * val : 0.f);
            if (tid < 128) qs[tid] = val; else if (tid < 256) ks[tid - 128] = val; else if (tid < 384) vs[tid - 256] = val;
            if (lane == 0 && wave < 4) part[wave] = sq;
            if (tid == 384) { sc[0] = sigmoidf_(bf2f(P1[m * LD1 + C_B + h])); sc[1] = -Aexp * softplusf_(bf2f(P1[m * LD1 + C_A + h]) + dtb); }
            LDS_BARRIER();
            const float qn = rsqrtf(part[0] + part[1] + EPS), kn = rsqrtf(part[2] + part[3] + EPS), beta = sc[0], dec = __expf(sc[1]);
            float kp = 0.f;
#pragma unroll
            for (int i = 0; i < 32; ++i) { s[i] *= dec; kp += ks[d0 + i] * s[i]; }
            red[dg * 128 + e] = kp * kn;
            LDS_BARRIER();
            const float kS = (red[e] + red[128 + e]) + (red[256 + e] + red[384 + e]);
            const float delta = beta * (vs[e] - kS) * kn;
            float op = 0.f;
#pragma unroll
            for (int i = 0; i < 32; ++i) { s[i] += ks[d0 + i] * delta; op += qs[d0 + i] * s[i]; }
            red2[dg * 128 + e] = op * qn;
            LDS_BARRIER();
            if (dg == 0) ORAW[m * 512 + h * 128 + e] = ((red2[e] + red2[128 + e]) + (red2[256 + e] + red2[384 + e])) * DK_SCALE;
        }
        float* So = c.out + (samp ? O_GDNS : O_GDNP) + ((size_t)(b * 4 + h) * 128 + d0) * 128 + e;
#pragma unroll
        for (int i = 0; i < 32; ++i) So[(size_t)i * 128] = s[i];
        __syncthreads();
        for (int t = wave; t < T; t += 8) { const size_t m = m0 + t;
            const float v0 = ORAW[m * 512 + h * 128 + lane], v1 = ORAW[m * 512 + h * 128 + 64 + lane];
            const float r = rsqrtf(wave_sum(v0 * v0 + v1 * v1) * (1.f / 128.f) + EPS);
            const float z0 = bf2f(P1[m * LD1 + C_Z + h * 128 + lane]), z1 = bf2f(P1[m * LD1 + C_Z + h * 128 + 64 + lane]);
            OCAT[m * D + h * 128 + lane] = (bf16)f2bf(v0 * r * gn[lane] * siluf_(z0));
            OCAT[m * D + h * 128 + 64 + lane] = (bf16)f2bf(v1 * r * gn[64 + lane] * siluf_(z1)); }
        __syncthreads();
    }
}

DEV void phase_hgrn_naive(const Ctx& c, int u_begin, int wg_first, int wg_stride) {
    float* red = (float*)c.lds; float* qs = red + 512; float* fs = qs + 128;
    const bf16* PC = c.w<bf16>(WS_P1); float* ORAW = c.w<float>(WS_ORAW); bf16* OC = c.w<bf16>(WS_OCAT);
    const float* lbl = c.in<float>(25); const float* gn = c.in<float>(26);
    const int tid = c.tid, lane = c.lane, wave = c.wave;
    const int NU = (BATCH + DECB) * 8;
    for (int u = u_begin + wg_first; u < NU; u += wg_stride) {
        const bool samp = u >= BATCH * 8; const int b = samp ? (u - BATCH * 8) >> 3 : u >> 3, h = u & 7;
        const int T = samp ? DECS : SEQ; const size_t m0 = samp ? (size_t)MP + (size_t)b * DECS : (size_t)b * SEQ;
        const int e = tid & 127, dg = tid >> 7, d0 = dg * 32;
        float s[32];
        if (samp) { const float* S0 = c.in<float>(6) + ((size_t)(b * 8 + h) * 128 + d0) * 128 + e;
#pragma unroll
            for (int i = 0; i < 32; ++i) s[i] = S0[(size_t)i * 128]; }
        else {
#pragma unroll
            for (int i = 0; i < 32; ++i) s[i] = 0.f; }
        float lb = 0.f; if (tid < 128) lb = sigmoidf_(lbl[1024 + h * 128 + tid] - lbl[h * 128 + tid]);
        bf16 nq = 0, nf = 0, nv = 0;
        { const bf16* row = PC + m0 * INC; if (tid < 128) { nq = row[h * 128 + tid]; nf = row[1024 + h * 128 + tid]; } nv = row[2048 + h * 128 + e]; }
        for (int t = 0; t < T; ++t) {
            const size_t m = m0 + t;
            if (tid < 128) { qs[tid] = siluf_(bf2f(nq)); fs[tid] = lb + (1.f - lb) * sigmoidf_(bf2f(nf)); }
            const float v = bf2f(nv);
            if (t + 1 < T) { const bf16* row = PC + (m + 1) * INC; if (tid < 128) { nq = row[h * 128 + tid]; nf = row[1024 + h * 128 + tid]; } nv = row[2048 + h * 128 + e]; }
            LDS_BARRIER();
            float op = 0.f;
#pragma unroll
            for (int i = 0; i < 32; ++i) { const float f = fs[d0 + i]; s[i] = f * s[i] + (1.f - f) * v; op += qs[d0 + i] * s[i]; }
            red[dg * 128 + e] = op;
            LDS_BARRIER();
            if (dg == 0) ORAW[m * D + h * 128 + e] = ((red[e] + red[128 + e]) + (red[256 + e] + red[384 + e])) * DK_SCALE;
        }
        float* So = c.out + (samp ? O_HGS : O_HGP) + ((size_t)(b * 8 + h) * 128 + d0) * 128 + e;
#pragma unroll
        for (int i = 0; i < 32; ++i) So[(size_t)i * 128] = s[i];
        __syncthreads();
        for (int t = wave; t < T; t += 8) { const size_t m = m0 + t;
            const float v0 = ORAW[m * D + h * 128 + lane], v1 = ORAW[m * D + h * 128 + 64 + lane];
            const float r = rsqrtf(wave_sum(v0 * v0 + v1 * v1) * (1.f / 128.f) + EPS);
            const float z0 = bf2f(PC[m * INC + 3072 + h * 128 + lane]), z1 = bf2f(PC[m * INC + 3072 + h * 128 + 64 + lane]);
            OC[m * D + h * 128 + lane] = (bf16)f2bf(v0 * r * gn[lane] * siluf_(z0));
            OC[m * D + h * 128 + 64 + lane] = (bf16)f2bf(v1 * r * gn[64 + lane] * siluf_(z1)); }
        __syncthreads();
    }
}

DEV bf16x8 ld8(const bf16* p) { return *(const bf16x8*)p; }
DEV void softmax_strip(f32x4 (&s)[4], float (&mrun)[4], float (&lrun)[4], float (&alpha)[4], bf16* Ps, int lane) {
#pragma unroll
    for (int r = 0; r < 4; ++r) {
        float mx = fmaxf(fmaxf(s[0][r], s[1][r]), fmaxf(s[2][r], s[3][r])); mx = grp16_max(mx);
        const float mn = fmaxf(mrun[r], mx);
        alpha[r] = __expf(mrun[r] - mn); mrun[r] = mn;
        float sum = 0.f;
#pragma unroll
        for (int nt = 0; nt < 4; ++nt) { const float p = __expf(s[nt][r] - mn); s[nt][r] = p; sum += p; }
        sum = grp16_sum(sum); lrun[r] = lrun[r] * alpha[r] + sum;
    }
#pragma unroll
    for (int nt = 0; nt < 4; ++nt)
#pragma unroll
        for (int r = 0; r < 4; ++r) Ps[((lane >> 4) * 4 + r) * 72 + nt * 16 + (lane & 15)] = (bf16)f2bf(s[nt][r]);
}
DEV void phase_attn_prompt(const Ctx& c) {
    bf16* Qs = (bf16*)c.lds;
    bf16* Ks = Qs + 128 * 104;
    bf16* Vt = Ks + 64 * 104;
    bf16* Psb = Vt + 64 * 72;
    const float* QH = c.w<float>(WS_QH); const bf16* KVP = c.w<bf16>(WS_KVP); const float* rope = c.w<float>(WS_ROPE); bf16* OCAT = c.w<bf16>(WS_OCAT);
    const float* kpe = c.out + O_KPEP;
    const int tid = c.tid, lane = c.lane, w = c.wave;
    bf16* Ps = Psb + w * 16 * 72;
    constexpr int NQB = SEQ / 128, NU = BATCH * 8 * NQB;
    for (int u = blockIdx.x; u < NU; u += gridDim.x) {
        const int qb = NQB - 1 - u / (BATCH * 8), bh = u % (BATCH * 8), b = bh >> 3, h = bh & 7;
        const int q0 = qb * 128; const size_t mb = (size_t)b * SEQ;
        __syncthreads();
        for (int idx = tid; idx < 128 * 80; idx += 512) {
            const int r = idx / 80, j = idx % 80; const float* qrow = QH + (mb + q0 + r) * 768 + h * 96;
            if (j < 64) Qs[r * 104 + j] = (bf16)f2bf(qrow[j] * MLA_SCALE);
            else { const int f = j - 64; const float* rt = rope + (size_t)(q0 + r) * 32; const float cs = rt[f], sn = rt[16 + f], x1 = qrow[64 + f], x2 = qrow[80 + f];
                Qs[r * 104 + 64 + f] = (bf16)f2bf((x1 * cs - x2 * sn) * MLA_SCALE); Qs[r * 104 + 80 + f] = (bf16)f2bf((x2 * cs + x1 * sn) * MLA_SCALE); }
        }
        __syncthreads();
        bf16x8 qf[3];
#pragma unroll
        for (int ks = 0; ks < 3; ++ks) qf[ks] = ld8(Qs + (w * 16 + (lane & 15)) * 104 + ks * 32 + 8 * (lane >> 4));
        float mrun[4], lrun[4], alpha[4]; f32x4 o[4];
#pragma unroll
        for (int r = 0; r < 4; ++r) { mrun[r] = -INFINITY; lrun[r] = 0.f; }
#pragma unroll
        for (int nt = 0; nt < 4; ++nt) o[nt] = (f32x4){0.f, 0.f, 0.f, 0.f};
        const int nkt = 2 * qb + 2;
        for (int kt = 0; kt < nkt; ++kt) {
            const int k0 = kt * 64;
            __syncthreads();
            for (int idx = tid; idx < 64 * 8; idx += 512) {
                const int key = idx >> 3, ch = idx & 7; *(u32x4*)(Ks + key * 104 + ch * 8) = *(const u32x4*)(KVP + (mb + k0 + key) * 1024 + h * 64 + ch * 8); }
            for (int idx = tid; idx < 64 * 32; idx += 512) { const int key = idx >> 5, f = idx & 31; Ks[key * 104 + 64 + f] = (bf16)f2bf(kpe[(mb + k0 + key) * 32 + f]); }
            for (int idx = tid; idx < 64 * 64; idx += 512) { const int key = idx >> 6, d = idx & 63; Vt[d * 72 + key] = KVP[(mb + k0 + key) * 1024 + 512 + h * 64 + d]; }
            __syncthreads();
            f32x4 s[4];
#pragma unroll
            for (int nt = 0; nt < 4; ++nt) { s[nt] = (f32x4){0.f, 0.f, 0.f, 0.f};
#pragma unroll
                for (int ks = 0; ks < 3; ++ks) s[nt] = mfma16(qf[ks], ld8(Ks + (nt * 16 + (lane & 15)) * 104 + ks * 32 + 8 * (lane >> 4)), s[nt]); }
            if (kt >= 2 * qb) {
#pragma unroll
                for (int nt = 0; nt < 4; ++nt)
#pragma unroll
                    for (int r = 0; r < 4; ++r) { const int qpos = q0 + w * 16 + (lane >> 4) * 4 + r, kpos = k0 + nt * 16 + (lane & 15); if (kpos > qpos) s[nt][r] = -INFINITY; }
            }
            softmax_strip(s, mrun, lrun, alpha, Ps, lane);
            WAVE_SYNC();
#pragma unroll
            for (int nt = 0; nt < 4; ++nt) {
#pragma unroll
                for (int r = 0; r < 4; ++r) o[nt][r] *= alpha[r];
#pragma unroll
                for (int k2 = 0; k2 < 2; ++k2) o[nt] = mfma16(ld8(Ps + (lane & 15) * 72 + k2 * 32 + 8 * (lane >> 4)), ld8(Vt + (nt * 16 + (lane & 15)) * 72 + k2 * 32 + 8 * (lane >> 4)), o[nt]); }
            WAVE_SYNC();
        }
#pragma unroll
        for (int nt = 0; nt < 4; ++nt)
#pragma unroll
            for (int r = 0; r < 4; ++r) OCAT[(mb + q0 + w * 16 + (lane >> 4) * 4 + r) * D + 512 + h * 64 + nt * 16 + (lane & 15)] = (bf16)f2bf(o[nt][r] / lrun[r]);
    }
}

DEV void phase_attn_sample(const Ctx& c) {
    bf16* Qs = (bf16*)c.lds;
    bf16* Ks = Qs + 64 * 296;
    bf16* Lt = Ks + 64 * 296;
    float* Sf = (float*)(Lt + 256 * 72);
    bf16* Psb = (bf16*)(Sf + 64 * 68);
    float* Of = (float*)Ks;
    const float* QH = c.w<float>(WS_QH); const float* rope = c.w<float>(WS_ROPE); bf16* OCAT = c.w<bf16>(WS_OCAT);
    const float* wuk = c.in<float>(21); const float* wuv = c.in<float>(22);
    const float* clat = c.in<float>(4); const float* ckr = c.in<float>(5); const int* ptab = c.in<int>(7);
    const int tid = c.tid, lane = c.lane, w = c.wave;
    bf16* Ps = Psb + w * 16 * 72;
    for (int b = blockIdx.x; b < DECB; b += gridDim.x) {
        const size_t mb = (size_t)MP + (size_t)b * DECS;
        __syncthreads();
        for (int idx = tid; idx < 64 * 64; idx += 512) { const int r = idx >> 6, d = idx & 63, t = r >> 3, h = r & 7; Sf[r * 68 + d] = QH[(mb + t) * 768 + h * 96 + d]; }
        for (int idx = tid; idx < 64 * 16; idx += 512) { const int r = idx >> 4, f = idx & 15, t = r >> 3, h = r & 7; const float* qrow = QH + (mb + t) * 768 + h * 96 + 64;
            const float* rt = rope + (size_t)(SEQ + t) * 32; const float cs = rt[f], sn = rt[16 + f], x1 = qrow[f], x2 = qrow[16 + f];
            Qs[r * 296 + 256 + f] = (bf16)f2bf((x1 * cs - x2 * sn) * MLA_SCALE); Qs[r * 296 + 272 + f] = (bf16)f2bf((x2 * cs + x1 * sn) * MLA_SCALE); }
        __syncthreads();
        {
            const int l = tid & 255, th = tid >> 8;
            for (int h = 0; h < 8; ++h) {
                float a0 = 0.f, a1 = 0.f, a2 = 0.f, a3 = 0.f; const float* wr = wuk + (size_t)l * 512 + h * 64;
                const float* q0 = Sf + ((th * 4 + 0) * 8 + h) * 68; const float* q1 = Sf + ((th * 4 + 1) * 8 + h) * 68; const float* q2 = Sf + ((th * 4 + 2) * 8 + h) * 68; const float* q3 = Sf + ((th * 4 + 3) * 8 + h) * 68;
#pragma unroll 4
                for (int d4 = 0; d4 < 16; ++d4) { const f32x4 wv = *(const f32x4*)(wr + 4 * d4);
#pragma unroll
                    for (int j = 0; j < 4; ++j) { a0 += q0[4 * d4 + j] * wv[j]; a1 += q1[4 * d4 + j] * wv[j]; a2 += q2[4 * d4 + j] * wv[j]; a3 += q3[4 * d4 + j] * wv[j]; } }
                Qs[((th * 4 + 0) * 8 + h) * 296 + l] = (bf16)f2bf(a0 * MLA_SCALE); Qs[((th * 4 + 1) * 8 + h) * 296 + l] = (bf16)f2bf(a1 * MLA_SCALE);
                Qs[((th * 4 + 2) * 8 + h) * 296 + l] = (bf16)f2bf(a2 * MLA_SCALE); Qs[((th * 4 + 3) * 8 + h) * 296 + l] = (bf16)f2bf(a3 * MLA_SCALE);
            }
        }
        __syncthreads();
        const int rt = w & 3, hh = w >> 2;
        bf16x8 qf[9];
#pragma unroll
        for (int ks = 0; ks < 9; ++ks) qf[ks] = ld8(Qs + (rt * 16 + (lane & 15)) * 296 + ks * 32 + 8 * (lane >> 4));
        float mrun[4], lrun[4], alpha[4]; f32x4 o[8];
#pragma unroll
        for (int r = 0; r < 4; ++r) { mrun[r] = -INFINITY; lrun[r] = 0.f; }
#pragma unroll
        for (int nt = 0; nt < 8; ++nt) o[nt] = (f32x4){0.f, 0.f, 0.f, 0.f};
        constexpr int NT = PAST / 64 + 1;
        for (int kt = 0; kt < NT; ++kt) {
            const bool fresh = kt == NT - 1;
            __syncthreads();
            if (!fresh) {
                const int k0 = kt * 64; const size_t rowbase = (size_t)ptab[b * NPAGES + (k0 >> 7)] * PAGE + (k0 & 127);
#pragma unroll 2
                for (int j = 0; j < 8; ++j) { const int idx = tid + 512 * j, key = idx >> 6, l4 = idx & 63;
                    const f32x4 v = *(const f32x4*)(clat + (rowbase + key) * 256 + 4 * l4);
                    u32x2 pk; pk.x = pk2(v[0], v[1]); pk.y = pk2(v[2], v[3]); *(u32x2*)(Ks + key * 296 + 4 * l4) = pk;
                    Lt[(4 * l4 + 0) * 72 + key] = (bf16)f2bf(v[0]); Lt[(4 * l4 + 1) * 72 + key] = (bf16)f2bf(v[1]); Lt[(4 * l4 + 2) * 72 + key] = (bf16)f2bf(v[2]); Lt[(4 * l4 + 3) * 72 + key] = (bf16)f2bf(v[3]); }
                { const int key = tid >> 3, i4 = tid & 7; const f32x4 v = *(const f32x4*)(ckr + (rowbase + key) * 32 + 4 * i4);
                    u32x2 pk; pk.x = pk2(v[0], v[1]); pk.y = pk2(v[2], v[3]); *(u32x2*)(Ks + key * 296 + 256 + 4 * i4) = pk; }
            } else {
                const float* nl = c.out + O_LATS + (size_t)b * DECS * 256; const float* nk = c.out + O_KPES + (size_t)b * DECS * 32;
                for (int idx = tid; idx < 64 * 256; idx += 512) { const int key = idx >> 8, l = idx & 255; const bf16 v = key < DECS ? (bf16)f2bf(nl[key * 256 + l]) : (bf16)0; Ks[key * 296 + l] = v; Lt[l * 72 + key] = v; }
                for (int idx = tid; idx < 64 * 32; idx += 512) { const int key = idx >> 5, f = idx & 31; Ks[key * 296 + 256 + f] = key < DECS ? (bf16)f2bf(nk[key * 32 + f]) : (bf16)0; }
            }
            __syncthreads();
#pragma unroll
            for (int n2 = 0; n2 < 2; ++n2) { const int nt = 2 * hh + n2; f32x4 s = (f32x4){0.f, 0.f, 0.f, 0.f};
#pragma unroll
                for (int ks = 0; ks < 9; ++ks) s = mfma16(qf[ks], ld8(Ks + (nt * 16 + (lane & 15)) * 296 + ks * 32 + 8 * (lane >> 4)), s);
#pragma unroll
                for (int r = 0; r < 4; ++r) { const int row = rt * 16 + (lane >> 4) * 4 + r, key = nt * 16 + (lane & 15); float v = s[r];
                    if (fresh && (key >= DECS || key > (row >> 3))) v = -INFINITY;
                    Sf[row * 68 + key] = v; } }
            __syncthreads();
            f32x4 s[4];
#pragma unroll
            for (int nt = 0; nt < 4; ++nt)
#pragma unroll
                for (int r = 0; r < 4; ++r) s[nt][r] = Sf[(rt * 16 + (lane >> 4) * 4 + r) * 68 + nt * 16 + (lane & 15)];
            softmax_strip(s, mrun, lrun, alpha, Ps, lane);
            WAVE_SYNC();
#pragma unroll
            for (int nt = 0; nt < 8; ++nt) {
#pragma unroll
                for (int r = 0; r < 4; ++r) o[nt][r] *= alpha[r];
#pragma unroll
                for (int k2 = 0; k2 < 2; ++k2) o[nt] = mfma16(ld8(Ps + (lane & 15) * 72 + k2 * 32 + 8 * (lane >> 4)), ld8(Lt + (hh * 128 + nt * 16 + (lane & 15)) * 72 + k2 * 32 + 8 * (lane >> 4)), o[nt]); }
            WAVE_SYNC();
        }
        __syncthreads();
#pragma unroll
        for (int nt = 0; nt < 8; ++nt)
#pragma unroll
            for (int r = 0; r < 4; ++r) Of[(rt * 16 + (lane >> 4) * 4 + r) * 260 + hh * 128 + nt * 16 + (lane & 15)] = o[nt][r] / lrun[r];
        __syncthreads();
        {
            const int d = tid & 63, h = tid >> 6; float a[8];
#pragma unroll
            for (int t = 0; t < 8; ++t) a[t] = 0.f;
            for (int l = 0; l < 256; ++l) { const float wv = wuv[(size_t)l * 512 + h * 64 + d];
#pragma unroll
                for (int t = 0; t < 8; ++t) a[t] += Of[(t * 8 + h) * 260 + l] * wv; }
#pragma unroll
            for (int t = 0; t < 8; ++t) OCAT[(mb + t) * D + 512 + h * 64 + d] = (bf16)f2bf(a[t]);
        }
    }
}

constexpr int NCH = SEQ / 64;
constexpr size_t HC_QG = WS_H, HC_BNT = HC_QG + (size_t)BATCH * 8 * NCH * 64 * 128 * 2,
    HC_A = HC_BNT + (size_t)BATCH * 8 * NCH * 128 * 128 * 2, HC_END = HC_A + (size_t)BATCH * 8 * NCH * 128 * 4;
constexpr size_t HC_SNT = WS_QH;
static_assert(HC_END <= WS_H_END && HC_SNT + (size_t)BATCH * 8 * NCH * 128 * 128 * 2 <= WS_OCAT, "hgrn scratch fits");
DEV u32x4 pack8(const float* v) { u32x4 o; o.x = pk2(v[0], v[1]); o.y = pk2(v[2], v[3]); o.z = pk2(v[4], v[5]); o.w = pk2(v[6], v[7]); return o; }

DEV void phase_hgrn_prep(const Ctx& c) {
    bf16* qt = (bf16*)c.lds;
    bf16* kt = qt + 64 * 136;
    bf16* vT = kt + 160 * 136;
    bf16* Ab = vT + 128 * 72;
    float* tot = (float*)(Ab + 64 * 72);
    bf16* kgl = (bf16*)(tot + 512);
    const bf16* PC = c.w<bf16>(WS_P1); float* ORAW = c.w<float>(WS_ORAW);
    bf16* QG = c.w<bf16>(HC_QG); bf16* BNT = c.w<bf16>(HC_BNT); float* Ag = c.w<float>(HC_A);
    const float* lbl = c.in<float>(25);
    const int tid = c.tid, lane = c.lane, w = c.wave;
    const int d = tid & 127, tq = tid >> 7;
    constexpr int NU = BATCH * 8 * NCH;
    bf16 rq[16], rf[16], rv[16];
#define HP_LOAD(u_) do { const int u__ = (u_); const int bh_ = u__ / NCH, n_ = u__ % NCH; const bf16* row_ = PC + ((size_t)(bh_ >> 3) * SEQ + (size_t)n_ * 64 + 16 * tq) * INC + (bh_ & 7) * 128 + d; \
        _Pragma("unroll") for (int i = 0; i < 16; ++i) { rq[i] = row_[(size_t)i * INC]; rf[i] = row_[(size_t)i * INC + 1024]; rv[i] = row_[(size_t)i * INC + 2048]; } } while (0)
    if ((int)blockIdx.x < NU) HP_LOAD(blockIdx.x);
    for (int u = blockIdx.x; u < NU; u += gridDim.x) {
        const int bh = u / NCH, n = u % NCH, b = bh >> 3, h = bh & 7;
        const size_t m0 = (size_t)b * SEQ + (size_t)n * 64;
        const float lb = sigmoidf_(lbl[1024 + h * 128 + d] - lbl[h * 128 + d]);
        float P[16], Sf[16], kk[16], qq[16], vv[16], ff[16];
        float run = 1.f;
#pragma unroll
        for (int i = 0; i < 16; ++i) {
            const float f = lb + (1.f - lb) * sigmoidf_(bf2f(rf[i]));
            ff[i] = f; kk[i] = 1.f - f; run *= f; P[i] = run;
            qq[i] = siluf_(bf2f(rq[i])) * DK_SCALE; vv[i] = bf2f(rv[i]);
        }
        { float sr = 1.f;
#pragma unroll
          for (int i = 15; i >= 0; --i) { Sf[i] = sr; sr *= ff[i]; } }
        if (u + (int)gridDim.x < NU) HP_LOAD(u + (int)gridDim.x);
        tot[tq * 128 + d] = run;
        { const u32x4 p0 = pack8(vv), p1 = pack8(vv + 8);
          *(u32x4*)(vT + d * 72 + 16 * tq) = p0; *(u32x4*)(vT + d * 72 + 16 * tq + 8) = p1; }
        for (int i = tid; i < 64 * 72 / 8; i += 512) { u32x4 z; z.x = z.y = z.z = z.w = 0u; *(u32x4*)(Ab + 8 * i) = z; }
        LDS_BARRIER();
        const float q0 = tot[d], q1 = tot[128 + d], q2 = tot[256 + d], q3 = tot[384 + d];
        const float Rt = tq == 0 ? 1.f : (tq == 1 ? q0 : (tq == 2 ? q0 * q1 : q0 * q1 * q2));
        const float Tt = tq == 0 ? q1 * q2 * q3 : (tq == 1 ? q2 * q3 : (tq == 2 ? q3 : 1.f));
        const float M1 = 1.f, M2 = tq == 0 ? q1 : 1.f, M3 = tq == 0 ? q1 * q2 : (tq == 1 ? q2 : 1.f);
        float kg[16];
#pragma unroll
        for (int i = 0; i < 16; ++i) {
            qt[(16 * tq + i) * 136 + d] = (bf16)f2bf(qq[i] * P[i]);
            QG[((size_t)u * 64 + 16 * tq + i) * 128 + d] = (bf16)f2bf(qq[i] * Rt * P[i]);
            kg[i] = kk[i] * Sf[i] * Tt;
            const float kinv = kk[i] * rcpf_(P[i]), ksf = kk[i] * Sf[i];
#pragma unroll
            for (int I = 0; I < 4; ++I) if (I >= tq) { const int base = I == 0 ? 0 : (I == 1 ? 16 : (I == 2 ? 48 : 96));
                const float mI = I == 1 ? M1 : (I == 2 ? M2 : M3);
                kt[(base + 16 * tq + i) * 136 + d] = (bf16)f2bf(I == tq ? kinv : ksf * mI); }
        }
        { bf16* g = kgl + d * 72 + 16 * tq; *(u32x4*)g = pack8(kg); *(u32x4*)(g + 8) = pack8(kg + 8); }
        if (tq == 0) Ag[(size_t)u * 128 + d] = (q0 * q1) * (q2 * q3);
        LDS_BARRIER();
        for (int ti = w; ti < 10; ti += 8) {
            const int I = ti == 0 ? 0 : (ti < 3 ? 1 : (ti < 6 ? 2 : 3)); const int J = ti - (I == 0 ? 0 : (I == 1 ? 1 : (I == 2 ? 3 : 6)));
            const int base = I == 0 ? 0 : (I == 1 ? 16 : (I == 2 ? 48 : 96));
            f32x4 acc = (f32x4){0.f, 0.f, 0.f, 0.f};
#pragma unroll
            for (int ks = 0; ks < 4; ++ks) acc = mfma16(ld8(qt + (16 * I + (lane & 15)) * 136 + ks * 32 + 8 * (lane >> 4)), ld8(kt + (base + 16 * J + (lane & 15)) * 136 + ks * 32 + 8 * (lane >> 4)), acc);
#pragma unroll
            for (int r = 0; r < 4; ++r) { const int i = 16 * I + (lane >> 4) * 4 + r, j = 16 * J + (lane & 15); Ab[i * 72 + j] = (bf16)f2bf((J < I || j <= i) ? acc[r] : 0.f); }
        }
        LDS_BARRIER();
        { const int it = w & 3;
          f32x4 acc[4];
#pragma unroll
          for (int e4 = 0; e4 < 4; ++e4) acc[e4] = (f32x4){0.f, 0.f, 0.f, 0.f};
#pragma unroll
          for (int ks = 0; ks < 2; ++ks) { const bf16x8 af = ld8(Ab + (16 * it + (lane & 15)) * 72 + ks * 32 + 8 * (lane >> 4)); bf16x8 vf[4];
#pragma unroll
            for (int e4 = 0; e4 < 4; ++e4) vf[e4] = ld8(vT + (16 * ((w >> 2) * 4 + e4) + (lane & 15)) * 72 + ks * 32 + 8 * (lane >> 4));
#pragma unroll
            for (int e4 = 0; e4 < 4; ++e4) acc[e4] = mfma16(af, vf[e4], acc[e4]); }
#pragma unroll
          for (int e4 = 0; e4 < 4; ++e4) { const int et = (w >> 2) * 4 + e4;
#pragma unroll
            for (int r = 0; r < 4; ++r) ORAW[(m0 + 16 * it + (lane >> 4) * 4 + r) * D + h * 128 + 16 * et + (lane & 15)] = acc[e4][r]; } }
        {
            bf16x8 ka[2];
#pragma unroll
            for (int ks = 0; ks < 2; ++ks) ka[ks] = ld8(kgl + (16 * w + (lane & 15)) * 72 + ks * 32 + 8 * (lane >> 4));
            bf16* g = BNT + (size_t)u * 16384;
            f32x4 acc[8];
#pragma unroll
            for (int et = 0; et < 8; ++et) acc[et] = (f32x4){0.f, 0.f, 0.f, 0.f};
#pragma unroll
            for (int ks = 0; ks < 2; ++ks) { bf16x8 vf[8];
#pragma unroll
                for (int et = 0; et < 8; ++et) vf[et] = ld8(vT + (16 * et + (lane & 15)) * 72 + ks * 32 + 8 * (lane >> 4));
#pragma unroll
                for (int et = 0; et < 8; ++et) acc[et] = mfma16(ka[ks], vf[et], acc[et]); }
#pragma unroll
            for (int et = 0; et < 8; ++et) { u32x2 o; o.x = pk2(acc[et][0], acc[et][1]); o.y = pk2(acc[et][2], acc[et][3]); *(u32x2*)(g + (16 * et + (lane & 15)) * 128 + 16 * w + 4 * (lane >> 4)) = o; }
        }
        LDS_BARRIER();
    }
}

#undef HP_LOAD
DEV void phase_hgrn_prefix(const Ctx& c) {
    const bf16* BNT = c.w<bf16>(HC_BNT); const float* Ag = c.w<float>(HC_A); bf16* SNT = c.w<bf16>(HC_SNT);
    constexpr int NV = BATCH * 8 * 2048;
    for (int v = blockIdx.x * 512 + c.tid; v < NV; v += gridDim.x * 512) {
        const int bh = v >> 11, x8 = (v & 2047) * 8, d0 = x8 & 127, e = x8 >> 7;
        float S[8];
#pragma unroll
        for (int j = 0; j < 8; ++j) S[j] = 0.f;
        const size_t base = (size_t)bh * NCH * 16384 + x8;
        constexpr int PFD = NCH < 8 ? NCH : 8;
        u32x4 bq[PFD]; f32x4 aq0[PFD], aq1[PFD];
#pragma unroll
        for (int j = 0; j < PFD; ++j) { bq[j] = *(const u32x4*)(BNT + base + (size_t)j * 16384); aq0[j] = *(const f32x4*)(Ag + ((size_t)bh * NCH + j) * 128 + d0); aq1[j] = *(const f32x4*)(Ag + ((size_t)bh * NCH + j) * 128 + d0 + 4); }
#pragma unroll
        for (int n = 0; n < NCH; ++n) {
            const u32x4 bv = bq[n % PFD]; const f32x4 a0 = aq0[n % PFD], a1 = aq1[n % PFD];
            if (n + PFD < NCH) { bq[n % PFD] = *(const u32x4*)(BNT + base + (size_t)(n + PFD) * 16384); aq0[n % PFD] = *(const f32x4*)(Ag + ((size_t)bh * NCH + n + PFD) * 128 + d0); aq1[n % PFD] = *(const f32x4*)(Ag + ((size_t)bh * NCH + n + PFD) * 128 + d0 + 4); }
            *(u32x4*)(SNT + base + (size_t)n * 16384) = pack8(S);
            S[0] = a0[0] * S[0] + __uint_as_float(bv.x << 16); S[1] = a0[1] * S[1] + __uint_as_float(bv.x & 0xffff0000u);
            S[2] = a0[2] * S[2] + __uint_as_float(bv.y << 16); S[3] = a0[3] * S[3] + __uint_as_float(bv.y & 0xffff0000u);
            S[4] = a1[0] * S[4] + __uint_as_float(bv.z << 16); S[5] = a1[1] * S[5] + __uint_as_float(bv.z & 0xffff0000u);
            S[6] = a1[2] * S[6] + __uint_as_float(bv.w << 16); S[7] = a1[3] * S[7] + __uint_as_float(bv.w & 0xffff0000u);
        }
        float* So = c.out + O_HGP + (size_t)bh * 16384;
#pragma unroll
        for (int j = 0; j < 8; ++j) So[(size_t)(d0 + j) * 128 + e] = S[j];
    }
}

DEV void phase_hgrn_out(const Ctx& c) {
    bf16* qg = (bf16*)c.lds;
    bf16* StT = qg + 64 * 136;
    float* ob = (float*)(StT + 128 * 136);
    const bf16* PC = c.w<bf16>(WS_P1); const float* ORAW = c.w<float>(WS_ORAW); bf16* OC = c.w<bf16>(WS_OCAT);
    const bf16* QG = c.w<bf16>(HC_QG); const bf16* SNT = c.w<bf16>(HC_SNT);
    const float* gn = c.in<float>(26);
    const int tid = c.tid, lane = c.lane, w = c.wave;
    const float gn0 = gn[lane], gn1 = gn[64 + lane];
    constexpr int NU = BATCH * 8 * NCH;
    u32x4 pq[2], ps[4]; float or0n[8], or1n[8]; bf16 zz0n[8], zz1n[8];
#define HO_LOAD(u_) do { const int u__ = (u_); const int bh_ = u__ / NCH, n_ = u__ % NCH, b_ = bh_ >> 3, h_ = bh_ & 7; const size_t m0_ = (size_t)b_ * SEQ + (size_t)n_ * 64; \
        _Pragma("unroll") for (int j = 0; j < 2; ++j) pq[j] = *(const u32x4*)(QG + (size_t)u__ * 8192 + 8 * (tid + 512 * j)); \
        _Pragma("unroll") for (int j = 0; j < 4; ++j) ps[j] = *(const u32x4*)(SNT + (size_t)u__ * 16384 + 8 * (tid + 512 * j)); \
        _Pragma("unroll") for (int i8 = 0; i8 < 8; ++i8) { const size_t m = m0_ + w * 8 + i8; or0n[i8] = ORAW[m * D + h_ * 128 + lane]; or1n[i8] = ORAW[m * D + h_ * 128 + 64 + lane]; \
            zz0n[i8] = PC[m * INC + 3072 + h_ * 128 + lane]; zz1n[i8] = PC[m * INC + 3072 + h_ * 128 + 64 + lane]; } } while (0)
    if ((int)blockIdx.x < NU) HO_LOAD(blockIdx.x);
    for (int u = blockIdx.x; u < NU; u += gridDim.x) {
        const int bh = u / NCH, n = u % NCH, b = bh >> 3, h = bh & 7; const size_t m0 = (size_t)b * SEQ + (size_t)n * 64;
        float or0[8], or1[8], zz0[8], zz1[8];
#pragma unroll
        for (int i8 = 0; i8 < 8; ++i8) { or0[i8] = or0n[i8]; or1[i8] = or1n[i8]; zz0[i8] = bf2f(zz0n[i8]); zz1[i8] = bf2f(zz1n[i8]); }
        LDS_BARRIER();
#pragma unroll
        for (int j = 0; j < 2; ++j) { const int idx = tid + 512 * j; *(u32x4*)(qg + (idx >> 4) * 136 + (idx & 15) * 8) = pq[j]; }
#pragma unroll
        for (int j = 0; j < 4; ++j) { const int idx = tid + 512 * j; *(u32x4*)(StT + (idx >> 4) * 136 + (idx & 15) * 8) = ps[j]; }
        if (u + (int)gridDim.x < NU) HO_LOAD(u + (int)gridDim.x);
        LDS_BARRIER();
        { const int it = w & 3; bf16x8 qa[4];
#pragma unroll
          for (int ks = 0; ks < 4; ++ks) qa[ks] = ld8(qg + (16 * it + (lane & 15)) * 136 + ks * 32 + 8 * (lane >> 4));
          f32x4 acc[4];
#pragma unroll
          for (int e4 = 0; e4 < 4; ++e4) acc[e4] = (f32x4){0.f, 0.f, 0.f, 0.f};
#pragma unroll
          for (int ks = 0; ks < 4; ++ks) { bf16x8 bs[4];
#pragma unroll
            for (int e4 = 0; e4 < 4; ++e4) bs[e4] = ld8(StT + (16 * ((w >> 2) * 4 + e4) + (lane & 15)) * 136 + ks * 32 + 8 * (lane >> 4));
#pragma unroll
            for (int e4 = 0; e4 < 4; ++e4) acc[e4] = mfma16(qa[ks], bs[e4], acc[e4]); }
#pragma unroll
          for (int e4 = 0; e4 < 4; ++e4) { const int et = (w >> 2) * 4 + e4;
#pragma unroll
            for (int r = 0; r < 4; ++r) ob[(16 * it + (lane >> 4) * 4 + r) * 132 + 16 * et + (lane & 15)] = acc[e4][r]; } }
        LDS_BARRIER();
        { float ss[8];
#pragma unroll
          for (int i8 = 0; i8 < 8; ++i8) { const int i = w * 8 + i8; or0[i8] += ob[i * 132 + lane]; or1[i8] += ob[i * 132 + 64 + lane]; ss[i8] = or0[i8] * or0[i8] + or1[i8] * or1[i8]; }
#pragma unroll
              for (int i8 = 0; i8 < 8; ++i8) ss[i8] = wave_sum(ss[i8]);
#pragma unroll
          for (int i8 = 0; i8 < 8; ++i8) { const size_t m = m0 + w * 8 + i8; const float r = rsqrtf(ss[i8] * (1.f / 128.f) + EPS);
            OC[m * D + h * 128 + lane] = (bf16)f2bf(or0[i8] * r * gn0 * siluf_(zz0[i8])); OC[m * D + h * 128 + 64 + lane] = (bf16)f2bf(or1[i8] * r * gn1 * siluf_(zz1[i8])); } }
    }
}


constexpr int NUG = BATCH * 4 * NCH;
constexpr size_t GC_W = WS_H, GC_UT = GC_W + (size_t)NUG * 64 * 128 * 2, GC_QG = GC_UT + (size_t)NUG * 128 * 64 * 4, GC_KGT = GC_QG + (size_t)NUG * 64 * 128 * 2,
    GC_AQK = GC_KGT + (size_t)NUG * 128 * 64 * 2, GC_GL = GC_AQK + (size_t)NUG * 64 * 64 * 2, GC_END = GC_GL + (size_t)NUG * 4;
static_assert(GC_END <= WS_H_END, "gdn scratch fits in H");

DEV void phase_gdn_prep(const Ctx& c) {
    bf16* qb = (bf16*)c.lds;
    bf16* kb = qb + 64 * 136;
    float* Lm = (float*)(kb + 64 * 136);
    float* part = Lm + 64 * 68;
    float* gl = part + 256; float* gcs = gl + 64; float* bet = gcs + 64; float* eg = bet + 64; float* egl = eg + 64; float* qn = egl + 64; float* kn = qn + 64;
    float* sqb = kn + 64;
    const bf16* P1 = c.w<bf16>(WS_P1);
    bf16* Wg = c.w<bf16>(GC_W); float* UTg = c.w<float>(GC_UT); bf16* QGg = c.w<bf16>(GC_QG); bf16* KGTg = c.w<bf16>(GC_KGT); bf16* AQKg = c.w<bf16>(GC_AQK); float* GLg = c.w<float>(GC_GL);
    const float* convw = c.in<float>(14);
    const int tid = c.tid, lane = c.lane, w = c.wave;
    const int role = tid >> 7, cc = tid & 127;
    for (int u = blockIdx.x; u < NUG; u += gridDim.x) {
        const int bh = u / NCH, n = u % NCH, b = bh >> 2, h = bh & 3;
        const size_t m0 = (size_t)b * SEQ + (size_t)n * 64;
        float x[64];
        if (role < 3) {
            const int col = role * 512 + h * 128 + cc;
            const float w0 = convw[col], w1 = convw[QKV_A + col], w2 = convw[2 * QKV_A + col], w3 = convw[3 * QKV_A + col];
            const bf16* src = P1 + m0 * LD1 + col;
            float p0 = 0.f, p1 = 0.f, p2 = 0.f;
            if (n > 0) { p0 = bf2f(src[-3 * (long)LD1]); p1 = bf2f(src[-2 * (long)LD1]); p2 = bf2f(src[-1 * (long)LD1]); }
#pragma unroll
            for (int j = 0; j < 64; ++j) x[j] = bf2f(src[(size_t)j * LD1]);
#pragma unroll
            for (int j = 0; j < 64; ++j) { const float cur = x[j]; const float y = w0 * p0 + w1 * p1 + w2 * p2 + w3 * cur; x[j] = siluf_(y); p0 = p1; p1 = p2; p2 = cur; }
            if (role < 2) {
#pragma unroll
                for (int j4 = 0; j4 < 16; ++j4) *(f32x4*)(sqb + tid * 68 + 4 * j4) = (f32x4){x[4 * j4] * x[4 * j4], x[4 * j4 + 1] * x[4 * j4 + 1], x[4 * j4 + 2] * x[4 * j4 + 2], x[4 * j4 + 3] * x[4 * j4 + 3]};
            }
        } else if (cc < 64) {
            const float Aexp = __expf(c.in<float>(15)[h]), dtb = c.in<float>(16)[h];
            bet[cc] = sigmoidf_(bf2f(P1[(m0 + cc) * LD1 + C_B + h]));
            gl[cc] = -Aexp * softplusf_(bf2f(P1[(m0 + cc) * LD1 + C_A + h]) + dtb);
        }
        __syncthreads();
        if (role == 3) {
            if (cc < 64) { float acc = 0.f, totl = 0.f;
                for (int i = 0; i < 64; ++i) { const float g = gl[i]; totl += g; if (i <= cc) acc += g; }
                gcs[cc] = acc; eg[cc] = __expf(acc); egl[cc] = __expf(totl - acc);
                if (cc == 0) GLg[u] = __expf(totl);
            } else { const int j = cc - 64; float sq = 0.f, sk = 0.f;
#pragma unroll 16
                for (int cx = 0; cx < 128; ++cx) { sq += sqb[cx * 68 + j]; sk += sqb[(128 + cx) * 68 + j]; }
                qn[j] = rsqrtf(sq + EPS); kn[j] = rsqrtf(sk + EPS); }
        }
        __syncthreads();
        if (role == 0) {
#pragma unroll
            for (int j = 0; j < 64; ++j) { const float qh = x[j] * qn[j]; qb[j * 136 + cc] = (bf16)f2bf(qh); QGg[((size_t)u * 64 + j) * 128 + cc] = (bf16)f2bf(qh * DK_SCALE * eg[j]); }
        } else if (role == 1) {
            bf16* g = KGTg + ((size_t)u * 128 + cc) * 64;
#pragma unroll
            for (int j8 = 0; j8 < 8; ++j8) { float t[8];
#pragma unroll
                for (int q = 0; q < 8; ++q) { const int j = 8 * j8 + q; const float kh = x[j] * kn[j]; kb[j * 136 + cc] = (bf16)f2bf(kh); t[q] = kh * egl[j]; x[j] = kh * bet[j] * eg[j]; }
                *(u32x4*)(g + 8 * j8) = pack8(t); }
        } else if (role == 2) {
#pragma unroll
            for (int j = 0; j < 64; ++j) x[j] *= bet[j];
        }
        __syncthreads();
        for (int ti = w; ti < 32; ti += 8) {
            const bool isq = ti >= 16; const int I = (ti & 15) >> 2, J = ti & 3;
            if (J > I) { if (isq) {
#pragma unroll
                    for (int r = 0; r < 4; ++r) AQKg[((size_t)u * 64 + 16 * I + (lane >> 4) * 4 + r) * 64 + 16 * J + (lane & 15)] = (bf16)0; }
                continue; }
            const bf16* Ab = isq ? qb : kb;
            f32x4 acc = (f32x4){0.f, 0.f, 0.f, 0.f};
#pragma unroll
            for (int ks = 0; ks < 4; ++ks) acc = mfma16(ld8(Ab + (16 * I + (lane & 15)) * 136 + ks * 32 + 8 * (lane >> 4)), ld8(kb + (16 * J + (lane & 15)) * 136 + ks * 32 + 8 * (lane >> 4)), acc);
#pragma unroll
            for (int r = 0; r < 4; ++r) { const int i = 16 * I + (lane >> 4) * 4 + r, j = 16 * J + (lane & 15);
                const float dcy = __expf(fminf(gcs[i] - gcs[j], 0.f));
                if (isq) AQKg[((size_t)u * 64 + i) * 64 + j] = (bf16)f2bf(i >= j ? acc[r] * DK_SCALE * dcy : 0.f);
                else Lm[i * 68 + j] = i > j ? bet[i] * acc[r] * dcy : 0.f; }
        }
        __syncthreads();
        if (role == 1 || role == 2) {
#pragma unroll
            for (int i = 1; i < 64; ++i) { float acc = x[i];
#pragma unroll
                for (int j = 0; j < i; ++j) acc -= Lm[i * 68 + j] * x[j];
                x[i] = acc; }
            if (role == 1) {
#pragma unroll
                for (int i = 0; i < 64; ++i) Wg[((size_t)u * 64 + i) * 128 + cc] = (bf16)f2bf(x[i]);
            } else { float* g = UTg + ((size_t)u * 128 + cc) * 64;
#pragma unroll
                for (int i4 = 0; i4 < 16; ++i4) *(f32x4*)(g + 4 * i4) = (f32x4){x[4 * i4], x[4 * i4 + 1], x[4 * i4 + 2], x[4 * i4 + 3]}; }
        }
        __syncthreads();
    }
}

DEV void phase_gdn_scan(const Ctx& c, int u_first, int u_stride) {
    bf16* wl = (bf16*)c.lds;
    bf16* qgl = wl + 64 * 136;
    bf16* kgT = qgl + 64 * 136;
    bf16* aqk = kgT + 128 * 72;
    bf16* StT = aqk + 64 * 72;
    bf16* vnT = StT + 128 * 136;
    float* ob = (float*)(vnT + 128 * 72);
    const bf16* P1 = c.w<bf16>(WS_P1); bf16* OCAT = c.w<bf16>(WS_OCAT);
    const bf16* Wg = c.w<bf16>(GC_W); const float* UTg = c.w<float>(GC_UT); const bf16* QGg = c.w<bf16>(GC_QG); const bf16* KGTg = c.w<bf16>(GC_KGT); const bf16* AQKg = c.w<bf16>(GC_AQK); const float* GLg = c.w<float>(GC_GL);
    const float* gn = c.in<float>(17);
    const int tid = c.tid, lane = c.lane, w = c.wave;
    constexpr int NU = BATCH * 4;
    for (int u = u_first; u < NU; u += u_stride) {
        const int b = u >> 2, h = u & 3; const size_t mb = (size_t)b * SEQ;
        f32x4 S[8];
#pragma unroll
        for (int et = 0; et < 8; ++et) S[et] = (f32x4){0.f, 0.f, 0.f, 0.f};
        __syncthreads();
        for (int i = tid; i < 128 * 136 / 8; i += 512) { u32x4 z; z.x = z.y = z.z = z.w = 0u; *(u32x4*)(StT + 8 * i) = z; }
        u32x4 pw[2], pq[2], pk[2], pa;
        const size_t cu0 = (size_t)u * NCH;
#define GD_LOAD(n_) do { const bf16* g0 = Wg + (cu0 + (n_)) * 64 * 128; const bf16* g1 = QGg + (cu0 + (n_)) * 64 * 128; const bf16* g2 = KGTg + (cu0 + (n_)) * 128 * 64; const bf16* g3 = AQKg + (cu0 + (n_)) * 64 * 64; \
            _Pragma("unroll") for (int j = 0; j < 2; ++j) { const int idx = tid + 512 * j; pw[j] = *(const u32x4*)(g0 + 8 * idx); pq[j] = *(const u32x4*)(g1 + 8 * idx); pk[j] = *(const u32x4*)(g2 + 8 * idx); } \
            pa = *(const u32x4*)(g3 + 8 * tid); } while (0)
#define GD_STORE_WQ() do { _Pragma("unroll") for (int j = 0; j < 2; ++j) { const int idx = tid + 512 * j; *(u32x4*)(wl + (idx >> 4) * 136 + (idx & 15) * 8) = pw[j]; *(u32x4*)(qgl + (idx >> 4) * 136 + (idx & 15) * 8) = pq[j]; } } while (0)
#define GD_STORE_KA() do { _Pragma("unroll") for (int j = 0; j < 2; ++j) { const int idx = tid + 512 * j; *(u32x4*)(kgT + (idx >> 3) * 72 + (idx & 7) * 8) = pk[j]; } \
            *(u32x4*)(aqk + (tid >> 3) * 72 + (tid & 7) * 8) = pa; } while (0)
        GD_LOAD(0); GD_STORE_WQ(); GD_STORE_KA();
        __syncthreads();
        const int it = w & 3;
        const float gn0 = gn[lane], gn1 = gn[64 + lane];
        f32x4 u4[4]; float dec, decn;
#define GD_LOADU(dst, dd, n_) do { _Pragma("unroll") for (int e4 = 0; e4 < 4; ++e4) { const int et = (w >> 2) * 4 + e4; dst[e4] = *(const f32x4*)(UTg + ((cu0 + (n_)) * 128 + 16 * et + (lane & 15)) * 64 + 16 * it + 4 * (lane >> 4)); } dd = GLg[cu0 + (n_)]; } while (0)
        GD_LOADU(u4, decn, 0);
        for (int n = 0; n < NCH; ++n) {
            dec = decn;
            if (n + 1 < NCH) GD_LOAD(n + 1);
            f32x4 ao[4], av[4];
#pragma unroll
            for (int e4 = 0; e4 < 4; ++e4) { ao[e4] = (f32x4){0.f, 0.f, 0.f, 0.f}; av[e4] = (f32x4){0.f, 0.f, 0.f, 0.f}; }
#pragma unroll
            for (int ks = 0; ks < 4; ++ks) {
                const bf16x8 wa = ld8(wl + (16 * it + (lane & 15)) * 136 + ks * 32 + 8 * (lane >> 4)), qa = ld8(qgl + (16 * it + (lane & 15)) * 136 + ks * 32 + 8 * (lane >> 4));
                bf16x8 bs[4];
#pragma unroll
                for (int e4 = 0; e4 < 4; ++e4) bs[e4] = ld8(StT + (16 * ((w >> 2) * 4 + e4) + (lane & 15)) * 136 + ks * 32 + 8 * (lane >> 4));
#pragma unroll
                for (int e4 = 0; e4 < 4; ++e4) { av[e4] = mfma16(wa, bs[e4], av[e4]); ao[e4] = mfma16(qa, bs[e4], ao[e4]); }
            }
#pragma unroll
            for (int e4 = 0; e4 < 4; ++e4) { const int et = (w >> 2) * 4 + e4; const f32x4 vn = u4[e4] - av[e4];
                u32x2 o; o.x = pk2(vn[0], vn[1]); o.y = pk2(vn[2], vn[3]); *(u32x2*)(vnT + (16 * et + (lane & 15)) * 72 + 16 * it + 4 * (lane >> 4)) = o; }
            if (n + 1 < NCH) GD_LOADU(u4, decn, n + 1);
            LDS_BARRIER();
            float zz0[8], zz1[8];
#pragma unroll
            for (int i8 = 0; i8 < 8; ++i8) { const size_t m = mb + (size_t)n * 64 + w * 8 + i8; zz0[i8] = bf2f(P1[m * LD1 + C_Z + h * 128 + lane]); zz1[i8] = bf2f(P1[m * LD1 + C_Z + h * 128 + 64 + lane]); }
#pragma unroll
            for (int et = 0; et < 8; ++et) S[et] = S[et] * dec;
#pragma unroll
            for (int ks = 0; ks < 2; ++ks) {
                const bf16x8 aa = ld8(aqk + (16 * it + (lane & 15)) * 72 + ks * 32 + 8 * (lane >> 4)), ka = ld8(kgT + (16 * w + (lane & 15)) * 72 + ks * 32 + 8 * (lane >> 4));
                bf16x8 vf[8];
#pragma unroll
                for (int et = 0; et < 8; ++et) vf[et] = ld8(vnT + (16 * et + (lane & 15)) * 72 + ks * 32 + 8 * (lane >> 4));
#pragma unroll
                for (int e4 = 0; e4 < 4; ++e4) ao[e4] = mfma16(aa, (w >> 2) ? vf[4 + e4] : vf[e4], ao[e4]);
#pragma unroll
                for (int et = 0; et < 8; ++et) S[et] = mfma16(ka, vf[et], S[et]);
            }
#pragma unroll
            for (int e4 = 0; e4 < 4; ++e4) { const int et = (w >> 2) * 4 + e4;
#pragma unroll
                for (int r = 0; r < 4; ++r) ob[(16 * it + (lane >> 4) * 4 + r) * 132 + 16 * et + (lane & 15)] = ao[e4][r]; }
#pragma unroll
            for (int et = 0; et < 8; ++et) { u32x2 o; o.x = pk2(S[et][0], S[et][1]); o.y = pk2(S[et][2], S[et][3]); *(u32x2*)(StT + (16 * et + (lane & 15)) * 136 + 16 * w + (lane >> 4) * 4) = o; }
            if (n + 1 < NCH) GD_STORE_WQ();
            LDS_BARRIER();
            { float ss[8], v0[8], v1[8];
#pragma unroll
              for (int i8 = 0; i8 < 8; ++i8) { const int i = w * 8 + i8; v0[i8] = ob[i * 132 + lane]; v1[i8] = ob[i * 132 + 64 + lane]; ss[i8] = v0[i8] * v0[i8] + v1[i8] * v1[i8]; }
#pragma unroll
              for (int i8 = 0; i8 < 8; ++i8) ss[i8] = wave_sum(ss[i8]);
#pragma unroll
              for (int i8 = 0; i8 < 8; ++i8) { const size_t m = mb + (size_t)n * 64 + w * 8 + i8; const float r = rsqrtf(ss[i8] * (1.f / 128.f) + EPS);
                OCAT[m * D + h * 128 + lane] = (bf16)f2bf(v0[i8] * r * gn0 * siluf_(zz0[i8])); OCAT[m * D + h * 128 + 64 + lane] = (bf16)f2bf(v1[i8] * r * gn1 * siluf_(zz1[i8])); } }
            if (n + 1 < NCH) GD_STORE_KA();
        }
#undef GD_LOAD
#undef GD_LOADU
#undef GD_STORE_WQ
#undef GD_STORE_KA
        int lane3 = lane; OPAQUE_V(lane3);
        float* So = c.out + O_GDNP + (size_t)(b * 4 + h) * 16384;
#pragma unroll
        for (int et = 0; et < 8; ++et)
#pragma unroll
            for (int r = 0; r < 4; ++r) So[(size_t)(16 * w + (lane3 >> 4) * 4 + r) * 128 + 16 * et + (lane3 & 15)] = S[et][r];
    }
}


template <int NT> DEV void softmax_rows(f32x4 (&s)[NT], float (&mrun)[4], float (&lrun)[4], float (&alpha)[4], bf16* Ps, int pitch, int lane) {
#pragma unroll
    for (int r = 0; r < 4; ++r) {
        float mx = s[0][r];
#pragma unroll
        for (int nt = 1; nt < NT; ++nt) mx = fmaxf(mx, s[nt][r]);
        mx = grp16_max(mx);
        const float mn = fmaxf(mrun[r], mx);
        alpha[r] = exp2f_(mrun[r] - mn); mrun[r] = mn;
        float sum = 0.f;
#pragma unroll
        for (int nt = 0; nt < NT; ++nt) { const float p = exp2f_(s[nt][r] - mn); s[nt][r] = p; sum += p; }
        sum = grp16_sum(sum); lrun[r] = lrun[r] * alpha[r] + sum;
    }
#pragma unroll
    for (int nt = 0; nt < NT; ++nt)
#pragma unroll
        for (int r = 0; r < 4; ++r) Ps[((lane >> 4) * 4 + r) * pitch + nt * 16 + (lane & 15)] = (bf16)f2bf(s[nt][r]);
}
DEV bf16x8 ldB_tr(const bf16* T, int pitch, int k0, int n0, int lane) {
    const bf16* p = T + (size_t)(k0 + 8 * (lane >> 4) + ((lane & 15) >> 2)) * pitch + n0 + 4 * (lane & 3);
    const s16x4 a = lds_tr(p), b = lds_tr(p + 4 * pitch);
    bf16x8 r; r[0] = a[0]; r[1] = a[1]; r[2] = a[2]; r[3] = a[3]; r[4] = b[0]; r[5] = b[1]; r[6] = b[2]; r[7] = b[3]; return r;
}
constexpr int AS_NSP = 2;
DEV void phase_attn_sample2(const Ctx& c) {
    bf16* Qs = (bf16*)c.lds;
    bf16* Kt0 = Qs + 64 * 296;
    bf16* Psb = Kt0 + 2 * 32 * 296;
    bf16* qtmp = Kt0;
    float* Xo = (float*)c.lds;
    float* Xm = Xo + 64 * 256; float* Xl = Xm + 64;
    const float* QH = c.w<float>(WS_QH); const float* rope = c.w<float>(WS_ROPE); const bf16* WUKB = c.w<bf16>(WS_WUKB);
    float* PO = c.w<float>(WS_PO); float* PM = c.w<float>(WS_PM); float* PL = c.w<float>(WS_PL);
    const float* clat = c.in<float>(4); const float* ckr = c.in<float>(5); const int* ptab = c.in<int>(7);
    const int tid = c.tid, lane = c.lane, w = c.wave, grp = w >> 2, wq = w & 3, gt = tid & 255;
    bf16* Kt = Kt0 + grp * 32 * 296; bf16* Ps = Psb + w * 16 * 40;
    constexpr int NPT32 = PAST / 32, TPS = NPT32 / AS_NSP;
    static_assert(NPT32 % (2 * AS_NSP) == 0, "tiles per split must be even");
    for (int u = blockIdx.x; u < DECB * AS_NSP; u += gridDim.x) {
        const int b = u / AS_NSP, sp = u % AS_NSP; const size_t mb = (size_t)MP + (size_t)b * DECS;
        __syncthreads();
        for (int idx = tid; idx < 64 * 8; idx += 512) { const int r = idx >> 3, ch = idx & 7, t = r >> 3, h = r & 7; const float* q = QH + (mb + t) * 768 + h * 96 + ch * 8;
            const f32x4 a = *(const f32x4*)q, bq = *(const f32x4*)(q + 4); u32x4 o; o.x = pk2(a[0], a[1]); o.y = pk2(a[2], a[3]); o.z = pk2(bq[0], bq[1]); o.w = pk2(bq[2], bq[3]); *(u32x4*)(qtmp + r * 72 + ch * 8) = o; }
        for (int idx = tid; idx < 64 * 16; idx += 512) { const int r = idx >> 4, f = idx & 15, t = r >> 3, h = r & 7; const float* qrow = QH + (mb + t) * 768 + h * 96 + 64;
            const float* rt = rope + (size_t)(SEQ + t) * 32; const float cs = rt[f], sn = rt[16 + f], x1 = qrow[f], x2 = qrow[16 + f];
            Qs[r * 296 + 256 + f] = (bf16)f2bf((x1 * cs - x2 * sn) * QK_SCALE2); Qs[r * 296 + 272 + f] = (bf16)f2bf((x2 * cs + x1 * sn) * QK_SCALE2); }
        __syncthreads();
        {
            const int h = w; bf16x8 af[2];
#pragma unroll
            for (int ks = 0; ks < 2; ++ks) af[ks] = ld8(qtmp + (((lane & 7)) * 8 + h) * 72 + ks * 32 + 8 * (lane >> 4));
#pragma unroll 4
            for (int nt = 0; nt < 16; ++nt) { f32x4 acc = (f32x4){0.f, 0.f, 0.f, 0.f};
#pragma unroll
                for (int ks = 0; ks < 2; ++ks) acc = mfma16(af[ks], ld8(WUKB + (size_t)(nt * 16 + (lane & 15)) * 512 + h * 64 + ks * 32 + 8 * (lane >> 4)), acc);
                if ((lane >> 4) < 2) {
#pragma unroll
                    for (int r = 0; r < 4; ++r) Qs[(((lane >> 4) * 4 + r) * 8 + h) * 296 + nt * 16 + (lane & 15)] = (bf16)f2bf(acc[r] * QK_SCALE2); } }
        }
        __syncthreads();
        float mrun[4], lrun[4], alpha[4]; f32x4 o[16];
#pragma unroll
        for (int r = 0; r < 4; ++r) { mrun[r] = -INFINITY; lrun[r] = 0.f; }
#pragma unroll
        for (int nt = 0; nt < 16; ++nt) o[nt] = (f32x4){0.f, 0.f, 0.f, 0.f};
        const int t_begin = sp * TPS, t_end = t_begin + TPS + (sp == AS_NSP - 1 ? 1 : 0);
        const int NI = (t_end - t_begin + 1) / 2;
        static_assert(NPAGES <= 64, "page table of one batch row is held one entry per lane");
        const int ptv = lane < NPAGES ? ptab[b * NPAGES + lane] : 0;
#ifdef HIPEMU
#define PT_LOOKUP(pg_) __shfl(ptv, (pg_))
#else
#define PT_LOOKUP(pg_) __builtin_amdgcn_readlane(ptv, (pg_))
#endif
        f32x4 plA[8], prA, plB[8], prB;
        const float* nl = c.out + O_LATS + (size_t)b * DECS * 256; const float* nk = c.out + O_KPES + (size_t)b * DECS * 32;
#define AS_LOAD(pl, pr, tile_) do { const int tl_ = (tile_); \
            if (tl_ < NPT32) { const int k0_ = tl_ * 32; const size_t rb_ = (size_t)PT_LOOKUP(k0_ >> 7) * PAGE + (k0_ & 127); \
                _Pragma("unroll") for (int j = 0; j < 8; ++j) { const int idx = gt + 256 * j; pl[j] = *(const f32x4*)(clat + (rb_ + (idx >> 6)) * 256 + 4 * (idx & 63)); } \
                pr = *(const f32x4*)(ckr + (rb_ + (gt >> 3)) * 32 + 4 * (gt & 7)); } \
            else if (tl_ == NPT32) { \
                _Pragma("unroll") for (int j = 0; j < 8; ++j) { const int idx = gt + 256 * j, key = idx >> 6; pl[j] = key < DECS ? *(const f32x4*)(nl + key * 256 + 4 * (idx & 63)) : (f32x4){0.f, 0.f, 0.f, 0.f}; } \
                pr = (gt >> 3) < DECS ? *(const f32x4*)(nk + (gt >> 3) * 32 + 4 * (gt & 7)) : (f32x4){0.f, 0.f, 0.f, 0.f}; } } while (0)
#define AS_ITER(pl, pr, it_) do { \
            const int tile = t_begin + 2 * (it_) + grp; const bool valid = tile < t_end; \
            if (valid) { \
                _Pragma("unroll") for (int j = 0; j < 8; ++j) { const int idx = gt + 256 * j; u32x2 pk; pk.x = pk2(pl[j][0], pl[j][1]); pk.y = pk2(pl[j][2], pl[j][3]); *(u32x2*)(Kt + (idx >> 6) * 296 + 4 * (idx & 63)) = pk; } \
                { u32x2 pk; pk.x = pk2(pr[0], pr[1]); pk.y = pk2(pr[2], pr[3]); *(u32x2*)(Kt + (gt >> 3) * 296 + 256 + 4 * (gt & 7)) = pk; } \
            } \
            { const int nt_ = tile + 4; AS_LOAD(pl, pr, nt_ < t_end ? nt_ : NPT32 + 1); } \
            LDS_BARRIER(); \
            if (valid) { \
                f32x4 s[2], s2_[2]; \
                _Pragma("unroll") for (int nt = 0; nt < 2; ++nt) { s[nt] = (f32x4){0.f, 0.f, 0.f, 0.f}; s2_[nt] = (f32x4){0.f, 0.f, 0.f, 0.f}; } \
                _Pragma("unroll") for (int ks = 0; ks < 9; ++ks) {   \
                    const bf16x8 qa_ = ld8(Qs + (wq * 16 + (lane & 15)) * 296 + ks * 32 + 8 * (lane >> 4)); \
                    const bf16x8 k0_ = ld8(Kt + ((lane & 15)) * 296 + ks * 32 + 8 * (lane >> 4)), k1_ = ld8(Kt + (16 + (lane & 15)) * 296 + ks * 32 + 8 * (lane >> 4)); \
                    if (ks & 1) { s2_[0] = mfma16(qa_, k0_, s2_[0]); s2_[1] = mfma16(qa_, k1_, s2_[1]); } else { s[0] = mfma16(qa_, k0_, s[0]); s[1] = mfma16(qa_, k1_, s[1]); } } \
                s[0] += s2_[0]; s[1] += s2_[1]; \
                if (tile == NPT32) { \
                    _Pragma("unroll") for (int nt = 0; nt < 2; ++nt) \
                        _Pragma("unroll") for (int r = 0; r < 4; ++r) { const int row = wq * 16 + (lane >> 4) * 4 + r, key = nt * 16 + (lane & 15); if (key >= DECS || key > (row >> 3)) s[nt][r] = -INFINITY; } \
                } \
                softmax_rows<2>(s, mrun, lrun, alpha, Ps, 40, lane); \
                WAVE_SYNC(); \
                const bf16x8 pf = ld8(Ps + (lane & 15) * 40 + 8 * (lane >> 4)); \
                if (wave_any((alpha[0] != 1.f) | (alpha[1] != 1.f) | (alpha[2] != 1.f) | (alpha[3] != 1.f))) { \
                    _Pragma("unroll") for (int nt = 0; nt < 16; ++nt) \
                        _Pragma("unroll") for (int r = 0; r < 4; ++r) o[nt][r] *= alpha[r]; } \
                _Pragma("unroll") for (int nt = 0; nt < 16; ++nt) o[nt] = mfma16(pf, ldB_tr(Kt, 296, 0, nt * 16, lane), o[nt]); \
            } \
            LDS_BARRIER(); } while (0)
        AS_LOAD(plA, prA, t_begin + grp < t_end ? t_begin + grp : NPT32 + 1);
        AS_LOAD(plB, prB, t_begin + 2 + grp < t_end ? t_begin + 2 + grp : NPT32 + 1);
#pragma unroll 1
        for (int it = 0; it < NI; it += 2) {
            AS_ITER(plA, prA, it);
            if (it + 1 < NI) AS_ITER(plB, prB, it + 1);
        }
#undef AS_ITER
#undef PT_LOOKUP
#undef AS_LOAD
        int lane2 = lane; OPAQUE_V(lane2);
        if (grp == 1) {
#pragma unroll
            for (int nt = 0; nt < 16; ++nt)
#pragma unroll
                for (int r = 0; r < 4; ++r) Xo[(wq * 16 + (lane2 >> 4) * 4 + r) * 256 + nt * 16 + (lane2 & 15)] = o[nt][r];
            if ((lane2 & 15) == 0) {
#pragma unroll
                for (int r = 0; r < 4; ++r) { Xm[wq * 16 + (lane2 >> 4) * 4 + r] = mrun[r]; Xl[wq * 16 + (lane2 >> 4) * 4 + r] = lrun[r]; } }
        }
        __syncthreads();
        if (grp == 0) {
            float a1[4], a2[4];
#pragma unroll
            for (int r = 0; r < 4; ++r) { const int row = wq * 16 + (lane2 >> 4) * 4 + r; const float m2 = Xm[row], l2 = Xl[row]; const float mm = fmaxf(mrun[r], m2);
                a1[r] = exp2f_(mrun[r] - mm); a2[r] = exp2f_(m2 - mm); lrun[r] = lrun[r] * a1[r] + l2 * a2[r]; mrun[r] = mm;
                if ((lane2 & 15) == 0) { PM[(size_t)u * 64 + row] = mm; PL[(size_t)u * 64 + row] = lrun[r]; } }
#pragma unroll
            for (int nt = 0; nt < 16; ++nt)
#pragma unroll
                for (int r = 0; r < 4; ++r) { const int row = wq * 16 + (lane2 >> 4) * 4 + r, col = nt * 16 + (lane2 & 15); PO[((size_t)u * 64 + row) * 256 + col] = o[nt][r] * a1[r] + Xo[row * 256 + col] * a2[r]; }
        }
    }
}
DEV void phase_attn_sample_combine(const Ctx& c) {
    bf16* Ol = (bf16*)c.lds;
    const float* PO = c.w<float>(WS_PO); const float* PM = c.w<float>(WS_PM); const float* PL = c.w<float>(WS_PL);
    const bf16* WUV = c.w<bf16>(WS_WUKV) + (size_t)512 * 256; bf16* OCAT = c.w<bf16>(WS_OCAT);
    const int tid = c.tid, lane = c.lane, w = c.wave;
    for (int b = (int)gridDim.x - 1 - (int)blockIdx.x; b < DECB; b += gridDim.x) {
        const size_t mb = (size_t)MP + (size_t)b * DECS;
        __syncthreads();
        for (int idx = tid; idx < 64 * 64; idx += 512) { const int row = idx >> 6, c4 = idx & 63;
            float mm = -INFINITY;
#pragma unroll
            for (int s = 0; s < AS_NSP; ++s) mm = fmaxf(mm, PM[((size_t)b * AS_NSP + s) * 64 + row]);
            float lt = 0.f; f32x4 acc = (f32x4){0.f, 0.f, 0.f, 0.f};
#pragma unroll
            for (int s = 0; s < AS_NSP; ++s) { const size_t ur = ((size_t)b * AS_NSP + s) * 64 + row; const float a = exp2f_(PM[ur] - mm); lt += PL[ur] * a; acc += *(const f32x4*)(PO + ur * 256 + 4 * c4) * a; }
            const float inv = 1.f / lt; u32x2 o; o.x = pk2(acc[0] * inv, acc[1] * inv); o.y = pk2(acc[2] * inv, acc[3] * inv); *(u32x2*)(Ol + row * 264 + 4 * c4) = o; }
        __syncthreads();
        { const int h = w;
#pragma unroll
          for (int nt = 0; nt < 4; ++nt) { f32x4 acc = (f32x4){0.f, 0.f, 0.f, 0.f};
#pragma unroll
            for (int ks = 0; ks < 8; ++ks) acc = mfma16(ld8(Ol + ((lane & 7) * 8 + h) * 264 + ks * 32 + 8 * (lane >> 4)), ld8(WUV + (size_t)(h * 64 + nt * 16 + (lane & 15)) * 256 + ks * 32 + 8 * (lane >> 4)), acc);
            if ((lane >> 4) < 2) {
#pragma unroll
                for (int r = 0; r < 4; ++r) OCAT[(mb + (lane >> 4) * 4 + r) * D + 512 + h * 64 + nt * 16 + (lane & 15)] = (bf16)f2bf(acc[r]); } } }
    }
}

DEV bf16x8 cvt8(const f32x4 a, const f32x4 b, float sc) { bf16x8 r; const u32x4 p = {pk2(a[0] * sc, a[1] * sc), pk2(a[2] * sc, a[3] * sc), pk2(b[0] * sc, b[1] * sc), pk2(b[2] * sc, b[3] * sc)};
    r = __builtin_bit_cast(bf16x8, p); return r; }
DEV void phase_attn_prompt2(const Ctx& c, int qid = 0) {
    bf16* KV0 = (bf16*)c.lds;
    constexpr int KVB = 64 * 104 + 64 * 72;
    bf16* Psb = KV0 + 2 * KVB;
    const float* QH = c.w<float>(WS_QH); const bf16* KVP = c.w<bf16>(WS_KVP); const bf16* KPEB = c.w<bf16>(WS_KPEB); const float* rope = c.w<float>(WS_ROPE); bf16* OCAT = c.w<bf16>(WS_OCAT);
    const int tid = c.tid, lane = c.lane, w = c.wave;
    bf16* Ps = Psb + w * 32 * 72;
    constexpr int NQB = SEQ / 256, NPU = NQB * BATCH * 8;
    for (;;) {
        const int pu = queue_next(c, qid);
        if (pu >= NPU) break;
        const int qb = NQB - 1 - pu / (BATCH * 8), bh = pu % (BATCH * 8), b = bh >> 3, h = bh & 7; const size_t mb = (size_t)b * SEQ;
        {
            const int q0 = qb * 256, rmin = q0 + 32 * w;
            bf16x8 qf[2][3];
#pragma unroll
            for (int mt = 0; mt < 2; ++mt) { const int qr = rmin + 16 * mt + (lane & 15); const float* qrow = QH + (mb + qr) * 768 + h * 96; const int g = lane >> 4;
#pragma unroll
                for (int ks = 0; ks < 2; ++ks) qf[mt][ks] = cvt8(*(const f32x4*)(qrow + ks * 32 + 8 * g), *(const f32x4*)(qrow + ks * 32 + 8 * g + 4), QK_SCALE2);
                const int f0 = 8 * (g & 1); const float* rt = rope + (size_t)qr * 32;
                const f32x4 x1a = *(const f32x4*)(qrow + 64 + f0), x1b = *(const f32x4*)(qrow + 64 + f0 + 4), x2a = *(const f32x4*)(qrow + 80 + f0), x2b = *(const f32x4*)(qrow + 80 + f0 + 4);
                const f32x4 ca = *(const f32x4*)(rt + f0), cb = *(const f32x4*)(rt + f0 + 4), sa = *(const f32x4*)(rt + 16 + f0), sb = *(const f32x4*)(rt + 16 + f0 + 4);
                const f32x4 ya = g < 2 ? x1a * ca - x2a * sa : x2a * ca + x1a * sa, yb = g < 2 ? x1b * cb - x2b * sb : x2b * cb + x1b * sb;
                qf[mt][2] = cvt8(ya, yb, QK_SCALE2); }
            float mrun[2][4], lrun[2][4], alpha[2][4]; f32x4 o[2][4];
#pragma unroll
            for (int mt = 0; mt < 2; ++mt) {
#pragma unroll
                for (int r = 0; r < 4; ++r) { mrun[mt][r] = -INFINITY; lrun[mt][r] = 0.f; }
#pragma unroll
                for (int nt = 0; nt < 4; ++nt) o[mt][nt] = (f32x4){0.f, 0.f, 0.f, 0.f}; }
            const int nkt = 4 * qb + 4;
            u32x4 pk_, pp_, pv_;
#define AP_LOAD(kt_) do { const size_t kr_ = mb + (size_t)(kt_) * 64; \
                pk_ = *(const u32x4*)(KVP + (kr_ + (tid >> 3)) * 1024 + h * 64 + (tid & 7) * 8); \
                pv_ = *(const u32x4*)(KVP + (kr_ + (tid >> 3)) * 1024 + 512 + h * 64 + (tid & 7) * 8); \
                if (tid < 256) pp_ = *(const u32x4*)(KPEB + (kr_ + (tid >> 2)) * 32 + (tid & 3) * 8); } while (0)
#define AP_STORE(buf_) do { bf16* Kb_ = KV0 + (buf_) * KVB; bf16* Vb_ = Kb_ + 64 * 104; \
                *(u32x4*)(Kb_ + (tid >> 3) * 104 + (tid & 7) * 8) = pk_; *(u32x4*)(Vb_ + (tid >> 3) * 72 + (tid & 7) * 8) = pv_; \
                if (tid < 256) *(u32x4*)(Kb_ + (tid >> 2) * 104 + 64 + (tid & 3) * 8) = pp_; } while (0)
            __syncthreads();
            AP_LOAD(0); AP_STORE(0);
            if (nkt > 1) AP_LOAD(1);
            __syncthreads();
            for (int kt = 0; kt < nkt; ++kt) {
                const bf16* Ks = KV0 + (kt & 1) * KVB; const bf16* Vs = Ks + 64 * 104;
                if (kt + 1 < nkt) AP_STORE((kt + 1) & 1);
                if (kt + 2 < nkt) AP_LOAD(kt + 2);
                const int k0 = kt * 64;
                if (k0 <= rmin + 31) {
                    f32x4 s[2][4];
#pragma unroll
                    for (int nt = 0; nt < 4; ++nt) { s[0][nt] = (f32x4){0.f, 0.f, 0.f, 0.f}; s[1][nt] = (f32x4){0.f, 0.f, 0.f, 0.f}; }
#pragma unroll
                    for (int ks = 0; ks < 3; ++ks) {
                        bf16x8 kf[4];
#pragma unroll
                        for (int nt = 0; nt < 4; ++nt) kf[nt] = ld8(Ks + (nt * 16 + (lane & 15)) * 104 + ks * 32 + 8 * (lane >> 4));
#pragma unroll
                        for (int nt = 0; nt < 4; ++nt) { s[0][nt] = mfma16(qf[0][ks], kf[nt], s[0][nt]); s[1][nt] = mfma16(qf[1][ks], kf[nt], s[1][nt]); } }
                    if (k0 + 63 > rmin) {
#pragma unroll
                        for (int mt = 0; mt < 2; ++mt)
#pragma unroll
                            for (int nt = 0; nt < 4; ++nt)
#pragma unroll
                                for (int r = 0; r < 4; ++r) { const int qpos = rmin + 16 * mt + (lane >> 4) * 4 + r, kpos = k0 + nt * 16 + (lane & 15); if (kpos > qpos) s[mt][nt][r] = -INFINITY; }
                    }
                    softmax_rows<4>(s[0], mrun[0], lrun[0], alpha[0], Ps, 72, lane);
                    softmax_rows<4>(s[1], mrun[1], lrun[1], alpha[1], Ps + 16 * 72, 72, lane);
                    WAVE_SYNC();
                    if (wave_any((alpha[0][0] != 1.f) | (alpha[0][1] != 1.f) | (alpha[0][2] != 1.f) | (alpha[0][3] != 1.f) | (alpha[1][0] != 1.f) | (alpha[1][1] != 1.f) | (alpha[1][2] != 1.f) | (alpha[1][3] != 1.f))) {
#pragma unroll
                    for (int mt = 0; mt < 2; ++mt)
#pragma unroll
                        for (int nt = 0; nt < 4; ++nt)
#pragma unroll
                            for (int r = 0; r < 4; ++r) o[mt][nt][r] *= alpha[mt][r]; }
#pragma unroll
                    for (int k2 = 0; k2 < 2; ++k2) { const bf16x8 p0 = ld8(Ps + (lane & 15) * 72 + k2 * 32 + 8 * (lane >> 4)), p1 = ld8(Ps + (16 + (lane & 15)) * 72 + k2 * 32 + 8 * (lane >> 4));
                        bf16x8 vf[4];
#pragma unroll
                        for (int nt = 0; nt < 4; ++nt) vf[nt] = ldB_tr(Vs, 72, k2 * 32, nt * 16, lane);
#pragma unroll
                        for (int nt = 0; nt < 4; ++nt) { o[0][nt] = mfma16(p0, vf[nt], o[0][nt]); o[1][nt] = mfma16(p1, vf[nt], o[1][nt]); } }
                    WAVE_SYNC();
                }
                LDS_BARRIER();
            }
#undef AP_LOAD
#undef AP_STORE
#pragma unroll
            for (int mt = 0; mt < 2; ++mt)
#pragma unroll
                for (int nt = 0; nt < 4; ++nt)
#pragma unroll
                    for (int r = 0; r < 4; ++r) OCAT[(mb + rmin + 16 * mt + (lane >> 4) * 4 + r) * D + 512 + h * 64 + nt * 16 + (lane & 15)] = (bf16)f2bf(o[mt][nt][r] / lrun[mt][r]);
        }
    }
}

DEV void phase_gdn_sample(const Ctx& c, int wg_first, int wg_stride) {
    float* red = (float*)c.lds; float* red2 = red + 512; float* qs = red2 + 512; float* ks = qs + 128; float* vs = ks + 128; float* part = vs + 128;
    float* scb = part + 8; float* scg = scb + 8; float* obuf = scg + 8;
    const bf16* P1 = c.w<bf16>(WS_P1); bf16* OCAT = c.w<bf16>(WS_OCAT);
    const float* convw = c.in<float>(14); const float* gn = c.in<float>(17);
    const int tid = c.tid, lane = c.lane, wave = c.wave;
    const int e = tid & 127, dg = tid >> 7, d0 = dg * 32;
    for (int u = wg_first; u < DECB * 4; u += wg_stride) {
        const int b = u >> 2, h = u & 3; const size_t m0 = (size_t)MP + (size_t)b * DECS;
        float s[32];
        { const float* S0 = c.in<float>(2) + ((size_t)(b * 4 + h) * 128 + d0) * 128 + e;
#pragma unroll
          for (int i = 0; i < 32; ++i) s[i] = S0[(size_t)i * 128]; }
        const int col = tid < 128 ? h * 128 + tid : (tid < 256 ? 512 + h * 128 + (tid - 128) : 1024 + h * 128 + (tid - 256));
        float w0 = 0.f, w1 = 0.f, w2 = 0.f, w3 = 0.f, x0 = 0.f, x1 = 0.f, x2 = 0.f; bf16 xs[8];
#pragma unroll
        for (int t = 0; t < 8; ++t) xs[t] = 0;
        if (tid < 384) { w0 = convw[col]; w1 = convw[QKV_A + col]; w2 = convw[2 * QKV_A + col]; w3 = convw[3 * QKV_A + col];
            const float* cb = c.in<float>(3) + (size_t)b * 3 * QKV_A + col; x0 = cb[0]; x1 = cb[QKV_A]; x2 = cb[2 * QKV_A];
#pragma unroll
            for (int t = 0; t < 8; ++t) xs[t] = P1[(m0 + t) * LD1 + col]; }
        else if (tid < 392) { const int t = tid - 384; const float Aexp = __expf(c.in<float>(15)[h]), dtb = c.in<float>(16)[h];
            scb[t] = sigmoidf_(bf2f(P1[(m0 + t) * LD1 + C_B + h])); scg[t] = __expf(-Aexp * softplusf_(bf2f(P1[(m0 + t) * LD1 + C_A + h]) + dtb)); }
        const bf16 zr0 = P1[(m0 + wave) * LD1 + C_Z + h * 128 + lane], zr1 = P1[(m0 + wave) * LD1 + C_Z + h * 128 + 64 + lane];
#pragma unroll
        for (int t = 0; t < 8; ++t) {
            float val = 0.f;
            if (tid < 384) { const float x3 = bf2f(xs[t]); const float y = w0 * x0 + w1 * x1 + w2 * x2 + w3 * x3; val = siluf_(y); x0 = x1; x1 = x2; x2 = x3; }
            const float sq = wave_sum(tid < 256 ? val * val : 0.f);
            if (tid < 128) qs[tid] = val; else if (tid < 256) ks[tid - 128] = val; else if (tid < 384) vs[tid - 256] = val;
            if (lane == 0 && wave < 4) part[wave] = sq;
            LDS_BARRIER();
            const float qn = rsqrtf(part[0] + part[1] + EPS), kn = rsqrtf(part[2] + part[3] + EPS), beta = scb[t], dec = scg[t];
            float kp = 0.f;
#pragma unroll
            for (int i = 0; i < 32; ++i) { s[i] *= dec; kp += ks[d0 + i] * s[i]; }
            red[dg * 128 + e] = kp * kn;
            LDS_BARRIER();
            const float kS = (red[e] + red[128 + e]) + (red[256 + e] + red[384 + e]);
            const float delta = beta * (vs[e] - kS) * kn;
            float op = 0.f;
#pragma unroll
            for (int i = 0; i < 32; ++i) { s[i] += ks[d0 + i] * delta; op += qs[d0 + i] * s[i]; }
            red2[dg * 128 + e] = op * qn;
            LDS_BARRIER();
            if (dg == 0) obuf[t * 128 + e] = ((red2[e] + red2[128 + e]) + (red2[256 + e] + red2[384 + e])) * DK_SCALE;
        }
        float* So = c.out + O_GDNS + ((size_t)(b * 4 + h) * 128 + d0) * 128 + e;
#pragma unroll
        for (int i = 0; i < 32; ++i) So[(size_t)i * 128] = s[i];
        LDS_BARRIER();
        {
            const size_t m = m0 + wave; const float v0 = obuf[wave * 128 + lane], v1 = obuf[wave * 128 + 64 + lane];
            const float r = rsqrtf(wave_sum(v0 * v0 + v1 * v1) * (1.f / 128.f) + EPS);
            OCAT[m * D + h * 128 + lane] = (bf16)f2bf(v0 * r * gn[lane] * siluf_(bf2f(zr0)));
            OCAT[m * D + h * 128 + 64 + lane] = (bf16)f2bf(v1 * r * gn[64 + lane] * siluf_(bf2f(zr1))); }
        LDS_BARRIER();
    }
}
DEV void phase_hgrn_sample(const Ctx& c, int wg_first, int wg_stride) {
    float* red = (float*)c.lds; float* qs = red + 512; float* fs = qs + 128; float* obuf = fs + 128;
    const bf16* PC = c.w<bf16>(WS_P1); bf16* OC = c.w<bf16>(WS_OCAT);
    const float* lbl = c.in<float>(25); const float* gn = c.in<float>(26);
    const int tid = c.tid, lane = c.lane, wave = c.wave;
    const int e = tid & 127, dg = tid >> 7, d0 = dg * 32;
    for (int u = wg_first; u < DECB * 8; u += wg_stride) {
        const int b = u >> 3, h = u & 7; const size_t m0 = (size_t)MP + (size_t)b * DECS;
        float s[32];
        { const float* S0 = c.in<float>(6) + ((size_t)(b * 8 + h) * 128 + d0) * 128 + e;
#pragma unroll
          for (int i = 0; i < 32; ++i) s[i] = S0[(size_t)i * 128]; }
        bf16 rq[8], rf[8], rv[8]; float lb = 0.f;
#pragma unroll
        for (int t = 0; t < 8; ++t) { rq[t] = 0; rf[t] = 0; rv[t] = PC[(m0 + t) * INC + 2048 + h * 128 + e]; }
        if (tid < 128) { lb = sigmoidf_(lbl[1024 + h * 128 + tid] - lbl[h * 128 + tid]);
#pragma unroll
            for (int t = 0; t < 8; ++t) { rq[t] = PC[(m0 + t) * INC + h * 128 + tid]; rf[t] = PC[(m0 + t) * INC + 1024 + h * 128 + tid]; } }
        const bf16 zr0 = PC[(m0 + wave) * INC + 3072 + h * 128 + lane], zr1 = PC[(m0 + wave) * INC + 3072 + h * 128 + 64 + lane];
#pragma unroll
        for (int t = 0; t < 8; ++t) {
            if (tid < 128) { qs[tid] = siluf_(bf2f(rq[t])); fs[tid] = lb + (1.f - lb) * sigmoidf_(bf2f(rf[t])); }
            const float v = bf2f(rv[t]);
            LDS_BARRIER();
            float op = 0.f;
#pragma unroll
            for (int i = 0; i < 32; ++i) { const float f = fs[d0 + i]; s[i] = f * s[i] + (1.f - f) * v; op += qs[d0 + i] * s[i]; }
            red[dg * 128 + e] = op;
            LDS_BARRIER();
            if (dg == 0) obuf[t * 128 + e] = ((red[e] + red[128 + e]) + (red[256 + e] + red[384 + e])) * DK_SCALE;
        }
        float* So = c.out + O_HGS + ((size_t)(b * 8 + h) * 128 + d0) * 128 + e;
#pragma unroll
        for (int i = 0; i < 32; ++i) So[(size_t)i * 128] = s[i];
        LDS_BARRIER();
        { const size_t m = m0 + wave; const float v0 = obuf[wave * 128 + lane], v1 = obuf[wave * 128 + 64 + lane];
          const float r = rsqrtf(wave_sum(v0 * v0 + v1 * v1) * (1.f / 128.f) + EPS);
          OC[m * D + h * 128 + lane] = (bf16)f2bf(v0 * r * gn[lane] * siluf_(bf2f(zr0)));
          OC[m * D + h * 128 + 64 + lane] = (bf16)f2bf(v1 * r * gn[64 + lane] * siluf_(bf2f(zr1))); }
        LDS_BARRIER();
    }
}

#ifndef HIPEMU
#define XB_TMO      128
#define XB_XCNT(j)  (256  + 64 * (j))
#define XB_XSUB(j)  (1280 + 64 * (j))
#define XB_XGEN(j)  (2304 + 64 * (j))
#define XB_TOP      3328
#define XB_TOPGEN   3392
#define XCD_BAR_WORDS 3456
#define XB_SPIN_CAP (1u << 22)
#define LAS __attribute__((address_space(3)))
__device__ __forceinline__ unsigned xb_ld(unsigned* p)              { return __hip_atomic_load(p, __ATOMIC_RELAXED, __HIP_MEMORY_SCOPE_AGENT); }
__device__ __forceinline__ unsigned xb_add(unsigned* p, unsigned v) { return __hip_atomic_fetch_add(p, v, __ATOMIC_RELAXED, __HIP_MEMORY_SCOPE_AGENT); }
__device__ __forceinline__ unsigned xb_xcc_id() { return (unsigned)__builtin_amdgcn_s_getreg((3 << 11) | 20) & 0xFu; }
#define XB_SPIN(cond, bar) do { unsigned _sp = 0; while (cond) { __builtin_amdgcn_s_sleep(1); \
    if ((++_sp & 255u) == 0u) { if (xb_ld(&(bar)[XB_TMO])) break; if (_sp > XB_SPIN_CAP) { atomicAdd(&(bar)[XB_TMO], 1u); break; } } } } while (0)
struct XcdBarrier { unsigned* bar; unsigned x; volatile LAS unsigned* st; bool t0; };
__device__ __forceinline__ XcdBarrier xcd_barrier_post(unsigned* bar, volatile LAS unsigned* st, bool t0) {
    XcdBarrier b; b.bar = bar; b.x = xb_xcc_id(); b.st = st; b.t0 = t0;
    if (t0) (void)xb_add(&bar[XB_XCNT(b.x)], 1u);
    return b;
}
__device__ __forceinline__ void xcd_barrier_complete(unsigned* bar, unsigned x, unsigned& nloc, unsigned& nx) {
    const unsigned G = gridDim.x * gridDim.y * gridDim.z;
    unsigned sum, cnt, mine, sp = 0u;
    for (;;) {
        sum = 0u; cnt = 0u; mine = 0u;
#pragma unroll
        for (unsigned j = 0; j < 16; ++j) { const unsigned c = xb_ld(&bar[XB_XCNT(j)]); sum += c; cnt += (c > 0u) ? 1u : 0u; mine = (j == x) ? c : mine; }
        if (sum == G) break;
        __builtin_amdgcn_s_sleep(1);
        if ((++sp & 255u) == 0u) { if (xb_ld(&bar[XB_TMO])) break; if (sp > XB_SPIN_CAP) { atomicAdd(&bar[XB_TMO], 1u); break; } }
    }
    nloc = mine > 0u ? mine : 1u; nx = cnt > 0u ? cnt : 1u;
}
__device__ __forceinline__ void xcd_barrier(const XcdBarrier& b) {
    asm volatile("s_waitcnt vmcnt(0)" ::: "memory");
    __syncthreads();
    if (b.t0) {
        unsigned* bar = b.bar;
        __builtin_amdgcn_s_waitcnt(0);
        unsigned nloc = b.st[0], nx = b.st[1];
        if (nloc == 0u) { xcd_barrier_complete(bar, b.x, nloc, nx); b.st[0] = nloc; b.st[1] = nx; }
        const unsigned old = xb_add(&bar[XB_XSUB(b.x)], 1u);
        const unsigned gen = old / nloc;
        if (old + 1u == (gen + 1u) * nloc) {
            __builtin_amdgcn_fence(__ATOMIC_RELEASE, "agent");
            asm volatile("s_waitcnt vmcnt(0)" ::: "memory");
            const unsigned og = xb_add(&bar[XB_TOP], 1u);
            const unsigned tg = og / nx;
            if (og + 1u == (tg + 1u) * nx) xb_add(&bar[XB_TOPGEN], 1u);
            else XB_SPIN(xb_ld(&bar[XB_TOPGEN]) == tg, bar);
            __builtin_amdgcn_fence(__ATOMIC_ACQUIRE, "agent");
            xb_add(&bar[XB_XGEN(b.x)], 1u);
            asm volatile("s_waitcnt vmcnt(0)" ::: "memory");
        } else {
            XB_SPIN(xb_ld(&bar[XB_XGEN(b.x)]) == gen, bar);
            __builtin_amdgcn_fence(__ATOMIC_ACQUIRE, "agent");
            asm volatile("s_waitcnt vmcnt(0)" ::: "memory");
        }
    }
    __syncthreads();
}
#endif

__global__ void __launch_bounds__(512, 2) mega_kernel(Params p) {
#ifdef HIPEMU
    unsigned char* lds = g_blk->smem;
#else
    extern __shared__ __attribute__((aligned(16))) unsigned char lds[];
#endif
    const int lo = p.ph_lo, hi = p.ph_hi;
#ifdef HIPEMU
    const int wave_s = threadIdx.x >> 6;
#define FRESH_LANE() ((int)(threadIdx.x & 63))
#define GRID_BAR(k) do { } while (0)
#else
    const int wave_s = __builtin_amdgcn_readfirstlane(threadIdx.x >> 6);
#define FRESH_LANE() ({ int l_; asm volatile("v_mbcnt_lo_u32_b32 %0, -1, 0\n\tv_mbcnt_hi_u32_b32 %0, -1, %0" : "=v"(l_)); l_; })
    { const int l0 = FRESH_LANE(); if (wave_s == 0) ((volatile LAS unsigned*)(lds + LDS_MISC))[l0] = 0u; }
    __syncthreads();
    if (hi - lo > 1) (void)xcd_barrier_post((unsigned*)(p.ws + WS_CTL), (volatile LAS unsigned*)(lds + LDS_MISC), wave_s == 0 && FRESH_LANE() == 0);
#define GRID_BAR(k) do { if (lo <= (k) && (k) + 1 < hi) { XcdBarrier bb_; bb_.bar = (unsigned*)(p.ws + WS_CTL); bb_.x = xb_xcc_id(); bb_.st = (volatile LAS unsigned*)(lds + LDS_MISC); bb_.t0 = (wave_s == 0 && FRESH_LANE() == 0); xcd_barrier(bb_); } } while (0)
#endif
#define MKCTX() Ctx c; c.p = &p; c.lds = lds; c.ws = p.ws; c.out = p.out; c.wave = wave_s; c.lane = FRESH_LANE(); c.tid = wave_s * 64 + c.lane; c.gw = blockIdx.x * 8 + wave_s; c.ngw = gridDim.x * 8;
#define IN(k) (lo <= (k) && (k) < hi)
#ifndef PROBE_MASK
#define PROBE_MASK 0u
#endif
#define NREP(k) (((PROBE_MASK >> (k)) & 1u) ? 2 : 1)
#ifndef PROBE_SUB
#define PROBE_SUB 0
#endif
#define SUB(id, ...) { MKCTX() __VA_ARGS__ } if (PROBE_SUB == (id)) { __syncthreads(); MKCTX() __VA_ARGS__ }
#define PHASE(k, ...) if (IN(k)) { { const int rep_ = 0; (void)rep_; MKCTX() __VA_ARGS__ } if (NREP(k) == 2) { const int rep_ = 1; (void)rep_; MKCTX() __VA_ARGS__ } }
#define X1 c.w<float>(WS_X1)
#define X2 c.w<float>(WS_X2)
#define P1 c.w<float>(WS_P1)
#define XN c.w<bf16>(WS_XN)
#define Hb c.w<bf16>(WS_H)
#define OCAT c.w<bf16>(WS_OCAT)

    PHASE(0,  phase_prologue(c); GRID_BAR(0); )
    PHASE(1,  run_gemm(c, XN, c.w<bf16>(WS_WINAB), M, LD1, D, EpiBf16<0>{c.w<bf16>(WS_P1), LD1}); GRID_BAR(1); )
    PHASE(2,  phase_prep0(c); GRID_BAR(2); )
    PHASE(3,          { run_gemm(c, c.w<bf16>(WS_CQN), c.w<bf16>(WS_WUQ), M, 768, 256, EpiStoreF32{c.w<float>(WS_QH), 768}); } { MKCTX() run_gemm(c, c.w<bf16>(WS_LATN), c.w<bf16>(WS_WUKV), MP, 1024, 256, EpiBf16<0>{c.w<bf16>(WS_KVP), 1024}); }         GRID_BAR(3); )
    PHASE(4,  { if ((blockIdx.x & 1) == 0) { MKCTX() phase_attn_sample2(c); } } __syncthreads(); { MKCTX() phase_gdn_prep(c); } __syncthreads();
               { if ((blockIdx.x & 1) != 0) { MKCTX() phase_attn_sample2(c); } } GRID_BAR(4); )
    PHASE(5,  SUB(4, phase_gdn_scan(c, blockIdx.x, gridDim.x);) __syncthreads(); SUB(5, phase_attn_sample_combine(c);) __syncthreads(); { MKCTX() phase_attn_prompt2(c, rep_ ? 6 : 0); } if (PROBE_SUB == 6) { __syncthreads(); MKCTX() phase_attn_prompt2(c, 5); } __syncthreads();
               SUB(9, const int NS_ = BATCH * 4; const int G_ = (int)gridDim.x; if (G_ > NS_ + 32) { if ((int)blockIdx.x >= NS_) { phase_gdn_sample(c, (int)blockIdx.x - NS_, G_ - NS_); } } else { phase_gdn_sample(c, (int)blockIdx.x, G_); }) __syncthreads();
               SUB(10, const int NS_ = BATCH * 4; const int G_ = (int)gridDim.x; if (G_ > NS_ + 32) { if ((int)blockIdx.x >= NS_) { phase_convert_late(c, c.gw - NS_ * 8, c.ngw - NS_ * 8); } } else { phase_convert_late(c, c.gw, c.ngw); }) GRID_BAR(5); )
    PHASE(6,  { run_gemm(c, OCAT, c.w<bf16>(WS_WOAB), MP, D, D, EpiResidF32{nullptr, c.in<float>(0), c.in<float>(1), X1}); } { MKCTX() run_gemm_sample_splitk(c, OCAT, c.w<bf16>(WS_WOAB), D, 256); } GRID_BAR(6); )
    PHASE(7,  phase_rmsnorm(c, X1, c.in<float>(9), nullptr, 4); GRID_BAR(7); )
    PHASE(8,  { run_gemm(c, XN, c.w<bf16>(WS_WUP0), M, FF, D, EpiBf16<1>{Hb, FF}); } __syncthreads();
               { MKCTX() const int NB_ = (M / 256 * (FF / 256)) % (int)gridDim.x, G_ = (int)gridDim.x;
                 if (NB_ > 0 && G_ - NB_ >= 32) { if ((int)blockIdx.x >= NB_) phase_convert_late2(c, c.gw - NB_ * 8, c.ngw - NB_ * 8); } else phase_convert_late2(c, c.gw, c.ngw); } GRID_BAR(8); )
    PHASE(9,  { run_gemm(c, Hb, c.w<bf16>(WS_WDN0), MP, D, FF, EpiResidF32{X1, nullptr, nullptr, X2}); } { MKCTX() run_gemm_sample_splitk(c, Hb, c.w<bf16>(WS_WDN0), FF, 256); } GRID_BAR(9); )
    PHASE(10,  phase_rmsnorm(c, X2, c.in<float>(8) + D, X1, 16); GRID_BAR(10); )
    PHASE(11,  run_gemm(c, XN, c.w<bf16>(WS_WINC), M, INC, D, EpiBf16<0>{c.w<bf16>(WS_P1), INC}); GRID_BAR(11); )
    PHASE(12,  SUB(7, phase_hgrn_prep(c);) GRID_BAR(12); )
    PHASE(13,  phase_hgrn_prefix(c); __syncthreads(); SUB(8, phase_hgrn_sample(c, (int)blockIdx.x, (int)gridDim.x);) GRID_BAR(13); )
    PHASE(14,  phase_hgrn_out(c); GRID_BAR(14); )
    PHASE(15,  { run_gemm(c, OCAT, c.w<bf16>(WS_WOC), MP, D, D, EpiResidF32{X2, nullptr, nullptr, X1}); } { MKCTX() run_gemm_sample_splitk(c, OCAT, c.w<bf16>(WS_WOC), D, 256); } GRID_BAR(15); )
    PHASE(16,  phase_rmsnorm(c, X1, c.in<float>(9) + D, X2, 4); GRID_BAR(16); )
    PHASE(17,  run_gemm(c, XN, c.w<bf16>(WS_WUP1), M, FF, D, EpiBf16<1>{Hb, FF}); GRID_BAR(17); )
    PHASE(18,  { run_gemm(c, Hb, c.w<bf16>(WS_WDN1), MP, D, FF, EpiResidF32{X1, nullptr, nullptr, X2}); } { MKCTX() run_gemm_sample_splitk(c, Hb, c.w<bf16>(WS_WDN1), FF, 256); } GRID_BAR(18); )
    PHASE(19,  phase_final(c, X2, c.in<float>(10), X1, 16); )
#undef IN
#undef X1
#undef X2
#undef P1
#undef XN
#undef Hb
#undef OCAT
}

#ifndef HIPEMU
extern "C" void kernel_launch(void* const* d_in, const int* in_sizes, int n_in, void* d_out, int out_size, void* d_ws, size_t ws_size, hipStream_t stream) {
    static int grid = 0;
    if (grid == 0) {
        if (n_in != 28 || (size_t)out_size != O_END || ws_size < WS_END) { fprintf(stderr, "kernel_launch: shape mismatch n_in %d out %d (want %zu) ws %zu (want %zu)\n", n_in, out_size, (size_t)O_END, ws_size, (size_t)WS_END); grid = -1; return; }
        int dev = 0, cus = 0, per_cu = 0;
        hipGetDevice(&dev); hipDeviceGetAttribute(&cus, hipDeviceAttributeMultiprocessorCount, dev);
        if (hipFuncSetAttribute((const void*)mega_kernel, hipFuncAttributeMaxDynamicSharedMemorySize, LDS_BYTES) != hipSuccess) { fprintf(stderr, "kernel_launch: hipFuncSetAttribute failed\n"); grid = -1; return; }
        if (hipOccupancyMaxActiveBlocksPerMultiprocessor(&per_cu, (const void*)mega_kernel, 512, LDS_BYTES) != hipSuccess || per_cu < 1) fprintf(stderr, "kernel_launch: occupancy query reports %d\n", per_cu);
        (void)hipGetLastError();
        grid = cus;
    }
    if (grid < 0) return;
    hipMemsetAsync((char*)d_ws + WS_CTL, 0, CTL_BYTES, stream);
    Params p{};
    for (int i = 0; i < 28; ++i) p.in[i] = d_in[i];
    p.out = (float*)d_out; p.ws = (unsigned char*)d_ws;
#if MK_N_LAUNCHES == 1
    p.ph_lo = 0; p.ph_hi = NPHASE;
    hipLaunchKernelGGL(mega_kernel, dim3(grid), dim3(512), LDS_BYTES, stream, p);
#else
    for (int k = 0; k < NPHASE; ++k) { p.ph_lo = k; p.ph_hi = k + 1; hipLaunchKernelGGL(mega_kernel, dim3(grid), dim3(512), LDS_BYTES, stream, p); }
#endif
}
#else
size_t emu_ws_bytes() { return WS_END; }
size_t emu_out_floats() { return O_END; }
void emu_forward(void* const* d_in, float* d_out, unsigned char* d_ws, int grid, int ph_from, int ph_to) {
    memset(d_ws + WS_CTL, 0, CTL_BYTES);
    Params p{};
    for (int i = 0; i < 28; ++i) p.in[i] = d_in[i];
    p.out = d_out; p.ws = d_ws;
    for (int k = ph_from; k < ph_to && k < NPHASE; ++k) { p.ph_lo = k; p.ph_hi = k + 1; fprintf(stderr, "[emu] phase %d\n", k); emu_launch(grid, 512, LDS_BYTES, [=]() { mega_kernel(p); }); }
}
struct EmuBuf { const char* name; size_t off; size_t bytes; int kind;   int ld; };
extern const EmuBuf emu_bufs[] = {
    {"P1", WS_P1, (size_t)M * 4096 * 4, 0, LD1}, {"XN", WS_XN, (size_t)M * D * 2, 1, D}, {"QH", WS_QH, (size_t)M * 768 * 4, 0, 768}, {"KVP", WS_KVP, (size_t)MP * 1024 * 2, 1, 1024},
    {"OCAT", WS_OCAT, (size_t)M * D * 2, 1, D}, {"ORAW", WS_ORAW, (size_t)M * D * 4, 0, D}, {"X1", WS_X1, (size_t)M * D * 4, 0, D}, {"X2", WS_X2, (size_t)M * D * 4, 0, D},
    {"H", WS_H, (size_t)M * FF * 2, 1, FF}, {"CQN", WS_CQN, (size_t)M * 256 * 2, 1, 256}, {"LATN", WS_LATN, (size_t)M * 256 * 2, 1, 256}, {nullptr, 0, 0, 0, 0}};
extern const int emu_cfg[8] = {BATCH, SEQ, DECB, PAST, MP, MS, MT, M};
#endif
```

```cpp
#ifdef HIPEMU
#include "hipemu.h"
#else
#include <hip/hip_runtime.h>
#endif
#include <cstdio>
#include <cstdint>

#ifndef CFG_BATCH
#define CFG_BATCH 8
#define CFG_SEQ 2048
#define CFG_DEC_BATCH 128
#define CFG_PAST_LEN 8192
#endif
#ifndef MK_N_LAUNCHES
#define MK_N_LAUNCHES 1
#endif

#define DEV __device__ __forceinline__
namespace pg8 {
#define PG8_LAS __attribute__((address_space(3)))
typedef unsigned short bf16_t;
typedef short bf16x8 __attribute__((ext_vector_type(8)));
typedef float f32x4 __attribute__((ext_vector_type(4)));
typedef unsigned u32x4 __attribute__((ext_vector_type(4)));
constexpr int BM = 256, BK = 64, HALF = 128, HTB = HALF * BK * 2  , STAGE_BYTES = 8 * HTB, NXCD = 8, WGM = 8;

__host__ __device__ __forceinline__ int lds_byte(int r, int c) { const int st = (r >> 4) * 2 + (c >> 5), rr = r & 15, cc = c & 31, ob = rr * 64 + cc * 2; return st * 1024 + (ob ^ (((ob >> 9) & 1) << 5)); }
__host__ __device__ __forceinline__ void stage_rc(int b, int& R, int& C) { const int st = b / 1024, sb = b % 1024, swz = sb ^ (((sb >> 9) & 1) << 5); R = (st >> 1) * 16 + swz / 64; C = (st & 1) * 32 + (swz % 64) / 2; }
__host__ __device__ __forceinline__ int perm32(int rho) { const int n = rho >> 4, i = rho & 15; return 8 * (i >> 2) + 4 * n + (i & 3); }

struct Unit { int pm, pn, kb; };
struct Gemm { const bf16_t* A; const bf16_t* Bt; int M, N, K, ld; };

struct StaticOrder {
    int nM, nN, nwg, G, c;
    __host__ __device__ void init(int M, int N, int G_, int c_) { nM = M / BM; nN = N / BM; nwg = nM * nN; G = G_; c = c_; }
    __host__ __device__ bool next(int i, Unit& u) const {
        const long L = (long)i * G + c; if (L >= nwg) return false;
        int wgid = (int)L; { const int q = nwg / NXCD, r = nwg % NXCD, xcd = wgid % NXCD, off = wgid / NXCD; wgid = (xcd < r ? xcd * (q + 1) : r * (q + 1) + (xcd - r) * q) + off; }
        const int nig = WGM * nN, gid = wgid / nig, fm = gid * WGM, gsz = (nM - fm) < WGM ? (nM - fm) : WGM;
        u.pm = fm + ((wgid % nig) % gsz); u.pn = (wgid % nig) / gsz; u.kb = 0; return true;
    }
    __device__ __forceinline__ void a_ready(const Unit&) const {}
    __device__ __forceinline__ void done(const Unit&) const {}
};

#ifndef HIPEMU
template <class Epi, class Sched, bool ALIGN_EPI = false, bool SP2 = false>
__device__ __forceinline__ void gemm_phase(PG8_LAS unsigned char* lds, const Gemm g, const Sched& S, const Epi& E, const int wid_in, const int lane_in) {
    const int wid = __builtin_amdgcn_readfirstlane(wid_in), lane = lane_in, tid = wid * 64 + lane, wr = wid >> 2, wc = wid & 3, fr = lane & 15, fq = lane >> 4;
    const int K = g.K, nt = K / BK, LDK = g.ld;
    unsigned voffA[2], voffB[2];
#pragma unroll
    for (int i = 0; i < 2; ++i) { int R, C; stage_rc(tid * 16 + i * 8192, R, C); const int Rb = Epi::PERM ? ((R & ~31) + perm32(R & 31)) : R;
        voffA[i] = (unsigned)(R * LDK + C) * 2u; voffB[i] = (unsigned)(Rb * LDK + C) * 2u; }
    const size_t kstep = (size_t)(BK * 2);
    const size_t hstep = (size_t)HALF * LDK * 2;
    const size_t tstep = 2 * hstep;
    const unsigned ldsw = (unsigned)wid * 1024u;
    const int aoff = lds_byte(wr * 64 + fr, fq * 8), boff = lds_byte(wc * 32 + fr, fq * 8);
#define PG8_SA(b, h) (((b) * 2 + (h)) * HTB)
#define PG8_SB(b, h) ((4 + (b) * 2 + (h)) * HTB)
#define PG8_STAGE(bufoff, gbase, voff) do { _Pragma("unroll") for (int _i = 0; _i < 2; ++_i) \
        __builtin_amdgcn_global_load_lds((const unsigned*)((const char*)(gbase) + (voff)[_i]), (PG8_LAS unsigned*)(lds + (bufoff) + ldsw + _i * 8192), 16, 0, 0); } while (0)
#define PG8_LDA(dst, b, h) do { _Pragma("unroll") for (int m = 0; m < 4; ++m) _Pragma("unroll") for (int k = 0; k < 2; ++k) dst[m][k] = *(const PG8_LAS bf16x8*)(lds + PG8_SA(b, h) + aoff + m * 2048 + k * 1024); } while (0)
#define PG8_LDB(dst, b, h) do { _Pragma("unroll") for (int n = 0; n < 2; ++n) _Pragma("unroll") for (int k = 0; k < 2; ++k) dst[n][k] = *(const PG8_LAS bf16x8*)(lds + PG8_SB(b, h) + boff + n * 2048 + k * 1024); } while (0)
#define PG8_MMA(ai, bj, At, Bt) do { __builtin_amdgcn_s_setprio(1); _Pragma("unroll") for (int m = 0; m < 4; ++m) _Pragma("unroll") for (int n = 0; n < 2; ++n) _Pragma("unroll") for (int k = 0; k < 2; ++k) \
        acc[ai][bj][m][n] = __builtin_amdgcn_mfma_f32_16x16x32_bf16(Bt[n][k], At[m][k], acc[ai][bj][m][n], 0, 0, 0); __builtin_amdgcn_s_setprio(0); } while (0)
#define PG8_WAIT_V(n) asm volatile("s_waitcnt vmcnt(" #n ")" ::: "memory")
#define PG8_WAIT_L(n) asm volatile("s_waitcnt lgkmcnt(" #n ")" ::: "memory")
#define PG8_BAR __builtin_amdgcn_s_barrier()
#define PG8_SCHED __builtin_amdgcn_sched_barrier(0)
    Unit cur, nxt; int ui = 0;
    if (!S.next(0, cur)) return;
    f32x4 acc[2][2][4][2];
#pragma unroll
    for (int a = 0; a < 2; ++a)
#pragma unroll
        for (int b = 0; b < 2; ++b)
#pragma unroll
            for (int m = 0; m < 4; ++m)
#pragma unroll
                for (int n = 0; n < 2; ++n) acc[a][b][m][n] = (f32x4){0.f, 0.f, 0.f, 0.f};
    bf16x8 At[4][2], B0[2][2], B1[2][2];
    const char* cA = (const char*)g.A + (size_t)cur.pm * tstep + (size_t)cur.kb * K * 2; const char* cB = (const char*)g.Bt + (size_t)cur.pn * tstep + (size_t)cur.kb * K * 2;
    S.a_ready(cur);
    if constexpr (SP2) {
        PG8_STAGE(PG8_SB(0, 0), cB, voffB); PG8_STAGE(PG8_SB(0, 1), cB + hstep, voffB); PG8_STAGE(PG8_SA(0, 0), cA, voffA); PG8_STAGE(PG8_SA(0, 1), cA + hstep, voffA);
        if (wr == 1) PG8_BAR;
        PG8_WAIT_V(2); PG8_BAR;
        PG8_STAGE(PG8_SB(1, 0), cB + kstep, voffB); PG8_STAGE(PG8_SA(1, 0), cA + kstep, voffA); PG8_STAGE(PG8_SB(1, 1), cB + hstep + kstep, voffB);
        PG8_WAIT_V(6); PG8_BAR;
    } else {
        PG8_STAGE(PG8_SB(0, 0), cB, voffB); PG8_STAGE(PG8_SA(0, 0), cA, voffA); PG8_STAGE(PG8_SB(0, 1), cB + hstep, voffB); PG8_STAGE(PG8_SA(0, 1), cA + hstep, voffA);
        if (wr == 1) PG8_BAR;
        PG8_WAIT_V(4); PG8_BAR;
        PG8_STAGE(PG8_SB(1, 0), cB + kstep, voffB); PG8_STAGE(PG8_SA(1, 0), cA + kstep, voffA); PG8_STAGE(PG8_SB(1, 1), cB + hstep + kstep, voffB);
        PG8_WAIT_V(6); PG8_BAR;
    }
    for (;;) {
        const bool has_next = S.next(ui + 1, nxt);
        const char* nA = has_next ? (const char*)g.A + (size_t)nxt.pm * tstep + (size_t)nxt.kb * K * 2 : cA; const char* nB = has_next ? (const char*)g.Bt + (size_t)nxt.pn * tstep + (size_t)nxt.kb * K * 2 : cB;
        for (int t = 0; t < nt; t += 2) {
            const bool last = (t == nt - 2);
            const char* a1 = cA + (size_t)(t + 1) * kstep;
            const char* a2 = last ? nA : cA + (size_t)(t + 2) * kstep; const char* b2 = last ? nB : cB + (size_t)(t + 2) * kstep;
            const char* a3 = a2 + kstep; const char* b3 = b2 + kstep;
            if (last && has_next) S.a_ready(nxt);
            if constexpr (SP2) {
            PG8_LDB(B0, 0, 0); PG8_LDB(B1, 0, 1); PG8_SCHED; PG8_LDA(At, 0, 0); PG8_STAGE(PG8_SA(1, 1), a1 + hstep, voffA);
            PG8_WAIT_V(8); PG8_WAIT_L(0); PG8_BAR; PG8_MMA(0, 0, At, B0); PG8_MMA(0, 1, At, B1); PG8_BAR; PG8_SCHED;
            PG8_LDA(At, 0, 1); PG8_STAGE(PG8_SB(0, 0), b2, voffB); PG8_STAGE(PG8_SB(0, 1), b2 + hstep, voffB); PG8_STAGE(PG8_SA(0, 0), a2, voffA);
            PG8_WAIT_V(8); PG8_WAIT_L(0); PG8_BAR; PG8_MMA(1, 0, At, B0); PG8_MMA(1, 1, At, B1); PG8_BAR; PG8_SCHED;
            PG8_LDB(B0, 1, 0); PG8_LDB(B1, 1, 1); PG8_SCHED; PG8_LDA(At, 1, 0); PG8_STAGE(PG8_SA(0, 1), a2 + hstep, voffA);
            PG8_WAIT_V(8); PG8_WAIT_L(0); PG8_BAR; PG8_MMA(0, 0, At, B0); PG8_MMA(0, 1, At, B1); PG8_BAR; PG8_SCHED;
            PG8_LDA(At, 1, 1); PG8_STAGE(PG8_SB(1, 0), b3, voffB); PG8_STAGE(PG8_SB(1, 1), b3 + hstep, voffB); PG8_STAGE(PG8_SA(1, 0), a3, voffA);
            PG8_WAIT_V(8); PG8_WAIT_L(0); PG8_BAR; PG8_MMA(1, 0, At, B0); PG8_MMA(1, 1, At, B1); PG8_BAR; PG8_SCHED;
            } else {
            PG8_LDB(B0, 0, 0); PG8_SCHED; PG8_LDA(At, 0, 0); PG8_STAGE(PG8_SA(1, 1), a1 + hstep, voffA);
            PG8_WAIT_L(8); PG8_BAR; PG8_WAIT_L(0); PG8_MMA(0, 0, At, B0); PG8_BAR; PG8_SCHED;
            PG8_LDB(B1, 0, 1); PG8_STAGE(PG8_SB(0, 0), b2, voffB);
            PG8_BAR; PG8_WAIT_L(0); PG8_MMA(0, 1, At, B1); PG8_BAR;
            PG8_LDA(At, 0, 1); PG8_STAGE(PG8_SA(0, 0), a2, voffA);
            PG8_BAR; PG8_WAIT_L(0); PG8_MMA(1, 0, At, B0); PG8_BAR; PG8_SCHED;
            PG8_STAGE(PG8_SB(0, 1), b2 + hstep, voffB);
            PG8_WAIT_V(6); PG8_BAR; PG8_MMA(1, 1, At, B1); PG8_BAR;
            PG8_LDB(B0, 1, 0); PG8_SCHED; PG8_LDA(At, 1, 0); PG8_STAGE(PG8_SA(0, 1), a2 + hstep, voffA);
            PG8_WAIT_L(8); PG8_BAR; PG8_WAIT_L(0); PG8_MMA(0, 0, At, B0); PG8_BAR; PG8_SCHED;
            PG8_LDB(B1, 1, 1); PG8_STAGE(PG8_SB(1, 0), b3, voffB);
            PG8_BAR; PG8_WAIT_L(0); PG8_MMA(0, 1, At, B1); PG8_BAR;
            PG8_LDA(At, 1, 1); PG8_STAGE(PG8_SA(1, 0), a3, voffA);
            PG8_BAR; PG8_WAIT_L(0); PG8_MMA(1, 0, At, B0); PG8_BAR; PG8_SCHED;
            PG8_STAGE(PG8_SB(1, 1), b3 + hstep, voffB);
            PG8_WAIT_V(6); PG8_BAR; PG8_MMA(1, 1, At, B1); PG8_BAR;
            }
        }
        if constexpr (ALIGN_EPI) { if (wr == 0) PG8_BAR; }
        if constexpr (!Epi::AFTER_DRAIN) { E(acc, cur, wr, wc, fr, fq); S.done(cur); }
        if (!has_next) break;
#pragma unroll
        for (int a = 0; a < 2; ++a)
#pragma unroll
            for (int b = 0; b < 2; ++b)
#pragma unroll
                for (int m = 0; m < 4; ++m)
#pragma unroll
                    for (int n = 0; n < 2; ++n) acc[a][b][m][n] = (f32x4){0.f, 0.f, 0.f, 0.f};
        cur = nxt; cA = nA; cB = nB; ++ui;
        if constexpr (ALIGN_EPI) { if (wr == 1) PG8_BAR; }
    }
    PG8_WAIT_V(0);
    if constexpr (!ALIGN_EPI) { if (wr == 0) PG8_BAR; }
    PG8_BAR;
    if constexpr (Epi::AFTER_DRAIN) { E.fused(acc, cur, wr, wc, fr, fq, lds, wid, lane); S.done(cur); }
#undef PG8_SA
#undef PG8_SB
#undef PG8_STAGE
#undef PG8_LDA
#undef PG8_LDB
#undef PG8_MMA
#undef PG8_WAIT_V
#undef PG8_WAIT_L
#undef PG8_BAR
#undef PG8_SCHED
}
}

#else
}
#endif

constexpr int D = 1024, BATCH = CFG_BATCH, SEQ = CFG_SEQ, DECB = CFG_DEC_BATCH, DECS = 8, PAST = CFG_PAST_LEN, PAGE = 128;
constexpr int MP = BATCH * SEQ, MS = DECB * DECS, MT = MP + MS, M = (MT + 255) / 256 * 256;
constexpr int NPAGES = PAST / PAGE;
constexpr int QKV_A = 1536, IN_AB = 2600, LD1 = 2816, FF = 4096, INC = 4096;
constexpr int C_Z = 1536, C_B = 2048, C_A = 2052, C_CQ = 2056, C_CKV = 2312, C_KPE = 2568;
constexpr float EPS = 1e-6f;
constexpr float MLA_SCALE = 0.10206207261596575f;
constexpr float DK_SCALE = 0.08838834764831845f;
static_assert(MP % 256 == 0 && SEQ % 128 == 0 && PAST % 128 == 0, "shape assumptions");

constexpr size_t O_YP = 0, O_YS = O_YP + (size_t)MP * D, O_GDNP = O_YS + (size_t)MS * D, O_CONVP = O_GDNP + (size_t)BATCH * 4 * 16384,
    O_LATP = O_CONVP + (size_t)BATCH * 3 * QKV_A, O_KPEP = O_LATP + (size_t)MP * 256, O_HGP = O_KPEP + (size_t)MP * 32,
    O_GDNS = O_HGP + (size_t)BATCH * 8 * 16384, O_CONVS = O_GDNS + (size_t)DECB * 4 * 16384, O_LATS = O_CONVS + (size_t)DECB * 3 * QKV_A,
    O_KPES = O_LATS + (size_t)MS * 256, O_HGS = O_KPES + (size_t)MS * 32, O_END = O_HGS + (size_t)DECB * 8 * 16384;

constexpr size_t al256(size_t x) { return (x + 255) & ~(size_t)255; }
constexpr size_t WS_CTL = 0, CTL_BYTES = 65536;
constexpr size_t WS_WINAB = CTL_BYTES,                      WS_WUP0 = WS_WINAB + (size_t)LD1 * D * 2,
    WS_WUP1 = WS_WUP0 + (size_t)FF * D * 2,                 WS_WDN0 = WS_WUP1 + (size_t)FF * D * 2,
    WS_WDN1 = WS_WDN0 + (size_t)FF * D * 2,                 WS_WINC = WS_WDN1 + (size_t)FF * D * 2,
    WS_WOAB = WS_WINC + (size_t)INC * D * 2,                WS_WOC = WS_WOAB + (size_t)D * D * 2,
    WS_WUQ = WS_WOC + (size_t)D * D * 2,                    WS_WUKV = WS_WUQ + (size_t)768 * 256 * 2,
    WS_ROPE = WS_WUKV + (size_t)1024 * 256 * 2,             WS_XN = al256(WS_ROPE + (size_t)(SEQ + 8) * 32 * 4),
    WS_P1 = WS_XN + (size_t)M * D * 2,                      WS_CQN = WS_P1 + (size_t)M * 4096 * 4,
    WS_LATN = WS_CQN + (size_t)M * 256 * 2,                 WS_QH = WS_LATN + (size_t)M * 256 * 2,
    WS_KVP = WS_QH + (size_t)M * 768 * 4,                   WS_OCAT = WS_KVP + (size_t)MP * 1024 * 2,
    WS_ORAW = WS_OCAT + (size_t)M * D * 2,                  WS_X1 = WS_ORAW + (size_t)M * D * 4,
    WS_X2 = WS_X1 + (size_t)M * D * 4,                      WS_H = WS_X2 + (size_t)M * D * 4,
    WS_WUKB = WS_H + (size_t)M * FF * 2,                    WS_PO = WS_WUKB + (size_t)256 * 512 * 2,
    WS_PM = WS_PO + (size_t)DECB * 2 * 64 * 256 * 4,        WS_PL = WS_PM + (size_t)DECB * 2 * 64 * 4,
    WS_KPEB = WS_PL + (size_t)DECB * 2 * 64 * 4,            WS_PART = al256(WS_KPEB + (size_t)MP * 32 * 2),
    WS_END = WS_PART + (size_t)16 * (M - MP) * D * 4;
constexpr size_t WS_H_END = WS_H + (size_t)M * FF * 2;

constexpr int LDS_BYTES = 155648;
constexpr int LDS_MISC = 155648 - 256;
constexpr int NPHASE = 20;

typedef unsigned short bf16;
typedef unsigned u32x4 __attribute__((ext_vector_type(4)));
typedef unsigned u32x2 __attribute__((ext_vector_type(2)));
#ifndef HIPEMU
typedef short bf16x8 __attribute__((ext_vector_type(8)));
typedef float f32x4 __attribute__((ext_vector_type(4)));
#endif

#ifdef HIPEMU
DEV unsigned f2bf(float f) { unsigned u = __float_as_uint(f); return (u + 0x7fffu + ((u >> 16) & 1u)) >> 16; }
#else
DEV unsigned f2bf(float f) { return (unsigned)__builtin_bit_cast(unsigned short, (__bf16)f); }
#endif
#ifdef HIPEMU
DEV unsigned pk2(float lo, float hi) { return f2bf(lo) | (f2bf(hi) << 16); }
#else
typedef float f32x2_t __attribute__((ext_vector_type(2))); typedef __bf16 bf16x2_t __attribute__((ext_vector_type(2)));
DEV unsigned pk2(float lo, float hi) { f32x2_t v = {lo, hi}; bf16x2_t b = __builtin_convertvector(v, bf16x2_t); return __builtin_bit_cast(unsigned, b); }
#endif
DEV float bf2f(bf16 b) { return __uint_as_float(((unsigned)b) << 16); }
#ifdef HIPEMU
DEV float rcpf_(float x) { return 1.0f / x; }
#else
DEV float rcpf_(float x) { return __builtin_amdgcn_rcpf(x); }
#endif
DEV float sigmoidf_(float x) { return 1.0f / (1.0f + __expf(-x)); }
DEV float siluf_(float x) { return x / (1.0f + __expf(-x)); }
DEV float softplusf_(float x) { return fmaxf(x, 0.f) + log1pf(__expf(-fabsf(x))); }
#ifdef HIPEMU
DEV f32x4 mfma16(bf16x8 a, bf16x8 b, f32x4 c) { return emu_mfma16(a, b, c); }
#define WAVE_SYNC() emu_wave_sync()
#define NT_LOAD4(p_) (*(const f32x4*)(p_))
#define OPAQUE_V(x) do { } while (0)
#define LDS_BARRIER() __syncthreads()
DEV s16x4 lds_tr(const unsigned short* p) { return emu_lds_tr((const void*)p); }
#else
typedef short s16x4 __attribute__((ext_vector_type(4)));
DEV s16x4 lds_tr(const unsigned short* p) { return __builtin_bit_cast(s16x4, __builtin_amdgcn_ds_read_tr16_b64_v4i16((__attribute__((address_space(3))) s16x4*)p)); }
DEV f32x4 mfma16(bf16x8 a, bf16x8 b, f32x4 c) { return __builtin_amdgcn_mfma_f32_16x16x32_bf16(a, b, c, 0, 0, 0); }
#define WAVE_SYNC() asm volatile("s_waitcnt lgkmcnt(0)" ::: "memory")
#define OPAQUE_V(x) asm volatile("" : "+v"(x))
#define NT_LOAD4(p_) __builtin_nontemporal_load((const f32x4*)(p_))
#define LDS_BARRIER() asm volatile("s_waitcnt lgkmcnt(0)\n\ts_barrier" ::: "memory")
#endif
DEV f32x4 ld4bf(const unsigned short* p) { const u32x2 u = *(const u32x2*)p; return (f32x4){__uint_as_float(u.x << 16), __uint_as_float(u.x & 0xffff0000u), __uint_as_float(u.y << 16), __uint_as_float(u.y & 0xffff0000u)}; }
constexpr float QK_SCALE2 = MLA_SCALE * 1.4426950408889634f;
#ifdef HIPEMU
DEV float exp2f_(float x) { return exp2f(x); }
DEV bool wave_any(bool p) { int v = p ? 1 : 0;
    for (int o = 1; o < 64; o <<= 1) v |= __shfl_xor(v, o);
    return v != 0; }
#else
DEV float exp2f_(float x) { return __builtin_amdgcn_exp2f(x); }
DEV bool wave_any(bool p) { return __builtin_amdgcn_ballot_w64(p) != 0ull; }
#endif
#ifdef HIPEMU
DEV float wave_sum(float v) {
#pragma unroll
    for (int o = 1; o < 64; o <<= 1) v += __shfl_xor(v, o);
    return v;
}
DEV float grp16_max(float v) {
#pragma unroll
    for (int o = 1; o < 16; o <<= 1) v = fmaxf(v, __shfl_xor(v, o));
    return v;
}
DEV float grp16_sum(float v) {
#pragma unroll
    for (int o = 1; o < 16; o <<= 1) v += __shfl_xor(v, o);
    return v;
}
#else
template <int CTRL> DEV float dppf(float x) { return __builtin_bit_cast(float, __builtin_amdgcn_mov_dpp(__builtin_bit_cast(int, x), CTRL, 0xf, 0xf, true)); }
DEV float grp16_max(float v) { v = fmaxf(v, dppf<0xB1>(v)); v = fmaxf(v, dppf<0x4E>(v)); v = fmaxf(v, dppf<0x141>(v)); v = fmaxf(v, dppf<0x128>(v)); return v; }
DEV float grp16_sum(float v) { v += dppf<0xB1>(v); v += dppf<0x4E>(v); v += dppf<0x141>(v); v += dppf<0x128>(v); return v; }
DEV float wave_sum(float v) {
    v = grp16_sum(v);
    auto s = __builtin_amdgcn_permlane16_swap(__float_as_uint(v), __float_as_uint(v), false, false);
    v = __uint_as_float(s[0]) + __uint_as_float(s[1]);
    auto t = __builtin_amdgcn_permlane32_swap(__float_as_uint(v), __float_as_uint(v), false, false);
    return __uint_as_float(t[0]) + __uint_as_float(t[1]);
}
#endif

struct Params { const void* in[28]; float* out; unsigned char* ws; int ph_lo, ph_hi; };
struct Ctx {
    const Params* p; unsigned char* lds; unsigned char* ws; float* out;
    int tid, lane, wave, gw, ngw;
    template <class T> DEV const T* in(int i) const { return (const T*)p->in[i]; }
    template <class T> DEV T* w(size_t off) const { return (T*)(ws + off); }
};
DEV int queue_next(const Ctx& c, int q) {
    unsigned* cnt = (unsigned*)(c.ws + WS_CTL) + 4096 + 64 * q; volatile unsigned* slot = (volatile unsigned*)(c.lds + LDS_MISC + 128);
    __syncthreads();
    if (c.tid == 0) *slot = atomicAdd(cnt, 1u);
    __syncthreads();
    return (int)*slot;
}
DEV const float* xin_row(const Ctx& c, int m) { return m < MP ? c.in<float>(0) + (size_t)m * D : c.in<float>(1) + (size_t)(m - MP) * D; }

struct EpiStoreF32 {
    static constexpr bool PERM = false, AFTER_DRAIN = false;
    float* C; int ldc;
    DEV void operator()(const pg8::f32x4 (&acc)[2][2][4][2], const pg8::Unit& u, int wr, int wc, int fr, int fq) const {
        const int row0 = u.pm * 256 + wr * 64 + fr, col0 = u.pn * 256 + wc * 32 + 4 * fq;
#pragma unroll
        for (int ai = 0; ai < 2; ++ai)
#pragma unroll
            for (int m = 0; m < 4; ++m) { float* rowp = C + (size_t)(row0 + ai * 128 + m * 16) * ldc + col0;
#pragma unroll
                for (int bj = 0; bj < 2; ++bj)
#pragma unroll
                    for (int n = 0; n < 2; ++n) *(pg8::f32x4*)(rowp + bj * 128 + n * 16) = acc[ai][bj][m][n]; }
    }
};
struct EpiResidF32 {
    static constexpr bool PERM = false, AFTER_DRAIN = false;
    const float* base; const float* xp; const float* xs; float* out;
    DEV void operator()(const pg8::f32x4 (&acc)[2][2][4][2], const pg8::Unit& u, int wr, int wc, int fr, int fq) const {
        const int row0 = u.pm * 256 + wr * 64 + fr, col0 = u.pn * 256 + wc * 32 + 4 * fq;
#pragma unroll
        for (int ai = 0; ai < 2; ++ai)
#pragma unroll
            for (int m = 0; m < 4; ++m) { const int row = row0 + ai * 128 + m * 16;
                const float* rp = base ? base + (size_t)row * D : (row < MP ? xp + (size_t)row * D : xs + (size_t)(row - MP) * D);
                const bool ok = base != nullptr || row < MT;
                float* op = out + (size_t)row * D + col0;
#pragma unroll
                for (int bj = 0; bj < 2; ++bj)
#pragma unroll
                    for (int n = 0; n < 2; ++n) { pg8::f32x4 r = ok ? *(const pg8::f32x4*)(rp + col0 + bj * 128 + n * 16) : (pg8::f32x4){0.f, 0.f, 0.f, 0.f};
                        *(pg8::f32x4*)(op + bj * 128 + n * 16) = r + acc[ai][bj][m][n]; } }
    }
};
template <int ACT  > struct EpiBf16 {
    static constexpr bool PERM = true, AFTER_DRAIN = false;
    bf16* O; int ldc;
    DEV void operator()(const pg8::f32x4 (&acc)[2][2][4][2], const pg8::Unit& u, int wr, int wc, int fr, int fq) const {
        const int row0 = u.pm * 256 + wr * 64 + fr, col0 = u.pn * 256 + wc * 32 + 8 * fq;
#pragma unroll
        for (int ai = 0; ai < 2; ++ai)
#pragma unroll
            for (int m = 0; m < 4; ++m) { bf16* rowp = O + (size_t)(row0 + ai * 128 + m * 16) * ldc + col0;
#pragma unroll
                for (int bj = 0; bj < 2; ++bj) { pg8::f32x4 v0 = acc[ai][bj][m][0], v1 = acc[ai][bj][m][1];
                    if (ACT == 1) {
#pragma unroll
                        for (int j = 0; j < 4; ++j) { const float a = fmaxf(v0[j], 0.f), b = fmaxf(v1[j], 0.f); v0[j] = a * a; v1[j] = b * b; } }
                    u32x4 w; w.x = pk2(v0[0], v0[1]); w.y = pk2(v0[2], v0[3]); w.z = pk2(v1[0], v1[1]); w.w = pk2(v1[2], v1[3]);
                    *(u32x4*)(rowp + bj * 128) = w; } }
    }
};

struct SplitKOrder {
    int nM, nN, nS, pm0, G, c;
    DEV void init(int nM_, int nN_, int nS_, int pm0_, int G_, int c_) { nM = nM_; nN = nN_; nS = nS_; pm0 = pm0_; G = G_; c = c_; }
    DEV bool next(int i, pg8::Unit& u) const { const int L = i * G + c; if (L >= nM * nN * nS) return false; u.pm = pm0 + L % nM; const int r = L / nM; u.pn = r % nN; u.kb = r / nN; return true; }
    DEV void a_ready(const pg8::Unit&) const {}
    DEV void done(const pg8::Unit&) const {}
};
struct EpiPartF32 {
    static constexpr bool PERM = false, AFTER_DRAIN = false;
    float* P;
    DEV void operator()(const pg8::f32x4 (&acc)[2][2][4][2], const pg8::Unit& u, int wr, int wc, int fr, int fq) const {
        const int row0 = u.pm * 256 - MP + wr * 64 + fr, col0 = u.pn * 256 + wc * 32 + 4 * fq;
        float* base = P + (size_t)u.kb * (M - MP) * D;
#pragma unroll
        for (int ai = 0; ai < 2; ++ai)
#pragma unroll
            for (int m = 0; m < 4; ++m) { float* op = base + (size_t)(row0 + ai * 128 + m * 16) * D + col0;
#pragma unroll
                for (int bj = 0; bj < 2; ++bj)
#pragma unroll
                    for (int n = 0; n < 2; ++n) *(pg8::f32x4*)(op + bj * 128 + n * 16) = acc[ai][bj][m][n]; }
    }
};
template <class Epi, class Sched> DEV void run_gemm_s(const Ctx& c, const bf16* A, const bf16* Bt, int Mr, int N, int K, int ld, const Sched& S, const Epi& E) {
#ifndef HIPEMU
    asm volatile("" : "+s"(K));
    pg8::Gemm g{A, Bt, Mr, N, K, ld};
    pg8::gemm_phase<Epi, Sched, true, true>((PG8_LAS unsigned char*)c.lds, g, S, E, c.wave, c.lane);
#else
    const int wid = c.wave, lane = c.lane, wr = wid >> 2, wc = wid & 3, fr = lane & 15, fq = lane >> 4;
    pg8::Unit u;
    for (int ui = 0; S.next(ui, u); ++ui) {
        pg8::f32x4 acc[2][2][4][2];
        for (int ai = 0; ai < 2; ++ai) for (int bj = 0; bj < 2; ++bj) for (int m = 0; m < 4; ++m) for (int n = 0; n < 2; ++n) for (int j = 0; j < 4; ++j) {
            const int row = 256 * u.pm + 128 * ai + 64 * wr + 16 * m + fr;
            const int col = Epi::PERM ? 256 * u.pn + 128 * bj + 32 * wc + 8 * fq + 4 * n + j : 256 * u.pn + 128 * bj + 32 * wc + 16 * n + 4 * fq + j;
            const bf16* a = A + (size_t)row * ld + (size_t)u.kb * K; const bf16* b = Bt + (size_t)col * ld + (size_t)u.kb * K; float s = 0.f;
            for (int k = 0; k < K; ++k) s += bf2f(a[k]) * bf2f(b[k]);
            acc[ai][bj][m][n][j] = s; }
        E(acc, u, wr, wc, fr, fq);
    }
#endif
}
template <class Epi> DEV void run_gemm(const Ctx& c, const bf16* A, const bf16* Bt, int Mr, int N, int K, const Epi& E) {
    pg8::StaticOrder S; S.init(Mr, N, (int)gridDim.x, (int)blockIdx.x);
    run_gemm_s(c, A, Bt, Mr, N, K, K, S, E);
}
DEV void run_gemm_sample_splitk(const Ctx& c, const bf16* A, const bf16* Bt, int K, int KS) {
    SplitKOrder S; S.init((M - MP) / 256, D / 256, K / KS, MP / 256, (int)gridDim.x, (int)((blockIdx.x + 128) % gridDim.x));
    run_gemm_s(c, A, Bt, M, D, KS, K, S, EpiPartF32{c.w<float>(WS_PART)});
}

DEV void transpose_item(const float* W, int K, int N, bf16* WT, float* scr, int item, int nblk, int lane) {
    const int kb = item / nblk, nb = item % nblk, k0 = 64 * kb, n0 = 32 * nb;
    const int nn = n0 + (lane & 31);
    float tv[32];
#pragma unroll
    for (int i = 0; i < 32; ++i) { const int kk = 2 * i + (lane >> 5); tv[i] = nn < N ? W[(size_t)(k0 + kk) * N + nn] : 0.f; }
#pragma unroll
    for (int i = 0; i < 32; ++i) { const int kk = 2 * i + (lane >> 5); scr[kk * 33 + (lane & 31)] = tv[i]; }
    WAVE_SYNC();
    const int cq = lane & 7;
#pragma unroll
    for (int j = 0; j < 4; ++j) { const int n = (lane >> 3) + 8 * j; const float* s = scr + (8 * cq) * 33 + n;
        u32x4 o; o.x = pk2(s[0 * 33], s[1 * 33]); o.y = pk2(s[2 * 33], s[3 * 33]); o.z = pk2(s[4 * 33], s[5 * 33]); o.w = pk2(s[6 * 33], s[7 * 33]);
        *(u32x4*)(WT + (size_t)(n0 + n) * K + k0 + 8 * cq) = o; }
    WAVE_SYNC();
}
DEV void rms_row_to_bf16(const float* xrow, const float* gain, bf16* orow, int lane) {
    f32x4 v[4]; float s = 0.f;
#pragma unroll
    for (int j = 0; j < 4; ++j) { v[j] = *(const f32x4*)(xrow + 4 * lane + 256 * j); s += (v[j][0] * v[j][0] + v[j][1] * v[j][1]) + (v[j][2] * v[j][2] + v[j][3] * v[j][3]); }
    const float rstd = rsqrtf(wave_sum(s) * (1.f / D) + EPS);
#pragma unroll
    for (int j = 0; j < 4; ++j) { const f32x4 g = *(const f32x4*)(gain + 4 * lane + 256 * j);
        u32x2 o; o.x = pk2(v[j][0] * rstd * g[0], v[j][1] * rstd * g[1]); o.y = pk2(v[j][2] * rstd * g[2], v[j][3] * rstd * g[3]);
        *(u32x2*)(orow + 4 * lane + 256 * j) = o; }
}
DEV void zero_row_bf16(bf16* orow, int lane) {
#pragma unroll
    for (int j = 0; j < 4; ++j) { u32x2 o; o.x = 0u; o.y = 0u; *(u32x2*)(orow + 4 * lane + 256 * j) = o; }
}
#define TJOB(Wp, K_, N_, Npad_, wt_) do { const int nblk = (Npad_) / 32, nitems = ((K_) / 64) * nblk; bf16* WT = c.w<bf16>(wt_); const float* Wsrc = (Wp); \
        for (int it = gw0; it < nitems; it += ngw0) transpose_item(Wsrc, (K_), (N_), WT, scr, it, nblk, c.lane); } while (0)
DEV void phase_convert_late(const Ctx& c, int gw0, int ngw0) {
    float* scr = (float*)(c.lds + c.wave * 8704);
    TJOB(c.in<float>(23), D, D, D, WS_WOAB);
    TJOB(c.in<float>(11), D, FF, FF, WS_WUP0);
    TJOB(c.in<float>(12), FF, D, D, WS_WDN0);
}
DEV void phase_convert_late2(const Ctx& c, int gw0, int ngw0) {
    float* scr = (float*)(c.lds + c.wave * 8704);
    TJOB(c.in<float>(24), D, INC, INC, WS_WINC);
    TJOB(c.in<float>(27), D, D, D, WS_WOC);
    TJOB(c.in<float>(11) + (size_t)D * FF, D, FF, FF, WS_WUP1);
    TJOB(c.in<float>(12) + (size_t)D * FF, FF, D, D, WS_WDN1);
}
DEV void phase_prologue(const Ctx& c) {
    float* scr = (float*)(c.lds + c.wave * 8704);
    const int gw0 = c.gw, ngw0 = c.ngw;
    TJOB(c.in<float>(13), D, IN_AB, LD1, WS_WINAB);
    TJOB(c.in<float>(19), 256, 768, 768, WS_WUQ);
    TJOB(c.in<float>(21), 256, 512, 512, WS_WUKV); TJOB(c.in<float>(22), 256, 512, 512, WS_WUKV + (size_t)512 * 256 * 2);
#undef TJOB
    {
        const float* src = c.in<float>(21); bf16* dst = c.w<bf16>(WS_WUKB);
        for (int i = blockIdx.x * 512 + c.tid; i < 256 * 512 / 4; i += gridDim.x * 512) { const f32x4 v = *(const f32x4*)(src + 4 * i); u32x2 o; o.x = pk2(v[0], v[1]); o.y = pk2(v[2], v[3]); *(u32x2*)(dst + 4 * i) = o; }
    }
    float* rope = c.w<float>(WS_ROPE);
    for (int i = blockIdx.x * 512 + c.tid; i < (SEQ + 8) * 16; i += gridDim.x * 512) {
        const int e = i >> 4, f = i & 15; const double pos = e < SEQ ? (double)e : (double)(PAST + e - SEQ);
        const double ang = pos * pow(10000.0, -(double)f / 16.0);
        rope[e * 32 + f] = (float)cos(ang); rope[e * 32 + 16 + f] = (float)sin(ang);
    }
    bf16* XN = c.w<bf16>(WS_XN);
    for (int m = c.gw; m < M; m += c.ngw) {
        if (m < MT) rms_row_to_bf16(xin_row(c, m), c.in<float>(8), XN + (size_t)m * D, c.lane); else zero_row_bf16(XN + (size_t)m * D, c.lane);
    }
}
DEV void sample_row_sum(const Ctx& c, int m, const float* X_res, int nsp, f32x4 (&v)[4]) {
    const int lane = c.lane; const float* P = c.w<float>(WS_PART) + (size_t)(m - MP) * D;
#pragma unroll
    for (int j = 0; j < 4; ++j) {
        if (X_res) v[j] = *(const f32x4*)(X_res + (size_t)m * D + 4 * lane + 256 * j);
        else v[j] = m < MT ? *(const f32x4*)(c.in<float>(1) + (size_t)(m - MP) * D + 4 * lane + 256 * j) : (f32x4){0.f, 0.f, 0.f, 0.f}; }
    for (int s = 0; s < nsp; ++s) {
#pragma unroll
        for (int j = 0; j < 4; ++j) v[j] += *(const f32x4*)(P + (size_t)s * (M - MP) * D + 4 * lane + 256 * j); }
}
DEV void phase_rmsnorm(const Ctx& c, float* X, const float* gain, const float* X_res, int nsp) {
    bf16* XN = c.w<bf16>(WS_XN); const int lane = c.lane;
    for (int m = c.gw; m < M; m += c.ngw) {
        if (m < MP) { rms_row_to_bf16(X + (size_t)m * D, gain, XN + (size_t)m * D, lane); continue; }
        f32x4 v[4]; sample_row_sum(c, m, X_res, nsp, v);
        float s = 0.f;
#pragma unroll
        for (int j = 0; j < 4; ++j) { *(f32x4*)(X + (size_t)m * D + 4 * lane + 256 * j) = v[j]; s += (v[j][0] * v[j][0] + v[j][1] * v[j][1]) + (v[j][2] * v[j][2] + v[j][3] * v[j][3]); }
        const float rstd = rsqrtf(wave_sum(s) * (1.f / D) + EPS);
#pragma unroll
        for (int j = 0; j < 4; ++j) { const f32x4 g = *(const f32x4*)(gain + 4 * lane + 256 * j);
            u32x2 o; o.x = pk2(v[j][0] * rstd * g[0], v[j][1] * rstd * g[1]); o.y = pk2(v[j][2] * rstd * g[2], v[j][3] * rstd * g[3]);
            *(u32x2*)(XN + (size_t)m * D + 4 * lane + 256 * j) = o; }
    }
}
DEV void phase_copy_rows(const Ctx& c, float* dst, const float* src, int nrows) {
    for (int r = (int)(gridDim.x * 8) - 1 - c.gw; r < nrows; r += c.ngw) {
#pragma unroll
        for (int j = 0; j < 4; ++j) *(f32x4*)(dst + (size_t)r * D + 4 * c.lane + 256 * j) = *(const f32x4*)(src + (size_t)r * D + 4 * c.lane + 256 * j); }
}
DEV void phase_final(const Ctx& c, const float* X, const float* gain, const float* X_res, int nsp) {
    for (int m = c.gw; m < MT; m += c.ngw) {
        const float* xrow = X + (size_t)m * D; float* orow = c.out + (m < MP ? O_YP + (size_t)m * D : O_YS + (size_t)(m - MP) * D);
        f32x4 v[4]; float s = 0.f;
        if (m >= MP) sample_row_sum(c, m, X_res, nsp, v);
#pragma unroll
        for (int j = 0; j < 4; ++j) { if (m < MP) v[j] = *(const f32x4*)(xrow + 4 * c.lane + 256 * j); s += (v[j][0] * v[j][0] + v[j][1] * v[j][1]) + (v[j][2] * v[j][2] + v[j][3] * v[j][3]); }
        const float rstd = rsqrtf(wave_sum(s) * (1.f / D) + EPS);
#pragma unroll
        for (int j = 0; j < 4; ++j) { const f32x4 g = *(const f32x4*)(gain + 4 * c.lane + 256 * j); *(f32x4*)(orow + 4 * c.lane + 256 * j) = v[j] * rstd * g; }
    }
}

DEV void phase_prep0(const Ctx& c) {
    const bf16* P1 = c.w<bf16>(WS_P1); const float* rope = c.w<float>(WS_ROPE);
    bf16* CQN = c.w<bf16>(WS_CQN); bf16* LATN = c.w<bf16>(WS_LATN);
    const float* qg = c.in<float>(18); const float* kvg = c.in<float>(20);
    const int lane = c.lane;
    for (int m = c.gw; m < M; m += c.ngw) {
        if (m >= MT) { u32x2 z; z.x = 0u; z.y = 0u; *(u32x2*)(CQN + (size_t)m * 256 + 4 * lane) = z; *(u32x2*)(LATN + (size_t)m * 256 + 4 * lane) = z; continue; }
        const bf16* row = P1 + (size_t)m * LD1;
        const bool samp = m >= MP; const int b = samp ? (m - MP) / DECS : m / SEQ, t = samp ? (m - MP) % DECS : m % SEQ;
        {
            const f32x4 v = ld4bf(row + C_CQ + 4 * lane); const f32x4 g = *(const f32x4*)(qg + 4 * lane);
            const float r = rsqrtf(wave_sum((v[0] * v[0] + v[1] * v[1]) + (v[2] * v[2] + v[3] * v[3])) * (1.f / 256.f) + EPS);
            u32x2 o; o.x = pk2(v[0] * r * g[0], v[1] * r * g[1]); o.y = pk2(v[2] * r * g[2], v[3] * r * g[3]); *(u32x2*)(CQN + (size_t)m * 256 + 4 * lane) = o;
        }
        {
            const f32x4 v = ld4bf(row + C_CKV + 4 * lane); const f32x4 g = *(const f32x4*)(kvg + 4 * lane);
            const float r = rsqrtf(wave_sum((v[0] * v[0] + v[1] * v[1]) + (v[2] * v[2] + v[3] * v[3])) * (1.f / 256.f) + EPS);
            const f32x4 y = v * r * g;
            float* lo = c.out + (samp ? O_LATS + (size_t)(m - MP) * 256 : O_LATP + (size_t)m * 256);
            *(f32x4*)(lo + 4 * lane) = y;
            u32x2 o; o.x = pk2(y[0], y[1]); o.y = pk2(y[2], y[3]); *(u32x2*)(LATN + (size_t)m * 256 + 4 * lane) = o;
        }
        if (lane < 16) {
            const float* rt = rope + (size_t)(samp ? SEQ + t : t) * 32; const float cs = rt[lane], sn = rt[16 + lane];
            const float x1 = bf2f(row[C_KPE + lane]), x2 = bf2f(row[C_KPE + 16 + lane]);
            float* ko = c.out + (samp ? O_KPES + (size_t)(m - MP) * 32 : O_KPEP + (size_t)m * 32);
            ko[lane] = x1 * cs - x2 * sn; ko[16 + lane] = x2 * cs + x1 * sn;
            if (!samp) { bf16* kb = c.w<bf16>(WS_KPEB) + (size_t)m * 32; kb[lane] = (bf16)f2bf(x1 * cs - x2 * sn); kb[16 + lane] = (bf16)f2bf(x2 * cs + x1 * sn); }
        }
        const int T = samp ? DECS : SEQ;
        if (t >= T - 3) {
            float* co = c.out + (samp ? O_CONVS : O_CONVP) + ((size_t)b * 3 + (t - (T - 3))) * QKV_A;
#pragma unroll
            for (int j = 0; j < 6; ++j) *(f32x4*)(co + 4 * lane + 256 * j) = ld4bf(row + 4 * lane + 256 * j);
        }
    }
}

DEV void phase_gdn_naive(const Ctx& c, int u_begin, int wg_first, int wg_stride) {
    float* red = (float*)c.lds; float* red2 = red + 512; float* qs = red2 + 512; float* ks = qs + 128; float* vs = ks + 128; float* part = vs + 128; float* sc = part + 8;
    const bf16* P1 = c.w<bf16>(WS_P1); float* ORAW = c.w<float>(WS_ORAW); bf16* OCAT = c.w<bf16>(WS_OCAT);
    const float* convw = c.in<float>(14); const float* gn = c.in<float>(17);
    const int tid = c.tid, lane = c.lane, wave = c.wave;
    const int NU = (BATCH + DECB) * 4;
    for (int u = u_begin + wg_first; u < NU; u += wg_stride) {
        const bool samp = u >= BATCH * 4; const int b = samp ? (u - BATCH * 4) >> 2 : u >> 2, h = u & 3;
        const int T = samp ? DECS : SEQ; const size_t m0 = samp ? (size_t)MP + (size_t)b * DECS : (size_t)b * SEQ;
        const int e = tid & 127, dg = tid >> 7, d0 = dg * 32;
        float s[32];
        if (samp) { const float* S0 = c.in<float>(2) + ((size_t)(b * 4 + h) * 128 + d0) * 128 + e;
#pragma unroll
            for (int i = 0; i < 32; ++i) s[i] = S0[(size_t)i * 128]; }
        else {
#pragma unroll
            for (int i = 0; i < 32; ++i) s[i] = 0.f; }
        const int col = tid < 128 ? h * 128 + tid : (tid < 256 ? 512 + h * 128 + (tid - 128) : 1024 + h * 128 + (tid - 256));
        float w0 = 0.f, w1 = 0.f, w2 = 0.f, w3 = 0.f, x0 = 0.f, x1 = 0.f, x2 = 0.f, xn = 0.f;
        if (tid < 384) { w0 = convw[col]; w1 = convw[QKV_A + col]; w2 = convw[2 * QKV_A + col]; w3 = convw[3 * QKV_A + col];
            if (samp) { const float* cb = c.in<float>(3) + (size_t)b * 3 * QKV_A + col; x0 = cb[0]; x1 = cb[QKV_A]; x2 = cb[2 * QKV_A]; }
            xn = bf2f(P1[m0 * LD1 + col]); }
        const float Aexp = __expf(c.in<float>(15)[h]), dtb = c.in<float>(16)[h];
        for (int t = 0; t < T; ++t) {
            const size_t m = m0 + t;
            const float x3 = xn; if (t + 1 < T && tid < 384) xn = bf2f(P1[(m + 1) * LD1 + col]);
            float val = 0.f;
            if (tid < 384) { const float y = w0 * x0 + w1 * x1 + w2 * x2 + w3 * x3; val = siluf_(y); x0 = x1; x1 = x2; x2 = x3; }
            const float sq = wave_sum(tid < 256 ? val * val : 0.f);
            if (tid < 128) qs[tid] = val; else if (tid < 256) ks[tid - 128] = val; else if (tid < 384) vs[tid - 256] = val;
            if (lane == 0 && wave < 4) part[wave] = sq;
            if (tid == 384) { sc[0] = sigmoidf_(bf2f(P1[m * LD1 + C_B + h])); sc[1] = -Aexp * softplusf_(bf2f(P1[m * LD1 + C_A + h]) + dtb); }
            LDS_BARRIER();
            const float qn = rsqrtf(part[0] + part[1] + EPS), kn = rsqrtf(part[2] + part[3] + EPS), beta = sc[0], dec = __expf(sc[1]);
            float kp = 0.f;
#pragma unroll
            for (int i = 0; i < 32; ++i) { s[i] *= dec; kp += ks[d0 + i] * s[i]; }
            red[dg * 128 + e] = kp * kn;
            LDS_BARRIER();
            const float kS = (red[e] + red[128 + e]) + (red[256 + e] + red[384 + e]);
            const float delta = beta * (vs[e] - kS) * kn;
            float op = 0.f;
#pragma unroll
            for (int i = 0; i < 32; ++i) { s[i] += ks[d0 + i] * delta; op += qs[d0 + i] * s[i]; }
            red2[dg * 128 + e] = op * qn;
            LDS_BARRIER();
            if (dg == 0) ORAW[m * 512 + h * 128 + e] = ((red2[e] + red2[128 + e]) + (red2[256 + e] + red2[384 + e])) * DK_SCALE;
        }
        float* So = c.out + (samp ? O_GDNS : O_GDNP) + ((size_t)(b * 4 + h) * 128 + d0) * 128 + e;
#pragma unroll
        for (int i = 0; i < 32; ++i) So[(size_t)i * 128] = s[i];
        __syncthreads();
        for (int t = wave; t < T; t += 8) { const size_t m = m0 + t;
            const float v0 = ORAW[m * 512 + h * 128 + lane], v1 = ORAW[m * 512 + h * 128 + 64 + lane];
            const float r = rsqrtf(wave_sum(v0 * v0 + v1 * v1) * (1.f / 128.f) + EPS);
            const float z0 = bf2f(P1[m * LD1 + C_Z + h * 128 + lane]), z1 = bf2f(P1[m * LD1 + C_Z + h * 128 + 64 + lane]);
            OCAT[m * D + h * 128 + lane] = (bf16)f2bf(v0 * r * gn[lane] * siluf_(z0));
            OCAT[m * D + h * 128 + 64 + lane] = (bf16)f2bf(v1 * r * gn[64 + lane] * siluf_(z1)); }
        __syncthreads();
    }
}

DEV void phase_hgrn_naive(const Ctx& c, int u_begin, int wg_first, int wg_stride) {
    float* red = (float*)c.lds; float* qs = red + 512; float* fs = qs + 128;
    const bf16* PC = c.w<bf16>(WS_P1); float* ORAW = c.w<float>(WS_ORAW); bf16* OC = c.w<bf16>(WS_OCAT);
    const float* lbl = c.in<float>(25); const float* gn = c.in<float>(26);
    const int tid = c.tid, lane = c.lane, wave = c.wave;
    const int NU = (BATCH + DECB) * 8;
    for (int u = u_begin + wg_first; u < NU; u += wg_stride) {
        const bool samp = u >= BATCH * 8; const int b = samp ? (u - BATCH * 8) >> 3 : u >> 3, h = u & 7;
        const int T = samp ? DECS : SEQ; const size_t m0 = samp ? (size_t)MP + (size_t)b * DECS : (size_t)b * SEQ;
        const int e = tid & 127, dg = tid >> 7, d0 = dg * 32;
        float s[32];
        if (samp) { const float* S0 = c.in<float>(6) + ((size_t)(b * 8 + h) * 128 + d0) * 128 + e;
#pragma unroll
            for (int i = 0; i < 32; ++i) s[i] = S0[(size_t)i * 128]; }
        else {
#pragma unroll
            for (int i = 0; i < 32; ++i) s[i] = 0.f; }
        float lb = 0.f; if (tid < 128) lb = sigmoidf_(lbl[1024 + h * 128 + tid] - lbl[h * 128 + tid]);
        bf16 nq = 0, nf = 0, nv = 0;
        { const bf16* row = PC + m0 * INC; if (tid < 128) { nq = row[h * 128 + tid]; nf = row[1024 + h * 128 + tid]; } nv = row[2048 + h * 128 + e]; }
        for (int t = 0; t < T; ++t) {
            const size_t m = m0 + t;
            if (tid < 128) { qs[tid] = siluf_(bf2f(nq)); fs[tid] = lb + (1.f - lb) * sigmoidf_(bf2f(nf)); }
            const float v = bf2f(nv);
            if (t + 1 < T) { const bf16* row = PC + (m + 1) * INC; if (tid < 128) { nq = row[h * 128 + tid]; nf = row[1024 + h * 128 + tid]; } nv = row[2048 + h * 128 + e]; }
            LDS_BARRIER();
            float op = 0.f;
#pragma unroll
            for (int i = 0; i < 32; ++i) { const float f = fs[d0 + i]; s[i] = f * s[i] + (1.f - f) * v; op += qs[d0 + i] * s[i]; }
            red[dg * 128 + e] = op;
            LDS_BARRIER();
            if (dg == 0) ORAW[m * D + h * 128 + e] = ((red[e] + red[128 + e]) + (red[256 + e] + red[384 + e])) * DK_SCALE;
        }
        float* So = c.out + (samp ? O_HGS : O_HGP) + ((size_t)(b * 8 + h) * 128 + d0) * 128 + e;
#pragma unroll
        for (int i = 0; i < 32; ++i) So[(size_t)i * 128] = s[i];
        __syncthreads();
        for (int t = wave; t < T; t += 8) { const size_t m = m0 + t;
            const float v0 = ORAW[m * D + h * 128 + lane], v1 = ORAW[m * D + h * 128 + 64 + lane];
            const float r = rsqrtf(wave_sum(v0 * v0 + v1 * v1) * (1.f / 128.f) + EPS);
            const float z0 = bf2f(PC[m * INC + 3072 + h * 128 + lane]), z1 = bf2f(PC[m * INC + 3072 + h * 128 + 64 + lane]);
            OC[m * D + h * 128 + lane] = (bf16)f2bf(v0 * r * gn[lane] * siluf_(z0));
            OC[m * D + h * 128 + 64 + lane] = (bf16)f2bf(v1 * r * gn[64 + lane] * siluf_(z1)); }
        __syncthreads();
    }
}

DEV bf16x8 ld8(const bf16* p) { return *(const bf16x8*)p; }
DEV void softmax_strip(f32x4 (&s)[4], float (&mrun)[4], float (&lrun)[4], float (&alpha)[4], bf16* Ps, int lane) {
#pragma unroll
    for (int r = 0; r < 4; ++r) {
        float mx = fmaxf(fmaxf(s[0][r], s[1][r]), fmaxf(s[2][r], s[3][r])); mx = grp16_max(mx);
        const float mn = fmaxf(mrun[r], mx);
        alpha[r] = __expf(mrun[r] - mn); mrun[r] = mn;
        float sum = 0.f;
#pragma unroll
        for (int nt = 0; nt < 4; ++nt) { const float p = __expf(s[nt][r] - mn); s[nt][r] = p; sum += p; }
        sum = grp16_sum(sum); lrun[r] = lrun[r] * alpha[r] + sum;
    }
#pragma unroll
    for (int nt = 0; nt < 4; ++nt)
#pragma unroll
        for (int r = 0; r < 4; ++r) Ps[((lane >> 4) * 4 + r) * 72 + nt * 16 + (lane & 15)] = (bf16)f2bf(s[nt][r]);
}
DEV void phase_attn_prompt(const Ctx& c) {
    bf16* Qs = (bf16*)c.lds;
    bf16* Ks = Qs + 128 * 104;
    bf16* Vt = Ks + 64 * 104;
    bf16* Psb = Vt + 64 * 72;
    const float* QH = c.w<float>(WS_QH); const bf16* KVP = c.w<bf16>(WS_KVP); const float* rope = c.w<float>(WS_ROPE); bf16* OCAT = c.w<bf16>(WS_OCAT);
    const float* kpe = c.out + O_KPEP;
    const int tid = c.tid, lane = c.lane, w = c.wave;
    bf16* Ps = Psb + w * 16 * 72;
    constexpr int NQB = SEQ / 128, NU = BATCH * 8 * NQB;
    for (int u = blockIdx.x; u < NU; u += gridDim.x) {
        const int qb = NQB - 1 - u / (BATCH * 8), bh = u % (BATCH * 8), b = bh >> 3, h = bh & 7;
        const int q0 = qb * 128; const size_t mb = (size_t)b * SEQ;
        __syncthreads();
        for (int idx = tid; idx < 128 * 80; idx += 512) {
            const int r = idx / 80, j = idx % 80; const float* qrow = QH + (mb + q0 + r) * 768 + h * 96;
            if (j < 64) Qs[r * 104 + j] = (bf16)f2bf(qrow[j] * MLA_SCALE);
            else { const int f = j - 64; const float* rt = rope + (size_t)(q0 + r) * 32; const float cs = rt[f], sn = rt[16 + f], x1 = qrow[64 + f], x2 = qrow[80 + f];
                Qs[r * 104 + 64 + f] = (bf16)f2bf((x1 * cs - x2 * sn) * MLA_SCALE); Qs[r * 104 + 80 + f] = (bf16)f2bf((x2 * cs + x1 * sn) * MLA_SCALE); }
        }
        __syncthreads();
        bf16x8 qf[3];
#pragma unroll
        for (int ks = 0; ks < 3; ++ks) qf[ks] = ld8(Qs + (w * 16 + (lane & 15)) * 104 + ks * 32 + 8 * (lane >> 4));
        float mrun[4], lrun[4], alpha[4]; f32x4 o[4];
#pragma unroll
        for (int r = 0; r < 4; ++r) { mrun[r] = -INFINITY; lrun[r] = 0.f; }
#pragma unroll
        for (int nt = 0; nt < 4; ++nt) o[nt] = (f32x4){0.f, 0.f, 0.f, 0.f};
        const int nkt = 2 * qb + 2;
        for (int kt = 0; kt < nkt; ++kt) {
            const int k0 = kt * 64;
            __syncthreads();
            for (int idx = tid; idx < 64 * 8; idx += 512) {
                const int key = idx >> 3, ch = idx & 7; *(u32x4*)(Ks + key * 104 + ch * 8) = *(const u32x4*)(KVP + (mb + k0 + key) * 1024 + h * 64 + ch * 8); }
            for (int idx = tid; idx < 64 * 32; idx += 512) { const int key = idx >> 5, f = idx & 31; Ks[key * 104 + 64 + f] = (bf16)f2bf(kpe[(mb + k0 + key) * 32 + f]); }
            for (int idx = tid; idx < 64 * 64; idx += 512) { const int key = idx >> 6, d = idx & 63; Vt[d * 72 + key] = KVP[(mb + k0 + key) * 1024 + 512 + h * 64 + d]; }
            __syncthreads();
            f32x4 s[4];
#pragma unroll
            for (int nt = 0; nt < 4; ++nt) { s[nt] = (f32x4){0.f, 0.f, 0.f, 0.f};
#pragma unroll
                for (int ks = 0; ks < 3; ++ks) s[nt] = mfma16(qf[ks], ld8(Ks + (nt * 16 + (lane & 15)) * 104 + ks * 32 + 8 * (lane >> 4)), s[nt]); }
            if (kt >= 2 * qb) {
#pragma unroll
                for (int nt = 0; nt < 4; ++nt)
#pragma unroll
                    for (int r = 0; r < 4; ++r) { const int qpos = q0 + w * 16 + (lane >> 4) * 4 + r, kpos = k0 + nt * 16 + (lane & 15); if (kpos > qpos) s[nt][r] = -INFINITY; }
            }
            softmax_strip(s, mrun, lrun, alpha, Ps, lane);
            WAVE_SYNC();
#pragma unroll
            for (int nt = 0; nt < 4; ++nt) {
#pragma unroll
                for (int r = 0; r < 4; ++r) o[nt][r] *= alpha[r];
#pragma unroll
                for (int k2 = 0; k2 < 2; ++k2) o[nt] = mfma16(ld8(Ps + (lane & 15) * 72 + k2 * 32 + 8 * (lane >> 4)), ld8(Vt + (nt * 16 + (lane & 15)) * 72 + k2 * 32 + 8 * (lane >> 4)), o[nt]); }
            WAVE_SYNC();
        }
#pragma unroll
        for (int nt = 0; nt < 4; ++nt)
#pragma unroll
            for (int r = 0; r < 4; ++r) OCAT[(mb + q0 + w * 16 + (lane >> 4) * 4 + r) * D + 512 + h * 64 + nt * 16 + (lane & 15)] = (bf16)f2bf(o[nt][r] / lrun[r]);
    }
}

DEV void phase_attn_sample(const Ctx& c) {
    bf16* Qs = (bf16*)c.lds;
    bf16* Ks = Qs + 64 * 296;
    bf16* Lt = Ks + 64 * 296;
    float* Sf = (float*)(Lt + 256 * 72);
    bf16* Psb = (bf16*)(Sf + 64 * 68);
    float* Of = (float*)Ks;
    const float* QH = c.w<float>(WS_QH); const float* rope = c.w<float>(WS_ROPE); bf16* OCAT = c.w<bf16>(WS_OCAT);
    const float* wuk = c.in<float>(21); const float* wuv = c.in<float>(22);
    const float* clat = c.in<float>(4); const float* ckr = c.in<float>(5); const int* ptab = c.in<int>(7);
    const int tid = c.tid, lane = c.lane, w = c.wave;
    bf16* Ps = Psb + w * 16 * 72;
    for (int b = blockIdx.x; b < DECB; b += gridDim.x) {
        const size_t mb = (size_t)MP + (size_t)b * DECS;
        __syncthreads();
        for (int idx = tid; idx < 64 * 64; idx += 512) { const int r = idx >> 6, d = idx & 63, t = r >> 3, h = r & 7; Sf[r * 68 + d] = QH[(mb + t) * 768 + h * 96 + d]; }
        for (int idx = tid; idx < 64 * 16; idx += 512) { const int r = idx >> 4, f = idx & 15, t = r >> 3, h = r & 7; const float* qrow = QH + (mb + t) * 768 + h * 96 + 64;
            const float* rt = rope + (size_t)(SEQ + t) * 32; const float cs = rt[f], sn = rt[16 + f], x1 = qrow[f], x2 = qrow[16 + f];
            Qs[r * 296 + 256 + f] = (bf16)f2bf((x1 * cs - x2 * sn) * MLA_SCALE); Qs[r * 296 + 272 + f] = (bf16)f2bf((x2 * cs + x1 * sn) * MLA_SCALE); }
        __syncthreads();
        {
            const int l = tid & 255, th = tid >> 8;
            for (int h = 0; h < 8; ++h) {
                float a0 = 0.f, a1 = 0.f, a2 = 0.f, a3 = 0.f; const float* wr = wuk + (size_t)l * 512 + h * 64;
                const float* q0 = Sf + ((th * 4 + 0) * 8 + h) * 68; const float* q1 = Sf + ((th * 4 + 1) * 8 + h) * 68; const float* q2 = Sf + ((th * 4 + 2) * 8 + h) * 68; const float* q3 = Sf + ((th * 4 + 3) * 8 + h) * 68;
#pragma unroll 4
                for (int d4 = 0; d4 < 16; ++d4) { const f32x4 wv = *(const f32x4*)(wr + 4 * d4);
#pragma unroll
                    for (int j = 0; j < 4; ++j) { a0 += q0[4 * d4 + j] * wv[j]; a1 += q1[4 * d4 + j] * wv[j]; a2 += q2[4 * d4 + j] * wv[j]; a3 += q3[4 * d4 + j] * wv[j]; } }
                Qs[((th * 4 + 0) * 8 + h) * 296 + l] = (bf16)f2bf(a0 * MLA_SCALE); Qs[((th * 4 + 1) * 8 + h) * 296 + l] = (bf16)f2bf(a1 * MLA_SCALE);
                Qs[((th * 4 + 2) * 8 + h) * 296 + l] = (bf16)f2bf(a2 * MLA_SCALE); Qs[((th * 4 + 3) * 8 + h) * 296 + l] = (bf16)f2bf(a3 * MLA_SCALE);
            }
        }
        __syncthreads();
        const int rt = w & 3, hh = w >> 2;
        bf16x8 qf[9];
#pragma unroll
        for (int ks = 0; ks < 9; ++ks) qf[ks] = ld8(Qs + (rt * 16 + (lane & 15)) * 296 + ks * 32 + 8 * (lane >> 4));
        float mrun[4], lrun[4], alpha[4]; f32x4 o[8];
#pragma unroll
        for (int r = 0; r < 4; ++r) { mrun[r] = -INFINITY; lrun[r] = 0.f; }
#pragma unroll
        for (int nt = 0; nt < 8; ++nt) o[nt] = (f32x4){0.f, 0.f, 0.f, 0.f};
        constexpr int NT = PAST / 64 + 1;
        for (int kt = 0; kt < NT; ++kt) {
            const bool fresh = kt == NT - 1;
            __syncthreads();
            if (!fresh) {
                const int k0 = kt * 64; const size_t rowbase = (size_t)ptab[b * NPAGES + (k0 >> 7)] * PAGE + (k0 & 127);
#pragma unroll 2
                for (int j = 0; j < 8; ++j) { const int idx = tid + 512 * j, key = idx >> 6, l4 = idx & 63;
                    const f32x4 v = *(const f32x4*)(clat + (rowbase + key) * 256 + 4 * l4);
                    u32x2 pk; pk.x = pk2(v[0], v[1]); pk.y = pk2(v[2], v[3]); *(u32x2*)(Ks + key * 296 + 4 * l4) = pk;
                    Lt[(4 * l4 + 0) * 72 + key] = (bf16)f2bf(v[0]); Lt[(4 * l4 + 1) * 72 + key] = (bf16)f2bf(v[1]); Lt[(4 * l4 + 2) * 72 + key] = (bf16)f2bf(v[2]); Lt[(4 * l4 + 3) * 72 + key] = (bf16)f2bf(v[3]); }
                { const int key = tid >> 3, i4 = tid & 7; const f32x4 v = *(const f32x4*)(ckr + (rowbase + key) * 32 + 4 * i4);
                    u32x2 pk; pk.x = pk2(v[0], v[1]); pk.y = pk2(v[2], v[3]); *(u32x2*)(Ks + key * 296 + 256 + 4 * i4) = pk; }
            } else {
                const float* nl = c.out + O_LATS + (size_t)b * DECS * 256; const float* nk = c.out + O_KPES + (size_t)b * DECS * 32;
                for (int idx = tid; idx < 64 * 256; idx += 512) { const int key = idx >> 8, l = idx & 255; const bf16 v = key < DECS ? (bf16)f2bf(nl[key * 256 + l]) : (bf16)0; Ks[key * 296 + l] = v; Lt[l * 72 + key] = v; }
                for (int idx = tid; idx < 64 * 32; idx += 512) { const int key = idx >> 5, f = idx & 31; Ks[key * 296 + 256 + f] = key < DECS ? (bf16)f2bf(nk[key * 32 + f]) : (bf16)0; }
            }
            __syncthreads();
#pragma unroll
            for (int n2 = 0; n2 < 2; ++n2) { const int nt = 2 * hh + n2; f32x4 s = (f32x4){0.f, 0.f, 0.f, 0.f};
#pragma unroll
                for (int ks = 0; ks < 9; ++ks) s = mfma16(qf[ks], ld8(Ks + (nt * 16 + (lane & 15)) * 296 + ks * 32 + 8 * (lane >> 4)), s);
#pragma unroll
                for (int r = 0; r < 4; ++r) { const int row = rt * 16 + (lane >> 4) * 4 + r, key = nt * 16 + (lane & 15); float v = s[r];
                    if (fresh && (key >= DECS || key > (row >> 3))) v = -INFINITY;
                    Sf[row * 68 + key] = v; } }
            __syncthreads();
            f32x4 s[4];
#pragma unroll
            for (int nt = 0; nt < 4; ++nt)
#pragma unroll
                for (int r = 0; r < 4; ++r) s[nt][r] = Sf[(rt * 16 + (lane >> 4) * 4 + r) * 68 + nt * 16 + (lane & 15)];
            softmax_strip(s, mrun, lrun, alpha, Ps, lane);
            WAVE_SYNC();
#pragma unroll
            for (int nt = 0; nt < 8; ++nt) {
#pragma unroll
                for (int r = 0; r < 4; ++r) o[nt][r] *= alpha[r];
#pragma unroll
                for (int k2 = 0; k2 < 2; ++k2) o[nt] = mfma16(ld8(Ps + (lane & 15) * 72 + k2 * 32 + 8 * (lane >> 4)), ld8(Lt + (hh * 128 + nt * 16 + (lane & 15)) * 72 + k2 * 32 + 8 * (lane >> 4)), o[nt]); }
            WAVE_SYNC();
        }
        __syncthreads();
#pragma unroll
        for (int nt = 0; nt < 8; ++nt)
#pragma unroll
            for (int r = 0; r < 4; ++r) Of[(rt * 16 + (lane >> 4) * 4 + r) * 260 + hh * 128 + nt * 16 + (lane & 15)] = o[nt][r] / lrun[r];
        __syncthreads();
        {
            const int d = tid & 63, h = tid >> 6; float a[8];
#pragma unroll
            for (int t = 0; t < 8; ++t) a[t] = 0.f;
            for (int l = 0; l < 256; ++l) { const float wv = wuv[(size_t)l * 512 + h * 64 + d];
#pragma unroll
                for (int t = 0; t < 8; ++t) a[t] += Of[(t * 8 + h) * 260 + l] * wv; }
#pragma unroll
            for (int t = 0; t < 8; ++t) OCAT[(mb + t) * D + 512 + h * 64 + d] = (bf16)f2bf(a[t]);
        }
    }
}

constexpr int NCH = SEQ / 64;
constexpr size_t HC_QG = WS_H, HC_BNT = HC_QG + (size_t)BATCH * 8 * NCH * 64 * 128 * 2,
    HC_A = HC_BNT + (size_t)BATCH * 8 * NCH * 128 * 128 * 2, HC_END = HC_A + (size_t)BATCH * 8 * NCH * 128 * 4;
constexpr size_t HC_SNT = WS_QH;
static_assert(HC_END <= WS_H_END && HC_SNT + (size_t)BATCH * 8 * NCH * 128 * 128 * 2 <= WS_OCAT, "hgrn scratch fits");
DEV u32x4 pack8(const float* v) { u32x4 o; o.x = pk2(v[0], v[1]); o.y = pk2(v[2], v[3]); o.z = pk2(v[4], v[5]); o.w = pk2(v[6], v[7]); return o; }

DEV void phase_hgrn_prep(const Ctx& c) {
    bf16* qt = (bf16*)c.lds;
    bf16* kt = qt + 64 * 136;
    bf16* vT = kt + 160 * 136;
    bf16* Ab = vT + 128 * 72;
    float* tot = (float*)(Ab + 64 * 72);
    bf16* kgl = (bf16*)(tot + 512);
    const bf16* PC = c.w<bf16>(WS_P1); float* ORAW = c.w<float>(WS_ORAW);
    bf16* QG = c.w<bf16>(HC_QG); bf16* BNT = c.w<bf16>(HC_BNT); float* Ag = c.w<float>(HC_A);
    const float* lbl = c.in<float>(25);
    const int tid = c.tid, lane = c.lane, w = c.wave;
    const int d = tid & 127, tq = tid >> 7;
    constexpr int NU = BATCH * 8 * NCH;
    bf16 rq[16], rf[16], rv[16];
#define HP_LOAD(u_) do { const int u__ = (u_); const int bh_ = u__ / NCH, n_ = u__ % NCH; const bf16* row_ = PC + ((size_t)(bh_ >> 3) * SEQ + (size_t)n_ * 64 + 16 * tq) * INC + (bh_ & 7) * 128 + d; \
        _Pragma("unroll") for (int i = 0; i < 16; ++i) { rq[i] = row_[(size_t)i * INC]; rf[i] = row_[(size_t)i * INC + 1024]; rv[i] = row_[(size_t)i * INC + 2048]; } } while (0)
    if ((int)blockIdx.x < NU) HP_LOAD(blockIdx.x);
    for (int u = blockIdx.x; u < NU; u += gridDim.x) {
        const int bh = u / NCH, n = u % NCH, b = bh >> 3, h = bh & 7;
        const size_t m0 = (size_t)b * SEQ + (size_t)n * 64;
        const float lb = sigmoidf_(lbl[1024 + h * 128 + d] - lbl[h * 128 + d]);
        float P[16], Sf[16], kk[16], qq[16], vv[16], ff[16];
        float run = 1.f;
#pragma unroll
        for (int i = 0; i < 16; ++i) {
            const float f = lb + (1.f - lb) * sigmoidf_(bf2f(rf[i]));
            ff[i] = f; kk[i] = 1.f - f; run *= f; P[i] = run;
            qq[i] = siluf_(bf2f(rq[i])) * DK_SCALE; vv[i] = bf2f(rv[i]);
        }
        { float sr = 1.f;
#pragma unroll
          for (int i = 15; i >= 0; --i) { Sf[i] = sr; sr *= ff[i]; } }
        if (u + (int)gridDim.x < NU) HP_LOAD(u + (int)gridDim.x);
        tot[tq * 128 + d] = run;
        { const u32x4 p0 = pack8(vv), p1 = pack8(vv + 8);
          *(u32x4*)(vT + d * 72 + 16 * tq) = p0; *(u32x4*)(vT + d * 72 + 16 * tq + 8) = p1; }
        for (int i = tid; i < 64 * 72 / 8; i += 512) { u32x4 z; z.x = z.y = z.z = z.w = 0u; *(u32x4*)(Ab + 8 * i) = z; }
        LDS_BARRIER();
        const float q0 = tot[d], q1 = tot[128 + d], q2 = tot[256 + d], q3 = tot[384 + d];
        const float Rt = tq == 0 ? 1.f : (tq == 1 ? q0 : (tq == 2 ? q0 * q1 : q0 * q1 * q2));
        const float Tt = tq == 0 ? q1 * q2 * q3 : (tq == 1 ? q2 * q3 : (tq == 2 ? q3 : 1.f));
        const float M1 = 1.f, M2 = tq == 0 ? q1 : 1.f, M3 = tq == 0 ? q1 * q2 : (tq == 1 ? q2 : 1.f);
        float kg[16];
#pragma unroll
        for (int i = 0; i < 16; ++i) {
            qt[(16 * tq + i) * 136 + d] = (bf16)f2bf(qq[i] * P[i]);
            QG[((size_t)u * 64 + 16 * tq + i) * 128 + d] = (bf16)f2bf(qq[i] * Rt * P[i]);
            kg[i] = kk[i] * Sf[i] * Tt;
            const float kinv = kk[i] * rcpf_(P[i]), ksf = kk[i] * Sf[i];
#pragma unroll
            for (int I = 0; I < 4; ++I) if (I >= tq) { const int base = I == 0 ? 0 : (I == 1 ? 16 : (I == 2 ? 48 : 96));
                const float mI = I == 1 ? M1 : (I == 2 ? M2 : M3);
                kt[(base + 16 * tq + i) * 136 + d] = (bf16)f2bf(I == tq ? kinv : ksf * mI); }
        }
        { bf16* g = kgl + d * 72 + 16 * tq; *(u32x4*)g = pack8(kg); *(u32x4*)(g + 8) = pack8(kg + 8); }
        if (tq == 0) Ag[(size_t)u * 128 + d] = (q0 * q1) * (q2 * q3);
        LDS_BARRIER();
        for (int ti = w; ti < 10; ti += 8) {
            const int I = ti == 0 ? 0 : (ti < 3 ? 1 : (ti < 6 ? 2 : 3)); const int J = ti - (I == 0 ? 0 : (I == 1 ? 1 : (I == 2 ? 3 : 6)));
            const int base = I == 0 ? 0 : (I == 1 ? 16 : (I == 2 ? 48 : 96));
            f32x4 acc = (f32x4){0.f, 0.f, 0.f, 0.f};
#pragma unroll
            for (int ks = 0; ks < 4; ++ks) acc = mfma16(ld8(qt + (16 * I + (lane & 15)) * 136 + ks * 32 + 8 * (lane >> 4)), ld8(kt + (base + 16 * J + (lane & 15)) * 136 + ks * 32 + 8 * (lane >> 4)), acc);
#pragma unroll
            for (int r = 0; r < 4; ++r) { const int i = 16 * I + (lane >> 4) * 4 + r, j = 16 * J + (lane & 15); Ab[i * 72 + j] = (bf16)f2bf((J < I || j <= i) ? acc[r] : 0.f); }
        }
        LDS_BARRIER();
        { const int it = w & 3;
          f32x4 acc[4];
#pragma unroll
          for (int e4 = 0; e4 < 4; ++e4) acc[e4] = (f32x4){0.f, 0.f, 0.f, 0.f};
#pragma unroll
          for (int ks = 0; ks < 2; ++ks) { const bf16x8 af = ld8(Ab + (16 * it + (lane & 15)) * 72 + ks * 32 + 8 * (lane >> 4)); bf16x8 vf[4];
#pragma unroll
            for (int e4 = 0; e4 < 4; ++e4) vf[e4] = ld8(vT + (16 * ((w >> 2) * 4 + e4) + (lane & 15)) * 72 + ks * 32 + 8 * (lane >> 4));
#pragma unroll
            for (int e4 = 0; e4 < 4; ++e4) acc[e4] = mfma16(af, vf[e4], acc[e4]); }
#pragma unroll
          for (int e4 = 0; e4 < 4; ++e4) { const int et = (w >> 2) * 4 + e4;
#pragma unroll
            for (int r = 0; r < 4; ++r) ORAW[(m0 + 16 * it + (lane >> 4) * 4 + r) * D + h * 128 + 16 * et + (lane & 15)] = acc[e4][r]; } }
        {
            bf16x8 ka[2];
#pragma unroll
            for (int ks = 0; ks < 2; ++ks) ka[ks] = ld8(kgl + (16 * w + (lane & 15)) * 72 + ks * 32 + 8 * (lane >> 4));
            bf16* g = BNT + (size_t)u * 16384;
            f32x4 acc[8];
#pragma unroll
            for (int et = 0; et < 8; ++et) acc[et] = (f32x4){0.f, 0.f, 0.f, 0.f};
#pragma unroll
            for (int ks = 0; ks < 2; ++ks) { bf16x8 vf[8];
#pragma unroll
                for (int et = 0; et < 8; ++et) vf[et] = ld8(vT + (16 * et + (lane & 15)) * 72 + ks * 32 + 8 * (lane >> 4));
#pragma unroll
                for (int et = 0; et < 8; ++et) acc[et] = mfma16(ka[ks], vf[et], acc[et]); }
#pragma unroll
            for (int et = 0; et < 8; ++et) { u32x2 o; o.x = pk2(acc[et][0], acc[et][1]); o.y = pk2(acc[et][2], acc[et][3]); *(u32x2*)(g + (16 * et + (lane & 15)) * 128 + 16 * w + 4 * (lane >> 4)) = o; }
        }
        LDS_BARRIER();
    }
}

#undef HP_LOAD
DEV void phase_hgrn_prefix(const Ctx& c) {
    const bf16* BNT = c.w<bf16>(HC_BNT); const float* Ag = c.w<float>(HC_A); bf16* SNT = c.w<bf16>(HC_SNT);
    constexpr int NV = BATCH * 8 * 2048;
    for (int v = blockIdx.x * 512 + c.tid; v < NV; v += gridDim.x * 512) {
        const int bh = v >> 11, x8 = (v & 2047) * 8, d0 = x8 & 127, e = x8 >> 7;
        float S[8];
#pragma unroll
        for (int j = 0; j < 8; ++j) S[j] = 0.f;
        const size_t base = (size_t)bh * NCH * 16384 + x8;
        constexpr int PFD = NCH < 8 ? NCH : 8;
        u32x4 bq[PFD]; f32x4 aq0[PFD], aq1[PFD];
#pragma unroll
        for (int j = 0; j < PFD; ++j) { bq[j] = *(const u32x4*)(BNT + base + (size_t)j * 16384); aq0[j] = *(const f32x4*)(Ag + ((size_t)bh * NCH + j) * 128 + d0); aq1[j] = *(const f32x4*)(Ag + ((size_t)bh * NCH + j) * 128 + d0 + 4); }
#pragma unroll
        for (int n = 0; n < NCH; ++n) {
            const u32x4 bv = bq[n % PFD]; const f32x4 a0 = aq0[n % PFD], a1 = aq1[n % PFD];
            if (n + PFD < NCH) { bq[n % PFD] = *(const u32x4*)(BNT + base + (size_t)(n + PFD) * 16384); aq0[n % PFD] = *(const f32x4*)(Ag + ((size_t)bh * NCH + n + PFD) * 128 + d0); aq1[n % PFD] = *(const f32x4*)(Ag + ((size_t)bh * NCH + n + PFD) * 128 + d0 + 4); }
            *(u32x4*)(SNT + base + (size_t)n * 16384) = pack8(S);
            S[0] = a0[0] * S[0] + __uint_as_float(bv.x << 16); S[1] = a0[1] * S[1] + __uint_as_float(bv.x & 0xffff0000u);
            S[2] = a0[2] * S[2] + __uint_as_float(bv.y << 16); S[3] = a0[3] * S[3] + __uint_as_float(bv.y & 0xffff0000u);
            S[4] = a1[0] * S[4] + __uint_as_float(bv.z << 16); S[5] = a1[1] * S[5] + __uint_as_float(bv.z & 0xffff0000u);
            S[6] = a1[2] * S[6] + __uint_as_float(bv.w << 16); S[7] = a1[3] * S[7] + __uint_as_float(bv.w & 0xffff0000u);
        }
        float* So = c.out + O_HGP + (size_t)bh * 16384;
#pragma unroll
        for (int j = 0; j < 8; ++j) So[(size_t)(d0 + j) * 128 + e] = S[j];
    }
}

DEV void phase_hgrn_out(const Ctx& c) {
    bf16* qg = (bf16*)c.lds;
    bf16* StT = qg + 64 * 136;
    float* ob = (float*)(StT + 128 * 136);
    const bf16* PC = c.w<bf16>(WS_P1); const float* ORAW = c.w<float>(WS_ORAW); bf16* OC = c.w<bf16>(WS_OCAT);
    const bf16* QG = c.w<bf16>(HC_QG); const bf16* SNT = c.w<bf16>(HC_SNT);
    const float* gn = c.in<float>(26);
    const int tid = c.tid, lane = c.lane, w = c.wave;
    const float gn0 = gn[lane], gn1 = gn[64 + lane];
    constexpr int NU = BATCH * 8 * NCH;
    u32x4 pq[2], ps[4]; float or0n[8], or1n[8]; bf16 zz0n[8], zz1n[8];
#define HO_LOAD(u_) do { const int u__ = (u_); const int bh_ = u__ / NCH, n_ = u__ % NCH, b_ = bh_ >> 3, h_ = bh_ & 7; const size_t m0_ = (size_t)b_ * SEQ + (size_t)n_ * 64; \
        _Pragma("unroll") for (int j = 0; j < 2; ++j) pq[j] = *(const u32x4*)(QG + (size_t)u__ * 8192 + 8 * (tid + 512 * j)); \
        _Pragma("unroll") for (int j = 0; j < 4; ++j) ps[j] = *(const u32x4*)(SNT + (size_t)u__ * 16384 + 8 * (tid + 512 * j)); \
        _Pragma("unroll") for (int i8 = 0; i8 < 8; ++i8) { const size_t m = m0_ + w * 8 + i8; or0n[i8] = ORAW[m * D + h_ * 128 + lane]; or1n[i8] = ORAW[m * D + h_ * 128 + 64 + lane]; \
            zz0n[i8] = PC[m * INC + 3072 + h_ * 128 + lane]; zz1n[i8] = PC[m * INC + 3072 + h_ * 128 + 64 + lane]; } } while (0)
    if ((int)blockIdx.x < NU) HO_LOAD(blockIdx.x);
    for (int u = blockIdx.x; u < NU; u += gridDim.x) {
        const int bh = u / NCH, n = u % NCH, b = bh >> 3, h = bh & 7; const size_t m0 = (size_t)b * SEQ + (size_t)n * 64;
        float or0[8], or1[8], zz0[8], zz1[8];
#pragma unroll
        for (int i8 = 0; i8 < 8; ++i8) { or0[i8] = or0n[i8]; or1[i8] = or1n[i8]; zz0[i8] = bf2f(zz0n[i8]); zz1[i8] = bf2f(zz1n[i8]); }
        LDS_BARRIER();
#pragma unroll
        for (int j = 0; j < 2; ++j) { const int idx = tid + 512 * j; *(u32x4*)(qg + (idx >> 4) * 136 + (idx & 15) * 8) = pq[j]; }
#pragma unroll
        for (int j = 0; j < 4; ++j) { const int idx = tid + 512 * j; *(u32x4*)(StT + (idx >> 4) * 136 + (idx & 15) * 8) = ps[j]; }
        if (u + (int)gridDim.x < NU) HO_LOAD(u + (int)gridDim.x);
        LDS_BARRIER();
        { const int it = w & 3; bf16x8 qa[4];
#pragma unroll
          for (int ks = 0; ks < 4; ++ks) qa[ks] = ld8(qg + (16 * it + (lane & 15)) * 136 + ks * 32 + 8 * (lane >> 4));
          f32x4 acc[4];
#pragma unroll
          for (int e4 = 0; e4 < 4; ++e4) acc[e4] = (f32x4){0.f, 0.f, 0.f, 0.f};
#pragma unroll
          for (int ks = 0; ks < 4; ++ks) { bf16x8 bs[4];
#pragma unroll
            for (int e4 = 0; e4 < 4; ++e4) bs[e4] = ld8(StT + (16 * ((w >> 2) * 4 + e4) + (lane & 15)) * 136 + ks * 32 + 8 * (lane >> 4));
#pragma unroll
            for (int e4 = 0; e4 < 4; ++e4) acc[e4] = mfma16(qa[ks], bs[e4], acc[e4]); }
#pragma unroll
          for (int e4 = 0; e4 < 4; ++e4) { const int et = (w >> 2) * 4 + e4;
#pragma unroll
            for (int r = 0; r < 4; ++r) ob[(16 * it + (lane >> 4) * 4 + r) * 132 + 16 * et + (lane & 15)] = acc[e4][r]; } }
        LDS_BARRIER();
        { float ss[8];
#pragma unroll
          for (int i8 = 0; i8 < 8; ++i8) { const int i = w * 8 + i8; or0[i8] += ob[i * 132 + lane]; or1[i8] += ob[i * 132 + 64 + lane]; ss[i8] = or0[i8] * or0[i8] + or1[i8] * or1[i8]; }
#pragma unroll
              for (int i8 = 0; i8 < 8; ++i8) ss[i8] = wave_sum(ss[i8]);
#pragma unroll
          for (int i8 = 0; i8 < 8; ++i8) { const size_t m = m0 + w * 8 + i8; const float r = rsqrtf(ss[i8] * (1.f / 128.f) + EPS);
            OC[m * D + h * 128 + lane] = (bf16)f2bf(or0[i8] * r * gn0 * siluf_(zz0[i8])); OC[m * D + h * 128 + 64 + lane] = (bf16)f2bf(or1[i8] * r * gn1 * siluf_(zz1[i8])); } }
    }
}


constexpr int NUG = BATCH * 4 * NCH;
constexpr size_t GC_W = WS_H, GC_UT = GC_W + (size_t)NUG * 64 * 128 * 2, GC_QG = GC_UT + (size_t)NUG * 128 * 64 * 4, GC_KGT = GC_QG + (size_t)NUG * 64 * 128 * 2,
    GC_AQK = GC_KGT + (size_t)NUG * 128 * 64 * 2, GC_GL = GC_AQK + (size_t)NUG * 64 * 64 * 2, GC_END = GC_GL + (size_t)NUG * 4;
static_assert(GC_END <= WS_H_END, "gdn scratch fits in H");

DEV void phase_gdn_prep(const Ctx& c) {
    bf16* qb = (bf16*)c.lds;
    bf16* kb = qb + 64 * 136;
    float* Lm = (float*)(kb + 64 * 136);
    float* part = Lm + 64 * 68;
    float* gl = part + 256; float* gcs = gl + 64; float* bet = gcs + 64; float* eg = bet + 64; float* egl = eg + 64; float* qn = egl + 64; float* kn = qn + 64;
    float* sqb = kn + 64;
    const bf16* P1 = c.w<bf16>(WS_P1);
    bf16* Wg = c.w<bf16>(GC_W); float* UTg = c.w<float>(GC_UT); bf16* QGg = c.w<bf16>(GC_QG); bf16* KGTg = c.w<bf16>(GC_KGT); bf16* AQKg = c.w<bf16>(GC_AQK); float* GLg = c.w<float>(GC_GL);
    const float* convw = c.in<float>(14);
    const int tid = c.tid, lane = c.lane, w = c.wave;
    const int role = tid >> 7, cc = tid & 127;
    for (int u = blockIdx.x; u < NUG; u += gridDim.x) {
        const int bh = u / NCH, n = u % NCH, b = bh >> 2, h = bh & 3;
        const size_t m0 = (size_t)b * SEQ + (size_t)n * 64;
        float x[64];
        if (role < 3) {
            const int col = role * 512 + h * 128 + cc;
            const float w0 = convw[col], w1 = convw[QKV_A + col], w2 = convw[2 * QKV_A + col], w3 = convw[3 * QKV_A + col];
            const bf16* src = P1 + m0 * LD1 + col;
            float p0 = 0.f, p1 = 0.f, p2 = 0.f;
            if (n > 0) { p0 = bf2f(src[-3 * (long)LD1]); p1 = bf2f(src[-2 * (long)LD1]); p2 = bf2f(src[-1 * (long)LD1]); }
#pragma unroll
            for (int j = 0; j < 64; ++j) x[j] = bf2f(src[(size_t)j * LD1]);
#pragma unroll
            for (int j = 0; j < 64; ++j) { const float cur = x[j]; const float y = w0 * p0 + w1 * p1 + w2 * p2 + w3 * cur; x[j] = siluf_(y); p0 = p1; p1 = p2; p2 = cur; }
            if (role < 2) {
#pragma unroll
                for (int j4 = 0; j4 < 16; ++j4) *(f32x4*)(sqb + tid * 68 + 4 * j4) = (f32x4){x[4 * j4] * x[4 * j4], x[4 * j4 + 1] * x[4 * j4 + 1], x[4 * j4 + 2] * x[4 * j4 + 2], x[4 * j4 + 3] * x[4 * j4 + 3]};
            }
        } else if (cc < 64) {
            const float Aexp = __expf(c.in<float>(15)[h]), dtb = c.in<float>(16)[h];
            bet[cc] = sigmoidf_(bf2f(P1[(m0 + cc) * LD1 + C_B + h]));
            gl[cc] = -Aexp * softplusf_(bf2f(P1[(m0 + cc) * LD1 + C_A + h]) + dtb);
        }
        __syncthreads();
        if (role == 3) {
            if (cc < 64) { float acc = 0.f, totl = 0.f;
                for (int i = 0; i < 64; ++i) { const float g = gl[i]; totl += g; if (i <= cc) acc += g; }
                gcs[cc] = acc; eg[cc] = __expf(acc); egl[cc] = __expf(totl - acc);
                if (cc == 0) GLg[u] = __expf(totl);
            } else { const int j = cc - 64; float sq = 0.f, sk = 0.f;
#pragma unroll 16
                for (int cx = 0; cx < 128; ++cx) { sq += sqb[cx * 68 + j]; sk += sqb[(128 + cx) * 68 + j]; }
                qn[j] = rsqrtf(sq + EPS); kn[j] = rsqrtf(sk + EPS); }
        }
        __syncthreads();
        if (role == 0) {
#pragma unroll
            for (int j = 0; j < 64; ++j) { const float qh = x[j] * qn[j]; qb[j * 136 + cc] = (bf16)f2bf(qh); QGg[((size_t)u * 64 + j) * 128 + cc] = (bf16)f2bf(qh * DK_SCALE * eg[j]); }
        } else if (role == 1) {
            bf16* g = KGTg + ((size_t)u * 128 + cc) * 64;
#pragma unroll
            for (int j8 = 0; j8 < 8; ++j8) { float t[8];
#pragma unroll
                for (int q = 0; q < 8; ++q) { const int j = 8 * j8 + q; const float kh = x[j] * kn[j]; kb[j * 136 + cc] = (bf16)f2bf(kh); t[q] = kh * egl[j]; x[j] = kh * bet[j] * eg[j]; }
                *(u32x4*)(g + 8 * j8) = pack8(t); }
        } else if (role == 2) {
#pragma unroll
            for (int j = 0; j < 64; ++j) x[j] *= bet[j];
        }
        __syncthreads();
        for (int ti = w; ti < 32; ti += 8) {
            const bool isq = ti >= 16; const int I = (ti & 15) >> 2, J = ti & 3;
            if (J > I) { if (isq) {
#pragma unroll
                    for (int r = 0; r < 4; ++r) AQKg[((size_t)u * 64 + 16 * I + (lane >> 4) * 4 + r) * 64 + 16 * J + (lane & 15)] = (bf16)0; }
                continue; }
            const bf16* Ab = isq ? qb : kb;
            f32x4 acc = (f32x4){0.f, 0.f, 0.f, 0.f};
#pragma unroll
            for (int ks = 0; ks < 4; ++ks) acc = mfma16(ld8(Ab + (16 * I + (lane & 15)) * 136 + ks * 32 + 8 * (lane >> 4)), ld8(kb + (16 * J + (lane & 15)) * 136 + ks * 32 + 8 * (lane >> 4)), acc);
#pragma unroll
            for (int r = 0; r < 4; ++r) { const int i = 16 * I + (lane >> 4) * 4 + r, j = 16 * J + (lane & 15);
                const float dcy = __expf(fminf(gcs[i] - gcs[j], 0.f));
                if (isq) AQKg[((size_t)u * 64 + i) * 64 + j] = (bf16)f2bf(i >= j ? acc[r] * DK_SCALE * dcy : 0.f);
                else Lm[i * 68 + j] = i > j ? bet[i] * acc[r] * dcy : 0.f; }
        }
        __syncthreads();
        if (role == 1 || role == 2) {
#pragma unroll
            for (int i = 1; i < 64; ++i) { float acc = x[i];
#pragma unroll
                for (int j = 0; j < i; ++j) acc -= Lm[i * 68 + j] * x[j];
                x[i] = acc; }
            if (role == 1) {
#pragma unroll
                for (int i = 0; i < 64; ++i) Wg[((size_t)u * 64 + i) * 128 + cc] = (bf16)f2bf(x[i]);
            } else { float* g = UTg + ((size_t)u * 128 + cc) * 64;
#pragma unroll
                for (int i4 = 0; i4 < 16; ++i4) *(f32x4*)(g + 4 * i4) = (f32x4){x[4 * i4], x[4 * i4 + 1], x[4 * i4 + 2], x[4 * i4 + 3]}; }
        }
        __syncthreads();
    }
}

DEV void phase_gdn_scan(const Ctx& c, int u_first, int u_stride) {
    bf16* wl = (bf16*)c.lds;
    bf16* qgl = wl + 64 * 136;
    bf16* kgT = qgl + 64 * 136;
    bf16* aqk = kgT + 128 * 72;
    bf16* StT = aqk + 64 * 72;
    bf16* vnT = StT + 128 * 136;
    float* ob = (float*)(vnT + 128 * 72);
    const bf16* P1 = c.w<bf16>(WS_P1); bf16* OCAT = c.w<bf16>(WS_OCAT);
    const bf16* Wg = c.w<bf16>(GC_W); const float* UTg = c.w<float>(GC_UT); const bf16* QGg = c.w<bf16>(GC_QG); const bf16* KGTg = c.w<bf16>(GC_KGT); const bf16* AQKg = c.w<bf16>(GC_AQK); const float* GLg = c.w<float>(GC_GL);
    const float* gn = c.in<float>(17);
    const int tid = c.tid, lane = c.lane, w = c.wave;
    constexpr int NU = BATCH * 4;
    for (int u = u_first; u < NU; u += u_stride) {
        const int b = u >> 2, h = u & 3; const size_t mb = (size_t)b * SEQ;
        f32x4 S[8];
#pragma unroll
        for (int et = 0; et < 8; ++et) S[et] = (f32x4){0.f, 0.f, 0.f, 0.f};
        __syncthreads();
        for (int i = tid; i < 128 * 136 / 8; i += 512) { u32x4 z; z.x = z.y = z.z = z.w = 0u; *(u32x4*)(StT + 8 * i) = z; }
        u32x4 pw[2], pq[2], pk[2], pa;
        const size_t cu0 = (size_t)u * NCH;
#define GD_LOAD(n_) do { const bf16* g0 = Wg + (cu0 + (n_)) * 64 * 128; const bf16* g1 = QGg + (cu0 + (n_)) * 64 * 128; const bf16* g2 = KGTg + (cu0 + (n_)) * 128 * 64; const bf16* g3 = AQKg + (cu0 + (n_)) * 64 * 64; \
            _Pragma("unroll") for (int j = 0; j < 2; ++j) { const int idx = tid + 512 * j; pw[j] = *(const u32x4*)(g0 + 8 * idx); pq[j] = *(const u32x4*)(g1 + 8 * idx); pk[j] = *(const u32x4*)(g2 + 8 * idx); } \
            pa = *(const u32x4*)(g3 + 8 * tid); } while (0)
#define GD_STORE_WQ() do { _Pragma("unroll") for (int j = 0; j < 2; ++j) { const int idx = tid + 512 * j; *(u32x4*)(wl + (idx >> 4) * 136 + (idx & 15) * 8) = pw[j]; *(u32x4*)(qgl + (idx >> 4) * 136 + (idx & 15) * 8) = pq[j]; } } while (0)
#define GD_STORE_KA() do { _Pragma("unroll") for (int j = 0; j < 2; ++j) { const int idx = tid + 512 * j; *(u32x4*)(kgT + (idx >> 3) * 72 + (idx & 7) * 8) = pk[j]; } \
            *(u32x4*)(aqk + (tid >> 3) * 72 + (tid & 7) * 8) = pa; } while (0)
        GD_LOAD(0); GD_STORE_WQ(); GD_STORE_KA();
        __syncthreads();
        const int it = w & 3;
        const float gn0 = gn[lane], gn1 = gn[64 + lane];
        f32x4 u4[4]; float dec, decn;
#define GD_LOADU(dst, dd, n_) do { _Pragma("unroll") for (int e4 = 0; e4 < 4; ++e4) { const int et = (w >> 2) * 4 + e4; dst[e4] = *(const f32x4*)(UTg + ((cu0 + (n_)) * 128 + 16 * et + (lane & 15)) * 64 + 16 * it + 4 * (lane >> 4)); } dd = GLg[cu0 + (n_)]; } while (0)
        GD_LOADU(u4, decn, 0);
        for (int n = 0; n < NCH; ++n) {
            dec = decn;
            if (n + 1 < NCH) GD_LOAD(n + 1);
            f32x4 ao[4], av[4];
#pragma unroll
            for (int e4 = 0; e4 < 4; ++e4) { ao[e4] = (f32x4){0.f, 0.f, 0.f, 0.f}; av[e4] = (f32x4){0.f, 0.f, 0.f, 0.f}; }
#pragma unroll
            for (int ks = 0; ks < 4; ++ks) {
                const bf16x8 wa = ld8(wl + (16 * it + (lane & 15)) * 136 + ks * 32 + 8 * (lane >> 4)), qa = ld8(qgl + (16 * it + (lane & 15)) * 136 + ks * 32 + 8 * (lane >> 4));
                bf16x8 bs[4];
#pragma unroll
                for (int e4 = 0; e4 < 4; ++e4) bs[e4] = ld8(StT + (16 * ((w >> 2) * 4 + e4) + (lane & 15)) * 136 + ks * 32 + 8 * (lane >> 4));
#pragma unroll
                for (int e4 = 0; e4 < 4; ++e4) { av[e4] = mfma16(wa, bs[e4], av[e4]); ao[e4] = mfma16(qa, bs[e4], ao[e4]); }
            }
#pragma unroll
            for (int e4 = 0; e4 < 4; ++e4) { const int et = (w >> 2) * 4 + e4; const f32x4 vn = u4[e4] - av[e4];
                u32x2 o; o.x = pk2(vn[0], vn[1]); o.y = pk2(vn[2], vn[3]); *(u32x2*)(vnT + (16 * et + (lane & 15)) * 72 + 16 * it + 4 * (lane >> 4)) = o; }
            if (n + 1 < NCH) GD_LOADU(u4, decn, n + 1);
            LDS_BARRIER();
            float zz0[8], zz1[8];
#pragma unroll
            for (int i8 = 0; i8 < 8; ++i8) { const size_t m = mb + (size_t)n * 64 + w * 8 + i8; zz0[i8] = bf2f(P1[m * LD1 + C_Z + h * 128 + lane]); zz1[i8] = bf2f(P1[m * LD1 + C_Z + h * 128 + 64 + lane]); }
#pragma unroll
            for (int et = 0; et < 8; ++et) S[et] = S[et] * dec;
#pragma unroll
            for (int ks = 0; ks < 2; ++ks) {
                const bf16x8 aa = ld8(aqk + (16 * it + (lane & 15)) * 72 + ks * 32 + 8 * (lane >> 4)), ka = ld8(kgT + (16 * w + (lane & 15)) * 72 + ks * 32 + 8 * (lane >> 4));
                bf16x8 vf[8];
#pragma unroll
                for (int et = 0; et < 8; ++et) vf[et] = ld8(vnT + (16 * et + (lane & 15)) * 72 + ks * 32 + 8 * (lane >> 4));
#pragma unroll
                for (int e4 = 0; e4 < 4; ++e4) ao[e4] = mfma16(aa, (w >> 2) ? vf[4 + e4] : vf[e4], ao[e4]);
#pragma unroll
                for (int et = 0; et < 8; ++et) S[et] = mfma16(ka, vf[et], S[et]);
            }
#pragma unroll
            for (int e4 = 0; e4 < 4; ++e4) { const int et = (w >> 2) * 4 + e4;
#pragma unroll
                for (int r = 0; r < 4; ++r) ob[(16 * it + (lane >> 4) * 4 + r) * 132 + 16 * et + (lane & 15)] = ao[e4][r]; }
#pragma unroll
            for (int et = 0; et < 8; ++et) { u32x2 o; o.x = pk2(S[et][0], S[et][1]); o.y = pk2(S[et][2], S[et][3]); *(u32x2*)(StT + (16 * et + (lane & 15)) * 136 + 16 * w + (lane >> 4) * 4) = o; }
            if (n + 1 < NCH) GD_STORE_WQ();
            LDS_BARRIER();
            { float ss[8], v0[8], v1[8];
#pragma unroll
              for (int i8 = 0; i8 < 8; ++i8) { const int i = w * 8 + i8; v0[i8] = ob[i * 132 + lane]; v1[i8] = ob[i * 132 + 64 + lane]; ss[i8] = v0[i8] * v0[i8] + v1[i8] * v1[i8]; }
#pragma unroll
              for (int i8 = 0; i8 < 8; ++i8) ss[i8] = wave_sum(ss[i8]);
#pragma unroll
              for (int i8 = 0; i8 < 8; ++i8) { const size_t m = mb + (size_t)n * 64 + w * 8 + i8; const float r = rsqrtf(ss[i8] * (1.f / 128.f) + EPS);
                OCAT[m * D + h * 128 + lane] = (bf16)f2bf(v0[i8] * r * gn0 * siluf_(zz0[i8])); OCAT[m * D + h * 128 + 64 + lane] = (bf16)f2bf(v1[i8] * r * gn1 * siluf_(zz1[i8])); } }
            if (n + 1 < NCH) GD_STORE_KA();
        }
#undef GD_LOAD
#undef GD_LOADU
#undef GD_STORE_WQ
#undef GD_STORE_KA
        int lane3 = lane; OPAQUE_V(lane3);
        float* So = c.out + O_GDNP + (size_t)(b * 4 + h) * 16384;
#pragma unroll
        for (int et = 0; et < 8; ++et)
#pragma unroll
            for (int r = 0; r < 4; ++r) So[(size_t)(16 * w + (lane3 >> 4) * 4 + r) * 128 + 16 * et + (lane3 & 15)] = S[et][r];
    }
}


template <int NT> DEV void softmax_rows(f32x4 (&s)[NT], float (&mrun)[4], float (&lrun)[4], float (&alpha)[4], bf16* Ps, int pitch, int lane) {
#pragma unroll
    for (int r = 0; r < 4; ++r) {
        float mx = s[0][r];
#pragma unroll
        for (int nt = 1; nt < NT; ++nt) mx = fmaxf(mx, s[nt][r]);
        mx = grp16_max(mx);
        const float mn = fmaxf(mrun[r], mx);
        alpha[r] = exp2f_(mrun[r] - mn); mrun[r] = mn;
        float sum = 0.f;
#pragma unroll
        for (int nt = 0; nt < NT; ++nt) { const float p = exp2f_(s[nt][r] - mn); s[nt][r] = p; sum += p; }
        sum = grp16_sum(sum); lrun[r] = lrun[r] * alpha[r] + sum;
    }
#pragma unroll
    for (int nt = 0; nt < NT; ++nt)
#pragma unroll
        for (int r = 0; r < 4; ++r) Ps[((lane >> 4) * 4 + r) * pitch + nt * 16 + (lane & 15)] = (bf16)f2bf(s[nt][r]);
}
DEV bf16x8 ldB_tr(const bf16* T, int pitch, int k0, int n0, int lane) {
    const bf16* p = T + (size_t)(k0 + 8 * (lane >> 4) + ((lane & 15) >> 2)) * pitch + n0 + 4 * (lane & 3);
    const s16x4 a = lds_tr(p), b = lds_tr(p + 4 * pitch);
    bf16x8 r; r[0] = a[0]; r[1] = a[1]; r[2] = a[2]; r[3] = a[3]; r[4] = b[0]; r[5] = b[1]; r[6] = b[2]; r[7] = b[3]; return r;
}
constexpr int AS_NSP = 2;
DEV void phase_attn_sample2(const Ctx& c) {
    bf16* Qs = (bf16*)c.lds;
    bf16* Kt0 = Qs + 64 * 296;
    bf16* Psb = Kt0 + 2 * 32 * 296;
    bf16* qtmp = Kt0;
    float* Xo = (float*)c.lds;
    float* Xm = Xo + 64 * 256; float* Xl = Xm + 64;
    const float* QH = c.w<float>(WS_QH); const float* rope = c.w<float>(WS_ROPE); const bf16* WUKB = c.w<bf16>(WS_WUKB);
    float* PO = c.w<float>(WS_PO); float* PM = c.w<float>(WS_PM); float* PL = c.w<float>(WS_PL);
    const float* clat = c.in<float>(4); const float* ckr = c.in<float>(5); const int* ptab = c.in<int>(7);
    const int tid = c.tid, lane = c.lane, w = c.wave, grp = w >> 2, wq = w & 3, gt = tid & 255;
    bf16* Kt = Kt0 + grp * 32 * 296; bf16* Ps = Psb + w * 16 * 40;
    constexpr int NPT32 = PAST / 32, TPS = NPT32 / AS_NSP;
    static_assert(NPT32 % (2 * AS_NSP) == 0, "tiles per split must be even");
    for (int u = blockIdx.x; u < DECB * AS_NSP; u += gridDim.x) {
        const int b = u / AS_NSP, sp = u % AS_NSP; const size_t mb = (size_t)MP + (size_t)b * DECS;
        __syncthreads();
        for (int idx = tid; idx < 64 * 8; idx += 512) { const int r = idx >> 3, ch = idx & 7, t = r >> 3, h = r & 7; const float* q = QH + (mb + t) * 768 + h * 96 + ch * 8;
            const f32x4 a = *(const f32x4*)q, bq = *(const f32x4*)(q + 4); u32x4 o; o.x = pk2(a[0], a[1]); o.y = pk2(a[2], a[3]); o.z = pk2(bq[0], bq[1]); o.w = pk2(bq[2], bq[3]); *(u32x4*)(qtmp + r * 72 + ch * 8) = o; }
        for (int idx = tid; idx < 64 * 16; idx += 512) { const int r = idx >> 4, f = idx & 15, t = r >> 3, h = r & 7; const float* qrow = QH + (mb + t) * 768 + h * 96 + 64;
            const float* rt = rope + (size_t)(SEQ + t) * 32; const float cs = rt[f], sn = rt[16 + f], x1 = qrow[f], x2 = qrow[16 + f];
            Qs[r * 296 + 256 + f] = (bf16)f2bf((x1 * cs - x2 * sn) * QK_SCALE2); Qs[r * 296 + 272 + f] = (bf16)f2bf((x2 * cs + x1 * sn) * QK_SCALE2); }
        __syncthreads();
        {
            const int h = w; bf16x8 af[2];
#pragma unroll
            for (int ks = 0; ks < 2; ++ks) af[ks] = ld8(qtmp + (((lane & 7)) * 8 + h) * 72 + ks * 32 + 8 * (lane >> 4));
#pragma unroll 4
            for (int nt = 0; nt < 16; ++nt) { f32x4 acc = (f32x4){0.f, 0.f, 0.f, 0.f};
#pragma unroll
                for (int ks = 0; ks < 2; ++ks) acc = mfma16(af[ks], ld8(WUKB + (size_t)(nt * 16 + (lane & 15)) * 512 + h * 64 + ks * 32 + 8 * (lane >> 4)), acc);
                if ((lane >> 4) < 2) {
#pragma unroll
                    for (int r = 0; r < 4; ++r) Qs[(((lane >> 4) * 4 + r) * 8 + h) * 296 + nt * 16 + (lane & 15)] = (bf16)f2bf(acc[r] * QK_SCALE2); } }
        }
        __syncthreads();
        float mrun[4], lrun[4], alpha[4]; f32x4 o[16];
#pragma unroll
        for (int r = 0; r < 4; ++r) { mrun[r] = -INFINITY; lrun[r] = 0.f; }
#pragma unroll
        for (int nt = 0; nt < 16; ++nt) o[nt] = (f32x4){0.f, 0.f, 0.f, 0.f};
        const int t_begin = sp * TPS, t_end = t_begin + TPS + (sp == AS_NSP - 1 ? 1 : 0);
        const int NI = (t_end - t_begin + 1) / 2;
        static_assert(NPAGES <= 64, "page table of one batch row is held one entry per lane");
        const int ptv = lane < NPAGES ? ptab[b * NPAGES + lane] : 0;
#ifdef HIPEMU
#define PT_LOOKUP(pg_) __shfl(ptv, (pg_))
#else
#define PT_LOOKUP(pg_) __builtin_amdgcn_readlane(ptv, (pg_))
#endif
        f32x4 plA[8], prA, plB[8], prB;
        const float* nl = c.out + O_LATS + (size_t)b * DECS * 256; const float* nk = c.out + O_KPES + (size_t)b * DECS * 32;
#define AS_LOAD(pl, pr, tile_) do { const int tl_ = (tile_); \
            if (tl_ < NPT32) { const int k0_ = tl_ * 32; const size_t rb_ = (size_t)PT_LOOKUP(k0_ >> 7) * PAGE + (k0_ & 127); \
                _Pragma("unroll") for (int j = 0; j < 8; ++j) { const int idx = gt + 256 * j; pl[j] = NT_LOAD4(clat + (rb_ + (idx >> 6)) * 256 + 4 * (idx & 63)); } \
                pr = NT_LOAD4(ckr + (rb_ + (gt >> 3)) * 32 + 4 * (gt & 7)); } \
            else if (tl_ == NPT32) { \
                _Pragma("unroll") for (int j = 0; j < 8; ++j) { const int idx = gt + 256 * j, key = idx >> 6; pl[j] = key < DECS ? *(const f32x4*)(nl + key * 256 + 4 * (idx & 63)) : (f32x4){0.f, 0.f, 0.f, 0.f}; } \
                pr = (gt >> 3) < DECS ? *(const f32x4*)(nk + (gt >> 3) * 32 + 4 * (gt & 7)) : (f32x4){0.f, 0.f, 0.f, 0.f}; } } while (0)
#define AS_ITER(pl, pr, it_) do { \
            const int tile = t_begin + 2 * (it_) + grp; const bool valid = tile < t_end; \
            if (valid) { \
                _Pragma("unroll") for (int j = 0; j < 8; ++j) { const int idx = gt + 256 * j; u32x2 pk; pk.x = pk2(pl[j][0], pl[j][1]); pk.y = pk2(pl[j][2], pl[j][3]); *(u32x2*)(Kt + (idx >> 6) * 296 + 4 * (idx & 63)) = pk; } \
                { u32x2 pk; pk.x = pk2(pr[0], pr[1]); pk.y = pk2(pr[2], pr[3]); *(u32x2*)(Kt + (gt >> 3) * 296 + 256 + 4 * (gt & 7)) = pk; } \
            } \
            { const int nt_ = tile + 4; AS_LOAD(pl, pr, nt_ < t_end ? nt_ : NPT32 + 1); } \
            LDS_BARRIER(); \
            if (valid) { \
                f32x4 s[2], s2_[2]; \
                _Pragma("unroll") for (int nt = 0; nt < 2; ++nt) { s[nt] = (f32x4){0.f, 0.f, 0.f, 0.f}; s2_[nt] = (f32x4){0.f, 0.f, 0.f, 0.f}; } \
                _Pragma("unroll") for (int ks = 0; ks < 9; ++ks) {   \
                    const bf16x8 qa_ = ld8(Qs + (wq * 16 + (lane & 15)) * 296 + ks * 32 + 8 * (lane >> 4)); \
                    const bf16x8 k0_ = ld8(Kt + ((lane & 15)) * 296 + ks * 32 + 8 * (lane >> 4)), k1_ = ld8(Kt + (16 + (lane & 15)) * 296 + ks * 32 + 8 * (lane >> 4)); \
                    if (ks & 1) { s2_[0] = mfma16(qa_, k0_, s2_[0]); s2_[1] = mfma16(qa_, k1_, s2_[1]); } else { s[0] = mfma16(qa_, k0_, s[0]); s[1] = mfma16(qa_, k1_, s[1]); } } \
                s[0] += s2_[0]; s[1] += s2_[1]; \
                if (tile == NPT32) { \
                    _Pragma("unroll") for (int nt = 0; nt < 2; ++nt) \
                        _Pragma("unroll") for (int r = 0; r < 4; ++r) { const int row = wq * 16 + (lane >> 4) * 4 + r, key = nt * 16 + (lane & 15); if (key >= DECS || key > (row >> 3)) s[nt][r] = -INFINITY; } \
                } \
                softmax_rows<2>(s, mrun, lrun, alpha, Ps, 40, lane); \
                WAVE_SYNC(); \
                const bf16x8 pf = ld8(Ps + (lane & 15) * 40 + 8 * (lane >> 4)); \
                if (wave_any((alpha[0] != 1.f) | (alpha[1] != 1.f) | (alpha[2] != 1.f) | (alpha[3] != 1.f))) { \
                    _Pragma("unroll") for (int nt = 0; nt < 16; ++nt) \
                        _Pragma("unroll") for (int r = 0; r < 4; ++r) o[nt][r] *= alpha[r]; } \
                _Pragma("unroll") for (int nt = 0; nt < 16; ++nt) o[nt] = mfma16(pf, ldB_tr(Kt, 296, 0, nt * 16, lane), o[nt]); \
            } \
            LDS_BARRIER(); } while (0)
        AS_LOAD(plA, prA, t_begin + grp < t_end ? t_begin + grp : NPT32 + 1);
        AS_LOAD(plB, prB, t_begin + 2 + grp < t_end ? t_begin + 2 + grp : NPT32 + 1);
#pragma unroll 1
        for (int it = 0; it < NI; it += 2) {
            AS_ITER(plA, prA, it);
            if (it + 1 < NI) AS_ITER(plB, prB, it + 1);
        }
#undef AS_ITER
#undef PT_LOOKUP
#undef AS_LOAD
        int lane2 = lane; OPAQUE_V(lane2);
        if (grp == 1) {
#pragma unroll
            for (int nt = 0; nt < 16; ++nt)
#pragma unroll
                for (int r = 0; r < 4; ++r) Xo[(wq * 16 + (lane2 >> 4) * 4 + r) * 256 + nt * 16 + (lane2 & 15)] = o[nt][r];
            if ((lane2 & 15) == 0) {
#pragma unroll
                for (int r = 0; r < 4; ++r) { Xm[wq * 16 + (lane2 >> 4) * 4 + r] = mrun[r]; Xl[wq * 16 + (lane2 >> 4) * 4 + r] = lrun[r]; } }
        }
        __syncthreads();
        if (grp == 0) {
            float a1[4], a2[4];
#pragma unroll
            for (int r = 0; r < 4; ++r) { const int row = wq * 16 + (lane2 >> 4) * 4 + r; const float m2 = Xm[row], l2 = Xl[row]; const float mm = fmaxf(mrun[r], m2);
                a1[r] = exp2f_(mrun[r] - mm); a2[r] = exp2f_(m2 - mm); lrun[r] = lrun[r] * a1[r] + l2 * a2[r]; mrun[r] = mm;
                if ((lane2 & 15) == 0) { PM[(size_t)u * 64 + row] = mm; PL[(size_t)u * 64 + row] = lrun[r]; } }
#pragma unroll
            for (int nt = 0; nt < 16; ++nt)
#pragma unroll
                for (int r = 0; r < 4; ++r) { const int row = wq * 16 + (lane2 >> 4) * 4 + r, col = nt * 16 + (lane2 & 15); PO[((size_t)u * 64 + row) * 256 + col] = o[nt][r] * a1[r] + Xo[row * 256 + col] * a2[r]; }
        }
    }
}
DEV void phase_attn_sample_combine(const Ctx& c) {
    bf16* Ol = (bf16*)c.lds;
    const float* PO = c.w<float>(WS_PO); const float* PM = c.w<float>(WS_PM); const float* PL = c.w<float>(WS_PL);
    const bf16* WUV = c.w<bf16>(WS_WUKV) + (size_t)512 * 256; bf16* OCAT = c.w<bf16>(WS_OCAT);
    const int tid = c.tid, lane = c.lane, w = c.wave;
    for (int b = (int)gridDim.x - 1 - (int)blockIdx.x; b < DECB; b += gridDim.x) {
        const size_t mb = (size_t)MP + (size_t)b * DECS;
        __syncthreads();
        for (int idx = tid; idx < 64 * 64; idx += 512) { const int row = idx >> 6, c4 = idx & 63;
            float mm = -INFINITY;
#pragma unroll
            for (int s = 0; s < AS_NSP; ++s) mm = fmaxf(mm, PM[((size_t)b * AS_NSP + s) * 64 + row]);
            float lt = 0.f; f32x4 acc = (f32x4){0.f, 0.f, 0.f, 0.f};
#pragma unroll
            for (int s = 0; s < AS_NSP; ++s) { const size_t ur = ((size_t)b * AS_NSP + s) * 64 + row; const float a = exp2f_(PM[ur] - mm); lt += PL[ur] * a; acc += *(const f32x4*)(PO + ur * 256 + 4 * c4) * a; }
            const float inv = 1.f / lt; u32x2 o; o.x = pk2(acc[0] * inv, acc[1] * inv); o.y = pk2(acc[2] * inv, acc[3] * inv); *(u32x2*)(Ol + row * 264 + 4 * c4) = o; }
        __syncthreads();
        { const int h = w;
#pragma unroll
          for (int nt = 0; nt < 4; ++nt) { f32x4 acc = (f32x4){0.f, 0.f, 0.f, 0.f};
#pragma unroll
            for (int ks = 0; ks < 8; ++ks) acc = mfma16(ld8(Ol + ((lane & 7) * 8 + h) * 264 + ks * 32 + 8 * (lane >> 4)), ld8(WUV + (size_t)(h * 64 + nt * 16 + (lane & 15)) * 256 + ks * 32 + 8 * (lane >> 4)), acc);
            if ((lane >> 4) < 2) {
#pragma unroll
                for (int r = 0; r < 4; ++r) OCAT[(mb + (lane >> 4) * 4 + r) * D + 512 + h * 64 + nt * 16 + (lane & 15)] = (bf16)f2bf(acc[r]); } } }
    }
}

DEV bf16x8 cvt8(const f32x4 a, const f32x4 b, float sc) { bf16x8 r; const u32x4 p = {pk2(a[0] * sc, a[1] * sc), pk2(a[2] * sc, a[3] * sc), pk2(b[0] * sc, b[1] * sc), pk2(b[2] * sc, b[3] * sc)};
    r = __builtin_bit_cast(bf16x8, p); return r; }
DEV void phase_attn_prompt2(const Ctx& c, int qid = 0) {
    bf16* KV0 = (bf16*)c.lds;
    constexpr int KVB = 64 * 104 + 64 * 72;
    bf16* Psb = KV0 + 2 * KVB;
    const float* QH = c.w<float>(WS_QH); const bf16* KVP = c.w<bf16>(WS_KVP); const bf16* KPEB = c.w<bf16>(WS_KPEB); const float* rope = c.w<float>(WS_ROPE); bf16* OCAT = c.w<bf16>(WS_OCAT);
    const int tid = c.tid, lane = c.lane, w = c.wave;
    bf16* Ps = Psb + w * 32 * 72;
    constexpr int NQB = SEQ / 256, NPU = NQB * BATCH * 8;
    for (;;) {
        const int pu = queue_next(c, qid);
        if (pu >= NPU) break;
        const int qb = NQB - 1 - pu / (BATCH * 8), bh = pu % (BATCH * 8), b = bh >> 3, h = bh & 7; const size_t mb = (size_t)b * SEQ;
        {
            const int q0 = qb * 256, rmin = q0 + 32 * w;
            bf16x8 qf[2][3];
#pragma unroll
            for (int mt = 0; mt < 2; ++mt) { const int qr = rmin + 16 * mt + (lane & 15); const float* qrow = QH + (mb + qr) * 768 + h * 96; const int g = lane >> 4;
#pragma unroll
                for (int ks = 0; ks < 2; ++ks) qf[mt][ks] = cvt8(*(const f32x4*)(qrow + ks * 32 + 8 * g), *(const f32x4*)(qrow + ks * 32 + 8 * g + 4), QK_SCALE2);
                const int f0 = 8 * (g & 1); const float* rt = rope + (size_t)qr * 32;
                const f32x4 x1a = *(const f32x4*)(qrow + 64 + f0), x1b = *(const f32x4*)(qrow + 64 + f0 + 4), x2a = *(const f32x4*)(qrow + 80 + f0), x2b = *(const f32x4*)(qrow + 80 + f0 + 4);
                const f32x4 ca = *(const f32x4*)(rt + f0), cb = *(const f32x4*)(rt + f0 + 4), sa = *(const f32x4*)(rt + 16 + f0), sb = *(const f32x4*)(rt + 16 + f0 + 4);
                const f32x4 ya = g < 2 ? x1a * ca - x2a * sa : x2a * ca + x1a * sa, yb = g < 2 ? x1b * cb - x2b * sb : x2b * cb + x1b * sb;
                qf[mt][2] = cvt8(ya, yb, QK_SCALE2); }
            float mrun[2][4], lrun[2][4], alpha[2][4]; f32x4 o[2][4];
#pragma unroll
            for (int mt = 0; mt < 2; ++mt) {
#pragma unroll
                for (int r = 0; r < 4; ++r) { mrun[mt][r] = -INFINITY; lrun[mt][r] = 0.f; }
#pragma unroll
                for (int nt = 0; nt < 4; ++nt) o[mt][nt] = (f32x4){0.f, 0.f, 0.f, 0.f}; }
            const int nkt = 4 * qb + 4;
            u32x4 pk_, pp_, pv_;
#define AP_LOAD(kt_) do { const size_t kr_ = mb + (size_t)(kt_) * 64; \
                pk_ = *(const u32x4*)(KVP + (kr_ + (tid >> 3)) * 1024 + h * 64 + (tid & 7) * 8); \
                pv_ = *(const u32x4*)(KVP + (kr_ + (tid >> 3)) * 1024 + 512 + h * 64 + (tid & 7) * 8); \
                if (tid < 256) pp_ = *(const u32x4*)(KPEB + (kr_ + (tid >> 2)) * 32 + (tid & 3) * 8); } while (0)
#define AP_STORE(buf_) do { bf16* Kb_ = KV0 + (buf_) * KVB; bf16* Vb_ = Kb_ + 64 * 104; \
                *(u32x4*)(Kb_ + (tid >> 3) * 104 + (tid & 7) * 8) = pk_; *(u32x4*)(Vb_ + (tid >> 3) * 72 + (tid & 7) * 8) = pv_; \
                if (tid < 256) *(u32x4*)(Kb_ + (tid >> 2) * 104 + 64 + (tid & 3) * 8) = pp_; } while (0)
            __syncthreads();
            AP_LOAD(0); AP_STORE(0);
            if (nkt > 1) AP_LOAD(1);
            __syncthreads();
            for (int kt = 0; kt < nkt; ++kt) {
                const bf16* Ks = KV0 + (kt & 1) * KVB; const bf16* Vs = Ks + 64 * 104;
                if (kt + 1 < nkt) AP_STORE((kt + 1) & 1);
                if (kt + 2 < nkt) AP_LOAD(kt + 2);
                const int k0 = kt * 64;
                if (k0 <= rmin + 31) {
                    f32x4 s[2][4];
#pragma unroll
                    for (int nt = 0; nt < 4; ++nt) { s[0][nt] = (f32x4){0.f, 0.f, 0.f, 0.f}; s[1][nt] = (f32x4){0.f, 0.f, 0.f, 0.f}; }
#pragma unroll
                    for (int ks = 0; ks < 3; ++ks) {
                        bf16x8 kf[4];
#pragma unroll
                        for (int nt = 0; nt < 4; ++nt) kf[nt] = ld8(Ks + (nt * 16 + (lane & 15)) * 104 + ks * 32 + 8 * (lane >> 4));
#pragma unroll
                        for (int nt = 0; nt < 4; ++nt) { s[0][nt] = mfma16(qf[0][ks], kf[nt], s[0][nt]); s[1][nt] = mfma16(qf[1][ks], kf[nt], s[1][nt]); } }
                    if (k0 + 63 > rmin) {
#pragma unroll
                        for (int mt = 0; mt < 2; ++mt)
#pragma unroll
                            for (int nt = 0; nt < 4; ++nt)
#pragma unroll
                                for (int r = 0; r < 4; ++r) { const int qpos = rmin + 16 * mt + (lane >> 4) * 4 + r, kpos = k0 + nt * 16 + (lane & 15); if (kpos > qpos) s[mt][nt][r] = -INFINITY; }
                    }
                    softmax_rows<4>(s[0], mrun[0], lrun[0], alpha[0], Ps, 72, lane);
                    softmax_rows<4>(s[1], mrun[1], lrun[1], alpha[1], Ps + 16 * 72, 72, lane);
                    WAVE_SYNC();
                    if (wave_any((alpha[0][0] != 1.f) | (alpha[0][1] != 1.f) | (alpha[0][2] != 1.f) | (alpha[0][3] != 1.f) | (alpha[1][0] != 1.f) | (alpha[1][1] != 1.f) | (alpha[1][2] != 1.f) | (alpha[1][3] != 1.f))) {
#pragma unroll
                    for (int mt = 0; mt < 2; ++mt)
#pragma unroll
                        for (int nt = 0; nt < 4; ++nt)
#pragma unroll
                            for (int r = 0; r < 4; ++r) o[mt][nt][r] *= alpha[mt][r]; }
#pragma unroll
                    for (int k2 = 0; k2 < 2; ++k2) { const bf16x8 p0 = ld8(Ps + (lane & 15) * 72 + k2 * 32 + 8 * (lane >> 4)), p1 = ld8(Ps + (16 + (lane & 15)) * 72 + k2 * 32 + 8 * (lane >> 4));
                        bf16x8 vf[4];
#pragma unroll
                        for (int nt = 0; nt < 4; ++nt) vf[nt] = ldB_tr(Vs, 72, k2 * 32, nt * 16, lane);
#pragma unroll
                        for (int nt = 0; nt < 4; ++nt) { o[0][nt] = mfma16(p0, vf[nt], o[0][nt]); o[1][nt] = mfma16(p1, vf[nt], o[1][nt]); } }
                    WAVE_SYNC();
                }
                LDS_BARRIER();
            }
#undef AP_LOAD
#undef AP_STORE
#pragma unroll
            for (int mt = 0; mt < 2; ++mt)
#pragma unroll
                for (int nt = 0; nt < 4; ++nt)
#pragma unroll
                    for (int r = 0; r < 4; ++r) OCAT[(mb + rmin + 16 * mt + (lane >> 4) * 4 + r) * D + 512 + h * 64 + nt * 16 + (lane & 15)] = (bf16)f2bf(o[mt][nt][r] / lrun[mt][r]);
        }
    }
}

DEV void phase_gdn_sample(const Ctx& c, int wg_first, int wg_stride) {
    float* red = (float*)c.lds; float* red2 = red + 512; float* qs = red2 + 512; float* ks = qs + 128; float* vs = ks + 128; float* part = vs + 128;
    float* scb = part + 8; float* scg = scb + 8; float* obuf = scg + 8;
    const bf16* P1 = c.w<bf16>(WS_P1); bf16* OCAT = c.w<bf16>(WS_OCAT);
    const float* convw = c.in<float>(14); const float* gn = c.in<float>(17);
    const int tid = c.tid, lane = c.lane, wave = c.wave;
    const int e = tid & 127, dg = tid >> 7, d0 = dg * 32;
    for (int u = wg_first; u < DECB * 4; u += wg_stride) {
        const int b = u >> 2, h = u & 3; const size_t m0 = (size_t)MP + (size_t)b * DECS;
        float s[32];
        { const float* S0 = c.in<float>(2) + ((size_t)(b * 4 + h) * 128 + d0) * 128 + e;
#pragma unroll
          for (int i = 0; i < 32; ++i) s[i] = S0[(size_t)i * 128]; }
        const int col = tid < 128 ? h * 128 + tid : (tid < 256 ? 512 + h * 128 + (tid - 128) : 1024 + h * 128 + (tid - 256));
        float w0 = 0.f, w1 = 0.f, w2 = 0.f, w3 = 0.f, x0 = 0.f, x1 = 0.f, x2 = 0.f; bf16 xs[8];
#pragma unroll
        for (int t = 0; t < 8; ++t) xs[t] = 0;
        if (tid < 384) { w0 = convw[col]; w1 = convw[QKV_A + col]; w2 = convw[2 * QKV_A + col]; w3 = convw[3 * QKV_A + col];
            const float* cb = c.in<float>(3) + (size_t)b * 3 * QKV_A + col; x0 = cb[0]; x1 = cb[QKV_A]; x2 = cb[2 * QKV_A];
#pragma unroll
            for (int t = 0; t < 8; ++t) xs[t] = P1[(m0 + t) * LD1 + col]; }
        else if (tid < 392) { const int t = tid - 384; const float Aexp = __expf(c.in<float>(15)[h]), dtb = c.in<float>(16)[h];
            scb[t] = sigmoidf_(bf2f(P1[(m0 + t) * LD1 + C_B + h])); scg[t] = __expf(-Aexp * softplusf_(bf2f(P1[(m0 + t) * LD1 + C_A + h]) + dtb)); }
        const bf16 zr0 = P1[(m0 + wave) * LD1 + C_Z + h * 128 + lane], zr1 = P1[(m0 + wave) * LD1 + C_Z + h * 128 + 64 + lane];
#pragma unroll
        for (int t = 0; t < 8; ++t) {
            float val = 0.f;
            if (tid < 384) { const float x3 = bf2f(xs[t]); const float y = w0 * x0 + w1 * x1 + w2 * x2 + w3 * x3; val = siluf_(y); x0 = x1; x1 = x2; x2 = x3; }
            const float sq = wave_sum(tid < 256 ? val * val : 0.f);
            if (tid < 128) qs[tid] = val; else if (tid < 256) ks[tid - 128] = val; else if (tid < 384) vs[tid - 256] = val;
            if (lane == 0 && wave < 4) part[wave] = sq;
            LDS_BARRIER();
            const float qn = rsqrtf(part[0] + part[1] + EPS), kn = rsqrtf(part[2] + part[3] + EPS), beta = scb[t], dec = scg[t];
            float kp = 0.f;
#pragma unroll
            for (int i = 0; i < 32; ++i) { s[i] *= dec; kp += ks[d0 + i] * s[i]; }
            red[dg * 128 + e] = kp * kn;
            LDS_BARRIER();
            const float kS = (red[e] + red[128 + e]) + (red[256 + e] + red[384 + e]);
            const float delta = beta * (vs[e] - kS) * kn;
            float op = 0.f;
#pragma unroll
            for (int i = 0; i < 32; ++i) { s[i] += ks[d0 + i] * delta; op += qs[d0 + i] * s[i]; }
            red2[dg * 128 + e] = op * qn;
            LDS_BARRIER();
            if (dg == 0) obuf[t * 128 + e] = ((red2[e] + red2[128 + e]) + (red2[256 + e] + red2[384 + e])) * DK_SCALE;
        }
        float* So = c.out + O_GDNS + ((size_t)(b * 4 + h) * 128 + d0) * 128 + e;
#pragma unroll
        for (int i = 0; i < 32; ++i) So[(size_t)i * 128] = s[i];
        LDS_BARRIER();
        {
            const size_t m = m0 + wave; const float v0 = obuf[wave * 128 + lane], v1 = obuf[wave * 128 + 64 + lane];
            const float r = rsqrtf(wave_sum(v0 * v0 + v1 * v1) * (1.f / 128.f) + EPS);
            OCAT[m * D + h * 128 + lane] = (bf16)f2bf(v0 * r * gn[lane] * siluf_(bf2f(zr0)));
            OCAT[m * D + h * 128 + 64 + lane] = (bf16)f2bf(v1 * r * gn[64 + lane] * siluf_(bf2f(zr1))); }
        LDS_BARRIER();
    }
}
DEV void phase_hgrn_sample(const Ctx& c, int wg_first, int wg_stride) {
    float* red = (float*)c.lds; float* qs = red + 512; float* fs = qs + 128; float* obuf = fs + 128;
    const bf16* PC = c.w<bf16>(WS_P1); bf16* OC = c.w<bf16>(WS_OCAT);
    const float* lbl = c.in<float>(25); const float* gn = c.in<float>(26);
    const int tid = c.tid, lane = c.lane, wave = c.wave;
    const int e = tid & 127, dg = tid >> 7, d0 = dg * 32;
    for (int u = wg_first; u < DECB * 8; u += wg_stride) {
        const int b = u >> 3, h = u & 7; const size_t m0 = (size_t)MP + (size_t)b * DECS;
        float s[32];
        { const float* S0 = c.in<float>(6) + ((size_t)(b * 8 + h) * 128 + d0) * 128 + e;
#pragma unroll
          for (int i = 0; i < 32; ++i) s[i] = S0[(size_t)i * 128]; }
        bf16 rq[8], rf[8], rv[8]; float lb = 0.f;
#pragma unroll
        for (int t = 0; t < 8; ++t) { rq[t] = 0; rf[t] = 0; rv[t] = PC[(m0 + t) * INC + 2048 + h * 128 + e]; }
        if (tid < 128) { lb = sigmoidf_(lbl[1024 + h * 128 + tid] - lbl[h * 128 + tid]);
#pragma unroll
            for (int t = 0; t < 8; ++t) { rq[t] = PC[(m0 + t) * INC + h * 128 + tid]; rf[t] = PC[(m0 + t) * INC + 1024 + h * 128 + tid]; } }
        const bf16 zr0 = PC[(m0 + wave) * INC + 3072 + h * 128 + lane], zr1 = PC[(m0 + wave) * INC + 3072 + h * 128 + 64 + lane];
#pragma unroll
        for (int t = 0; t < 8; ++t) {
            if (tid < 128) { qs[tid] = siluf_(bf2f(rq[t])); fs[tid] = lb + (1.f - lb) * sigmoidf_(bf2f(rf[t])); }
            const float v = bf2f(rv[t]);
            LDS_BARRIER();
            float op = 0.f;
#pragma unroll
            for (int i = 0; i < 32; ++i) { const float f = fs[d0 + i]; s[i] = f * s[i] + (1.f - f) * v; op += qs[d0 + i] * s[i]; }
            red[dg * 128 + e] = op;
            LDS_BARRIER();
            if (dg == 0) obuf[t * 128 + e] = ((red[e] + red[128 + e]) + (red[256 + e] + red[384 + e])) * DK_SCALE;
        }
        float* So = c.out + O_HGS + ((size_t)(b * 8 + h) * 128 + d0) * 128 + e;
#pragma unroll
        for (int i = 0; i < 32; ++i) So[(size_t)i * 128] = s[i];
        LDS_BARRIER();
        { const size_t m = m0 + wave; const float v0 = obuf[wave * 128 + lane], v1 = obuf[wave * 128 + 64 + lane];
          const float r = rsqrtf(wave_sum(v0 * v0 + v1 * v1) * (1.f / 128.f) + EPS);
          OC[m * D + h * 128 + lane] = (bf16)f2bf(v0 * r * gn[lane] * siluf_(bf2f(zr0)));
          OC[m * D + h * 128 + 64 + lane] = (bf16)f2bf(v1 * r * gn[64 + lane] * siluf_(bf2f(zr1))); }
        LDS_BARRIER();
    }
}

#ifndef HIPEMU
#define XB_TMO      128
#define XB_XCNT(j)  (256  + 64 * (j))
#define XB_XSUB(j)  (1280 + 64 * (j))
#define XB_XGEN(j)  (2304 + 64 * (j))
#define XB_TOP      3328
#define XB_TOPGEN   3392
#define XCD_BAR_WORDS 3456
#define XB_SPIN_CAP (1u << 22)
#define LAS __attribute__((address_space(3)))
__device__ __forceinline__ unsigned xb_ld(unsigned* p)              { return __hip_atomic_load(p, __ATOMIC_RELAXED, __HIP_MEMORY_SCOPE_AGENT); }
__device__ __forceinline__ unsigned xb_add(unsigned* p, unsigned v) { return __hip_atomic_fetch_add(p, v, __ATOMIC_RELAXED, __HIP_MEMORY_SCOPE_AGENT); }
__device__ __forceinline__ unsigned xb_xcc_id() { return (unsigned)__builtin_amdgcn_s_getreg((3 << 11) | 20) & 0xFu; }
#define XB_SPIN(cond, bar) do { unsigned _sp = 0; while (cond) { __builtin_amdgcn_s_sleep(1); \
    if ((++_sp & 255u) == 0u) { if (xb_ld(&(bar)[XB_TMO])) break; if (_sp > XB_SPIN_CAP) { atomicAdd(&(bar)[XB_TMO], 1u); break; } } } } while (0)
struct XcdBarrier { unsigned* bar; unsigned x; volatile LAS unsigned* st; bool t0; };
__device__ __forceinline__ XcdBarrier xcd_barrier_post(unsigned* bar, volatile LAS unsigned* st, bool t0) {
    XcdBarrier b; b.bar = bar; b.x = xb_xcc_id(); b.st = st; b.t0 = t0;
    if (t0) (void)xb_add(&bar[XB_XCNT(b.x)], 1u);
    return b;
}
__device__ __forceinline__ void xcd_barrier_complete(unsigned* bar, unsigned x, unsigned& nloc, unsigned& nx) {
    const unsigned G = gridDim.x * gridDim.y * gridDim.z;
    unsigned sum, cnt, mine, sp = 0u;
    for (;;) {
        sum = 0u; cnt = 0u; mine = 0u;
#pragma unroll
        for (unsigned j = 0; j < 16; ++j) { const unsigned c = xb_ld(&bar[XB_XCNT(j)]); sum += c; cnt += (c > 0u) ? 1u : 0u; mine = (j == x) ? c : mine; }
        if (sum == G) break;
        __builtin_amdgcn_s_sleep(1);
        if ((++sp & 255u) == 0u) { if (xb_ld(&bar[XB_TMO])) break; if (sp > XB_SPIN_CAP) { atomicAdd(&bar[XB_TMO], 1u); break; } }
    }
    nloc = mine > 0u ? mine : 1u; nx = cnt > 0u ? cnt : 1u;
}
__device__ __forceinline__ void xcd_barrier(const XcdBarrier& b) {
    asm volatile("s_waitcnt vmcnt(0)" ::: "memory");
    __syncthreads();
    if (b.t0) {
        unsigned* bar = b.bar;
        __builtin_amdgcn_s_waitcnt(0);
        unsigned nloc = b.st[0], nx = b.st[1];
        if (nloc == 0u) { xcd_barrier_complete(bar, b.x, nloc, nx); b.st[0] = nloc; b.st[1] = nx; }
        const unsigned old = xb_add(&bar[XB_XSUB(b.x)], 1u);
        const unsigned gen = old / nloc;
        if (old + 1u == (gen + 1u) * nloc) {
            __builtin_amdgcn_fence(__ATOMIC_RELEASE, "agent");
            asm volatile("s_waitcnt vmcnt(0)" ::: "memory");
            const unsigned og = xb_add(&bar[XB_TOP], 1u);
            const unsigned tg = og / nx;
            if (og + 1u == (tg + 1u) * nx) xb_add(&bar[XB_TOPGEN], 1u);
            else XB_SPIN(xb_ld(&bar[XB_TOPGEN]) == tg, bar);
            __builtin_amdgcn_fence(__ATOMIC_ACQUIRE, "agent");
            xb_add(&bar[XB_XGEN(b.x)], 1u);
            asm volatile("s_waitcnt vmcnt(0)" ::: "memory");
        } else {
            XB_SPIN(xb_ld(&bar[XB_XGEN(b.x)]) == gen, bar);
            __builtin_amdgcn_fence(__ATOMIC_ACQUIRE, "agent");
            asm volatile("s_waitcnt vmcnt(0)" ::: "memory");
        }
    }
    __syncthreads();
}
#endif

__global__ void __launch_bounds__(512, 2) mega_kernel(Params p) {
#ifdef HIPEMU
    unsigned char* lds = g_blk->smem;
#else
    extern __shared__ __attribute__((aligned(16))) unsigned char lds[];
#endif
    const int lo = p.ph_lo, hi = p.ph_hi;
#ifdef HIPEMU
    const int wave_s = threadIdx.x >> 6;
#define FRESH_LANE() ((int)(threadIdx.x & 63))
#define GRID_BAR(k) do { } while (0)
#else
    const int wave_s = __builtin_amdgcn_readfirstlane(threadIdx.x >> 6);
#define FRESH_LANE() ({ int l_; asm volatile("v_mbcnt_lo_u32_b32 %0, -1, 0\n\tv_mbcnt_hi_u32_b32 %0, -1, %0" : "=v"(l_)); l_; })
    { const int l0 = FRESH_LANE(); if (wave_s == 0) ((volatile LAS unsigned*)(lds + LDS_MISC))[l0] = 0u; }
    __syncthreads();
    if (hi - lo > 1) (void)xcd_barrier_post((unsigned*)(p.ws + WS_CTL), (volatile LAS unsigned*)(lds + LDS_MISC), wave_s == 0 && FRESH_LANE() == 0);
#define GRID_BAR(k) do { if (lo <= (k) && (k) + 1 < hi) { XcdBarrier bb_; bb_.bar = (unsigned*)(p.ws + WS_CTL); bb_.x = xb_xcc_id(); bb_.st = (volatile LAS unsigned*)(lds + LDS_MISC); bb_.t0 = (wave_s == 0 && FRESH_LANE() == 0); xcd_barrier(bb_); } } while (0)
#endif
#define MKCTX() Ctx c; c.p = &p; c.lds = lds; c.ws = p.ws; c.out = p.out; c.wave = wave_s; c.lane = FRESH_LANE(); c.tid = wave_s * 64 + c.lane; c.gw = blockIdx.x * 8 + wave_s; c.ngw = gridDim.x * 8;
#define IN(k) (lo <= (k) && (k) < hi)
#ifndef PROBE_MASK
#define PROBE_MASK 0u
#endif
#define NREP(k) (((PROBE_MASK >> (k)) & 1u) ? 2 : 1)
#ifndef PROBE_SUB
#define PROBE_SUB 0
#endif
#define SUB(id, ...) { MKCTX() __VA_ARGS__ } if (PROBE_SUB == (id)) { __syncthreads(); MKCTX() __VA_ARGS__ }
#define PHASE(k, ...) if (IN(k)) { { const int rep_ = 0; (void)rep_; MKCTX() __VA_ARGS__ } if (NREP(k) == 2) { const int rep_ = 1; (void)rep_; MKCTX() __VA_ARGS__ } }
#define X1 c.w<float>(WS_X1)
#define X2 c.w<float>(WS_X2)
#define P1 c.w<float>(WS_P1)
#define XN c.w<bf16>(WS_XN)
#define Hb c.w<bf16>(WS_H)
#define OCAT c.w<bf16>(WS_OCAT)

    PHASE(0,  phase_prologue(c); GRID_BAR(0); )
    PHASE(1,  run_gemm(c, XN, c.w<bf16>(WS_WINAB), M, LD1, D, EpiBf16<0>{c.w<bf16>(WS_P1), LD1}); GRID_BAR(1); )
    PHASE(2,  phase_prep0(c); GRID_BAR(2); )
    PHASE(3,          { run_gemm(c, c.w<bf16>(WS_CQN), c.w<bf16>(WS_WUQ), M, 768, 256, EpiStoreF32{c.w<float>(WS_QH), 768}); } { MKCTX() run_gemm(c, c.w<bf16>(WS_LATN), c.w<bf16>(WS_WUKV), MP, 1024, 256, EpiBf16<0>{c.w<bf16>(WS_KVP), 1024}); }         GRID_BAR(3); )
    PHASE(4,  { if ((blockIdx.x & 1) == 0) { MKCTX() phase_attn_sample2(c); } } __syncthreads(); { MKCTX() phase_gdn_prep(c); } __syncthreads();
               { if ((blockIdx.x & 1) != 0) { MKCTX() phase_attn_sample2(c); } } GRID_BAR(4); )
    PHASE(5,  SUB(4, phase_gdn_scan(c, blockIdx.x, gridDim.x);) __syncthreads(); SUB(5, phase_attn_sample_combine(c);) __syncthreads(); { MKCTX() phase_attn_prompt2(c, rep_ ? 6 : 0); } if (PROBE_SUB == 6) { __syncthreads(); MKCTX() phase_attn_prompt2(c, 5); } __syncthreads();
               SUB(9, const int NS_ = BATCH * 4; const int G_ = (int)gridDim.x; if (G_ > NS_ + 32) { if ((int)blockIdx.x >= NS_) { phase_gdn_sample(c, (int)blockIdx.x - NS_, G_ - NS_); } } else { phase_gdn_sample(c, (int)blockIdx.x, G_); }) __syncthreads();
               SUB(10, const int NS_ = BATCH * 4; const int G_ = (int)gridDim.x; if (G_ > NS_ + 32) { if ((int)blockIdx.x >= NS_) { phase_convert_late(c, c.gw - NS_ * 8, c.ngw - NS_ * 8); } } else { phase_convert_late(c, c.gw, c.ngw); }) GRID_BAR(5); )
    PHASE(6,  { run_gemm(c, OCAT, c.w<bf16>(WS_WOAB), MP, D, D, EpiResidF32{nullptr, c.in<float>(0), c.in<float>(1), X1}); } { MKCTX() run_gemm_sample_splitk(c, OCAT, c.w<bf16>(WS_WOAB), D, 256); } GRID_BAR(6); )
    PHASE(7,  phase_rmsnorm(c, X1, c.in<float>(9), nullptr, 4); GRID_BAR(7); )
    PHASE(8,  { run_gemm(c, XN, c.w<bf16>(WS_WUP0), M, FF, D, EpiBf16<1>{Hb, FF}); } __syncthreads();
               { MKCTX() const int NB_ = (M / 256 * (FF / 256)) % (int)gridDim.x, G_ = (int)gridDim.x;
                 if (NB_ > 0 && G_ - NB_ >= 32) { if ((int)blockIdx.x >= NB_) phase_convert_late2(c, c.gw - NB_ * 8, c.ngw - NB_ * 8); } else phase_convert_late2(c, c.gw, c.ngw); } GRID_BAR(8); )
    PHASE(9,  { run_gemm(c, Hb, c.w<bf16>(WS_WDN0), MP, D, FF, EpiResidF32{X1, nullptr, nullptr, X2}); } { MKCTX() run_gemm_sample_splitk(c, Hb, c.w<bf16>(WS_WDN0), FF, 256); } GRID_BAR(9); )
    PHASE(10,  phase_rmsnorm(c, X2, c.in<float>(8) + D, X1, 16); GRID_BAR(10); )
    PHASE(11,  run_gemm(c, XN, c.w<bf16>(WS_WINC), M, INC, D, EpiBf16<0>{c.w<bf16>(WS_P1), INC}); GRID_BAR(11); )
    PHASE(12,  SUB(7, phase_hgrn_prep(c);) GRID_BAR(12); )
    PHASE(13,  phase_hgrn_prefix(c); __syncthreads(); SUB(8, phase_hgrn_sample(c, (int)blockIdx.x, (int)gridDim.x);) GRID_BAR(13); )
    PHASE(14,  phase_hgrn_out(c); GRID_BAR(14); )
    PHASE(15,  { run_gemm(c, OCAT, c.w<bf16>(WS_WOC), MP, D, D, EpiResidF32{X2, nullptr, nullptr, X1}); } { MKCTX() run_gemm_sample_splitk(c, OCAT, c.w<bf16>(WS_WOC), D, 256); } GRID_BAR(15); )
    PHASE(16,  phase_rmsnorm(c, X1, c.in<float>(9) + D, X2, 4); GRID_BAR(16); )
    PHASE(17,  run_gemm(c, XN, c.w<bf16>(WS_WUP1), M, FF, D, EpiBf16<1>{Hb, FF}); GRID_BAR(17); )
    PHASE(18,  { run_gemm(c, Hb, c.w<bf16>(WS_WDN1), MP, D, FF, EpiResidF32{X1, nullptr, nullptr, X2}); } { MKCTX() run_gemm_sample_splitk(c, Hb, c.w<bf16>(WS_WDN1), FF, 256); } GRID_BAR(18); )
    PHASE(19,  phase_final(c, X2, c.in<float>(10), X1, 16); )
#undef IN
#undef X1
#undef X2
#undef P1
#undef XN
#undef Hb
#undef OCAT
}

#ifndef HIPEMU
extern "C" void kernel_launch(void* const* d_in, const int* in_sizes, int n_in, void* d_out, int out_size, void* d_ws, size_t ws_size, hipStream_t stream) {
    static int grid = 0;
    if (grid == 0) {
        if (n_in != 28 || (size_t)out_size != O_END || ws_size < WS_END) { fprintf(stderr, "kernel_launch: shape mismatch n_in %d out %d (want %zu) ws %zu (want %zu)\n", n_in, out_size, (size_t)O_END, ws_size, (size_t)WS_END); grid = -1; return; }
        int dev = 0, cus = 0, per_cu = 0;
        hipGetDevice(&dev); hipDeviceGetAttribute(&cus, hipDeviceAttributeMultiprocessorCount, dev);
        if (hipFuncSetAttribute((const void*)mega_kernel, hipFuncAttributeMaxDynamicSharedMemorySize, LDS_BYTES) != hipSuccess) { fprintf(stderr, "kernel_launch: hipFuncSetAttribute failed\n"); grid = -1; return; }
        if (hipOccupancyMaxActiveBlocksPerMultiprocessor(&per_cu, (const void*)mega_kernel, 512, LDS_BYTES) != hipSuccess || per_cu < 1) fprintf(stderr, "kernel_launch: occupancy query reports %d\n", per_cu);
        (void)hipGetLastError();
        grid = cus;
    }
    if (grid < 0) return;
    hipMemsetAsync((char*)d_ws + WS_CTL, 0, CTL_BYTES, stream);
    Params p{};
    for (int i = 0; i < 28; ++i) p.in[i] = d_in[i];
    p.out = (float*)d_out; p.ws = (unsigned char*)d_ws;
#if MK_N_LAUNCHES == 1
    p.ph_lo = 0; p.ph_hi = NPHASE;
    hipLaunchKernelGGL(mega_kernel, dim3(grid), dim3(512), LDS_BYTES, stream, p);
#else
    for (int k = 0; k < NPHASE; ++k) { p.ph_lo = k; p.ph_hi = k + 1; hipLaunchKernelGGL(mega_kernel, dim3(grid), dim3(512), LDS_BYTES, stream, p); }
#endif
}
#else
size_t emu_ws_bytes() { return WS_END; }
size_t emu_out_floats() { return O_END; }
void emu_forward(void* const* d_in, float* d_out, unsigned char* d_ws, int grid, int ph_from, int ph_to) {
    memset(d_ws + WS_CTL, 0, CTL_BYTES);
    Params p{};
    for (int i = 0; i < 28; ++i) p.in[i] = d_in[i];
    p.out = d_out; p.ws = d_ws;
    for (int k = ph_from; k < ph_to && k < NPHASE; ++k) { p.ph_lo = k; p.ph_hi = k + 1; fprintf(stderr, "[emu] phase %d\n", k); emu_launch(grid, 512, LDS_BYTES, [=]() { mega_kernel(p); }); }
}
struct EmuBuf { const char* name; size_t off; size_t bytes; int kind;   int ld; };
extern const EmuBuf emu_bufs[] = {
    {"P1", WS_P1, (size_t)M * 4096 * 4, 0, LD1}, {"XN", WS_XN, (size_t)M * D * 2, 1, D}, {"QH", WS_QH, (size_t)M * 768 * 4, 0, 768}, {"KVP", WS_KVP, (size_t)MP * 1024 * 2, 1, 1024},
    {"OCAT", WS_OCAT, (size_t)M * D * 2, 1, D}, {"ORAW", WS_ORAW, (size_t)M * D * 4, 0, D}, {"X1", WS_X1, (size_t)M * D * 4, 0, D}, {"X2", WS_X2, (size_t)M * D * 4, 0, D},
    {"H", WS_H, (size_t)M * FF * 2, 1, FF}, {"CQN", WS_CQN, (size_t)M * 256 * 2, 1, 256}, {"LATN", WS_LATN, (size_t)M * 256 * 2, 1, 256}, {nullptr, 0, 0, 0, 0}};
extern const int emu_cfg[8] = {BATCH, SEQ, DECB, PAST, MP, MS, MT, M};
#endif
```

```cpp
#ifdef HIPEMU
#include "hipemu.h"
#else
#include <hip/hip_runtime.h>
#endif
#include <cstdio>
#include <cstdint>

#ifndef CFG_BATCH
#define CFG_BATCH 8
#define CFG_SEQ 2048
#define CFG_DEC_BATCH 128
#define CFG_PAST_LEN 8192
#endif
#ifndef MK_N_LAUNCHES
#define MK_N_LAUNCHES 1
#endif

#define DEV __device__ __forceinline__
namespace pg8 {
#define PG8_LAS __attribute__((address_space(3)))
typedef unsigned short bf16_t;
typedef short bf16x8 __attribute__((ext_vector_type(8)));
typedef float f32x4 __attribute__((ext_vector_type(4)));
typedef unsigned u32x4 __attribute__((ext_vector_type(4)));
constexpr int BM = 256, BK = 64, HALF = 128, HTB = HALF * BK * 2  , STAGE_BYTES = 8 * HTB, NXCD = 8, WGM = 8;

__host__ __device__ __forceinline__ int lds_byte(int r, int c) { const int st = (r >> 4) * 2 + (c >> 5), rr = r & 15, cc = c & 31, ob = rr * 64 + cc * 2; return st * 1024 + (ob ^ (((ob >> 9) & 1) << 5)); }
__host__ __device__ __forceinline__ void stage_rc(int b, int& R, int& C) { const int st = b / 1024, sb = b % 1024, swz = sb ^ (((sb >> 9) & 1) << 5); R = (st >> 1) * 16 + swz / 64; C = (st & 1) * 32 + (swz % 64) / 2; }
__host__ __device__ __forceinline__ int perm32(int rho) { const int n = rho >> 4, i = rho & 15; return 8 * (i >> 2) + 4 * n + (i & 3); }

struct Unit { int pm, pn, kb; };
struct Gemm { const bf16_t* A; const bf16_t* Bt; int M, N, K, ld; };

struct StaticOrder {
    int nM, nN, nwg, G, c;
    __host__ __device__ void init(int M, int N, int G_, int c_) { nM = M / BM; nN = N / BM; nwg = nM * nN; G = G_; c = c_; }
    __host__ __device__ bool next(int i, Unit& u) const {
        const long L = (long)i * G + c; if (L >= nwg) return false;
        int wgid = (int)L; { const int q = nwg / NXCD, r = nwg % NXCD, xcd = wgid % NXCD, off = wgid / NXCD; wgid = (xcd < r ? xcd * (q + 1) : r * (q + 1) + (xcd - r) * q) + off; }
        const int nig = WGM * nN, gid = wgid / nig, fm = gid * WGM, gsz = (nM - fm) < WGM ? (nM - fm) : WGM;
        u.pm = fm + ((wgid % nig) % gsz); u.pn = (wgid % nig) / gsz; u.kb = 0; return true;
    }
    __device__ __forceinline__ void a_ready(const Unit&) const {}
    __device__ __forceinline__ void done(const Unit&) const {}
};

#ifndef HIPEMU
template <class Epi, class Sched, bool ALIGN_EPI = false, bool SP2 = false>
__device__ __forceinline__ void gemm_phase(PG8_LAS unsigned char* lds, const Gemm g, const Sched& S, const Epi& E, const int wid_in, const int lane_in) {
    const int wid = __builtin_amdgcn_readfirstlane(wid_in), lane = lane_in, tid = wid * 64 + lane, wr = wid >> 2, wc = wid & 3, fr = lane & 15, fq = lane >> 4;
    const int K = g.K, nt = K / BK, LDK = g.ld;
    unsigned voffA[2], voffB[2];
#pragma unroll
    for (int i = 0; i < 2; ++i) { int R, C; stage_rc(tid * 16 + i * 8192, R, C); const int Rb = Epi::PERM ? ((R & ~31) + perm32(R & 31)) : R;
        voffA[i] = (unsigned)(R * LDK + C) * 2u; voffB[i] = (unsigned)(Rb * LDK + C) * 2u; }
    const size_t kstep = (size_t)(BK * 2);
    const size_t hstep = (size_t)HALF * LDK * 2;
    const size_t tstep = 2 * hstep;
    const unsigned ldsw = (unsigned)wid * 1024u;
    const int aoff = lds_byte(wr * 64 + fr, fq * 8), boff = lds_byte(wc * 32 + fr, fq * 8);
#define PG8_SA(b, h) (((b) * 2 + (h)) * HTB)
#define PG8_SB(b, h) ((4 + (b) * 2 + (h)) * HTB)
#define PG8_STAGE(bufoff, gbase, voff) do { _Pragma("unroll") for (int _i = 0; _i < 2; ++_i) \
        __builtin_amdgcn_global_load_lds((const unsigned*)((const char*)(gbase) + (voff)[_i]), (PG8_LAS unsigned*)(lds + (bufoff) + ldsw + _i * 8192), 16, 0, 0); } while (0)
#define PG8_LDA(dst, b, h) do { _Pragma("unroll") for (int m = 0; m < 4; ++m) _Pragma("unroll") for (int k = 0; k < 2; ++k) dst[m][k] = *(const PG8_LAS bf16x8*)(lds + PG8_SA(b, h) + aoff + m * 2048 + k * 1024); } while (0)
#define PG8_LDB(dst, b, h) do { _Pragma("unroll") for (int n = 0; n < 2; ++n) _Pragma("unroll") for (int k = 0; k < 2; ++k) dst[n][k] = *(const PG8_LAS bf16x8*)(lds + PG8_SB(b, h) + boff + n * 2048 + k * 1024); } while (0)
#define PG8_MMA(ai, bj, At, Bt) do { __builtin_amdgcn_s_setprio(1); _Pragma("unroll") for (int m = 0; m < 4; ++m) _Pragma("unroll") for (int n = 0; n < 2; ++n) _Pragma("unroll") for (int k = 0; k < 2; ++k) \
        acc[ai][bj][m][n] = __builtin_amdgcn_mfma_f32_16x16x32_bf16(Bt[n][k], At[m][k], acc[ai][bj][m][n], 0, 0, 0); __builtin_amdgcn_s_setprio(0); } while (0)
#define PG8_WAIT_V(n) asm volatile("s_waitcnt vmcnt(" #n ")" ::: "memory")
#define PG8_WAIT_L(n) asm volatile("s_waitcnt lgkmcnt(" #n ")" ::: "memory")
#define PG8_BAR __builtin_amdgcn_s_barrier()
#define PG8_SCHED __builtin_amdgcn_sched_barrier(0)
    Unit cur, nxt; int ui = 0;
    if (!S.next(0, cur)) return;
    f32x4 acc[2][2][4][2];
#pragma unroll
    for (int a = 0; a < 2; ++a)
#pragma unroll
        for (int b = 0; b < 2; ++b)
#pragma unroll
            for (int m = 0; m < 4; ++m)
#pragma unroll
                for (int n = 0; n < 2; ++n) acc[a][b][m][n] = (f32x4){0.f, 0.f, 0.f, 0.f};
    bf16x8 At[4][2], B0[2][2], B1[2][2];
    const char* cA = (const char*)g.A + (size_t)cur.pm * tstep + (size_t)cur.kb * K * 2; const char* cB = (const char*)g.Bt + (size_t)cur.pn * tstep + (size_t)cur.kb * K * 2;
    S.a_ready(cur);
    if constexpr (SP2) {
        PG8_STAGE(PG8_SB(0, 0), cB, voffB); PG8_STAGE(PG8_SB(0, 1), cB + hstep, voffB); PG8_STAGE(PG8_SA(0, 0), cA, voffA); PG8_STAGE(PG8_SA(0, 1), cA + hstep, voffA);
        if (wr == 1) PG8_BAR;
        PG8_WAIT_V(2); PG8_BAR;
        PG8_STAGE(PG8_SB(1, 0), cB + kstep, voffB); PG8_STAGE(PG8_SA(1, 0), cA + kstep, voffA); PG8_STAGE(PG8_SB(1, 1), cB + hstep + kstep, voffB);
        PG8_WAIT_V(6); PG8_BAR;
    } else {
        PG8_STAGE(PG8_SB(0, 0), cB, voffB); PG8_STAGE(PG8_SA(0, 0), cA, voffA); PG8_STAGE(PG8_SB(0, 1), cB + hstep, voffB); PG8_STAGE(PG8_SA(0, 1), cA + hstep, voffA);
        if (wr == 1) PG8_BAR;
        PG8_WAIT_V(4); PG8_BAR;
        PG8_STAGE(PG8_SB(1, 0), cB + kstep, voffB); PG8_STAGE(PG8_SA(1, 0), cA + kstep, voffA); PG8_STAGE(PG8_SB(1, 1), cB + hstep + kstep, voffB);
        PG8_WAIT_V(6); PG8_BAR;
    }
    for (;;) {
        const bool has_next = S.next(ui + 1, nxt);
        const char* nA = has_next ? (const char*)g.A + (size_t)nxt.pm * tstep + (size_t)nxt.kb * K * 2 : cA; const char* nB = has_next ? (const char*)g.Bt + (size_t)nxt.pn * tstep + (size_t)nxt.kb * K * 2 : cB;
        for (int t = 0; t < nt; t += 2) {
            const bool last = (t == nt - 2);
            const char* a1 = cA + (size_t)(t + 1) * kstep;
            const char* a2 = last ? nA : cA + (size_t)(t + 2) * kstep; const char* b2 = last ? nB : cB + (size_t)(t + 2) * kstep;
            const char* a3 = a2 + kstep; const char* b3 = b2 + kstep;
            if (last && has_next) S.a_ready(nxt);
            if constexpr (SP2) {
            PG8_LDB(B0, 0, 0); PG8_LDB(B1, 0, 1); PG8_SCHED; PG8_LDA(At, 0, 0); PG8_STAGE(PG8_SA(1, 1), a1 + hstep, voffA);
            PG8_WAIT_V(8); PG8_WAIT_L(0); PG8_BAR; PG8_MMA(0, 0, At, B0); PG8_MMA(0, 1, At, B1); PG8_BAR; PG8_SCHED;
            PG8_LDA(At, 0, 1); PG8_STAGE(PG8_SB(0, 0), b2, voffB); PG8_STAGE(PG8_SB(0, 1), b2 + hstep, voffB); PG8_STAGE(PG8_SA(0, 0), a2, voffA);
            PG8_WAIT_V(8); PG8_WAIT_L(0); PG8_BAR; PG8_MMA(1, 0, At, B0); PG8_MMA(1, 1, At, B1); PG8_BAR; PG8_SCHED;
            PG8_LDB(B0, 1, 0); PG8_LDB(B1, 1, 1); PG8_SCHED; PG8_LDA(At, 1, 0); PG8_STAGE(PG8_SA(0, 1), a2 + hstep, voffA);
            PG8_WAIT_V(8); PG8_WAIT_L(0); PG8_BAR; PG8_MMA(0, 0, At, B0); PG8_MMA(0, 1, At, B1); PG8_BAR; PG8_SCHED;
            PG8_LDA(At, 1, 1); PG8_STAGE(PG8_SB(1, 0), b3, voffB); PG8_STAGE(PG8_SB(1, 1), b3 + hstep, voffB); PG8_STAGE(PG8_SA(1, 0), a3, voffA);
            PG8_WAIT_V(8); PG8_WAIT_L(0); PG8_BAR; PG8_MMA(1, 0, At, B0); PG8_MMA(1, 1, At, B1); PG8_BAR; PG8_SCHED;
            } else {
            PG8_LDB(B0, 0, 0); PG8_SCHED; PG8_LDA(At, 0, 0); PG8_STAGE(PG8_SA(1, 1), a1 + hstep, voffA);
            PG8_WAIT_L(8); PG8_BAR; PG8_WAIT_L(0); PG8_MMA(0, 0, At, B0); PG8_BAR; PG8_SCHED;
            PG8_LDB(B1, 0, 1); PG8_STAGE(PG8_SB(0, 0), b2, voffB);
            PG8_BAR; PG8_WAIT_L(0); PG8_MMA(0, 1, At, B1); PG8_BAR;
            PG8_LDA(At, 0, 1); PG8_STAGE(PG8_SA(0, 0), a2, voffA);
            PG8_BAR; PG8_WAIT_L(0); PG8_MMA(1, 0, At, B0); PG8_BAR; PG8_SCHED;
            PG8_STAGE(PG8_SB(0, 1), b2 + hstep, voffB);
            PG8_WAIT_V(6); PG8_BAR; PG8_MMA(1, 1, At, B1); PG8_BAR;
            PG8_LDB(B0, 1, 0); PG8_SCHED; PG8_LDA(At, 1, 0); PG8_STAGE(PG8_SA(0, 1), a2 + hstep, voffA);
            PG8_WAIT_L(8); PG8_BAR; PG8_WAIT_L(0); PG8_MMA(0, 0, At, B0); PG8_BAR; PG8_SCHED;
            PG8_LDB(B1, 1, 1); PG8_STAGE(PG8_SB(1, 0), b3, voffB);
            PG8_BAR; PG8_WAIT_L(0); PG8_MMA(0, 1, At, B1); PG8_BAR;
            PG8_LDA(At, 1, 1); PG8_STAGE(PG8_SA(1, 0), a3, voffA);
            PG8_BAR; PG8_WAIT_L(0); PG8_MMA(1, 0, At, B0); PG8_BAR; PG8_SCHED;
            PG8_STAGE(PG8_SB(1, 1), b3 + hstep, voffB);
            PG8_WAIT_V(6); PG8_BAR; PG8_MMA(1, 1, At, B1); PG8_BAR;
            }
        }
        if constexpr (ALIGN_EPI) { if (wr == 0) PG8_BAR; }
        if constexpr (!Epi::AFTER_DRAIN) { E(acc, cur, wr, wc, fr, fq); S.done(cur); }
        if (!has_next) break;
#pragma unroll
        for (int a = 0; a < 2; ++a)
#pragma unroll
            for (int b = 0; b < 2; ++b)
#pragma unroll
                for (int m = 0; m < 4; ++m)
#pragma unroll
                    for (int n = 0; n < 2; ++n) acc[a][b][m][n] = (f32x4){0.f, 0.f, 0.f, 0.f};
        cur = nxt; cA = nA; cB = nB; ++ui;
        if constexpr (ALIGN_EPI) { if (wr == 1) PG8_BAR; }
    }
    PG8_WAIT_V(0);
    if constexpr (!ALIGN_EPI) { if (wr == 0) PG8_BAR; }
    PG8_BAR;
    if constexpr (Epi::AFTER_DRAIN) { E.fused(acc, cur, wr, wc, fr, fq, lds, wid, lane); S.done(cur); }
#undef PG8_SA
#undef PG8_SB
#undef PG8_STAGE
#undef PG8_LDA
#undef PG8_LDB
#undef PG8_MMA
#undef PG8_WAIT_V
#undef PG8_WAIT_L
#undef PG8_BAR
#undef PG8_SCHED
}
}

#else
}
#endif

constexpr int D = 1024, BATCH = CFG_BATCH, SEQ = CFG_SEQ, DECB = CFG_DEC_BATCH, DECS = 8, PAST = CFG_PAST_LEN, PAGE = 128;
constexpr int MP = BATCH * SEQ, MS = DECB * DECS, MT = MP + MS, M = (MT + 255) / 256 * 256;
constexpr int NPAGES = PAST / PAGE;
constexpr int QKV_A = 1536, IN_AB = 2600, LD1 = 2816, FF = 4096, INC = 4096;
constexpr int C_Z = 1536, C_B = 2048, C_A = 2052, C_CQ = 2056, C_CKV = 2312, C_KPE = 2568;
constexpr float EPS = 1e-6f;
constexpr float MLA_SCALE = 0.10206207261596575f;
constexpr float DK_SCALE = 0.08838834764831845f;
static_assert(MP % 256 == 0 && SEQ % 128 == 0 && PAST % 128 == 0, "shape assumptions");

constexpr size_t O_YP = 0, O_YS = O_YP + (size_t)MP * D, O_GDNP = O_YS + (size_t)MS * D, O_CONVP = O_GDNP + (size_t)BATCH * 4 * 16384,
    O_LATP = O_CONVP + (size_t)BATCH * 3 * QKV_A, O_KPEP = O_LATP + (size_t)MP * 256, O_HGP = O_KPEP + (size_t)MP * 32,
    O_GDNS = O_HGP + (size_t)BATCH * 8 * 16384, O_CONVS = O_GDNS + (size_t)DECB * 4 * 16384, O_LATS = O_CONVS + (size_t)DECB * 3 * QKV_A,
    O_KPES = O_LATS + (size_t)MS * 256, O_HGS = O_KPES + (size_t)MS * 32, O_END = O_HGS + (size_t)DECB * 8 * 16384;

constexpr size_t al256(size_t x) { return (x + 255) & ~(size_t)255; }
constexpr size_t WS_CTL = 0, CTL_BYTES = 65536;
constexpr size_t WS_WINAB = CTL_BYTES,                      WS_WUP0 = WS_WINAB + (size_t)LD1 * D * 2,
    WS_WUP1 = WS_WUP0 + (size_t)FF * D * 2,                 WS_WDN0 = WS_WUP1 + (size_t)FF * D * 2,
    WS_WDN1 = WS_WDN0 + (size_t)FF * D * 2,                 WS_WINC = WS_WDN1 + (size_t)FF * D * 2,
    WS_WOAB = WS_WINC + (size_t)INC * D * 2,                WS_WOC = WS_WOAB + (size_t)D * D * 2,
    WS_WUQ = WS_WOC + (size_t)D * D * 2,                    WS_WUKV = WS_WUQ + (size_t)768 * 256 * 2,
    WS_ROPE = WS_WUKV + (size_t)1024 * 256 * 2,             WS_XN = al256(WS_ROPE + (size_t)(SEQ + 8) * 32 * 4),
    WS_P1 = WS_XN + (size_t)M * D * 2,                      WS_CQN = WS_P1 + (size_t)M * 4096 * 4,
    WS_LATN = WS_CQN + (size_t)M * 256 * 2,                 WS_QH = WS_LATN + (size_t)M * 256 * 2,
    WS_KVP = WS_QH + (size_t)M * 768 * 4,                   WS_OCAT = WS_KVP + (size_t)MP * 1024 * 2,
    WS_ORAW = WS_OCAT + (size_t)M * D * 2,                  WS_X1 = WS_ORAW + (size_t)M * D * 4,
    WS_X2 = WS_X1 + (size_t)M * D * 4,                      WS_H = WS_X2 + (size_t)M * D * 4,
    WS_WUKB = WS_H + (size_t)M * FF * 2,                    WS_PO = WS_WUKB + (size_t)256 * 512 * 2,
    WS_PM = WS_PO + (size_t)DECB * 2 * 64 * 256 * 4,        WS_PL = WS_PM + (size_t)DECB * 2 * 64 * 4,
    WS_KPEB = WS_PL + (size_t)DECB * 2 * 64 * 4,            WS_PART = al256(WS_KPEB + (size_t)MP * 32 * 2),
    WS_END = WS_PART + (size_t)16 * (M - MP) * D * 4;
constexpr size_t WS_H_END = WS_H + (size_t)M * FF * 2;

constexpr int LDS_BYTES = 155648;
constexpr int LDS_MISC = 155648 - 256;
constexpr int NPHASE = 20;

typedef unsigned short bf16;
typedef unsigned u32x4 __attribute__((ext_vector_type(4)));
typedef unsigned u32x2 __attribute__((ext_vector_type(2)));
#ifndef HIPEMU
typedef short bf16x8 __attribute__((ext_vector_type(8)));
typedef float f32x4 __attribute__((ext_vector_type(4)));
#endif

#ifdef HIPEMU
DEV unsigned f2bf(float f) { unsigned u = __float_as_uint(f); return (u + 0x7fffu + ((u >> 16) & 1u)) >> 16; }
#else
DEV unsigned f2bf(float f) { return (unsigned)__builtin_bit_cast(unsigned short, (__bf16)f); }
#endif
#ifdef HIPEMU
DEV unsigned pk2(float lo, float hi) { return f2bf(lo) | (f2bf(hi) << 16); }
#else
typedef float f32x2_t __attribute__((ext_vector_type(2))); typedef __bf16 bf16x2_t __attribute__((ext_vector_type(2)));
DEV unsigned pk2(float lo, float hi) { f32x2_t v = {lo, hi}; bf16x2_t b = __builtin_convertvector(v, bf16x2_t); return __builtin_bit_cast(unsigned, b); }
#endif
DEV float bf2f(bf16 b) { return __uint_as_float(((unsigned)b) << 16); }
#ifdef HIPEMU
DEV float rcpf_(float x) { return 1.0f / x; }
#else
DEV float rcpf_(float x) { return __builtin_amdgcn_rcpf(x); }
#endif
DEV float sigmoidf_(float x) { return 1.0f / (1.0f + __expf(-x)); }
DEV float siluf_(float x) { return x / (1.0f + __expf(-x)); }
DEV float softplusf_(float x) { return fmaxf(x, 0.f) + log1pf(__expf(-fabsf(x))); }
#ifdef HIPEMU
DEV f32x4 mfma16(bf16x8 a, bf16x8 b, f32x4 c) { return emu_mfma16(a, b, c); }
#define WAVE_SYNC() emu_wave_sync()
#define NT_LOAD4(p_) (*(const f32x4*)(p_))
#define OPAQUE_V(x) do { } while (0)
#define LDS_BARRIER() __syncthreads()
DEV s16x4 lds_tr(const unsigned short* p) { return emu_lds_tr((const void*)p); }
#else
typedef short s16x4 __attribute__((ext_vector_type(4)));
DEV s16x4 lds_tr(const unsigned short* p) { return __builtin_bit_cast(s16x4, __builtin_amdgcn_ds_read_tr16_b64_v4i16((__attribute__((address_space(3))) s16x4*)p)); }
DEV f32x4 mfma16(bf16x8 a, bf16x8 b, f32x4 c) { return __builtin_amdgcn_mfma_f32_16x16x32_bf16(a, b, c, 0, 0, 0); }
#define WAVE_SYNC() asm volatile("s_waitcnt lgkmcnt(0)" ::: "memory")
#define OPAQUE_V(x) asm volatile("" : "+v"(x))
#define NT_LOAD4(p_) __builtin_nontemporal_load((const f32x4*)(p_))
#define LDS_BARRIER() asm volatile("s_waitcnt lgkmcnt(0)\n\ts_barrier" ::: "memory")
#endif
DEV f32x4 ld4bf(const unsigned short* p) { const u32x2 u = *(const u32x2*)p; return (f32x4){__uint_as_float(u.x << 16), __uint_as_float(u.x & 0xffff0000u), __uint_as_float(u.y << 16), __uint_as_float(u.y & 0xffff0000u)}; }
constexpr float QK_SCALE2 = MLA_SCALE * 1.4426950408889634f;
#ifdef HIPEMU
DEV float exp2f_(float x) { return exp2f(x); }
DEV bool wave_any(bool p) { int v = p ? 1 : 0;
    for (int o = 1; o < 64; o <<= 1) v |= __shfl_xor(v, o);
    return v != 0; }
#else
DEV float exp2f_(float x) { return __builtin_amdgcn_exp2f(x); }
DEV bool wave_any(bool p) { return __builtin_amdgcn_ballot_w64(p) != 0ull; }
#endif
#ifdef HIPEMU
DEV float wave_sum(float v) {
#pragma unroll
    for (int o = 1; o < 64; o <<= 1) v += __shfl_xor(v, o);
    return v;
}
DEV float grp16_max(float v) {
#pragma unroll
    for (int o = 1; o < 16; o <<= 1) v = fmaxf(v, __shfl_xor(v, o));
    return v;
}
DEV float grp16_sum(float v) {
#pragma unroll
    for (int o = 1; o < 16; o <<= 1) v += __shfl_xor(v, o);
    return v;
}
#else
template <int CTRL> DEV float dppf(float x) { return __builtin_bit_cast(float, __builtin_amdgcn_mov_dpp(__builtin_bit_cast(int, x), CTRL, 0xf, 0xf, true)); }
DEV float grp16_max(float v) { v = fmaxf(v, dppf<0xB1>(v)); v = fmaxf(v, dppf<0x4E>(v)); v = fmaxf(v, dppf<0x141>(v)); v = fmaxf(v, dppf<0x128>(v)); return v; }
DEV float grp16_sum(float v) { v += dppf<0xB1>(v); v += dppf<0x4E>(v); v += dppf<0x141>(v); v += dppf<0x128>(v); return v; }
DEV float wave_sum(float v) {
    v = grp16_sum(v);
    auto s = __builtin_amdgcn_permlane16_swap(__float_as_uint(v), __float_as_uint(v), false, false);
    v = __uint_as_float(s[0]) + __uint_as_float(s[1]);
    auto t = __builtin_amdgcn_permlane32_swap(__float_as_uint(v), __float_as_uint(v), false, false);
    return __uint_as_float(t[0]) + __uint_as_float(t[1]);
}
#endif

#ifdef HIPEMU
DEV float xg_max(float v) { v = fmaxf(v, __shfl_xor(v, 16)); v = fmaxf(v, __shfl_xor(v, 32)); return v; }
DEV float xg_sum(float v) { v += __shfl_xor(v, 16); v += __shfl_xor(v, 32); return v; }
#else
DEV float xg_max(float v) {
    auto s = __builtin_amdgcn_permlane16_swap(__float_as_uint(v), __float_as_uint(v), false, false); v = fmaxf(__uint_as_float(s[0]), __uint_as_float(s[1]));
    auto t = __builtin_amdgcn_permlane32_swap(__float_as_uint(v), __float_as_uint(v), false, false); return fmaxf(__uint_as_float(t[0]), __uint_as_float(t[1])); }
DEV float xg_sum(float v) {
    auto s = __builtin_amdgcn_permlane16_swap(__float_as_uint(v), __float_as_uint(v), false, false); v = __uint_as_float(s[0]) + __uint_as_float(s[1]);
    auto t = __builtin_amdgcn_permlane32_swap(__float_as_uint(v), __float_as_uint(v), false, false); return __uint_as_float(t[0]) + __uint_as_float(t[1]); }
#endif
struct Params { const void* in[28]; float* out; unsigned char* ws; int ph_lo, ph_hi; };
struct Ctx {
    const Params* p; unsigned char* lds; unsigned char* ws; float* out;
    int tid, lane, wave, gw, ngw;
    template <class T> DEV const T* in(int i) const { return (const T*)p->in[i]; }
    template <class T> DEV T* w(size_t off) const { return (T*)(ws + off); }
};
DEV int queue_next(const Ctx& c, int q) {
    unsigned* cnt = (unsigned*)(c.ws + WS_CTL) + 4096 + 64 * q; volatile unsigned* slot = (volatile unsigned*)(c.lds + LDS_MISC + 128);
    __syncthreads();
    if (c.tid == 0) *slot = atomicAdd(cnt, 1u);
    __syncthreads();
    return (int)*slot;
}
DEV const float* xin_row(const Ctx& c, int m) { return m < MP ? c.in<float>(0) + (size_t)m * D : c.in<float>(1) + (size_t)(m - MP) * D; }

struct EpiStoreF32 {
    static constexpr bool PERM = false, AFTER_DRAIN = false;
    float* C; int ldc;
    DEV void operator()(const pg8::f32x4 (&acc)[2][2][4][2], const pg8::Unit& u, int wr, int wc, int fr, int fq) const {
        const int row0 = u.pm * 256 + wr * 64 + fr, col0 = u.pn * 256 + wc * 32 + 4 * fq;
#pragma unroll
        for (int ai = 0; ai < 2; ++ai)
#pragma unroll
            for (int m = 0; m < 4; ++m) { float* rowp = C + (size_t)(row0 + ai * 128 + m * 16) * ldc + col0;
#pragma unroll
                for (int bj = 0; bj < 2; ++bj)
#pragma unroll
                    for (int n = 0; n < 2; ++n) *(pg8::f32x4*)(rowp + bj * 128 + n * 16) = acc[ai][bj][m][n]; }
    }
};
struct EpiResidF32 {
    static constexpr bool PERM = false, AFTER_DRAIN = false;
    const float* base; const float* xp; const float* xs; float* out;
    DEV void operator()(const pg8::f32x4 (&acc)[2][2][4][2], const pg8::Unit& u, int wr, int wc, int fr, int fq) const {
        const int row0 = u.pm * 256 + wr * 64 + fr, col0 = u.pn * 256 + wc * 32 + 4 * fq;
#pragma unroll
        for (int ai = 0; ai < 2; ++ai)
#pragma unroll
            for (int m = 0; m < 4; ++m) { const int row = row0 + ai * 128 + m * 16;
                const float* rp = base ? base + (size_t)row * D : (row < MP ? xp + (size_t)row * D : xs + (size_t)(row - MP) * D);
                const bool ok = base != nullptr || row < MT;
                float* op = out + (size_t)row * D + col0;
#pragma unroll
                for (int bj = 0; bj < 2; ++bj)
#pragma unroll
                    for (int n = 0; n < 2; ++n) { pg8::f32x4 r = ok ? *(const pg8::f32x4*)(rp + col0 + bj * 128 + n * 16) : (pg8::f32x4){0.f, 0.f, 0.f, 0.f};
                        *(pg8::f32x4*)(op + bj * 128 + n * 16) = r + acc[ai][bj][m][n]; } }
    }
};
template <int ACT  > struct EpiBf16 {
    static constexpr bool PERM = true, AFTER_DRAIN = false;
    bf16* O; int ldc;
    DEV void operator()(const pg8::f32x4 (&acc)[2][2][4][2], const pg8::Unit& u, int wr, int wc, int fr, int fq) const {
        const int row0 = u.pm * 256 + wr * 64 + fr, col0 = u.pn * 256 + wc * 32 + 8 * fq;
#pragma unroll
        for (int ai = 0; ai < 2; ++ai)
#pragma unroll
            for (int m = 0; m < 4; ++m) { bf16* rowp = O + (size_t)(row0 + ai * 128 + m * 16) * ldc + col0;
#pragma unroll
                for (int bj = 0; bj < 2; ++bj) { pg8::f32x4 v0 = acc[ai][bj][m][0], v1 = acc[ai][bj][m][1];
                    if (ACT == 1) {
#pragma unroll
                        for (int j = 0; j < 4; ++j) { const float a = fmaxf(v0[j], 0.f), b = fmaxf(v1[j], 0.f); v0[j] = a * a; v1[j] = b * b; } }
                    u32x4 w; w.x = pk2(v0[0], v0[1]); w.y = pk2(v0[2], v0[3]); w.z = pk2(v1[0], v1[1]); w.w = pk2(v1[2], v1[3]);
                    *(u32x4*)(rowp + bj * 128) = w; } }
    }
};

struct SplitKOrder {
    int nM, nN, nS, pm0, G, c;
    DEV void init(int nM_, int nN_, int nS_, int pm0_, int G_, int c_) { nM = nM_; nN = nN_; nS = nS_; pm0 = pm0_; G = G_; c = c_; }
    DEV bool next(int i, pg8::Unit& u) const { const int L = i * G + c; if (L >= nM * nN * nS) return false; u.pm = pm0 + L % nM; const int r = L / nM; u.pn = r % nN; u.kb = r / nN; return true; }
    DEV void a_ready(const pg8::Unit&) const {}
    DEV void done(const pg8::Unit&) const {}
};
struct EpiPartF32 {
    static constexpr bool PERM = false, AFTER_DRAIN = false;
    float* P;
    DEV void operator()(const pg8::f32x4 (&acc)[2][2][4][2], const pg8::Unit& u, int wr, int wc, int fr, int fq) const {
        const int row0 = u.pm * 256 - MP + wr * 64 + fr, col0 = u.pn * 256 + wc * 32 + 4 * fq;
        float* base = P + (size_t)u.kb * (M - MP) * D;
#pragma unroll
        for (int ai = 0; ai < 2; ++ai)
#pragma unroll
            for (int m = 0; m < 4; ++m) { float* op = base + (size_t)(row0 + ai * 128 + m * 16) * D + col0;
#pragma unroll
                for (int bj = 0; bj < 2; ++bj)
#pragma unroll
                    for (int n = 0; n < 2; ++n) *(pg8::f32x4*)(op + bj * 128 + n * 16) = acc[ai][bj][m][n]; }
    }
};
template <class Epi, class Sched> DEV void run_gemm_s(const Ctx& c, const bf16* A, const bf16* Bt, int Mr, int N, int K, int ld, const Sched& S, const Epi& E) {
#ifndef HIPEMU
    asm volatile("" : "+s"(K));
    pg8::Gemm g{A, Bt, Mr, N, K, ld};
    pg8::gemm_phase<Epi, Sched, true, true>((PG8_LAS unsigned char*)c.lds, g, S, E, c.wave, c.lane);
#else
    const int wid = c.wave, lane = c.lane, wr = wid >> 2, wc = wid & 3, fr = lane & 15, fq = lane >> 4;
    pg8::Unit u;
    for (int ui = 0; S.next(ui, u); ++ui) {
        pg8::f32x4 acc[2][2][4][2];
        for (int ai = 0; ai < 2; ++ai) for (int bj = 0; bj < 2; ++bj) for (int m = 0; m < 4; ++m) for (int n = 0; n < 2; ++n) for (int j = 0; j < 4; ++j) {
            const int row = 256 * u.pm + 128 * ai + 64 * wr + 16 * m + fr;
            const int col = Epi::PERM ? 256 * u.pn + 128 * bj + 32 * wc + 8 * fq + 4 * n + j : 256 * u.pn + 128 * bj + 32 * wc + 16 * n + 4 * fq + j;
            const bf16* a = A + (size_t)row * ld + (size_t)u.kb * K; const bf16* b = Bt + (size_t)col * ld + (size_t)u.kb * K; float s = 0.f;
            for (int k = 0; k < K; ++k) s += bf2f(a[k]) * bf2f(b[k]);
            acc[ai][bj][m][n][j] = s; }
        E(acc, u, wr, wc, fr, fq);
    }
#endif
}
template <class Epi> DEV void run_gemm(const Ctx& c, const bf16* A, const bf16* Bt, int Mr, int N, int K, const Epi& E) {
    pg8::StaticOrder S; S.init(Mr, N, (int)gridDim.x, (int)blockIdx.x);
    run_gemm_s(c, A, Bt, Mr, N, K, K, S, E);
}
DEV void run_gemm_sample_splitk(const Ctx& c, const bf16* A, const bf16* Bt, int K, int KS) {
    SplitKOrder S; S.init((M - MP) / 256, D / 256, K / KS, MP / 256, (int)gridDim.x, (int)((blockIdx.x + 128) % gridDim.x));
    run_gemm_s(c, A, Bt, M, D, KS, K, S, EpiPartF32{c.w<float>(WS_PART)});
}

DEV void transpose_item(const float* W, int K, int N, bf16* WT, float* scr, int item, int nblk, int lane) {
    const int kb = item / nblk, nb = item % nblk, k0 = 64 * kb, n0 = 32 * nb;
    const int nn = n0 + (lane & 31);
    float tv[32];
#pragma unroll
    for (int i = 0; i < 32; ++i) { const int kk = 2 * i + (lane >> 5); tv[i] = nn < N ? W[(size_t)(k0 + kk) * N + nn] : 0.f; }
#pragma unroll
    for (int i = 0; i < 32; ++i) { const int kk = 2 * i + (lane >> 5); scr[kk * 33 + (lane & 31)] = tv[i]; }
    WAVE_SYNC();
    const int cq = lane & 7;
#pragma unroll
    for (int j = 0; j < 4; ++j) { const int n = (lane >> 3) + 8 * j; const float* s = scr + (8 * cq) * 33 + n;
        u32x4 o; o.x = pk2(s[0 * 33], s[1 * 33]); o.y = pk2(s[2 * 33], s[3 * 33]); o.z = pk2(s[4 * 33], s[5 * 33]); o.w = pk2(s[6 * 33], s[7 * 33]);
        *(u32x4*)(WT + (size_t)(n0 + n) * K + k0 + 8 * cq) = o; }
    WAVE_SYNC();
}
DEV void rms_row_to_bf16(const float* xrow, const float* gain, bf16* orow, int lane) {
    f32x4 v[4]; float s = 0.f;
#pragma unroll
    for (int j = 0; j < 4; ++j) { v[j] = *(const f32x4*)(xrow + 4 * lane + 256 * j); s += (v[j][0] * v[j][0] + v[j][1] * v[j][1]) + (v[j][2] * v[j][2] + v[j][3] * v[j][3]); }
    const float rstd = rsqrtf(wave_sum(s) * (1.f / D) + EPS);
#pragma unroll
    for (int j = 0; j < 4; ++j) { const f32x4 g = *(const f32x4*)(gain + 4 * lane + 256 * j);
        u32x2 o; o.x = pk2(v[j][0] * rstd * g[0], v[j][1] * rstd * g[1]); o.y = pk2(v[j][2] * rstd * g[2], v[j][3] * rstd * g[3]);
        *(u32x2*)(orow + 4 * lane + 256 * j) = o; }
}
DEV void zero_row_bf16(bf16* orow, int lane) {
#pragma unroll
    for (int j = 0; j < 4; ++j) { u32x2 o; o.x = 0u; o.y = 0u; *(u32x2*)(orow + 4 * lane + 256 * j) = o; }
}
#define TJOB(Wp, K_, N_, Npad_, wt_) do { const int nblk = (Npad_) / 32, nitems = ((K_) / 64) * nblk; bf16* WT = c.w<bf16>(wt_); const float* Wsrc = (Wp); \
        for (int it = gw0; it < nitems; it += ngw0) transpose_item(Wsrc, (K_), (N_), WT, scr, it, nblk, c.lane); } while (0)
DEV void phase_convert_late(const Ctx& c, int gw0, int ngw0) {
    float* scr = (float*)(c.lds + c.wave * 8704);
    TJOB(c.in<float>(23), D, D, D, WS_WOAB);
    TJOB(c.in<float>(11), D, FF, FF, WS_WUP0);
    TJOB(c.in<float>(12), FF, D, D, WS_WDN0);
}
DEV void phase_convert_late2(const Ctx& c, int gw0, int ngw0) {
    float* scr = (float*)(c.lds + c.wave * 8704);
    TJOB(c.in<float>(24), D, INC, INC, WS_WINC);
    TJOB(c.in<float>(27), D, D, D, WS_WOC);
    TJOB(c.in<float>(11) + (size_t)D * FF, D, FF, FF, WS_WUP1);
    TJOB(c.in<float>(12) + (size_t)D * FF, FF, D, D, WS_WDN1);
}
DEV void phase_prologue(const Ctx& c) {
    float* scr = (float*)(c.lds + c.wave * 8704);
    const int gw0 = c.gw, ngw0 = c.ngw;
    TJOB(c.in<float>(13), D, IN_AB, LD1, WS_WINAB);
    TJOB(c.in<float>(19), 256, 768, 768, WS_WUQ);
    TJOB(c.in<float>(21), 256, 512, 512, WS_WUKV); TJOB(c.in<float>(22), 256, 512, 512, WS_WUKV + (size_t)512 * 256 * 2);
#undef TJOB
    {
        const float* src = c.in<float>(21); bf16* dst = c.w<bf16>(WS_WUKB);
        for (int i = blockIdx.x * 512 + c.tid; i < 256 * 512 / 4; i += gridDim.x * 512) { const f32x4 v = *(const f32x4*)(src + 4 * i); u32x2 o; o.x = pk2(v[0], v[1]); o.y = pk2(v[2], v[3]); *(u32x2*)(dst + 4 * i) = o; }
    }
    float* rope = c.w<float>(WS_ROPE);
    for (int i = blockIdx.x * 512 + c.tid; i < (SEQ + 8) * 16; i += gridDim.x * 512) {
        const int e = i >> 4, f = i & 15; const double pos = e < SEQ ? (double)e : (double)(PAST + e - SEQ);
        const double ang = pos * pow(10000.0, -(double)f / 16.0);
        rope[e * 32 + f] = (float)cos(ang); rope[e * 32 + 16 + f] = (float)sin(ang);
    }
    bf16* XN = c.w<bf16>(WS_XN);
    for (int m = c.gw; m < M; m += c.ngw) {
        if (m < MT) rms_row_to_bf16(xin_row(c, m), c.in<float>(8), XN + (size_t)m * D, c.lane); else zero_row_bf16(XN + (size_t)m * D, c.lane);
    }
}
DEV void sample_row_sum(const Ctx& c, int m, const float* X_res, int nsp, f32x4 (&v)[4]) {
    const int lane = c.lane; const float* P = c.w<float>(WS_PART) + (size_t)(m - MP) * D;
#pragma unroll
    for (int j = 0; j < 4; ++j) {
        if (X_res) v[j] = *(const f32x4*)(X_res + (size_t)m * D + 4 * lane + 256 * j);
        else v[j] = m < MT ? *(const f32x4*)(c.in<float>(1) + (size_t)(m - MP) * D + 4 * lane + 256 * j) : (f32x4){0.f, 0.f, 0.f, 0.f}; }
    for (int s = 0; s < nsp; ++s) {
#pragma unroll
        for (int j = 0; j < 4; ++j) v[j] += *(const f32x4*)(P + (size_t)s * (M - MP) * D + 4 * lane + 256 * j); }
}
DEV void phase_rmsnorm(const Ctx& c, float* X, const float* gain, const float* X_res, int nsp) {
    bf16* XN = c.w<bf16>(WS_XN); const int lane = c.lane;
    for (int m = c.gw; m < M; m += c.ngw) {
        if (m < MP) { rms_row_to_bf16(X + (size_t)m * D, gain, XN + (size_t)m * D, lane); continue; }
        f32x4 v[4]; sample_row_sum(c, m, X_res, nsp, v);
        float s = 0.f;
#pragma unroll
        for (int j = 0; j < 4; ++j) { *(f32x4*)(X + (size_t)m * D + 4 * lane + 256 * j) = v[j]; s += (v[j][0] * v[j][0] + v[j][1] * v[j][1]) + (v[j][2] * v[j][2] + v[j][3] * v[j][3]); }
        const float rstd = rsqrtf(wave_sum(s) * (1.f / D) + EPS);
#pragma unroll
        for (int j = 0; j < 4; ++j) { const f32x4 g = *(const f32x4*)(gain + 4 * lane + 256 * j);
            u32x2 o; o.x = pk2(v[j][0] * rstd * g[0], v[j][1] * rstd * g[1]); o.y = pk2(v[j][2] * rstd * g[2], v[j][3] * rstd * g[3]);
            *(u32x2*)(XN + (size_t)m * D + 4 * lane + 256 * j) = o; }
    }
}
DEV void phase_copy_rows(const Ctx& c, float* dst, const float* src, int nrows) {
    for (int r = (int)(gridDim.x * 8) - 1 - c.gw; r < nrows; r += c.ngw) {
#pragma unroll
        for (int j = 0; j < 4; ++j) *(f32x4*)(dst + (size_t)r * D + 4 * c.lane + 256 * j) = *(const f32x4*)(src + (size_t)r * D + 4 * c.lane + 256 * j); }
}
DEV void phase_final(const Ctx& c, const float* X, const float* gain, const float* X_res, int nsp) {
    for (int m = c.gw; m < MT; m += c.ngw) {
        const float* xrow = X + (size_t)m * D; float* orow = c.out + (m < MP ? O_YP + (size_t)m * D : O_YS + (size_t)(m - MP) * D);
        f32x4 v[4]; float s = 0.f;
        if (m >= MP) sample_row_sum(c, m, X_res, nsp, v);
#pragma unroll
        for (int j = 0; j < 4; ++j) { if (m < MP) v[j] = *(const f32x4*)(xrow + 4 * c.lane + 256 * j); s += (v[j][0] * v[j][0] + v[j][1] * v[j][1]) + (v[j][2] * v[j][2] + v[j][3] * v[j][3]); }
        const float rstd = rsqrtf(wave_sum(s) * (1.f / D) + EPS);
#pragma unroll
        for (int j = 0; j < 4; ++j) { const f32x4 g = *(const f32x4*)(gain + 4 * c.lane + 256 * j); *(f32x4*)(orow + 4 * c.lane + 256 * j) = v[j] * rstd * g; }
    }
}

DEV void phase_prep0(const Ctx& c) {
    const bf16* P1 = c.w<bf16>(WS_P1); const float* rope = c.w<float>(WS_ROPE);
    bf16* CQN = c.w<bf16>(WS_CQN); bf16* LATN = c.w<bf16>(WS_LATN);
    const float* qg = c.in<float>(18); const float* kvg = c.in<float>(20);
    const int lane = c.lane;
    for (int m = c.gw; m < M; m += c.ngw) {
        if (m >= MT) { u32x2 z; z.x = 0u; z.y = 0u; *(u32x2*)(CQN + (size_t)m * 256 + 4 * lane) = z; *(u32x2*)(LATN + (size_t)m * 256 + 4 * lane) = z; continue; }
        const bf16* row = P1 + (size_t)m * LD1;
        const bool samp = m >= MP; const int b = samp ? (m - MP) / DECS : m / SEQ, t = samp ? (m - MP) % DECS : m % SEQ;
        {
            const f32x4 v = ld4bf(row + C_CQ + 4 * lane); const f32x4 g = *(const f32x4*)(qg + 4 * lane);
            const float r = rsqrtf(wave_sum((v[0] * v[0] + v[1] * v[1]) + (v[2] * v[2] + v[3] * v[3])) * (1.f / 256.f) + EPS);
            u32x2 o; o.x = pk2(v[0] * r * g[0], v[1] * r * g[1]); o.y = pk2(v[2] * r * g[2], v[3] * r * g[3]); *(u32x2*)(CQN + (size_t)m * 256 + 4 * lane) = o;
        }
        {
            const f32x4 v = ld4bf(row + C_CKV + 4 * lane); const f32x4 g = *(const f32x4*)(kvg + 4 * lane);
            const float r = rsqrtf(wave_sum((v[0] * v[0] + v[1] * v[1]) + (v[2] * v[2] + v[3] * v[3])) * (1.f / 256.f) + EPS);
            const f32x4 y = v * r * g;
            float* lo = c.out + (samp ? O_LATS + (size_t)(m - MP) * 256 : O_LATP + (size_t)m * 256);
            *(f32x4*)(lo + 4 * lane) = y;
            u32x2 o; o.x = pk2(y[0], y[1]); o.y = pk2(y[2], y[3]); *(u32x2*)(LATN + (size_t)m * 256 + 4 * lane) = o;
        }
        if (lane < 16) {
            const float* rt = rope + (size_t)(samp ? SEQ + t : t) * 32; const float cs = rt[lane], sn = rt[16 + lane];
            const float x1 = bf2f(row[C_KPE + lane]), x2 = bf2f(row[C_KPE + 16 + lane]);
            float* ko = c.out + (samp ? O_KPES + (size_t)(m - MP) * 32 : O_KPEP + (size_t)m * 32);
            ko[lane] = x1 * cs - x2 * sn; ko[16 + lane] = x2 * cs + x1 * sn;
            if (!samp) { bf16* kb = c.w<bf16>(WS_KPEB) + (size_t)m * 32; kb[lane] = (bf16)f2bf(x1 * cs - x2 * sn); kb[16 + lane] = (bf16)f2bf(x2 * cs + x1 * sn); }
        }
        const int T = samp ? DECS : SEQ;
        if (t >= T - 3) {
            float* co = c.out + (samp ? O_CONVS : O_CONVP) + ((size_t)b * 3 + (t - (T - 3))) * QKV_A;
#pragma unroll
            for (int j = 0; j < 6; ++j) *(f32x4*)(co + 4 * lane + 256 * j) = ld4bf(row + 4 * lane + 256 * j);
        }
    }
}

DEV void phase_gdn_naive(const Ctx& c, int u_begin, int wg_first, int wg_stride) {
    float* red = (float*)c.lds; float* red2 = red + 512; float* qs = red2 + 512; float* ks = qs + 128; float* vs = ks + 128; float* part = vs + 128; float* sc = part + 8;
    const bf16* P1 = c.w<bf16>(WS_P1); float* ORAW = c.w<float>(WS_ORAW); bf16* OCAT = c.w<bf16>(WS_OCAT);
    const float* convw = c.in<float>(14); const float* gn = c.in<float>(17);
    const int tid = c.tid, lane = c.lane, wave = c.wave;
    const int NU = (BATCH + DECB) * 4;
    for (int u = u_begin + wg_first; u < NU; u += wg_stride) {
        const bool samp = u >= BATCH * 4; const int b = samp ? (u - BATCH * 4) >> 2 : u >> 2, h = u & 3;
        const int T = samp ? DECS : SEQ; const size_t m0 = samp ? (size_t)MP + (size_t)b * DECS : (size_t)b * SEQ;
        const int e = tid & 127, dg = tid >> 7, d0 = dg * 32;
        float s[32];
        if (samp) { const float* S0 = c.in<float>(2) + ((size_t)(b * 4 + h) * 128 + d0) * 128 + e;
#pragma unroll
            for (int i = 0; i < 32; ++i) s[i] = S0[(size_t)i * 128]; }
        else {
#pragma unroll
            for (int i = 0; i < 32; ++i) s[i] = 0.f; }
        const int col = tid < 128 ? h * 128 + tid : (tid < 256 ? 512 + h * 128 + (tid - 128) : 1024 + h * 128 + (tid - 256));
        float w0 = 0.f, w1 = 0.f, w2 = 0.f, w3 = 0.f, x0 = 0.f, x1 = 0.f, x2 = 0.f, xn = 0.f;
        if (tid < 384) { w0 = convw[col]; w1 = convw[QKV_A + col]; w2 = convw[2 * QKV_A + col]; w3 = convw[3 * QKV_A + col];
            if (samp) { const float* cb = c.in<float>(3) + (size_t)b * 3 * QKV_A + col; x0 = cb[0]; x1 = cb[QKV_A]; x2 = cb[2 * QKV_A]; }
            xn = bf2f(P1[m0 * LD1 + col]); }
        const float Aexp = __expf(c.in<float>(15)[h]), dtb = c.in<float>(16)[h];
        for (int t = 0; t < T; ++t) {
            const size_t m = m0 + t;
            const float x3 = xn; if (t + 1 < T && tid < 384) xn = bf2f(P1[(m + 1) * LD1 + col]);
            float val = 0.f;
            if (tid < 384) { const float y = w0 * x0 + w1 * x1 + w2 * x2 + w3 * x3; val = siluf_(y); x0 = x1; x1 = x2; x2 = x3; }
            const float sq = wave_sum(tid < 256 ? val * val : 0.f);
            if (tid < 128) qs[tid] = val; else if (tid < 256) ks[tid - 128] = val; else if (tid < 384) vs[tid - 256] = val;
            if (lane == 0 && wave < 4) part[wave] = sq;
            if (tid == 384) { sc[0] = sigmoidf_(bf2f(P1[m * LD1 + C_B + h])); sc[1] = -Aexp * softplusf_(bf2f(P1[m * LD1 + C_A + h]) + dtb); }
            LDS_BARRIER();
            const float qn = rsqrtf(part[0] + part[1] + EPS), kn = rsqrtf(part[2] + part[3] + EPS), beta = sc[0], dec = __expf(sc[1]);
            float kp = 0.f;
#pragma unroll
            for (int i = 0; i < 32; ++i) { s[i] *= dec; kp += ks[d0 + i] * s[i]; }
            red[dg * 128 + e] = kp * kn;
            LDS_BARRIER();
            const float kS = (red[e] + red[128 + e]) + (red[256 + e] + red[384 + e]);
            const float delta = beta * (vs[e] - kS) * kn;
            float op = 0.f;
#pragma unroll
            for (int i = 0; i < 32; ++i) { s[i] += ks[d0 + i] * delta; op += qs[d0 + i] * s[i]; }
            red2[dg * 128 + e] = op * qn;
            LDS_BARRIER();
            if (dg == 0) ORAW[m * 512 + h * 128 + e] = ((red2[e] + red2[128 + e]) + (red2[256 + e] + red2[384 + e])) * DK_SCALE;
        }
        float* So = c.out + (samp ? O_GDNS : O_GDNP) + ((size_t)(b * 4 + h) * 128 + d0) * 128 + e;
#pragma unroll
        for (int i = 0; i < 32; ++i) So[(size_t)i * 128] = s[i];
        __syncthreads();
        for (int t = wave; t < T; t += 8) { const size_t m = m0 + t;
            const float v0 = ORAW[m * 512 + h * 128 + lane], v1 = ORAW[m * 512 + h * 128 + 64 + lane];
            const float r = rsqrtf(wave_sum(v0 * v0 + v1 * v1) * (1.f / 128.f) + EPS);
            const float z0 = bf2f(P1[m * LD1 + C_Z + h * 128 + lane]), z1 = bf2f(P1[m * LD1 + C_Z + h * 128 + 64 + lane]);
            OCAT[m * D + h * 128 + lane] = (bf16)f2bf(v0 * r * gn[lane] * siluf_(z0));
            OCAT[m * D + h * 128 + 64 + lane] = (bf16)f2bf(v1 * r * gn[64 + lane] * siluf_(z1)); }
        __syncthreads();
    }
}

DEV void phase_hgrn_naive(const Ctx& c, int u_begin, int wg_first, int wg_stride) {
    float* red = (float*)c.lds; float* qs = red + 512; float* fs = qs + 128;
    const bf16* PC = c.w<bf16>(WS_P1); float* ORAW = c.w<float>(WS_ORAW); bf16* OC = c.w<bf16>(WS_OCAT);
    const float* lbl = c.in<float>(25); const float* gn = c.in<float>(26);
    const int tid = c.tid, lane = c.lane, wave = c.wave;
    const int NU = (BATCH + DECB) * 8;
    for (int u = u_begin + wg_first; u < NU; u += wg_stride) {
        const bool samp = u >= BATCH * 8; const int b = samp ? (u - BATCH * 8) >> 3 : u >> 3, h = u & 7;
        const int T = samp ? DECS : SEQ; const size_t m0 = samp ? (size_t)MP + (size_t)b * DECS : (size_t)b * SEQ;
        const int e = tid & 127, dg = tid >> 7, d0 = dg * 32;
        float s[32];
        if (samp) { const float* S0 = c.in<float>(6) + ((size_t)(b * 8 + h) * 128 + d0) * 128 + e;
#pragma unroll
            for (int i = 0; i < 32; ++i) s[i] = S0[(size_t)i * 128]; }
        else {
#pragma unroll
            for (int i = 0; i < 32; ++i) s[i] = 0.f; }
        float lb = 0.f; if (tid < 128) lb = sigmoidf_(lbl[1024 + h * 128 + tid] - lbl[h * 128 + tid]);
        bf16 nq = 0, nf = 0, nv = 0;
        { const bf16* row = PC + m0 * INC; if (tid < 128) { nq = row[h * 128 + tid]; nf = row[1024 + h * 128 + tid]; } nv = row[2048 + h * 128 + e]; }
        for (int t = 0; t < T; ++t) {
            const size_t m = m0 + t;
            if (tid < 128) { qs[tid] = siluf_(bf2f(nq)); fs[tid] = lb + (1.f - lb) * sigmoidf_(bf2f(nf)); }
            const float v = bf2f(nv);
            if (t + 1 < T) { const bf16* row = PC + (m + 1) * INC; if (tid < 128) { nq = row[h * 128 + tid]; nf = row[1024 + h * 128 + tid]; } nv = row[2048 + h * 128 + e]; }
            LDS_BARRIER();
            float op = 0.f;
#pragma unroll
            for (int i = 0; i < 32; ++i) { const float f = fs[d0 + i]; s[i] = f * s[i] + (1.f - f) * v; op += qs[d0 + i] * s[i]; }
            red[dg * 128 + e] = op;
            LDS_BARRIER();
            if (dg == 0) ORAW[m * D + h * 128 + e] = ((red[e] + red[128 + e]) + (red[256 + e] + red[384 + e])) * DK_SCALE;
        }
        float* So = c.out + (samp ? O_HGS : O_HGP) + ((size_t)(b * 8 + h) * 128 + d0) * 128 + e;
#pragma unroll
        for (int i = 0; i < 32; ++i) So[(size_t)i * 128] = s[i];
        __syncthreads();
        for (int t = wave; t < T; t += 8) { const size_t m = m0 + t;
            const float v0 = ORAW[m * D + h * 128 + lane], v1 = ORAW[m * D + h * 128 + 64 + lane];
            const float r = rsqrtf(wave_sum(v0 * v0 + v1 * v1) * (1.f / 128.f) + EPS);
            const float z0 = bf2f(PC[m * INC + 3072 + h * 128 + lane]), z1 = bf2f(PC[m * INC + 3072 + h * 128 + 64 + lane]);
            OC[m * D + h * 128 + lane] = (bf16)f2bf(v0 * r * gn[lane] * siluf_(z0));
            OC[m * D + h * 128 + 64 + lane] = (bf16)f2bf(v1 * r * gn[64 + lane] * siluf_(z1)); }
        __syncthreads();
    }
}

DEV bf16x8 ld8(const bf16* p) { return *(const bf16x8*)p; }
DEV void softmax_strip(f32x4 (&s)[4], float (&mrun)[4], float (&lrun)[4], float (&alpha)[4], bf16* Ps, int lane) {
#pragma unroll
    for (int r = 0; r < 4; ++r) {
        float mx = fmaxf(fmaxf(s[0][r], s[1][r]), fmaxf(s[2][r], s[3][r])); mx = grp16_max(mx);
        const float mn = fmaxf(mrun[r], mx);
        alpha[r] = __expf(mrun[r] - mn); mrun[r] = mn;
        float sum = 0.f;
#pragma unroll
        for (int nt = 0; nt < 4; ++nt) { const float p = __expf(s[nt][r] - mn); s[nt][r] = p; sum += p; }
        sum = grp16_sum(sum); lrun[r] = lrun[r] * alpha[r] + sum;
    }
#pragma unroll
    for (int nt = 0; nt < 4; ++nt)
#pragma unroll
        for (int r = 0; r < 4; ++r) Ps[((lane >> 4) * 4 + r) * 72 + nt * 16 + (lane & 15)] = (bf16)f2bf(s[nt][r]);
}
DEV void phase_attn_prompt(const Ctx& c) {
    bf16* Qs = (bf16*)c.lds;
    bf16* Ks = Qs + 128 * 104;
    bf16* Vt = Ks + 64 * 104;
    bf16* Psb = Vt + 64 * 72;
    const float* QH = c.w<float>(WS_QH); const bf16* KVP = c.w<bf16>(WS_KVP); const float* rope = c.w<float>(WS_ROPE); bf16* OCAT = c.w<bf16>(WS_OCAT);
    const float* kpe = c.out + O_KPEP;
    const int tid = c.tid, lane = c.lane, w = c.wave;
    bf16* Ps = Psb + w * 16 * 72;
    constexpr int NQB = SEQ / 128, NU = BATCH * 8 * NQB;
    for (int u = blockIdx.x; u < NU; u += gridDim.x) {
        const int qb = NQB - 1 - u / (BATCH * 8), bh = u % (BATCH * 8), b = bh >> 3, h = bh & 7;
        const int q0 = qb * 128; const size_t mb = (size_t)b * SEQ;
        __syncthreads();
        for (int idx = tid; idx < 128 * 80; idx += 512) {
            const int r = idx / 80, j = idx % 80; const float* qrow = QH + (mb + q0 + r) * 768 + h * 96;
            if (j < 64) Qs[r * 104 + j] = (bf16)f2bf(qrow[j] * MLA_SCALE);
            else { const int f = j - 64; const float* rt = rope + (size_t)(q0 + r) * 32; const float cs = rt[f], sn = rt[16 + f], x1 = qrow[64 + f], x2 = qrow[80 + f];
                Qs[r * 104 + 64 + f] = (bf16)f2bf((x1 * cs - x2 * sn) * MLA_SCALE); Qs[r * 104 + 80 + f] = (bf16)f2bf((x2 * cs + x1 * sn) * MLA_SCALE); }
        }
        __syncthreads();
        bf16x8 qf[3];
#pragma unroll
        for (int ks = 0; ks < 3; ++ks) qf[ks] = ld8(Qs + (w * 16 + (lane & 15)) * 104 + ks * 32 + 8 * (lane >> 4));
        float mrun[4], lrun[4], alpha[4]; f32x4 o[4];
#pragma unroll
        for (int r = 0; r < 4; ++r) { mrun[r] = -INFINITY; lrun[r] = 0.f; }
#pragma unroll
        for (int nt = 0; nt < 4; ++nt) o[nt] = (f32x4){0.f, 0.f, 0.f, 0.f};
        const int nkt = 2 * qb + 2;
        for (int kt = 0; kt < nkt; ++kt) {
            const int k0 = kt * 64;
            __syncthreads();
            for (int idx = tid; idx < 64 * 8; idx += 512) {
                const int key = idx >> 3, ch = idx & 7; *(u32x4*)(Ks + key * 104 + ch * 8) = *(const u32x4*)(KVP + (mb + k0 + key) * 1024 + h * 64 + ch * 8); }
            for (int idx = tid; idx < 64 * 32; idx += 512) { const int key = idx >> 5, f = idx & 31; Ks[key * 104 + 64 + f] = (bf16)f2bf(kpe[(mb + k0 + key) * 32 + f]); }
            for (int idx = tid; idx < 64 * 64; idx += 512) { const int key = idx >> 6, d = idx & 63; Vt[d * 72 + key] = KVP[(mb + k0 + key) * 1024 + 512 + h * 64 + d]; }
            __syncthreads();
            f32x4 s[4];
#pragma unroll
            for (int nt = 0; nt < 4; ++nt) { s[nt] = (f32x4){0.f, 0.f, 0.f, 0.f};
#pragma unroll
                for (int ks = 0; ks < 3; ++ks) s[nt] = mfma16(qf[ks], ld8(Ks + (nt * 16 + (lane & 15)) * 104 + ks * 32 + 8 * (lane >> 4)), s[nt]); }
            if (kt >= 2 * qb) {
#pragma unroll
                for (int nt = 0; nt < 4; ++nt)
#pragma unroll
                    for (int r = 0; r < 4; ++r) { const int qpos = q0 + w * 16 + (lane >> 4) * 4 + r, kpos = k0 + nt * 16 + (lane & 15); if (kpos > qpos) s[nt][r] = -INFINITY; }
            }
            softmax_strip(s, mrun, lrun, alpha, Ps, lane);
            WAVE_SYNC();
#pragma unroll
            for (int nt = 0; nt < 4; ++nt) {
#pragma unroll
                for (int r = 0; r < 4; ++r) o[nt][r] *= alpha[r];
#pragma unroll
                for (int k2 = 0; k2 < 2; ++k2) o[nt] = mfma16(ld8(Ps + (lane & 15) * 72 + k2 * 32 + 8 * (lane >> 4)), ld8(Vt + (nt * 16 + (lane & 15)) * 72 + k2 * 32 + 8 * (lane >> 4)), o[nt]); }
            WAVE_SYNC();
        }
#pragma unroll
        for (int nt = 0; nt < 4; ++nt)
#pragma unroll
            for (int r = 0; r < 4; ++r) OCAT[(mb + q0 + w * 16 + (lane >> 4) * 4 + r) * D + 512 + h * 64 + nt * 16 + (lane & 15)] = (bf16)f2bf(o[nt][r] / lrun[r]);
    }
}

DEV void phase_attn_sample(const Ctx& c) {
    bf16* Qs = (bf16*)c.lds;
    bf16* Ks = Qs + 64 * 296;
    bf16* Lt = Ks + 64 * 296;
    float* Sf = (float*)(Lt + 256 * 72);
    bf16* Psb = (bf16*)(Sf + 64 * 68);
    float* Of = (float*)Ks;
    const float* QH = c.w<float>(WS_QH); const float* rope = c.w<float>(WS_ROPE); bf16* OCAT = c.w<bf16>(WS_OCAT);
    const float* wuk = c.in<float>(21); const float* wuv = c.in<float>(22);
    const float* clat = c.in<float>(4); const float* ckr = c.in<float>(5); const int* ptab = c.in<int>(7);
    const int tid = c.tid, lane = c.lane, w = c.wave;
    bf16* Ps = Psb + w * 16 * 72;
    for (int b = blockIdx.x; b < DECB; b += gridDim.x) {
        const size_t mb = (size_t)MP + (size_t)b * DECS;
        __syncthreads();
        for (int idx = tid; idx < 64 * 64; idx += 512) { const int r = idx >> 6, d = idx & 63, t = r >> 3, h = r & 7; Sf[r * 68 + d] = QH[(mb + t) * 768 + h * 96 + d]; }
        for (int idx = tid; idx < 64 * 16; idx += 512) { const int r = idx >> 4, f = idx & 15, t = r >> 3, h = r & 7; const float* qrow = QH + (mb + t) * 768 + h * 96 + 64;
            const float* rt = rope + (size_t)(SEQ + t) * 32; const float cs = rt[f], sn = rt[16 + f], x1 = qrow[f], x2 = qrow[16 + f];
            Qs[r * 296 + 256 + f] = (bf16)f2bf((x1 * cs - x2 * sn) * MLA_SCALE); Qs[r * 296 + 272 + f] = (bf16)f2bf((x2 * cs + x1 * sn) * MLA_SCALE); }
        __syncthreads();
        {
            const int l = tid & 255, th = tid >> 8;
            for (int h = 0; h < 8; ++h) {
                float a0 = 0.f, a1 = 0.f, a2 = 0.f, a3 = 0.f; const float* wr = wuk + (size_t)l * 512 + h * 64;
                const float* q0 = Sf + ((th * 4 + 0) * 8 + h) * 68; const float* q1 = Sf + ((th * 4 + 1) * 8 + h) * 68; const float* q2 = Sf + ((th * 4 + 2) * 8 + h) * 68; const float* q3 = Sf + ((th * 4 + 3) * 8 + h) * 68;
#pragma unroll 4
                for (int d4 = 0; d4 < 16; ++d4) { const f32x4 wv = *(const f32x4*)(wr + 4 * d4);
#pragma unroll
                    for (int j = 0; j < 4; ++j) { a0 += q0[4 * d4 + j] * wv[j]; a1 += q1[4 * d4 + j] * wv[j]; a2 += q2[4 * d4 + j] * wv[j]; a3 += q3[4 * d4 + j] * wv[j]; } }
                Qs[((th * 4 + 0) * 8 + h) * 296 + l] = (bf16)f2bf(a0 * MLA_SCALE); Qs[((th * 4 + 1) * 8 + h) * 296 + l] = (bf16)f2bf(a1 * MLA_SCALE);
                Qs[((th * 4 + 2) * 8 + h) * 296 + l] = (bf16)f2bf(a2 * MLA_SCALE); Qs[((th * 4 + 3) * 8 + h) * 296 + l] = (bf16)f2bf(a3 * MLA_SCALE);
            }
        }
        __syncthreads();
        const int rt = w & 3, hh = w >> 2;
        bf16x8 qf[9];
#pragma unroll
        for (int ks = 0; ks < 9; ++ks) qf[ks] = ld8(Qs + (rt * 16 + (lane & 15)) * 296 + ks * 32 + 8 * (lane >> 4));
        float mrun[4], lrun[4], alpha[4]; f32x4 o[8];
#pragma unroll
        for (int r = 0; r < 4; ++r) { mrun[r] = -INFINITY; lrun[r] = 0.f; }
#pragma unroll
        for (int nt = 0; nt < 8; ++nt) o[nt] = (f32x4){0.f, 0.f, 0.f, 0.f};
        constexpr int NT = PAST / 64 + 1;
        for (int kt = 0; kt < NT; ++kt) {
            const bool fresh = kt == NT - 1;
            __syncthreads();
            if (!fresh) {
                const int k0 = kt * 64; const size_t rowbase = (size_t)ptab[b * NPAGES + (k0 >> 7)] * PAGE + (k0 & 127);
#pragma unroll 2
                for (int j = 0; j < 8; ++j) { const int idx = tid + 512 * j, key = idx >> 6, l4 = idx & 63;
                    const f32x4 v = *(const f32x4*)(clat + (rowbase + key) * 256 + 4 * l4);
                    u32x2 pk; pk.x = pk2(v[0], v[1]); pk.y = pk2(v[2], v[3]); *(u32x2*)(Ks + key * 296 + 4 * l4) = pk;
                    Lt[(4 * l4 + 0) * 72 + key] = (bf16)f2bf(v[0]); Lt[(4 * l4 + 1) * 72 + key] = (bf16)f2bf(v[1]); Lt[(4 * l4 + 2) * 72 + key] = (bf16)f2bf(v[2]); Lt[(4 * l4 + 3) * 72 + key] = (bf16)f2bf(v[3]); }
                { const int key = tid >> 3, i4 = tid & 7; const f32x4 v = *(const f32x4*)(ckr + (rowbase + key) * 32 + 4 * i4);
                    u32x2 pk; pk.x = pk2(v[0], v[1]); pk.y = pk2(v[2], v[3]); *(u32x2*)(Ks + key * 296 + 256 + 4 * i4) = pk; }
            } else {
                const float* nl = c.out + O_LATS + (size_t)b * DECS * 256; const float* nk = c.out + O_KPES + (size_t)b * DECS * 32;
                for (int idx = tid; idx < 64 * 256; idx += 512) { const int key = idx >> 8, l = idx & 255; const bf16 v = key < DECS ? (bf16)f2bf(nl[key * 256 + l]) : (bf16)0; Ks[key * 296 + l] = v; Lt[l * 72 + key] = v; }
                for (int idx = tid; idx < 64 * 32; idx += 512) { const int key = idx >> 5, f = idx & 31; Ks[key * 296 + 256 + f] = key < DECS ? (bf16)f2bf(nk[key * 32 + f]) : (bf16)0; }
            }
            __syncthreads();
#pragma unroll
            for (int n2 = 0; n2 < 2; ++n2) { const int nt = 2 * hh + n2; f32x4 s = (f32x4){0.f, 0.f, 0.f, 0.f};
#pragma unroll
                for (int ks = 0; ks < 9; ++ks) s = mfma16(qf[ks], ld8(Ks + (nt * 16 + (lane & 15)) * 296 + ks * 32 + 8 * (lane >> 4)), s);
#pragma unroll
                for (int r = 0; r < 4; ++r) { const int row = rt * 16 + (lane >> 4) * 4 + r, key = nt * 16 + (lane & 15); float v = s[r];
                    if (fresh && (key >= DECS || key > (row >> 3))) v = -INFINITY;
                    Sf[row * 68 + key] = v; } }
            __syncthreads();
            f32x4 s[4];
#pragma unroll
            for (int nt = 0; nt < 4; ++nt)
#pragma unroll
                for (int r = 0; r < 4; ++r) s[nt][r] = Sf[(rt * 16 + (lane >> 4) * 4 + r) * 68 + nt * 16 + (lane & 15)];
            softmax_strip(s, mrun, lrun, alpha, Ps, lane);
            WAVE_SYNC();
#pragma unroll
            for (int nt = 0; nt < 8; ++nt) {
#pragma unroll
                for (int r = 0; r < 4; ++r) o[nt][r] *= alpha[r];
#pragma unroll
                for (int k2 = 0; k2 < 2; ++k2) o[nt] = mfma16(ld8(Ps + (lane & 15) * 72 + k2 * 32 + 8 * (lane >> 4)), ld8(Lt + (hh * 128 + nt * 16 + (lane & 15)) * 72 + k2 * 32 + 8 * (lane >> 4)), o[nt]); }
            WAVE_SYNC();
        }
        __syncthreads();
#pragma unroll
        for (int nt = 0; nt < 8; ++nt)
#pragma unroll
            for (int r = 0; r < 4; ++r) Of[(rt * 16 + (lane >> 4) * 4 + r) * 260 + hh * 128 + nt * 16 + (lane & 15)] = o[nt][r] / lrun[r];
        __syncthreads();
        {
            const int d = tid & 63, h = tid >> 6; float a[8];
#pragma unroll
            for (int t = 0; t < 8; ++t) a[t] = 0.f;
            for (int l = 0; l < 256; ++l) { const float wv = wuv[(size_t)l * 512 + h * 64 + d];
#pragma unroll
                for (int t = 0; t < 8; ++t) a[t] += Of[(t * 8 + h) * 260 + l] * wv; }
#pragma unroll
            for (int t = 0; t < 8; ++t) OCAT[(mb + t) * D + 512 + h * 64 + d] = (bf16)f2bf(a[t]);
        }
    }
}

constexpr int NCH = SEQ / 64;
constexpr size_t HC_QG = WS_H, HC_BNT = HC_QG + (size_t)BATCH * 8 * NCH * 64 * 128 * 2,
    HC_A = HC_BNT + (size_t)BATCH * 8 * NCH * 128 * 128 * 2, HC_END = HC_A + (size_t)BATCH * 8 * NCH * 128 * 4;
constexpr size_t HC_SNT = WS_QH;
static_assert(HC_END <= WS_H_END && HC_SNT + (size_t)BATCH * 8 * NCH * 128 * 128 * 2 <= WS_OCAT, "hgrn scratch fits");
DEV u32x4 pack8(const float* v) { u32x4 o; o.x = pk2(v[0], v[1]); o.y = pk2(v[2], v[3]); o.z = pk2(v[4], v[5]); o.w = pk2(v[6], v[7]); return o; }

DEV void phase_hgrn_prep(const Ctx& c) {
    bf16* qt = (bf16*)c.lds;
    bf16* kt = qt + 64 * 136;
    bf16* vT = kt + 160 * 136;
    bf16* Ab = vT + 128 * 72;
    float* tot = (float*)(Ab + 64 * 72);
    bf16* kgl = (bf16*)(tot + 512);
    const bf16* PC = c.w<bf16>(WS_P1); float* ORAW = c.w<float>(WS_ORAW);
    bf16* QG = c.w<bf16>(HC_QG); bf16* BNT = c.w<bf16>(HC_BNT); float* Ag = c.w<float>(HC_A);
    const float* lbl = c.in<float>(25);
    const int tid = c.tid, lane = c.lane, w = c.wave;
    const int d = tid & 127, tq = tid >> 7;
    constexpr int NU = BATCH * 8 * NCH;
    bf16 rq[16], rf[16], rv[16];
#define HP_LOAD(u_) do { const int u__ = (u_); const int bh_ = u__ / NCH, n_ = u__ % NCH; const bf16* row_ = PC + ((size_t)(bh_ >> 3) * SEQ + (size_t)n_ * 64 + 16 * tq) * INC + (bh_ & 7) * 128 + d; \
        _Pragma("unroll") for (int i = 0; i < 16; ++i) { rq[i] = row_[(size_t)i * INC]; rf[i] = row_[(size_t)i * INC + 1024]; rv[i] = row_[(size_t)i * INC + 2048]; } } while (0)
    if ((int)blockIdx.x < NU) HP_LOAD(blockIdx.x);
    for (int u = blockIdx.x; u < NU; u += gridDim.x) {
        const int bh = u / NCH, n = u % NCH, b = bh >> 3, h = bh & 7;
        const size_t m0 = (size_t)b * SEQ + (size_t)n * 64;
        const float lb = sigmoidf_(lbl[1024 + h * 128 + d] - lbl[h * 128 + d]);
        float P[16], Sf[16], kk[16], qq[16], vv[16], ff[16];
        float run = 1.f;
#pragma unroll
        for (int i = 0; i < 16; ++i) {
            const float f = lb + (1.f - lb) * sigmoidf_(bf2f(rf[i]));
            ff[i] = f; kk[i] = 1.f - f; run *= f; P[i] = run;
            qq[i] = siluf_(bf2f(rq[i])) * DK_SCALE; vv[i] = bf2f(rv[i]);
        }
        { float sr = 1.f;
#pragma unroll
          for (int i = 15; i >= 0; --i) { Sf[i] = sr; sr *= ff[i]; } }
        if (u + (int)gridDim.x < NU) HP_LOAD(u + (int)gridDim.x);
        tot[tq * 128 + d] = run;
        { const u32x4 p0 = pack8(vv), p1 = pack8(vv + 8);
          *(u32x4*)(vT + d * 72 + 16 * tq) = p0; *(u32x4*)(vT + d * 72 + 16 * tq + 8) = p1; }
        for (int i = tid; i < 64 * 72 / 8; i += 512) { u32x4 z; z.x = z.y = z.z = z.w = 0u; *(u32x4*)(Ab + 8 * i) = z; }
        LDS_BARRIER();
        const float q0 = tot[d], q1 = tot[128 + d], q2 = tot[256 + d], q3 = tot[384 + d];
        const float Rt = tq == 0 ? 1.f : (tq == 1 ? q0 : (tq == 2 ? q0 * q1 : q0 * q1 * q2));
        const float Tt = tq == 0 ? q1 * q2 * q3 : (tq == 1 ? q2 * q3 : (tq == 2 ? q3 : 1.f));
        const float M1 = 1.f, M2 = tq == 0 ? q1 : 1.f, M3 = tq == 0 ? q1 * q2 : (tq == 1 ? q2 : 1.f);
        float kg[16];
#pragma unroll
        for (int i = 0; i < 16; ++i) {
            qt[(16 * tq + i) * 136 + d] = (bf16)f2bf(qq[i] * P[i]);
            QG[((size_t)u * 64 + 16 * tq + i) * 128 + d] = (bf16)f2bf(qq[i] * Rt * P[i]);
            kg[i] = kk[i] * Sf[i] * Tt;
            const float kinv = kk[i] * rcpf_(P[i]), ksf = kk[i] * Sf[i];
#pragma unroll
            for (int I = 0; I < 4; ++I) if (I >= tq) { const int base = I == 0 ? 0 : (I == 1 ? 16 : (I == 2 ? 48 : 96));
                const float mI = I == 1 ? M1 : (I == 2 ? M2 : M3);
                kt[(base + 16 * tq + i) * 136 + d] = (bf16)f2bf(I == tq ? kinv : ksf * mI); }
        }
        { bf16* g = kgl + d * 72 + 16 * tq; *(u32x4*)g = pack8(kg); *(u32x4*)(g + 8) = pack8(kg + 8); }
        if (tq == 0) Ag[(size_t)u * 128 + d] = (q0 * q1) * (q2 * q3);
        LDS_BARRIER();
        for (int ti = w; ti < 10; ti += 8) {
            const int I = ti == 0 ? 0 : (ti < 3 ? 1 : (ti < 6 ? 2 : 3)); const int J = ti - (I == 0 ? 0 : (I == 1 ? 1 : (I == 2 ? 3 : 6)));
            const int base = I == 0 ? 0 : (I == 1 ? 16 : (I == 2 ? 48 : 96));
            f32x4 acc = (f32x4){0.f, 0.f, 0.f, 0.f};
#pragma unroll
            for (int ks = 0; ks < 4; ++ks) acc = mfma16(ld8(qt + (16 * I + (lane & 15)) * 136 + ks * 32 + 8 * (lane >> 4)), ld8(kt + (base + 16 * J + (lane & 15)) * 136 + ks * 32 + 8 * (lane >> 4)), acc);
#pragma unroll
            for (int r = 0; r < 4; ++r) { const int i = 16 * I + (lane >> 4) * 4 + r, j = 16 * J + (lane & 15); Ab[i * 72 + j] = (bf16)f2bf((J < I || j <= i) ? acc[r] : 0.f); }
        }
        LDS_BARRIER();
        { const int it = w & 3;
          f32x4 acc[4];
#pragma unroll
          for (int e4 = 0; e4 < 4; ++e4) acc[e4] = (f32x4){0.f, 0.f, 0.f, 0.f};
#pragma unroll
          for (int ks = 0; ks < 2; ++ks) { const bf16x8 af = ld8(Ab + (16 * it + (lane & 15)) * 72 + ks * 32 + 8 * (lane >> 4)); bf16x8 vf[4];
#pragma unroll
            for (int e4 = 0; e4 < 4; ++e4) vf[e4] = ld8(vT + (16 * ((w >> 2) * 4 + e4) + (lane & 15)) * 72 + ks * 32 + 8 * (lane >> 4));
#pragma unroll
            for (int e4 = 0; e4 < 4; ++e4) acc[e4] = mfma16(af, vf[e4], acc[e4]); }
#pragma unroll
          for (int e4 = 0; e4 < 4; ++e4) { const int et = (w >> 2) * 4 + e4;
#pragma unroll
            for (int r = 0; r < 4; ++r) ORAW[(m0 + 16 * it + (lane >> 4) * 4 + r) * D + h * 128 + 16 * et + (lane & 15)] = acc[e4][r]; } }
        {
            bf16x8 ka[2];
#pragma unroll
            for (int ks = 0; ks < 2; ++ks) ka[ks] = ld8(kgl + (16 * w + (lane & 15)) * 72 + ks * 32 + 8 * (lane >> 4));
            bf16* g = BNT + (size_t)u * 16384;
            f32x4 acc[8];
#pragma unroll
            for (int et = 0; et < 8; ++et) acc[et] = (f32x4){0.f, 0.f, 0.f, 0.f};
#pragma unroll
            for (int ks = 0; ks < 2; ++ks) { bf16x8 vf[8];
#pragma unroll
                for (int et = 0; et < 8; ++et) vf[et] = ld8(vT + (16 * et + (lane & 15)) * 72 + ks * 32 + 8 * (lane >> 4));
#pragma unroll
                for (int et = 0; et < 8; ++et) acc[et] = mfma16(ka[ks], vf[et], acc[et]); }
#pragma unroll
            for (int et = 0; et < 8; ++et) { u32x2 o; o.x = pk2(acc[et][0], acc[et][1]); o.y = pk2(acc[et][2], acc[et][3]); *(u32x2*)(g + (16 * et + (lane & 15)) * 128 + 16 * w + 4 * (lane >> 4)) = o; }
        }
        LDS_BARRIER();
    }
}

#undef HP_LOAD
DEV void phase_hgrn_prefix(const Ctx& c) {
    const bf16* BNT = c.w<bf16>(HC_BNT); const float* Ag = c.w<float>(HC_A); bf16* SNT = c.w<bf16>(HC_SNT);
    constexpr int NV = BATCH * 8 * 2048;
    for (int v = blockIdx.x * 512 + c.tid; v < NV; v += gridDim.x * 512) {
        const int bh = v >> 11, x8 = (v & 2047) * 8, d0 = x8 & 127, e = x8 >> 7;
        float S[8];
#pragma unroll
        for (int j = 0; j < 8; ++j) S[j] = 0.f;
        const size_t base = (size_t)bh * NCH * 16384 + x8;
        constexpr int PFD = NCH < 8 ? NCH : 8;
        u32x4 bq[PFD]; f32x4 aq0[PFD], aq1[PFD];
#pragma unroll
        for (int j = 0; j < PFD; ++j) { bq[j] = *(const u32x4*)(BNT + base + (size_t)j * 16384); aq0[j] = *(const f32x4*)(Ag + ((size_t)bh * NCH + j) * 128 + d0); aq1[j] = *(const f32x4*)(Ag + ((size_t)bh * NCH + j) * 128 + d0 + 4); }
#pragma unroll
        for (int n = 0; n < NCH; ++n) {
            const u32x4 bv = bq[n % PFD]; const f32x4 a0 = aq0[n % PFD], a1 = aq1[n % PFD];
            if (n + PFD < NCH) { bq[n % PFD] = *(const u32x4*)(BNT + base + (size_t)(n + PFD) * 16384); aq0[n % PFD] = *(const f32x4*)(Ag + ((size_t)bh * NCH + n + PFD) * 128 + d0); aq1[n % PFD] = *(const f32x4*)(Ag + ((size_t)bh * NCH + n + PFD) * 128 + d0 + 4); }
            *(u32x4*)(SNT + base + (size_t)n * 16384) = pack8(S);
            S[0] = a0[0] * S[0] + __uint_as_float(bv.x << 16); S[1] = a0[1] * S[1] + __uint_as_float(bv.x & 0xffff0000u);
            S[2] = a0[2] * S[2] + __uint_as_float(bv.y << 16); S[3] = a0[3] * S[3] + __uint_as_float(bv.y & 0xffff0000u);
            S[4] = a1[0] * S[4] + __uint_as_float(bv.z << 16); S[5] = a1[1] * S[5] + __uint_as_float(bv.z & 0xffff0000u);
            S[6] = a1[2] * S[6] + __uint_as_float(bv.w << 16); S[7] = a1[3] * S[7] + __uint_as_float(bv.w & 0xffff0000u);
        }
        float* So = c.out + O_HGP + (size_t)bh * 16384;
#pragma unroll
        for (int j = 0; j < 8; ++j) So[(size_t)(d0 + j) * 128 + e] = S[j];
    }
}

DEV void phase_hgrn_out(const Ctx& c) {
    bf16* qg = (bf16*)c.lds;
    bf16* StT = qg + 64 * 136;
    float* ob = (float*)(StT + 128 * 136);
    const bf16* PC = c.w<bf16>(WS_P1); const float* ORAW = c.w<float>(WS_ORAW); bf16* OC = c.w<bf16>(WS_OCAT);
    const bf16* QG = c.w<bf16>(HC_QG); const bf16* SNT = c.w<bf16>(HC_SNT);
    const float* gn = c.in<float>(26);
    const int tid = c.tid, lane = c.lane, w = c.wave;
    const float gn0 = gn[lane], gn1 = gn[64 + lane];
    constexpr int NU = BATCH * 8 * NCH;
    u32x4 pq[2], ps[4]; float or0n[8], or1n[8]; bf16 zz0n[8], zz1n[8];
#define HO_LOAD(u_) do { const int u__ = (u_); const int bh_ = u__ / NCH, n_ = u__ % NCH, b_ = bh_ >> 3, h_ = bh_ & 7; const size_t m0_ = (size_t)b_ * SEQ + (size_t)n_ * 64; \
        _Pragma("unroll") for (int j = 0; j < 2; ++j) pq[j] = *(const u32x4*)(QG + (size_t)u__ * 8192 + 8 * (tid + 512 * j)); \
        _Pragma("unroll") for (int j = 0; j < 4; ++j) ps[j] = *(const u32x4*)(SNT + (size_t)u__ * 16384 + 8 * (tid + 512 * j)); \
        _Pragma("unroll") for (int i8 = 0; i8 < 8; ++i8) { const size_t m = m0_ + w * 8 + i8; or0n[i8] = ORAW[m * D + h_ * 128 + lane]; or1n[i8] = ORAW[m * D + h_ * 128 + 64 + lane]; \
            zz0n[i8] = PC[m * INC + 3072 + h_ * 128 + lane]; zz1n[i8] = PC[m * INC + 3072 + h_ * 128 + 64 + lane]; } } while (0)
    if ((int)blockIdx.x < NU) HO_LOAD(blockIdx.x);
    for (int u = blockIdx.x; u < NU; u += gridDim.x) {
        const int bh = u / NCH, n = u % NCH, b = bh >> 3, h = bh & 7; const size_t m0 = (size_t)b * SEQ + (size_t)n * 64;
        float or0[8], or1[8], zz0[8], zz1[8];
#pragma unroll
        for (int i8 = 0; i8 < 8; ++i8) { or0[i8] = or0n[i8]; or1[i8] = or1n[i8]; zz0[i8] = bf2f(zz0n[i8]); zz1[i8] = bf2f(zz1n[i8]); }
        LDS_BARRIER();
#pragma unroll
        for (int j = 0; j < 2; ++j) { const int idx = tid + 512 * j; *(u32x4*)(qg + (idx >> 4) * 136 + (idx & 15) * 8) = pq[j]; }
#pragma unroll
        for (int j = 0; j < 4; ++j) { const int idx = tid + 512 * j; *(u32x4*)(StT + (idx >> 4) * 136 + (idx & 15) * 8) = ps[j]; }
        if (u + (int)gridDim.x < NU) HO_LOAD(u + (int)gridDim.x);
        LDS_BARRIER();
        { const int it = w & 3; bf16x8 qa[4];
#pragma unroll
          for (int ks = 0; ks < 4; ++ks) qa[ks] = ld8(qg + (16 * it + (lane & 15)) * 136 + ks * 32 + 8 * (lane >> 4));
          f32x4 acc[4];
#pragma unroll
          for (int e4 = 0; e4 < 4; ++e4) acc[e4] = (f32x4){0.f, 0.f, 0.f, 0.f};
#pragma unroll
          for (int ks = 0; ks < 4; ++ks) { bf16x8 bs[4];
#pragma unroll
            for (int e4 = 0; e4 < 4; ++e4) bs[e4] = ld8(StT + (16 * ((w >> 2) * 4 + e4) + (lane & 15)) * 136 + ks * 32 + 8 * (lane >> 4));
#pragma unroll
            for (int e4 = 0; e4 < 4; ++e4) acc[e4] = mfma16(qa[ks], bs[e4], acc[e4]); }
#pragma unroll
          for (int e4 = 0; e4 < 4; ++e4) { const int et = (w >> 2) * 4 + e4;
#pragma unroll
            for (int r = 0; r < 4; ++r) ob[(16 * it + (lane >> 4) * 4 + r) * 132 + 16 * et + (lane & 15)] = acc[e4][r]; } }
        LDS_BARRIER();
        { float ss[8];
#pragma unroll
          for (int i8 = 0; i8 < 8; ++i8) { const int i = w * 8 + i8; or0[i8] += ob[i * 132 + lane]; or1[i8] += ob[i * 132 + 64 + lane]; ss[i8] = or0[i8] * or0[i8] + or1[i8] * or1[i8]; }
#pragma unroll
              for (int i8 = 0; i8 < 8; ++i8) ss[i8] = wave_sum(ss[i8]);
#pragma unroll
          for (int i8 = 0; i8 < 8; ++i8) { const size_t m = m0 + w * 8 + i8; const float r = rsqrtf(ss[i8] * (1.f / 128.f) + EPS);
            OC[m * D + h * 128 + lane] = (bf16)f2bf(or0[i8] * r * gn0 * siluf_(zz0[i8])); OC[m * D + h * 128 + 64 + lane] = (bf16)f2bf(or1[i8] * r * gn1 * siluf_(zz1[i8])); } }
    }
}


constexpr int NUG = BATCH * 4 * NCH;
constexpr size_t GC_W = WS_H, GC_UT = GC_W + (size_t)NUG * 64 * 128 * 2, GC_QG = GC_UT + (size_t)NUG * 128 * 64 * 4, GC_KGT = GC_QG + (size_t)NUG * 64 * 128 * 2,
    GC_AQK = GC_KGT + (size_t)NUG * 128 * 64 * 2, GC_GL = GC_AQK + (size_t)NUG * 64 * 64 * 2, GC_END = GC_GL + (size_t)NUG * 4;
static_assert(GC_END <= WS_H_END, "gdn scratch fits in H");

DEV void phase_gdn_prep(const Ctx& c) {
    bf16* qb = (bf16*)c.lds;
    bf16* kb = qb + 64 * 136;
    float* Lm = (float*)(kb + 64 * 136);
    float* part = Lm + 64 * 68;
    float* gl = part + 256; float* gcs = gl + 64; float* bet = gcs + 64; float* eg = bet + 64; float* egl = eg + 64; float* qn = egl + 64; float* kn = qn + 64;
    float* sqb = kn + 64;
    const bf16* P1 = c.w<bf16>(WS_P1);
    bf16* Wg = c.w<bf16>(GC_W); float* UTg = c.w<float>(GC_UT); bf16* QGg = c.w<bf16>(GC_QG); bf16* KGTg = c.w<bf16>(GC_KGT); bf16* AQKg = c.w<bf16>(GC_AQK); float* GLg = c.w<float>(GC_GL);
    const float* convw = c.in<float>(14);
    const int tid = c.tid, lane = c.lane, w = c.wave;
    const int role = tid >> 7, cc = tid & 127;
    for (int u = blockIdx.x; u < NUG; u += gridDim.x) {
        const int bh = u / NCH, n = u % NCH, b = bh >> 2, h = bh & 3;
        const size_t m0 = (size_t)b * SEQ + (size_t)n * 64;
        float x[64];
        if (role < 3) {
            const int col = role * 512 + h * 128 + cc;
            const float w0 = convw[col], w1 = convw[QKV_A + col], w2 = convw[2 * QKV_A + col], w3 = convw[3 * QKV_A + col];
            const bf16* src = P1 + m0 * LD1 + col;
            float p0 = 0.f, p1 = 0.f, p2 = 0.f;
            if (n > 0) { p0 = bf2f(src[-3 * (long)LD1]); p1 = bf2f(src[-2 * (long)LD1]); p2 = bf2f(src[-1 * (long)LD1]); }
#pragma unroll
            for (int j = 0; j < 64; ++j) x[j] = bf2f(src[(size_t)j * LD1]);
#pragma unroll
            for (int j = 0; j < 64; ++j) { const float cur = x[j]; const float y = w0 * p0 + w1 * p1 + w2 * p2 + w3 * cur; x[j] = siluf_(y); p0 = p1; p1 = p2; p2 = cur; }
            if (role < 2) {
#pragma unroll
                for (int j4 = 0; j4 < 16; ++j4) *(f32x4*)(sqb + tid * 68 + 4 * j4) = (f32x4){x[4 * j4] * x[4 * j4], x[4 * j4 + 1] * x[4 * j4 + 1], x[4 * j4 + 2] * x[4 * j4 + 2], x[4 * j4 + 3] * x[4 * j4 + 3]};
            }
        } else if (cc < 64) {
            const float Aexp = __expf(c.in<float>(15)[h]), dtb = c.in<float>(16)[h];
            bet[cc] = sigmoidf_(bf2f(P1[(m0 + cc) * LD1 + C_B + h]));
            gl[cc] = -Aexp * softplusf_(bf2f(P1[(m0 + cc) * LD1 + C_A + h]) + dtb);
        }
        __syncthreads();
        if (role == 3) {
            if (cc < 64) { float acc = 0.f, totl = 0.f;
                for (int i = 0; i < 64; ++i) { const float g = gl[i]; totl += g; if (i <= cc) acc += g; }
                gcs[cc] = acc; eg[cc] = __expf(acc); egl[cc] = __expf(totl - acc);
                if (cc == 0) GLg[u] = __expf(totl);
            } else { const int j = cc - 64; float sq = 0.f, sk = 0.f;
#pragma unroll 16
                for (int cx = 0; cx < 128; ++cx) { sq += sqb[cx * 68 + j]; sk += sqb[(128 + cx) * 68 + j]; }
                qn[j] = rsqrtf(sq + EPS); kn[j] = rsqrtf(sk + EPS); }
        }
        __syncthreads();
        if (role == 0) {
#pragma unroll
            for (int j = 0; j < 64; ++j) { const float qh = x[j] * qn[j]; qb[j * 136 + cc] = (bf16)f2bf(qh); QGg[((size_t)u * 64 + j) * 128 + cc] = (bf16)f2bf(qh * DK_SCALE * eg[j]); }
        } else if (role == 1) {
            bf16* g = KGTg + ((size_t)u * 128 + cc) * 64;
#pragma unroll
            for (int j8 = 0; j8 < 8; ++j8) { float t[8];
#pragma unroll
                for (int q = 0; q < 8; ++q) { const int j = 8 * j8 + q; const float kh = x[j] * kn[j]; kb[j * 136 + cc] = (bf16)f2bf(kh); t[q] = kh * egl[j]; x[j] = kh * bet[j] * eg[j]; }
                *(u32x4*)(g + 8 * j8) = pack8(t); }
        } else if (role == 2) {
#pragma unroll
            for (int j = 0; j < 64; ++j) x[j] *= bet[j];
        }
        __syncthreads();
        for (int ti = w; ti < 32; ti += 8) {
            const bool isq = ti >= 16; const int I = (ti & 15) >> 2, J = ti & 3;
            if (J > I) { if (isq) {
#pragma unroll
                    for (int r = 0; r < 4; ++r) AQKg[((size_t)u * 64 + 16 * I + (lane >> 4) * 4 + r) * 64 + 16 * J + (lane & 15)] = (bf16)0; }
                continue; }
            const bf16* Ab = isq ? qb : kb;
            f32x4 acc = (f32x4){0.f, 0.f, 0.f, 0.f};
#pragma unroll
            for (int ks = 0; ks < 4; ++ks) acc = mfma16(ld8(Ab + (16 * I + (lane & 15)) * 136 + ks * 32 + 8 * (lane >> 4)), ld8(kb + (16 * J + (lane & 15)) * 136 + ks * 32 + 8 * (lane >> 4)), acc);
#pragma unroll
            for (int r = 0; r < 4; ++r) { const int i = 16 * I + (lane >> 4) * 4 + r, j = 16 * J + (lane & 15);
                const float dcy = __expf(fminf(gcs[i] - gcs[j], 0.f));
                if (isq) AQKg[((size_t)u * 64 + i) * 64 + j] = (bf16)f2bf(i >= j ? acc[r] * DK_SCALE * dcy : 0.f);
                else Lm[i * 68 + j] = i > j ? bet[i] * acc[r] * dcy : 0.f; }
        }
        __syncthreads();
        if (role == 1 || role == 2) {
#pragma unroll
            for (int i = 1; i < 64; ++i) { float acc = x[i];
#pragma unroll
                for (int j = 0; j < i; ++j) acc -= Lm[i * 68 + j] * x[j];
                x[i] = acc; }
            if (role == 1) {
#pragma unroll
                for (int i = 0; i < 64; ++i) Wg[((size_t)u * 64 + i) * 128 + cc] = (bf16)f2bf(x[i]);
            } else { float* g = UTg + ((size_t)u * 128 + cc) * 64;
#pragma unroll
                for (int i4 = 0; i4 < 16; ++i4) *(f32x4*)(g + 4 * i4) = (f32x4){x[4 * i4], x[4 * i4 + 1], x[4 * i4 + 2], x[4 * i4 + 3]}; }
        }
        __syncthreads();
    }
}

DEV void phase_gdn_scan(const Ctx& c, int u_first, int u_stride) {
    bf16* wl = (bf16*)c.lds;
    bf16* qgl = wl + 64 * 136;
    bf16* kgT = qgl + 64 * 136;
    bf16* aqk = kgT + 128 * 72;
    bf16* StT = aqk + 64 * 72;
    bf16* vnT = StT + 128 * 136;
    float* ob = (float*)(vnT + 128 * 72);
    const bf16* P1 = c.w<bf16>(WS_P1); bf16* OCAT = c.w<bf16>(WS_OCAT);
    const bf16* Wg = c.w<bf16>(GC_W); const float* UTg = c.w<float>(GC_UT); const bf16* QGg = c.w<bf16>(GC_QG); const bf16* KGTg = c.w<bf16>(GC_KGT); const bf16* AQKg = c.w<bf16>(GC_AQK); const float* GLg = c.w<float>(GC_GL);
    const float* gn = c.in<float>(17);
    const int tid = c.tid, lane = c.lane, w = c.wave;
    constexpr int NU = BATCH * 4;
    for (int u = u_first; u < NU; u += u_stride) {
        const int b = u >> 2, h = u & 3; const size_t mb = (size_t)b * SEQ;
        f32x4 S[8];
#pragma unroll
        for (int et = 0; et < 8; ++et) S[et] = (f32x4){0.f, 0.f, 0.f, 0.f};
        __syncthreads();
        for (int i = tid; i < 128 * 136 / 8; i += 512) { u32x4 z; z.x = z.y = z.z = z.w = 0u; *(u32x4*)(StT + 8 * i) = z; }
        u32x4 pw[2], pq[2], pk[2], pa;
        const size_t cu0 = (size_t)u * NCH;
#define GD_LOAD(n_) do { const bf16* g0 = Wg + (cu0 + (n_)) * 64 * 128; const bf16* g1 = QGg + (cu0 + (n_)) * 64 * 128; const bf16* g2 = KGTg + (cu0 + (n_)) * 128 * 64; const bf16* g3 = AQKg + (cu0 + (n_)) * 64 * 64; \
            _Pragma("unroll") for (int j = 0; j < 2; ++j) { const int idx = tid + 512 * j; pw[j] = *(const u32x4*)(g0 + 8 * idx); pq[j] = *(const u32x4*)(g1 + 8 * idx); pk[j] = *(const u32x4*)(g2 + 8 * idx); } \
            pa = *(const u32x4*)(g3 + 8 * tid); } while (0)
#define GD_STORE_WQ() do { _Pragma("unroll") for (int j = 0; j < 2; ++j) { const int idx = tid + 512 * j; *(u32x4*)(wl + (idx >> 4) * 136 + (idx & 15) * 8) = pw[j]; *(u32x4*)(qgl + (idx >> 4) * 136 + (idx & 15) * 8) = pq[j]; } } while (0)
#define GD_STORE_KA() do { _Pragma("unroll") for (int j = 0; j < 2; ++j) { const int idx = tid + 512 * j; *(u32x4*)(kgT + (idx >> 3) * 72 + (idx & 7) * 8) = pk[j]; } \
            *(u32x4*)(aqk + (tid >> 3) * 72 + (tid & 7) * 8) = pa; } while (0)
        GD_LOAD(0); GD_STORE_WQ(); GD_STORE_KA();
        __syncthreads();
        const int it = w & 3;
        const float gn0 = gn[lane], gn1 = gn[64 + lane];
        f32x4 u4[4]; float dec, decn;
#define GD_LOADU(dst, dd, n_) do { _Pragma("unroll") for (int e4 = 0; e4 < 4; ++e4) { const int et = (w >> 2) * 4 + e4; dst[e4] = *(const f32x4*)(UTg + ((cu0 + (n_)) * 128 + 16 * et + (lane & 15)) * 64 + 16 * it + 4 * (lane >> 4)); } dd = GLg[cu0 + (n_)]; } while (0)
        GD_LOADU(u4, decn, 0);
        for (int n = 0; n < NCH; ++n) {
            dec = decn;
            if (n + 1 < NCH) GD_LOAD(n + 1);
            f32x4 ao[4], av[4];
#pragma unroll
            for (int e4 = 0; e4 < 4; ++e4) { ao[e4] = (f32x4){0.f, 0.f, 0.f, 0.f}; av[e4] = (f32x4){0.f, 0.f, 0.f, 0.f}; }
#pragma unroll
            for (int ks = 0; ks < 4; ++ks) {
                const bf16x8 wa = ld8(wl + (16 * it + (lane & 15)) * 136 + ks * 32 + 8 * (lane >> 4)), qa = ld8(qgl + (16 * it + (lane & 15)) * 136 + ks * 32 + 8 * (lane >> 4));
                bf16x8 bs[4];
#pragma unroll
                for (int e4 = 0; e4 < 4; ++e4) bs[e4] = ld8(StT + (16 * ((w >> 2) * 4 + e4) + (lane & 15)) * 136 + ks * 32 + 8 * (lane >> 4));
#pragma unroll
                for (int e4 = 0; e4 < 4; ++e4) { av[e4] = mfma16(wa, bs[e4], av[e4]); ao[e4] = mfma16(qa, bs[e4], ao[e4]); }
            }
#pragma unroll
            for (int e4 = 0; e4 < 4; ++e4) { const int et = (w >> 2) * 4 + e4; const f32x4 vn = u4[e4] - av[e4];
                u32x2 o; o.x = pk2(vn[0], vn[1]); o.y = pk2(vn[2], vn[3]); *(u32x2*)(vnT + (16 * et + (lane & 15)) * 72 + 16 * it + 4 * (lane >> 4)) = o; }
            if (n + 1 < NCH) GD_LOADU(u4, decn, n + 1);
            LDS_BARRIER();
            float zz0[8], zz1[8];
#pragma unroll
            for (int i8 = 0; i8 < 8; ++i8) { const size_t m = mb + (size_t)n * 64 + w * 8 + i8; zz0[i8] = bf2f(P1[m * LD1 + C_Z + h * 128 + lane]); zz1[i8] = bf2f(P1[m * LD1 + C_Z + h * 128 + 64 + lane]); }
#pragma unroll
            for (int et = 0; et < 8; ++et) S[et] = S[et] * dec;
#pragma unroll
            for (int ks = 0; ks < 2; ++ks) {
                const bf16x8 aa = ld8(aqk + (16 * it + (lane & 15)) * 72 + ks * 32 + 8 * (lane >> 4)), ka = ld8(kgT + (16 * w + (lane & 15)) * 72 + ks * 32 + 8 * (lane >> 4));
                bf16x8 vf[8];
#pragma unroll
                for (int et = 0; et < 8; ++et) vf[et] = ld8(vnT + (16 * et + (lane & 15)) * 72 + ks * 32 + 8 * (lane >> 4));
#pragma unroll
                for (int e4 = 0; e4 < 4; ++e4) ao[e4] = mfma16(aa, (w >> 2) ? vf[4 + e4] : vf[e4], ao[e4]);
#pragma unroll
                for (int et = 0; et < 8; ++et) S[et] = mfma16(ka, vf[et], S[et]);
            }
#pragma unroll
            for (int e4 = 0; e4 < 4; ++e4) { const int et = (w >> 2) * 4 + e4;
#pragma unroll
                for (int r = 0; r < 4; ++r) ob[(16 * it + (lane >> 4) * 4 + r) * 132 + 16 * et + (lane & 15)] = ao[e4][r]; }
#pragma unroll
            for (int et = 0; et < 8; ++et) { u32x2 o; o.x = pk2(S[et][0], S[et][1]); o.y = pk2(S[et][2], S[et][3]); *(u32x2*)(StT + (16 * et + (lane & 15)) * 136 + 16 * w + (lane >> 4) * 4) = o; }
            if (n + 1 < NCH) GD_STORE_WQ();
            LDS_BARRIER();
            { float ss[8], v0[8], v1[8];
#pragma unroll
              for (int i8 = 0; i8 < 8; ++i8) { const int i = w * 8 + i8; v0[i8] = ob[i * 132 + lane]; v1[i8] = ob[i * 132 + 64 + lane]; ss[i8] = v0[i8] * v0[i8] + v1[i8] * v1[i8]; }
#pragma unroll
              for (int i8 = 0; i8 < 8; ++i8) ss[i8] = wave_sum(ss[i8]);
#pragma unroll
              for (int i8 = 0; i8 < 8; ++i8) { const size_t m = mb + (size_t)n * 64 + w * 8 + i8; const float r = rsqrtf(ss[i8] * (1.f / 128.f) + EPS);
                OCAT[m * D + h * 128 + lane] = (bf16)f2bf(v0[i8] * r * gn0 * siluf_(zz0[i8])); OCAT[m * D + h * 128 + 64 + lane] = (bf16)f2bf(v1[i8] * r * gn1 * siluf_(zz1[i8])); } }
            if (n + 1 < NCH) GD_STORE_KA();
        }
#undef GD_LOAD
#undef GD_LOADU
#undef GD_STORE_WQ
#undef GD_STORE_KA
        int lane3 = lane; OPAQUE_V(lane3);
        float* So = c.out + O_GDNP + (size_t)(b * 4 + h) * 16384;
#pragma unroll
        for (int et = 0; et < 8; ++et)
#pragma unroll
            for (int r = 0; r < 4; ++r) So[(size_t)(16 * w + (lane3 >> 4) * 4 + r) * 128 + 16 * et + (lane3 & 15)] = S[et][r];
    }
}


template <int NT> DEV void softmax_rows(f32x4 (&s)[NT], float (&mrun)[4], float (&lrun)[4], float (&alpha)[4], bf16* Ps, int pitch, int lane) {
#pragma unroll
    for (int r = 0; r < 4; ++r) {
        float mx = s[0][r];
#pragma unroll
        for (int nt = 1; nt < NT; ++nt) mx = fmaxf(mx, s[nt][r]);
        mx = grp16_max(mx);
        const float mn = fmaxf(mrun[r], mx);
        alpha[r] = exp2f_(mrun[r] - mn); mrun[r] = mn;
        float sum = 0.f;
#pragma unroll
        for (int nt = 0; nt < NT; ++nt) { const float p = exp2f_(s[nt][r] - mn); s[nt][r] = p; sum += p; }
        sum = grp16_sum(sum); lrun[r] = lrun[r] * alpha[r] + sum;
    }
#pragma unroll
    for (int nt = 0; nt < NT; ++nt)
#pragma unroll
        for (int r = 0; r < 4; ++r) Ps[((lane >> 4) * 4 + r) * pitch + nt * 16 + (lane & 15)] = (bf16)f2bf(s[nt][r]);
}
DEV bf16x8 ldB_tr(const bf16* T, int pitch, int k0, int n0, int lane) {
    const bf16* p = T + (size_t)(k0 + 8 * (lane >> 4) + ((lane & 15) >> 2)) * pitch + n0 + 4 * (lane & 3);
    const s16x4 a = lds_tr(p), b = lds_tr(p + 4 * pitch);
    bf16x8 r; r[0] = a[0]; r[1] = a[1]; r[2] = a[2]; r[3] = a[3]; r[4] = b[0]; r[5] = b[1]; r[6] = b[2]; r[7] = b[3]; return r;
}
constexpr int AS_NSP = 2;
DEV void phase_attn_sample2(const Ctx& c) {
    bf16* Qs = (bf16*)c.lds;
    bf16* Kt0 = Qs + 64 * 296;
    bf16* Psb = Kt0 + 2 * 32 * 296;
    bf16* qtmp = Kt0;
    float* Xo = (float*)c.lds;
    float* Xm = Xo + 64 * 256; float* Xl = Xm + 64;
    const float* QH = c.w<float>(WS_QH); const float* rope = c.w<float>(WS_ROPE); const bf16* WUKB = c.w<bf16>(WS_WUKB);
    float* PO = c.w<float>(WS_PO); float* PM = c.w<float>(WS_PM); float* PL = c.w<float>(WS_PL);
    const float* clat = c.in<float>(4); const float* ckr = c.in<float>(5); const int* ptab = c.in<int>(7);
    const int tid = c.tid, lane = c.lane, w = c.wave, grp = w >> 2, wq = w & 3, gt = tid & 255;
    bf16* Kt = Kt0 + grp * 32 * 296; bf16* Ps = Psb + w * 16 * 40;
    constexpr int NPT32 = PAST / 32, TPS = NPT32 / AS_NSP;
    static_assert(NPT32 % (2 * AS_NSP) == 0, "tiles per split must be even");
    for (int u = blockIdx.x; u < DECB * AS_NSP; u += gridDim.x) {
        const int b = u / AS_NSP, sp = u % AS_NSP; const size_t mb = (size_t)MP + (size_t)b * DECS;
        __syncthreads();
        for (int idx = tid; idx < 64 * 8; idx += 512) { const int r = idx >> 3, ch = idx & 7, t = r >> 3, h = r & 7; const float* q = QH + (mb + t) * 768 + h * 96 + ch * 8;
            const f32x4 a = *(const f32x4*)q, bq = *(const f32x4*)(q + 4); u32x4 o; o.x = pk2(a[0], a[1]); o.y = pk2(a[2], a[3]); o.z = pk2(bq[0], bq[1]); o.w = pk2(bq[2], bq[3]); *(u32x4*)(qtmp + r * 72 + ch * 8) = o; }
        for (int idx = tid; idx < 64 * 16; idx += 512) { const int r = idx >> 4, f = idx & 15, t = r >> 3, h = r & 7; const float* qrow = QH + (mb + t) * 768 + h * 96 + 64;
            const float* rt = rope + (size_t)(SEQ + t) * 32; const float cs = rt[f], sn = rt[16 + f], x1 = qrow[f], x2 = qrow[16 + f];
            Qs[r * 296 + 256 + f] = (bf16)f2bf((x1 * cs - x2 * sn) * QK_SCALE2); Qs[r * 296 + 272 + f] = (bf16)f2bf((x2 * cs + x1 * sn) * QK_SCALE2); }
        __syncthreads();
        {
            const int h = w; bf16x8 af[2];
#pragma unroll
            for (int ks = 0; ks < 2; ++ks) af[ks] = ld8(qtmp + (((lane & 7)) * 8 + h) * 72 + ks * 32 + 8 * (lane >> 4));
#pragma unroll 4
            for (int nt = 0; nt < 16; ++nt) { f32x4 acc = (f32x4){0.f, 0.f, 0.f, 0.f};
#pragma unroll
                for (int ks = 0; ks < 2; ++ks) acc = mfma16(af[ks], ld8(WUKB + (size_t)(nt * 16 + (lane & 15)) * 512 + h * 64 + ks * 32 + 8 * (lane >> 4)), acc);
                if ((lane >> 4) < 2) {
#pragma unroll
                    for (int r = 0; r < 4; ++r) Qs[(((lane >> 4) * 4 + r) * 8 + h) * 296 + nt * 16 + (lane & 15)] = (bf16)f2bf(acc[r] * QK_SCALE2); } }
        }
        __syncthreads();
        float mrun[4], lrun[4], alpha[4]; f32x4 o[16];
#pragma unroll
        for (int r = 0; r < 4; ++r) { mrun[r] = -INFINITY; lrun[r] = 0.f; }
#pragma unroll
        for (int nt = 0; nt < 16; ++nt) o[nt] = (f32x4){0.f, 0.f, 0.f, 0.f};
        const int t_begin = sp * TPS, t_end = t_begin + TPS + (sp == AS_NSP - 1 ? 1 : 0);
        const int NI = (t_end - t_begin + 1) / 2;
        static_assert(NPAGES <= 64, "page table of one batch row is held one entry per lane");
        const int ptv = lane < NPAGES ? ptab[b * NPAGES + lane] : 0;
#ifdef HIPEMU
#define PT_LOOKUP(pg_) __shfl(ptv, (pg_))
#else
#define PT_LOOKUP(pg_) __builtin_amdgcn_readlane(ptv, (pg_))
#endif
        f32x4 plA[8], prA, plB[8], prB;
        const float* nl = c.out + O_LATS + (size_t)b * DECS * 256; const float* nk = c.out + O_KPES + (size_t)b * DECS * 32;
#define AS_LOAD(pl, pr, tile_) do { const int tl_ = (tile_); \
            if (tl_ < NPT32) { const int k0_ = tl_ * 32; const size_t rb_ = (size_t)PT_LOOKUP(k0_ >> 7) * PAGE + (k0_ & 127); \
                _Pragma("unroll") for (int j = 0; j < 8; ++j) { const int idx = gt + 256 * j; pl[j] = NT_LOAD4(clat + (rb_ + (idx >> 6)) * 256 + 4 * (idx & 63)); } \
                pr = NT_LOAD4(ckr + (rb_ + (gt >> 3)) * 32 + 4 * (gt & 7)); } \
            else if (tl_ == NPT32) { \
                _Pragma("unroll") for (int j = 0; j < 8; ++j) { const int idx = gt + 256 * j, key = idx >> 6; pl[j] = key < DECS ? *(const f32x4*)(nl + key * 256 + 4 * (idx & 63)) : (f32x4){0.f, 0.f, 0.f, 0.f}; } \
                pr = (gt >> 3) < DECS ? *(const f32x4*)(nk + (gt >> 3) * 32 + 4 * (gt & 7)) : (f32x4){0.f, 0.f, 0.f, 0.f}; } } while (0)
#define AS_ITER(pl, pr, it_) do { \
            const int tile = t_begin + 2 * (it_) + grp; const bool valid = tile < t_end; \
            if (valid) { \
                _Pragma("unroll") for (int j = 0; j < 8; ++j) { const int idx = gt + 256 * j; u32x2 pk; pk.x = pk2(pl[j][0], pl[j][1]); pk.y = pk2(pl[j][2], pl[j][3]); *(u32x2*)(Kt + (idx >> 6) * 296 + 4 * (idx & 63)) = pk; } \
                { u32x2 pk; pk.x = pk2(pr[0], pr[1]); pk.y = pk2(pr[2], pr[3]); *(u32x2*)(Kt + (gt >> 3) * 296 + 256 + 4 * (gt & 7)) = pk; } \
            } \
            { const int nt_ = tile + 4; AS_LOAD(pl, pr, nt_ < t_end ? nt_ : NPT32 + 1); } \
            LDS_BARRIER(); \
            if (valid) { \
                f32x4 s[2], s2_[2]; \
                _Pragma("unroll") for (int nt = 0; nt < 2; ++nt) { s[nt] = (f32x4){0.f, 0.f, 0.f, 0.f}; s2_[nt] = (f32x4){0.f, 0.f, 0.f, 0.f}; } \
                _Pragma("unroll") for (int ks = 0; ks < 9; ++ks) {   \
                    const bf16x8 qa_ = ld8(Qs + (wq * 16 + (lane & 15)) * 296 + ks * 32 + 8 * (lane >> 4)); \
                    const bf16x8 k0_ = ld8(Kt + ((lane & 15)) * 296 + ks * 32 + 8 * (lane >> 4)), k1_ = ld8(Kt + (16 + (lane & 15)) * 296 + ks * 32 + 8 * (lane >> 4)); \
                    if (ks & 1) { s2_[0] = mfma16(qa_, k0_, s2_[0]); s2_[1] = mfma16(qa_, k1_, s2_[1]); } else { s[0] = mfma16(qa_, k0_, s[0]); s[1] = mfma16(qa_, k1_, s[1]); } } \
                s[0] += s2_[0]; s[1] += s2_[1]; \
                if (tile == NPT32) { \
                    _Pragma("unroll") for (int nt = 0; nt < 2; ++nt) \
                        _Pragma("unroll") for (int r = 0; r < 4; ++r) { const int row = wq * 16 + (lane >> 4) * 4 + r, key = nt * 16 + (lane & 15); if (key >= DECS || key > (row >> 3)) s[nt][r] = -INFINITY; } \
                } \
                softmax_rows<2>(s, mrun, lrun, alpha, Ps, 40, lane); \
                WAVE_SYNC(); \
                const bf16x8 pf = ld8(Ps + (lane & 15) * 40 + 8 * (lane >> 4)); \
                if (wave_any((alpha[0] != 1.f) | (alpha[1] != 1.f) | (alpha[2] != 1.f) | (alpha[3] != 1.f))) { \
                    _Pragma("unroll") for (int nt = 0; nt < 16; ++nt) \
                        _Pragma("unroll") for (int r = 0; r < 4; ++r) o[nt][r] *= alpha[r]; } \
                _Pragma("unroll") for (int nt = 0; nt < 16; ++nt) o[nt] = mfma16(pf, ldB_tr(Kt, 296, 0, nt * 16, lane), o[nt]); \
            } \
            LDS_BARRIER(); } while (0)
        AS_LOAD(plA, prA, t_begin + grp < t_end ? t_begin + grp : NPT32 + 1);
        AS_LOAD(plB, prB, t_begin + 2 + grp < t_end ? t_begin + 2 + grp : NPT32 + 1);
#pragma unroll 1
        for (int it = 0; it < NI; it += 2) {
            AS_ITER(plA, prA, it);
            if (it + 1 < NI) AS_ITER(plB, prB, it + 1);
        }
#undef AS_ITER
#undef PT_LOOKUP
#undef AS_LOAD
        int lane2 = lane; OPAQUE_V(lane2);
        if (grp == 1) {
#pragma unroll
            for (int nt = 0; nt < 16; ++nt)
#pragma unroll
                for (int r = 0; r < 4; ++r) Xo[(wq * 16 + (lane2 >> 4) * 4 + r) * 256 + nt * 16 + (lane2 & 15)] = o[nt][r];
            if ((lane2 & 15) == 0) {
#pragma unroll
                for (int r = 0; r < 4; ++r) { Xm[wq * 16 + (lane2 >> 4) * 4 + r] = mrun[r]; Xl[wq * 16 + (lane2 >> 4) * 4 + r] = lrun[r]; } }
        }
        __syncthreads();
        if (grp == 0) {
            float a1[4], a2[4];
#pragma unroll
            for (int r = 0; r < 4; ++r) { const int row = wq * 16 + (lane2 >> 4) * 4 + r; const float m2 = Xm[row], l2 = Xl[row]; const float mm = fmaxf(mrun[r], m2);
                a1[r] = exp2f_(mrun[r] - mm); a2[r] = exp2f_(m2 - mm); lrun[r] = lrun[r] * a1[r] + l2 * a2[r]; mrun[r] = mm;
                if ((lane2 & 15) == 0) { PM[(size_t)u * 64 + row] = mm; PL[(size_t)u * 64 + row] = lrun[r]; } }
#pragma unroll
            for (int nt = 0; nt < 16; ++nt)
#pragma unroll
                for (int r = 0; r < 4; ++r) { const int row = wq * 16 + (lane2 >> 4) * 4 + r, col = nt * 16 + (lane2 & 15); PO[((size_t)u * 64 + row) * 256 + col] = o[nt][r] * a1[r] + Xo[row * 256 + col] * a2[r]; }
        }
    }
}
DEV void phase_attn_sample_combine(const Ctx& c) {
    bf16* Ol = (bf16*)c.lds;
    const float* PO = c.w<float>(WS_PO); const float* PM = c.w<float>(WS_PM); const float* PL = c.w<float>(WS_PL);
    const bf16* WUV = c.w<bf16>(WS_WUKV) + (size_t)512 * 256; bf16* OCAT = c.w<bf16>(WS_OCAT);
    const int tid = c.tid, lane = c.lane, w = c.wave;
    for (int b = (int)gridDim.x - 1 - (int)blockIdx.x; b < DECB; b += gridDim.x) {
        const size_t mb = (size_t)MP + (size_t)b * DECS;
        __syncthreads();
        for (int idx = tid; idx < 64 * 64; idx += 512) { const int row = idx >> 6, c4 = idx & 63;
            float mm = -INFINITY;
#pragma unroll
            for (int s = 0; s < AS_NSP; ++s) mm = fmaxf(mm, PM[((size_t)b * AS_NSP + s) * 64 + row]);
            float lt = 0.f; f32x4 acc = (f32x4){0.f, 0.f, 0.f, 0.f};
#pragma unroll
            for (int s = 0; s < AS_NSP; ++s) { const size_t ur = ((size_t)b * AS_NSP + s) * 64 + row; const float a = exp2f_(PM[ur] - mm); lt += PL[ur] * a; acc += *(const f32x4*)(PO + ur * 256 + 4 * c4) * a; }
            const float inv = 1.f / lt; u32x2 o; o.x = pk2(acc[0] * inv, acc[1] * inv); o.y = pk2(acc[2] * inv, acc[3] * inv); *(u32x2*)(Ol + row * 264 + 4 * c4) = o; }
        __syncthreads();
        { const int h = w;
#pragma unroll
          for (int nt = 0; nt < 4; ++nt) { f32x4 acc = (f32x4){0.f, 0.f, 0.f, 0.f};
#pragma unroll
            for (int ks = 0; ks < 8; ++ks) acc = mfma16(ld8(Ol + ((lane & 7) * 8 + h) * 264 + ks * 32 + 8 * (lane >> 4)), ld8(WUV + (size_t)(h * 64 + nt * 16 + (lane & 15)) * 256 + ks * 32 + 8 * (lane >> 4)), acc);
            if ((lane >> 4) < 2) {
#pragma unroll
                for (int r = 0; r < 4; ++r) OCAT[(mb + (lane >> 4) * 4 + r) * D + 512 + h * 64 + nt * 16 + (lane & 15)] = (bf16)f2bf(acc[r]); } } }
    }
}

DEV bf16x8 cvt8(const f32x4 a, const f32x4 b, float sc) { bf16x8 r; const u32x4 p = {pk2(a[0] * sc, a[1] * sc), pk2(a[2] * sc, a[3] * sc), pk2(b[0] * sc, b[1] * sc), pk2(b[2] * sc, b[3] * sc)};
    r = __builtin_bit_cast(bf16x8, p); return r; }
DEV void phase_attn_prompt2(const Ctx& c, int qid = 0) {
    bf16* KV0 = (bf16*)c.lds;
    constexpr int KVB = 64 * 104 + 64 * 72;
    bf16* Psb = KV0 + 2 * KVB;
    const float* QH = c.w<float>(WS_QH); const bf16* KVP = c.w<bf16>(WS_KVP); const bf16* KPEB = c.w<bf16>(WS_KPEB); const float* rope = c.w<float>(WS_ROPE); bf16* OCAT = c.w<bf16>(WS_OCAT);
    const int tid = c.tid, lane = c.lane, w = c.wave;
    bf16* Ps = Psb + w * 32 * 72;
    constexpr int NQB = SEQ / 256, NPU = NQB * BATCH * 8;
    for (;;) {
        const int pu = queue_next(c, qid);
        if (pu >= NPU) break;
        const int qb = NQB - 1 - pu / (BATCH * 8), bh = pu % (BATCH * 8), b = bh >> 3, h = bh & 7; const size_t mb = (size_t)b * SEQ;
        {
            const int q0 = qb * 256, rmin = q0 + 32 * w;
            bf16x8 qf[2][3];
#pragma unroll
            for (int mt = 0; mt < 2; ++mt) { const int qr = rmin + 16 * mt + (lane & 15); const float* qrow = QH + (mb + qr) * 768 + h * 96; const int g = lane >> 4;
#pragma unroll
                for (int ks = 0; ks < 2; ++ks) qf[mt][ks] = cvt8(*(const f32x4*)(qrow + ks * 32 + 8 * g), *(const f32x4*)(qrow + ks * 32 + 8 * g + 4), QK_SCALE2);
                const int f0 = 8 * (g & 1); const float* rt = rope + (size_t)qr * 32;
                const f32x4 x1a = *(const f32x4*)(qrow + 64 + f0), x1b = *(const f32x4*)(qrow + 64 + f0 + 4), x2a = *(const f32x4*)(qrow + 80 + f0), x2b = *(const f32x4*)(qrow + 80 + f0 + 4);
                const f32x4 ca = *(const f32x4*)(rt + f0), cb = *(const f32x4*)(rt + f0 + 4), sa = *(const f32x4*)(rt + 16 + f0), sb = *(const f32x4*)(rt + 16 + f0 + 4);
                const f32x4 ya = g < 2 ? x1a * ca - x2a * sa : x2a * ca + x1a * sa, yb = g < 2 ? x1b * cb - x2b * sb : x2b * cb + x1b * sb;
                qf[mt][2] = cvt8(ya, yb, QK_SCALE2); }
            float mrun[2][4], lrun[2][4], alpha[2][4]; f32x4 o[2][4];
#pragma unroll
            for (int mt = 0; mt < 2; ++mt) {
#pragma unroll
                for (int r = 0; r < 4; ++r) { mrun[mt][r] = -INFINITY; lrun[mt][r] = 0.f; }
#pragma unroll
                for (int nt = 0; nt < 4; ++nt) o[mt][nt] = (f32x4){0.f, 0.f, 0.f, 0.f}; }
            const int nkt = 4 * qb + 4;
            u32x4 pk_, pp_, pv_;
#define AP_LOAD(kt_) do { const size_t kr_ = mb + (size_t)(kt_) * 64; \
                pk_ = *(const u32x4*)(KVP + (kr_ + (tid >> 3)) * 1024 + h * 64 + (tid & 7) * 8); \
                pv_ = *(const u32x4*)(KVP + (kr_ + (tid >> 3)) * 1024 + 512 + h * 64 + (tid & 7) * 8); \
                if (tid < 256) pp_ = *(const u32x4*)(KPEB + (kr_ + (tid >> 2)) * 32 + (tid & 3) * 8); } while (0)
#define AP_STORE(buf_) do { bf16* Kb_ = KV0 + (buf_) * KVB; bf16* Vb_ = Kb_ + 64 * 104; \
                *(u32x4*)(Kb_ + (tid >> 3) * 104 + (tid & 7) * 8) = pk_; *(u32x4*)(Vb_ + (tid >> 3) * 72 + (tid & 7) * 8) = pv_; \
                if (tid < 256) *(u32x4*)(Kb_ + (tid >> 2) * 104 + 64 + (tid & 3) * 8) = pp_; } while (0)
            __syncthreads();
            AP_LOAD(0); AP_STORE(0);
            if (nkt > 1) AP_LOAD(1);
            __syncthreads();
            for (int kt = 0; kt < nkt; ++kt) {
                const bf16* Ks = KV0 + (kt & 1) * KVB; const bf16* Vs = Ks + 64 * 104;
                if (kt + 1 < nkt) AP_STORE((kt + 1) & 1);
                if (kt + 2 < nkt) AP_LOAD(kt + 2);
                const int k0 = kt * 64;
                if (k0 <= rmin + 31) {
                    f32x4 s[2][4];
#pragma unroll
                    for (int nt = 0; nt < 4; ++nt) { s[0][nt] = (f32x4){0.f, 0.f, 0.f, 0.f}; s[1][nt] = (f32x4){0.f, 0.f, 0.f, 0.f}; }
#pragma unroll
                    for (int ks = 0; ks < 3; ++ks) {
                        bf16x8 kf[4];
#pragma unroll
                        for (int nt = 0; nt < 4; ++nt) kf[nt] = ld8(Ks + (nt * 16 + (lane & 15)) * 104 + ks * 32 + 8 * (lane >> 4));
#pragma unroll
                        for (int nt = 0; nt < 4; ++nt) { s[0][nt] = mfma16(qf[0][ks], kf[nt], s[0][nt]); s[1][nt] = mfma16(qf[1][ks], kf[nt], s[1][nt]); } }
                    if (k0 + 63 > rmin) {
#pragma unroll
                        for (int mt = 0; mt < 2; ++mt)
#pragma unroll
                            for (int nt = 0; nt < 4; ++nt)
#pragma unroll
                                for (int r = 0; r < 4; ++r) { const int qpos = rmin + 16 * mt + (lane >> 4) * 4 + r, kpos = k0 + nt * 16 + (lane & 15); if (kpos > qpos) s[mt][nt][r] = -INFINITY; }
                    }
                    softmax_rows<4>(s[0], mrun[0], lrun[0], alpha[0], Ps, 72, lane);
                    softmax_rows<4>(s[1], mrun[1], lrun[1], alpha[1], Ps + 16 * 72, 72, lane);
                    WAVE_SYNC();
                    if (wave_any((alpha[0][0] != 1.f) | (alpha[0][1] != 1.f) | (alpha[0][2] != 1.f) | (alpha[0][3] != 1.f) | (alpha[1][0] != 1.f) | (alpha[1][1] != 1.f) | (alpha[1][2] != 1.f) | (alpha[1][3] != 1.f))) {
#pragma unroll
                    for (int mt = 0; mt < 2; ++mt)
#pragma unroll
                        for (int nt = 0; nt < 4; ++nt)
#pragma unroll
                            for (int r = 0; r < 4; ++r) o[mt][nt][r] *= alpha[mt][r]; }
#pragma unroll
                    for (int k2 = 0; k2 < 2; ++k2) { const bf16x8 p0 = ld8(Ps + (lane & 15) * 72 + k2 * 32 + 8 * (lane >> 4)), p1 = ld8(Ps + (16 + (lane & 15)) * 72 + k2 * 32 + 8 * (lane >> 4));
                        bf16x8 vf[4];
#pragma unroll
                        for (int nt = 0; nt < 4; ++nt) vf[nt] = ldB_tr(Vs, 72, k2 * 32, nt * 16, lane);
#pragma unroll
                        for (int nt = 0; nt < 4; ++nt) { o[0][nt] = mfma16(p0, vf[nt], o[0][nt]); o[1][nt] = mfma16(p1, vf[nt], o[1][nt]); } }
                    WAVE_SYNC();
                }
                LDS_BARRIER();
            }
#undef AP_LOAD
#undef AP_STORE
#pragma unroll
            for (int mt = 0; mt < 2; ++mt)
#pragma unroll
                for (int nt = 0; nt < 4; ++nt)
#pragma unroll
                    for (int r = 0; r < 4; ++r) OCAT[(mb + rmin + 16 * mt + (lane >> 4) * 4 + r) * D + 512 + h * 64 + nt * 16 + (lane & 15)] = (bf16)f2bf(o[mt][nt][r] / lrun[mt][r]);
        }
    }
}

DEV void phase_attn_prompt3(const Ctx& c, int qid = 0) {
    bf16* KV0 = (bf16*)c.lds;
    constexpr int KVB = 64 * 104 + 64 * 72;
    const float* QH = c.w<float>(WS_QH); const bf16* KVP = c.w<bf16>(WS_KVP); const bf16* KPEB = c.w<bf16>(WS_KPEB); const float* rope = c.w<float>(WS_ROPE); bf16* OCAT = c.w<bf16>(WS_OCAT);
    const int tid = c.tid, lane = c.lane, w = c.wave;
    constexpr int NQB = SEQ / 256, NPU = NQB * BATCH * 8;
    for (;;) {
        const int pu = queue_next(c, qid);
        if (pu >= NPU) break;
        const int qb = NQB - 1 - pu / (BATCH * 8), bh = pu % (BATCH * 8), b = bh >> 3, h = bh & 7; const size_t mb = (size_t)b * SEQ;
        {
            const int q0 = qb * 256, rmin = q0 + 32 * w;
            bf16x8 qf[2][3];
#pragma unroll
            for (int mt = 0; mt < 2; ++mt) { const int qr = rmin + 16 * mt + (lane & 15); const float* qrow = QH + (mb + qr) * 768 + h * 96; const int g = lane >> 4;
#pragma unroll
                for (int ks = 0; ks < 2; ++ks) qf[mt][ks] = cvt8(*(const f32x4*)(qrow + ks * 32 + 8 * g), *(const f32x4*)(qrow + ks * 32 + 8 * g + 4), QK_SCALE2);
                const int f0 = 8 * (g & 1); const float* rt = rope + (size_t)qr * 32;
                const f32x4 x1a = *(const f32x4*)(qrow + 64 + f0), x1b = *(const f32x4*)(qrow + 64 + f0 + 4), x2a = *(const f32x4*)(qrow + 80 + f0), x2b = *(const f32x4*)(qrow + 80 + f0 + 4);
                const f32x4 ca = *(const f32x4*)(rt + f0), cb = *(const f32x4*)(rt + f0 + 4), sa = *(const f32x4*)(rt + 16 + f0), sb = *(const f32x4*)(rt + 16 + f0 + 4);
                const f32x4 ya = g < 2 ? x1a * ca - x2a * sa : x2a * ca + x1a * sa, yb = g < 2 ? x1b * cb - x2b * sb : x2b * cb + x1b * sb;
                qf[mt][2] = cvt8(ya, yb, QK_SCALE2); }
            float mrun[2], lrun[2], alpha[2]; f32x4 o[2][4];
#pragma unroll
            for (int mt = 0; mt < 2; ++mt) { mrun[mt] = -INFINITY; lrun[mt] = 0.f;
#pragma unroll
                for (int nt = 0; nt < 4; ++nt) o[mt][nt] = (f32x4){0.f, 0.f, 0.f, 0.f}; }
            const int nkt = 4 * qb + 4;
            u32x4 pk_, pp_, pv_;
#define AP_LOAD(kt_) do { const size_t kr_ = mb + (size_t)(kt_) * 64; \
                pk_ = *(const u32x4*)(KVP + (kr_ + (tid >> 3)) * 1024 + h * 64 + (tid & 7) * 8); \
                pv_ = *(const u32x4*)(KVP + (kr_ + (tid >> 3)) * 1024 + 512 + h * 64 + (tid & 7) * 8); \
                if (tid < 256) pp_ = *(const u32x4*)(KPEB + (kr_ + (tid >> 2)) * 32 + (tid & 3) * 8); } while (0)
#define AP_STORE(buf_) do { bf16* Kb_ = KV0 + (buf_) * KVB; bf16* Vb_ = Kb_ + 64 * 104; \
                *(u32x4*)(Kb_ + (tid >> 3) * 104 + (tid & 7) * 8) = pk_; *(u32x4*)(Vb_ + (tid >> 3) * 72 + (tid & 7) * 8) = pv_; \
                if (tid < 256) *(u32x4*)(Kb_ + (tid >> 2) * 104 + 64 + (tid & 3) * 8) = pp_; } while (0)
            __syncthreads();
            AP_LOAD(0); AP_STORE(0);
            if (nkt > 1) AP_LOAD(1);
            __syncthreads();
            for (int kt = 0; kt < nkt; ++kt) {
                const bf16* Ks = KV0 + (kt & 1) * KVB; const bf16* Vs = Ks + 64 * 104;
                if (kt + 1 < nkt) AP_STORE((kt + 1) & 1);
                if (kt + 2 < nkt) AP_LOAD(kt + 2);
                const int k0 = kt * 64;
                if (k0 <= rmin + 31) {
                    f32x4 s[2][4];
#pragma unroll
                    for (int nt = 0; nt < 4; ++nt) { s[0][nt] = (f32x4){0.f, 0.f, 0.f, 0.f}; s[1][nt] = (f32x4){0.f, 0.f, 0.f, 0.f}; }
#pragma unroll
                    for (int ks = 0; ks < 3; ++ks) {
                        bf16x8 kf[4];
#pragma unroll
                        for (int nt = 0; nt < 4; ++nt) kf[nt] = ld8(Ks + (nt * 16 + (lane & 15)) * 104 + ks * 32 + 8 * (lane >> 4));
#pragma unroll
                        for (int nt = 0; nt < 4; ++nt) { s[0][nt] = mfma16(kf[nt], qf[0][ks], s[0][nt]); s[1][nt] = mfma16(kf[nt], qf[1][ks], s[1][nt]); } }
                    if (k0 + 63 > rmin) {
#pragma unroll
                        for (int mt = 0; mt < 2; ++mt)
#pragma unroll
                            for (int nt = 0; nt < 4; ++nt)
#pragma unroll
                                for (int r = 0; r < 4; ++r) { const int qpos = rmin + 16 * mt + (lane & 15), kpos = k0 + nt * 16 + (lane >> 4) * 4 + r; if (kpos > qpos) s[mt][nt][r] = -INFINITY; }
                    }
#pragma unroll
                    for (int mt = 0; mt < 2; ++mt) {
                        float mx = s[mt][0][0];
#pragma unroll
                        for (int nt = 0; nt < 4; ++nt)
#pragma unroll
                            for (int r = 0; r < 4; ++r) mx = fmaxf(mx, s[mt][nt][r]);
                        mx = xg_max(mx);
                        const float mn = fmaxf(mrun[mt], mx);
                        alpha[mt] = exp2f_(mrun[mt] - mn); mrun[mt] = mn;
                        float sum = 0.f;
#pragma unroll
                        for (int nt = 0; nt < 4; ++nt)
#pragma unroll
                            for (int r = 0; r < 4; ++r) { const float pv = exp2f_(s[mt][nt][r] - mn); s[mt][nt][r] = pv; sum += pv; }
                        lrun[mt] = lrun[mt] * alpha[mt] + xg_sum(sum);
                    }
                    if (wave_any((alpha[0] != 1.f) | (alpha[1] != 1.f))) {
#pragma unroll
                        for (int mt = 0; mt < 2; ++mt)
#pragma unroll
                            for (int nt = 0; nt < 4; ++nt) o[mt][nt] = o[mt][nt] * alpha[mt]; }
#pragma unroll
                    for (int k2 = 0; k2 < 2; ++k2) {
                        bf16x8 pf[2];
#pragma unroll
                        for (int mt = 0; mt < 2; ++mt) { const u32x4 pw = {pk2(s[mt][2 * k2][0], s[mt][2 * k2][1]), pk2(s[mt][2 * k2][2], s[mt][2 * k2][3]), pk2(s[mt][2 * k2 + 1][0], s[mt][2 * k2 + 1][1]), pk2(s[mt][2 * k2 + 1][2], s[mt][2 * k2 + 1][3])};
                            pf[mt] = __builtin_bit_cast(bf16x8, pw); }
                        bf16x8 vf[4];
#pragma unroll
                        for (int nt = 0; nt < 4; ++nt) { const bf16* vb = Vs + (size_t)(32 * k2 + 4 * (lane >> 4) + ((lane & 15) >> 2)) * 72 + nt * 16 + 4 * (lane & 3);
                            const s16x4 a = lds_tr(vb), bq = lds_tr(vb + 16 * 72);
                            bf16x8 r8; r8[0] = a[0]; r8[1] = a[1]; r8[2] = a[2]; r8[3] = a[3]; r8[4] = bq[0]; r8[5] = bq[1]; r8[6] = bq[2]; r8[7] = bq[3]; vf[nt] = r8; }
#pragma unroll
                        for (int nt = 0; nt < 4; ++nt) { o[0][nt] = mfma16(vf[nt], pf[0], o[0][nt]); o[1][nt] = mfma16(vf[nt], pf[1], o[1][nt]); } }
                }
                LDS_BARRIER();
            }
#undef AP_LOAD
#undef AP_STORE
#pragma unroll
            for (int mt = 0; mt < 2; ++mt) { const float inv = 1.f / lrun[mt];
#pragma unroll
                for (int nt = 0; nt < 4; ++nt) { u32x2 ov; ov.x = pk2(o[mt][nt][0] * inv, o[mt][nt][1] * inv); ov.y = pk2(o[mt][nt][2] * inv, o[mt][nt][3] * inv);
                    *(u32x2*)(OCAT + (mb + rmin + 16 * mt + (lane & 15)) * D + 512 + h * 64 + nt * 16 + 4 * (lane >> 4)) = ov; } }
        }
    }
}

DEV void phase_gdn_sample(const Ctx& c, int wg_first, int wg_stride) {
    float* red = (float*)c.lds; float* red2 = red + 512; float* qs = red2 + 512; float* ks = qs + 128; float* vs = ks + 128; float* part = vs + 128;
    float* scb = part + 8; float* scg = scb + 8; float* obuf = scg + 8;
    const bf16* P1 = c.w<bf16>(WS_P1); bf16* OCAT = c.w<bf16>(WS_OCAT);
    const float* convw = c.in<float>(14); const float* gn = c.in<float>(17);
    const int tid = c.tid, lane = c.lane, wave = c.wave;
    const int e = tid & 127, dg = tid >> 7, d0 = dg * 32;
    for (int u = wg_first; u < DECB * 4; u += wg_stride) {
        const int b = u >> 2, h = u & 3; const size_t m0 = (size_t)MP + (size_t)b * DECS;
        float s[32];
        { const float* S0 = c.in<float>(2) + ((size_t)(b * 4 + h) * 128 + d0) * 128 + e;
#pragma unroll
          for (int i = 0; i < 32; ++i) s[i] = S0[(size_t)i * 128]; }
        const int col = tid < 128 ? h * 128 + tid : (tid < 256 ? 512 + h * 128 + (tid - 128) : 1024 + h * 128 + (tid - 256));
        float w0 = 0.f, w1 = 0.f, w2 = 0.f, w3 = 0.f, x0 = 0.f, x1 = 0.f, x2 = 0.f; bf16 xs[8];
#pragma unroll
        for (int t = 0; t < 8; ++t) xs[t] = 0;
        if (tid < 384) { w0 = convw[col]; w1 = convw[QKV_A + col]; w2 = convw[2 * QKV_A + col]; w3 = convw[3 * QKV_A + col];
            const float* cb = c.in<float>(3) + (size_t)b * 3 * QKV_A + col; x0 = cb[0]; x1 = cb[QKV_A]; x2 = cb[2 * QKV_A];
#pragma unroll
            for (int t = 0; t < 8; ++t) xs[t] = P1[(m0 + t) * LD1 + col]; }
        else if (tid < 392) { const int t = tid - 384; const float Aexp = __expf(c.in<float>(15)[h]), dtb = c.in<float>(16)[h];
            scb[t] = sigmoidf_(bf2f(P1[(m0 + t) * LD1 + C_B + h])); scg[t] = __expf(-Aexp * softplusf_(bf2f(P1[(m0 + t) * LD1 + C_A + h]) + dtb)); }
        const bf16 zr0 = P1[(m0 + wave) * LD1 + C_Z + h * 128 + lane], zr1 = P1[(m0 + wave) * LD1 + C_Z + h * 128 + 64 + lane];
#pragma unroll
        for (int t = 0; t < 8; ++t) {
            float val = 0.f;
            if (tid < 384) { const float x3 = bf2f(xs[t]); const float y = w0 * x0 + w1 * x1 + w2 * x2 + w3 * x3; val = siluf_(y); x0 = x1; x1 = x2; x2 = x3; }
            const float sq = wave_sum(tid < 256 ? val * val : 0.f);
            if (tid < 128) qs[tid] = val; else if (tid < 256) ks[tid - 128] = val; else if (tid < 384) vs[tid - 256] = val;
            if (lane == 0 && wave < 4) part[wave] = sq;
            LDS_BARRIER();
            const float qn = rsqrtf(part[0] + part[1] + EPS), kn = rsqrtf(part[2] + part[3] + EPS), beta = scb[t], dec = scg[t];
            float kp = 0.f;
#pragma unroll
            for (int i = 0; i < 32; ++i) { s[i] *= dec; kp += ks[d0 + i] * s[i]; }
            red[dg * 128 + e] = kp * kn;
            LDS_BARRIER();
            const float kS = (red[e] + red[128 + e]) + (red[256 + e] + red[384 + e]);
            const float delta = beta * (vs[e] - kS) * kn;
            float op = 0.f;
#pragma unroll
            for (int i = 0; i < 32; ++i) { s[i] += ks[d0 + i] * delta; op += qs[d0 + i] * s[i]; }
            red2[dg * 128 + e] = op * qn;
            LDS_BARRIER();
            if (dg == 0) obuf[t * 128 + e] = ((red2[e] + red2[128 + e]) + (red2[256 + e] + red2[384 + e])) * DK_SCALE;
        }
        float* So = c.out + O_GDNS + ((size_t)(b * 4 + h) * 128 + d0) * 128 + e;
#pragma unroll
        for (int i = 0; i < 32; ++i) So[(size_t)i * 128] = s[i];
        LDS_BARRIER();
        {
            const size_t m = m0 + wave; const float v0 = obuf[wave * 128 + lane], v1 = obuf[wave * 128 + 64 + lane];
            const float r = rsqrtf(wave_sum(v0 * v0 + v1 * v1) * (1.f / 128.f) + EPS);
            OCAT[m * D + h * 128 + lane] = (bf16)f2bf(v0 * r * gn[lane] * siluf_(bf2f(zr0)));
            OCAT[m * D + h * 128 + 64 + lane] = (bf16)f2bf(v1 * r * gn[64 + lane] * siluf_(bf2f(zr1))); }
        LDS_BARRIER();
    }
}
DEV void phase_hgrn_sample(const Ctx& c, int wg_first, int wg_stride) {
    float* red = (float*)c.lds; float* qs = red + 512; float* fs = qs + 128; float* obuf = fs + 128;
    const bf16* PC = c.w<bf16>(WS_P1); bf16* OC = c.w<bf16>(WS_OCAT);
    const float* lbl = c.in<float>(25); const float* gn = c.in<float>(26);
    const int tid = c.tid, lane = c.lane, wave = c.wave;
    const int e = tid & 127, dg = tid >> 7, d0 = dg * 32;
    for (int u = wg_first; u < DECB * 8; u += wg_stride) {
        const int b = u >> 3, h = u & 7; const size_t m0 = (size_t)MP + (size_t)b * DECS;
        float s[32];
        { const float* S0 = c.in<float>(6) + ((size_t)(b * 8 + h) * 128 + d0) * 128 + e;
#pragma unroll
          for (int i = 0; i < 32; ++i) s[i] = S0[(size_t)i * 128]; }
        bf16 rq[8], rf[8], rv[8]; float lb = 0.f;
#pragma unroll
        for (int t = 0; t < 8; ++t) { rq[t] = 0; rf[t] = 0; rv[t] = PC[(m0 + t) * INC + 2048 + h * 128 + e]; }
        if (tid < 128) { lb = sigmoidf_(lbl[1024 + h * 128 + tid] - lbl[h * 128 + tid]);
#pragma unroll
            for (int t = 0; t < 8; ++t) { rq[t] = PC[(m0 + t) * INC + h * 128 + tid]; rf[t] = PC[(m0 + t) * INC + 1024 + h * 128 + tid]; } }
        const bf16 zr0 = PC[(m0 + wave) * INC + 3072 + h * 128 + lane], zr1 = PC[(m0 + wave) * INC + 3072 + h * 128 + 64 + lane];
#pragma unroll
        for (int t = 0; t < 8; ++t) {
            if (tid < 128) { qs[tid] = siluf_(bf2f(rq[t])); fs[tid] = lb + (1.f - lb) * sigmoidf_(bf2f(rf[t])); }
            const float v = bf2f(rv[t]);
            LDS_BARRIER();
            float op = 0.f;
#pragma unroll
            for (int i = 0; i < 32; ++i) { const float f = fs[d0 + i]; s[i] = f * s[i] + (1.f - f) * v; op += qs[d0 + i] * s[i]; }
            red[dg * 128 + e] = op;
            LDS_BARRIER();
            if (dg == 0) obuf[t * 128 + e] = ((red[e] + red[128 + e]) + (red[256 + e] + red[384 + e])) * DK_SCALE;
        }
        float* So = c.out + O_HGS + ((size_t)(b * 8 + h) * 128 + d0) * 128 + e;
#pragma unroll
        for (int i = 0; i < 32; ++i) So[(size_t)i * 128] = s[i];
        LDS_BARRIER();
        { const size_t m = m0 + wave; const float v0 = obuf[wave * 128 + lane], v1 = obuf[wave * 128 + 64 + lane];
          const float r = rsqrtf(wave_sum(v0 * v0 + v1 * v1) * (1.f / 128.f) + EPS);
          OC[m * D + h * 128 + lane] = (bf16)f2bf(v0 * r * gn[lane] * siluf_(bf2f(zr0)));
          OC[m * D + h * 128 + 64 + lane] = (bf16)f2bf(v1 * r * gn[64 + lane] * siluf_(bf2f(zr1))); }
        LDS_BARRIER();
    }
}

#ifndef HIPEMU
#define XB_TMO      128
#define XB_XCNT(j)  (256  + 64 * (j))
#define XB_XSUB(j)  (1280 + 64 * (j))
#define XB_XGEN(j)  (2304 + 64 * (j))
#define XB_TOP      3328
#define XB_TOPGEN   3392
#define XCD_BAR_WORDS 3456
#define XB_SPIN_CAP (1u << 22)
#define LAS __attribute__((address_space(3)))
__device__ __forceinline__ unsigned xb_ld(unsigned* p)              { return __hip_atomic_load(p, __ATOMIC_RELAXED, __HIP_MEMORY_SCOPE_AGENT); }
__device__ __forceinline__ unsigned xb_add(unsigned* p, unsigned v) { return __hip_atomic_fetch_add(p, v, __ATOMIC_RELAXED, __HIP_MEMORY_SCOPE_AGENT); }
__device__ __forceinline__ unsigned xb_xcc_id() { return (unsigned)__builtin_amdgcn_s_getreg((3 << 11) | 20) & 0xFu; }
#define XB_SPIN(cond, bar) do { unsigned _sp = 0; while (cond) { __builtin_amdgcn_s_sleep(1); \
    if ((++_sp & 255u) == 0u) { if (xb_ld(&(bar)[XB_TMO])) break; if (_sp > XB_SPIN_CAP) { atomicAdd(&(bar)[XB_TMO], 1u); break; } } } } while (0)
struct XcdBarrier { unsigned* bar; unsigned x; volatile LAS unsigned* st; bool t0; };
__device__ __forceinline__ XcdBarrier xcd_barrier_post(unsigned* bar, volatile LAS unsigned* st, bool t0) {
    XcdBarrier b; b.bar = bar; b.x = xb_xcc_id(); b.st = st; b.t0 = t0;
    if (t0) (void)xb_add(&bar[XB_XCNT(b.x)], 1u);
    return b;
}
__device__ __forceinline__ void xcd_barrier_complete(unsigned* bar, unsigned x, unsigned& nloc, unsigned& nx) {
    const unsigned G = gridDim.x * gridDim.y * gridDim.z;
    unsigned sum, cnt, mine, sp = 0u;
    for (;;) {
        sum = 0u; cnt = 0u; mine = 0u;
#pragma unroll
        for (unsigned j = 0; j < 16; ++j) { const unsigned c = xb_ld(&bar[XB_XCNT(j)]); sum += c; cnt += (c > 0u) ? 1u : 0u; mine = (j == x) ? c : mine; }
        if (sum == G) break;
        __builtin_amdgcn_s_sleep(1);
        if ((++sp & 255u) == 0u) { if (xb_ld(&bar[XB_TMO])) break; if (sp > XB_SPIN_CAP) { atomicAdd(&bar[XB_TMO], 1u); break; } }
    }
    nloc = mine > 0u ? mine : 1u; nx = cnt > 0u ? cnt : 1u;
}
__device__ __forceinline__ void xcd_barrier(const XcdBarrier& b) {
    asm volatile("s_waitcnt vmcnt(0)" ::: "memory");
    __syncthreads();
    if (b.t0) {
        unsigned* bar = b.bar;
        __builtin_amdgcn_s_waitcnt(0);
        unsigned nloc = b.st[0], nx = b.st[1];
        if (nloc == 0u) { xcd_barrier_complete(bar, b.x, nloc, nx); b.st[0] = nloc; b.st[1] = nx; }
        const unsigned old = xb_add(&bar[XB_XSUB(b.x)], 1u);
        const unsigned gen = old / nloc;
        if (old + 1u == (gen + 1u) * nloc) {
            __builtin_amdgcn_fence(__ATOMIC_RELEASE, "agent");
            asm volatile("s_waitcnt vmcnt(0)" ::: "memory");
            const unsigned og = xb_add(&bar[XB_TOP], 1u);
            const unsigned tg = og / nx;
            if (og + 1u == (tg + 1u) * nx) xb_add(&bar[XB_TOPGEN], 1u);
            else XB_SPIN(xb_ld(&bar[XB_TOPGEN]) == tg, bar);
            __builtin_amdgcn_fence(__ATOMIC_ACQUIRE, "agent");
            xb_add(&bar[XB_XGEN(b.x)], 1u);
            asm volatile("s_waitcnt vmcnt(0)" ::: "memory");
        } else {
            XB_SPIN(xb_ld(&bar[XB_XGEN(b.x)]) == gen, bar);
            __builtin_amdgcn_fence(__ATOMIC_ACQUIRE, "agent");
            asm volatile("s_waitcnt vmcnt(0)" ::: "memory");
        }
    }
    __syncthreads();
}
#endif

__global__ void __launch_bounds__(512, 2) mega_kernel(Params p) {
#ifdef HIPEMU
    unsigned char* lds = g_blk->smem;
#else
    extern __shared__ __attribute__((aligned(16))) unsigned char lds[];
#endif
    const int lo = p.ph_lo, hi = p.ph_hi;
#ifdef HIPEMU
    const int wave_s = threadIdx.x >> 6;
#define FRESH_LANE() ((int)(threadIdx.x & 63))
#define GRID_BAR(k) do { } while (0)
#else
    const int wave_s = __builtin_amdgcn_readfirstlane(threadIdx.x >> 6);
#define FRESH_LANE() ({ int l_; asm volatile("v_mbcnt_lo_u32_b32 %0, -1, 0\n\tv_mbcnt_hi_u32_b32 %0, -1, %0" : "=v"(l_)); l_; })
    { const int l0 = FRESH_LANE(); if (wave_s == 0) ((volatile LAS unsigned*)(lds + LDS_MISC))[l0] = 0u; }
    __syncthreads();
    if (hi - lo > 1) (void)xcd_barrier_post((unsigned*)(p.ws + WS_CTL), (volatile LAS unsigned*)(lds + LDS_MISC), wave_s == 0 && FRESH_LANE() == 0);
#define GRID_BAR(k) do { if (lo <= (k) && (k) + 1 < hi) { XcdBarrier bb_; bb_.bar = (unsigned*)(p.ws + WS_CTL); bb_.x = xb_xcc_id(); bb_.st = (volatile LAS unsigned*)(lds + LDS_MISC); bb_.t0 = (wave_s == 0 && FRESH_LANE() == 0); xcd_barrier(bb_); } } while (0)
#endif
#define MKCTX() Ctx c; c.p = &p; c.lds = lds; c.ws = p.ws; c.out = p.out; c.wave = wave_s; c.lane = FRESH_LANE(); c.tid = wave_s * 64 + c.lane; c.gw = blockIdx.x * 8 + wave_s; c.ngw = gridDim.x * 8;
#define IN(k) (lo <= (k) && (k) < hi)
#ifndef PROBE_MASK
#define PROBE_MASK 0u
#endif
#define NREP(k) (((PROBE_MASK >> (k)) & 1u) ? 2 : 1)
#ifndef PROBE_SUB
#define PROBE_SUB 0
#endif
#define SUB(id, ...) { MKCTX() __VA_ARGS__ } if (PROBE_SUB == (id)) { __syncthreads(); MKCTX() __VA_ARGS__ }
#define PHASE(k, ...) if (IN(k)) { { const int rep_ = 0; (void)rep_; MKCTX() __VA_ARGS__ } if (NREP(k) == 2) { const int rep_ = 1; (void)rep_; MKCTX() __VA_ARGS__ } }
#define X1 c.w<float>(WS_X1)
#define X2 c.w<float>(WS_X2)
#define P1 c.w<float>(WS_P1)
#define XN c.w<bf16>(WS_XN)
#define Hb c.w<bf16>(WS_H)
#define OCAT c.w<bf16>(WS_OCAT)

    PHASE(0,  phase_prologue(c); GRID_BAR(0); )
    PHASE(1,  run_gemm(c, XN, c.w<bf16>(WS_WINAB), M, LD1, D, EpiBf16<0>{c.w<bf16>(WS_P1), LD1}); GRID_BAR(1); )
    PHASE(2,  phase_prep0(c); GRID_BAR(2); )
    PHASE(3,          { run_gemm(c, c.w<bf16>(WS_CQN), c.w<bf16>(WS_WUQ), M, 768, 256, EpiStoreF32{c.w<float>(WS_QH), 768}); } { MKCTX() run_gemm(c, c.w<bf16>(WS_LATN), c.w<bf16>(WS_WUKV), MP, 1024, 256, EpiBf16<0>{c.w<bf16>(WS_KVP), 1024}); }         GRID_BAR(3); )
    PHASE(4,  { if ((blockIdx.x & 1) == 0) { MKCTX() phase_attn_sample2(c); } } __syncthreads(); { MKCTX() phase_gdn_prep(c); } __syncthreads();
               { if ((blockIdx.x & 1) != 0) { MKCTX() phase_attn_sample2(c); } } GRID_BAR(4); )
    PHASE(5,  SUB(4, phase_gdn_scan(c, blockIdx.x, gridDim.x);) __syncthreads(); SUB(5, phase_attn_sample_combine(c);) __syncthreads(); { MKCTX() phase_attn_prompt3(c, rep_ ? 6 : 0); } if (PROBE_SUB == 6) { __syncthreads(); MKCTX() phase_attn_prompt3(c, 5); } __syncthreads();
               SUB(9, const int NS_ = BATCH * 4; const int G_ = (int)gridDim.x; if (G_ > NS_ + 32) { if ((int)blockIdx.x >= NS_) { phase_gdn_sample(c, (int)blockIdx.x - NS_, G_ - NS_); } } else { phase_gdn_sample(c, (int)blockIdx.x, G_); }) __syncthreads();
               SUB(10, const int NS_ = BATCH * 4; const int G_ = (int)gridDim.x; if (G_ > NS_ + 32) { if ((int)blockIdx.x >= NS_) { phase_convert_late(c, c.gw - NS_ * 8, c.ngw - NS_ * 8); } } else { phase_convert_late(c, c.gw, c.ngw); }) GRID_BAR(5); )
    PHASE(6,  { run_gemm(c, OCAT, c.w<bf16>(WS_WOAB), MP, D, D, EpiResidF32{nullptr, c.in<float>(0), c.in<float>(1), X1}); } { MKCTX() run_gemm_sample_splitk(c, OCAT, c.w<bf16>(WS_WOAB), D, 256); } GRID_BAR(6); )
    PHASE(7,  phase_rmsnorm(c, X1, c.in<float>(9), nullptr, 4); GRID_BAR(7); )
    PHASE(8,  { run_gemm(c, XN, c.w<bf16>(WS_WUP0), M, FF, D, EpiBf16<1>{Hb, FF}); } __syncthreads();
               { MKCTX() const int NB_ = (M / 256 * (FF / 256)) % (int)gridDim.x, G_ = (int)gridDim.x;
                 if (NB_ > 0 && G_ - NB_ >= 32) { if ((int)blockIdx.x >= NB_) phase_convert_late2(c, c.gw - NB_ * 8, c.ngw - NB_ * 8); } else phase_convert_late2(c, c.gw, c.ngw); } GRID_BAR(8); )
    PHASE(9,  { run_gemm(c, Hb, c.w<bf16>(WS_WDN0), MP, D, FF, EpiResidF32{X1, nullptr, nullptr, X2}); } { MKCTX() run_gemm_sample_splitk(c, Hb, c.w<bf16>(WS_WDN0), FF, 256); } GRID_BAR(9); )
    PHASE(10,  phase_rmsnorm(c, X2, c.in<float>(8) + D, X1, 16); GRID_BAR(10); )
    PHASE(11,  run_gemm(c, XN, c.w<bf16>(WS_WINC), M, INC, D, EpiBf16<0>{c.w<bf16>(WS_P1), INC}); GRID_BAR(11); )
    PHASE(12,  SUB(7, phase_hgrn_prep(c);) GRID_BAR(12); )
    PHASE(13,  phase_hgrn_prefix(c); __syncthreads(); SUB(8, phase_hgrn_sample(c, (int)blockIdx.x, (int)gridDim.x);) GRID_BAR(13); )
    PHASE(14,  phase_hgrn_out(c); GRID_BAR(14); )
    PHASE(15,  { run_gemm(c, OCAT, c.w<bf16>(WS_WOC), MP, D, D, EpiResidF32{X2, nullptr, nullptr, X1}); } { MKCTX() run_gemm_sample_splitk(c, OCAT, c.w<bf16>(WS_WOC), D, 256); } GRID_BAR(15); )
    PHASE(16,  phase_rmsnorm(c, X1, c.in<float>(9) + D, X2, 4); GRID_BAR(16); )
    PHASE(17,  run_gemm(c, XN, c.w<bf16>(WS_WUP1), M, FF, D, EpiBf16<1>{Hb, FF}); GRID_BAR(17); )
    PHASE(18,  { run_gemm(c, Hb, c.w<bf16>(WS_WDN1), MP, D, FF, EpiResidF32{X1, nullptr, nullptr, X2}); } { MKCTX() run_gemm_sample_splitk(c, Hb, c.w<bf16>(WS_WDN1), FF, 256); } GRID_BAR(18); )
    PHASE(19,  phase_final(c, X2, c.in<float>(10), X1, 16); )
#undef IN
#undef X1
#undef X2
#undef P1
#undef XN
#undef Hb
#undef OCAT
}

#ifndef HIPEMU
extern "C" void kernel_launch(void* const* d_in, const int* in_sizes, int n_in, void* d_out, int out_size, void* d_ws, size_t ws_size, hipStream_t stream) {
    static int grid = 0;
    if (grid == 0) {
        if (n_in != 28 || (size_t)out_size != O_END || ws_size < WS_END) { fprintf(stderr, "kernel_launch: shape mismatch n_in %d out %d (want %zu) ws %zu (want %zu)\n", n_in, out_size, (size_t)O_END, ws_size, (size_t)WS_END); grid = -1; return; }
        int dev = 0, cus = 0, per_cu = 0;
        hipGetDevice(&dev); hipDeviceGetAttribute(&cus, hipDeviceAttributeMultiprocessorCount, dev);
        if (hipFuncSetAttribute((const void*)mega_kernel, hipFuncAttributeMaxDynamicSharedMemorySize, LDS_BYTES) != hipSuccess) { fprintf(stderr, "kernel_launch: hipFuncSetAttribute failed\n"); grid = -1; return; }
        if (hipOccupancyMaxActiveBlocksPerMultiprocessor(&per_cu, (const void*)mega_kernel, 512, LDS_BYTES) != hipSuccess || per_cu < 1) fprintf(stderr, "kernel_launch: occupancy query reports %d\n", per_cu);
        (void)hipGetLastError();
        grid = cus;
    }
    if (grid < 0) return;
    hipMemsetAsync((char*)d_ws + WS_CTL, 0, CTL_BYTES, stream);
    Params p{};
    for (int i = 0; i < 28; ++i) p.in[i] = d_in[i];
    p.out = (float*)d_out; p.ws = (unsigned char*)d_ws;
#if MK_N_LAUNCHES == 1
    p.ph_lo = 0; p.ph_hi = NPHASE;
    hipLaunchKernelGGL(mega_kernel, dim3(grid), dim3(512), LDS_BYTES, stream, p);
#else
    for (int k = 0; k < NPHASE; ++k) { p.ph_lo = k; p.ph_hi = k + 1; hipLaunchKernelGGL(mega_kernel, dim3(grid), dim3(512), LDS_BYTES, stream, p); }
#endif
}
#else
size_t emu_ws_bytes() { return WS_END; }
size_t emu_out_floats() { return O_END; }
void emu_forward(void* const* d_in, float* d_out, unsigned char* d_ws, int grid, int ph_from, int ph_to) {
    memset(d_ws + WS_CTL, 0, CTL_BYTES);
    Params p{};
    for (int i = 0; i < 28; ++i) p.in[i] = d_in[i];
    p.out = d_out; p.ws = d_ws;
    for (int k = ph_from; k < ph_to && k < NPHASE; ++k) { p.ph_lo = k; p.ph_hi = k + 1; fprintf(stderr, "[emu] phase %d\n", k); emu_launch(grid, 512, LDS_BYTES, [=]() { mega_kernel(p); }); }
}
struct EmuBuf { const char* name; size_t off; size_t bytes; int kind;   int ld; };
extern const EmuBuf emu_bufs[] = {
    {"P1", WS_P1, (size_t)M * 4096 * 4, 0, LD1}, {"XN", WS_XN, (size_t)M * D * 2, 1, D}, {"QH", WS_QH, (size_t)M * 768 * 4, 0, 768}, {"KVP", WS_KVP, (size_t)MP * 1024 * 2, 1, 1024},
    {"OCAT", WS_OCAT, (size_t)M * D * 2, 1, D}, {"ORAW", WS_ORAW, (size_t)M * D * 4, 0, D}, {"X1", WS_X1, (size_t)M * D * 4, 0, D}, {"X2", WS_X2, (size_t)M * D * 4, 0, D},
    {"H", WS_H, (size_t)M * FF * 2, 1, FF}, {"CQN", WS_CQN, (size_t)M * 256 * 2, 1, 256}, {"LATN", WS_LATN, (size_t)M * 256 * 2, 1, 256}, {nullptr, 0, 0, 0, 0}};
extern const int emu_cfg[8] = {BATCH, SEQ, DECB, PAST, MP, MS, MT, M};
#endif
```
